# Optimizing an MI355X kernel written in HIP

```python
import math
import jax, jax.numpy as jnp
from jax import lax
import numpy as np

D_MODEL = 1024
BATCH = 8
SEQ = 2048
DEPTH = 1
DEC_BATCH = 128
DEC_SEQ = 1
PAST_LEN = 16384
PAGE_SIZE = 128

D_MIX = D_MODEL
HG_WIDTH = D_MIX // 2
GDN_WIDTH = D_MIX - HG_WIDTH
HG_HEADS = 4
HG_KEY = 128
HG_VAL = HG_WIDTH // HG_HEADS
GDN_HEADS = 4
GDN_DK = 128
GDN_DV = GDN_WIDTH // GDN_HEADS
CONV_W = 4
CHUNK = 64
EPS = 1e-6

SPLITS = (HG_HEADS * HG_KEY, HG_HEADS * HG_KEY, HG_WIDTH, HG_WIDTH,
          GDN_HEADS * GDN_DK, GDN_HEADS * GDN_DK, GDN_WIDTH, GDN_WIDTH,
          GDN_HEADS, GDN_HEADS)
D_IN = sum(SPLITS)
SPLIT_POINTS = tuple(int(v) for v in np.cumsum(SPLITS)[:-1])
CONV_CH = 2 * GDN_HEADS * GDN_DK + GDN_WIDTH

kernel_name = "hgrn2_gated_deltanet_parallel_heads_step"


def rmsnorm(x, w):
    x32 = x.astype(jnp.float32)
    y = x32 * lax.rsqrt(jnp.mean(x32 * x32, axis=-1, keepdims=True) + EPS)
    return (y * w.astype(jnp.float32)).astype(x.dtype)


def l2norm(x):
    return x * lax.rsqrt(jnp.sum(x * x, axis=-1, keepdims=True) + EPS)


def _chunks(a):
    B, T = a.shape[:2]
    a = a.reshape((B, T // CHUNK, CHUNK) + a.shape[2:])
    return jnp.moveaxis(jnp.moveaxis(a, 1, 0), 2, 3)


def _unchunks(o):
    n, B, H, C, V = o.shape
    return jnp.moveaxis(jnp.moveaxis(o, 0, 1), 3, 2).reshape(B, n * C, H, V)


def hgrn2_chunked(q, k, v, log_f, s0):
    causal = jnp.tril(jnp.ones((CHUNK, CHUNK), dtype=bool))

    def step(s, inp):
        qc, kc, vc, lfc = inp
        b = jnp.cumsum(lfc, axis=2)
        diff = b[:, :, :, None, :] - b[:, :, None, :, :]
        decay = jnp.exp(jnp.where(causal[:, :, None], diff, -jnp.inf))
        scores = jnp.einsum('bhtk,bhtsk,bhsk->bhts', qc, decay, kc)
        o = (jnp.einsum('bhts,bhsv->bhtv', scores, vc)
             + jnp.einsum('bhtk,bhkv->bhtv', qc * jnp.exp(b), s))
        b_last = b[:, :, -1:, :]
        s_new = (jnp.exp(b_last[:, :, 0, :])[..., None] * s
                 + jnp.einsum('bhsk,bhsv->bhkv', kc * jnp.exp(b_last - b), vc))
        return s_new, o

    s_fin, o = lax.scan(step, s0, (_chunks(q), _chunks(k), _chunks(v), _chunks(log_f)))
    return _unchunks(o), s_fin


def hgrn2_recurrent(q, k, v, log_f, s0):
    def step(s, inp):
        qt, kt, vt, lft = inp
        s = jnp.exp(lft)[..., None] * s + kt[..., None] * vt[:, :, None, :]
        return s, jnp.einsum('bhk,bhkv->bhv', qt, s)

    tm = lambda a: jnp.moveaxis(a, 1, 0)
    s_fin, o = lax.scan(step, s0, (tm(q), tm(k), tm(v), tm(log_f)))
    return jnp.moveaxis(o, 0, 1), s_fin


def gdn_chunked(q, k, v, beta, g, s0):
    causal = jnp.tril(jnp.ones((CHUNK, CHUNK), dtype=bool))
    strict = jnp.tril(jnp.ones((CHUNK, CHUNK), dtype=bool), k=-1)
    eye = jnp.eye(CHUNK, dtype=jnp.float32)
    V = v.shape[-1]

    def step(s, inp):
        qc, kc, vc, bc, gc = inp
        G = jnp.cumsum(gc, axis=-1)
        diff = G[..., :, None] - G[..., None, :]
        L = jnp.exp(jnp.where(causal, diff, -jnp.inf))
        kb = kc * bc[..., None]
        A = jnp.where(strict, jnp.einsum('bhtk,bhsk->bhts', kb, kc) * L, 0.0) + eye
        rhs = jnp.concatenate([vc * bc[..., None], kb * jnp.exp(G)[..., None]], axis=-1)
        sol = lax.linalg.triangular_solve(A, rhs, left_side=True, lower=True,
                                          unit_diagonal=True)
        u = sol[..., :V] - jnp.einsum('bhtk,bhkv->bhtv', sol[..., V:], s)
        attn = jnp.einsum('bhtk,bhsk->bhts', qc, kc) * L
        o = (jnp.einsum('bhtk,bhkv->bhtv', qc * jnp.exp(G)[..., None], s)
             + jnp.einsum('bhts,bhsv->bhtv', attn, u))
        G_last = G[..., -1:]
        s_new = (jnp.exp(G_last)[..., None] * s
                 + jnp.einsum('bhsk,bhsv->bhkv', kc * jnp.exp(G_last - G)[..., None], u))
        return s_new, o

    s_fin, o = lax.scan(step, s0, (_chunks(q), _chunks(k), _chunks(v),
                                   _chunks(beta), _chunks(g)))
    return _unchunks(o), s_fin


def gdn_recurrent(q, k, v, beta, g, s0):
    def step(s, inp):
        qt, kt, vt, bt, gt = inp
        s = jnp.exp(gt)[..., None, None] * s
        delta = (vt - jnp.einsum('bhk,bhkv->bhv', kt, s)) * bt[..., None]
        s = s + kt[..., None] * delta[:, :, None, :]
        return s, jnp.einsum('bhk,bhkv->bhv', qt, s)

    tm = lambda a: jnp.moveaxis(a, 1, 0)
    s_fin, o = lax.scan(step, s0, (tm(q), tm(k), tm(v), tm(beta), tm(g)))
    return jnp.moveaxis(o, 0, 1), s_fin


def hybrid_mixer(h, w_in, conv_w, lb, a_log, dt_bias, hg_norm, gdn_norm, w_out,
                 s_hg, s_gdn, conv_prev, chunked):
    f32 = jnp.float32
    B, T, _ = h.shape
    p = jnp.einsum('btd,de->bte', h, w_in).astype(f32)
    hq, hf, hi, hz, gq, gk, gv, gz, gb, ga = jnp.split(p, SPLIT_POINTS, axis=-1)

    fg = lb + (1.0 - lb) * jax.nn.sigmoid(hf)
    hg_q = hq.reshape(B, T, HG_HEADS, HG_KEY)
    hg_k = (1.0 - fg).reshape(B, T, HG_HEADS, HG_KEY)
    hg_lf = jnp.log(fg).reshape(B, T, HG_HEADS, HG_KEY)
    hg_v = hi.reshape(B, T, HG_HEADS, HG_VAL)

    qkv = jnp.concatenate([gq, gk, gv], axis=-1)
    padded = jnp.concatenate([conv_prev.astype(f32), qkv], axis=1)
    cw = conv_w.astype(f32)
    conv = sum(padded[:, j:j + T] * cw[j] for j in range(CONV_W))
    qkv_c = jax.nn.silu(conv)
    new_conv = padded[:, T:]
    cq, ck, cv = jnp.split(qkv_c, (GDN_HEADS * GDN_DK, 2 * GDN_HEADS * GDN_DK), axis=-1)
    gdn_q = l2norm(cq.reshape(B, T, GDN_HEADS, GDN_DK)) * (GDN_DK ** -0.5)
    gdn_k = l2norm(ck.reshape(B, T, GDN_HEADS, GDN_DK))
    gdn_v = cv.reshape(B, T, GDN_HEADS, GDN_DV)
    beta = jax.nn.sigmoid(gb)
    g = -jnp.exp(a_log.astype(f32)) * jax.nn.softplus(ga + dt_bias.astype(f32))

    s_hg = s_hg.astype(f32)
    s_gdn = s_gdn.astype(f32)
    if chunked:
        o_hg, s_hg_new = hgrn2_chunked(hg_q, hg_k, hg_v, hg_lf, s_hg)
        o_gdn, s_gdn_new = gdn_chunked(gdn_q, gdn_k, gdn_v, beta, g, s_gdn)
    else:
        o_hg, s_hg_new = hgrn2_recurrent(hg_q, hg_k, hg_v, hg_lf, s_hg)
        o_gdn, s_gdn_new = gdn_recurrent(gdn_q, gdn_k, gdn_v, beta, g, s_gdn)

    o_hg = rmsnorm(o_hg, hg_norm) * jax.nn.silu(hz.reshape(B, T, HG_HEADS, HG_VAL))
    o_gdn = rmsnorm(o_gdn, gdn_norm) * jax.nn.silu(gz.reshape(B, T, GDN_HEADS, GDN_DV))
    o = jnp.concatenate([o_hg.reshape(B, T, HG_WIDTH), o_gdn.reshape(B, T, GDN_WIDTH)], axis=-1)
    out = jnp.einsum('bte,ed->btd', o.astype(h.dtype), w_out)
    return out.astype(h.dtype), s_hg_new, s_gdn_new, new_conv


def setup_inputs(seed: int = 0) -> dict:
    key = jax.random.key(seed)
    ks = jax.random.split(key, 16)
    f32 = jnp.float32
    x_prompt = jax.random.normal(ks[0], (BATCH, SEQ, D_MODEL), f32)
    x_sample = jax.random.normal(ks[1], (DEC_BATCH, DEC_SEQ, D_MODEL), f32)
    state_hgrn = jax.random.normal(ks[2], (DEPTH, DEC_BATCH, HG_HEADS, HG_KEY, HG_VAL), f32) * 0.5
    state_gdn = jax.random.normal(ks[3], (DEPTH, DEC_BATCH, GDN_HEADS, GDN_DK, GDN_DV), f32) * (GDN_DK ** -0.5)
    state_gdn_conv = jax.random.normal(ks[4], (DEPTH, DEC_BATCH, CONV_W - 1, CONV_CH), f32)
    norm_w = 1.0 + 0.01 * jax.random.normal(ks[5], (DEPTH, D_MODEL), f32)
    w_in = jax.random.normal(ks[6], (DEPTH, D_MODEL, D_IN), f32) * (D_MODEL ** -0.5)
    hg_lb_logits = 0.1 * jax.random.normal(ks[7], (DEPTH + 1, HG_HEADS * HG_KEY), f32)
    conv_w = jax.random.normal(ks[8], (DEPTH, CONV_W, CONV_CH), f32) * (CONV_W ** -0.5)
    gdn_a_log = jnp.log(jax.random.uniform(ks[9], (DEPTH, GDN_HEADS), f32, 1.0, 16.0))
    dt = jnp.exp(jax.random.uniform(ks[10], (DEPTH, GDN_HEADS), f32, math.log(1e-3), math.log(1e-1)))
    gdn_dt_bias = dt + jnp.log(-jnp.expm1(-dt))
    hg_out_norm = 1.0 + 0.01 * jax.random.normal(ks[11], (DEPTH, HG_VAL), f32)
    gdn_out_norm = 1.0 + 0.01 * jax.random.normal(ks[12], (DEPTH, GDN_DV), f32)
    w_out = jax.random.normal(ks[13], (DEPTH, D_MIX, D_MODEL), f32) * (D_MIX ** -0.5)
    final_norm = 1.0 + 0.01 * jax.random.normal(ks[14], (D_MODEL,), f32)
    return {"x_prompt": x_prompt, "x_sample": x_sample,
            "state_hgrn": state_hgrn, "state_gdn": state_gdn, "state_gdn_conv": state_gdn_conv,
            "norm_w": norm_w, "w_in": w_in, "hg_lb_logits": hg_lb_logits, "conv_w": conv_w,
            "gdn_a_log": gdn_a_log, "gdn_dt_bias": gdn_dt_bias,
            "hg_out_norm": hg_out_norm, "gdn_out_norm": gdn_out_norm,
            "w_out": w_out, "final_norm": final_norm}


def reference(x_prompt, x_sample, state_hgrn, state_gdn, state_gdn_conv,
              norm_w, w_in, hg_lb_logits, conv_w, gdn_a_log, gdn_dt_bias,
              hg_out_norm, gdn_out_norm, w_out, final_norm):
    f32 = jnp.float32
    lower_bounds = jnp.cumsum(jax.nn.softmax(hg_lb_logits.astype(f32), axis=0), axis=0)
    hp, hs = x_prompt, x_sample
    p_hg, p_gdn, p_conv, s_hg_l, s_gdn_l, s_conv_l = [], [], [], [], [], []
    for l in range(DEPTH):
        lb = lower_bounds[l]
        z_hg = jnp.zeros((BATCH, HG_HEADS, HG_KEY, HG_VAL), f32)
        z_gdn = jnp.zeros((BATCH, GDN_HEADS, GDN_DK, GDN_DV), f32)
        z_conv = jnp.zeros((BATCH, CONV_W - 1, CONV_CH), f32)
        dp, a, b, c = hybrid_mixer(rmsnorm(hp, norm_w[l]), w_in[l], conv_w[l], lb,
                                   gdn_a_log[l], gdn_dt_bias[l], hg_out_norm[l],
                                   gdn_out_norm[l], w_out[l], z_hg, z_gdn, z_conv, True)
        hp = hp + dp
        p_hg.append(a.astype(x_prompt.dtype))
        p_gdn.append(b.astype(x_prompt.dtype))
        p_conv.append(c.astype(x_prompt.dtype))
        ds, a, b, c = hybrid_mixer(rmsnorm(hs, norm_w[l]), w_in[l], conv_w[l], lb,
                                   gdn_a_log[l], gdn_dt_bias[l], hg_out_norm[l],
                                   gdn_out_norm[l], w_out[l], state_hgrn[l], state_gdn[l],
                                   state_gdn_conv[l], False)
        hs = hs + ds
        s_hg_l.append(a.astype(state_hgrn.dtype))
        s_gdn_l.append(b.astype(state_gdn.dtype))
        s_conv_l.append(c.astype(state_gdn_conv.dtype))
    y_prompt = rmsnorm(hp, final_norm)
    y_sample = rmsnorm(hs, final_norm)
    new_hgrn_prompt = jnp.stack(p_hg, axis=0)
    new_gdn_prompt = jnp.stack(p_gdn, axis=0)
    new_conv_prompt = jnp.stack(p_conv, axis=0)
    new_hgrn_sample = jnp.stack(s_hg_l, axis=0)
    new_gdn_sample = jnp.stack(s_gdn_l, axis=0)
    new_conv_sample = jnp.stack(s_conv_l, axis=0)
    return (y_prompt, y_sample, new_hgrn_prompt, new_gdn_prompt, new_conv_prompt,
            new_hgrn_sample, new_gdn_sample, new_conv_sample)
```

```cpp
#include <hip/hip_runtime.h>
#include <hip/hip_cooperative_groups.h>
#include <cstdio>
namespace cg = cooperative_groups;

#ifndef MEGA
#define MEGA 0
#endif

typedef unsigned short u16;
using bf16x8 = __attribute__((ext_vector_type(8))) short;
using f32x4 = __attribute__((ext_vector_type(4))) float;
using u32x4 = __attribute__((ext_vector_type(4))) unsigned;

#define NTH 512
constexpr int MP = 16384, MS = 128, MT = 16512, DM = 1024, DIN = 4104, PQW = 2560;
constexpr float EPS = 1e-6f;
constexpr size_t LDS_BYTES = 139264;

constexpr size_t O_YP = 0, O_YS = 16777216, O_HGP = 16908288, O_GDP = 17432576, O_CVP = 17956864,
                 O_HGS = 17993728, O_GDS = 26382336, O_CVS = 34770944;
constexpr size_t W_WINT = 0;
constexpr size_t W_WOUTT = W_WINT + 8388608;
constexpr size_t W_BETA = W_WOUTT + 2097152;
constexpr size_t W_GDEC = W_BETA + 264192;
constexpr size_t W_DVEC = W_GDEC + 264192;
constexpr size_t W_DSC = W_DVEC + 524288;
constexpr size_t W_PQ = W_DSC + 4096;
constexpr size_t W_GATES = W_PQ + 84541440;
constexpr size_t W_H = W_GATES + 33816576;
constexpr size_t W_QS = W_H + 33816576;
constexpr size_t W_MNEG = W_QS + 33554432;
constexpr size_t W_LF = W_MNEG + 33554432;
constexpr size_t W_END = W_LF + 33816576;

struct Params {
  const float *x_prompt, *x_sample, *state_hgrn, *state_gdn, *state_conv, *norm_w, *w_in, *lb_logits,
      *conv_w, *a_log, *dt_bias, *hg_norm, *gdn_norm, *w_out, *final_norm;
  float* out;
  char* ws;
};

__device__ __forceinline__ u16 f2bf(float x) {
  unsigned u = __float_as_uint(x);
  u += 0x7fffu + ((u >> 16) & 1u);
  return (u16)(u >> 16);
}
__device__ __forceinline__ float bf2f(u16 h) { return __uint_as_float(((unsigned)h) << 16); }
__device__ __forceinline__ unsigned pack2(float a, float b) { return (unsigned)f2bf(a) | ((unsigned)f2bf(b) << 16); }
__device__ __forceinline__ float wave_sum(float v) {
#pragma unroll
  for (int o = 32; o > 0; o >>= 1) v += __shfl_xor(v, o, 64);
  return v;
}
__device__ __forceinline__ float sigmoidf_(float x) { return 1.f / (1.f + __expf(-x)); }
__device__ __forceinline__ float siluf_(float x) { return x / (1.f + __expf(-x)); }
__device__ __forceinline__ f32x4 mfma16(bf16x8 a, bf16x8 b, f32x4 c) {
  return __builtin_amdgcn_mfma_f32_16x16x32_bf16(a, b, c, 0, 0, 0);
}
__device__ __forceinline__ bf16x8 frag(const u16* base, int row0, int stride, int koff, int lane) {
  return *(const bf16x8*)(base + (row0 + (lane & 15)) * stride + koff + (lane >> 4) * 8);
}

__device__ void phase0(const Params& p, char* smem, int bid, int nb) {
  const int tid = threadIdx.x, lane = tid & 63, w = tid >> 6;
  u16* WinT = (u16*)(p.ws + W_WINT);
  u16* WoutT = (u16*)(p.ws + W_WOUTT);
  u16* H = (u16*)(p.ws + W_H);
  float* BETA = (float*)(p.ws + W_BETA);
  float* GDEC = (float*)(p.ws + W_GDEC);
  float* tl = (float*)smem;
  for (int t = bid; t < 1280; t += nb) {
    const float* src; int sstride; u16* dst; int kt, nt;
    if (t < 1024) { src = p.w_in; sstride = DIN; dst = WinT; kt = t >> 6; nt = t & 63; }
    else { int u = t - 1024; src = p.w_out; sstride = 1024; dst = WoutT; kt = u >> 4; nt = u & 15; }
#pragma unroll
    for (int i = 0; i < 8; ++i) {
      int idx = tid + 512 * i; int kk = idx >> 6, nn = idx & 63;
      tl[kk * 65 + nn] = src[(size_t)(kt * 64 + kk) * sstride + nt * 64 + nn];
    }
    __syncthreads();
    {
      int nn = tid >> 3, k8 = (tid & 7) * 8;
      unsigned pk[4];
#pragma unroll
      for (int e = 0; e < 4; ++e) pk[e] = pack2(tl[(k8 + 2 * e) * 65 + nn], tl[(k8 + 2 * e + 1) * 65 + nn]);
      *(uint4*)(dst + (size_t)(nt * 64 + nn) * 1024 + kt * 64 + k8) = make_uint4(pk[0], pk[1], pk[2], pk[3]);
    }
    __syncthreads();
  }
  float* W8s = (float*)smem;
  for (int idx = tid; idx < 8192; idx += 512) {
    int j = idx & 7, k = idx >> 3;
    W8s[j * 1024 + k] = p.w_in[(size_t)k * DIN + 4096 + j];
  }
  __syncthreads();
  for (int g = bid; g < MT / 8; g += nb) {
    int row = g * 8 + w;
    const float* x = row < MP ? p.x_prompt + (size_t)row * 1024 : p.x_sample + (size_t)(row - MP) * 1024;
    float4 xv[4];
    float ss = 0.f;
#pragma unroll
    for (int i = 0; i < 4; ++i) {
      xv[i] = *(const float4*)(x + i * 256 + lane * 4);
      ss += xv[i].x * xv[i].x + xv[i].y * xv[i].y + xv[i].z * xv[i].z + xv[i].w * xv[i].w;
    }
    ss = wave_sum(ss);
    float rstd = rsqrtf(ss * (1.f / 1024.f) + EPS);
    float d0 = 0, d1 = 0, d2 = 0, d3 = 0, d4 = 0, d5 = 0, d6 = 0, d7 = 0;
#pragma unroll
    for (int i = 0; i < 4; ++i) {
      float4 nw = *(const float4*)(p.norm_w + i * 256 + lane * 4);
      float4 hv;
      hv.x = xv[i].x * rstd * nw.x; hv.y = xv[i].y * rstd * nw.y; hv.z = xv[i].z * rstd * nw.z; hv.w = xv[i].w * rstd * nw.w;
      *(uint2*)(H + (size_t)row * 1024 + i * 256 + lane * 4) = make_uint2(pack2(hv.x, hv.y), pack2(hv.z, hv.w));
#define GDOT(j, dj) { float4 wv = *(const float4*)(W8s + j * 1024 + i * 256 + lane * 4); dj += hv.x * wv.x + hv.y * wv.y + hv.z * wv.z + hv.w * wv.w; }
      GDOT(0, d0) GDOT(1, d1) GDOT(2, d2) GDOT(3, d3) GDOT(4, d4) GDOT(5, d5) GDOT(6, d6) GDOT(7, d7)
#undef GDOT
    }
    d0 = wave_sum(d0); d1 = wave_sum(d1); d2 = wave_sum(d2); d3 = wave_sum(d3);
    d4 = wave_sum(d4); d5 = wave_sum(d5); d6 = wave_sum(d6); d7 = wave_sum(d7);
    if (lane < 4) {
      float gb = lane == 0 ? d0 : lane == 1 ? d1 : lane == 2 ? d2 : d3;
      float ga = lane == 0 ? d4 : lane == 1 ? d5 : lane == 2 ? d6 : d7;
      BETA[row * 4 + lane] = 1.f / (1.f + expf(-gb));
      float z = ga + p.dt_bias[lane];
      float sp = z > 20.f ? z : log1pf(expf(z));
      GDEC[row * 4 + lane] = -expf(p.a_log[lane]) * sp;
    }
  }
  __syncthreads();
}

template <int EPI>
__device__ void gemm_phase(const Params& p, const u16* __restrict__ A, const u16* __restrict__ Bt, int ntn,
                           char* smem, int bid, int nb) {
  const int tid = threadIdx.x, lane = tid & 63, w = tid >> 6;
  const int wr = w >> 1, wc = w & 1, lr = lane & 15, lq = lane >> 4;
  u16* As = (u16*)smem;
  u16* Bs = As + 256 * 72;
  const int ntm = (MT + 255) / 256;
  const int ntiles = ntm * ntn;
  for (int tile = bid; tile < ntiles; tile += nb) {
    const int tm = tile / ntn, tn = tile % ntn;
    const int m0 = tm * 256, n0 = tn * 128;
    f32x4 acc[4][4];
#pragma unroll
    for (int i = 0; i < 4; ++i)
#pragma unroll
      for (int j = 0; j < 4; ++j) acc[i][j] = f32x4{0.f, 0.f, 0.f, 0.f};
    u32x4 ra[4], rb[2];
    const u16* ap[4]; const u16* bp[2];
#pragma unroll
    for (int i = 0; i < 4; ++i) {
      int id = tid + 512 * i; int row = id >> 3, c16 = id & 7;
      int gr = m0 + row; if (gr > MT - 1) gr = MT - 1;
      ap[i] = A + (size_t)gr * 1024 + c16 * 8;
    }
#pragma unroll
    for (int i = 0; i < 2; ++i) {
      int id = tid + 512 * i; int row = id >> 3, c16 = id & 7;
      bp[i] = Bt + (size_t)(n0 + row) * 1024 + c16 * 8;
    }
#pragma unroll
    for (int i = 0; i < 4; ++i) ra[i] = *(const u32x4*)(ap[i]);
#pragma unroll
    for (int i = 0; i < 2; ++i) rb[i] = *(const u32x4*)(bp[i]);
    for (int kt = 0; kt < 16; ++kt) {
      __syncthreads();
#pragma unroll
      for (int i = 0; i < 4; ++i) { int id = tid + 512 * i; *(u32x4*)(As + (id >> 3) * 72 + (id & 7) * 8) = ra[i]; }
#pragma unroll
      for (int i = 0; i < 2; ++i) { int id = tid + 512 * i; *(u32x4*)(Bs + (id >> 3) * 72 + (id & 7) * 8) = rb[i]; }
      __syncthreads();
      {
        const int kn = (kt + 1 < 16 ? kt + 1 : 15) * 64;
#pragma unroll
        for (int i = 0; i < 4; ++i) ra[i] = *(const u32x4*)(ap[i] + kn);
#pragma unroll
        for (int i = 0; i < 2; ++i) rb[i] = *(const u32x4*)(bp[i] + kn);
      }
#pragma unroll
      for (int ks = 0; ks < 2; ++ks) {
        bf16x8 af[4], bf[4];
#pragma unroll
        for (int mi = 0; mi < 4; ++mi) af[mi] = frag(As, wr * 64 + mi * 16, 72, ks * 32, lane);
#pragma unroll
        for (int ni = 0; ni < 4; ++ni) bf[ni] = frag(Bs, wc * 64 + ni * 16, 72, ks * 32, lane);
#pragma unroll
        for (int mi = 0; mi < 4; ++mi)
#pragma unroll
          for (int ni = 0; ni < 4; ++ni) acc[mi][ni] = mfma16(af[mi], bf[ni], acc[mi][ni]);
      }
    }
    if (EPI == 0) {
      u16* PQ = (u16*)(p.ws + W_PQ);
      u16* GATES = (u16*)(p.ws + W_GATES);
      float* LF = (float*)(p.ws + W_LF);
      const int sec = n0 >> 9;
#pragma unroll
      for (int ni = 0; ni < 4; ++ni) {
        const int col = n0 + wc * 64 + ni * 16 + lr;
        float lbv = 0.f;
        if (sec == 1) {
          int cc = col - 512;
          lbv = 1.f / (1.f + expf(p.lb_logits[512 + cc] - p.lb_logits[cc]));
        }
#pragma unroll
        for (int mi = 0; mi < 4; ++mi) {
#pragma unroll
          for (int j = 0; j < 4; ++j) {
            const int row = m0 + wr * 64 + mi * 16 + lq * 4 + j;
            if (row >= MT) continue;
            const float v = acc[mi][ni][j];
            if (sec == 0) PQ[(size_t)row * PQW + col] = f2bf(v);
            else if (sec == 1) LF[(size_t)row * 512 + (col - 512)] = logf(lbv + (1.f - lbv) / (1.f + expf(-v)));
            else if (sec == 2) PQ[(size_t)row * PQW + 512 + (col - 1024)] = f2bf(v);
            else if (sec == 3) GATES[(size_t)row * 1024 + (col - 1536)] = f2bf(v / (1.f + expf(-v)));
            else if (sec == 7) GATES[(size_t)row * 1024 + 512 + (col - 3584)] = f2bf(v / (1.f + expf(-v)));
            else {
              const int cc = col - 2048;
              PQ[(size_t)row * PQW + 1024 + cc] = f2bf(v);
              if (row < MP) {
                int tt = row & 2047;
                if (tt >= 2045) p.out[O_CVP + (size_t)((row >> 11) * 3 + (tt - 2045)) * 1536 + cc] = v;
              } else {
                p.out[O_CVS + (size_t)((row - MP) * 3 + 2) * 1536 + cc] = v;
              }
            }
          }
        }
      }
    } else {
#pragma unroll
      for (int ni = 0; ni < 4; ++ni) {
        const int col = n0 + wc * 64 + ni * 16 + lr;
#pragma unroll
        for (int mi = 0; mi < 4; ++mi) {
#pragma unroll
          for (int j = 0; j < 4; ++j) {
            const int row = m0 + wr * 64 + mi * 16 + lq * 4 + j;
            if (row >= MT) continue;
            const float v = acc[mi][ni][j];
            if (row < MP) p.out[O_YP + (size_t)row * 1024 + col] = p.x_prompt[(size_t)row * 1024 + col] + v;
            else p.out[O_YS + (size_t)(row - MP) * 1024 + col] = p.x_sample[(size_t)(row - MP) * 1024 + col] + v;
          }
        }
      }
    }
  }
  __syncthreads();
}

__device__ void hgrn_item(const Params& p, char* smem, int idx) {
  const int tid = threadIdx.x, lane = tid & 63, w = tid >> 6;
  const int lr = lane & 15, lq = lane >> 4;
  const int h = idx & 3, c = (idx >> 2) & 31, b = idx >> 7;
  const int r0 = b * 2048 + c * 64;
  const u16* PQ = (const u16*)(p.ws + W_PQ);
  const float* LF = (const float*)(p.ws + W_LF);
  u16* QS = (u16*)(p.ws + W_QS);
  u16* O0 = (u16*)(p.ws + W_H);
  u16* NB = (u16*)(p.out);
  float* DVEC = (float*)(p.ws + W_DVEC);
  u16* qt = (u16*)smem;
  u16* kt = qt + 64 * 136;
  u16* ktT = kt + 64 * 136;
  u16* vT = ktT + 128 * 72;
  u16* sc = vT + 128 * 72;
  float* ps = (float*)(sc + 64 * 72);
  const int col = tid & 127, part = tid >> 7;
  float lfv[16], bcum[16];
  {
    const float* lfp = LF + (size_t)(r0 + part * 16) * 512 + h * 128 + col;
#pragma unroll
    for (int i = 0; i < 16; ++i) lfv[i] = lfp[(size_t)i * 512];
    float run = 0.f;
#pragma unroll
    for (int i = 0; i < 16; ++i) { run += lfv[i]; bcum[i] = run; }
    ps[part * 128 + col] = run;
  }
  __syncthreads();
  {
    float off = 0.f, blast = 0.f;
#pragma unroll
    for (int pp = 0; pp < 4; ++pp) { float t = ps[pp * 128 + col]; blast += t; if (pp < part) off += t; }
    const u16* qp = PQ + (size_t)(r0 + part * 16) * PQW + h * 128 + col;
    u16* qsout = QS + ((size_t)idx * 64 + part * 16) * 128 + col;
#pragma unroll
    for (int i = 0; i < 16; ++i) {
      const float bb = bcum[i] + off;
      const int row = part * 16 + i;
      const float q = bf2f(qp[(size_t)i * PQW]);
      const u16 v = qp[(size_t)i * PQW + 512];
      qsout[i * 128] = f2bf(q * expf(bb));
      qt[row * 136 + col] = f2bf(q * expf(bb - blast));
      const float kk = (1.f - expf(lfv[i])) * expf(blast - bb);
      const u16 kbv = f2bf(kk);
      kt[row * 136 + col] = kbv;
      ktT[col * 72 + row] = kbv;
      vT[col * 72 + row] = v;
    }
    if (part == 0) DVEC[idx * 128 + col] = expf(blast);
  }
  __syncthreads();
  {
    const int tr = w >> 1;
    bf16x8 a[4];
#pragma unroll
    for (int ks = 0; ks < 4; ++ks) a[ks] = frag(qt, tr * 16, 136, ks * 32, lane);
#pragma unroll
    for (int tci = 0; tci < 2; ++tci) {
      const int tc = (w & 1) * 2 + tci;
      f32x4 acc = {0.f, 0.f, 0.f, 0.f};
#pragma unroll
      for (int ks = 0; ks < 4; ++ks) acc = mfma16(a[ks], frag(kt, tc * 16, 136, ks * 32, lane), acc);
#pragma unroll
      for (int j = 0; j < 4; ++j) {
        const int t = tr * 16 + lq * 4 + j, s = tc * 16 + lr;
        sc[t * 72 + s] = f2bf(t >= s ? acc[j] : 0.f);
      }
    }
  }
  __syncthreads();
  {
    const int tr = w >> 1;
    const bf16x8 a0 = frag(sc, tr * 16, 72, 0, lane), a1 = frag(sc, tr * 16, 72, 32, lane);
#pragma unroll
    for (int tci = 0; tci < 4; ++tci) {
      const int tc = (w & 1) * 4 + tci;
      f32x4 acc = {0.f, 0.f, 0.f, 0.f};
      acc = mfma16(a0, frag(vT, tc * 16, 72, 0, lane), acc);
      acc = mfma16(a1, frag(vT, tc * 16, 72, 32, lane), acc);
#pragma unroll
      for (int j = 0; j < 4; ++j) {
        const int t = tr * 16 + lq * 4 + j, n = tc * 16 + lr;
        O0[((size_t)idx * 64 + t) * 128 + n] = f2bf(acc[j]);
      }
    }
  }
  {
    const int tr = w;
    const bf16x8 a0 = frag(ktT, tr * 16, 72, 0, lane), a1 = frag(ktT, tr * 16, 72, 32, lane);
#pragma unroll
    for (int tc = 0; tc < 8; ++tc) {
      f32x4 acc = {0.f, 0.f, 0.f, 0.f};
      acc = mfma16(a0, frag(vT, tc * 16, 72, 0, lane), acc);
      acc = mfma16(a1, frag(vT, tc * 16, 72, 32, lane), acc);
#pragma unroll
      for (int j = 0; j < 4; ++j) {
        const int kd = tr * 16 + lq * 4 + j, n = tc * 16 + lr;
        NB[((size_t)idx * 128 + kd) * 128 + n] = f2bf(acc[j]);
      }
    }
  }
  __syncthreads();
}

template <int J>
struct SolveCol {
  static __device__ __forceinline__ void run(f32x4 (&x)[16], const float* AT) {
    if constexpr (J < 63) {
      const float xj = x[J / 4][J % 4];
#pragma unroll
      for (int B = (J + 1) / 4; B < 16; ++B) {
        const f32x4 av = *(const f32x4*)(AT + J * 64 + B * 4);
        x[B] -= av * xj;
      }
      __builtin_amdgcn_sched_barrier(0);
      SolveCol<J + 1>::run(x, AT);
    }
  }
};

__device__ void gdn_item(const Params& p, char* smem, int idx) {
  const int tid = threadIdx.x, lane = tid & 63, w = tid >> 6;
  const int lr = lane & 15, lq = lane >> 4;
  const int h = idx & 3, c = (idx >> 2) & 31, b = idx >> 7;
  const int r0 = b * 2048 + c * 64;
  const u16* PQ = (const u16*)(p.ws + W_PQ);
  const float* BETA = (const float*)(p.ws + W_BETA);
  const float* GDEC = (const float*)(p.ws + W_GDEC);
  u16* QS = (u16*)(p.ws + W_QS);
  u16* O0 = (u16*)(p.ws + W_H);
  u16* NB = (u16*)(p.out);
  u16* MNEG = (u16*)(p.ws + W_MNEG);
  float* DSC = (float*)(p.ws + W_DSC);
  u16* kb = (u16*)smem;
  u16* qb = kb + 64 * 136;
  u16* vS = qb + 64 * 136;
  float* Asol = (float*)(vS + 64 * 128);
  u16* attn = (u16*)(Asol + 64 * 64);
  u16* khT = attn + 64 * 72;
  u16* WT = khT + 128 * 72;
  u16* U0T = WT + 128 * 72;
  float* gc = (float*)(U0T + 128 * 72);
  float* bet = gc + 64;

  if (w == 0) {
    float g = GDEC[(size_t)(r0 + lane) * 4 + h];
#pragma unroll
    for (int o = 1; o < 64; o <<= 1) { float t = __shfl_up(g, o, 64); if (lane >= o) g += t; }
    gc[lane] = g;
    bet[lane] = BETA[(size_t)(r0 + lane) * 4 + h];
  }
  {
    const int chq = 1024 + h * 128 + 2 * lane;
    const int cwq = h * 128 + 2 * lane;
    float cw[3][4][2];
#pragma unroll
    for (int ty = 0; ty < 3; ++ty)
#pragma unroll
      for (int j = 0; j < 4; ++j) {
        float2 t2 = *(const float2*)(p.conv_w + j * 1536 + ty * 512 + cwq);
        cw[ty][j][0] = t2.x; cw[ty][j][1] = t2.y;
      }
    float win[3][3][2];
    const int t0 = w * 8;
#pragma unroll
    for (int a = 0; a < 3; ++a) {
      const int rr = t0 - 3 + a;
      const bool valid = (c > 0) || (rr >= 0);
#pragma unroll
      for (int ty = 0; ty < 3; ++ty) {
        unsigned u = 0;
        if (valid) u = *(const unsigned*)(PQ + (ptrdiff_t)(r0 + rr) * PQW + chq + ty * 512);
        win[ty][a][0] = bf2f((u16)(u & 0xffff)); win[ty][a][1] = bf2f((u16)(u >> 16));
      }
    }
#pragma unroll
    for (int tt = 0; tt < 8; ++tt) {
      const int t = t0 + tt;
      float cv[3][2];
#pragma unroll
      for (int ty = 0; ty < 3; ++ty) {
        unsigned u = *(const unsigned*)(PQ + (size_t)(r0 + t) * PQW + chq + ty * 512);
        float c0 = bf2f((u16)(u & 0xffff)), c1 = bf2f((u16)(u >> 16));
        float s0 = cw[ty][0][0] * win[ty][0][0] + cw[ty][1][0] * win[ty][1][0] + cw[ty][2][0] * win[ty][2][0] + cw[ty][3][0] * c0;
        float s1 = cw[ty][0][1] * win[ty][0][1] + cw[ty][1][1] * win[ty][1][1] + cw[ty][2][1] * win[ty][2][1] + cw[ty][3][1] * c1;
        win[ty][0][0] = win[ty][1][0]; win[ty][0][1] = win[ty][1][1];
        win[ty][1][0] = win[ty][2][0]; win[ty][1][1] = win[ty][2][1];
        win[ty][2][0] = c0; win[ty][2][1] = c1;
        cv[ty][0] = siluf_(s0); cv[ty][1] = siluf_(s1);
      }
      float ssq = wave_sum(cv[0][0] * cv[0][0] + cv[0][1] * cv[0][1]);
      float ssk = wave_sum(cv[1][0] * cv[1][0] + cv[1][1] * cv[1][1]);
      const float rq = rsqrtf(ssq + EPS) * 0.08838834764831845f;
      const float rk = rsqrtf(ssk + EPS);
      *(unsigned*)(qb + t * 136 + 2 * lane) = pack2(cv[0][0] * rq, cv[0][1] * rq);
      *(unsigned*)(kb + t * 136 + 2 * lane) = pack2(cv[1][0] * rk, cv[1][1] * rk);
      *(unsigned*)(vS + t * 128 + 2 * lane) = pack2(cv[2][0], cv[2][1]);
    }
  }
  __syncthreads();
  {
    const int which = w >> 2, tr = w & 3;
    const u16* Asrc = which ? qb : kb;
    bf16x8 a[4];
#pragma unroll
    for (int ks = 0; ks < 4; ++ks) a[ks] = frag(Asrc, tr * 16, 136, ks * 32, lane);
#pragma unroll
    for (int tc = 0; tc < 4; ++tc) {
      f32x4 acc = {0.f, 0.f, 0.f, 0.f};
#pragma unroll
      for (int ks = 0; ks < 4; ++ks) acc = mfma16(a[ks], frag(kb, tc * 16, 136, ks * 32, lane), acc);
#pragma unroll
      for (int j = 0; j < 4; ++j) {
        const int t = tr * 16 + lq * 4 + j, s = tc * 16 + lr;
        const float L = expf(fminf(gc[t] - gc[s], 0.f));
        if (which == 0) Asol[s * 64 + t] = (t > s) ? bet[t] * acc[j] * L : 0.f;
        else attn[t * 72 + s] = f2bf((t >= s) ? acc[j] * L : 0.f);
      }
    }
  }
  __syncthreads();
  if (tid < 256) {
    f32x4 x[16];
    if (tid < 128) {
#pragma unroll
      for (int s = 0; s < 64; ++s) x[s >> 2][s & 3] = bf2f(vS[s * 128 + tid]) * bet[s];
    } else {
#pragma unroll
      for (int s = 0; s < 64; ++s) x[s >> 2][s & 3] = bf2f(kb[s * 136 + tid - 128]) * bet[s] * expf(gc[s]);
    }
    SolveCol<0>::run(x, Asol);
    u16* dst = (tid < 128) ? (U0T + tid * 72) : (WT + (tid - 128) * 72);
#pragma unroll
    for (int s8 = 0; s8 < 8; ++s8) {
      *(u32x4*)(dst + s8 * 8) = u32x4{pack2(x[2 * s8][0], x[2 * s8][1]), pack2(x[2 * s8][2], x[2 * s8][3]),
                                      pack2(x[2 * s8 + 1][0], x[2 * s8 + 1][1]), pack2(x[2 * s8 + 1][2], x[2 * s8 + 1][3])};
    }
  } else {
    const float glast = gc[63];
    const int e0 = tid - 256;
#pragma unroll 4
    for (int i = 0; i < 32; ++i) {
      const int e = e0 + 256 * i;
      const int s = e & 63, kd = e >> 6;
      khT[kd * 72 + s] = f2bf(bf2f(kb[s * 136 + kd]) * expf(glast - gc[s]));
    }
  }
  __syncthreads();
  {
    const int tr = w & 3, half = w >> 2;
    const u16* Bsrc = half ? U0T : WT;
    const bf16x8 a0 = frag(attn, tr * 16, 72, 0, lane), a1 = frag(attn, tr * 16, 72, 32, lane);
#pragma unroll
    for (int tc = 0; tc < 8; ++tc) {
      f32x4 acc = {0.f, 0.f, 0.f, 0.f};
      acc = mfma16(a0, frag(Bsrc, tc * 16, 72, 0, lane), acc);
      acc = mfma16(a1, frag(Bsrc, tc * 16, 72, 32, lane), acc);
#pragma unroll
      for (int j = 0; j < 4; ++j) {
        const int t = tr * 16 + lq * 4 + j, n = tc * 16 + lr;
        const size_t o = ((size_t)(1024 + idx) * 64 + t) * 128 + n;
        if (half == 0) QS[o] = f2bf(bf2f(qb[t * 136 + n]) * expf(gc[t]) - acc[j]);
        else O0[o] = f2bf(acc[j]);
      }
    }
  }
  {
    const int tr = w;
    const bf16x8 a0 = frag(khT, tr * 16, 72, 0, lane), a1 = frag(khT, tr * 16, 72, 32, lane);
#pragma unroll
    for (int tc = 0; tc < 16; ++tc) {
      const u16* Bsrc = tc < 8 ? WT : U0T;
      const int tcc = tc & 7;
      f32x4 acc = {0.f, 0.f, 0.f, 0.f};
      acc = mfma16(a0, frag(Bsrc, tcc * 16, 72, 0, lane), acc);
      acc = mfma16(a1, frag(Bsrc, tcc * 16, 72, 32, lane), acc);
#pragma unroll
      for (int j = 0; j < 4; ++j) {
        const int kd = tr * 16 + lq * 4 + j, n = tcc * 16 + lr;
        if (tc < 8) MNEG[((size_t)idx * 128 + kd) * 128 + n] = f2bf(-acc[j]);
        else NB[((size_t)(1024 + idx) * 128 + kd) * 128 + n] = f2bf(acc[j]);
      }
    }
  }
  if (tid == 0) DSC[idx] = expf(gc[63]);
  __syncthreads();
}

__device__ void phase2(const Params& p, char* smem, int bid, int nb) {
  for (int it = bid; it < 2048; it += nb) {
    if (it & 1) gdn_item(p, smem, it >> 1);
    else hgrn_item(p, smem, it >> 1);
  }
}

struct ScanRegs {
  bf16x8 Aq[4];
  bf16x8 Am[4];
  u16 o0[4];
  u16 nn[4];
  float dd[4];
};

__device__ __forceinline__ void scan_load(ScanRegs& r, const Params& p, int type, int idx, int vs, int w, int lr, int lq) {
  const u16* QS = (const u16*)(p.ws + W_QS);
  const u16* O0 = (const u16*)(p.ws + W_H);
  const u16* NB = (const u16*)(p.out);
  const u16* MNEG = (const u16*)(p.ws + W_MNEG);
  const float* DVEC = (const float*)(p.ws + W_DVEC);
  const float* DSC = (const float*)(p.ws + W_DSC);
  const size_t ti = (size_t)type * 1024 + idx;
  if (w < 4) {
    const u16* qrow = QS + (ti * 64 + w * 16 + lr) * 128 + lq * 8;
#pragma unroll
    for (int ks = 0; ks < 4; ++ks) r.Aq[ks] = *(const bf16x8*)(qrow + ks * 32);
#pragma unroll
    for (int j = 0; j < 4; ++j) r.o0[j] = O0[(ti * 64 + w * 16 + lq * 4 + j) * 128 + vs * 16 + lr];
  }
#pragma unroll
  for (int j = 0; j < 4; ++j) r.nn[j] = NB[(ti * 128 + w * 16 + lq * 4 + j) * 128 + vs * 16 + lr];
  if (type == 1) {
    const u16* mrow = MNEG + ((size_t)idx * 128 + w * 16 + lr) * 128 + lq * 8;
#pragma unroll
    for (int ks = 0; ks < 4; ++ks) r.Am[ks] = *(const bf16x8*)(mrow + ks * 32);
    const float d = DSC[idx];
#pragma unroll
    for (int j = 0; j < 4; ++j) r.dd[j] = d;
  } else {
#pragma unroll
    for (int j = 0; j < 4; ++j) r.dd[j] = DVEC[idx * 128 + w * 16 + lq * 4 + j];
  }
}

__device__ void scan_unit(const Params& p, char* smem, int u) {
  const int tid = threadIdx.x, lane = tid & 63, w = tid >> 6;
  const int lr = lane & 15, lq = lane >> 4;
  const int type = u >> 8, rem = u & 255;
  const int b = rem >> 5, h = (rem >> 3) & 3, vs = rem & 7;
  float* OPRE = (float*)(p.ws + W_PQ);
  u16* SbT = (u16*)smem;
  for (int i = tid; i < 2 * 16 * 136; i += 512) SbT[i] = 0;
  f32x4 S = {0.f, 0.f, 0.f, 0.f};
  ScanRegs cur, nxt;
  scan_load(cur, p, type, (b * 32 + 0) * 4 + h, vs, w, lr, lq);
  for (int c = 0; c < 32; ++c) {
    __syncthreads();
    const u16* Sb = SbT + (c & 1) * 16 * 136;
    bf16x8 Bf[4];
#pragma unroll
    for (int ks = 0; ks < 4; ++ks) Bf[ks] = *(const bf16x8*)(Sb + lr * 136 + ks * 32 + lq * 8);
    if (c + 1 < 32) scan_load(nxt, p, type, (b * 32 + c + 1) * 4 + h, vs, w, lr, lq);
    if (w < 4) {
      f32x4 acc;
#pragma unroll
      for (int j = 0; j < 4; ++j) acc[j] = bf2f(cur.o0[j]);
#pragma unroll
      for (int ks = 0; ks < 4; ++ks) acc = mfma16(cur.Aq[ks], Bf[ks], acc);
#pragma unroll
      for (int j = 0; j < 4; ++j) {
        const int row = b * 2048 + c * 64 + w * 16 + lq * 4 + j;
        OPRE[(size_t)row * 1024 + type * 512 + h * 128 + vs * 16 + lr] = acc[j];
      }
    }
    f32x4 Sn;
#pragma unroll
    for (int j = 0; j < 4; ++j) Sn[j] = cur.dd[j] * S[j] + bf2f(cur.nn[j]);
    if (type == 1) {
#pragma unroll
      for (int ks = 0; ks < 4; ++ks) Sn = mfma16(cur.Am[ks], Bf[ks], Sn);
    }
    S = Sn;
    u16* Sw = SbT + ((c + 1) & 1) * 16 * 136;
    *(uint2*)(Sw + lr * 136 + w * 16 + lq * 4) = make_uint2(pack2(S[0], S[1]), pack2(S[2], S[3]));
    cur = nxt;
  }
  float* so = p.out + (type ? O_GDP : O_HGP) + (size_t)(b * 4 + h) * 16384;
#pragma unroll
  for (int j = 0; j < 4; ++j) so[(w * 16 + lq * 4 + j) * 128 + vs * 16 + lr] = S[j];
  __syncthreads();
}

__device__ void sample_item(const Params& p, char* smem, int it) {
  const int tid = threadIdx.x, lane = tid & 63, w = tid >> 6;
  const int type = it >> 9, b = (it >> 2) & 127, h = it & 3;
  const int row = MP + b;
  const u16* PQ = (const u16*)(p.ws + W_PQ);
  const float* LF = (const float*)(p.ws + W_LF);
  const float* BETA = (const float*)(p.ws + W_BETA);
  const float* GDEC = (const float*)(p.ws + W_GDEC);
  float* OPRE = (float*)(p.ws + W_PQ);
  float* fq = (float*)smem;
  float* fk = fq + 128;
  float* fv = fk + 128;
  float* fe = fv + 128;
  float* red = fe + 128;
  float* sc = red + 1024;
  const int n = tid & 127, kp = tid >> 7;
  if (type == 0) {
    if (tid < 128) {
      const float lf = LF[(size_t)row * 512 + h * 128 + tid];
      const float f = expf(lf);
      fe[tid] = f;
      fk[tid] = 1.f - f;
      fq[tid] = bf2f(PQ[(size_t)row * PQW + h * 128 + tid]);
      fv[tid] = bf2f(PQ[(size_t)row * PQW + 512 + h * 128 + tid]);
    }
    __syncthreads();
    const float* S = p.state_hgrn + ((size_t)(b * 4 + h) * 128) * 128;
    float* So = p.out + O_HGS + ((size_t)(b * 4 + h) * 128) * 128;
    const float vn = fv[n];
    float o = 0.f;
#pragma unroll 8
    for (int i = 0; i < 32; ++i) {
      const int k = kp * 32 + i;
      const float sn = fe[k] * S[k * 128 + n] + fk[k] * vn;
      So[k * 128 + n] = sn;
      o += fq[k] * sn;
    }
    red[kp * 128 + n] = o;
    __syncthreads();
    if (tid < 128) OPRE[(size_t)row * 1024 + h * 128 + tid] = red[tid] + red[128 + tid] + red[256 + tid] + red[384 + tid];
    __syncthreads();
  } else {
    const float* cprev = p.state_conv + (size_t)b * 3 * 1536;
    if (tid < 384) {
      const int ty = tid >> 7, cc = tid & 127;
      const int ch = ty * 512 + h * 128 + cc;
      const float p0 = cprev[ch], p1 = cprev[1536 + ch], p2 = cprev[3072 + ch];
      const float nw = bf2f(PQ[(size_t)row * PQW + 1024 + ch]);
      const float s = p.conv_w[ch] * p0 + p.conv_w[1536 + ch] * p1 + p.conv_w[3072 + ch] * p2 + p.conv_w[4608 + ch] * nw;
      fq[ty * 128 + cc] = siluf_(s);
      p.out[O_CVS + (size_t)(b * 3 + 0) * 1536 + ch] = p1;
      p.out[O_CVS + (size_t)(b * 3 + 1) * 1536 + ch] = p2;
    }
    __syncthreads();
    if (w < 2) {
      const float a0 = fq[w * 128 + lane], a1 = fq[w * 128 + 64 + lane];
      const float ss = wave_sum(a0 * a0 + a1 * a1);
      if (lane == 0) sc[w] = ss;
    }
    __syncthreads();
    const float rq = rsqrtf(sc[0] + EPS) * 0.08838834764831845f;
    const float rk = rsqrtf(sc[1] + EPS);
    __syncthreads();
    if (tid < 128) fq[tid] *= rq;
    else if (tid < 256) fk[tid - 128] *= rk;
    __syncthreads();
    if (w == 0) {
      const float qk = wave_sum(fq[lane] * fk[lane] + fq[64 + lane] * fk[64 + lane]);
      if (lane == 0) sc[2] = qk;
    }
    const float eg = expf(GDEC[(size_t)row * 4 + h]);
    const float beta = BETA[(size_t)row * 4 + h];
    const float* S = p.state_gdn + ((size_t)(b * 4 + h) * 128) * 128;
    float* So = p.out + O_GDS + ((size_t)(b * 4 + h) * 128) * 128;
    float sd[32];
    float ks_ = 0.f, qs_ = 0.f;
#pragma unroll
    for (int i = 0; i < 32; ++i) {
      const int k = kp * 32 + i;
      sd[i] = eg * S[k * 128 + n];
      ks_ += fk[k] * sd[i];
      qs_ += fq[k] * sd[i];
    }
    red[kp * 128 + n] = ks_;
    red[512 + kp * 128 + n] = qs_;
    __syncthreads();
    const float kS = red[n] + red[128 + n] + red[256 + n] + red[384 + n];
    const float delta = (fv[n] - kS) * beta;
#pragma unroll
    for (int i = 0; i < 32; ++i) {
      const int k = kp * 32 + i;
      So[k * 128 + n] = sd[i] + fk[k] * delta;
    }
    if (tid < 128) {
      const float qS = red[512 + n] + red[640 + n] + red[768 + n] + red[896 + n];
      OPRE[(size_t)row * 1024 + 512 + h * 128 + n] = qS + sc[2] * delta;
    }
    __syncthreads();
  }
}

__device__ void phase3(const Params& p, char* smem, int bid, int nb) {
  for (int u = bid; u < 512; u += nb) scan_unit(p, smem, u);
  for (int it = bid; it < 1024; it += nb) sample_item(p, smem, it);
}

__device__ void phase4(const Params& p, int bid, int nb) {
  const int tid = threadIdx.x, lane = tid & 63, w = tid >> 6;
  const float* OPRE = (const float*)(p.ws + W_PQ);
  const u16* GATES = (const u16*)(p.ws + W_GATES);
  u16* A2 = (u16*)(p.ws + W_QS);
  for (int g = bid; g < MT / 8; g += nb) {
    const int row = g * 8 + w;
#pragma unroll
    for (int i = 0; i < 4; ++i) {
      const int col = i * 256 + lane * 4;
      const float4 v = *(const float4*)(OPRE + (size_t)row * 1024 + col);
      float ss = v.x * v.x + v.y * v.y + v.z * v.z + v.w * v.w;
#pragma unroll
      for (int o = 16; o > 0; o >>= 1) ss += __shfl_xor(ss, o, 64);
      const float rstd = rsqrtf(ss * (1.f / 128.f) + EPS);
      const int cn = col & 127;
      const float4 nw = *(const float4*)((col < 512 ? p.hg_norm : p.gdn_norm) + cn);
      const uint2 gt = *(const uint2*)(GATES + (size_t)row * 1024 + col);
      const float g0 = bf2f((u16)(gt.x & 0xffff)), g1 = bf2f((u16)(gt.x >> 16));
      const float g2 = bf2f((u16)(gt.y & 0xffff)), g3 = bf2f((u16)(gt.y >> 16));
      *(uint2*)(A2 + (size_t)row * 1024 + col) =
          make_uint2(pack2(v.x * rstd * nw.x * g0, v.y * rstd * nw.y * g1), pack2(v.z * rstd * nw.z * g2, v.w * rstd * nw.w * g3));
    }
  }
}

__device__ void phase6(const Params& p, int bid, int nb) {
  const int tid = threadIdx.x, lane = tid & 63, w = tid >> 6;
  for (int g = bid; g < MT / 8; g += nb) {
    const int row = g * 8 + w;
    float* y = row < MP ? p.out + O_YP + (size_t)row * 1024 : p.out + O_YS + (size_t)(row - MP) * 1024;
    float4 xv[4];
    float ss = 0.f;
#pragma unroll
    for (int i = 0; i < 4; ++i) {
      xv[i] = *(const float4*)(y + i * 256 + lane * 4);
      ss += xv[i].x * xv[i].x + xv[i].y * xv[i].y + xv[i].z * xv[i].z + xv[i].w * xv[i].w;
    }
    ss = wave_sum(ss);
    const float rstd = rsqrtf(ss * (1.f / 1024.f) + EPS);
#pragma unroll
    for (int i = 0; i < 4; ++i) {
      const float4 nw = *(const float4*)(p.final_norm + i * 256 + lane * 4);
      float4 o;
      o.x = xv[i].x * rstd * nw.x; o.y = xv[i].y * rstd * nw.y; o.z = xv[i].z * rstd * nw.z; o.w = xv[i].w * rstd * nw.w;
      *(float4*)(y + i * 256 + lane * 4) = o;
    }
  }
}

template <int PH>
__device__ __forceinline__ void run_phase(const Params& p, char* smem, int bid, int nb) {
  if (PH == 0) phase0(p, smem, bid, nb);
  else if (PH == 1) gemm_phase<0>(p, (const u16*)(p.ws + W_H), (const u16*)(p.ws + W_WINT), 32, smem, bid, nb);
  else if (PH == 2) phase2(p, smem, bid, nb);
  else if (PH == 3) phase3(p, smem, bid, nb);
  else if (PH == 4) phase4(p, bid, nb);
  else if (PH == 5) gemm_phase<1>(p, (const u16*)(p.ws + W_QS), (const u16*)(p.ws + W_WOUTT), 8, smem, bid, nb);
  else phase6(p, bid, nb);
}

#if MEGA
__global__ void __launch_bounds__(NTH) mega_kernel(Params p) {
  extern __shared__ __attribute__((aligned(16))) char smem[];
  cg::grid_group grid = cg::this_grid();
  const int bid = blockIdx.x, nb = gridDim.x;
  run_phase<0>(p, smem, bid, nb); grid.sync();
  run_phase<1>(p, smem, bid, nb); grid.sync();
  run_phase<2>(p, smem, bid, nb); grid.sync();
  run_phase<3>(p, smem, bid, nb); grid.sync();
  run_phase<4>(p, smem, bid, nb); grid.sync();
  run_phase<5>(p, smem, bid, nb); grid.sync();
  run_phase<6>(p, smem, bid, nb);
}
#else
template <int PH>
__global__ void __launch_bounds__(NTH) phase_kernel(Params p) {
  extern __shared__ __attribute__((aligned(16))) char smem[];
  run_phase<PH>(p, smem, blockIdx.x, gridDim.x);
}
template <int PH>
static void launch_phase(const Params& p, int grid, hipStream_t stream) {
  hipFuncSetAttribute((const void*)phase_kernel<PH>, hipFuncAttributeMaxDynamicSharedMemorySize, (int)LDS_BYTES);
  hipLaunchKernelGGL(phase_kernel<PH>, dim3(grid), dim3(NTH), LDS_BYTES, stream, p);
}
#endif

extern "C" void kernel_launch(void* const* d_in, const int* in_sizes, int n_in, void* d_out, int out_size,
                              void* d_ws, size_t ws_size, hipStream_t stream) {
  Params p{};
  p.x_prompt = (const float*)d_in[0];
  p.x_sample = (const float*)d_in[1];
  p.state_hgrn = (const float*)d_in[2];
  p.state_gdn = (const float*)d_in[3];
  p.state_conv = (const float*)d_in[4];
  p.norm_w = (const float*)d_in[5];
  p.w_in = (const float*)d_in[6];
  p.lb_logits = (const float*)d_in[7];
  p.conv_w = (const float*)d_in[8];
  p.a_log = (const float*)d_in[9];
  p.dt_bias = (const float*)d_in[10];
  p.hg_norm = (const float*)d_in[11];
  p.gdn_norm = (const float*)d_in[12];
  p.w_out = (const float*)d_in[13];
  p.final_norm = (const float*)d_in[14];
  p.out = (float*)d_out;
  p.ws = (char*)d_ws;
  if (ws_size < W_END) { fprintf(stderr, "workspace too small: %zu < %zu\n", ws_size, (size_t)W_END); return; }
#if MEGA
  static int grid_blocks = 0;
  if (!grid_blocks) {
    int dev = 0, cus = 0, per_cu = 0;
    hipGetDevice(&dev);
    hipDeviceGetAttribute(&cus, hipDeviceAttributeMultiprocessorCount, dev);
    hipFuncSetAttribute((const void*)mega_kernel, hipFuncAttributeMaxDynamicSharedMemorySize, (int)LDS_BYTES);
    hipOccupancyMaxActiveBlocksPerMultiprocessor(&per_cu, mega_kernel, NTH, LDS_BYTES);
    if (per_cu < 1) per_cu = 1;
    grid_blocks = cus * per_cu;
  }
  void* args[] = {&p};
  hipError_t e = hipLaunchCooperativeKernel((void*)mega_kernel, dim3(grid_blocks), dim3(NTH), args, LDS_BYTES, stream);
  if (e != hipSuccess) fprintf(stderr, "cooperative launch failed: %s (grid %d)\n", hipGetErrorString(e), grid_blocks);
#else
  const int grid = 256;
  launch_phase<0>(p, grid, stream);
  launch_phase<1>(p, grid, stream);
  launch_phase<2>(p, grid, stream);
  launch_phase<3>(p, grid, stream);
  launch_phase<4>(p, grid, stream);
  launch_phase<5>(p, grid, stream);
  launch_phase<6>(p, grid, stream);
#endif
}
```

```cpp
#include <hip/hip_runtime.h>
#include <hip/hip_cooperative_groups.h>
#include <cstdio>
namespace cg = cooperative_groups;

#ifndef MEGA
#define MEGA 1
#endif

typedef unsigned short u16;
using bf16x8 = __attribute__((ext_vector_type(8))) short;
using f32x4 = __attribute__((ext_vector_type(4))) float;
using u32x4 = __attribute__((ext_vector_type(4))) unsigned;

#define NTH 512
constexpr int MP = 16384, MS = 128, MT = 16512, DM = 1024, DIN = 4104, PQW = 2560;
constexpr float EPS = 1e-6f;
constexpr size_t LDS_BYTES = 139264;

constexpr size_t O_YP = 0, O_YS = 16777216, O_HGP = 16908288, O_GDP = 17432576, O_CVP = 17956864,
                 O_HGS = 17993728, O_GDS = 26382336, O_CVS = 34770944;
constexpr size_t W_WINT = 0;
constexpr size_t W_WOUTT = W_WINT + 8388608;
constexpr size_t W_BETA = W_WOUTT + 2097152;
constexpr size_t W_GDEC = W_BETA + 264192;
constexpr size_t W_DVEC = W_GDEC + 264192;
constexpr size_t W_DSC = W_DVEC + 524288;
constexpr size_t W_PQ = W_DSC + 4096;
constexpr size_t W_GATES = W_PQ + 84541440;
constexpr size_t W_H = W_GATES + 33816576;
constexpr size_t W_QS = W_H + 33816576;
constexpr size_t W_MNEG = W_QS + 33554432;
constexpr size_t W_LF = W_MNEG + 33554432;
constexpr size_t W_END = W_LF + 33816576;

struct Params {
  const float *x_prompt, *x_sample, *state_hgrn, *state_gdn, *state_conv, *norm_w, *w_in, *lb_logits,
      *conv_w, *a_log, *dt_bias, *hg_norm, *gdn_norm, *w_out, *final_norm;
  float* out;
  char* ws;
};

__device__ __forceinline__ u16 f2bf(float x) {
  unsigned u = __float_as_uint(x);
  u += 0x7fffu + ((u >> 16) & 1u);
  return (u16)(u >> 16);
}
__device__ __forceinline__ float bf2f(u16 h) { return __uint_as_float(((unsigned)h) << 16); }
__device__ __forceinline__ unsigned pack2(float a, float b) { return (unsigned)f2bf(a) | ((unsigned)f2bf(b) << 16); }
__device__ __forceinline__ float wave_sum(float v) {
#pragma unroll
  for (int o = 32; o > 0; o >>= 1) v += __shfl_xor(v, o, 64);
  return v;
}
__device__ __forceinline__ float sigmoidf_(float x) { return 1.f / (1.f + __expf(-x)); }
__device__ __forceinline__ float siluf_(float x) { return x / (1.f + __expf(-x)); }
__device__ __forceinline__ f32x4 mfma16(bf16x8 a, bf16x8 b, f32x4 c) {
  return __builtin_amdgcn_mfma_f32_16x16x32_bf16(a, b, c, 0, 0, 0);
}
__device__ __forceinline__ bf16x8 frag(const u16* base, int row0, int stride, int koff, int lane) {
  return *(const bf16x8*)(base + (row0 + (lane & 15)) * stride + koff + (lane >> 4) * 8);
}

__device__ void phase0(const Params& p, char* smem, int bid, int nb) {
  const int tid = threadIdx.x, lane = tid & 63, w = tid >> 6;
  u16* WinT = (u16*)(p.ws + W_WINT);
  u16* WoutT = (u16*)(p.ws + W_WOUTT);
  u16* H = (u16*)(p.ws + W_H);
  float* BETA = (float*)(p.ws + W_BETA);
  float* GDEC = (float*)(p.ws + W_GDEC);
  float* tl = (float*)smem;
  for (int t = bid; t < 1280; t += nb) {
    const float* src; int sstride; u16* dst; int kt, nt;
    if (t < 1024) { src = p.w_in; sstride = DIN; dst = WinT; kt = t >> 6; nt = t & 63; }
    else { int u = t - 1024; src = p.w_out; sstride = 1024; dst = WoutT; kt = u >> 4; nt = u & 15; }
#pragma unroll
    for (int i = 0; i < 8; ++i) {
      int idx = tid + 512 * i; int kk = idx >> 6, nn = idx & 63;
      tl[kk * 65 + nn] = src[(size_t)(kt * 64 + kk) * sstride + nt * 64 + nn];
    }
    __syncthreads();
    {
      int nn = tid >> 3, k8 = (tid & 7) * 8;
      unsigned pk[4];
#pragma unroll
      for (int e = 0; e < 4; ++e) pk[e] = pack2(tl[(k8 + 2 * e) * 65 + nn], tl[(k8 + 2 * e + 1) * 65 + nn]);
      *(uint4*)(dst + (size_t)(nt * 64 + nn) * 1024 + kt * 64 + k8) = make_uint4(pk[0], pk[1], pk[2], pk[3]);
    }
    __syncthreads();
  }
  float* W8s = (float*)smem;
  for (int idx = tid; idx < 8192; idx += 512) {
    int j = idx & 7, k = idx >> 3;
    W8s[j * 1024 + k] = p.w_in[(size_t)k * DIN + 4096 + j];
  }
  __syncthreads();
  for (int g = bid; g < MT / 8; g += nb) {
    int row = g * 8 + w;
    const float* x = row < MP ? p.x_prompt + (size_t)row * 1024 : p.x_sample + (size_t)(row - MP) * 1024;
    float4 xv[4];
    float ss = 0.f;
#pragma unroll
    for (int i = 0; i < 4; ++i) {
      xv[i] = *(const float4*)(x + i * 256 + lane * 4);
      ss += xv[i].x * xv[i].x + xv[i].y * xv[i].y + xv[i].z * xv[i].z + xv[i].w * xv[i].w;
    }
    ss = wave_sum(ss);
    float rstd = rsqrtf(ss * (1.f / 1024.f) + EPS);
    float d0 = 0, d1 = 0, d2 = 0, d3 = 0, d4 = 0, d5 = 0, d6 = 0, d7 = 0;
#pragma unroll
    for (int i = 0; i < 4; ++i) {
      float4 nw = *(const float4*)(p.norm_w + i * 256 + lane * 4);
      float4 hv;
      hv.x = xv[i].x * rstd * nw.x; hv.y = xv[i].y * rstd * nw.y; hv.z = xv[i].z * rstd * nw.z; hv.w = xv[i].w * rstd * nw.w;
      *(uint2*)(H + (size_t)row * 1024 + i * 256 + lane * 4) = make_uint2(pack2(hv.x, hv.y), pack2(hv.z, hv.w));
#define GDOT(j, dj) { float4 wv = *(const float4*)(W8s + j * 1024 + i * 256 + lane * 4); dj += hv.x * wv.x + hv.y * wv.y + hv.z * wv.z + hv.w * wv.w; }
      GDOT(0, d0) GDOT(1, d1) GDOT(2, d2) GDOT(3, d3) GDOT(4, d4) GDOT(5, d5) GDOT(6, d6) GDOT(7, d7)
#undef GDOT
    }
    d0 = wave_sum(d0); d1 = wave_sum(d1); d2 = wave_sum(d2); d3 = wave_sum(d3);
    d4 = wave_sum(d4); d5 = wave_sum(d5); d6 = wave_sum(d6); d7 = wave_sum(d7);
    if (lane < 4) {
      float gb = lane == 0 ? d0 : lane == 1 ? d1 : lane == 2 ? d2 : d3;
      float ga = lane == 0 ? d4 : lane == 1 ? d5 : lane == 2 ? d6 : d7;
      BETA[row * 4 + lane] = 1.f / (1.f + expf(-gb));
      float z = ga + p.dt_bias[lane];
      float sp = z > 20.f ? z : log1pf(expf(z));
      GDEC[row * 4 + lane] = -expf(p.a_log[lane]) * sp;
    }
  }
  __syncthreads();
}

template <int EPI>
__device__ void gemm_phase(const Params& p, const u16* __restrict__ A, const u16* __restrict__ Bt, int ntn,
                           char* smem, int bid, int nb) {
  const int tid = threadIdx.x, lane = tid & 63, w = tid >> 6;
  const int wr = w >> 1, wc = w & 1, lr = lane & 15, lq = lane >> 4;
  u16* As = (u16*)smem;
  u16* Bs = As + 256 * 72;
  const int ntm = (MT + 255) / 256;
  const int ntiles = ntm * ntn;
  for (int tile = bid; tile < ntiles; tile += nb) {
    const int tm = tile / ntn, tn = tile % ntn;
    const int m0 = tm * 256, n0 = tn * 128;
    f32x4 acc[4][4];
#pragma unroll
    for (int i = 0; i < 4; ++i)
#pragma unroll
      for (int j = 0; j < 4; ++j) acc[i][j] = f32x4{0.f, 0.f, 0.f, 0.f};
    u32x4 ra[4], rb[2];
    const u16* ap[4]; const u16* bp[2];
#pragma unroll
    for (int i = 0; i < 4; ++i) {
      int id = tid + 512 * i; int row = id >> 3, c16 = id & 7;
      int gr = m0 + row; if (gr > MT - 1) gr = MT - 1;
      ap[i] = A + (size_t)gr * 1024 + c16 * 8;
    }
#pragma unroll
    for (int i = 0; i < 2; ++i) {
      int id = tid + 512 * i; int row = id >> 3, c16 = id & 7;
      bp[i] = Bt + (size_t)(n0 + row) * 1024 + c16 * 8;
    }
#pragma unroll
    for (int i = 0; i < 4; ++i) ra[i] = *(const u32x4*)(ap[i]);
#pragma unroll
    for (int i = 0; i < 2; ++i) rb[i] = *(const u32x4*)(bp[i]);
    for (int kt = 0; kt < 16; ++kt) {
      __syncthreads();
#pragma unroll
      for (int i = 0; i < 4; ++i) { int id = tid + 512 * i; *(u32x4*)(As + (id >> 3) * 72 + (id & 7) * 8) = ra[i]; }
#pragma unroll
      for (int i = 0; i < 2; ++i) { int id = tid + 512 * i; *(u32x4*)(Bs + (id >> 3) * 72 + (id & 7) * 8) = rb[i]; }
      __syncthreads();
      {
        const int kn = (kt + 1 < 16 ? kt + 1 : 15) * 64;
#pragma unroll
        for (int i = 0; i < 4; ++i) ra[i] = *(const u32x4*)(ap[i] + kn);
#pragma unroll
        for (int i = 0; i < 2; ++i) rb[i] = *(const u32x4*)(bp[i] + kn);
      }
#pragma unroll
      for (int ks = 0; ks < 2; ++ks) {
        bf16x8 af[4], bf[4];
#pragma unroll
        for (int mi = 0; mi < 4; ++mi) af[mi] = frag(As, wr * 64 + mi * 16, 72, ks * 32, lane);
#pragma unroll
        for (int ni = 0; ni < 4; ++ni) bf[ni] = frag(Bs, wc * 64 + ni * 16, 72, ks * 32, lane);
#pragma unroll
        for (int mi = 0; mi < 4; ++mi)
#pragma unroll
          for (int ni = 0; ni < 4; ++ni) acc[mi][ni] = mfma16(af[mi], bf[ni], acc[mi][ni]);
      }
    }
    if (EPI == 0) {
      u16* PQ = (u16*)(p.ws + W_PQ);
      u16* GATES = (u16*)(p.ws + W_GATES);
      float* LF = (float*)(p.ws + W_LF);
      const int sec = n0 >> 9;
#pragma unroll
      for (int ni = 0; ni < 4; ++ni) {
        const int col = n0 + wc * 64 + ni * 16 + lr;
        float lbv = 0.f;
        if (sec == 1) {
          int cc = col - 512;
          lbv = 1.f / (1.f + expf(p.lb_logits[512 + cc] - p.lb_logits[cc]));
        }
#pragma unroll
        for (int mi = 0; mi < 4; ++mi) {
#pragma unroll
          for (int j = 0; j < 4; ++j) {
            const int row = m0 + wr * 64 + mi * 16 + lq * 4 + j;
            if (row >= MT) continue;
            const float v = acc[mi][ni][j];
            if (sec == 0) PQ[(size_t)row * PQW + col] = f2bf(v);
            else if (sec == 1) LF[(size_t)row * 512 + (col - 512)] = logf(lbv + (1.f - lbv) / (1.f + expf(-v)));
            else if (sec == 2) PQ[(size_t)row * PQW + 512 + (col - 1024)] = f2bf(v);
            else if (sec == 3) GATES[(size_t)row * 1024 + (col - 1536)] = f2bf(v / (1.f + expf(-v)));
            else if (sec == 7) GATES[(size_t)row * 1024 + 512 + (col - 3584)] = f2bf(v / (1.f + expf(-v)));
            else {
              const int cc = col - 2048;
              PQ[(size_t)row * PQW + 1024 + cc] = f2bf(v);
              if (row < MP) {
                int tt = row & 2047;
                if (tt >= 2045) p.out[O_CVP + (size_t)((row >> 11) * 3 + (tt - 2045)) * 1536 + cc] = v;
              } else {
                p.out[O_CVS + (size_t)((row - MP) * 3 + 2) * 1536 + cc] = v;
              }
            }
          }
        }
      }
    } else {
#pragma unroll
      for (int ni = 0; ni < 4; ++ni) {
        const int col = n0 + wc * 64 + ni * 16 + lr;
#pragma unroll
        for (int mi = 0; mi < 4; ++mi) {
#pragma unroll
          for (int j = 0; j < 4; ++j) {
            const int row = m0 + wr * 64 + mi * 16 + lq * 4 + j;
            if (row >= MT) continue;
            const float v = acc[mi][ni][j];
            if (row < MP) p.out[O_YP + (size_t)row * 1024 + col] = p.x_prompt[(size_t)row * 1024 + col] + v;
            else p.out[O_YS + (size_t)(row - MP) * 1024 + col] = p.x_sample[(size_t)(row - MP) * 1024 + col] + v;
          }
        }
      }
    }
  }
  __syncthreads();
}

__device__ void hgrn_item(const Params& p, char* smem, int idx) {
  const int tid = threadIdx.x, lane = tid & 63, w = tid >> 6;
  const int lr = lane & 15, lq = lane >> 4;
  const int h = idx & 3, c = (idx >> 2) & 31, b = idx >> 7;
  const int r0 = b * 2048 + c * 64;
  const u16* PQ = (const u16*)(p.ws + W_PQ);
  const float* LF = (const float*)(p.ws + W_LF);
  u16* QS = (u16*)(p.ws + W_QS);
  u16* O0 = (u16*)(p.ws + W_H);
  u16* NB = (u16*)(p.out);
  float* DVEC = (float*)(p.ws + W_DVEC);
  u16* qt = (u16*)smem;
  u16* kt = qt + 64 * 136;
  u16* ktT = kt + 64 * 136;
  u16* vT = ktT + 128 * 72;
  u16* sc = vT + 128 * 72;
  float* ps = (float*)(sc + 64 * 72);
  const int col = tid & 127, part = tid >> 7;
  float lfv[16], bcum[16];
  {
    const float* lfp = LF + (size_t)(r0 + part * 16) * 512 + h * 128 + col;
#pragma unroll
    for (int i = 0; i < 16; ++i) lfv[i] = lfp[(size_t)i * 512];
    float run = 0.f;
#pragma unroll
    for (int i = 0; i < 16; ++i) { run += lfv[i]; bcum[i] = run; }
    ps[part * 128 + col] = run;
  }
  __syncthreads();
  {
    float off = 0.f, blast = 0.f;
#pragma unroll
    for (int pp = 0; pp < 4; ++pp) { float t = ps[pp * 128 + col]; blast += t; if (pp < part) off += t; }
    const u16* qp = PQ + (size_t)(r0 + part * 16) * PQW + h * 128 + col;
    u16* qsout = QS + ((size_t)idx * 64 + part * 16) * 128 + col;
#pragma unroll
    for (int i = 0; i < 16; ++i) {
      const float bb = bcum[i] + off;
      const int row = part * 16 + i;
      const float q = bf2f(qp[(size_t)i * PQW]);
      const u16 v = qp[(size_t)i * PQW + 512];
      qsout[i * 128] = f2bf(q * expf(bb));
      qt[row * 136 + col] = f2bf(q * expf(bb - blast));
      const float kk = (1.f - expf(lfv[i])) * expf(blast - bb);
      const u16 kbv = f2bf(kk);
      kt[row * 136 + col] = kbv;
      ktT[col * 72 + row] = kbv;
      vT[col * 72 + row] = v;
    }
    if (part == 0) DVEC[idx * 128 + col] = expf(blast);
  }
  __syncthreads();
  {
    const int tr = w >> 1;
    bf16x8 a[4];
#pragma unroll
    for (int ks = 0; ks < 4; ++ks) a[ks] = frag(qt, tr * 16, 136, ks * 32, lane);
#pragma unroll
    for (int tci = 0; tci < 2; ++tci) {
      const int tc = (w & 1) * 2 + tci;
      f32x4 acc = {0.f, 0.f, 0.f, 0.f};
#pragma unroll
      for (int ks = 0; ks < 4; ++ks) acc = mfma16(a[ks], frag(kt, tc * 16, 136, ks * 32, lane), acc);
#pragma unroll
      for (int j = 0; j < 4; ++j) {
        const int t = tr * 16 + lq * 4 + j, s = tc * 16 + lr;
        sc[t * 72 + s] = f2bf(t >= s ? acc[j] : 0.f);
      }
    }
  }
  __syncthreads();
  {
    const int tr = w >> 1;
    const bf16x8 a0 = frag(sc, tr * 16, 72, 0, lane), a1 = frag(sc, tr * 16, 72, 32, lane);
#pragma unroll
    for (int tci = 0; tci < 4; ++tci) {
      const int tc = (w & 1) * 4 + tci;
      f32x4 acc = {0.f, 0.f, 0.f, 0.f};
      acc = mfma16(a0, frag(vT, tc * 16, 72, 0, lane), acc);
      acc = mfma16(a1, frag(vT, tc * 16, 72, 32, lane), acc);
#pragma unroll
      for (int j = 0; j < 4; ++j) {
        const int t = tr * 16 + lq * 4 + j, n = tc * 16 + lr;
        O0[((size_t)idx * 64 + t) * 128 + n] = f2bf(acc[j]);
      }
    }
  }
  {
    const int tr = w;
    const bf16x8 a0 = frag(ktT, tr * 16, 72, 0, lane), a1 = frag(ktT, tr * 16, 72, 32, lane);
#pragma unroll
    for (int tc = 0; tc < 8; ++tc) {
      f32x4 acc = {0.f, 0.f, 0.f, 0.f};
      acc = mfma16(a0, frag(vT, tc * 16, 72, 0, lane), acc);
      acc = mfma16(a1, frag(vT, tc * 16, 72, 32, lane), acc);
#pragma unroll
      for (int j = 0; j < 4; ++j) {
        const int kd = tr * 16 + lq * 4 + j, n = tc * 16 + lr;
        NB[((size_t)idx * 128 + kd) * 128 + n] = f2bf(acc[j]);
      }
    }
  }
  __syncthreads();
}

template <int J>
struct SolveCol {
  static __device__ __forceinline__ void run(f32x4 (&x)[16], const float* AT) {
    if constexpr (J < 63) {
      const float xj = x[J / 4][J % 4];
#pragma unroll
      for (int B = (J + 1) / 4; B < 16; ++B) {
        const f32x4 av = *(const f32x4*)(AT + J * 64 + B * 4);
        x[B] -= av * xj;
        if ((B & 7) == 7) __builtin_amdgcn_sched_barrier(0);
      }
      __builtin_amdgcn_sched_barrier(0);
      SolveCol<J + 1>::run(x, AT);
    }
  }
};

__device__ void gdn_item(const Params& p, char* smem, int idx) {
  const int tid = threadIdx.x, lane = tid & 63, w = tid >> 6;
  const int lr = lane & 15, lq = lane >> 4;
  const int h = idx & 3, c = (idx >> 2) & 31, b = idx >> 7;
  const int r0 = b * 2048 + c * 64;
  const u16* PQ = (const u16*)(p.ws + W_PQ);
  const float* BETA = (const float*)(p.ws + W_BETA);
  const float* GDEC = (const float*)(p.ws + W_GDEC);
  u16* QS = (u16*)(p.ws + W_QS);
  u16* O0 = (u16*)(p.ws + W_H);
  u16* NB = (u16*)(p.out);
  u16* MNEG = (u16*)(p.ws + W_MNEG);
  float* DSC = (float*)(p.ws + W_DSC);
  u16* kb = (u16*)smem;
  u16* qb = kb + 64 * 136;
  u16* vS = qb + 64 * 136;
  float* Asol = (float*)(vS + 64 * 128);
  u16* attn = (u16*)(Asol + 64 * 64);
  u16* khT = attn + 64 * 72;
  u16* WT = khT + 128 * 72;
  u16* U0T = WT + 128 * 72;
  float* gc = (float*)(U0T + 128 * 72);
  float* bet = gc + 64;

  if (w == 0) {
    float g = GDEC[(size_t)(r0 + lane) * 4 + h];
#pragma unroll
    for (int o = 1; o < 64; o <<= 1) { float t = __shfl_up(g, o, 64); if (lane >= o) g += t; }
    gc[lane] = g;
    bet[lane] = BETA[(size_t)(r0 + lane) * 4 + h];
  }
  {
    const int chq = 1024 + h * 128 + 2 * lane;
    const int cwq = h * 128 + 2 * lane;
    float cw[3][4][2];
#pragma unroll
    for (int ty = 0; ty < 3; ++ty)
#pragma unroll
      for (int j = 0; j < 4; ++j) {
        float2 t2 = *(const float2*)(p.conv_w + j * 1536 + ty * 512 + cwq);
        cw[ty][j][0] = t2.x; cw[ty][j][1] = t2.y;
      }
    float win[3][3][2];
    const int t0 = w * 8;
#pragma unroll
    for (int a = 0; a < 3; ++a) {
      const int rr = t0 - 3 + a;
      const bool valid = (c > 0) || (rr >= 0);
#pragma unroll
      for (int ty = 0; ty < 3; ++ty) {
        unsigned u = 0;
        if (valid) u = *(const unsigned*)(PQ + (ptrdiff_t)(r0 + rr) * PQW + chq + ty * 512);
        win[ty][a][0] = bf2f((u16)(u & 0xffff)); win[ty][a][1] = bf2f((u16)(u >> 16));
      }
    }
#pragma unroll
    for (int tt = 0; tt < 8; ++tt) {
      const int t = t0 + tt;
      float cv[3][2];
#pragma unroll
      for (int ty = 0; ty < 3; ++ty) {
        unsigned u = *(const unsigned*)(PQ + (size_t)(r0 + t) * PQW + chq + ty * 512);
        float c0 = bf2f((u16)(u & 0xffff)), c1 = bf2f((u16)(u >> 16));
        float s0 = cw[ty][0][0] * win[ty][0][0] + cw[ty][1][0] * win[ty][1][0] + cw[ty][2][0] * win[ty][2][0] + cw[ty][3][0] * c0;
        float s1 = cw[ty][0][1] * win[ty][0][1] + cw[ty][1][1] * win[ty][1][1] + cw[ty][2][1] * win[ty][2][1] + cw[ty][3][1] * c1;
        win[ty][0][0] = win[ty][1][0]; win[ty][0][1] = win[ty][1][1];
        win[ty][1][0] = win[ty][2][0]; win[ty][1][1] = win[ty][2][1];
        win[ty][2][0] = c0; win[ty][2][1] = c1;
        cv[ty][0] = siluf_(s0); cv[ty][1] = siluf_(s1);
      }
      float ssq = wave_sum(cv[0][0] * cv[0][0] + cv[0][1] * cv[0][1]);
      float ssk = wave_sum(cv[1][0] * cv[1][0] + cv[1][1] * cv[1][1]);
      const float rq = rsqrtf(ssq + EPS) * 0.08838834764831845f;
      const float rk = rsqrtf(ssk + EPS);
      *(unsigned*)(qb + t * 136 + 2 * lane) = pack2(cv[0][0] * rq, cv[0][1] * rq);
      *(unsigned*)(kb + t * 136 + 2 * lane) = pack2(cv[1][0] * rk, cv[1][1] * rk);
      *(unsigned*)(vS + t * 128 + 2 * lane) = pack2(cv[2][0], cv[2][1]);
    }
  }
  __syncthreads();
  {
    const int which = w >> 2, tr = w & 3;
    const u16* Asrc = which ? qb : kb;
    bf16x8 a[4];
#pragma unroll
    for (int ks = 0; ks < 4; ++ks) a[ks] = frag(Asrc, tr * 16, 136, ks * 32, lane);
#pragma unroll
    for (int tc = 0; tc < 4; ++tc) {
      f32x4 acc = {0.f, 0.f, 0.f, 0.f};
#pragma unroll
      for (int ks = 0; ks < 4; ++ks) acc = mfma16(a[ks], frag(kb, tc * 16, 136, ks * 32, lane), acc);
#pragma unroll
      for (int j = 0; j < 4; ++j) {
        const int t = tr * 16 + lq * 4 + j, s = tc * 16 + lr;
        const float L = expf(fminf(gc[t] - gc[s], 0.f));
        if (which == 0) Asol[s * 64 + t] = (t > s) ? bet[t] * acc[j] * L : 0.f;
        else attn[t * 72 + s] = f2bf((t >= s) ? acc[j] * L : 0.f);
      }
    }
  }
  __syncthreads();
  if (tid < 256) {
    f32x4 x[16];
    if (tid < 128) {
#pragma unroll
      for (int s = 0; s < 64; ++s) { x[s >> 2][s & 3] = bf2f(vS[s * 128 + tid]) * bet[s]; if ((s & 7) == 7) __builtin_amdgcn_sched_barrier(0); }
    } else {
#pragma unroll
      for (int s = 0; s < 64; ++s) { x[s >> 2][s & 3] = bf2f(kb[s * 136 + tid - 128]) * bet[s] * expf(gc[s]); if ((s & 7) == 7) __builtin_amdgcn_sched_barrier(0); }
    }
    SolveCol<0>::run(x, Asol);
    u16* dst = (tid < 128) ? (U0T + tid * 72) : (WT + (tid - 128) * 72);
#pragma unroll
    for (int s8 = 0; s8 < 8; ++s8) {
      *(u32x4*)(dst + s8 * 8) = u32x4{pack2(x[2 * s8][0], x[2 * s8][1]), pack2(x[2 * s8][2], x[2 * s8][3]),
                                      pack2(x[2 * s8 + 1][0], x[2 * s8 + 1][1]), pack2(x[2 * s8 + 1][2], x[2 * s8 + 1][3])};
    }
  } else {
    const float glast = gc[63];
    const int e0 = tid - 256;
#pragma unroll 4
    for (int i = 0; i < 32; ++i) {
      const int e = e0 + 256 * i;
      const int s = e & 63, kd = e >> 6;
      khT[kd * 72 + s] = f2bf(bf2f(kb[s * 136 + kd]) * expf(glast - gc[s]));
    }
  }
  __syncthreads();
  {
    const int tr = w & 3, half = w >> 2;
    const u16* Bsrc = half ? U0T : WT;
    const bf16x8 a0 = frag(attn, tr * 16, 72, 0, lane), a1 = frag(attn, tr * 16, 72, 32, lane);
#pragma unroll 2
    for (int tc = 0; tc < 8; ++tc) {
      f32x4 acc = {0.f, 0.f, 0.f, 0.f};
      acc = mfma16(a0, frag(Bsrc, tc * 16, 72, 0, lane), acc);
      acc = mfma16(a1, frag(Bsrc, tc * 16, 72, 32, lane), acc);
#pragma unroll
      for (int j = 0; j < 4; ++j) {
        const int t = tr * 16 + lq * 4 + j, n = tc * 16 + lr;
        const size_t o = ((size_t)(1024 + idx) * 64 + t) * 128 + n;
        if (half == 0) QS[o] = f2bf(bf2f(qb[t * 136 + n]) * expf(gc[t]) - acc[j]);
        else O0[o] = f2bf(acc[j]);
      }
    }
  }
  {
    const int tr = w;
    const bf16x8 a0 = frag(khT, tr * 16, 72, 0, lane), a1 = frag(khT, tr * 16, 72, 32, lane);
#pragma unroll 2
    for (int tc = 0; tc < 16; ++tc) {
      const u16* Bsrc = tc < 8 ? WT : U0T;
      const int tcc = tc & 7;
      f32x4 acc = {0.f, 0.f, 0.f, 0.f};
      acc = mfma16(a0, frag(Bsrc, tcc * 16, 72, 0, lane), acc);
      acc = mfma16(a1, frag(Bsrc, tcc * 16, 72, 32, lane), acc);
#pragma unroll
      for (int j = 0; j < 4; ++j) {
        const int kd = tr * 16 + lq * 4 + j, n = tcc * 16 + lr;
        if (tc < 8) MNEG[((size_t)idx * 128 + kd) * 128 + n] = f2bf(-acc[j]);
        else NB[((size_t)(1024 + idx) * 128 + kd) * 128 + n] = f2bf(acc[j]);
      }
    }
  }
  if (tid == 0) DSC[idx] = expf(gc[63]);
  __syncthreads();
}

__device__ void phase2(const Params& p, char* smem, int bid, int nb) {
  for (int it = bid; it < 2048; it += nb) {
    if (it & 1) gdn_item(p, smem, it >> 1);
    else hgrn_item(p, smem, it >> 1);
  }
}

struct ScanRegs {
  bf16x8 Aq[4];
  bf16x8 Am[4];
  u16 o0[4];
  u16 nn[4];
  float dd[4];
};

__device__ __forceinline__ void scan_load(ScanRegs& r, const Params& p, int type, int idx, int vs, int w, int lr, int lq) {
  const u16* QS = (const u16*)(p.ws + W_QS);
  const u16* O0 = (const u16*)(p.ws + W_H);
  const u16* NB = (const u16*)(p.out);
  const u16* MNEG = (const u16*)(p.ws + W_MNEG);
  const float* DVEC = (const float*)(p.ws + W_DVEC);
  const float* DSC = (const float*)(p.ws + W_DSC);
  const size_t ti = (size_t)type * 1024 + idx;
  if (w < 4) {
    const u16* qrow = QS + (ti * 64 + w * 16 + lr) * 128 + lq * 8;
#pragma unroll
    for (int ks = 0; ks < 4; ++ks) r.Aq[ks] = *(const bf16x8*)(qrow + ks * 32);
#pragma unroll
    for (int j = 0; j < 4; ++j) r.o0[j] = O0[(ti * 64 + w * 16 + lq * 4 + j) * 128 + vs * 16 + lr];
  }
#pragma unroll
  for (int j = 0; j < 4; ++j) r.nn[j] = NB[(ti * 128 + w * 16 + lq * 4 + j) * 128 + vs * 16 + lr];
  if (type == 1) {
    const u16* mrow = MNEG + ((size_t)idx * 128 + w * 16 + lr) * 128 + lq * 8;
#pragma unroll
    for (int ks = 0; ks < 4; ++ks) r.Am[ks] = *(const bf16x8*)(mrow + ks * 32);
    const float d = DSC[idx];
#pragma unroll
    for (int j = 0; j < 4; ++j) r.dd[j] = d;
  } else {
#pragma unroll
    for (int j = 0; j < 4; ++j) r.dd[j] = DVEC[idx * 128 + w * 16 + lq * 4 + j];
  }
}

__device__ void scan_unit(const Params& p, char* smem, int u) {
  const int tid = threadIdx.x, lane = tid & 63, w = tid >> 6;
  const int lr = lane & 15, lq = lane >> 4;
  const int type = u >> 8, rem = u & 255;
  const int b = rem >> 5, h = (rem >> 3) & 3, vs = rem & 7;
  float* OPRE = (float*)(p.ws + W_PQ);
  u16* SbT = (u16*)smem;
  for (int i = tid; i < 2 * 16 * 136; i += 512) SbT[i] = 0;
  f32x4 S = {0.f, 0.f, 0.f, 0.f};
  ScanRegs cur, nxt;
  scan_load(cur, p, type, (b * 32 + 0) * 4 + h, vs, w, lr, lq);
  for (int c = 0; c < 32; ++c) {
    __syncthreads();
    const u16* Sb = SbT + (c & 1) * 16 * 136;
    bf16x8 Bf[4];
#pragma unroll
    for (int ks = 0; ks < 4; ++ks) Bf[ks] = *(const bf16x8*)(Sb + lr * 136 + ks * 32 + lq * 8);
    if (c + 1 < 32) scan_load(nxt, p, type, (b * 32 + c + 1) * 4 + h, vs, w, lr, lq);
    if (w < 4) {
      f32x4 acc;
#pragma unroll
      for (int j = 0; j < 4; ++j) acc[j] = bf2f(cur.o0[j]);
#pragma unroll
      for (int ks = 0; ks < 4; ++ks) acc = mfma16(cur.Aq[ks], Bf[ks], acc);
#pragma unroll
      for (int j = 0; j < 4; ++j) {
        const int row = b * 2048 + c * 64 + w * 16 + lq * 4 + j;
        OPRE[(size_t)row * 1024 + type * 512 + h * 128 + vs * 16 + lr] = acc[j];
      }
    }
    f32x4 Sn;
#pragma unroll
    for (int j = 0; j < 4; ++j) Sn[j] = cur.dd[j] * S[j] + bf2f(cur.nn[j]);
    if (type == 1) {
#pragma unroll
      for (int ks = 0; ks < 4; ++ks) Sn = mfma16(cur.Am[ks], Bf[ks], Sn);
    }
    S = Sn;
    u16* Sw = SbT + ((c + 1) & 1) * 16 * 136;
    *(uint2*)(Sw + lr * 136 + w * 16 + lq * 4) = make_uint2(pack2(S[0], S[1]), pack2(S[2], S[3]));
    cur = nxt;
  }
  float* so = p.out + (type ? O_GDP : O_HGP) + (size_t)(b * 4 + h) * 16384;
#pragma unroll
  for (int j = 0; j < 4; ++j) so[(w * 16 + lq * 4 + j) * 128 + vs * 16 + lr] = S[j];
  __syncthreads();
}

__device__ void sample_item(const Params& p, char* smem, int it) {
  const int tid = threadIdx.x, lane = tid & 63, w = tid >> 6;
  const int type = it >> 9, b = (it >> 2) & 127, h = it & 3;
  const int row = MP + b;
  const u16* PQ = (const u16*)(p.ws + W_PQ);
  const float* LF = (const float*)(p.ws + W_LF);
  const float* BETA = (const float*)(p.ws + W_BETA);
  const float* GDEC = (const float*)(p.ws + W_GDEC);
  float* OPRE = (float*)(p.ws + W_PQ);
  float* fq = (float*)smem;
  float* fk = fq + 128;
  float* fv = fk + 128;
  float* fe = fv + 128;
  float* red = fe + 128;
  float* sc = red + 1024;
  const int n = tid & 127, kp = tid >> 7;
  if (type == 0) {
    if (tid < 128) {
      const float lf = LF[(size_t)row * 512 + h * 128 + tid];
      const float f = expf(lf);
      fe[tid] = f;
      fk[tid] = 1.f - f;
      fq[tid] = bf2f(PQ[(size_t)row * PQW + h * 128 + tid]);
      fv[tid] = bf2f(PQ[(size_t)row * PQW + 512 + h * 128 + tid]);
    }
    __syncthreads();
    const float* S = p.state_hgrn + ((size_t)(b * 4 + h) * 128) * 128;
    float* So = p.out + O_HGS + ((size_t)(b * 4 + h) * 128) * 128;
    const float vn = fv[n];
    float o = 0.f;
#pragma unroll 8
    for (int i = 0; i < 32; ++i) {
      const int k = kp * 32 + i;
      const float sn = fe[k] * S[k * 128 + n] + fk[k] * vn;
      So[k * 128 + n] = sn;
      o += fq[k] * sn;
    }
    red[kp * 128 + n] = o;
    __syncthreads();
    if (tid < 128) OPRE[(size_t)row * 1024 + h * 128 + tid] = red[tid] + red[128 + tid] + red[256 + tid] + red[384 + tid];
    __syncthreads();
  } else {
    const float* cprev = p.state_conv + (size_t)b * 3 * 1536;
    if (tid < 384) {
      const int ty = tid >> 7, cc = tid & 127;
      const int ch = ty * 512 + h * 128 + cc;
      const float p0 = cprev[ch], p1 = cprev[1536 + ch], p2 = cprev[3072 + ch];
      const float nw = bf2f(PQ[(size_t)row * PQW + 1024 + ch]);
      const float s = p.conv_w[ch] * p0 + p.conv_w[1536 + ch] * p1 + p.conv_w[3072 + ch] * p2 + p.conv_w[4608 + ch] * nw;
      fq[ty * 128 + cc] = siluf_(s);
      p.out[O_CVS + (size_t)(b * 3 + 0) * 1536 + ch] = p1;
      p.out[O_CVS + (size_t)(b * 3 + 1) * 1536 + ch] = p2;
    }
    __syncthreads();
    if (w < 2) {
      const float a0 = fq[w * 128 + lane], a1 = fq[w * 128 + 64 + lane];
      const float ss = wave_sum(a0 * a0 + a1 * a1);
      if (lane == 0) sc[w] = ss;
    }
    __syncthreads();
    const float rq = rsqrtf(sc[0] + EPS) * 0.08838834764831845f;
    const float rk = rsqrtf(sc[1] + EPS);
    __syncthreads();
    if (tid < 128) fq[tid] *= rq;
    else if (tid < 256) fk[tid - 128] *= rk;
    __syncthreads();
    if (w == 0) {
      const float qk = wave_sum(fq[lane] * fk[lane] + fq[64 + lane] * fk[64 + lane]);
      if (lane == 0) sc[2] = qk;
    }
    const float eg = expf(GDEC[(size_t)row * 4 + h]);
    const float beta = BETA[(size_t)row * 4 + h];
    const float* S = p.state_gdn + ((size_t)(b * 4 + h) * 128) * 128;
    float* So = p.out + O_GDS + ((size_t)(b * 4 + h) * 128) * 128;
    float sd[32];
    float ks_ = 0.f, qs_ = 0.f;
#pragma unroll
    for (int i = 0; i < 32; ++i) {
      const int k = kp * 32 + i;
      sd[i] = eg * S[k * 128 + n];
      ks_ += fk[k] * sd[i];
      qs_ += fq[k] * sd[i];
    }
    red[kp * 128 + n] = ks_;
    red[512 + kp * 128 + n] = qs_;
    __syncthreads();
    const float kS = red[n] + red[128 + n] + red[256 + n] + red[384 + n];
    const float delta = (fv[n] - kS) * beta;
#pragma unroll
    for (int i = 0; i < 32; ++i) {
      const int k = kp * 32 + i;
      So[k * 128 + n] = sd[i] + fk[k] * delta;
    }
    if (tid < 128) {
      const float qS = red[512 + n] + red[640 + n] + red[768 + n] + red[896 + n];
      OPRE[(size_t)row * 1024 + 512 + h * 128 + n] = qS + sc[2] * delta;
    }
    __syncthreads();
  }
}

__device__ void phase3(const Params& p, char* smem, int bid, int nb) {
  for (int u = bid; u < 512; u += nb) scan_unit(p, smem, u);
  for (int it = bid; it < 1024; it += nb) sample_item(p, smem, it);
}

__device__ void phase4(const Params& p, int bid, int nb) {
  const int tid = threadIdx.x, lane = tid & 63, w = tid >> 6;
  const float* OPRE = (const float*)(p.ws + W_PQ);
  const u16* GATES = (const u16*)(p.ws + W_GATES);
  u16* A2 = (u16*)(p.ws + W_QS);
  for (int g = bid; g < MT / 8; g += nb) {
    const int row = g * 8 + w;
#pragma unroll
    for (int i = 0; i < 4; ++i) {
      const int col = i * 256 + lane * 4;
      const float4 v = *(const float4*)(OPRE + (size_t)row * 1024 + col);
      float ss = v.x * v.x + v.y * v.y + v.z * v.z + v.w * v.w;
#pragma unroll
      for (int o = 16; o > 0; o >>= 1) ss += __shfl_xor(ss, o, 64);
      const float rstd = rsqrtf(ss * (1.f / 128.f) + EPS);
      const int cn = col & 127;
      const float4 nw = *(const float4*)((col < 512 ? p.hg_norm : p.gdn_norm) + cn);
      const uint2 gt = *(const uint2*)(GATES + (size_t)row * 1024 + col);
      const float g0 = bf2f((u16)(gt.x & 0xffff)), g1 = bf2f((u16)(gt.x >> 16));
      const float g2 = bf2f((u16)(gt.y & 0xffff)), g3 = bf2f((u16)(gt.y >> 16));
      *(uint2*)(A2 + (size_t)row * 1024 + col) =
          make_uint2(pack2(v.x * rstd * nw.x * g0, v.y * rstd * nw.y * g1), pack2(v.z * rstd * nw.z * g2, v.w * rstd * nw.w * g3));
    }
  }
}

__device__ void phase6(const Params& p, int bid, int nb) {
  const int tid = threadIdx.x, lane = tid & 63, w = tid >> 6;
  for (int g = bid; g < MT / 8; g += nb) {
    const int row = g * 8 + w;
    float* y = row < MP ? p.out + O_YP + (size_t)row * 1024 : p.out + O_YS + (size_t)(row - MP) * 1024;
    float4 xv[4];
    float ss = 0.f;
#pragma unroll
    for (int i = 0; i < 4; ++i) {
      xv[i] = *(const float4*)(y + i * 256 + lane * 4);
      ss += xv[i].x * xv[i].x + xv[i].y * xv[i].y + xv[i].z * xv[i].z + xv[i].w * xv[i].w;
    }
    ss = wave_sum(ss);
    const float rstd = rsqrtf(ss * (1.f / 1024.f) + EPS);
#pragma unroll
    for (int i = 0; i < 4; ++i) {
      const float4 nw = *(const float4*)(p.final_norm + i * 256 + lane * 4);
      float4 o;
      o.x = xv[i].x * rstd * nw.x; o.y = xv[i].y * rstd * nw.y; o.z = xv[i].z * rstd * nw.z; o.w = xv[i].w * rstd * nw.w;
      *(float4*)(y + i * 256 + lane * 4) = o;
    }
  }
}

template <int PH>
__device__ __forceinline__ void run_phase(const Params& p, char* smem, int bid, int nb) {
  if (PH == 0) phase0(p, smem, bid, nb);
  else if (PH == 1) gemm_phase<0>(p, (const u16*)(p.ws + W_H), (const u16*)(p.ws + W_WINT), 32, smem, bid, nb);
  else if (PH == 2) phase2(p, smem, bid, nb);
  else if (PH == 3) phase3(p, smem, bid, nb);
  else if (PH == 4) phase4(p, bid, nb);
  else if (PH == 5) gemm_phase<1>(p, (const u16*)(p.ws + W_QS), (const u16*)(p.ws + W_WOUTT), 8, smem, bid, nb);
  else phase6(p, bid, nb);
}

#if MEGA
__global__ void __launch_bounds__(NTH) mega_kernel(Params p) {
  extern __shared__ __attribute__((aligned(16))) char smem[];
  cg::grid_group grid = cg::this_grid();
  const int bid = blockIdx.x, nb = gridDim.x;
  run_phase<0>(p, smem, bid, nb); grid.sync();
  run_phase<1>(p, smem, bid, nb); grid.sync();
  run_phase<2>(p, smem, bid, nb); grid.sync();
  run_phase<3>(p, smem, bid, nb); grid.sync();
  run_phase<4>(p, smem, bid, nb); grid.sync();
  run_phase<5>(p, smem, bid, nb); grid.sync();
  run_phase<6>(p, smem, bid, nb);
}
#else
template <int PH>
__global__ void __launch_bounds__(NTH) phase_kernel(Params p) {
  extern __shared__ __attribute__((aligned(16))) char smem[];
  run_phase<PH>(p, smem, blockIdx.x, gridDim.x);
}
template <int PH>
static void launch_phase(const Params& p, int grid, hipStream_t stream) {
  hipFuncSetAttribute((const void*)phase_kernel<PH>, hipFuncAttributeMaxDynamicSharedMemorySize, (int)LDS_BYTES);
  hipLaunchKernelGGL(phase_kernel<PH>, dim3(grid), dim3(NTH), LDS_BYTES, stream, p);
}
#endif

extern "C" void kernel_launch(void* const* d_in, const int* in_sizes, int n_in, void* d_out, int out_size,
                              void* d_ws, size_t ws_size, hipStream_t stream) {
  Params p{};
  p.x_prompt = (const float*)d_in[0];
  p.x_sample = (const float*)d_in[1];
  p.state_hgrn = (const float*)d_in[2];
  p.state_gdn = (const float*)d_in[3];
  p.state_conv = (const float*)d_in[4];
  p.norm_w = (const float*)d_in[5];
  p.w_in = (const float*)d_in[6];
  p.lb_logits = (const float*)d_in[7];
  p.conv_w = (const float*)d_in[8];
  p.a_log = (const float*)d_in[9];
  p.dt_bias = (const float*)d_in[10];
  p.hg_norm = (const float*)d_in[11];
  p.gdn_norm = (const float*)d_in[12];
  p.w_out = (const float*)d_in[13];
  p.final_norm = (const float*)d_in[14];
  p.out = (float*)d_out;
  p.ws = (char*)d_ws;
  if (ws_size < W_END) { fprintf(stderr, "workspace too small: %zu < %zu\n", ws_size, (size_t)W_END); return; }
#if MEGA
  static int grid_blocks = 0;
  if (!grid_blocks) {
    int dev = 0, cus = 0, per_cu = 0;
    hipGetDevice(&dev);
    hipDeviceGetAttribute(&cus, hipDeviceAttributeMultiprocessorCount, dev);
    hipFuncSetAttribute((const void*)mega_kernel, hipFuncAttributeMaxDynamicSharedMemorySize, (int)LDS_BYTES);
    hipOccupancyMaxActiveBlocksPerMultiprocessor(&per_cu, mega_kernel, NTH, LDS_BYTES);
    if (per_cu < 1) per_cu = 1;
    grid_blocks = cus * per_cu;
  }
  void* args[] = {&p};
  hipError_t e = hipLaunchCooperativeKernel((void*)mega_kernel, dim3(grid_blocks), dim3(NTH), args, LDS_BYTES, stream);
  if (e != hipSuccess) fprintf(stderr, "cooperative launch failed: %s (grid %d)\n", hipGetErrorString(e), grid_blocks);
#else
  const int grid = 256;
  launch_phase<0>(p, grid, stream);
  launch_phase<1>(p, grid, stream);
  launch_phase<2>(p, grid, stream);
  launch_phase<3>(p, grid, stream);
  launch_phase<4>(p, grid, stream);
  launch_phase<5>(p, grid, stream);
  launch_phase<6>(p, grid, stream);
#endif
}
```

```cpp
#include <hip/hip_runtime.h>
#include <hip/hip_cooperative_groups.h>
#include <cstdio>
namespace cg = cooperative_groups;

#ifndef MEGA
#define MEGA 1
#define DUP_MASK 0
#endif

typedef unsigned short u16;
using bf16x8 = __attribute__((ext_vector_type(8))) short;
using f32x4 = __attribute__((ext_vector_type(4))) float;
using u32x4 = __attribute__((ext_vector_type(4))) unsigned;

#define NTH 512
constexpr int MP = 16384, MS = 128, MT = 16512, DM = 1024, DIN = 4104, PQW = 2560;
constexpr float EPS = 1e-6f;
constexpr size_t LDS_BYTES = 139264;

constexpr size_t O_YP = 0, O_YS = 16777216, O_HGP = 16908288, O_GDP = 17432576, O_CVP = 17956864,
                 O_HGS = 17993728, O_GDS = 26382336, O_CVS = 34770944;
constexpr size_t W_WINT = 0;
constexpr size_t W_WOUTT = W_WINT + 8388608;
constexpr size_t W_BETA = W_WOUTT + 2097152;
constexpr size_t W_GDEC = W_BETA + 264192;
constexpr size_t W_DVEC = W_GDEC + 264192;
constexpr size_t W_DSC = W_DVEC + 524288;
constexpr size_t W_PQ = W_DSC + 4096;
constexpr size_t W_GATES = W_PQ + 84541440;
constexpr size_t W_H = W_GATES + 33816576;
constexpr size_t W_QS = W_H + 33816576;
constexpr size_t W_MNEG = W_QS + 33554432;
constexpr size_t W_LF = W_MNEG + 33554432;
constexpr size_t W_END = W_LF + 33816576;

struct Params {
  const float *x_prompt, *x_sample, *state_hgrn, *state_gdn, *state_conv, *norm_w, *w_in, *lb_logits,
      *conv_w, *a_log, *dt_bias, *hg_norm, *gdn_norm, *w_out, *final_norm;
  float* out;
  char* ws;
};

__device__ __forceinline__ int opaque_tid() { int t = threadIdx.x; asm volatile("" : "+v"(t)); return t; }
__device__ __forceinline__ u16 f2bf(float x) {
  unsigned u = __float_as_uint(x);
  u += 0x7fffu + ((u >> 16) & 1u);
  return (u16)(u >> 16);
}
__device__ __forceinline__ float bf2f(u16 h) { return __uint_as_float(((unsigned)h) << 16); }
__device__ __forceinline__ unsigned pack2(float a, float b) { return (unsigned)f2bf(a) | ((unsigned)f2bf(b) << 16); }
__device__ __forceinline__ float wave_sum(float v) {
#pragma unroll
  for (int o = 32; o > 0; o >>= 1) v += __shfl_xor(v, o, 64);
  return v;
}
__device__ __forceinline__ float sigmoidf_(float x) { return 1.f / (1.f + __expf(-x)); }
__device__ __forceinline__ float siluf_(float x) { return x / (1.f + __expf(-x)); }
__device__ __forceinline__ f32x4 mfma16(bf16x8 a, bf16x8 b, f32x4 c) {
  return __builtin_amdgcn_mfma_f32_16x16x32_bf16(a, b, c, 0, 0, 0);
}
__device__ __forceinline__ bf16x8 frag(const u16* base, int row0, int stride, int koff, int lane) {
  return *(const bf16x8*)(base + (row0 + (lane & 15)) * stride + koff + (lane >> 4) * 8);
}

__device__ void phase0(const Params& p, char* smem, int bid, int nb) {
  const int tid = opaque_tid(), lane = tid & 63, w = tid >> 6;
  u16* WinT = (u16*)(p.ws + W_WINT);
  u16* WoutT = (u16*)(p.ws + W_WOUTT);
  u16* H = (u16*)(p.ws + W_H);
  float* BETA = (float*)(p.ws + W_BETA);
  float* GDEC = (float*)(p.ws + W_GDEC);
  float* tl = (float*)smem;
  for (int t = bid; t < 1280; t += nb) {
    const float* src; int sstride; u16* dst; int kt, nt;
    if (t < 1024) { src = p.w_in; sstride = DIN; dst = WinT; kt = t >> 6; nt = t & 63; }
    else { int u = t - 1024; src = p.w_out; sstride = 1024; dst = WoutT; kt = u >> 4; nt = u & 15; }
#pragma unroll
    for (int i = 0; i < 8; ++i) {
      int idx = tid + 512 * i; int kk = idx >> 6, nn = idx & 63;
      tl[kk * 65 + nn] = src[(size_t)(kt * 64 + kk) * sstride + nt * 64 + nn];
    }
    __syncthreads();
    {
      int nn = tid >> 3, k8 = (tid & 7) * 8;
      unsigned pk[4];
#pragma unroll
      for (int e = 0; e < 4; ++e) pk[e] = pack2(tl[(k8 + 2 * e) * 65 + nn], tl[(k8 + 2 * e + 1) * 65 + nn]);
      *(uint4*)(dst + (size_t)(nt * 64 + nn) * 1024 + kt * 64 + k8) = make_uint4(pk[0], pk[1], pk[2], pk[3]);
    }
    __syncthreads();
  }
  float* W8s = (float*)smem;
  for (int idx = tid; idx < 8192; idx += 512) {
    int j = idx & 7, k = idx >> 3;
    W8s[j * 1024 + k] = p.w_in[(size_t)k * DIN + 4096 + j];
  }
  __syncthreads();
  for (int g = bid; g < MT / 8; g += nb) {
    int row = g * 8 + w;
    const float* x = row < MP ? p.x_prompt + (size_t)row * 1024 : p.x_sample + (size_t)(row - MP) * 1024;
    float4 xv[4];
    float ss = 0.f;
#pragma unroll
    for (int i = 0; i < 4; ++i) {
      xv[i] = *(const float4*)(x + i * 256 + lane * 4);
      ss += xv[i].x * xv[i].x + xv[i].y * xv[i].y + xv[i].z * xv[i].z + xv[i].w * xv[i].w;
    }
    ss = wave_sum(ss);
    float rstd = rsqrtf(ss * (1.f / 1024.f) + EPS);
    float d0 = 0, d1 = 0, d2 = 0, d3 = 0, d4 = 0, d5 = 0, d6 = 0, d7 = 0;
#pragma unroll
    for (int i = 0; i < 4; ++i) {
      float4 nw = *(const float4*)(p.norm_w + i * 256 + lane * 4);
      float4 hv;
      hv.x = xv[i].x * rstd * nw.x; hv.y = xv[i].y * rstd * nw.y; hv.z = xv[i].z * rstd * nw.z; hv.w = xv[i].w * rstd * nw.w;
      *(uint2*)(H + (size_t)row * 1024 + i * 256 + lane * 4) = make_uint2(pack2(hv.x, hv.y), pack2(hv.z, hv.w));
#define GDOT(j, dj) { float4 wv = *(const float4*)(W8s + j * 1024 + i * 256 + lane * 4); dj += hv.x * wv.x + hv.y * wv.y + hv.z * wv.z + hv.w * wv.w; }
      GDOT(0, d0) GDOT(1, d1) GDOT(2, d2) GDOT(3, d3) GDOT(4, d4) GDOT(5, d5) GDOT(6, d6) GDOT(7, d7)
#undef GDOT
    }
    d0 = wave_sum(d0); d1 = wave_sum(d1); d2 = wave_sum(d2); d3 = wave_sum(d3);
    d4 = wave_sum(d4); d5 = wave_sum(d5); d6 = wave_sum(d6); d7 = wave_sum(d7);
    if (lane < 4) {
      float gb = lane == 0 ? d0 : lane == 1 ? d1 : lane == 2 ? d2 : d3;
      float ga = lane == 0 ? d4 : lane == 1 ? d5 : lane == 2 ? d6 : d7;
      BETA[row * 4 + lane] = 1.f / (1.f + expf(-gb));
      float z = ga + p.dt_bias[lane];
      float sp = z > 20.f ? z : log1pf(expf(z));
      GDEC[row * 4 + lane] = -expf(p.a_log[lane]) * sp;
    }
  }
  __syncthreads();
}

__device__ __forceinline__ int lds_byte2(int r, int c) {
  int st = (r >> 4) * 2 + (c >> 5), ob = (r & 15) * 64 + (c & 31) * 2;
  return st * 1024 + (ob ^ (((ob >> 9) & 1) << 5));
}
__device__ __forceinline__ void stage_rc2(int b, int& R, int& C) {
  int st = b >> 10, sb = b & 1023, swz = sb ^ (((sb >> 9) & 1) << 5);
  R = (st >> 1) * 16 + swz / 64;
  C = (st & 1) * 32 + (swz % 64) / 2;
}
__device__ __forceinline__ void quad_transpose(float (&v)[4], int lane) {
  {
    const bool b = lane & 1;
    float s0 = b ? v[0] : v[1], s1 = b ? v[2] : v[3];
    float r0 = __shfl_xor(s0, 1, 64), r1 = __shfl_xor(s1, 1, 64);
    if (b) { v[0] = r0; v[2] = r1; } else { v[1] = r0; v[3] = r1; }
  }
  {
    const bool b = lane & 2;
    float s0 = b ? v[0] : v[2], s1 = b ? v[1] : v[3];
    float r0 = __shfl_xor(s0, 2, 64), r1 = __shfl_xor(s1, 2, 64);
    if (b) { v[0] = r0; v[1] = r1; } else { v[2] = r0; v[3] = r1; }
  }
}

template <int EPI>
__device__ __forceinline__ void epi_store4(const Params& p, int row, int col4, const float (&v)[4]) {
  if (EPI == 0) {
    u16* PQ = (u16*)(p.ws + W_PQ);
    u16* GATES = (u16*)(p.ws + W_GATES);
    float* LF = (float*)(p.ws + W_LF);
    const int sec = col4 >> 9;
    if (sec == 0) {
      *(uint2*)(PQ + (size_t)row * PQW + col4) = make_uint2(pack2(v[0], v[1]), pack2(v[2], v[3]));
    } else if (sec == 1) {
      const int cc = col4 - 512;
      const f32x4 l0 = *(const f32x4*)(p.lb_logits + cc), l1 = *(const f32x4*)(p.lb_logits + 512 + cc);
      f32x4 o;
#pragma unroll
      for (int i = 0; i < 4; ++i) {
        const float lbv = 1.f / (1.f + __expf(l1[i] - l0[i]));
        o[i] = __logf(lbv + (1.f - lbv) / (1.f + __expf(-v[i])));
      }
      *(f32x4*)(LF + (size_t)row * 512 + cc) = o;
    } else if (sec == 2) {
      *(uint2*)(PQ + (size_t)row * PQW + 512 + (col4 - 1024)) = make_uint2(pack2(v[0], v[1]), pack2(v[2], v[3]));
    } else if (sec == 3 || sec == 7) {
      const int cc = sec == 3 ? col4 - 1536 : 512 + col4 - 3584;
      *(uint2*)(GATES + (size_t)row * 1024 + cc) =
          make_uint2(pack2(v[0] / (1.f + __expf(-v[0])), v[1] / (1.f + __expf(-v[1]))),
                     pack2(v[2] / (1.f + __expf(-v[2])), v[3] / (1.f + __expf(-v[3]))));
    } else {
      const int cc = col4 - 2048;
      *(uint2*)(PQ + (size_t)row * PQW + 1024 + cc) = make_uint2(pack2(v[0], v[1]), pack2(v[2], v[3]));
      if (row < MP) {
        const int tt = row & 2047;
        if (tt >= 2045) *(f32x4*)(p.out + O_CVP + (size_t)((row >> 11) * 3 + (tt - 2045)) * 1536 + cc) = f32x4{v[0], v[1], v[2], v[3]};
      } else {
        *(f32x4*)(p.out + O_CVS + (size_t)((row - MP) * 3 + 2) * 1536 + cc) = f32x4{v[0], v[1], v[2], v[3]};
      }
    }
  } else {
    const float* xr = row < MP ? p.x_prompt + (size_t)row * 1024 : p.x_sample + (size_t)(row - MP) * 1024;
    float* yr = row < MP ? p.out + O_YP + (size_t)row * 1024 : p.out + O_YS + (size_t)(row - MP) * 1024;
    const f32x4 xv = *(const f32x4*)(xr + col4);
    *(f32x4*)(yr + col4) = f32x4{xv[0] + v[0], xv[1] + v[1], xv[2] + v[2], xv[3] + v[3]};
  }
}

template <int EPI>
__device__ void gemm_phase(const Params& p, const u16* __restrict__ A, const u16* __restrict__ Bt, int ntn,
                           char* smem, int bid, int nb) {
  const int tid = opaque_tid(), lane = tid & 63, wid = tid >> 6;
  const int wr = wid >> 2, wc = wid & 3, fr = lane & 15, fq = lane >> 4;
  constexpr int TILE_B = 256 * 64 * 2, STAGE_B = 2 * TILE_B;
  int sR0, sC0;
  stage_rc2(wid * 1024 + lane * 16, sR0, sC0);
  const unsigned goff = (unsigned)(sR0 * 1024 + sC0);
  const unsigned lbase = (unsigned)(size_t)smem + (unsigned)(wid * 1024);
  const int aoff = (wr * 16) * 1024 + ((fr * 64 + fq * 16) ^ ((((fr * 64 + fq * 16) >> 9) & 1) << 5));
  const int boff = TILE_B + (wc * 8) * 1024 + ((fr * 64 + fq * 16) ^ ((((fr * 64 + fq * 16) >> 9) & 1) << 5));
  const int ntiles = 64 * ntn;
  for (int tile = bid; tile < ntiles; tile += nb) {
    int tm, tn;
    {
      const int rnd = tile >> 8, t = tile & 255, xcd = t & 7, j = t >> 3;
      if (ntn == 16) { tm = rnd * 16 + (xcd >> 1) * 4 + (j & 3); tn = (xcd & 1) * 8 + (j >> 2); }
      else { tm = xcd * 8 + (j & 7); tn = j >> 3; }
    }
    const u16* Ab = A + (size_t)tm * 256 * 1024;
    const u16* Bb = Bt + (size_t)tn * 256 * 1024;
    f32x4 acc[8][4];
#pragma unroll
    for (int m = 0; m < 8; ++m)
#pragma unroll
      for (int n = 0; n < 4; ++n) acc[m][n] = f32x4{0.f, 0.f, 0.f, 0.f};
#define G_STAGE(buf, kt) { _Pragma("unroll") for (int i = 0; i < 4; ++i) { \
      __builtin_amdgcn_global_load_lds((const unsigned*)(Ab + (goff + (unsigned)(i * 65536 + (kt) * 64))), \
          (__attribute__((address_space(3))) unsigned*)(lbase + (buf) * STAGE_B + i * 8192), 16, 0, 0); \
      __builtin_amdgcn_global_load_lds((const unsigned*)(Bb + (goff + (unsigned)(i * 65536 + (kt) * 64))), \
          (__attribute__((address_space(3))) unsigned*)(lbase + (buf) * STAGE_B + TILE_B + i * 8192), 16, 0, 0); } }
    G_STAGE(0, 0);
    asm volatile("s_waitcnt vmcnt(0)" ::: "memory");
    __syncthreads();
    for (int t = 0; t < 16; ++t) {
      const int cur = t & 1;
      if (t + 1 < 16) G_STAGE(cur ^ 1, t + 1);
      const char* sA = smem + cur * STAGE_B + aoff;
      const char* sB = smem + cur * STAGE_B + boff;
#pragma unroll
      for (int ks = 0; ks < 2; ++ks) {
        bf16x8 Bf[4];
#pragma unroll
        for (int n = 0; n < 4; ++n) Bf[n] = *(const bf16x8*)(sB + (n * 2 + ks) * 1024);
#pragma unroll
        for (int mh = 0; mh < 2; ++mh) {
          bf16x8 At[4];
#pragma unroll
          for (int m = 0; m < 4; ++m) At[m] = *(const bf16x8*)(sA + ((mh * 4 + m) * 2 + ks) * 1024);
#pragma unroll
          for (int m = 0; m < 4; ++m)
#pragma unroll
            for (int n = 0; n < 4; ++n) acc[mh * 4 + m][n] = mfma16(At[m], Bf[n], acc[mh * 4 + m][n]);
        }
        __builtin_amdgcn_sched_barrier(0);
      }
      asm volatile("s_waitcnt vmcnt(0)" ::: "memory");
      __syncthreads();
    }
#undef G_STAGE
    {
      int t2 = threadIdx.x;
      asm volatile("" : "+v"(t2));
      const int lane2 = t2 & 63, wid2 = t2 >> 6;
      const int rbase = tm * 256 + (wid2 >> 2) * 128 + (lane2 >> 4) * 4 + (lane2 & 3);
      const int cbase = tn * 256 + (wid2 & 3) * 64 + (lane2 & 12);
#pragma unroll
      for (int m = 0; m < 8; ++m)
#pragma unroll
        for (int n = 0; n < 4; ++n) {
          float v[4] = {acc[m][n][0], acc[m][n][1], acc[m][n][2], acc[m][n][3]};
          quad_transpose(v, lane2);
          epi_store4<EPI>(p, rbase + m * 16, cbase + n * 16, v);
        }
    }
  }
  const int nunits = ntn * 16;
  int t3 = threadIdx.x;
  asm volatile("" : "+v"(t3));
  for (int u = bid; u < nunits; u += nb) {
    const int lane = t3 & 63, wid = t3 >> 6, fr = lane & 15, fq = lane >> 4;
    const u16* ar = A + (size_t)(MP + wid * 16 + fr) * 1024 + fq * 8;
    const u16* br = Bt + (size_t)(u * 16 + fr) * 1024 + fq * 8;
    f32x4 acc0 = {0.f, 0.f, 0.f, 0.f}, acc1 = {0.f, 0.f, 0.f, 0.f};
#pragma unroll 4
    for (int ks = 0; ks < 32; ks += 2) {
      const bf16x8 a0 = *(const bf16x8*)(ar + ks * 32), b0 = *(const bf16x8*)(br + ks * 32);
      const bf16x8 a1 = *(const bf16x8*)(ar + ks * 32 + 32), b1 = *(const bf16x8*)(br + ks * 32 + 32);
      acc0 = mfma16(a0, b0, acc0);
      acc1 = mfma16(a1, b1, acc1);
    }
    float v[4] = {acc0[0] + acc1[0], acc0[1] + acc1[1], acc0[2] + acc1[2], acc0[3] + acc1[3]};
    quad_transpose(v, lane);
    epi_store4<EPI>(p, MP + wid * 16 + fq * 4 + (lane & 3), u * 16 + (fr & ~3), v);
  }
  __syncthreads();
}

__device__ void hgrn_item(const Params& p, char* smem, int idx) {
  const int tid = opaque_tid(), lane = tid & 63, w = tid >> 6;
  const int lr = lane & 15, lq = lane >> 4;
  const int h = idx & 3, c = (idx >> 2) & 31, b = idx >> 7;
  const int r0 = b * 2048 + c * 64;
  const u16* PQ = (const u16*)(p.ws + W_PQ);
  const float* LF = (const float*)(p.ws + W_LF);
  u16* QS = (u16*)(p.ws + W_QS);
  u16* O0 = (u16*)(p.ws + W_H);
  u16* NB = (u16*)(p.out);
  float* DVEC = (float*)(p.ws + W_DVEC);
  u16* qt = (u16*)smem;
  u16* kt = qt + 64 * 136;
  u16* ktT = kt + 64 * 136;
  u16* vT = ktT + 128 * 72;
  u16* sc = vT + 128 * 72;
  float* ps = (float*)(sc + 64 * 72);
  const int col = tid & 127, part = tid >> 7;
  float lfv[16], bcum[16];
  {
    const float* lfp = LF + (size_t)(r0 + part * 16) * 512 + h * 128 + col;
#pragma unroll
    for (int i = 0; i < 16; ++i) lfv[i] = lfp[(size_t)i * 512];
    float run = 0.f;
#pragma unroll
    for (int i = 0; i < 16; ++i) { run += lfv[i]; bcum[i] = run; }
    ps[part * 128 + col] = run;
  }
  __syncthreads();
  {
    float off = 0.f, blast = 0.f;
#pragma unroll
    for (int pp = 0; pp < 4; ++pp) { float t = ps[pp * 128 + col]; blast += t; if (pp < part) off += t; }
    const u16* qp = PQ + (size_t)(r0 + part * 16) * PQW + h * 128 + col;
    u16* qsout = QS + ((size_t)idx * 64 + part * 16) * 128 + col;
#pragma unroll
    for (int i = 0; i < 16; ++i) {
      const float bb = bcum[i] + off;
      const int row = part * 16 + i;
      const float q = bf2f(qp[(size_t)i * PQW]);
      const u16 v = qp[(size_t)i * PQW + 512];
      qsout[i * 128] = f2bf(q * expf(bb));
      qt[row * 136 + col] = f2bf(q * expf(bb - blast));
      const float kk = (1.f - expf(lfv[i])) * expf(blast - bb);
      const u16 kbv = f2bf(kk);
      kt[row * 136 + col] = kbv;
      ktT[col * 72 + row] = kbv;
      vT[col * 72 + row] = v;
    }
    if (part == 0) DVEC[idx * 128 + col] = expf(blast);
  }
  __syncthreads();
  {
    const int tr = w >> 1;
    bf16x8 a[4];
#pragma unroll
    for (int ks = 0; ks < 4; ++ks) a[ks] = frag(qt, tr * 16, 136, ks * 32, lane);
#pragma unroll
    for (int tci = 0; tci < 2; ++tci) {
      const int tc = (w & 1) * 2 + tci;
      f32x4 acc = {0.f, 0.f, 0.f, 0.f};
#pragma unroll
      for (int ks = 0; ks < 4; ++ks) acc = mfma16(a[ks], frag(kt, tc * 16, 136, ks * 32, lane), acc);
#pragma unroll
      for (int j = 0; j < 4; ++j) {
        const int t = tr * 16 + lq * 4 + j, s = tc * 16 + lr;
        sc[t * 72 + s] = f2bf(t >= s ? acc[j] : 0.f);
      }
    }
  }
  __syncthreads();
  {
    const int tr = w >> 1;
    const bf16x8 a0 = frag(sc, tr * 16, 72, 0, lane), a1 = frag(sc, tr * 16, 72, 32, lane);
#pragma unroll
    for (int tci = 0; tci < 4; ++tci) {
      const int tc = (w & 1) * 4 + tci;
      f32x4 acc = {0.f, 0.f, 0.f, 0.f};
      acc = mfma16(a0, frag(vT, tc * 16, 72, 0, lane), acc);
      acc = mfma16(a1, frag(vT, tc * 16, 72, 32, lane), acc);
#pragma unroll
      for (int j = 0; j < 4; ++j) {
        const int t = tr * 16 + lq * 4 + j, n = tc * 16 + lr;
        O0[((size_t)idx * 64 + t) * 128 + n] = f2bf(acc[j]);
      }
    }
  }
  {
    const int tr = w;
    const bf16x8 a0 = frag(ktT, tr * 16, 72, 0, lane), a1 = frag(ktT, tr * 16, 72, 32, lane);
#pragma unroll
    for (int tc = 0; tc < 8; ++tc) {
      f32x4 acc = {0.f, 0.f, 0.f, 0.f};
      acc = mfma16(a0, frag(vT, tc * 16, 72, 0, lane), acc);
      acc = mfma16(a1, frag(vT, tc * 16, 72, 32, lane), acc);
#pragma unroll
      for (int j = 0; j < 4; ++j) {
        const int kd = tr * 16 + lq * 4 + j, n = tc * 16 + lr;
        NB[((size_t)idx * 128 + kd) * 128 + n] = f2bf(acc[j]);
      }
    }
  }
  __syncthreads();
}

template <int J>
struct SolveCol {
  static __device__ __forceinline__ void run(f32x4 (&x)[16], const float* AT) {
    if constexpr (J < 63) {
      const float xj = x[J / 4][J % 4];
#pragma unroll
      for (int B = (J + 1) / 4; B < 16; ++B) {
        const f32x4 av = *(const f32x4*)(AT + J * 64 + B * 4);
        x[B] -= av * xj;
        if ((B & 7) == 7) __builtin_amdgcn_sched_barrier(0);
      }
      __builtin_amdgcn_sched_barrier(0);
      SolveCol<J + 1>::run(x, AT);
    }
  }
};

__device__ void gdn_item(const Params& p, char* smem, int idx) {
  const int tid = opaque_tid(), lane = tid & 63, w = tid >> 6;
  const int lr = lane & 15, lq = lane >> 4;
  const int h = idx & 3, c = (idx >> 2) & 31, b = idx >> 7;
  const int r0 = b * 2048 + c * 64;
  const u16* PQ = (const u16*)(p.ws + W_PQ);
  const float* BETA = (const float*)(p.ws + W_BETA);
  const float* GDEC = (const float*)(p.ws + W_GDEC);
  u16* QS = (u16*)(p.ws + W_QS);
  u16* O0 = (u16*)(p.ws + W_H);
  u16* NB = (u16*)(p.out);
  u16* MNEG = (u16*)(p.ws + W_MNEG);
  float* DSC = (float*)(p.ws + W_DSC);
  u16* kb = (u16*)smem;
  u16* qb = kb + 64 * 136;
  u16* vS = qb + 64 * 136;
  float* Asol = (float*)(vS + 64 * 128);
  u16* attn = (u16*)(Asol + 64 * 64);
  u16* khT = attn + 64 * 72;
  u16* WT = khT + 128 * 72;
  u16* U0T = WT + 128 * 72;
  float* gc = (float*)(U0T + 128 * 72);
  float* bet = gc + 64;

  if (w == 0) {
    float g = GDEC[(size_t)(r0 + lane) * 4 + h];
#pragma unroll
    for (int o = 1; o < 64; o <<= 1) { float t = __shfl_up(g, o, 64); if (lane >= o) g += t; }
    gc[lane] = g;
    bet[lane] = BETA[(size_t)(r0 + lane) * 4 + h];
  }
  {
    const int chq = 1024 + h * 128 + 2 * lane;
    const int cwq = h * 128 + 2 * lane;
    float cw[3][4][2];
#pragma unroll
    for (int ty = 0; ty < 3; ++ty)
#pragma unroll
      for (int j = 0; j < 4; ++j) {
        float2 t2 = *(const float2*)(p.conv_w + j * 1536 + ty * 512 + cwq);
        cw[ty][j][0] = t2.x; cw[ty][j][1] = t2.y;
      }
    float win[3][3][2];
    const int t0 = w * 8;
#pragma unroll
    for (int a = 0; a < 3; ++a) {
      const int rr = t0 - 3 + a;
      const bool valid = (c > 0) || (rr >= 0);
#pragma unroll
      for (int ty = 0; ty < 3; ++ty) {
        unsigned u = 0;
        if (valid) u = *(const unsigned*)(PQ + (ptrdiff_t)(r0 + rr) * PQW + chq + ty * 512);
        win[ty][a][0] = bf2f((u16)(u & 0xffff)); win[ty][a][1] = bf2f((u16)(u >> 16));
      }
    }
#pragma unroll
    for (int tt = 0; tt < 8; ++tt) {
      const int t = t0 + tt;
      float cv[3][2];
#pragma unroll
      for (int ty = 0; ty < 3; ++ty) {
        unsigned u = *(const unsigned*)(PQ + (size_t)(r0 + t) * PQW + chq + ty * 512);
        float c0 = bf2f((u16)(u & 0xffff)), c1 = bf2f((u16)(u >> 16));
        float s0 = cw[ty][0][0] * win[ty][0][0] + cw[ty][1][0] * win[ty][1][0] + cw[ty][2][0] * win[ty][2][0] + cw[ty][3][0] * c0;
        float s1 = cw[ty][0][1] * win[ty][0][1] + cw[ty][1][1] * win[ty][1][1] + cw[ty][2][1] * win[ty][2][1] + cw[ty][3][1] * c1;
        win[ty][0][0] = win[ty][1][0]; win[ty][0][1] = win[ty][1][1];
        win[ty][1][0] = win[ty][2][0]; win[ty][1][1] = win[ty][2][1];
        win[ty][2][0] = c0; win[ty][2][1] = c1;
        cv[ty][0] = siluf_(s0); cv[ty][1] = siluf_(s1);
      }
      float ssq = wave_sum(cv[0][0] * cv[0][0] + cv[0][1] * cv[0][1]);
      float ssk = wave_sum(cv[1][0] * cv[1][0] + cv[1][1] * cv[1][1]);
      const float rq = rsqrtf(ssq + EPS) * 0.08838834764831845f;
      const float rk = rsqrtf(ssk + EPS);
      *(unsigned*)(qb + t * 136 + 2 * lane) = pack2(cv[0][0] * rq, cv[0][1] * rq);
      *(unsigned*)(kb + t * 136 + 2 * lane) = pack2(cv[1][0] * rk, cv[1][1] * rk);
      *(unsigned*)(vS + t * 128 + 2 * lane) = pack2(cv[2][0], cv[2][1]);
    }
  }
  __syncthreads();
  {
    const int which = w >> 2, tr = w & 3;
    const u16* Asrc = which ? qb : kb;
    bf16x8 a[4];
#pragma unroll
    for (int ks = 0; ks < 4; ++ks) a[ks] = frag(Asrc, tr * 16, 136, ks * 32, lane);
#pragma unroll
    for (int tc = 0; tc < 4; ++tc) {
      f32x4 acc = {0.f, 0.f, 0.f, 0.f};
#pragma unroll
      for (int ks = 0; ks < 4; ++ks) acc = mfma16(a[ks], frag(kb, tc * 16, 136, ks * 32, lane), acc);
#pragma unroll
      for (int j = 0; j < 4; ++j) {
        const int t = tr * 16 + lq * 4 + j, s = tc * 16 + lr;
        const float L = expf(fminf(gc[t] - gc[s], 0.f));
        if (which == 0) Asol[s * 64 + t] = (t > s) ? bet[t] * acc[j] * L : 0.f;
        else attn[t * 72 + s] = f2bf((t >= s) ? acc[j] * L : 0.f);
      }
    }
  }
  __syncthreads();
  if (tid < 256) {
    f32x4 x[16];
    if (tid < 128) {
#pragma unroll
      for (int s = 0; s < 64; ++s) { x[s >> 2][s & 3] = bf2f(vS[s * 128 + tid]) * bet[s]; if ((s & 7) == 7) __builtin_amdgcn_sched_barrier(0); }
    } else {
#pragma unroll
      for (int s = 0; s < 64; ++s) { x[s >> 2][s & 3] = bf2f(kb[s * 136 + tid - 128]) * bet[s] * expf(gc[s]); if ((s & 7) == 7) __builtin_amdgcn_sched_barrier(0); }
    }
    SolveCol<0>::run(x, Asol);
    u16* dst = (tid < 128) ? (U0T + tid * 72) : (WT + (tid - 128) * 72);
#pragma unroll
    for (int s8 = 0; s8 < 8; ++s8) {
      *(u32x4*)(dst + s8 * 8) = u32x4{pack2(x[2 * s8][0], x[2 * s8][1]), pack2(x[2 * s8][2], x[2 * s8][3]),
                                      pack2(x[2 * s8 + 1][0], x[2 * s8 + 1][1]), pack2(x[2 * s8 + 1][2], x[2 * s8 + 1][3])};
    }
  } else {
    const float glast = gc[63];
    const int e0 = tid - 256;
#pragma unroll 4
    for (int i = 0; i < 32; ++i) {
      const int e = e0 + 256 * i;
      const int s = e & 63, kd = e >> 6;
      khT[kd * 72 + s] = f2bf(bf2f(kb[s * 136 + kd]) * expf(glast - gc[s]));
    }
  }
  __syncthreads();
  {
    const int tr = w & 3, half = w >> 2;
    const u16* Bsrc = half ? U0T : WT;
    const bf16x8 a0 = frag(attn, tr * 16, 72, 0, lane), a1 = frag(attn, tr * 16, 72, 32, lane);
#pragma unroll 2
    for (int tc = 0; tc < 8; ++tc) {
      f32x4 acc = {0.f, 0.f, 0.f, 0.f};
      acc = mfma16(a0, frag(Bsrc, tc * 16, 72, 0, lane), acc);
      acc = mfma16(a1, frag(Bsrc, tc * 16, 72, 32, lane), acc);
#pragma unroll
      for (int j = 0; j < 4; ++j) {
        const int t = tr * 16 + lq * 4 + j, n = tc * 16 + lr;
        const size_t o = ((size_t)(1024 + idx) * 64 + t) * 128 + n;
        if (half == 0) QS[o] = f2bf(bf2f(qb[t * 136 + n]) * expf(gc[t]) - acc[j]);
        else O0[o] = f2bf(acc[j]);
      }
    }
  }
  {
    const int tr = w;
    const bf16x8 a0 = frag(khT, tr * 16, 72, 0, lane), a1 = frag(khT, tr * 16, 72, 32, lane);
#pragma unroll 2
    for (int tc = 0; tc < 16; ++tc) {
      const u16* Bsrc = tc < 8 ? WT : U0T;
      const int tcc = tc & 7;
      f32x4 acc = {0.f, 0.f, 0.f, 0.f};
      acc = mfma16(a0, frag(Bsrc, tcc * 16, 72, 0, lane), acc);
      acc = mfma16(a1, frag(Bsrc, tcc * 16, 72, 32, lane), acc);
#pragma unroll
      for (int j = 0; j < 4; ++j) {
        const int kd = tr * 16 + lq * 4 + j, n = tcc * 16 + lr;
        if (tc < 8) MNEG[((size_t)idx * 128 + kd) * 128 + n] = f2bf(-acc[j]);
        else NB[((size_t)(1024 + idx) * 128 + kd) * 128 + n] = f2bf(acc[j]);
      }
    }
  }
  if (tid == 0) DSC[idx] = expf(gc[63]);
  __syncthreads();
}

__device__ void phase2(const Params& p, char* smem, int bid, int nb) {
  for (int it = bid; it < 2048; it += nb) {
    if (it & 1) gdn_item(p, smem, it >> 1);
    else hgrn_item(p, smem, it >> 1);
  }
}

struct ScanRegs {
  bf16x8 Aq[4];
  bf16x8 Am[4];
  u16 o0[4];
  u16 nn[4];
  float dd[4];
};

__device__ __forceinline__ void scan_load(ScanRegs& r, const Params& p, int type, int idx, int vs, int w, int lr, int lq) {
  const u16* QS = (const u16*)(p.ws + W_QS);
  const u16* O0 = (const u16*)(p.ws + W_H);
  const u16* NB = (const u16*)(p.out);
  const u16* MNEG = (const u16*)(p.ws + W_MNEG);
  const float* DVEC = (const float*)(p.ws + W_DVEC);
  const float* DSC = (const float*)(p.ws + W_DSC);
  const size_t ti = (size_t)type * 1024 + idx;
  if (w < 4) {
    const u16* qrow = QS + (ti * 64 + w * 16 + lr) * 128 + lq * 8;
#pragma unroll
    for (int ks = 0; ks < 4; ++ks) r.Aq[ks] = *(const bf16x8*)(qrow + ks * 32);
#pragma unroll
    for (int j = 0; j < 4; ++j) r.o0[j] = O0[(ti * 64 + w * 16 + lq * 4 + j) * 128 + vs * 16 + lr];
  }
#pragma unroll
  for (int j = 0; j < 4; ++j) r.nn[j] = NB[(ti * 128 + w * 16 + lq * 4 + j) * 128 + vs * 16 + lr];
  if (type == 1) {
    const u16* mrow = MNEG + ((size_t)idx * 128 + w * 16 + lr) * 128 + lq * 8;
#pragma unroll
    for (int ks = 0; ks < 4; ++ks) r.Am[ks] = *(const bf16x8*)(mrow + ks * 32);
    const float d = DSC[idx];
#pragma unroll
    for (int j = 0; j < 4; ++j) r.dd[j] = d;
  } else {
#pragma unroll
    for (int j = 0; j < 4; ++j) r.dd[j] = DVEC[idx * 128 + w * 16 + lq * 4 + j];
  }
}

__device__ void scan_unit(const Params& p, char* smem, int u) {
  const int tid = opaque_tid(), lane = tid & 63, w = tid >> 6;
  const int lr = lane & 15, lq = lane >> 4;
  const int type = u >> 8, rem = u & 255;
  const int b = rem >> 5, h = (rem >> 3) & 3, vs = rem & 7;
  float* OPRE = (float*)(p.ws + W_PQ);
  u16* SbT = (u16*)smem;
  for (int i = tid; i < 2 * 16 * 136; i += 512) SbT[i] = 0;
  f32x4 S = {0.f, 0.f, 0.f, 0.f};
  ScanRegs cur, nxt;
  scan_load(cur, p, type, (b * 32 + 0) * 4 + h, vs, w, lr, lq);
  for (int c = 0; c < 32; ++c) {
    __syncthreads();
    const u16* Sb = SbT + (c & 1) * 16 * 136;
    bf16x8 Bf[4];
#pragma unroll
    for (int ks = 0; ks < 4; ++ks) Bf[ks] = *(const bf16x8*)(Sb + lr * 136 + ks * 32 + lq * 8);
    if (c + 1 < 32) scan_load(nxt, p, type, (b * 32 + c + 1) * 4 + h, vs, w, lr, lq);
    if (w < 4) {
      f32x4 acc;
#pragma unroll
      for (int j = 0; j < 4; ++j) acc[j] = bf2f(cur.o0[j]);
#pragma unroll
      for (int ks = 0; ks < 4; ++ks) acc = mfma16(cur.Aq[ks], Bf[ks], acc);
#pragma unroll
      for (int j = 0; j < 4; ++j) {
        const int row = b * 2048 + c * 64 + w * 16 + lq * 4 + j;
        OPRE[(size_t)row * 1024 + type * 512 + h * 128 + vs * 16 + lr] = acc[j];
      }
    }
    f32x4 Sn;
#pragma unroll
    for (int j = 0; j < 4; ++j) Sn[j] = cur.dd[j] * S[j] + bf2f(cur.nn[j]);
    if (type == 1) {
#pragma unroll
      for (int ks = 0; ks < 4; ++ks) Sn = mfma16(cur.Am[ks], Bf[ks], Sn);
    }
    S = Sn;
    u16* Sw = SbT + ((c + 1) & 1) * 16 * 136;
    *(uint2*)(Sw + lr * 136 + w * 16 + lq * 4) = make_uint2(pack2(S[0], S[1]), pack2(S[2], S[3]));
    cur = nxt;
  }
  float* so = p.out + (type ? O_GDP : O_HGP) + (size_t)(b * 4 + h) * 16384;
#pragma unroll
  for (int j = 0; j < 4; ++j) so[(w * 16 + lq * 4 + j) * 128 + vs * 16 + lr] = S[j];
  __syncthreads();
}

__device__ void sample_item(const Params& p, char* smem, int it) {
  const int tid = opaque_tid(), lane = tid & 63, w = tid >> 6;
  const int type = it >> 9, b = (it >> 2) & 127, h = it & 3;
  const int row = MP + b;
  const u16* PQ = (const u16*)(p.ws + W_PQ);
  const float* LF = (const float*)(p.ws + W_LF);
  const float* BETA = (const float*)(p.ws + W_BETA);
  const float* GDEC = (const float*)(p.ws + W_GDEC);
  float* OPRE = (float*)(p.ws + W_PQ);
  float* fq = (float*)smem;
  float* fk = fq + 128;
  float* fv = fk + 128;
  float* fe = fv + 128;
  float* red = fe + 128;
  float* sc = red + 1024;
  const int n = tid & 127, kp = tid >> 7;
  if (type == 0) {
    if (tid < 128) {
      const float lf = LF[(size_t)row * 512 + h * 128 + tid];
      const float f = expf(lf);
      fe[tid] = f;
      fk[tid] = 1.f - f;
      fq[tid] = bf2f(PQ[(size_t)row * PQW + h * 128 + tid]);
      fv[tid] = bf2f(PQ[(size_t)row * PQW + 512 + h * 128 + tid]);
    }
    __syncthreads();
    const float* S = p.state_hgrn + ((size_t)(b * 4 + h) * 128) * 128;
    float* So = p.out + O_HGS + ((size_t)(b * 4 + h) * 128) * 128;
    const float vn = fv[n];
    float o = 0.f;
#pragma unroll 8
    for (int i = 0; i < 32; ++i) {
      const int k = kp * 32 + i;
      const float sn = fe[k] * S[k * 128 + n] + fk[k] * vn;
      So[k * 128 + n] = sn;
      o += fq[k] * sn;
    }
    red[kp * 128 + n] = o;
    __syncthreads();
    if (tid < 128) OPRE[(size_t)row * 1024 + h * 128 + tid] = red[tid] + red[128 + tid] + red[256 + tid] + red[384 + tid];
    __syncthreads();
  } else {
    const float* cprev = p.state_conv + (size_t)b * 3 * 1536;
    if (tid < 384) {
      const int ty = tid >> 7, cc = tid & 127;
      const int ch = ty * 512 + h * 128 + cc;
      const float p0 = cprev[ch], p1 = cprev[1536 + ch], p2 = cprev[3072 + ch];
      const float nw = bf2f(PQ[(size_t)row * PQW + 1024 + ch]);
      const float s = p.conv_w[ch] * p0 + p.conv_w[1536 + ch] * p1 + p.conv_w[3072 + ch] * p2 + p.conv_w[4608 + ch] * nw;
      fq[ty * 128 + cc] = siluf_(s);
      p.out[O_CVS + (size_t)(b * 3 + 0) * 1536 + ch] = p1;
      p.out[O_CVS + (size_t)(b * 3 + 1) * 1536 + ch] = p2;
    }
    __syncthreads();
    if (w < 2) {
      const float a0 = fq[w * 128 + lane], a1 = fq[w * 128 + 64 + lane];
      const float ss = wave_sum(a0 * a0 + a1 * a1);
      if (lane == 0) sc[w] = ss;
    }
    __syncthreads();
    const float rq = rsqrtf(sc[0] + EPS) * 0.08838834764831845f;
    const float rk = rsqrtf(sc[1] + EPS);
    __syncthreads();
    if (tid < 128) fq[tid] *= rq;
    else if (tid < 256) fk[tid - 128] *= rk;
    __syncthreads();
    if (w == 0) {
      const float qk = wave_sum(fq[lane] * fk[lane] + fq[64 + lane] * fk[64 + lane]);
      if (lane == 0) sc[2] = qk;
    }
    const float eg = expf(GDEC[(size_t)row * 4 + h]);
    const float beta = BETA[(size_t)row * 4 + h];
    const float* S = p.state_gdn + ((size_t)(b * 4 + h) * 128) * 128;
    float* So = p.out + O_GDS + ((size_t)(b * 4 + h) * 128) * 128;
    float sd[32];
    float ks_ = 0.f, qs_ = 0.f;
#pragma unroll
    for (int i = 0; i < 32; ++i) {
      const int k = kp * 32 + i;
      sd[i] = eg * S[k * 128 + n];
      ks_ += fk[k] * sd[i];
      qs_ += fq[k] * sd[i];
    }
    red[kp * 128 + n] = ks_;
    red[512 + kp * 128 + n] = qs_;
    __syncthreads();
    const float kS = red[n] + red[128 + n] + red[256 + n] + red[384 + n];
    const float delta = (fv[n] - kS) * beta;
#pragma unroll
    for (int i = 0; i < 32; ++i) {
      const int k = kp * 32 + i;
      So[k * 128 + n] = sd[i] + fk[k] * delta;
    }
    if (tid < 128) {
      const float qS = red[512 + n] + red[640 + n] + red[768 + n] + red[896 + n];
      OPRE[(size_t)row * 1024 + 512 + h * 128 + n] = qS + sc[2] * delta;
    }
    __syncthreads();
  }
}

__device__ void phase3(const Params& p, char* smem, int bid, int nb) {
  for (int u = bid; u < 512; u += nb) scan_unit(p, smem, u);
  for (int it = bid; it < 1024; it += nb) sample_item(p, smem, it);
}

__device__ void phase4(const Params& p, int bid, int nb) {
  const int tid = opaque_tid(), lane = tid & 63, w = tid >> 6;
  const float* OPRE = (const float*)(p.ws + W_PQ);
  const u16* GATES = (const u16*)(p.ws + W_GATES);
  u16* A2 = (u16*)(p.ws + W_QS);
  for (int g = bid; g < MT / 8; g += nb) {
    const int row = g * 8 + w;
#pragma unroll
    for (int i = 0; i < 4; ++i) {
      const int col = i * 256 + lane * 4;
      const float4 v = *(const float4*)(OPRE + (size_t)row * 1024 + col);
      float ss = v.x * v.x + v.y * v.y + v.z * v.z + v.w * v.w;
#pragma unroll
      for (int o = 16; o > 0; o >>= 1) ss += __shfl_xor(ss, o, 64);
      const float rstd = rsqrtf(ss * (1.f / 128.f) + EPS);
      const int cn = col & 127;
      const float4 nw = *(const float4*)((col < 512 ? p.hg_norm : p.gdn_norm) + cn);
      const uint2 gt = *(const uint2*)(GATES + (size_t)row * 1024 + col);
      const float g0 = bf2f((u16)(gt.x & 0xffff)), g1 = bf2f((u16)(gt.x >> 16));
      const float g2 = bf2f((u16)(gt.y & 0xffff)), g3 = bf2f((u16)(gt.y >> 16));
      *(uint2*)(A2 + (size_t)row * 1024 + col) =
          make_uint2(pack2(v.x * rstd * nw.x * g0, v.y * rstd * nw.y * g1), pack2(v.z * rstd * nw.z * g2, v.w * rstd * nw.w * g3));
    }
  }
}

__device__ void phase6(const Params& p, int bid, int nb) {
  const int tid = opaque_tid(), lane = tid & 63, w = tid >> 6;
  for (int g = bid; g < MT / 8; g += nb) {
    const int row = g * 8 + w;
    float* y = row < MP ? p.out + O_YP + (size_t)row * 1024 : p.out + O_YS + (size_t)(row - MP) * 1024;
    float4 xv[4];
    float ss = 0.f;
#pragma unroll
    for (int i = 0; i < 4; ++i) {
      xv[i] = *(const float4*)(y + i * 256 + lane * 4);
      ss += xv[i].x * xv[i].x + xv[i].y * xv[i].y + xv[i].z * xv[i].z + xv[i].w * xv[i].w;
    }
    ss = wave_sum(ss);
    const float rstd = rsqrtf(ss * (1.f / 1024.f) + EPS);
#pragma unroll
    for (int i = 0; i < 4; ++i) {
      const float4 nw = *(const float4*)(p.final_norm + i * 256 + lane * 4);
      float4 o;
      o.x = xv[i].x * rstd * nw.x; o.y = xv[i].y * rstd * nw.y; o.z = xv[i].z * rstd * nw.z; o.w = xv[i].w * rstd * nw.w;
      *(float4*)(y + i * 256 + lane * 4) = o;
    }
  }
}

template <int PH>
__device__ __forceinline__ void run_phase(const Params& p, char* smem, int bid, int nb) {
  if (PH == 0) phase0(p, smem, bid, nb);
  else if (PH == 1) gemm_phase<0>(p, (const u16*)(p.ws + W_H), (const u16*)(p.ws + W_WINT), 16, smem, bid, nb);
  else if (PH == 2) phase2(p, smem, bid, nb);
  else if (PH == 3) phase3(p, smem, bid, nb);
  else if (PH == 4) phase4(p, bid, nb);
  else if (PH == 5) gemm_phase<1>(p, (const u16*)(p.ws + W_QS), (const u16*)(p.ws + W_WOUTT), 4, smem, bid, nb);
  else phase6(p, bid, nb);
}

#if MEGA
__global__ void __launch_bounds__(NTH) mega_kernel(Params p) {
  extern __shared__ __attribute__((aligned(16))) char smem[];
  cg::grid_group grid = cg::this_grid();
  const int bid = blockIdx.x, nb = gridDim.x;
#define RUNP(k) run_phase<k>(p, smem, bid, nb); grid.sync(); if (DUP_MASK & (1 << k)) { run_phase<k>(p, smem, bid, nb); grid.sync(); }
  RUNP(0) RUNP(1) RUNP(2) RUNP(3) RUNP(4) RUNP(5)
#undef RUNP
  run_phase<6>(p, smem, bid, nb);
}
#else
template <int PH>
__global__ void __launch_bounds__(NTH) phase_kernel(Params p) {
  extern __shared__ __attribute__((aligned(16))) char smem[];
  run_phase<PH>(p, smem, blockIdx.x, gridDim.x);
}
template <int PH>
static void launch_phase(const Params& p, int grid, hipStream_t stream) {
  hipFuncSetAttribute((const void*)phase_kernel<PH>, hipFuncAttributeMaxDynamicSharedMemorySize, (int)LDS_BYTES);
  hipLaunchKernelGGL(phase_kernel<PH>, dim3(grid), dim3(NTH), LDS_BYTES, stream, p);
}
#endif

extern "C" void kernel_launch(void* const* d_in, const int* in_sizes, int n_in, void* d_out, int out_size,
                              void* d_ws, size_t ws_size, hipStream_t stream) {
  Params p{};
  p.x_prompt = (const float*)d_in[0];
  p.x_sample = (const float*)d_in[1];
  p.state_hgrn = (const float*)d_in[2];
  p.state_gdn = (const float*)d_in[3];
  p.state_conv = (const float*)d_in[4];
  p.norm_w = (const float*)d_in[5];
  p.w_in = (const float*)d_in[6];
  p.lb_logits = (const float*)d_in[7];
  p.conv_w = (const float*)d_in[8];
  p.a_log = (const float*)d_in[9];
  p.dt_bias = (const float*)d_in[10];
  p.hg_norm = (const float*)d_in[11];
  p.gdn_norm = (const float*)d_in[12];
  p.w_out = (const float*)d_in[13];
  p.final_norm = (const float*)d_in[14];
  p.out = (float*)d_out;
  p.ws = (char*)d_ws;
  if (ws_size < W_END) { fprintf(stderr, "workspace too small: %zu < %zu\n", ws_size, (size_t)W_END); return; }
#if MEGA
  static int grid_blocks = 0;
  if (!grid_blocks) {
    int dev = 0, cus = 0, per_cu = 0;
    hipGetDevice(&dev);
    hipDeviceGetAttribute(&cus, hipDeviceAttributeMultiprocessorCount, dev);
    hipFuncSetAttribute((const void*)mega_kernel, hipFuncAttributeMaxDynamicSharedMemorySize, (int)LDS_BYTES);
    hipOccupancyMaxActiveBlocksPerMultiprocessor(&per_cu, mega_kernel, NTH, LDS_BYTES);
    if (per_cu < 1) per_cu = 1;
    grid_blocks = cus * per_cu;
  }
  void* args[] = {&p};
  hipError_t e = hipLaunchCooperativeKernel((void*)mega_kernel, dim3(grid_blocks), dim3(NTH), args, LDS_BYTES, stream);
  if (e != hipSuccess) fprintf(stderr, "cooperative launch failed: %s (grid %d)\n", hipGetErrorString(e), grid_blocks);
#else
  const int grid = 256;
  launch_phase<0>(p, grid, stream);
  launch_phase<1>(p, grid, stream);
  launch_phase<2>(p, grid, stream);
  launch_phase<3>(p, grid, stream);
  launch_phase<4>(p, grid, stream);
  launch_phase<5>(p, grid, stream);
  launch_phase<6>(p, grid, stream);
#endif
}
```

```cpp
#include <hip/hip_runtime.h>
#include <hip/hip_cooperative_groups.h>
#include <cstdio>
namespace cg = cooperative_groups;

#ifndef MEGA
#define MEGA 1
#define DUP_MASK 0
#endif

typedef unsigned short u16;
using bf16x8 = __attribute__((ext_vector_type(8))) short;
using f32x4 = __attribute__((ext_vector_type(4))) float;
using u32x4 = __attribute__((ext_vector_type(4))) unsigned;
using u32x2 = __attribute__((ext_vector_type(2))) unsigned;

#define NTH 512
constexpr int MP = 16384, MS = 128, MT = 16512, DM = 1024, DIN = 4104, PQW = 2560;
constexpr float EPS = 1e-6f;
constexpr size_t LDS_BYTES = 139264;

constexpr size_t O_YP = 0, O_YS = 16777216, O_HGP = 16908288, O_GDP = 17432576, O_CVP = 17956864,
                 O_HGS = 17993728, O_GDS = 26382336, O_CVS = 34770944;
constexpr size_t W_WINT = 0;
constexpr size_t W_WOUTT = W_WINT + 8388608;
constexpr size_t W_BETA = W_WOUTT + 2097152;
constexpr size_t W_GDEC = W_BETA + 264192;
constexpr size_t W_DVEC = W_GDEC + 264192;
constexpr size_t W_DSC = W_DVEC + 1048576;
constexpr size_t W_PQ = W_DSC + 4096;
constexpr size_t W_GATES = W_PQ + 84541440;
constexpr size_t W_H = W_GATES + 33816576;
constexpr size_t W_QS = W_H + 33816576;
constexpr size_t W_MNEG = W_QS + 33554432;
constexpr size_t W_LF = W_MNEG + 33554432;
constexpr size_t W_END = W_LF + 33816576;

struct Params {
  const float *x_prompt, *x_sample, *state_hgrn, *state_gdn, *state_conv, *norm_w, *w_in, *lb_logits,
      *conv_w, *a_log, *dt_bias, *hg_norm, *gdn_norm, *w_out, *final_norm;
  float* out;
  char* ws;
};

__device__ __forceinline__ int opaque_tid() { int t = threadIdx.x; asm volatile("" : "+v"(t)); return t; }
__device__ __forceinline__ u16 f2bf(float x) {
  unsigned u = __float_as_uint(x);
  u += 0x7fffu + ((u >> 16) & 1u);
  return (u16)(u >> 16);
}
__device__ __forceinline__ float bf2f(u16 h) { return __uint_as_float(((unsigned)h) << 16); }
__device__ __forceinline__ unsigned pack2(float a, float b) { return (unsigned)f2bf(a) | ((unsigned)f2bf(b) << 16); }
__device__ __forceinline__ float wave_sum(float v) {
#pragma unroll
  for (int o = 32; o > 0; o >>= 1) v += __shfl_xor(v, o, 64);
  return v;
}
__device__ __forceinline__ float sigmoidf_(float x) { return 1.f / (1.f + __expf(-x)); }
__device__ __forceinline__ float siluf_(float x) { return x / (1.f + __expf(-x)); }
__device__ __forceinline__ f32x4 mfma16(bf16x8 a, bf16x8 b, f32x4 c) {
  return __builtin_amdgcn_mfma_f32_16x16x32_bf16(a, b, c, 0, 0, 0);
}
__device__ __forceinline__ bf16x8 frag(const u16* base, int row0, int stride, int koff, int lane) {
  return *(const bf16x8*)(base + (row0 + (lane & 15)) * stride + koff + (lane >> 4) * 8);
}

__device__ void phase0(const Params& p, char* smem, int bid, int nb) {
  const int tid = opaque_tid(), lane = tid & 63, w = tid >> 6;
  u16* WinT = (u16*)(p.ws + W_WINT);
  u16* WoutT = (u16*)(p.ws + W_WOUTT);
  u16* H = (u16*)(p.ws + W_H);
  float* BETA = (float*)(p.ws + W_BETA);
  float* GDEC = (float*)(p.ws + W_GDEC);
  float* tl = (float*)smem;
  for (int t = bid; t < 1280; t += nb) {
    const float* src; int sstride; u16* dst; int kt, nt;
    if (t < 1024) { src = p.w_in; sstride = DIN; dst = WinT; kt = t >> 6; nt = t & 63; }
    else { int u = t - 1024; src = p.w_out; sstride = 1024; dst = WoutT; kt = u >> 4; nt = u & 15; }
#pragma unroll
    for (int i = 0; i < 8; ++i) {
      int idx = tid + 512 * i; int kk = idx >> 6, nn = idx & 63;
      tl[kk * 65 + nn] = src[(size_t)(kt * 64 + kk) * sstride + nt * 64 + nn];
    }
    __syncthreads();
    {
      int nn = tid >> 3, k8 = (tid & 7) * 8;
      unsigned pk[4];
#pragma unroll
      for (int e = 0; e < 4; ++e) pk[e] = pack2(tl[(k8 + 2 * e) * 65 + nn], tl[(k8 + 2 * e + 1) * 65 + nn]);
      *(uint4*)(dst + (size_t)(nt * 64 + nn) * 1024 + kt * 64 + k8) = make_uint4(pk[0], pk[1], pk[2], pk[3]);
    }
    __syncthreads();
  }
  float* W8s = (float*)smem;
  for (int idx = tid; idx < 8192; idx += 512) {
    int j = idx & 7, k = idx >> 3;
    W8s[j * 1024 + k] = p.w_in[(size_t)k * DIN + 4096 + j];
  }
  __syncthreads();
  for (int g = bid; g < MT / 8; g += nb) {
    int row = g * 8 + w;
    const float* x = row < MP ? p.x_prompt + (size_t)row * 1024 : p.x_sample + (size_t)(row - MP) * 1024;
    float4 xv[4];
    float ss = 0.f;
#pragma unroll
    for (int i = 0; i < 4; ++i) {
      xv[i] = *(const float4*)(x + i * 256 + lane * 4);
      ss += xv[i].x * xv[i].x + xv[i].y * xv[i].y + xv[i].z * xv[i].z + xv[i].w * xv[i].w;
    }
    ss = wave_sum(ss);
    float rstd = rsqrtf(ss * (1.f / 1024.f) + EPS);
    float d0 = 0, d1 = 0, d2 = 0, d3 = 0, d4 = 0, d5 = 0, d6 = 0, d7 = 0;
#pragma unroll
    for (int i = 0; i < 4; ++i) {
      float4 nw = *(const float4*)(p.norm_w + i * 256 + lane * 4);
      float4 hv;
      hv.x = xv[i].x * rstd * nw.x; hv.y = xv[i].y * rstd * nw.y; hv.z = xv[i].z * rstd * nw.z; hv.w = xv[i].w * rstd * nw.w;
      *(uint2*)(H + (size_t)row * 1024 + i * 256 + lane * 4) = make_uint2(pack2(hv.x, hv.y), pack2(hv.z, hv.w));
#define GDOT(j, dj) { float4 wv = *(const float4*)(W8s + j * 1024 + i * 256 + lane * 4); dj += hv.x * wv.x + hv.y * wv.y + hv.z * wv.z + hv.w * wv.w; }
      GDOT(0, d0) GDOT(1, d1) GDOT(2, d2) GDOT(3, d3) GDOT(4, d4) GDOT(5, d5) GDOT(6, d6) GDOT(7, d7)
#undef GDOT
    }
    d0 = wave_sum(d0); d1 = wave_sum(d1); d2 = wave_sum(d2); d3 = wave_sum(d3);
    d4 = wave_sum(d4); d5 = wave_sum(d5); d6 = wave_sum(d6); d7 = wave_sum(d7);
    if (lane < 4) {
      float gb = lane == 0 ? d0 : lane == 1 ? d1 : lane == 2 ? d2 : d3;
      float ga = lane == 0 ? d4 : lane == 1 ? d5 : lane == 2 ? d6 : d7;
      BETA[row * 4 + lane] = 1.f / (1.f + expf(-gb));
      float z = ga + p.dt_bias[lane];
      float sp = z > 20.f ? z : log1pf(expf(z));
      GDEC[row * 4 + lane] = -expf(p.a_log[lane]) * sp;
    }
  }
  __syncthreads();
}

__device__ __forceinline__ int lds_byte2(int r, int c) {
  int st = (r >> 4) * 2 + (c >> 5), ob = (r & 15) * 64 + (c & 31) * 2;
  return st * 1024 + (ob ^ (((ob >> 9) & 1) << 5));
}
__device__ __forceinline__ void stage_rc2(int b, int& R, int& C) {
  int st = b >> 10, sb = b & 1023, swz = sb ^ (((sb >> 9) & 1) << 5);
  R = (st >> 1) * 16 + swz / 64;
  C = (st & 1) * 32 + (swz % 64) / 2;
}
__device__ __forceinline__ void quad_transpose(float (&v)[4], int lane) {
  {
    const bool b = lane & 1;
    float s0 = b ? v[0] : v[1], s1 = b ? v[2] : v[3];
    float r0 = __shfl_xor(s0, 1, 64), r1 = __shfl_xor(s1, 1, 64);
    if (b) { v[0] = r0; v[2] = r1; } else { v[1] = r0; v[3] = r1; }
  }
  {
    const bool b = lane & 2;
    float s0 = b ? v[0] : v[2], s1 = b ? v[1] : v[3];
    float r0 = __shfl_xor(s0, 2, 64), r1 = __shfl_xor(s1, 2, 64);
    if (b) { v[0] = r0; v[1] = r1; } else { v[2] = r0; v[3] = r1; }
  }
}

template <int EPI>
__device__ __forceinline__ void epi_store4(const Params& p, int row, int col4, const float (&v)[4]) {
  if (EPI == 0) {
    u16* PQ = (u16*)(p.ws + W_PQ);
    u16* GATES = (u16*)(p.ws + W_GATES);
    float* LF = (float*)(p.ws + W_LF);
    const int sec = col4 >> 9;
    if (sec == 0) {
      *(uint2*)(PQ + (size_t)row * PQW + col4) = make_uint2(pack2(v[0], v[1]), pack2(v[2], v[3]));
    } else if (sec == 1) {
      const int cc = col4 - 512;
      const f32x4 l0 = *(const f32x4*)(p.lb_logits + cc), l1 = *(const f32x4*)(p.lb_logits + 512 + cc);
      f32x4 o;
#pragma unroll
      for (int i = 0; i < 4; ++i) {
        const float lbv = 1.f / (1.f + __expf(l1[i] - l0[i]));
        o[i] = __logf(lbv + (1.f - lbv) / (1.f + __expf(-v[i])));
      }
      *(f32x4*)(LF + (size_t)row * 512 + cc) = o;
    } else if (sec == 2) {
      *(uint2*)(PQ + (size_t)row * PQW + 512 + (col4 - 1024)) = make_uint2(pack2(v[0], v[1]), pack2(v[2], v[3]));
    } else if (sec == 3 || sec == 7) {
      const int cc = sec == 3 ? col4 - 1536 : 512 + col4 - 3584;
      *(uint2*)(GATES + (size_t)row * 1024 + cc) =
          make_uint2(pack2(v[0] / (1.f + __expf(-v[0])), v[1] / (1.f + __expf(-v[1]))),
                     pack2(v[2] / (1.f + __expf(-v[2])), v[3] / (1.f + __expf(-v[3]))));
    } else {
      const int cc = col4 - 2048;
      *(uint2*)(PQ + (size_t)row * PQW + 1024 + cc) = make_uint2(pack2(v[0], v[1]), pack2(v[2], v[3]));
      if (row < MP) {
        const int tt = row & 2047;
        if (tt >= 2045) *(f32x4*)(p.out + O_CVP + (size_t)((row >> 11) * 3 + (tt - 2045)) * 1536 + cc) = f32x4{v[0], v[1], v[2], v[3]};
      } else {
        *(f32x4*)(p.out + O_CVS + (size_t)((row - MP) * 3 + 2) * 1536 + cc) = f32x4{v[0], v[1], v[2], v[3]};
      }
    }
  } else {
    const float* xr = row < MP ? p.x_prompt + (size_t)row * 1024 : p.x_sample + (size_t)(row - MP) * 1024;
    float* yr = row < MP ? p.out + O_YP + (size_t)row * 1024 : p.out + O_YS + (size_t)(row - MP) * 1024;
    const f32x4 xv = *(const f32x4*)(xr + col4);
    *(f32x4*)(yr + col4) = f32x4{xv[0] + v[0], xv[1] + v[1], xv[2] + v[2], xv[3] + v[3]};
  }
}

template <int EPI>
__device__ void gemm_phase(const Params& p, const u16* __restrict__ A, const u16* __restrict__ Bt, int ntn,
                           char* smem, int bid, int nb) {
  const int tid = opaque_tid(), lane = tid & 63, wid = tid >> 6;
  const int wr = wid >> 2, wc = wid & 3, fr = lane & 15, fq = lane >> 4;
  constexpr int TILE_B = 256 * 64 * 2, STAGE_B = 2 * TILE_B;
  int sR0, sC0;
  stage_rc2(wid * 1024 + lane * 16, sR0, sC0);
  const unsigned goff = (unsigned)(sR0 * 1024 + sC0);
  const unsigned lbase = (unsigned)(size_t)smem + (unsigned)(wid * 1024);
  const int aoff = (wr * 16) * 1024 + ((fr * 64 + fq * 16) ^ ((((fr * 64 + fq * 16) >> 9) & 1) << 5));
  const int boff = TILE_B + (wc * 8) * 1024 + ((fr * 64 + fq * 16) ^ ((((fr * 64 + fq * 16) >> 9) & 1) << 5));
  const int ntiles = 64 * ntn;
  for (int tile = bid; tile < ntiles; tile += nb) {
    int tm, tn;
    {
      const int rnd = tile >> 8, t = tile & 255, xcd = t & 7, j = t >> 3;
      if (ntn == 16) { tm = rnd * 16 + (xcd >> 1) * 4 + (j & 3); tn = (xcd & 1) * 8 + (j >> 2); }
      else { tm = xcd * 8 + (j & 7); tn = j >> 3; }
    }
    const u16* Ab = A + (size_t)tm * 256 * 1024;
    const u16* Bb = Bt + (size_t)tn * 256 * 1024;
    f32x4 acc[8][4];
#pragma unroll
    for (int m = 0; m < 8; ++m)
#pragma unroll
      for (int n = 0; n < 4; ++n) acc[m][n] = f32x4{0.f, 0.f, 0.f, 0.f};
#define G_STAGE(buf, kt) { _Pragma("unroll") for (int i = 0; i < 4; ++i) { \
      __builtin_amdgcn_global_load_lds((const unsigned*)(Ab + (goff + (unsigned)(i * 65536 + (kt) * 64))), \
          (__attribute__((address_space(3))) unsigned*)(lbase + (buf) * STAGE_B + i * 8192), 16, 0, 0); \
      __builtin_amdgcn_global_load_lds((const unsigned*)(Bb + (goff + (unsigned)(i * 65536 + (kt) * 64))), \
          (__attribute__((address_space(3))) unsigned*)(lbase + (buf) * STAGE_B + TILE_B + i * 8192), 16, 0, 0); } }
    G_STAGE(0, 0);
    asm volatile("s_waitcnt vmcnt(0)" ::: "memory");
    __syncthreads();
    for (int t = 0; t < 16; ++t) {
      const int cur = t & 1;
      if (t + 1 < 16) G_STAGE(cur ^ 1, t + 1);
      const char* sA = smem + cur * STAGE_B + aoff;
      const char* sB = smem + cur * STAGE_B + boff;
#pragma unroll
      for (int ks = 0; ks < 2; ++ks) {
        bf16x8 Bf[4];
#pragma unroll
        for (int n = 0; n < 4; ++n) Bf[n] = *(const bf16x8*)(sB + (n * 2 + ks) * 1024);
#pragma unroll
        for (int mh = 0; mh < 2; ++mh) {
          bf16x8 At[4];
#pragma unroll
          for (int m = 0; m < 4; ++m) At[m] = *(const bf16x8*)(sA + ((mh * 4 + m) * 2 + ks) * 1024);
#pragma unroll
          for (int m = 0; m < 4; ++m)
#pragma unroll
            for (int n = 0; n < 4; ++n) acc[mh * 4 + m][n] = mfma16(At[m], Bf[n], acc[mh * 4 + m][n]);
        }
        __builtin_amdgcn_sched_barrier(0);
      }
      asm volatile("s_waitcnt vmcnt(0)" ::: "memory");
      __syncthreads();
    }
#undef G_STAGE
    {
      int t2 = threadIdx.x;
      asm volatile("" : "+v"(t2));
      const int lane2 = t2 & 63, wid2 = t2 >> 6;
      const int rbase = tm * 256 + (wid2 >> 2) * 128 + (lane2 >> 4) * 4 + (lane2 & 3);
      const int cbase = tn * 256 + (wid2 & 3) * 64 + (lane2 & 12);
#pragma unroll
      for (int m = 0; m < 8; ++m)
#pragma unroll
        for (int n = 0; n < 4; ++n) {
          float v[4] = {acc[m][n][0], acc[m][n][1], acc[m][n][2], acc[m][n][3]};
          quad_transpose(v, lane2);
          epi_store4<EPI>(p, rbase + m * 16, cbase + n * 16, v);
        }
    }
  }
  const int nunits = ntn * 16;
  int t3 = threadIdx.x;
  asm volatile("" : "+v"(t3));
  for (int u = bid; u < nunits; u += nb) {
    const int lane = t3 & 63, wid = t3 >> 6, fr = lane & 15, fq = lane >> 4;
    const u16* ar = A + (size_t)(MP + wid * 16 + fr) * 1024 + fq * 8;
    const u16* br = Bt + (size_t)(u * 16 + fr) * 1024 + fq * 8;
    f32x4 acc0 = {0.f, 0.f, 0.f, 0.f}, acc1 = {0.f, 0.f, 0.f, 0.f};
#pragma unroll 4
    for (int ks = 0; ks < 32; ks += 2) {
      const bf16x8 a0 = *(const bf16x8*)(ar + ks * 32), b0 = *(const bf16x8*)(br + ks * 32);
      const bf16x8 a1 = *(const bf16x8*)(ar + ks * 32 + 32), b1 = *(const bf16x8*)(br + ks * 32 + 32);
      acc0 = mfma16(a0, b0, acc0);
      acc1 = mfma16(a1, b1, acc1);
    }
    float v[4] = {acc0[0] + acc1[0], acc0[1] + acc1[1], acc0[2] + acc1[2], acc0[3] + acc1[3]};
    quad_transpose(v, lane);
    epi_store4<EPI>(p, MP + wid * 16 + fq * 4 + (lane & 3), u * 16 + (fr & ~3), v);
  }
  __syncthreads();
}

__device__ void hgrn_item(const Params& p, char* smem, int idx) {
  const int tid = opaque_tid(), lane = tid & 63, w = tid >> 6;
  const int lr = lane & 15, lq = lane >> 4;
  const int h = idx & 3, c = (idx >> 2) & 31, b = idx >> 7;
  const int r0 = b * 2048 + c * 64;
  const u16* PQ = (const u16*)(p.ws + W_PQ);
  const float* LF = (const float*)(p.ws + W_LF);
  u16* QS = (u16*)(p.ws + W_QS);
  u16* O0 = (u16*)(p.ws + W_H);
  u16* NB = (u16*)(p.out);
  float* DVEC = (float*)(p.ws + W_DVEC);
  u16* qt = (u16*)smem;
  u16* kt = qt + 64 * 136;
  u16* ktT = kt + 64 * 136;
  u16* vT = ktT + 128 * 72;
  u16* sc = vT + 128 * 72;
  float* ps = (float*)(sc + 64 * 72);
  const int col = tid & 127, part = tid >> 7;
  float lfv[16], bcum[16];
  {
    const float* lfp = LF + (size_t)(r0 + part * 16) * 512 + h * 128 + col;
#pragma unroll
    for (int i = 0; i < 16; ++i) lfv[i] = lfp[(size_t)i * 512];
    float run = 0.f;
#pragma unroll
    for (int i = 0; i < 16; ++i) { run += lfv[i]; bcum[i] = run; }
    ps[part * 128 + col] = run;
  }
  __syncthreads();
  {
    float off = 0.f, blast = 0.f;
#pragma unroll
    for (int pp = 0; pp < 4; ++pp) { float t = ps[pp * 128 + col]; blast += t; if (pp < part) off += t; }
    const u16* qp = PQ + (size_t)(r0 + part * 16) * PQW + h * 128 + col;
    u16* qsout = QS + ((size_t)idx * 64 + part * 16) * 128 + col;
#pragma unroll
    for (int i = 0; i < 16; ++i) {
      const float bb = bcum[i] + off;
      const int row = part * 16 + i;
      const float q = bf2f(qp[(size_t)i * PQW]);
      const u16 v = qp[(size_t)i * PQW + 512];
      qsout[i * 128] = f2bf(q * expf(bb));
      qt[row * 136 + col] = f2bf(q * expf(bb - blast));
      const float kk = (1.f - expf(lfv[i])) * expf(blast - bb);
      const u16 kbv = f2bf(kk);
      kt[row * 136 + col] = kbv;
      ktT[col * 72 + row] = kbv;
      vT[col * 72 + row] = v;
    }
    if (part == 0) DVEC[idx * 128 + col] = expf(blast);
  }
  __syncthreads();
  {
    const int tr = w >> 1;
    bf16x8 a[4];
#pragma unroll
    for (int ks = 0; ks < 4; ++ks) a[ks] = frag(qt, tr * 16, 136, ks * 32, lane);
#pragma unroll
    for (int tci = 0; tci < 2; ++tci) {
      const int tc = (w & 1) * 2 + tci;
      f32x4 acc = {0.f, 0.f, 0.f, 0.f};
#pragma unroll
      for (int ks = 0; ks < 4; ++ks) acc = mfma16(a[ks], frag(kt, tc * 16, 136, ks * 32, lane), acc);
#pragma unroll
      for (int j = 0; j < 4; ++j) {
        const int t = tr * 16 + lq * 4 + j, s = tc * 16 + lr;
        sc[t * 72 + s] = f2bf(t >= s ? acc[j] : 0.f);
      }
    }
  }
  __syncthreads();
  {
    const int tr = w >> 1;
    const bf16x8 a0 = frag(sc, tr * 16, 72, 0, lane), a1 = frag(sc, tr * 16, 72, 32, lane);
#pragma unroll
    for (int tci = 0; tci < 4; ++tci) {
      const int tc = (w & 1) * 4 + tci;
      f32x4 acc = {0.f, 0.f, 0.f, 0.f};
      acc = mfma16(a0, frag(vT, tc * 16, 72, 0, lane), acc);
      acc = mfma16(a1, frag(vT, tc * 16, 72, 32, lane), acc);
#pragma unroll
      for (int j = 0; j < 4; ++j) {
        const int t = tr * 16 + lq * 4 + j, n = tc * 16 + lr;
        O0[((size_t)idx * 64 + t) * 128 + n] = f2bf(acc[j]);
      }
    }
  }
  {
    const int tr = w;
    const bf16x8 a0 = frag(ktT, tr * 16, 72, 0, lane), a1 = frag(ktT, tr * 16, 72, 32, lane);
#pragma unroll
    for (int tc = 0; tc < 8; ++tc) {
      f32x4 acc = {0.f, 0.f, 0.f, 0.f};
      acc = mfma16(a0, frag(vT, tc * 16, 72, 0, lane), acc);
      acc = mfma16(a1, frag(vT, tc * 16, 72, 32, lane), acc);
#pragma unroll
      for (int j = 0; j < 4; ++j) {
        const int kd = tr * 16 + lq * 4 + j, n = tc * 16 + lr;
        NB[((size_t)idx * 128 + kd) * 128 + n] = f2bf(acc[j]);
      }
    }
  }
  __syncthreads();
}

template <int J>
struct SolveCol {
  static __device__ __forceinline__ void run(f32x4 (&x)[16], const float* AT) {
    if constexpr (J < 63) {
      const float xj = x[J / 4][J % 4];
#pragma unroll
      for (int B = (J + 1) / 4; B < 16; ++B) {
        const f32x4 av = *(const f32x4*)(AT + J * 64 + B * 4);
        x[B] -= av * xj;
        if ((B & 7) == 7) __builtin_amdgcn_sched_barrier(0);
      }
      __builtin_amdgcn_sched_barrier(0);
      SolveCol<J + 1>::run(x, AT);
    }
  }
};

__device__ void gdn_item(const Params& p, char* smem, int idx) {
  const int tid = opaque_tid(), lane = tid & 63, w = tid >> 6;
  const int lr = lane & 15, lq = lane >> 4;
  const int h = idx & 3, c = (idx >> 2) & 31, b = idx >> 7;
  const int r0 = b * 2048 + c * 64;
  const u16* PQ = (const u16*)(p.ws + W_PQ);
  const float* BETA = (const float*)(p.ws + W_BETA);
  const float* GDEC = (const float*)(p.ws + W_GDEC);
  u16* QS = (u16*)(p.ws + W_QS);
  u16* O0 = (u16*)(p.ws + W_H);
  u16* NB = (u16*)(p.out);
  u16* MNEG = (u16*)(p.ws + W_MNEG);
  float* DSC = (float*)(p.ws + W_DSC);
  u16* kb = (u16*)smem;
  u16* qb = kb + 64 * 136;
  u16* vS = qb + 64 * 136;
  float* Asol = (float*)(vS + 64 * 128);
  u16* attn = (u16*)(Asol + 64 * 64);
  u16* khT = attn + 64 * 72;
  u16* WT = khT + 128 * 72;
  u16* U0T = WT + 128 * 72;
  float* gc = (float*)(U0T + 128 * 72);
  float* bet = gc + 64;

  if (w == 0) {
    float g = GDEC[(size_t)(r0 + lane) * 4 + h];
#pragma unroll
    for (int o = 1; o < 64; o <<= 1) { float t = __shfl_up(g, o, 64); if (lane >= o) g += t; }
    gc[lane] = g;
    bet[lane] = BETA[(size_t)(r0 + lane) * 4 + h];
  }
  {
    const int chq = 1024 + h * 128 + 2 * lane;
    const int cwq = h * 128 + 2 * lane;
    float cw[3][4][2];
#pragma unroll
    for (int ty = 0; ty < 3; ++ty)
#pragma unroll
      for (int j = 0; j < 4; ++j) {
        float2 t2 = *(const float2*)(p.conv_w + j * 1536 + ty * 512 + cwq);
        cw[ty][j][0] = t2.x; cw[ty][j][1] = t2.y;
      }
    float win[3][3][2];
    const int t0 = w * 8;
#pragma unroll
    for (int a = 0; a < 3; ++a) {
      const int rr = t0 - 3 + a;
      const bool valid = (c > 0) || (rr >= 0);
#pragma unroll
      for (int ty = 0; ty < 3; ++ty) {
        unsigned u = 0;
        if (valid) u = *(const unsigned*)(PQ + (ptrdiff_t)(r0 + rr) * PQW + chq + ty * 512);
        win[ty][a][0] = bf2f((u16)(u & 0xffff)); win[ty][a][1] = bf2f((u16)(u >> 16));
      }
    }
#pragma unroll
    for (int tt = 0; tt < 8; ++tt) {
      const int t = t0 + tt;
      float cv[3][2];
#pragma unroll
      for (int ty = 0; ty < 3; ++ty) {
        unsigned u = *(const unsigned*)(PQ + (size_t)(r0 + t) * PQW + chq + ty * 512);
        float c0 = bf2f((u16)(u & 0xffff)), c1 = bf2f((u16)(u >> 16));
        float s0 = cw[ty][0][0] * win[ty][0][0] + cw[ty][1][0] * win[ty][1][0] + cw[ty][2][0] * win[ty][2][0] + cw[ty][3][0] * c0;
        float s1 = cw[ty][0][1] * win[ty][0][1] + cw[ty][1][1] * win[ty][1][1] + cw[ty][2][1] * win[ty][2][1] + cw[ty][3][1] * c1;
        win[ty][0][0] = win[ty][1][0]; win[ty][0][1] = win[ty][1][1];
        win[ty][1][0] = win[ty][2][0]; win[ty][1][1] = win[ty][2][1];
        win[ty][2][0] = c0; win[ty][2][1] = c1;
        cv[ty][0] = siluf_(s0); cv[ty][1] = siluf_(s1);
      }
      float ssq = wave_sum(cv[0][0] * cv[0][0] + cv[0][1] * cv[0][1]);
      float ssk = wave_sum(cv[1][0] * cv[1][0] + cv[1][1] * cv[1][1]);
      const float rq = rsqrtf(ssq + EPS) * 0.08838834764831845f;
      const float rk = rsqrtf(ssk + EPS);
      *(unsigned*)(qb + t * 136 + 2 * lane) = pack2(cv[0][0] * rq, cv[0][1] * rq);
      *(unsigned*)(kb + t * 136 + 2 * lane) = pack2(cv[1][0] * rk, cv[1][1] * rk);
      *(unsigned*)(vS + t * 128 + 2 * lane) = pack2(cv[2][0], cv[2][1]);
    }
  }
  __syncthreads();
  {
    const int which = w >> 2, tr = w & 3;
    const u16* Asrc = which ? qb : kb;
    bf16x8 a[4];
#pragma unroll
    for (int ks = 0; ks < 4; ++ks) a[ks] = frag(Asrc, tr * 16, 136, ks * 32, lane);
#pragma unroll
    for (int tc = 0; tc < 4; ++tc) {
      f32x4 acc = {0.f, 0.f, 0.f, 0.f};
#pragma unroll
      for (int ks = 0; ks < 4; ++ks) acc = mfma16(a[ks], frag(kb, tc * 16, 136, ks * 32, lane), acc);
#pragma unroll
      for (int j = 0; j < 4; ++j) {
        const int t = tr * 16 + lq * 4 + j, s = tc * 16 + lr;
        const float L = expf(fminf(gc[t] - gc[s], 0.f));
        if (which == 0) Asol[s * 64 + t] = (t > s) ? bet[t] * acc[j] * L : 0.f;
        else attn[t * 72 + s] = f2bf((t >= s) ? acc[j] * L : 0.f);
      }
    }
  }
  __syncthreads();
  if (tid < 256) {
    f32x4 x[16];
    if (tid < 128) {
#pragma unroll
      for (int s = 0; s < 64; ++s) { x[s >> 2][s & 3] = bf2f(vS[s * 128 + tid]) * bet[s]; if ((s & 7) == 7) __builtin_amdgcn_sched_barrier(0); }
    } else {
#pragma unroll
      for (int s = 0; s < 64; ++s) { x[s >> 2][s & 3] = bf2f(kb[s * 136 + tid - 128]) * bet[s] * expf(gc[s]); if ((s & 7) == 7) __builtin_amdgcn_sched_barrier(0); }
    }
    SolveCol<0>::run(x, Asol);
    u16* dst = (tid < 128) ? (U0T + tid * 72) : (WT + (tid - 128) * 72);
#pragma unroll
    for (int s8 = 0; s8 < 8; ++s8) {
      *(u32x4*)(dst + s8 * 8) = u32x4{pack2(x[2 * s8][0], x[2 * s8][1]), pack2(x[2 * s8][2], x[2 * s8][3]),
                                      pack2(x[2 * s8 + 1][0], x[2 * s8 + 1][1]), pack2(x[2 * s8 + 1][2], x[2 * s8 + 1][3])};
    }
  } else {
    const float glast = gc[63];
    const int e0 = tid - 256;
#pragma unroll 4
    for (int i = 0; i < 32; ++i) {
      const int e = e0 + 256 * i;
      const int s = e & 63, kd = e >> 6;
      khT[kd * 72 + s] = f2bf(bf2f(kb[s * 136 + kd]) * expf(glast - gc[s]));
    }
  }
  __syncthreads();
  {
    const int tr = w & 3, half = w >> 2;
    const u16* Bsrc = half ? U0T : WT;
    const bf16x8 a0 = frag(attn, tr * 16, 72, 0, lane), a1 = frag(attn, tr * 16, 72, 32, lane);
#pragma unroll 2
    for (int tc = 0; tc < 8; ++tc) {
      f32x4 acc = {0.f, 0.f, 0.f, 0.f};
      acc = mfma16(a0, frag(Bsrc, tc * 16, 72, 0, lane), acc);
      acc = mfma16(a1, frag(Bsrc, tc * 16, 72, 32, lane), acc);
#pragma unroll
      for (int j = 0; j < 4; ++j) {
        const int t = tr * 16 + lq * 4 + j, n = tc * 16 + lr;
        const size_t o = ((size_t)(1024 + idx) * 64 + t) * 128 + n;
        if (half == 0) QS[o] = f2bf(bf2f(qb[t * 136 + n]) * expf(gc[t]) - acc[j]);
        else O0[o] = f2bf(acc[j]);
      }
    }
  }
  {
    const int tr = w;
    const bf16x8 a0 = frag(khT, tr * 16, 72, 0, lane), a1 = frag(khT, tr * 16, 72, 32, lane);
#pragma unroll 2
    for (int tc = 0; tc < 16; ++tc) {
      const u16* Bsrc = tc < 8 ? WT : U0T;
      const int tcc = tc & 7;
      f32x4 acc = {0.f, 0.f, 0.f, 0.f};
      acc = mfma16(a0, frag(Bsrc, tcc * 16, 72, 0, lane), acc);
      acc = mfma16(a1, frag(Bsrc, tcc * 16, 72, 32, lane), acc);
#pragma unroll
      for (int j = 0; j < 4; ++j) {
        const int kd = tr * 16 + lq * 4 + j, n = tcc * 16 + lr;
        if (tc < 8) MNEG[((size_t)idx * 128 + kd) * 128 + n] = f2bf(-acc[j]);
        else NB[((size_t)(1024 + idx) * 128 + kd) * 128 + n] = f2bf(acc[j]);
      }
    }
  }
  if (tid < 128) ((float*)(p.ws + W_DVEC))[(size_t)(1024 + idx) * 128 + tid] = expf(gc[63]);
  __syncthreads();
}

__device__ void phase2(const Params& p, char* smem, int bid, int nb) {
  for (int it = bid; it < 2048; it += nb) {
    if (it >= 1024) { gdn_item(p, smem, it - 1024); if (DUP_MASK & 2048) gdn_item(p, smem, it - 1024); }
    else { hgrn_item(p, smem, it); if (DUP_MASK & 1024) hgrn_item(p, smem, it); }
  }
}

struct ScanRegs {
  bf16x8 Aq[4];
  bf16x8 Am[4];
  u32x2 o0, nn0, nn1;
  f32x4 dd;
};
#define RAW_BARRIER() do { asm volatile("s_waitcnt lgkmcnt(0)" ::: "memory"); __builtin_amdgcn_s_barrier(); asm volatile("" ::: "memory"); } while (0)

template <int TYPE>
__device__ __forceinline__ void scan_load(ScanRegs& r, const Params& p, int idx, unsigned qoff, unsigned ooff, unsigned moff,
                                          unsigned noff, unsigned doff) {
  const int ii = __builtin_amdgcn_readfirstlane(idx);
  const int ti = TYPE * 1024 + ii;
  const u16* QSb = (const u16*)(p.ws + W_QS) + (size_t)ti * 8192;
  const u16* O0b = (const u16*)(p.ws + W_H) + (size_t)ti * 8192;
  const u16* NBb = (const u16*)(p.out) + (size_t)ti * 16384;
#pragma unroll
  for (int ks = 0; ks < 4; ++ks) r.Aq[ks] = *(const bf16x8*)(QSb + (qoff + ks * 32));
  r.o0 = *(const u32x2*)(O0b + ooff);
  r.nn0 = *(const u32x2*)(NBb + noff);
  r.nn1 = *(const u32x2*)(NBb + (noff + 16));
  if (TYPE == 1) {
    const u16* Mb = (const u16*)(p.ws + W_MNEG) + (size_t)ii * 16384;
#pragma unroll
    for (int ks = 0; ks < 4; ++ks) r.Am[ks] = *(const bf16x8*)(Mb + (moff + ks * 32));
  }
  r.dd = *(const f32x4*)((const float*)(p.ws + W_DVEC) + (size_t)ti * 128 + doff);
}
__device__ __forceinline__ void unpack4(u32x2 u, float (&v)[4]) {
  v[0] = bf2f((u16)(u[0] & 0xffff)); v[1] = bf2f((u16)(u[0] >> 16));
  v[2] = bf2f((u16)(u[1] & 0xffff)); v[3] = bf2f((u16)(u[1] >> 16));
}

template <int TYPE>
__device__ void scan_unit(const Params& p, char* smem, int rem) {
  const int tid = opaque_tid(), lane = tid & 63, w = tid >> 6;
  const int lr = lane & 15, lq = lane >> 4;
  const int b = rem >> 4, h = (rem >> 2) & 3, vs2 = rem & 3;
  const int tr = lq * 4 + (lane & 3), tc4 = lr & 12;
  const int otr = w & 3, otc = w >> 2;
  float* OPRE = (float*)(p.ws + W_PQ);
  u16* SbT = (u16*)smem;
  for (int i = tid; i < 2 * 32 * 136; i += 512) SbT[i] = 0;
  f32x4 S0 = {0.f, 0.f, 0.f, 0.f}, S1 = {0.f, 0.f, 0.f, 0.f};
  const unsigned qoff = (unsigned)((otr * 16 + lr) * 128 + lq * 8);
  const unsigned ooff = (unsigned)((otr * 16 + tr) * 128 + vs2 * 32 + otc * 16 + tc4);
  const unsigned moff = (unsigned)((w * 16 + lr) * 128 + lq * 8);
  const unsigned noff = (unsigned)((w * 16 + tr) * 128 + vs2 * 32 + tc4);
  const unsigned doff = (unsigned)(w * 16 + lq * 4);
  float* const orow = OPRE + (size_t)(b * 2048 + otr * 16 + tr) * 1024 + TYPE * 512 + h * 128 + vs2 * 32 + otc * 16 + tc4;
  ScanRegs r0, r1, r2, r3;
  const int idx0 = (b * 32) * 4 + h;
  scan_load<TYPE>(r0, p, idx0 + 0, qoff, ooff, moff, noff, doff);
  scan_load<TYPE>(r1, p, idx0 + 4, qoff, ooff, moff, noff, doff);
  scan_load<TYPE>(r2, p, idx0 + 8, qoff, ooff, moff, noff, doff);
  scan_load<TYPE>(r3, p, idx0 + 12, qoff, ooff, moff, noff, doff);
  __builtin_amdgcn_sched_barrier(0);
#define SCAN_STEP(R, c) { \
    RAW_BARRIER(); \
    const u16* Sb = SbT + ((c) & 1) * 32 * 136 + lr * 136 + lq * 8; \
    bf16x8 B0[4], B1[4], Bo[4]; \
    _Pragma("unroll") for (int ks = 0; ks < 4; ++ks) { \
      B0[ks] = *(const bf16x8*)(Sb + ks * 32); \
      B1[ks] = *(const bf16x8*)(Sb + 16 * 136 + ks * 32); \
      Bo[ks] = *(const bf16x8*)(Sb + otc * 16 * 136 + ks * 32); } \
    { \
      float ov[4]; unpack4(R.o0, ov); quad_transpose(ov, lane); \
      f32x4 acc = {ov[0], ov[1], ov[2], ov[3]}; \
      _Pragma("unroll") for (int ks = 0; ks < 4; ++ks) acc = mfma16(R.Aq[ks], Bo[ks], acc); \
      float o[4] = {acc[0], acc[1], acc[2], acc[3]}; \
      quad_transpose(o, lane); \
      *(f32x4*)(orow + (size_t)(c) * 65536) = f32x4{o[0], o[1], o[2], o[3]}; \
    } \
    float n0[4], n1[4]; unpack4(R.nn0, n0); unpack4(R.nn1, n1); \
    quad_transpose(n0, lane); quad_transpose(n1, lane); \
    f32x4 T0, T1; \
    _Pragma("unroll") for (int j = 0; j < 4; ++j) { T0[j] = R.dd[j] * S0[j] + n0[j]; T1[j] = R.dd[j] * S1[j] + n1[j]; } \
    if (TYPE == 1) { _Pragma("unroll") for (int ks = 0; ks < 4; ++ks) { T0 = mfma16(R.Am[ks], B0[ks], T0); T1 = mfma16(R.Am[ks], B1[ks], T1); } } \
    S0 = T0; S1 = T1; \
    u16* Sw = SbT + (((c) + 1) & 1) * 32 * 136 + lr * 136 + w * 16 + lq * 4; \
    *(u32x2*)(Sw) = u32x2{pack2(S0[0], S0[1]), pack2(S0[2], S0[3])}; \
    *(u32x2*)(Sw + 16 * 136) = u32x2{pack2(S1[0], S1[1]), pack2(S1[2], S1[3])}; \
    __builtin_amdgcn_sched_barrier(0); \
    scan_load<TYPE>(R, p, idx0 + (((c) + 4 < 32) ? (c) + 4 : 31) * 4, qoff, ooff, moff, noff, doff); \
    __builtin_amdgcn_sched_barrier(0); \
  }
  for (int c0 = 0; c0 < 32; c0 += 4) {
    SCAN_STEP(r0, c0)
    SCAN_STEP(r1, c0 + 1)
    SCAN_STEP(r2, c0 + 2)
    SCAN_STEP(r3, c0 + 3)
  }
#undef SCAN_STEP
  float* so = p.out + (TYPE ? O_GDP : O_HGP) + (size_t)(b * 4 + h) * 16384 + (w * 16 + tr) * 128 + vs2 * 32 + tc4;
  {
    float sv[4] = {S0[0], S0[1], S0[2], S0[3]};
    quad_transpose(sv, lane);
    *(f32x4*)(so) = f32x4{sv[0], sv[1], sv[2], sv[3]};
    float sw[4] = {S1[0], S1[1], S1[2], S1[3]};
    quad_transpose(sw, lane);
    *(f32x4*)(so + 16) = f32x4{sw[0], sw[1], sw[2], sw[3]};
  }
  __syncthreads();
}

__device__ void sample_item(const Params& p, char* smem, int it) {
  const int tid = opaque_tid(), lane = tid & 63, w = tid >> 6;
  const int type = it >> 9, b = (it >> 2) & 127, h = it & 3;
  const int row = MP + b;
  const u16* PQ = (const u16*)(p.ws + W_PQ);
  const float* LF = (const float*)(p.ws + W_LF);
  const float* BETA = (const float*)(p.ws + W_BETA);
  const float* GDEC = (const float*)(p.ws + W_GDEC);
  float* OPRE = (float*)(p.ws + W_PQ);
  float* fq = (float*)smem;
  float* fk = fq + 128;
  float* fv = fk + 128;
  float* fe = fv + 128;
  float* red = fe + 128;
  float* sc = red + 1024;
  const int n = tid & 127, kp = tid >> 7;
  if (type == 0) {
    if (tid < 128) {
      const float lf = LF[(size_t)row * 512 + h * 128 + tid];
      const float f = expf(lf);
      fe[tid] = f;
      fk[tid] = 1.f - f;
      fq[tid] = bf2f(PQ[(size_t)row * PQW + h * 128 + tid]);
      fv[tid] = bf2f(PQ[(size_t)row * PQW + 512 + h * 128 + tid]);
    }
    __syncthreads();
    const float* S = p.state_hgrn + ((size_t)(b * 4 + h) * 128) * 128;
    float* So = p.out + O_HGS + ((size_t)(b * 4 + h) * 128) * 128;
    const float vn = fv[n];
    float o = 0.f;
#pragma unroll
    for (int i = 0; i < 32; ++i) {
      const int k = kp * 32 + i;
      const float sn = fe[k] * S[k * 128 + n] + fk[k] * vn;
      So[k * 128 + n] = sn;
      o += fq[k] * sn;
    }
    red[kp * 128 + n] = o;
    __syncthreads();
    if (tid < 128) OPRE[(size_t)row * 1024 + h * 128 + tid] = red[tid] + red[128 + tid] + red[256 + tid] + red[384 + tid];
    __syncthreads();
  } else {
    const float* cprev = p.state_conv + (size_t)b * 3 * 1536;
    if (tid < 384) {
      const int ty = tid >> 7, cc = tid & 127;
      const int ch = ty * 512 + h * 128 + cc;
      const float p0 = cprev[ch], p1 = cprev[1536 + ch], p2 = cprev[3072 + ch];
      const float nw = bf2f(PQ[(size_t)row * PQW + 1024 + ch]);
      const float s = p.conv_w[ch] * p0 + p.conv_w[1536 + ch] * p1 + p.conv_w[3072 + ch] * p2 + p.conv_w[4608 + ch] * nw;
      fq[ty * 128 + cc] = siluf_(s);
      p.out[O_CVS + (size_t)(b * 3 + 0) * 1536 + ch] = p1;
      p.out[O_CVS + (size_t)(b * 3 + 1) * 1536 + ch] = p2;
    }
    __syncthreads();
    if (w < 2) {
      const float a0 = fq[w * 128 + lane], a1 = fq[w * 128 + 64 + lane];
      const float ss = wave_sum(a0 * a0 + a1 * a1);
      if (lane == 0) sc[w] = ss;
    }
    __syncthreads();
    const float rq = rsqrtf(sc[0] + EPS) * 0.08838834764831845f;
    const float rk = rsqrtf(sc[1] + EPS);
    __syncthreads();
    if (tid < 128) fq[tid] *= rq;
    else if (tid < 256) fk[tid - 128] *= rk;
    __syncthreads();
    if (w == 0) {
      const float qk = wave_sum(fq[lane] * fk[lane] + fq[64 + lane] * fk[64 + lane]);
      if (lane == 0) sc[2] = qk;
    }
    const float eg = expf(GDEC[(size_t)row * 4 + h]);
    const float beta = BETA[(size_t)row * 4 + h];
    const float* S = p.state_gdn + ((size_t)(b * 4 + h) * 128) * 128;
    float* So = p.out + O_GDS + ((size_t)(b * 4 + h) * 128) * 128;
    float sd[32];
    float ks_ = 0.f, qs_ = 0.f;
#pragma unroll
    for (int i = 0; i < 32; ++i) {
      const int k = kp * 32 + i;
      sd[i] = eg * S[k * 128 + n];
      ks_ += fk[k] * sd[i];
      qs_ += fq[k] * sd[i];
    }
    red[kp * 128 + n] = ks_;
    red[512 + kp * 128 + n] = qs_;
    __syncthreads();
    const float kS = red[n] + red[128 + n] + red[256 + n] + red[384 + n];
    const float delta = (fv[n] - kS) * beta;
#pragma unroll
    for (int i = 0; i < 32; ++i) {
      const int k = kp * 32 + i;
      So[k * 128 + n] = sd[i] + fk[k] * delta;
    }
    if (tid < 128) {
      const float qS = red[512 + n] + red[640 + n] + red[768 + n] + red[896 + n];
      OPRE[(size_t)row * 1024 + 512 + h * 128 + n] = qS + sc[2] * delta;
    }
    __syncthreads();
  }
}

__device__ void phase3(const Params& p, char* smem, int bid, int nb) {
  for (int u = bid; u < 256; u += nb) {
    int uu = u;
    if (nb == 256) {
      const int xcd = u & 7, j = u >> 3;
      uu = ((xcd * 8 + (j >> 2)) << 2) | (j & 3);
    }
    if (uu < 128) scan_unit<0>(p, smem, uu); else scan_unit<1>(p, smem, uu - 128);
    if (DUP_MASK & 256) { if (uu < 128) scan_unit<0>(p, smem, uu); else scan_unit<1>(p, smem, uu - 128); }
  }
  for (int it = bid; it < 1024; it += nb) sample_item(p, smem, it);
}

__device__ void phase4(const Params& p, int bid, int nb) {
  const int tid = opaque_tid(), lane = tid & 63, w = tid >> 6;
  const float* OPRE = (const float*)(p.ws + W_PQ);
  const u16* GATES = (const u16*)(p.ws + W_GATES);
  u16* A2 = (u16*)(p.ws + W_QS);
  for (int g = bid; g < MT / 8; g += nb) {
    const int row = g * 8 + w;
#pragma unroll
    for (int i = 0; i < 4; ++i) {
      const int col = i * 256 + lane * 4;
      const float4 v = *(const float4*)(OPRE + (size_t)row * 1024 + col);
      float ss = v.x * v.x + v.y * v.y + v.z * v.z + v.w * v.w;
#pragma unroll
      for (int o = 16; o > 0; o >>= 1) ss += __shfl_xor(ss, o, 64);
      const float rstd = rsqrtf(ss * (1.f / 128.f) + EPS);
      const int cn = col & 127;
      const float4 nw = *(const float4*)((col < 512 ? p.hg_norm : p.gdn_norm) + cn);
      const uint2 gt = *(const uint2*)(GATES + (size_t)row * 1024 + col);
      const float g0 = bf2f((u16)(gt.x & 0xffff)), g1 = bf2f((u16)(gt.x >> 16));
      const float g2 = bf2f((u16)(gt.y & 0xffff)), g3 = bf2f((u16)(gt.y >> 16));
      *(uint2*)(A2 + (size_t)row * 1024 + col) =
          make_uint2(pack2(v.x * rstd * nw.x * g0, v.y * rstd * nw.y * g1), pack2(v.z * rstd * nw.z * g2, v.w * rstd * nw.w * g3));
    }
  }
}

__device__ void phase6(const Params& p, int bid, int nb) {
  const int tid = opaque_tid(), lane = tid & 63, w = tid >> 6;
  for (int g = bid; g < MT / 8; g += nb) {
    const int row = g * 8 + w;
    float* y = row < MP ? p.out + O_YP + (size_t)row * 1024 : p.out + O_YS + (size_t)(row - MP) * 1024;
    float4 xv[4];
    float ss = 0.f;
#pragma unroll
    for (int i = 0; i < 4; ++i) {
      xv[i] = *(const float4*)(y + i * 256 + lane * 4);
      ss += xv[i].x * xv[i].x + xv[i].y * xv[i].y + xv[i].z * xv[i].z + xv[i].w * xv[i].w;
    }
    ss = wave_sum(ss);
    const float rstd = rsqrtf(ss * (1.f / 1024.f) + EPS);
#pragma unroll
    for (int i = 0; i < 4; ++i) {
      const float4 nw = *(const float4*)(p.final_norm + i * 256 + lane * 4);
      float4 o;
      o.x = xv[i].x * rstd * nw.x; o.y = xv[i].y * rstd * nw.y; o.z = xv[i].z * rstd * nw.z; o.w = xv[i].w * rstd * nw.w;
      *(float4*)(y + i * 256 + lane * 4) = o;
    }
  }
}

template <int PH>
__device__ __forceinline__ void run_phase(const Params& p, char* smem, int bid, int nb) {
  if (PH == 0) phase0(p, smem, bid, nb);
  else if (PH == 1) gemm_phase<0>(p, (const u16*)(p.ws + W_H), (const u16*)(p.ws + W_WINT), 16, smem, bid, nb);
  else if (PH == 2) phase2(p, smem, bid, nb);
  else if (PH == 3) phase3(p, smem, bid, nb);
  else if (PH == 4) phase4(p, bid, nb);
  else if (PH == 5) gemm_phase<1>(p, (const u16*)(p.ws + W_QS), (const u16*)(p.ws + W_WOUTT), 4, smem, bid, nb);
  else phase6(p, bid, nb);
}

#if MEGA
__global__ void __launch_bounds__(NTH) mega_kernel(Params p) {
  extern __shared__ __attribute__((aligned(16))) char smem[];
  cg::grid_group grid = cg::this_grid();
  const int bid = blockIdx.x, nb = gridDim.x;
#define RUNP(k) run_phase<k>(p, smem, bid, nb); grid.sync(); if (DUP_MASK & (1 << k)) { run_phase<k>(p, smem, bid, nb); grid.sync(); }
  RUNP(0) RUNP(1) RUNP(2) RUNP(3) RUNP(4) RUNP(5)
#undef RUNP
  run_phase<6>(p, smem, bid, nb);
}
#else
template <int PH>
__global__ void __launch_bounds__(NTH) phase_kernel(Params p) {
  extern __shared__ __attribute__((aligned(16))) char smem[];
  run_phase<PH>(p, smem, blockIdx.x, gridDim.x);
}
template <int PH>
static void launch_phase(const Params& p, int grid, hipStream_t stream) {
  hipFuncSetAttribute((const void*)phase_kernel<PH>, hipFuncAttributeMaxDynamicSharedMemorySize, (int)LDS_BYTES);
  hipLaunchKernelGGL(phase_kernel<PH>, dim3(grid), dim3(NTH), LDS_BYTES, stream, p);
}
#endif

extern "C" void kernel_launch(void* const* d_in, const int* in_sizes, int n_in, void* d_out, int out_size,
                              void* d_ws, size_t ws_size, hipStream_t stream) {
  Params p{};
  p.x_prompt = (const float*)d_in[0];
  p.x_sample = (const float*)d_in[1];
  p.state_hgrn = (const float*)d_in[2];
  p.state_gdn = (const float*)d_in[3];
  p.state_conv = (const float*)d_in[4];
  p.norm_w = (const float*)d_in[5];
  p.w_in = (const float*)d_in[6];
  p.lb_logits = (const float*)d_in[7];
  p.conv_w = (const float*)d_in[8];
  p.a_log = (const float*)d_in[9];
  p.dt_bias = (const float*)d_in[10];
  p.hg_norm = (const float*)d_in[11];
  p.gdn_norm = (const float*)d_in[12];
  p.w_out = (const float*)d_in[13];
  p.final_norm = (const float*)d_in[14];
  p.out = (float*)d_out;
  p.ws = (char*)d_ws;
  if (ws_size < W_END) { fprintf(stderr, "workspace too small: %zu < %zu\n", ws_size, (size_t)W_END); return; }
#if MEGA
  static int grid_blocks = 0;
  if (!grid_blocks) {
    int dev = 0, cus = 0, per_cu = 0;
    hipGetDevice(&dev);
    hipDeviceGetAttribute(&cus, hipDeviceAttributeMultiprocessorCount, dev);
    hipFuncSetAttribute((const void*)mega_kernel, hipFuncAttributeMaxDynamicSharedMemorySize, (int)LDS_BYTES);
    hipOccupancyMaxActiveBlocksPerMultiprocessor(&per_cu, mega_kernel, NTH, LDS_BYTES);
    if (per_cu < 1) per_cu = 1;
    grid_blocks = cus * per_cu;
  }
  void* args[] = {&p};
  hipError_t e = hipLaunchCooperativeKernel((void*)mega_kernel, dim3(grid_blocks), dim3(NTH), args, LDS_BYTES, stream);
  if (e != hipSuccess) fprintf(stderr, "cooperative launch failed: %s (grid %d)\n", hipGetErrorString(e), grid_blocks);
#else
  const int grid = 256;
  launch_phase<0>(p, grid, stream);
  launch_phase<1>(p, grid, stream);
  launch_phase<2>(p, grid, stream);
  launch_phase<3>(p, grid, stream);
  launch_phase<4>(p, grid, stream);
  launch_phase<5>(p, grid, stream);
  launch_phase<6>(p, grid, stream);
#endif
}
```

```cpp
#include <hip/hip_runtime.h>
#include <hip/hip_cooperative_groups.h>
#include <cstdio>
namespace cg = cooperative_groups;

#ifndef MEGA
#define MEGA 1
#define DUP_MASK 0
#endif

typedef unsigned short u16;
using bf16x8 = __attribute__((ext_vector_type(8))) short;
using f32x4 = __attribute__((ext_vector_type(4))) float;
using u32x4 = __attribute__((ext_vector_type(4))) unsigned;
using u32x2 = __attribute__((ext_vector_type(2))) unsigned;

#define NTH 512
constexpr int MP = 16384, MS = 128, MT = 16512, DM = 1024, DIN = 4104, PQW = 2560;
constexpr float EPS = 1e-6f;
constexpr size_t LDS_BYTES = 139264;

constexpr size_t O_YP = 0, O_YS = 16777216, O_HGP = 16908288, O_GDP = 17432576, O_CVP = 17956864,
                 O_HGS = 17993728, O_GDS = 26382336, O_CVS = 34770944;
constexpr size_t W_WINT = 0;
constexpr size_t W_WOUTT = W_WINT + 8388608;
constexpr size_t W_BETA = W_WOUTT + 2097152;
constexpr size_t W_GDEC = W_BETA + 264192;
constexpr size_t W_DVEC = W_GDEC + 264192;
constexpr size_t W_DSC = W_DVEC + 1048576;
constexpr size_t W_PQ = W_DSC + 4096;
constexpr size_t W_GATES = W_PQ + 84541440;
constexpr size_t W_H = W_GATES + 33816576;
constexpr size_t W_QS = W_H + 33816576;
constexpr size_t W_MNEG = W_QS + 33554432;
constexpr size_t W_LF = W_MNEG + 33554432;
constexpr size_t W_END = W_LF + 33816576;

struct Params {
  const float *x_prompt, *x_sample, *state_hgrn, *state_gdn, *state_conv, *norm_w, *w_in, *lb_logits,
      *conv_w, *a_log, *dt_bias, *hg_norm, *gdn_norm, *w_out, *final_norm;
  float* out;
  char* ws;
};

__device__ __forceinline__ int opaque_tid() { int t = threadIdx.x; asm volatile("" : "+v"(t)); return t; }
typedef __bf16 bf16x2_t __attribute__((ext_vector_type(2)));
typedef float f32x2_t __attribute__((ext_vector_type(2)));
__device__ __forceinline__ u16 f2bf(float x) { return __builtin_bit_cast(u16, (__bf16)x); }
__device__ __forceinline__ float bf2f(u16 h) { return __uint_as_float(((unsigned)h) << 16); }
__device__ __forceinline__ unsigned pack2(float a, float b) {
  f32x2_t v = {a, b};
  return __builtin_bit_cast(unsigned, __builtin_convertvector(v, bf16x2_t));
}
template <int CTRL, int ROWMASK>
__device__ __forceinline__ float dpp_mov(float v) {
  return __builtin_bit_cast(float, __builtin_amdgcn_update_dpp(0, __builtin_bit_cast(int, v), CTRL, ROWMASK, 0xf, false));
}
__device__ __forceinline__ float wave_sum(float v) {
  v += dpp_mov<0xB1, 0xf>(v);
  v += dpp_mov<0x4E, 0xf>(v);
  v += dpp_mov<0x141, 0xf>(v);
  v += dpp_mov<0x140, 0xf>(v);
  v += dpp_mov<0x142, 0xa>(v);
  v += dpp_mov<0x143, 0xc>(v);
  return __builtin_bit_cast(float, __builtin_amdgcn_readlane(__builtin_bit_cast(int, v), 63));
}
__device__ __forceinline__ float sigmoidf_(float x) { return 1.f / (1.f + __expf(-x)); }
__device__ __forceinline__ float siluf_(float x) { return x / (1.f + __expf(-x)); }
__device__ __forceinline__ f32x4 mfma16(bf16x8 a, bf16x8 b, f32x4 c) {
  return __builtin_amdgcn_mfma_f32_16x16x32_bf16(a, b, c, 0, 0, 0);
}
__device__ __forceinline__ bf16x8 frag(const u16* base, int row0, int stride, int koff, int lane) {
  return *(const bf16x8*)(base + (row0 + (lane & 15)) * stride + koff + (lane >> 4) * 8);
}

__device__ __forceinline__ void quad_transpose(float (&v)[4], int lane) {
  {
    const bool b = lane & 1;
    float s0 = b ? v[0] : v[1], s1 = b ? v[2] : v[3];
    float r0 = __shfl_xor(s0, 1, 64), r1 = __shfl_xor(s1, 1, 64);
    if (b) { v[0] = r0; v[2] = r1; } else { v[1] = r0; v[3] = r1; }
  }
  {
    const bool b = lane & 2;
    float s0 = b ? v[0] : v[2], s1 = b ? v[1] : v[3];
    float r0 = __shfl_xor(s0, 2, 64), r1 = __shfl_xor(s1, 2, 64);
    if (b) { v[0] = r0; v[1] = r1; } else { v[2] = r0; v[3] = r1; }
  }
}

__device__ __forceinline__ void store4_bf16(u16* dst, const float (&v)[4]) {
  *(u32x2*)dst = u32x2{pack2(v[0], v[1]), pack2(v[2], v[3])};
}
__device__ void phase0(const Params& p, char* smem, int bid, int nb) {
  const int tid = opaque_tid(), lane = tid & 63, w = tid >> 6;
  u16* WinT = (u16*)(p.ws + W_WINT);
  u16* WoutT = (u16*)(p.ws + W_WOUTT);
  u16* H = (u16*)(p.ws + W_H);
  float* BETA = (float*)(p.ws + W_BETA);
  float* GDEC = (float*)(p.ws + W_GDEC);
  float* tl = (float*)smem;
  for (int t = bid; t < 1280; t += nb) {
    const float* src; int sstride; u16* dst; int kt, nt;
    if (t < 1024) { src = p.w_in; sstride = DIN; dst = WinT; kt = t >> 6; nt = t & 63; }
    else { int u = t - 1024; src = p.w_out; sstride = 1024; dst = WoutT; kt = u >> 4; nt = u & 15; }
#pragma unroll
    for (int i = 0; i < 8; ++i) {
      int idx = tid + 512 * i; int kk = idx >> 6, nn = idx & 63;
      tl[kk * 65 + nn] = src[(size_t)(kt * 64 + kk) * sstride + nt * 64 + nn];
    }
    __syncthreads();
    {
      int nn = tid >> 3, k8 = (tid & 7) * 8;
      unsigned pk[4];
#pragma unroll
      for (int e = 0; e < 4; ++e) pk[e] = pack2(tl[(k8 + 2 * e) * 65 + nn], tl[(k8 + 2 * e + 1) * 65 + nn]);
      *(uint4*)(dst + (size_t)(nt * 64 + nn) * 1024 + kt * 64 + k8) = make_uint4(pk[0], pk[1], pk[2], pk[3]);
    }
    __syncthreads();
  }
  float* W8s = (float*)smem;
  for (int idx = tid; idx < 8192; idx += 512) {
    int j = idx & 7, k = idx >> 3;
    W8s[j * 1024 + k] = p.w_in[(size_t)k * DIN + 4096 + j];
  }
  __syncthreads();
  for (int g = bid; g < MT / 8; g += nb) {
    int row = g * 8 + w;
    const float* x = row < MP ? p.x_prompt + (size_t)row * 1024 : p.x_sample + (size_t)(row - MP) * 1024;
    float4 xv[4];
    float ss = 0.f;
#pragma unroll
    for (int i = 0; i < 4; ++i) {
      xv[i] = *(const float4*)(x + i * 256 + lane * 4);
      ss += xv[i].x * xv[i].x + xv[i].y * xv[i].y + xv[i].z * xv[i].z + xv[i].w * xv[i].w;
    }
    ss = wave_sum(ss);
    float rstd = rsqrtf(ss * (1.f / 1024.f) + EPS);
    float d0 = 0, d1 = 0, d2 = 0, d3 = 0, d4 = 0, d5 = 0, d6 = 0, d7 = 0;
#pragma unroll
    for (int i = 0; i < 4; ++i) {
      float4 nw = *(const float4*)(p.norm_w + i * 256 + lane * 4);
      float4 hv;
      hv.x = xv[i].x * rstd * nw.x; hv.y = xv[i].y * rstd * nw.y; hv.z = xv[i].z * rstd * nw.z; hv.w = xv[i].w * rstd * nw.w;
      *(uint2*)(H + (size_t)row * 1024 + i * 256 + lane * 4) = make_uint2(pack2(hv.x, hv.y), pack2(hv.z, hv.w));
#define GDOT(j, dj) { float4 wv = *(const float4*)(W8s + j * 1024 + i * 256 + lane * 4); dj += hv.x * wv.x + hv.y * wv.y + hv.z * wv.z + hv.w * wv.w; }
      GDOT(0, d0) GDOT(1, d1) GDOT(2, d2) GDOT(3, d3) GDOT(4, d4) GDOT(5, d5) GDOT(6, d6) GDOT(7, d7)
#undef GDOT
    }
    d0 = wave_sum(d0); d1 = wave_sum(d1); d2 = wave_sum(d2); d3 = wave_sum(d3);
    d4 = wave_sum(d4); d5 = wave_sum(d5); d6 = wave_sum(d6); d7 = wave_sum(d7);
    if (lane < 4) {
      float gb = lane == 0 ? d0 : lane == 1 ? d1 : lane == 2 ? d2 : d3;
      float ga = lane == 0 ? d4 : lane == 1 ? d5 : lane == 2 ? d6 : d7;
      BETA[row * 4 + lane] = 1.f / (1.f + expf(-gb));
      float z = ga + p.dt_bias[lane];
      float sp = z > 20.f ? z : log1pf(expf(z));
      GDEC[row * 4 + lane] = -expf(p.a_log[lane]) * sp;
    }
  }
  __syncthreads();
}

__device__ __forceinline__ int lds_byte2(int r, int c) {
  int st = (r >> 4) * 2 + (c >> 5), ob = (r & 15) * 64 + (c & 31) * 2;
  return st * 1024 + (ob ^ (((ob >> 9) & 1) << 5));
}
__device__ __forceinline__ void stage_rc2(int b, int& R, int& C) {
  int st = b >> 10, sb = b & 1023, swz = sb ^ (((sb >> 9) & 1) << 5);
  R = (st >> 1) * 16 + swz / 64;
  C = (st & 1) * 32 + (swz % 64) / 2;
}
template <int EPI>
__device__ __forceinline__ void epi_store4(const Params& p, int row, int col4, const float (&v)[4]) {
  if (EPI == 0) {
    u16* PQ = (u16*)(p.ws + W_PQ);
    u16* GATES = (u16*)(p.ws + W_GATES);
    float* LF = (float*)(p.ws + W_LF);
    const int sec = col4 >> 9;
    if (sec == 0) {
      *(uint2*)(PQ + (size_t)row * PQW + col4) = make_uint2(pack2(v[0], v[1]), pack2(v[2], v[3]));
    } else if (sec == 1) {
      const int cc = col4 - 512;
      const f32x4 l0 = *(const f32x4*)(p.lb_logits + cc), l1 = *(const f32x4*)(p.lb_logits + 512 + cc);
      f32x4 o;
#pragma unroll
      for (int i = 0; i < 4; ++i) {
        const float lbv = 1.f / (1.f + __expf(l1[i] - l0[i]));
        o[i] = __logf(lbv + (1.f - lbv) / (1.f + __expf(-v[i])));
      }
      *(f32x4*)(LF + (size_t)row * 512 + cc) = o;
    } else if (sec == 2) {
      *(uint2*)(PQ + (size_t)row * PQW + 512 + (col4 - 1024)) = make_uint2(pack2(v[0], v[1]), pack2(v[2], v[3]));
    } else if (sec == 3 || sec == 7) {
      const int cc = sec == 3 ? col4 - 1536 : 512 + col4 - 3584;
      *(uint2*)(GATES + (size_t)row * 1024 + cc) =
          make_uint2(pack2(v[0] / (1.f + __expf(-v[0])), v[1] / (1.f + __expf(-v[1]))),
                     pack2(v[2] / (1.f + __expf(-v[2])), v[3] / (1.f + __expf(-v[3]))));
    } else {
      const int cc = col4 - 2048;
      *(uint2*)(PQ + (size_t)row * PQW + 1024 + cc) = make_uint2(pack2(v[0], v[1]), pack2(v[2], v[3]));
      if (row < MP) {
        const int tt = row & 2047;
        if (tt >= 2045) *(f32x4*)(p.out + O_CVP + (size_t)((row >> 11) * 3 + (tt - 2045)) * 1536 + cc) = f32x4{v[0], v[1], v[2], v[3]};
      } else {
        *(f32x4*)(p.out + O_CVS + (size_t)((row - MP) * 3 + 2) * 1536 + cc) = f32x4{v[0], v[1], v[2], v[3]};
      }
    }
  } else {
    const float* xr = row < MP ? p.x_prompt + (size_t)row * 1024 : p.x_sample + (size_t)(row - MP) * 1024;
    float* yr = row < MP ? p.out + O_YP + (size_t)row * 1024 : p.out + O_YS + (size_t)(row - MP) * 1024;
    const f32x4 xv = *(const f32x4*)(xr + col4);
    *(f32x4*)(yr + col4) = f32x4{xv[0] + v[0], xv[1] + v[1], xv[2] + v[2], xv[3] + v[3]};
  }
}

template <int EPI>
__device__ void gemm_phase(const Params& p, const u16* __restrict__ A, const u16* __restrict__ Bt, int ntn,
                           char* smem, int bid, int nb) {
  const int tid = opaque_tid(), lane = tid & 63, wid = tid >> 6;
  const int wr = wid >> 2, wc = wid & 3, fr = lane & 15, fq = lane >> 4;
  constexpr int TILE_B = 256 * 64 * 2, STAGE_B = 2 * TILE_B;
  int sR0, sC0;
  stage_rc2(wid * 1024 + lane * 16, sR0, sC0);
  const unsigned goff = (unsigned)(sR0 * 1024 + sC0);
  const unsigned lbase = (unsigned)(size_t)smem + (unsigned)(wid * 1024);
  const int aoff = (wr * 16) * 1024 + ((fr * 64 + fq * 16) ^ ((((fr * 64 + fq * 16) >> 9) & 1) << 5));
  const int boff = TILE_B + (wc * 8) * 1024 + ((fr * 64 + fq * 16) ^ ((((fr * 64 + fq * 16) >> 9) & 1) << 5));
  const int ntiles = 64 * ntn;
  for (int tile = bid; tile < ntiles; tile += nb) {
    int tm, tn;
    {
      const int rnd = tile >> 8, t = tile & 255, xcd = t & 7, j = t >> 3;
      if (ntn == 16) { tm = rnd * 16 + (xcd >> 1) * 4 + (j & 3); tn = (xcd & 1) * 8 + (j >> 2); }
      else { tm = xcd * 8 + (j & 7); tn = j >> 3; }
    }
    const u16* Ab = A + (size_t)tm * 256 * 1024;
    const u16* Bb = Bt + (size_t)tn * 256 * 1024;
    f32x4 acc[8][4];
#pragma unroll
    for (int m = 0; m < 8; ++m)
#pragma unroll
      for (int n = 0; n < 4; ++n) acc[m][n] = f32x4{0.f, 0.f, 0.f, 0.f};
#define G_STAGE(buf, kt) { _Pragma("unroll") for (int i = 0; i < 4; ++i) { \
      __builtin_amdgcn_global_load_lds((const unsigned*)(Ab + (goff + (unsigned)(i * 65536 + (kt) * 64))), \
          (__attribute__((address_space(3))) unsigned*)(lbase + (buf) * STAGE_B + i * 8192), 16, 0, 0); \
      __builtin_amdgcn_global_load_lds((const unsigned*)(Bb + (goff + (unsigned)(i * 65536 + (kt) * 64))), \
          (__attribute__((address_space(3))) unsigned*)(lbase + (buf) * STAGE_B + TILE_B + i * 8192), 16, 0, 0); } }
    G_STAGE(0, 0);
    asm volatile("s_waitcnt vmcnt(0)" ::: "memory");
    __syncthreads();
    for (int t = 0; t < 16; ++t) {
      const int cur = t & 1;
      if (t + 1 < 16) G_STAGE(cur ^ 1, t + 1);
      const char* sA = smem + cur * STAGE_B + aoff;
      const char* sB = smem + cur * STAGE_B + boff;
#pragma unroll
      for (int ks = 0; ks < 2; ++ks) {
        bf16x8 Bf[4];
#pragma unroll
        for (int n = 0; n < 4; ++n) Bf[n] = *(const bf16x8*)(sB + (n * 2 + ks) * 1024);
#pragma unroll
        for (int mh = 0; mh < 2; ++mh) {
          bf16x8 At[4];
#pragma unroll
          for (int m = 0; m < 4; ++m) At[m] = *(const bf16x8*)(sA + ((mh * 4 + m) * 2 + ks) * 1024);
#pragma unroll
          for (int m = 0; m < 4; ++m)
#pragma unroll
            for (int n = 0; n < 4; ++n) acc[mh * 4 + m][n] = mfma16(At[m], Bf[n], acc[mh * 4 + m][n]);
        }
        __builtin_amdgcn_sched_barrier(0);
      }
      asm volatile("s_waitcnt vmcnt(0)" ::: "memory");
      __syncthreads();
    }
#undef G_STAGE
    {
      int t2 = threadIdx.x;
      asm volatile("" : "+v"(t2));
      const int lane2 = t2 & 63, wid2 = t2 >> 6;
      const int rbase = tm * 256 + (wid2 >> 2) * 128 + (lane2 >> 4) * 4 + (lane2 & 3);
      const int cbase = tn * 256 + (wid2 & 3) * 64 + (lane2 & 12);
#pragma unroll
      for (int m = 0; m < 8; ++m)
#pragma unroll
        for (int n = 0; n < 4; ++n) {
          float v[4] = {acc[m][n][0], acc[m][n][1], acc[m][n][2], acc[m][n][3]};
          quad_transpose(v, lane2);
          epi_store4<EPI>(p, rbase + m * 16, cbase + n * 16, v);
        }
    }
  }
  const int nunits = ntn * 16;
  int t3 = threadIdx.x;
  asm volatile("" : "+v"(t3));
  for (int u = bid; u < nunits; u += nb) {
    const int lane = t3 & 63, wid = t3 >> 6, fr = lane & 15, fq = lane >> 4;
    const u16* ar = A + (size_t)(MP + wid * 16 + fr) * 1024 + fq * 8;
    const u16* br = Bt + (size_t)(u * 16 + fr) * 1024 + fq * 8;
    f32x4 acc0 = {0.f, 0.f, 0.f, 0.f}, acc1 = {0.f, 0.f, 0.f, 0.f};
#pragma unroll 4
    for (int ks = 0; ks < 32; ks += 2) {
      const bf16x8 a0 = *(const bf16x8*)(ar + ks * 32), b0 = *(const bf16x8*)(br + ks * 32);
      const bf16x8 a1 = *(const bf16x8*)(ar + ks * 32 + 32), b1 = *(const bf16x8*)(br + ks * 32 + 32);
      acc0 = mfma16(a0, b0, acc0);
      acc1 = mfma16(a1, b1, acc1);
    }
    float v[4] = {acc0[0] + acc1[0], acc0[1] + acc1[1], acc0[2] + acc1[2], acc0[3] + acc1[3]};
    quad_transpose(v, lane);
    epi_store4<EPI>(p, MP + wid * 16 + fq * 4 + (lane & 3), u * 16 + (fr & ~3), v);
  }
  __syncthreads();
}

__device__ void hgrn_item(const Params& p, char* smem, int idx) {
  const int tid = opaque_tid(), lane = tid & 63, w = tid >> 6;
  const int lr = lane & 15, lq = lane >> 4;
  const int h = idx & 3, c = (idx >> 2) & 31, b = idx >> 7;
  const int r0 = b * 2048 + c * 64;
  const u16* PQ = (const u16*)(p.ws + W_PQ);
  const float* LF = (const float*)(p.ws + W_LF);
  u16* QS = (u16*)(p.ws + W_QS);
  u16* O0 = (u16*)(p.ws + W_H);
  u16* NB = (u16*)(p.out);
  float* DVEC = (float*)(p.ws + W_DVEC);
  u16* qt = (u16*)smem;
  u16* kt = qt + 64 * 136;
  u16* ktT = kt + 64 * 136;
  u16* vT = ktT + 128 * 72;
  u16* sc = vT + 128 * 72;
  float* ps = (float*)(sc + 64 * 72);
  const int col = tid & 127, part = tid >> 7;
  float lfv[16], bcum[16];
  {
    const float* lfp = LF + (size_t)(r0 + part * 16) * 512 + h * 128 + col;
#pragma unroll
    for (int i = 0; i < 16; ++i) lfv[i] = lfp[(size_t)i * 512];
    float run = 0.f;
#pragma unroll
    for (int i = 0; i < 16; ++i) { run += lfv[i]; bcum[i] = run; }
    ps[part * 128 + col] = run;
  }
  __syncthreads();
  {
    float off = 0.f, blast = 0.f;
#pragma unroll
    for (int pp = 0; pp < 4; ++pp) { float t = ps[pp * 128 + col]; blast += t; if (pp < part) off += t; }
    const u16* qp = PQ + (size_t)(r0 + part * 16) * PQW + h * 128 + col;
    u16* qsout = QS + ((size_t)idx * 64 + part * 16) * 128 + col;
#pragma unroll
    for (int i = 0; i < 16; ++i) {
      const float bb = bcum[i] + off;
      const int row = part * 16 + i;
      const float q = bf2f(qp[(size_t)i * PQW]);
      const u16 v = qp[(size_t)i * PQW + 512];
      qsout[i * 128] = f2bf(q * __expf(bb));
      qt[row * 136 + col] = f2bf(q * __expf(bb - blast));
      const float kk = (1.f - __expf(lfv[i])) * __expf(blast - bb);
      const u16 kbv = f2bf(kk);
      kt[row * 136 + col] = kbv;
      ktT[col * 72 + row] = kbv;
      vT[col * 72 + row] = v;
    }
    if (part == 0) DVEC[idx * 128 + col] = __expf(blast);
  }
  __syncthreads();
  {
    const int tr = w >> 1;
    bf16x8 a[4];
#pragma unroll
    for (int ks = 0; ks < 4; ++ks) a[ks] = frag(qt, tr * 16, 136, ks * 32, lane);
#pragma unroll
    for (int tci = 0; tci < 2; ++tci) {
      const int tc = (w & 1) * 2 + tci;
      f32x4 acc = {0.f, 0.f, 0.f, 0.f};
#pragma unroll
      for (int ks = 0; ks < 4; ++ks) acc = mfma16(a[ks], frag(kt, tc * 16, 136, ks * 32, lane), acc);
#pragma unroll
      for (int j = 0; j < 4; ++j) {
        const int t = tr * 16 + lq * 4 + j, s = tc * 16 + lr;
        sc[t * 72 + s] = f2bf(t >= s ? acc[j] : 0.f);
      }
    }
  }
  __syncthreads();
  {
    const int tr = w >> 1;
    const bf16x8 a0 = frag(sc, tr * 16, 72, 0, lane), a1 = frag(sc, tr * 16, 72, 32, lane);
#pragma unroll
    for (int tci = 0; tci < 4; ++tci) {
      const int tc = (w & 1) * 4 + tci;
      f32x4 acc = {0.f, 0.f, 0.f, 0.f};
      acc = mfma16(a0, frag(vT, tc * 16, 72, 0, lane), acc);
      acc = mfma16(a1, frag(vT, tc * 16, 72, 32, lane), acc);
      {
        float v[4] = {acc[0], acc[1], acc[2], acc[3]};
        quad_transpose(v, lane);
        store4_bf16(O0 + ((size_t)idx * 64 + tr * 16 + lq * 4 + (lane & 3)) * 128 + tc * 16 + (lr & 12), v);
      }
    }
  }
  {
    const int tr = w;
    const bf16x8 a0 = frag(ktT, tr * 16, 72, 0, lane), a1 = frag(ktT, tr * 16, 72, 32, lane);
#pragma unroll
    for (int tc = 0; tc < 8; ++tc) {
      f32x4 acc = {0.f, 0.f, 0.f, 0.f};
      acc = mfma16(a0, frag(vT, tc * 16, 72, 0, lane), acc);
      acc = mfma16(a1, frag(vT, tc * 16, 72, 32, lane), acc);
      {
        float v[4] = {acc[0], acc[1], acc[2], acc[3]};
        quad_transpose(v, lane);
        store4_bf16(NB + ((size_t)idx * 128 + tr * 16 + lq * 4 + (lane & 3)) * 128 + tc * 16 + (lr & 12), v);
      }
    }
  }
  __syncthreads();
}

template <int J>
struct SolveCol {
  static __device__ __forceinline__ void run(f32x4 (&x)[16], const float* AT) {
    if constexpr (J < 63) {
      const float xj = x[J / 4][J % 4];
#pragma unroll
      for (int B = (J + 1) / 4; B < 16; ++B) {
        const f32x4 av = *(const f32x4*)(AT + J * 64 + B * 4);
        x[B] -= av * xj;
      }
      if ((J & 3) == 3) __builtin_amdgcn_sched_barrier(0);
      SolveCol<J + 1>::run(x, AT);
    }
  }
};

__device__ void gdn_item(const Params& p, char* smem, int idx) {
  const int tid = opaque_tid(), lane = tid & 63, w = tid >> 6;
  const int lr = lane & 15, lq = lane >> 4;
  const int h = idx & 3, c = (idx >> 2) & 31, b = idx >> 7;
  const int r0 = b * 2048 + c * 64;
  const u16* PQ = (const u16*)(p.ws + W_PQ);
  const float* BETA = (const float*)(p.ws + W_BETA);
  const float* GDEC = (const float*)(p.ws + W_GDEC);
  u16* QS = (u16*)(p.ws + W_QS);
  u16* O0 = (u16*)(p.ws + W_H);
  u16* NB = (u16*)(p.out);
  u16* MNEG = (u16*)(p.ws + W_MNEG);
  float* DSC = (float*)(p.ws + W_DSC);
  u16* kb = (u16*)smem;
  u16* qb = kb + 64 * 136;
  u16* vS = qb + 64 * 136;
  float* Asol = (float*)(vS + 64 * 128);
  u16* attn = (u16*)(Asol + 64 * 64);
  u16* khT = attn + 64 * 72;
  u16* WT = khT + 128 * 72;
  u16* U0T = WT + 128 * 72;
  float* gc = (float*)(U0T + 128 * 72);
  float* bet = gc + 64;

  if (w == 0) {
    float g = GDEC[(size_t)(r0 + lane) * 4 + h];
#pragma unroll
    for (int o = 1; o < 64; o <<= 1) { float t = __shfl_up(g, o, 64); if (lane >= o) g += t; }
    gc[lane] = g;
    bet[lane] = BETA[(size_t)(r0 + lane) * 4 + h];
  }
  {
    const int chq = 1024 + h * 128 + 2 * lane;
    const int cwq = h * 128 + 2 * lane;
    float cw[3][4][2];
#pragma unroll
    for (int ty = 0; ty < 3; ++ty)
#pragma unroll
      for (int j = 0; j < 4; ++j) {
        float2 t2 = *(const float2*)(p.conv_w + j * 1536 + ty * 512 + cwq);
        cw[ty][j][0] = t2.x; cw[ty][j][1] = t2.y;
      }
    float win[3][3][2];
    const int t0 = w * 8;
#pragma unroll
    for (int a = 0; a < 3; ++a) {
      const int rr = t0 - 3 + a;
      const bool valid = (c > 0) || (rr >= 0);
#pragma unroll
      for (int ty = 0; ty < 3; ++ty) {
        unsigned u = 0;
        if (valid) u = *(const unsigned*)(PQ + (ptrdiff_t)(r0 + rr) * PQW + chq + ty * 512);
        win[ty][a][0] = bf2f((u16)(u & 0xffff)); win[ty][a][1] = bf2f((u16)(u >> 16));
      }
    }
#pragma unroll
    for (int tt = 0; tt < 8; ++tt) {
      const int t = t0 + tt;
      float cv[3][2];
#pragma unroll
      for (int ty = 0; ty < 3; ++ty) {
        unsigned u = *(const unsigned*)(PQ + (size_t)(r0 + t) * PQW + chq + ty * 512);
        float c0 = bf2f((u16)(u & 0xffff)), c1 = bf2f((u16)(u >> 16));
        float s0 = cw[ty][0][0] * win[ty][0][0] + cw[ty][1][0] * win[ty][1][0] + cw[ty][2][0] * win[ty][2][0] + cw[ty][3][0] * c0;
        float s1 = cw[ty][0][1] * win[ty][0][1] + cw[ty][1][1] * win[ty][1][1] + cw[ty][2][1] * win[ty][2][1] + cw[ty][3][1] * c1;
        win[ty][0][0] = win[ty][1][0]; win[ty][0][1] = win[ty][1][1];
        win[ty][1][0] = win[ty][2][0]; win[ty][1][1] = win[ty][2][1];
        win[ty][2][0] = c0; win[ty][2][1] = c1;
        cv[ty][0] = siluf_(s0); cv[ty][1] = siluf_(s1);
      }
      float ssq = wave_sum(cv[0][0] * cv[0][0] + cv[0][1] * cv[0][1]);
      float ssk = wave_sum(cv[1][0] * cv[1][0] + cv[1][1] * cv[1][1]);
      const float rq = rsqrtf(ssq + EPS) * 0.08838834764831845f;
      const float rk = rsqrtf(ssk + EPS);
      *(unsigned*)(qb + t * 136 + 2 * lane) = pack2(cv[0][0] * rq, cv[0][1] * rq);
      *(unsigned*)(kb + t * 136 + 2 * lane) = pack2(cv[1][0] * rk, cv[1][1] * rk);
      *(unsigned*)(vS + t * 128 + 2 * lane) = pack2(cv[2][0], cv[2][1]);
    }
  }
  __syncthreads();
  {
    const int which = w >> 2, tr = w & 3;
    const u16* Asrc = which ? qb : kb;
    bf16x8 a[4];
#pragma unroll
    for (int ks = 0; ks < 4; ++ks) a[ks] = frag(Asrc, tr * 16, 136, ks * 32, lane);
#pragma unroll
    for (int tc = 0; tc < 4; ++tc) {
      f32x4 acc = {0.f, 0.f, 0.f, 0.f};
#pragma unroll
      for (int ks = 0; ks < 4; ++ks) acc = mfma16(a[ks], frag(kb, tc * 16, 136, ks * 32, lane), acc);
#pragma unroll
      for (int j = 0; j < 4; ++j) {
        const int t = tr * 16 + lq * 4 + j, s = tc * 16 + lr;
        const float L = __expf(fminf(gc[t] - gc[s], 0.f));
        if (which == 0) Asol[s * 64 + t] = (t > s) ? bet[t] * acc[j] * L : 0.f;
        else attn[t * 72 + s] = f2bf((t >= s) ? acc[j] * L : 0.f);
      }
    }
  }
  __syncthreads();
  if (tid < 256) {
    f32x4 x[16];
    if (tid < 128) {
#pragma unroll
      for (int s = 0; s < 64; ++s) { x[s >> 2][s & 3] = bf2f(vS[s * 128 + tid]) * bet[s]; if ((s & 7) == 7) __builtin_amdgcn_sched_barrier(0); }
    } else {
#pragma unroll
      for (int s = 0; s < 64; ++s) { x[s >> 2][s & 3] = bf2f(kb[s * 136 + tid - 128]) * bet[s] * __expf(gc[s]); if ((s & 7) == 7) __builtin_amdgcn_sched_barrier(0); }
    }
    SolveCol<0>::run(x, Asol);
    u16* dst = (tid < 128) ? (U0T + tid * 72) : (WT + (tid - 128) * 72);
#pragma unroll
    for (int s8 = 0; s8 < 8; ++s8) {
      *(u32x4*)(dst + s8 * 8) = u32x4{pack2(x[2 * s8][0], x[2 * s8][1]), pack2(x[2 * s8][2], x[2 * s8][3]),
                                      pack2(x[2 * s8 + 1][0], x[2 * s8 + 1][1]), pack2(x[2 * s8 + 1][2], x[2 * s8 + 1][3])};
    }
  } else {
    const float glast = gc[63];
    const int e0 = tid - 256;
#pragma unroll 4
    for (int i = 0; i < 32; ++i) {
      const int e = e0 + 256 * i;
      const int s = e & 63, kd = e >> 6;
      khT[kd * 72 + s] = f2bf(bf2f(kb[s * 136 + kd]) * __expf(glast - gc[s]));
    }
  }
  __syncthreads();
  {
    const int tr = w & 3, half = w >> 2;
    const u16* Bsrc = half ? U0T : WT;
    const bf16x8 a0 = frag(attn, tr * 16, 72, 0, lane), a1 = frag(attn, tr * 16, 72, 32, lane);
#pragma unroll 2
    for (int tc = 0; tc < 8; ++tc) {
      f32x4 acc = {0.f, 0.f, 0.f, 0.f};
      acc = mfma16(a0, frag(Bsrc, tc * 16, 72, 0, lane), acc);
      acc = mfma16(a1, frag(Bsrc, tc * 16, 72, 32, lane), acc);
      {
        float v[4];
#pragma unroll
        for (int j = 0; j < 4; ++j) {
          const int t = tr * 16 + lq * 4 + j, n = tc * 16 + lr;
          v[j] = half == 0 ? bf2f(qb[t * 136 + n]) * __expf(gc[t]) - acc[j] : acc[j];
        }
        quad_transpose(v, lane);
        const size_t o = ((size_t)(1024 + idx) * 64 + tr * 16 + lq * 4 + (lane & 3)) * 128 + tc * 16 + (lr & 12);
        store4_bf16((half == 0 ? QS : O0) + o, v);
      }
    }
  }
  {
    const int tr = w;
    const bf16x8 a0 = frag(khT, tr * 16, 72, 0, lane), a1 = frag(khT, tr * 16, 72, 32, lane);
#pragma unroll 2
    for (int tc = 0; tc < 16; ++tc) {
      const u16* Bsrc = tc < 8 ? WT : U0T;
      const int tcc = tc & 7;
      f32x4 acc = {0.f, 0.f, 0.f, 0.f};
      acc = mfma16(a0, frag(Bsrc, tcc * 16, 72, 0, lane), acc);
      acc = mfma16(a1, frag(Bsrc, tcc * 16, 72, 32, lane), acc);
      {
        float v[4];
#pragma unroll
        for (int j = 0; j < 4; ++j) v[j] = tc < 8 ? -acc[j] : acc[j];
        quad_transpose(v, lane);
        const size_t o = (size_t)(tr * 16 + lq * 4 + (lane & 3)) * 128 + tcc * 16 + (lr & 12);
        store4_bf16((tc < 8 ? MNEG + (size_t)idx * 16384 : NB + (size_t)(1024 + idx) * 16384) + o, v);
      }
    }
  }
  if (tid < 128) ((float*)(p.ws + W_DVEC))[(size_t)(1024 + idx) * 128 + tid] = __expf(gc[63]);
  __syncthreads();
}

__device__ void phase2(const Params& p, char* smem, int bid, int nb) {
  for (int it = bid; it < 2048; it += nb) {
    if (it >= 1024) { gdn_item(p, smem, it - 1024); if (DUP_MASK & 2048) gdn_item(p, smem, it - 1024); }
    else { hgrn_item(p, smem, it); if (DUP_MASK & 1024) hgrn_item(p, smem, it); }
  }
}

struct ScanRegs {
  bf16x8 Aq[4];
  bf16x8 Am[4];
  u32x2 o0, nn0, nn1;
  f32x4 dd;
};
#define RAW_BARRIER() do { asm volatile("s_waitcnt lgkmcnt(0)" ::: "memory"); __builtin_amdgcn_s_barrier(); asm volatile("" ::: "memory"); } while (0)

template <int TYPE>
__device__ __forceinline__ void scan_load(ScanRegs& r, const Params& p, int idx, unsigned qoff, unsigned ooff, unsigned moff,
                                          unsigned noff, unsigned doff) {
  const int ii = __builtin_amdgcn_readfirstlane(idx);
  const int ti = TYPE * 1024 + ii;
  const u16* QSb = (const u16*)(p.ws + W_QS) + (size_t)ti * 8192;
  const u16* O0b = (const u16*)(p.ws + W_H) + (size_t)ti * 8192;
  const u16* NBb = (const u16*)(p.out) + (size_t)ti * 16384;
#pragma unroll
  for (int ks = 0; ks < 4; ++ks) r.Aq[ks] = *(const bf16x8*)(QSb + (qoff + ks * 32));
  r.o0 = *(const u32x2*)(O0b + ooff);
  r.nn0 = *(const u32x2*)(NBb + noff);
  r.nn1 = *(const u32x2*)(NBb + (noff + 16));
  if (TYPE == 1) {
    const u16* Mb = (const u16*)(p.ws + W_MNEG) + (size_t)ii * 16384;
#pragma unroll
    for (int ks = 0; ks < 4; ++ks) r.Am[ks] = *(const bf16x8*)(Mb + (moff + ks * 32));
  }
  r.dd = *(const f32x4*)((const float*)(p.ws + W_DVEC) + (size_t)ti * 128 + doff);
}
__device__ __forceinline__ void unpack4(u32x2 u, float (&v)[4]) {
  v[0] = bf2f((u16)(u[0] & 0xffff)); v[1] = bf2f((u16)(u[0] >> 16));
  v[2] = bf2f((u16)(u[1] & 0xffff)); v[3] = bf2f((u16)(u[1] >> 16));
}

template <int TYPE>
__device__ void scan_unit(const Params& p, char* smem, int rem) {
  const int tid = opaque_tid(), lane = tid & 63, w = tid >> 6;
  const int lr = lane & 15, lq = lane >> 4;
  const int b = rem >> 4, h = (rem >> 2) & 3, vs2 = rem & 3;
  const int tr = lq * 4 + (lane & 3), tc4 = lr & 12;
  const int otr = w & 3, otc = w >> 2;
  float* OPRE = (float*)(p.ws + W_PQ);
  u16* SbT = (u16*)smem;
  for (int i = tid; i < 2 * 32 * 136; i += 512) SbT[i] = 0;
  f32x4 S0 = {0.f, 0.f, 0.f, 0.f}, S1 = {0.f, 0.f, 0.f, 0.f};
  const unsigned qoff = (unsigned)((otr * 16 + lr) * 128 + lq * 8);
  const unsigned ooff = (unsigned)((otr * 16 + tr) * 128 + vs2 * 32 + otc * 16 + tc4);
  const unsigned moff = (unsigned)((w * 16 + lr) * 128 + lq * 8);
  const unsigned noff = (unsigned)((w * 16 + tr) * 128 + vs2 * 32 + tc4);
  const unsigned doff = (unsigned)(w * 16 + lq * 4);
  float* const orow = OPRE + (size_t)(b * 2048 + otr * 16 + tr) * 1024 + TYPE * 512 + h * 128 + vs2 * 32 + otc * 16 + tc4;
  ScanRegs r0, r1, r2, r3;
  const int idx0 = (b * 32) * 4 + h;
  scan_load<TYPE>(r0, p, idx0 + 0, qoff, ooff, moff, noff, doff);
  scan_load<TYPE>(r1, p, idx0 + 4, qoff, ooff, moff, noff, doff);
  scan_load<TYPE>(r2, p, idx0 + 8, qoff, ooff, moff, noff, doff);
  scan_load<TYPE>(r3, p, idx0 + 12, qoff, ooff, moff, noff, doff);
  __builtin_amdgcn_sched_barrier(0);
#define SCAN_STEP(R, c) { \
    RAW_BARRIER(); \
    const u16* Sb = SbT + ((c) & 1) * 32 * 136 + lr * 136 + lq * 8; \
    bf16x8 B0[4], B1[4], Bo[4]; \
    _Pragma("unroll") for (int ks = 0; ks < 4; ++ks) { \
      B0[ks] = *(const bf16x8*)(Sb + ks * 32); \
      B1[ks] = *(const bf16x8*)(Sb + 16 * 136 + ks * 32); \
      Bo[ks] = *(const bf16x8*)(Sb + otc * 16 * 136 + ks * 32); } \
    { \
      float ov[4]; unpack4(R.o0, ov); quad_transpose(ov, lane); \
      f32x4 acc = {ov[0], ov[1], ov[2], ov[3]}; \
      _Pragma("unroll") for (int ks = 0; ks < 4; ++ks) acc = mfma16(R.Aq[ks], Bo[ks], acc); \
      float o[4] = {acc[0], acc[1], acc[2], acc[3]}; \
      quad_transpose(o, lane); \
      *(f32x4*)(orow + (size_t)(c) * 65536) = f32x4{o[0], o[1], o[2], o[3]}; \
    } \
    float n0[4], n1[4]; unpack4(R.nn0, n0); unpack4(R.nn1, n1); \
    quad_transpose(n0, lane); quad_transpose(n1, lane); \
    f32x4 T0, T1; \
    _Pragma("unroll") for (int j = 0; j < 4; ++j) { T0[j] = R.dd[j] * S0[j] + n0[j]; T1[j] = R.dd[j] * S1[j] + n1[j]; } \
    if (TYPE == 1) { _Pragma("unroll") for (int ks = 0; ks < 4; ++ks) { T0 = mfma16(R.Am[ks], B0[ks], T0); T1 = mfma16(R.Am[ks], B1[ks], T1); } } \
    S0 = T0; S1 = T1; \
    u16* Sw = SbT + (((c) + 1) & 1) * 32 * 136 + lr * 136 + w * 16 + lq * 4; \
    *(u32x2*)(Sw) = u32x2{pack2(S0[0], S0[1]), pack2(S0[2], S0[3])}; \
    *(u32x2*)(Sw + 16 * 136) = u32x2{pack2(S1[0], S1[1]), pack2(S1[2], S1[3])}; \
    __builtin_amdgcn_sched_barrier(0); \
    scan_load<TYPE>(R, p, idx0 + (((c) + 4 < 32) ? (c) + 4 : 31) * 4, qoff, ooff, moff, noff, doff); \
    __builtin_amdgcn_sched_barrier(0); \
  }
  for (int c0 = 0; c0 < 32; c0 += 4) {
    SCAN_STEP(r0, c0)
    SCAN_STEP(r1, c0 + 1)
    SCAN_STEP(r2, c0 + 2)
    SCAN_STEP(r3, c0 + 3)
  }
#undef SCAN_STEP
  float* so = p.out + (TYPE ? O_GDP : O_HGP) + (size_t)(b * 4 + h) * 16384 + (w * 16 + tr) * 128 + vs2 * 32 + tc4;
  {
    float sv[4] = {S0[0], S0[1], S0[2], S0[3]};
    quad_transpose(sv, lane);
    *(f32x4*)(so) = f32x4{sv[0], sv[1], sv[2], sv[3]};
    float sw[4] = {S1[0], S1[1], S1[2], S1[3]};
    quad_transpose(sw, lane);
    *(f32x4*)(so + 16) = f32x4{sw[0], sw[1], sw[2], sw[3]};
  }
  __syncthreads();
}

__device__ void sample_item(const Params& p, char* smem, int it) {
  const int tid = opaque_tid(), lane = tid & 63, w = tid >> 6;
  const int type = it >> 9, b = (it >> 2) & 127, h = it & 3;
  const int row = MP + b;
  const u16* PQ = (const u16*)(p.ws + W_PQ);
  const float* LF = (const float*)(p.ws + W_LF);
  const float* BETA = (const float*)(p.ws + W_BETA);
  const float* GDEC = (const float*)(p.ws + W_GDEC);
  float* OPRE = (float*)(p.ws + W_PQ);
  float* fq = (float*)smem;
  float* fk = fq + 128;
  float* fv = fk + 128;
  float* fe = fv + 128;
  float* red = fe + 128;
  float* sc = red + 1024;
  const int n = tid & 127, kp = tid >> 7;
  if (type == 0) {
    if (tid < 128) {
      const float lf = LF[(size_t)row * 512 + h * 128 + tid];
      const float f = __expf(lf);
      fe[tid] = f;
      fk[tid] = 1.f - f;
      fq[tid] = bf2f(PQ[(size_t)row * PQW + h * 128 + tid]);
      fv[tid] = bf2f(PQ[(size_t)row * PQW + 512 + h * 128 + tid]);
    }
    __syncthreads();
    const float* S = p.state_hgrn + ((size_t)(b * 4 + h) * 128) * 128;
    float* So = p.out + O_HGS + ((size_t)(b * 4 + h) * 128) * 128;
    const float vn = fv[n];
    float o = 0.f;
#pragma unroll
    for (int i = 0; i < 32; ++i) {
      const int k = kp * 32 + i;
      const float sn = fe[k] * S[k * 128 + n] + fk[k] * vn;
      So[k * 128 + n] = sn;
      o += fq[k] * sn;
    }
    red[kp * 128 + n] = o;
    __syncthreads();
    if (tid < 128) OPRE[(size_t)row * 1024 + h * 128 + tid] = red[tid] + red[128 + tid] + red[256 + tid] + red[384 + tid];
    __syncthreads();
  } else {
    const float* cprev = p.state_conv + (size_t)b * 3 * 1536;
    if (tid < 384) {
      const int ty = tid >> 7, cc = tid & 127;
      const int ch = ty * 512 + h * 128 + cc;
      const float p0 = cprev[ch], p1 = cprev[1536 + ch], p2 = cprev[3072 + ch];
      const float nw = bf2f(PQ[(size_t)row * PQW + 1024 + ch]);
      const float s = p.conv_w[ch] * p0 + p.conv_w[1536 + ch] * p1 + p.conv_w[3072 + ch] * p2 + p.conv_w[4608 + ch] * nw;
      fq[ty * 128 + cc] = siluf_(s);
      p.out[O_CVS + (size_t)(b * 3 + 0) * 1536 + ch] = p1;
      p.out[O_CVS + (size_t)(b * 3 + 1) * 1536 + ch] = p2;
    }
    __syncthreads();
    if (w < 2) {
      const float a0 = fq[w * 128 + lane], a1 = fq[w * 128 + 64 + lane];
      const float ss = wave_sum(a0 * a0 + a1 * a1);
      if (lane == 0) sc[w] = ss;
    }
    __syncthreads();
    const float rq = rsqrtf(sc[0] + EPS) * 0.08838834764831845f;
    const float rk = rsqrtf(sc[1] + EPS);
    __syncthreads();
    if (tid < 128) fq[tid] *= rq;
    else if (tid < 256) fk[tid - 128] *= rk;
    __syncthreads();
    if (w == 0) {
      const float qk = wave_sum(fq[lane] * fk[lane] + fq[64 + lane] * fk[64 + lane]);
      if (lane == 0) sc[2] = qk;
    }
    const float eg = __expf(GDEC[(size_t)row * 4 + h]);
    const float beta = BETA[(size_t)row * 4 + h];
    const float* S = p.state_gdn + ((size_t)(b * 4 + h) * 128) * 128;
    float* So = p.out + O_GDS + ((size_t)(b * 4 + h) * 128) * 128;
    float sd[32];
    float ks_ = 0.f, qs_ = 0.f;
#pragma unroll
    for (int i = 0; i < 32; ++i) {
      const int k = kp * 32 + i;
      sd[i] = eg * S[k * 128 + n];
      ks_ += fk[k] * sd[i];
      qs_ += fq[k] * sd[i];
    }
    red[kp * 128 + n] = ks_;
    red[512 + kp * 128 + n] = qs_;
    __syncthreads();
    const float kS = red[n] + red[128 + n] + red[256 + n] + red[384 + n];
    const float delta = (fv[n] - kS) * beta;
#pragma unroll
    for (int i = 0; i < 32; ++i) {
      const int k = kp * 32 + i;
      So[k * 128 + n] = sd[i] + fk[k] * delta;
    }
    if (tid < 128) {
      const float qS = red[512 + n] + red[640 + n] + red[768 + n] + red[896 + n];
      OPRE[(size_t)row * 1024 + 512 + h * 128 + n] = qS + sc[2] * delta;
    }
    __syncthreads();
  }
}

__device__ void phase3(const Params& p, char* smem, int bid, int nb) {
  for (int u = bid; u < 256; u += nb) {
    int uu = u;
    if (nb == 256) {
      const int xcd = u & 7, j = u >> 3;
      uu = ((xcd * 8 + (j >> 2)) << 2) | (j & 3);
    }
    if (uu < 128) scan_unit<0>(p, smem, uu); else scan_unit<1>(p, smem, uu - 128);
    if (DUP_MASK & 256) { if (uu < 128) scan_unit<0>(p, smem, uu); else scan_unit<1>(p, smem, uu - 128); }
  }
  for (int it = bid; it < 1024; it += nb) sample_item(p, smem, it);
}

__device__ void phase4(const Params& p, int bid, int nb) {
  const int tid = opaque_tid(), lane = tid & 63, w = tid >> 6;
  const float* OPRE = (const float*)(p.ws + W_PQ);
  const u16* GATES = (const u16*)(p.ws + W_GATES);
  u16* A2 = (u16*)(p.ws + W_QS);
  for (int g = bid; g < MT / 8; g += nb) {
    const int row = g * 8 + w;
#pragma unroll
    for (int i = 0; i < 4; ++i) {
      const int col = i * 256 + lane * 4;
      const float4 v = *(const float4*)(OPRE + (size_t)row * 1024 + col);
      float ss = v.x * v.x + v.y * v.y + v.z * v.z + v.w * v.w;
#pragma unroll
      for (int o = 16; o > 0; o >>= 1) ss += __shfl_xor(ss, o, 64);
      const float rstd = rsqrtf(ss * (1.f / 128.f) + EPS);
      const int cn = col & 127;
      const float4 nw = *(const float4*)((col < 512 ? p.hg_norm : p.gdn_norm) + cn);
      const uint2 gt = *(const uint2*)(GATES + (size_t)row * 1024 + col);
      const float g0 = bf2f((u16)(gt.x & 0xffff)), g1 = bf2f((u16)(gt.x >> 16));
      const float g2 = bf2f((u16)(gt.y & 0xffff)), g3 = bf2f((u16)(gt.y >> 16));
      *(uint2*)(A2 + (size_t)row * 1024 + col) =
          make_uint2(pack2(v.x * rstd * nw.x * g0, v.y * rstd * nw.y * g1), pack2(v.z * rstd * nw.z * g2, v.w * rstd * nw.w * g3));
    }
  }
}

__device__ void phase6(const Params& p, int bid, int nb) {
  const int tid = opaque_tid(), lane = tid & 63, w = tid >> 6;
  for (int g = bid; g < MT / 8; g += nb) {
    const int row = g * 8 + w;
    float* y = row < MP ? p.out + O_YP + (size_t)row * 1024 : p.out + O_YS + (size_t)(row - MP) * 1024;
    float4 xv[4];
    float ss = 0.f;
#pragma unroll
    for (int i = 0; i < 4; ++i) {
      xv[i] = *(const float4*)(y + i * 256 + lane * 4);
      ss += xv[i].x * xv[i].x + xv[i].y * xv[i].y + xv[i].z * xv[i].z + xv[i].w * xv[i].w;
    }
    ss = wave_sum(ss);
    const float rstd = rsqrtf(ss * (1.f / 1024.f) + EPS);
#pragma unroll
    for (int i = 0; i < 4; ++i) {
      const float4 nw = *(const float4*)(p.final_norm + i * 256 + lane * 4);
      float4 o;
      o.x = xv[i].x * rstd * nw.x; o.y = xv[i].y * rstd * nw.y; o.z = xv[i].z * rstd * nw.z; o.w = xv[i].w * rstd * nw.w;
      *(float4*)(y + i * 256 + lane * 4) = o;
    }
  }
}

template <int PH>
__device__ __forceinline__ void run_phase(const Params& p, char* smem, int bid, int nb) {
  if (PH == 0) phase0(p, smem, bid, nb);
  else if (PH == 1) gemm_phase<0>(p, (const u16*)(p.ws + W_H), (const u16*)(p.ws + W_WINT), 16, smem, bid, nb);
  else if (PH == 2) phase2(p, smem, bid, nb);
  else if (PH == 3) phase3(p, smem, bid, nb);
  else if (PH == 4) phase4(p, bid, nb);
  else if (PH == 5) gemm_phase<1>(p, (const u16*)(p.ws + W_QS), (const u16*)(p.ws + W_WOUTT), 4, smem, bid, nb);
  else phase6(p, bid, nb);
}

#if MEGA
__global__ void __launch_bounds__(NTH) mega_kernel(Params p) {
  extern __shared__ __attribute__((aligned(16))) char smem[];
  cg::grid_group grid = cg::this_grid();
  const int bid = blockIdx.x, nb = gridDim.x;
#define RUNP(k) run_phase<k>(p, smem, bid, nb); grid.sync(); if (DUP_MASK & (1 << k)) { run_phase<k>(p, smem, bid, nb); grid.sync(); }
  RUNP(0) RUNP(1) RUNP(2) RUNP(3) RUNP(4) RUNP(5)
#undef RUNP
  run_phase<6>(p, smem, bid, nb);
}
#else
template <int PH>
__global__ void __launch_bounds__(NTH) phase_kernel(Params p) {
  extern __shared__ __attribute__((aligned(16))) char smem[];
  run_phase<PH>(p, smem, blockIdx.x, gridDim.x);
}
template <int PH>
static void launch_phase(const Params& p, int grid, hipStream_t stream) {
  hipFuncSetAttribute((const void*)phase_kernel<PH>, hipFuncAttributeMaxDynamicSharedMemorySize, (int)LDS_BYTES);
  hipLaunchKernelGGL(phase_kernel<PH>, dim3(grid), dim3(NTH), LDS_BYTES, stream, p);
}
#endif

extern "C" void kernel_launch(void* const* d_in, const int* in_sizes, int n_in, void* d_out, int out_size,
                              void* d_ws, size_t ws_size, hipStream_t stream) {
  Params p{};
  p.x_prompt = (const float*)d_in[0];
  p.x_sample = (const float*)d_in[1];
  p.state_hgrn = (const float*)d_in[2];
  p.state_gdn = (const float*)d_in[3];
  p.state_conv = (const float*)d_in[4];
  p.norm_w = (const float*)d_in[5];
  p.w_in = (const float*)d_in[6];
  p.lb_logits = (const float*)d_in[7];
  p.conv_w = (const float*)d_in[8];
  p.a_log = (const float*)d_in[9];
  p.dt_bias = (const float*)d_in[10];
  p.hg_norm = (const float*)d_in[11];
  p.gdn_norm = (const float*)d_in[12];
  p.w_out = (const float*)d_in[13];
  p.final_norm = (const float*)d_in[14];
  p.out = (float*)d_out;
  p.ws = (char*)d_ws;
  if (ws_size < W_END) { fprintf(stderr, "workspace too small: %zu < %zu\n", ws_size, (size_t)W_END); return; }
#if MEGA
  static int grid_blocks = 0;
  if (!grid_blocks) {
    int dev = 0, cus = 0, per_cu = 0;
    hipGetDevice(&dev);
    hipDeviceGetAttribute(&cus, hipDeviceAttributeMultiprocessorCount, dev);
    hipFuncSetAttribute((const void*)mega_kernel, hipFuncAttributeMaxDynamicSharedMemorySize, (int)LDS_BYTES);
    hipOccupancyMaxActiveBlocksPerMultiprocessor(&per_cu, mega_kernel, NTH, LDS_BYTES);
    if (per_cu < 1) per_cu = 1;
    grid_blocks = cus * per_cu;
  }
  void* args[] = {&p};
  hipError_t e = hipLaunchCooperativeKernel((void*)mega_kernel, dim3(grid_blocks), dim3(NTH), args, LDS_BYTES, stream);
  if (e != hipSuccess) fprintf(stderr, "cooperative launch failed: %s (grid %d)\n", hipGetErrorString(e), grid_blocks);
#else
  const int grid = 256;
  launch_phase<0>(p, grid, stream);
  launch_phase<1>(p, grid, stream);
  launch_phase<2>(p, grid, stream);
  launch_phase<3>(p, grid, stream);
  launch_phase<4>(p, grid, stream);
  launch_phase<5>(p, grid, stream);
  launch_phase<6>(p, grid, stream);
#endif
}
```

```cpp
#include <hip/hip_runtime.h>
#include <hip/hip_cooperative_groups.h>
#include <cstdio>
namespace cg = cooperative_groups;

#ifndef MEGA
#define MEGA 1
#define DUP_MASK 0
#endif

typedef unsigned short u16;
using bf16x8 = __attribute__((ext_vector_type(8))) short;
using f32x4 = __attribute__((ext_vector_type(4))) float;
using u32x4 = __attribute__((ext_vector_type(4))) unsigned;
using u32x2 = __attribute__((ext_vector_type(2))) unsigned;

#define NTH 512
constexpr int MP = 16384, MS = 128, MT = 16512, DM = 1024, DIN = 4104, PQW = 2560;
constexpr float EPS = 1e-6f;
constexpr int LDK = 1088;
constexpr size_t LDS_BYTES = 139264;

constexpr size_t O_YP = 0, O_YS = 16777216, O_HGP = 16908288, O_GDP = 17432576, O_CVP = 17956864,
                 O_HGS = 17993728, O_GDS = 26382336, O_CVS = 34770944;
constexpr size_t W_WINT = 0;
constexpr size_t W_WOUTT = W_WINT + (size_t)4096 * LDK * 2;
constexpr size_t W_BETA = W_WOUTT + (size_t)1024 * LDK * 2;
constexpr size_t W_GDEC = W_BETA + 264192;
constexpr size_t W_DVEC = W_GDEC + 264192;
constexpr size_t W_DSC = W_DVEC + 1048576;
constexpr size_t W_PQ = W_DSC + 4096;
constexpr size_t W_GATES = W_PQ + 84541440;
constexpr size_t W_H = W_GATES + 33816576;
constexpr size_t W_QS = W_H + (size_t)MT * LDK * 2;
constexpr size_t W_MNEG = W_QS + 33554432;
constexpr size_t W_LF = W_MNEG + 33554432;
constexpr size_t W_END = W_LF + 33816576;

struct Params {
  const float *x_prompt, *x_sample, *state_hgrn, *state_gdn, *state_conv, *norm_w, *w_in, *lb_logits,
      *conv_w, *a_log, *dt_bias, *hg_norm, *gdn_norm, *w_out, *final_norm;
  float* out;
  char* ws;
};

__device__ __forceinline__ int opaque_tid() { int t = threadIdx.x; asm volatile("" : "+v"(t)); return t; }
typedef __bf16 bf16x2_t __attribute__((ext_vector_type(2)));
typedef float f32x2_t __attribute__((ext_vector_type(2)));
__device__ __forceinline__ u16 f2bf(float x) { return __builtin_bit_cast(u16, (__bf16)x); }
__device__ __forceinline__ float bf2f(u16 h) { return __uint_as_float(((unsigned)h) << 16); }
__device__ __forceinline__ unsigned pack2(float a, float b) {
  f32x2_t v = {a, b};
  return __builtin_bit_cast(unsigned, __builtin_convertvector(v, bf16x2_t));
}
template <int CTRL, int ROWMASK>
__device__ __forceinline__ float dpp_mov(float v) {
  return __builtin_bit_cast(float, __builtin_amdgcn_update_dpp(0, __builtin_bit_cast(int, v), CTRL, ROWMASK, 0xf, false));
}
__device__ __forceinline__ float wave_sum(float v) {
  v += dpp_mov<0xB1, 0xf>(v);
  v += dpp_mov<0x4E, 0xf>(v);
  v += dpp_mov<0x141, 0xf>(v);
  v += dpp_mov<0x140, 0xf>(v);
  v += dpp_mov<0x142, 0xa>(v);
  v += dpp_mov<0x143, 0xc>(v);
  return __builtin_bit_cast(float, __builtin_amdgcn_readlane(__builtin_bit_cast(int, v), 63));
}
__device__ __forceinline__ float sigmoidf_(float x) { return 1.f / (1.f + __expf(-x)); }
__device__ __forceinline__ float siluf_(float x) { return x / (1.f + __expf(-x)); }
__device__ __forceinline__ f32x4 mfma16(bf16x8 a, bf16x8 b, f32x4 c) {
  return __builtin_amdgcn_mfma_f32_16x16x32_bf16(a, b, c, 0, 0, 0);
}
__device__ __forceinline__ bf16x8 frag(const u16* base, int row0, int stride, int koff, int lane) {
  return *(const bf16x8*)(base + (row0 + (lane & 15)) * stride + koff + (lane >> 4) * 8);
}

__device__ __forceinline__ void quad_transpose(float (&v)[4], int lane) {
  {
    const bool b = lane & 1;
    float s0 = b ? v[0] : v[1], s1 = b ? v[2] : v[3];
    float r0 = dpp_mov<0xB1, 0xf>(s0), r1 = dpp_mov<0xB1, 0xf>(s1);
    if (b) { v[0] = r0; v[2] = r1; } else { v[1] = r0; v[3] = r1; }
  }
  {
    const bool b = lane & 2;
    float s0 = b ? v[0] : v[2], s1 = b ? v[1] : v[3];
    float r0 = dpp_mov<0x4E, 0xf>(s0), r1 = dpp_mov<0x4E, 0xf>(s1);
    if (b) { v[0] = r0; v[1] = r1; } else { v[2] = r0; v[3] = r1; }
  }
}
__device__ __forceinline__ void store4_bf16(u16* dst, const float (&v)[4]) {
  *(u32x2*)dst = u32x2{pack2(v[0], v[1]), pack2(v[2], v[3])};
}
__device__ void phase0(const Params& p, char* smem, int bid, int nb) {
  const int tid = opaque_tid(), lane = tid & 63, w = tid >> 6;
  u16* WinT = (u16*)(p.ws + W_WINT);
  u16* WoutT = (u16*)(p.ws + W_WOUTT);
  u16* H = (u16*)(p.ws + W_H);
  float* BETA = (float*)(p.ws + W_BETA);
  float* GDEC = (float*)(p.ws + W_GDEC);
  float* tl = (float*)smem;
  for (int t = bid; t < 1280; t += nb) {
    const float* src; int sstride; u16* dst; int kt, nt;
    if (t < 1024) { src = p.w_in; sstride = DIN; dst = WinT; kt = t >> 6; nt = t & 63; }
    else { int u = t - 1024; src = p.w_out; sstride = 1024; dst = WoutT; kt = u >> 4; nt = u & 15; }
#pragma unroll
    for (int i = 0; i < 8; ++i) {
      int idx = tid + 512 * i; int kk = idx >> 6, nn = idx & 63;
      tl[kk * 65 + nn] = src[(size_t)(kt * 64 + kk) * sstride + nt * 64 + nn];
    }
    __syncthreads();
    {
      int nn = tid >> 3, k8 = (tid & 7) * 8;
      unsigned pk[4];
#pragma unroll
      for (int e = 0; e < 4; ++e) pk[e] = pack2(tl[(k8 + 2 * e) * 65 + nn], tl[(k8 + 2 * e + 1) * 65 + nn]);
      *(uint4*)(dst + (size_t)(nt * 64 + nn) * LDK + kt * 64 + k8) = make_uint4(pk[0], pk[1], pk[2], pk[3]);
    }
    __syncthreads();
  }
  float* W8s = (float*)smem;
  for (int idx = tid; idx < 8192; idx += 512) {
    int j = idx & 7, k = idx >> 3;
    W8s[j * 1024 + k] = p.w_in[(size_t)k * DIN + 4096 + j];
  }
  __syncthreads();
  for (int g = bid; g < MT / 8; g += nb) {
    int row = g * 8 + w;
    const float* x = row < MP ? p.x_prompt + (size_t)row * 1024 : p.x_sample + (size_t)(row - MP) * 1024;
    float4 xv[4];
    float ss = 0.f;
#pragma unroll
    for (int i = 0; i < 4; ++i) {
      xv[i] = *(const float4*)(x + i * 256 + lane * 4);
      ss += xv[i].x * xv[i].x + xv[i].y * xv[i].y + xv[i].z * xv[i].z + xv[i].w * xv[i].w;
    }
    ss = wave_sum(ss);
    float rstd = rsqrtf(ss * (1.f / 1024.f) + EPS);
    float d0 = 0, d1 = 0, d2 = 0, d3 = 0, d4 = 0, d5 = 0, d6 = 0, d7 = 0;
#pragma unroll
    for (int i = 0; i < 4; ++i) {
      float4 nw = *(const float4*)(p.norm_w + i * 256 + lane * 4);
      float4 hv;
      hv.x = xv[i].x * rstd * nw.x; hv.y = xv[i].y * rstd * nw.y; hv.z = xv[i].z * rstd * nw.z; hv.w = xv[i].w * rstd * nw.w;
      *(uint2*)(H + (size_t)row * LDK + i * 256 + lane * 4) = make_uint2(pack2(hv.x, hv.y), pack2(hv.z, hv.w));
#define GDOT(j, dj) { float4 wv = *(const float4*)(W8s + j * 1024 + i * 256 + lane * 4); dj += hv.x * wv.x + hv.y * wv.y + hv.z * wv.z + hv.w * wv.w; }
      GDOT(0, d0) GDOT(1, d1) GDOT(2, d2) GDOT(3, d3) GDOT(4, d4) GDOT(5, d5) GDOT(6, d6) GDOT(7, d7)
#undef GDOT
    }
    d0 = wave_sum(d0); d1 = wave_sum(d1); d2 = wave_sum(d2); d3 = wave_sum(d3);
    d4 = wave_sum(d4); d5 = wave_sum(d5); d6 = wave_sum(d6); d7 = wave_sum(d7);
    if (lane < 4) {
      float gb = lane == 0 ? d0 : lane == 1 ? d1 : lane == 2 ? d2 : d3;
      float ga = lane == 0 ? d4 : lane == 1 ? d5 : lane == 2 ? d6 : d7;
      BETA[row * 4 + lane] = 1.f / (1.f + expf(-gb));
      float z = ga + p.dt_bias[lane];
      float sp = z > 20.f ? z : log1pf(expf(z));
      GDEC[row * 4 + lane] = -expf(p.a_log[lane]) * sp;
    }
  }
  __syncthreads();
}

__device__ __forceinline__ int lds_byte2(int r, int c) {
  int st = (r >> 4) * 2 + (c >> 5), ob = (r & 15) * 64 + (c & 31) * 2;
  return st * 1024 + (ob ^ (((ob >> 9) & 1) << 5));
}
__device__ __forceinline__ void stage_rc2(int b, int& R, int& C) {
  int st = b >> 10, sb = b & 1023, swz = sb ^ (((sb >> 9) & 1) << 5);
  R = (st >> 1) * 16 + swz / 64;
  C = (st & 1) * 32 + (swz % 64) / 2;
}
template <int EPI, int SEC>
__device__ __forceinline__ void epi_store4(const Params& p, int row, int col4, const float (&v)[4]) {
  if (EPI == 0) {
    u16* PQ = (u16*)(p.ws + W_PQ);
    u16* GATES = (u16*)(p.ws + W_GATES);
    float* LF = (float*)(p.ws + W_LF);
    const int sec = SEC >= 0 ? SEC : (col4 >> 9);
    if (sec == 0) {
      *(uint2*)(PQ + (size_t)row * PQW + col4) = make_uint2(pack2(v[0], v[1]), pack2(v[2], v[3]));
    } else if (sec == 1) {
      const int cc = col4 - 512;
      const f32x4 l0 = *(const f32x4*)(p.lb_logits + cc), l1 = *(const f32x4*)(p.lb_logits + 512 + cc);
      f32x4 o;
#pragma unroll
      for (int i = 0; i < 4; ++i) {
        const float lbv = 1.f / (1.f + __expf(l1[i] - l0[i]));
        o[i] = __logf(lbv + (1.f - lbv) / (1.f + __expf(-v[i])));
      }
      *(f32x4*)(LF + (size_t)row * 512 + cc) = o;
    } else if (sec == 2) {
      *(uint2*)(PQ + (size_t)row * PQW + 512 + (col4 - 1024)) = make_uint2(pack2(v[0], v[1]), pack2(v[2], v[3]));
    } else if (sec == 3 || sec == 7) {
      const int cc = sec == 3 ? col4 - 1536 : 512 + col4 - 3584;
      *(uint2*)(GATES + (size_t)row * 1024 + cc) =
          make_uint2(pack2(v[0] / (1.f + __expf(-v[0])), v[1] / (1.f + __expf(-v[1]))),
                     pack2(v[2] / (1.f + __expf(-v[2])), v[3] / (1.f + __expf(-v[3]))));
    } else {
      const int cc = col4 - 2048;
      *(uint2*)(PQ + (size_t)row * PQW + 1024 + cc) = make_uint2(pack2(v[0], v[1]), pack2(v[2], v[3]));
      if (row < MP) {
        const int tt = row & 2047;
        if (tt >= 2045) *(f32x4*)(p.out + O_CVP + (size_t)((row >> 11) * 3 + (tt - 2045)) * 1536 + cc) = f32x4{v[0], v[1], v[2], v[3]};
      } else {
        *(f32x4*)(p.out + O_CVS + (size_t)((row - MP) * 3 + 2) * 1536 + cc) = f32x4{v[0], v[1], v[2], v[3]};
      }
    }
  } else {
    const float* xr = row < MP ? p.x_prompt + (size_t)row * 1024 : p.x_sample + (size_t)(row - MP) * 1024;
    float* yr = row < MP ? p.out + O_YP + (size_t)row * 1024 : p.out + O_YS + (size_t)(row - MP) * 1024;
    const f32x4 xv = *(const f32x4*)(xr + col4);
    *(f32x4*)(yr + col4) = f32x4{xv[0] + v[0], xv[1] + v[1], xv[2] + v[2], xv[3] + v[3]};
  }
}

template <int EPI>
__device__ void gemm_phase(const Params& p, const u16* __restrict__ A, const u16* __restrict__ Bt, int ntn,
                           char* smem, int bid, int nb) {
  const int tid = opaque_tid(), lane = tid & 63, wid = tid >> 6;
  const int wr = wid >> 2, wc = wid & 3, fr = lane & 15, fq = lane >> 4;
  constexpr int TILE_B = 256 * 64 * 2, STAGE_B = 2 * TILE_B;
  int sR0, sC0;
  stage_rc2(wid * 1024 + lane * 16, sR0, sC0);
  const unsigned goff = (unsigned)(sR0 * LDK + sC0);
  const unsigned lbase = (unsigned)(size_t)smem + (unsigned)(wid * 1024);
  const int aoff = (wr * 16) * 1024 + ((fr * 64 + fq * 16) ^ ((((fr * 64 + fq * 16) >> 9) & 1) << 5));
  const int boff = TILE_B + (wc * 8) * 1024 + ((fr * 64 + fq * 16) ^ ((((fr * 64 + fq * 16) >> 9) & 1) << 5));
  const int ntiles = 64 * ntn;
  for (int tile = bid; tile < ntiles; tile += nb) {
    int tm, tn;
    {
      const int rnd = tile >> 8, t = tile & 255, xcd = t & 7, j = t >> 3;
      if (ntn == 16) { tm = rnd * 16 + (xcd >> 1) * 4 + (j & 3); tn = (xcd & 1) * 8 + (j >> 2); }
      else { tm = xcd * 8 + (j & 7); tn = j >> 3; }
    }
    const u16* Ab = A + (size_t)tm * 256 * LDK;
    const u16* Bb = Bt + (size_t)tn * 256 * LDK;
    f32x4 acc[8][4];
#pragma unroll
    for (int m = 0; m < 8; ++m)
#pragma unroll
      for (int n = 0; n < 4; ++n) acc[m][n] = f32x4{0.f, 0.f, 0.f, 0.f};
#define G_STAGE(buf, kt) { _Pragma("unroll") for (int i = 0; i < 4; ++i) { \
      __builtin_amdgcn_global_load_lds((const unsigned*)(Ab + (goff + (unsigned)(i * 64 * LDK + (kt) * 64))), \
          (__attribute__((address_space(3))) unsigned*)(lbase + (buf) * STAGE_B + i * 8192), 16, 0, 0); \
      __builtin_amdgcn_global_load_lds((const unsigned*)(Bb + (goff + (unsigned)(i * 64 * LDK + (kt) * 64))), \
          (__attribute__((address_space(3))) unsigned*)(lbase + (buf) * STAGE_B + TILE_B + i * 8192), 16, 0, 0); } }
    G_STAGE(0, 0);
    asm volatile("s_waitcnt vmcnt(0)" ::: "memory");
    __syncthreads();
    for (int t = 0; t < 16; ++t) {
      const int cur = t & 1;
      if (t + 1 < 16) G_STAGE(cur ^ 1, t + 1);
      const char* sA = smem + cur * STAGE_B + aoff;
      const char* sB = smem + cur * STAGE_B + boff;
#pragma unroll
      for (int ks = 0; ks < 2; ++ks) {
        bf16x8 At[8], Bf[4];
#pragma unroll
        for (int m = 0; m < 8; ++m) At[m] = *(const bf16x8*)(sA + (m * 2 + ks) * 1024);
#pragma unroll
        for (int n = 0; n < 4; ++n) Bf[n] = *(const bf16x8*)(sB + (n * 2 + ks) * 1024);
#pragma unroll
        for (int m = 0; m < 8; ++m)
#pragma unroll
          for (int n = 0; n < 4; ++n) acc[m][n] = mfma16(At[m], Bf[n], acc[m][n]);
        __builtin_amdgcn_sched_barrier(0);
      }
      asm volatile("s_waitcnt vmcnt(0)" ::: "memory");
      __syncthreads();
    }
#undef G_STAGE
    {
      int t2 = threadIdx.x;
      asm volatile("" : "+v"(t2));
      const int lane2 = t2 & 63, wid2 = t2 >> 6;
      const int rbase = tm * 256 + (wid2 >> 2) * 128 + (lane2 >> 4) * 4 + (lane2 & 3);
      const int cbase = tn * 256 + (wid2 & 3) * 64 + (lane2 & 12);
#define EPI_LOOP(SEC) { _Pragma("unroll") for (int m = 0; m < 8; ++m) { _Pragma("unroll") for (int n = 0; n < 4; ++n) { \
          float v[4] = {acc[m][n][0], acc[m][n][1], acc[m][n][2], acc[m][n][3]}; \
          quad_transpose(v, lane2); \
          epi_store4<EPI, SEC>(p, rbase + m * 16, cbase + n * 16, v); } } }
      if (EPI == 0) {
        const int sec = tn >> 1;
        if (sec == 0) EPI_LOOP(0) else if (sec == 1) EPI_LOOP(1) else if (sec == 2) EPI_LOOP(2)
        else if (sec == 3) EPI_LOOP(3) else if (sec == 7) EPI_LOOP(7) else EPI_LOOP(4)
      } else EPI_LOOP(0)
#undef EPI_LOOP
    }
  }
  const int nunits = ntn * 16;
  int t3 = threadIdx.x;
  asm volatile("" : "+v"(t3));
  for (int u = bid; u < nunits; u += nb) {
    const int lane = t3 & 63, wid = t3 >> 6, fr = lane & 15, fq = lane >> 4;
    const u16* ar = A + (size_t)(MP + wid * 16 + fr) * LDK + fq * 8;
    const u16* br = Bt + (size_t)(u * 16 + fr) * LDK + fq * 8;
    f32x4 acc0 = {0.f, 0.f, 0.f, 0.f}, acc1 = {0.f, 0.f, 0.f, 0.f};
#pragma unroll 4
    for (int ks = 0; ks < 32; ks += 2) {
      const bf16x8 a0 = *(const bf16x8*)(ar + ks * 32), b0 = *(const bf16x8*)(br + ks * 32);
      const bf16x8 a1 = *(const bf16x8*)(ar + ks * 32 + 32), b1 = *(const bf16x8*)(br + ks * 32 + 32);
      acc0 = mfma16(a0, b0, acc0);
      acc1 = mfma16(a1, b1, acc1);
    }
    float v[4] = {acc0[0] + acc1[0], acc0[1] + acc1[1], acc0[2] + acc1[2], acc0[3] + acc1[3]};
    quad_transpose(v, lane);
    epi_store4<EPI, -1>(p, MP + wid * 16 + fq * 4 + (lane & 3), u * 16 + (fr & ~3), v);
  }
  __syncthreads();
}

__device__ void hgrn_item(const Params& p, char* smem, int idx) {
  const int tid = opaque_tid(), lane = tid & 63, w = tid >> 6;
  const int lr = lane & 15, lq = lane >> 4;
  const int h = idx & 3, c = (idx >> 2) & 31, b = idx >> 7;
  const int r0 = b * 2048 + c * 64;
  const u16* PQ = (const u16*)(p.ws + W_PQ);
  const float* LF = (const float*)(p.ws + W_LF);
  u16* QS = (u16*)(p.ws + W_QS);
  u16* O0 = (u16*)(p.ws + W_H);
  u16* NB = (u16*)(p.out);
  float* DVEC = (float*)(p.ws + W_DVEC);
  u16* qt = (u16*)smem;
  u16* kt = qt + 64 * 136;
  u16* ktT = kt + 64 * 136;
  u16* vT = ktT + 128 * 72;
  u16* sc = vT + 128 * 72;
  float* ps = (float*)(sc + 64 * 72);
  const int col = tid & 127, part = tid >> 7;
  float lfv[16], bcum[16];
  {
    const float* lfp = LF + (size_t)(r0 + part * 16) * 512 + h * 128 + col;
#pragma unroll
    for (int i = 0; i < 16; ++i) lfv[i] = lfp[(size_t)i * 512];
    float run = 0.f;
#pragma unroll
    for (int i = 0; i < 16; ++i) { run += lfv[i]; bcum[i] = run; }
    ps[part * 128 + col] = run;
  }
  __syncthreads();
  {
    float off = 0.f, blast = 0.f;
#pragma unroll
    for (int pp = 0; pp < 4; ++pp) { float t = ps[pp * 128 + col]; blast += t; if (pp < part) off += t; }
    const u16* qp = PQ + (size_t)(r0 + part * 16) * PQW + h * 128 + col;
    u16* qsout = QS + ((size_t)idx * 64 + part * 16) * 128 + col;
#pragma unroll
    for (int i = 0; i < 16; ++i) {
      const float bb = bcum[i] + off;
      const int row = part * 16 + i;
      const float q = bf2f(qp[(size_t)i * PQW]);
      const u16 v = qp[(size_t)i * PQW + 512];
      qsout[i * 128] = f2bf(q * __expf(bb));
      qt[row * 136 + col] = f2bf(q * __expf(bb - blast));
      const float kk = (1.f - __expf(lfv[i])) * __expf(blast - bb);
      const u16 kbv = f2bf(kk);
      kt[row * 136 + col] = kbv;
      ktT[col * 72 + row] = kbv;
      vT[col * 72 + row] = v;
    }
    if (part == 0) DVEC[idx * 128 + col] = __expf(blast);
  }
  __syncthreads();
  {
    const int tr = w >> 1;
    bf16x8 a[4];
#pragma unroll
    for (int ks = 0; ks < 4; ++ks) a[ks] = frag(qt, tr * 16, 136, ks * 32, lane);
#pragma unroll
    for (int tci = 0; tci < 2; ++tci) {
      const int tc = (w & 1) * 2 + tci;
      f32x4 acc = {0.f, 0.f, 0.f, 0.f};
#pragma unroll
      for (int ks = 0; ks < 4; ++ks) acc = mfma16(a[ks], frag(kt, tc * 16, 136, ks * 32, lane), acc);
#pragma unroll
      for (int j = 0; j < 4; ++j) {
        const int t = tr * 16 + lq * 4 + j, s = tc * 16 + lr;
        sc[t * 72 + s] = f2bf(t >= s ? acc[j] : 0.f);
      }
    }
  }
  __syncthreads();
  {
    const int tr = w >> 1;
    const bf16x8 a0 = frag(sc, tr * 16, 72, 0, lane), a1 = frag(sc, tr * 16, 72, 32, lane);
#pragma unroll
    for (int tci = 0; tci < 4; ++tci) {
      const int tc = (w & 1) * 4 + tci;
      f32x4 acc = {0.f, 0.f, 0.f, 0.f};
      acc = mfma16(a0, frag(vT, tc * 16, 72, 0, lane), acc);
      acc = mfma16(a1, frag(vT, tc * 16, 72, 32, lane), acc);
      {
        float v[4] = {acc[0], acc[1], acc[2], acc[3]};
        quad_transpose(v, lane);
        store4_bf16(O0 + ((size_t)idx * 64 + tr * 16 + lq * 4 + (lane & 3)) * 128 + tc * 16 + (lr & 12), v);
      }
    }
  }
  {
    const int tr = w;
    const bf16x8 a0 = frag(ktT, tr * 16, 72, 0, lane), a1 = frag(ktT, tr * 16, 72, 32, lane);
#pragma unroll
    for (int tc = 0; tc < 8; ++tc) {
      f32x4 acc = {0.f, 0.f, 0.f, 0.f};
      acc = mfma16(a0, frag(vT, tc * 16, 72, 0, lane), acc);
      acc = mfma16(a1, frag(vT, tc * 16, 72, 32, lane), acc);
      {
        float v[4] = {acc[0], acc[1], acc[2], acc[3]};
        quad_transpose(v, lane);
        store4_bf16(NB + ((size_t)idx * 128 + tr * 16 + lq * 4 + (lane & 3)) * 128 + tc * 16 + (lr & 12), v);
      }
    }
  }
  __syncthreads();
}

template <int J>
struct SolveCol {
  static __device__ __forceinline__ void run(f32x4 (&x)[16], const float* AT) {
    if constexpr (J < 63) {
      const float xj = x[J / 4][J % 4];
#pragma unroll
      for (int B = (J + 1) / 4; B < 16; ++B) {
        const f32x4 av = *(const f32x4*)(AT + J * 64 + B * 4);
        x[B] -= av * xj;
      }
      if ((J & 3) == 3) __builtin_amdgcn_sched_barrier(0);
      SolveCol<J + 1>::run(x, AT);
    }
  }
};

__device__ void gdn_item(const Params& p, char* smem, int idx) {
  const int tid = opaque_tid(), lane = tid & 63, w = tid >> 6;
  const int lr = lane & 15, lq = lane >> 4;
  const int h = idx & 3, c = (idx >> 2) & 31, b = idx >> 7;
  const int r0 = b * 2048 + c * 64;
  const u16* PQ = (const u16*)(p.ws + W_PQ);
  const float* BETA = (const float*)(p.ws + W_BETA);
  const float* GDEC = (const float*)(p.ws + W_GDEC);
  u16* QS = (u16*)(p.ws + W_QS);
  u16* O0 = (u16*)(p.ws + W_H);
  u16* NB = (u16*)(p.out);
  u16* MNEG = (u16*)(p.ws + W_MNEG);
  float* DSC = (float*)(p.ws + W_DSC);
  u16* kb = (u16*)smem;
  u16* qb = kb + 64 * 136;
  u16* vS = qb + 64 * 136;
  float* Asol = (float*)(vS + 64 * 128);
  u16* attn = (u16*)(Asol + 64 * 64);
  u16* khT = attn + 64 * 72;
  u16* WT = khT + 128 * 72;
  u16* U0T = WT + 128 * 72;
  float* gc = (float*)(U0T + 128 * 72);
  float* bet = gc + 64;

  if (w == 0) {
    float g = GDEC[(size_t)(r0 + lane) * 4 + h];
#pragma unroll
    for (int o = 1; o < 64; o <<= 1) { float t = __shfl_up(g, o, 64); if (lane >= o) g += t; }
    gc[lane] = g;
    bet[lane] = BETA[(size_t)(r0 + lane) * 4 + h];
  }
  {
    const int chq = 1024 + h * 128 + 2 * lane;
    const int cwq = h * 128 + 2 * lane;
    float cw[3][4][2];
#pragma unroll
    for (int ty = 0; ty < 3; ++ty)
#pragma unroll
      for (int j = 0; j < 4; ++j) {
        float2 t2 = *(const float2*)(p.conv_w + j * 1536 + ty * 512 + cwq);
        cw[ty][j][0] = t2.x; cw[ty][j][1] = t2.y;
      }
    float win[3][3][2];
    const int t0 = w * 8;
#pragma unroll
    for (int a = 0; a < 3; ++a) {
      const int rr = t0 - 3 + a;
      const bool valid = (c > 0) || (rr >= 0);
#pragma unroll
      for (int ty = 0; ty < 3; ++ty) {
        unsigned u = 0;
        if (valid) u = *(const unsigned*)(PQ + (ptrdiff_t)(r0 + rr) * PQW + chq + ty * 512);
        win[ty][a][0] = bf2f((u16)(u & 0xffff)); win[ty][a][1] = bf2f((u16)(u >> 16));
      }
    }
#pragma unroll
    for (int tt = 0; tt < 8; ++tt) {
      const int t = t0 + tt;
      float cv[3][2];
#pragma unroll
      for (int ty = 0; ty < 3; ++ty) {
        unsigned u = *(const unsigned*)(PQ + (size_t)(r0 + t) * PQW + chq + ty * 512);
        float c0 = bf2f((u16)(u & 0xffff)), c1 = bf2f((u16)(u >> 16));
        float s0 = cw[ty][0][0] * win[ty][0][0] + cw[ty][1][0] * win[ty][1][0] + cw[ty][2][0] * win[ty][2][0] + cw[ty][3][0] * c0;
        float s1 = cw[ty][0][1] * win[ty][0][1] + cw[ty][1][1] * win[ty][1][1] + cw[ty][2][1] * win[ty][2][1] + cw[ty][3][1] * c1;
        win[ty][0][0] = win[ty][1][0]; win[ty][0][1] = win[ty][1][1];
        win[ty][1][0] = win[ty][2][0]; win[ty][1][1] = win[ty][2][1];
        win[ty][2][0] = c0; win[ty][2][1] = c1;
        cv[ty][0] = siluf_(s0); cv[ty][1] = siluf_(s1);
      }
      float ssq = wave_sum(cv[0][0] * cv[0][0] + cv[0][1] * cv[0][1]);
      float ssk = wave_sum(cv[1][0] * cv[1][0] + cv[1][1] * cv[1][1]);
      const float rq = rsqrtf(ssq + EPS) * 0.08838834764831845f;
      const float rk = rsqrtf(ssk + EPS);
      *(unsigned*)(qb + t * 136 + 2 * lane) = pack2(cv[0][0] * rq, cv[0][1] * rq);
      *(unsigned*)(kb + t * 136 + 2 * lane) = pack2(cv[1][0] * rk, cv[1][1] * rk);
      *(unsigned*)(vS + t * 128 + 2 * lane) = pack2(cv[2][0], cv[2][1]);
    }
  }
  __syncthreads();
  {
    const int which = w >> 2, tr = w & 3;
    const u16* Asrc = which ? qb : kb;
    bf16x8 a[4];
#pragma unroll
    for (int ks = 0; ks < 4; ++ks) a[ks] = frag(Asrc, tr * 16, 136, ks * 32, lane);
#pragma unroll
    for (int tc = 0; tc < 4; ++tc) {
      f32x4 acc = {0.f, 0.f, 0.f, 0.f};
#pragma unroll
      for (int ks = 0; ks < 4; ++ks) acc = mfma16(a[ks], frag(kb, tc * 16, 136, ks * 32, lane), acc);
#pragma unroll
      for (int j = 0; j < 4; ++j) {
        const int t = tr * 16 + lq * 4 + j, s = tc * 16 + lr;
        const float L = __expf(fminf(gc[t] - gc[s], 0.f));
        if (which == 0) Asol[s * 64 + t] = (t > s) ? bet[t] * acc[j] * L : 0.f;
        else attn[t * 72 + s] = f2bf((t >= s) ? acc[j] * L : 0.f);
      }
    }
  }
  __syncthreads();
  if (tid < 256) {
    f32x4 x[16];
    if (tid < 128) {
#pragma unroll
      for (int s = 0; s < 64; ++s) { x[s >> 2][s & 3] = bf2f(vS[s * 128 + tid]) * bet[s]; if ((s & 7) == 7) __builtin_amdgcn_sched_barrier(0); }
    } else {
#pragma unroll
      for (int s = 0; s < 64; ++s) { x[s >> 2][s & 3] = bf2f(kb[s * 136 + tid - 128]) * bet[s] * __expf(gc[s]); if ((s & 7) == 7) __builtin_amdgcn_sched_barrier(0); }
    }
    SolveCol<0>::run(x, Asol);
    u16* dst = (tid < 128) ? (U0T + tid * 72) : (WT + (tid - 128) * 72);
#pragma unroll
    for (int s8 = 0; s8 < 8; ++s8) {
      *(u32x4*)(dst + s8 * 8) = u32x4{pack2(x[2 * s8][0], x[2 * s8][1]), pack2(x[2 * s8][2], x[2 * s8][3]),
                                      pack2(x[2 * s8 + 1][0], x[2 * s8 + 1][1]), pack2(x[2 * s8 + 1][2], x[2 * s8 + 1][3])};
    }
  } else {
    const float glast = gc[63];
    const int e0 = tid - 256;
#pragma unroll 4
    for (int i = 0; i < 32; ++i) {
      const int e = e0 + 256 * i;
      const int s = e & 63, kd = e >> 6;
      khT[kd * 72 + s] = f2bf(bf2f(kb[s * 136 + kd]) * __expf(glast - gc[s]));
    }
  }
  __syncthreads();
  {
    const int tr = w & 3, half = w >> 2;
    const u16* Bsrc = half ? U0T : WT;
    const bf16x8 a0 = frag(attn, tr * 16, 72, 0, lane), a1 = frag(attn, tr * 16, 72, 32, lane);
#pragma unroll 2
    for (int tc = 0; tc < 8; ++tc) {
      f32x4 acc = {0.f, 0.f, 0.f, 0.f};
      acc = mfma16(a0, frag(Bsrc, tc * 16, 72, 0, lane), acc);
      acc = mfma16(a1, frag(Bsrc, tc * 16, 72, 32, lane), acc);
      {
        float v[4];
#pragma unroll
        for (int j = 0; j < 4; ++j) {
          const int t = tr * 16 + lq * 4 + j, n = tc * 16 + lr;
          v[j] = half == 0 ? bf2f(qb[t * 136 + n]) * __expf(gc[t]) - acc[j] : acc[j];
        }
        quad_transpose(v, lane);
        const size_t o = ((size_t)(1024 + idx) * 64 + tr * 16 + lq * 4 + (lane & 3)) * 128 + tc * 16 + (lr & 12);
        store4_bf16((half == 0 ? QS : O0) + o, v);
      }
    }
  }
  {
    const int tr = w;
    const bf16x8 a0 = frag(khT, tr * 16, 72, 0, lane), a1 = frag(khT, tr * 16, 72, 32, lane);
#pragma unroll 2
    for (int tc = 0; tc < 16; ++tc) {
      const u16* Bsrc = tc < 8 ? WT : U0T;
      const int tcc = tc & 7;
      f32x4 acc = {0.f, 0.f, 0.f, 0.f};
      acc = mfma16(a0, frag(Bsrc, tcc * 16, 72, 0, lane), acc);
      acc = mfma16(a1, frag(Bsrc, tcc * 16, 72, 32, lane), acc);
      {
        float v[4];
#pragma unroll
        for (int j = 0; j < 4; ++j) v[j] = tc < 8 ? -acc[j] : acc[j];
        quad_transpose(v, lane);
        const size_t o = (size_t)(tr * 16 + lq * 4 + (lane & 3)) * 128 + tcc * 16 + (lr & 12);
        store4_bf16((tc < 8 ? MNEG + (size_t)idx * 16384 : NB + (size_t)(1024 + idx) * 16384) + o, v);
      }
    }
  }
  if (tid < 128) ((float*)(p.ws + W_DVEC))[(size_t)(1024 + idx) * 128 + tid] = __expf(gc[63]);
  __syncthreads();
}

__device__ void phase2(const Params& p, char* smem, int bid, int nb) {
  for (int it = bid; it < 2048; it += nb) {
    if (it >= 1024) { gdn_item(p, smem, it - 1024); if (DUP_MASK & 2048) gdn_item(p, smem, it - 1024); }
    else { hgrn_item(p, smem, it); if (DUP_MASK & 1024) hgrn_item(p, smem, it); }
  }
}

struct ScanRegs {
  bf16x8 Aq[4];
  bf16x8 Am[4];
  u32x2 o0, nn0, nn1;
  f32x4 dd;
};
#define RAW_BARRIER() do { asm volatile("s_waitcnt lgkmcnt(0)" ::: "memory"); __builtin_amdgcn_s_barrier(); asm volatile("" ::: "memory"); } while (0)

template <int TYPE>
__device__ __forceinline__ void scan_load(ScanRegs& r, const Params& p, int idx, unsigned qoff, unsigned ooff, unsigned moff,
                                          unsigned noff, unsigned doff) {
  const int ii = __builtin_amdgcn_readfirstlane(idx);
  const int ti = TYPE * 1024 + ii;
  const u16* QSb = (const u16*)(p.ws + W_QS) + (size_t)ti * 8192;
  const u16* O0b = (const u16*)(p.ws + W_H) + (size_t)ti * 8192;
  const u16* NBb = (const u16*)(p.out) + (size_t)ti * 16384;
#pragma unroll
  for (int ks = 0; ks < 4; ++ks) r.Aq[ks] = *(const bf16x8*)(QSb + (qoff + ks * 32));
  r.o0 = *(const u32x2*)(O0b + ooff);
  r.nn0 = *(const u32x2*)(NBb + noff);
  r.nn1 = *(const u32x2*)(NBb + (noff + 16));
  if (TYPE == 1) {
    const u16* Mb = (const u16*)(p.ws + W_MNEG) + (size_t)ii * 16384;
#pragma unroll
    for (int ks = 0; ks < 4; ++ks) r.Am[ks] = *(const bf16x8*)(Mb + (moff + ks * 32));
  }
  r.dd = *(const f32x4*)((const float*)(p.ws + W_DVEC) + (size_t)ti * 128 + doff);
}
__device__ __forceinline__ void unpack4(u32x2 u, float (&v)[4]) {
  v[0] = bf2f((u16)(u[0] & 0xffff)); v[1] = bf2f((u16)(u[0] >> 16));
  v[2] = bf2f((u16)(u[1] & 0xffff)); v[3] = bf2f((u16)(u[1] >> 16));
}

template <int TYPE>
__device__ void scan_unit(const Params& p, char* smem, int rem) {
  const int tid = opaque_tid(), lane = tid & 63, w = tid >> 6;
  const int lr = lane & 15, lq = lane >> 4;
  const int b = rem >> 4, h = (rem >> 2) & 3, vs2 = rem & 3;
  const int tr = lq * 4 + (lane & 3), tc4 = lr & 12;
  const int otr = w & 3, otc = w >> 2;
  float* OPRE = (float*)(p.ws + W_PQ);
  u16* SbT = (u16*)smem;
  for (int i = tid; i < 2 * 32 * 136; i += 512) SbT[i] = 0;
  f32x4 S0 = {0.f, 0.f, 0.f, 0.f}, S1 = {0.f, 0.f, 0.f, 0.f};
  const unsigned qoff = (unsigned)((otr * 16 + lr) * 128 + lq * 8);
  const unsigned ooff = (unsigned)((otr * 16 + tr) * 128 + vs2 * 32 + otc * 16 + tc4);
  const unsigned moff = (unsigned)((w * 16 + lr) * 128 + lq * 8);
  const unsigned noff = (unsigned)((w * 16 + tr) * 128 + vs2 * 32 + tc4);
  const unsigned doff = (unsigned)(w * 16 + lq * 4);
  float* const orow = OPRE + (size_t)(b * 2048 + otr * 16 + tr) * 1024 + TYPE * 512 + h * 128 + vs2 * 32 + otc * 16 + tc4;
  ScanRegs r0, r1, r2, r3;
  const int idx0 = (b * 32) * 4 + h;
  scan_load<TYPE>(r0, p, idx0 + 0, qoff, ooff, moff, noff, doff);
  scan_load<TYPE>(r1, p, idx0 + 4, qoff, ooff, moff, noff, doff);
  scan_load<TYPE>(r2, p, idx0 + 8, qoff, ooff, moff, noff, doff);
  scan_load<TYPE>(r3, p, idx0 + 12, qoff, ooff, moff, noff, doff);
  __builtin_amdgcn_sched_barrier(0);
#define SCAN_STEP(R, c) { \
    RAW_BARRIER(); \
    const u16* Sb = SbT + ((c) & 1) * 32 * 136 + lr * 136 + lq * 8; \
    bf16x8 B0[4], B1[4], Bo[4]; \
    _Pragma("unroll") for (int ks = 0; ks < 4; ++ks) { \
      B0[ks] = *(const bf16x8*)(Sb + ks * 32); \
      B1[ks] = *(const bf16x8*)(Sb + 16 * 136 + ks * 32); \
      Bo[ks] = *(const bf16x8*)(Sb + otc * 16 * 136 + ks * 32); } \
    { \
      float ov[4]; unpack4(R.o0, ov); quad_transpose(ov, lane); \
      f32x4 acc = {ov[0], ov[1], ov[2], ov[3]}; \
      _Pragma("unroll") for (int ks = 0; ks < 4; ++ks) acc = mfma16(R.Aq[ks], Bo[ks], acc); \
      float o[4] = {acc[0], acc[1], acc[2], acc[3]}; \
      quad_transpose(o, lane); \
      *(f32x4*)(orow + (size_t)(c) * 65536) = f32x4{o[0], o[1], o[2], o[3]}; \
    } \
    float n0[4], n1[4]; unpack4(R.nn0, n0); unpack4(R.nn1, n1); \
    quad_transpose(n0, lane); quad_transpose(n1, lane); \
    f32x4 T0, T1; \
    _Pragma("unroll") for (int j = 0; j < 4; ++j) { T0[j] = R.dd[j] * S0[j] + n0[j]; T1[j] = R.dd[j] * S1[j] + n1[j]; } \
    if (TYPE == 1) { _Pragma("unroll") for (int ks = 0; ks < 4; ++ks) { T0 = mfma16(R.Am[ks], B0[ks], T0); T1 = mfma16(R.Am[ks], B1[ks], T1); } } \
    S0 = T0; S1 = T1; \
    u16* Sw = SbT + (((c) + 1) & 1) * 32 * 136 + lr * 136 + w * 16 + lq * 4; \
    *(u32x2*)(Sw) = u32x2{pack2(S0[0], S0[1]), pack2(S0[2], S0[3])}; \
    *(u32x2*)(Sw + 16 * 136) = u32x2{pack2(S1[0], S1[1]), pack2(S1[2], S1[3])}; \
    __builtin_amdgcn_sched_barrier(0); \
    scan_load<TYPE>(R, p, idx0 + (((c) + 4 < 32) ? (c) + 4 : 31) * 4, qoff, ooff, moff, noff, doff); \
    __builtin_amdgcn_sched_barrier(0); \
  }
  for (int c0 = 0; c0 < 32; c0 += 4) {
    SCAN_STEP(r0, c0)
    SCAN_STEP(r1, c0 + 1)
    SCAN_STEP(r2, c0 + 2)
    SCAN_STEP(r3, c0 + 3)
  }
#undef SCAN_STEP
  float* so = p.out + (TYPE ? O_GDP : O_HGP) + (size_t)(b * 4 + h) * 16384 + (w * 16 + tr) * 128 + vs2 * 32 + tc4;
  {
    float sv[4] = {S0[0], S0[1], S0[2], S0[3]};
    quad_transpose(sv, lane);
    *(f32x4*)(so) = f32x4{sv[0], sv[1], sv[2], sv[3]};
    float sw[4] = {S1[0], S1[1], S1[2], S1[3]};
    quad_transpose(sw, lane);
    *(f32x4*)(so + 16) = f32x4{sw[0], sw[1], sw[2], sw[3]};
  }
  __syncthreads();
}

__device__ void sample_item(const Params& p, char* smem, int it) {
  const int tid = opaque_tid(), lane = tid & 63, w = tid >> 6;
  const int type = it >> 9, b = (it >> 2) & 127, h = it & 3;
  const int row = MP + b;
  const u16* PQ = (const u16*)(p.ws + W_PQ);
  const float* LF = (const float*)(p.ws + W_LF);
  const float* BETA = (const float*)(p.ws + W_BETA);
  const float* GDEC = (const float*)(p.ws + W_GDEC);
  float* OPRE = (float*)(p.ws + W_PQ);
  float* fq = (float*)smem;
  float* fk = fq + 128;
  float* fv = fk + 128;
  float* fe = fv + 128;
  float* red = fe + 128;
  float* sc = red + 1024;
  const int n = tid & 127, kp = tid >> 7;
  if (type == 0) {
    if (tid < 128) {
      const float lf = LF[(size_t)row * 512 + h * 128 + tid];
      const float f = __expf(lf);
      fe[tid] = f;
      fk[tid] = 1.f - f;
      fq[tid] = bf2f(PQ[(size_t)row * PQW + h * 128 + tid]);
      fv[tid] = bf2f(PQ[(size_t)row * PQW + 512 + h * 128 + tid]);
    }
    __syncthreads();
    const float* S = p.state_hgrn + ((size_t)(b * 4 + h) * 128) * 128;
    float* So = p.out + O_HGS + ((size_t)(b * 4 + h) * 128) * 128;
    const float vn = fv[n];
    float o = 0.f;
#pragma unroll
    for (int i = 0; i < 32; ++i) {
      const int k = kp * 32 + i;
      const float sn = fe[k] * S[k * 128 + n] + fk[k] * vn;
      So[k * 128 + n] = sn;
      o += fq[k] * sn;
    }
    red[kp * 128 + n] = o;
    __syncthreads();
    if (tid < 128) OPRE[(size_t)row * 1024 + h * 128 + tid] = red[tid] + red[128 + tid] + red[256 + tid] + red[384 + tid];
    __syncthreads();
  } else {
    const float* cprev = p.state_conv + (size_t)b * 3 * 1536;
    if (tid < 384) {
      const int ty = tid >> 7, cc = tid & 127;
      const int ch = ty * 512 + h * 128 + cc;
      const float p0 = cprev[ch], p1 = cprev[1536 + ch], p2 = cprev[3072 + ch];
      const float nw = bf2f(PQ[(size_t)row * PQW + 1024 + ch]);
      const float s = p.conv_w[ch] * p0 + p.conv_w[1536 + ch] * p1 + p.conv_w[3072 + ch] * p2 + p.conv_w[4608 + ch] * nw;
      fq[ty * 128 + cc] = siluf_(s);
      p.out[O_CVS + (size_t)(b * 3 + 0) * 1536 + ch] = p1;
      p.out[O_CVS + (size_t)(b * 3 + 1) * 1536 + ch] = p2;
    }
    __syncthreads();
    if (w < 2) {
      const float a0 = fq[w * 128 + lane], a1 = fq[w * 128 + 64 + lane];
      const float ss = wave_sum(a0 * a0 + a1 * a1);
      if (lane == 0) sc[w] = ss;
    }
    __syncthreads();
    const float rq = rsqrtf(sc[0] + EPS) * 0.08838834764831845f;
    const float rk = rsqrtf(sc[1] + EPS);
    __syncthreads();
    if (tid < 128) fq[tid] *= rq;
    else if (tid < 256) fk[tid - 128] *= rk;
    __syncthreads();
    if (w == 0) {
      const float qk = wave_sum(fq[lane] * fk[lane] + fq[64 + lane] * fk[64 + lane]);
      if (lane == 0) sc[2] = qk;
    }
    const float eg = __expf(GDEC[(size_t)row * 4 + h]);
    const float beta = BETA[(size_t)row * 4 + h];
    const float* S = p.state_gdn + ((size_t)(b * 4 + h) * 128) * 128;
    float* So = p.out + O_GDS + ((size_t)(b * 4 + h) * 128) * 128;
    float sd[32];
    float ks_ = 0.f, qs_ = 0.f;
#pragma unroll
    for (int i = 0; i < 32; ++i) {
      const int k = kp * 32 + i;
      sd[i] = eg * S[k * 128 + n];
      ks_ += fk[k] * sd[i];
      qs_ += fq[k] * sd[i];
    }
    red[kp * 128 + n] = ks_;
    red[512 + kp * 128 + n] = qs_;
    __syncthreads();
    const float kS = red[n] + red[128 + n] + red[256 + n] + red[384 + n];
    const float delta = (fv[n] - kS) * beta;
#pragma unroll
    for (int i = 0; i < 32; ++i) {
      const int k = kp * 32 + i;
      So[k * 128 + n] = sd[i] + fk[k] * delta;
    }
    if (tid < 128) {
      const float qS = red[512 + n] + red[640 + n] + red[768 + n] + red[896 + n];
      OPRE[(size_t)row * 1024 + 512 + h * 128 + n] = qS + sc[2] * delta;
    }
    __syncthreads();
  }
}

__device__ void sample_block4(const Params& p, char* smem, int bid) {
  const int tid = opaque_tid(), lane = tid & 63, w = tid >> 6;
  const u16* PQ = (const u16*)(p.ws + W_PQ);
  const float* LF = (const float*)(p.ws + W_LF);
  const float* BETA = (const float*)(p.ws + W_BETA);
  const float* GDEC = (const float*)(p.ws + W_GDEC);
  float* OPRE = (float*)(p.ws + W_PQ);
  float* vec = (float*)smem;
  float* red = vec + 2048;
  float* sc = red + 1024;
  if (tid < 256) {
    const int j = tid >> 7, c = tid & 127;
    const int it = bid + 256 * j, b = (it >> 2) & 127, h = it & 3, row = MP + b;
    const float f = __expf(LF[(size_t)row * 512 + h * 128 + c]);
    vec[(j * 4 + 0) * 128 + c] = bf2f(PQ[(size_t)row * PQW + h * 128 + c]);
    vec[(j * 4 + 1) * 128 + c] = 1.f - f;
    vec[(j * 4 + 2) * 128 + c] = bf2f(PQ[(size_t)row * PQW + 512 + h * 128 + c]);
    vec[(j * 4 + 3) * 128 + c] = f;
  }
  for (int e = tid; e < 768; e += 512) {
    const int j = 2 + e / 384, r = e % 384, ty = r >> 7, cc = r & 127;
    const int it = bid + 256 * j, b = (it >> 2) & 127, h = it & 3, row = MP + b;
    const int ch = ty * 512 + h * 128 + cc;
    const float* cprev = p.state_conv + (size_t)b * 3 * 1536;
    const float p0 = cprev[ch], p1 = cprev[1536 + ch], p2 = cprev[3072 + ch];
    const float nw = bf2f(PQ[(size_t)row * PQW + 1024 + ch]);
    const float s = p.conv_w[ch] * p0 + p.conv_w[1536 + ch] * p1 + p.conv_w[3072 + ch] * p2 + p.conv_w[4608 + ch] * nw;
    vec[(j * 4 + ty) * 128 + cc] = siluf_(s);
    p.out[O_CVS + (size_t)(b * 3 + 0) * 1536 + ch] = p1;
    p.out[O_CVS + (size_t)(b * 3 + 1) * 1536 + ch] = p2;
  }
  __syncthreads();
  if (w < 4) {
    const int j = 2 + (w >> 1), which = w & 1;
    const float a0 = vec[(j * 4 + which) * 128 + lane], a1 = vec[(j * 4 + which) * 128 + 64 + lane];
    const float ss = wave_sum(a0 * a0 + a1 * a1);
    if (lane == 0) sc[j * 4 + which] = ss;
  }
  __syncthreads();
  {
    const int j = 2 + (tid >> 8), which = (tid >> 7) & 1, c = tid & 127;
    const float r = which == 0 ? rsqrtf(sc[j * 4 + 0] + EPS) * 0.08838834764831845f : rsqrtf(sc[j * 4 + 1] + EPS);
    vec[(j * 4 + which) * 128 + c] *= r;
  }
  __syncthreads();
  if (w < 2) {
    const int j = 2 + w;
    const float qk = wave_sum(vec[(j * 4 + 0) * 128 + lane] * vec[(j * 4 + 1) * 128 + lane] +
                              vec[(j * 4 + 0) * 128 + 64 + lane] * vec[(j * 4 + 1) * 128 + 64 + lane]);
    if (lane == 0) sc[j * 4 + 2] = qk;
  }
  __syncthreads();
  const int n = tid & 127, kp = tid >> 7;
  float cur[32], nxt[32];
  {
    const int it = bid, b = (it >> 2) & 127, h = it & 3;
    const float* S = p.state_hgrn + ((size_t)(b * 4 + h) * 128) * 128;
#pragma unroll
    for (int i = 0; i < 32; ++i) cur[i] = S[(kp * 32 + i) * 128 + n];
  }
#pragma unroll
  for (int j = 0; j < 4; ++j) {
    const int it = bid + 256 * j, b = (it >> 2) & 127, h = it & 3, row = MP + b;
    if (j < 3) {
      const int it2 = bid + 256 * (j + 1), b2 = (it2 >> 2) & 127, h2 = it2 & 3;
      const float* S2 = ((j + 1) < 2 ? p.state_hgrn : p.state_gdn) + ((size_t)(b2 * 4 + h2) * 128) * 128;
#pragma unroll
      for (int i = 0; i < 32; ++i) nxt[i] = S2[(kp * 32 + i) * 128 + n];
    }
    const float* fq = vec + (j * 4 + 0) * 128;
    const float* fk = vec + (j * 4 + 1) * 128;
    const float* fv = vec + (j * 4 + 2) * 128;
    const float* fe = vec + (j * 4 + 3) * 128;
    if (j < 2) {
      float* So = p.out + O_HGS + ((size_t)(b * 4 + h) * 128) * 128;
      const float vn = fv[n];
      float o = 0.f;
#pragma unroll
      for (int i = 0; i < 32; ++i) {
        const int k = kp * 32 + i;
        const float sn = fe[k] * cur[i] + fk[k] * vn;
        So[k * 128 + n] = sn;
        o += fq[k] * sn;
      }
      red[kp * 128 + n] = o;
      __syncthreads();
      if (tid < 128) OPRE[(size_t)row * 1024 + h * 128 + tid] = red[tid] + red[128 + tid] + red[256 + tid] + red[384 + tid];
      __syncthreads();
    } else {
      float* So = p.out + O_GDS + ((size_t)(b * 4 + h) * 128) * 128;
      const float eg = __expf(GDEC[(size_t)row * 4 + h]);
      const float beta = BETA[(size_t)row * 4 + h];
      float ks_ = 0.f, qs_ = 0.f;
#pragma unroll
      for (int i = 0; i < 32; ++i) {
        const int k = kp * 32 + i;
        cur[i] *= eg;
        ks_ += fk[k] * cur[i];
        qs_ += fq[k] * cur[i];
      }
      red[kp * 128 + n] = ks_;
      red[512 + kp * 128 + n] = qs_;
      __syncthreads();
      const float kS = red[n] + red[128 + n] + red[256 + n] + red[384 + n];
      const float delta = (fv[n] - kS) * beta;
#pragma unroll
      for (int i = 0; i < 32; ++i) {
        const int k = kp * 32 + i;
        So[k * 128 + n] = cur[i] + fk[k] * delta;
      }
      if (tid < 128) {
        const float qS = red[512 + n] + red[640 + n] + red[768 + n] + red[896 + n];
        OPRE[(size_t)row * 1024 + 512 + h * 128 + n] = qS + sc[j * 4 + 2] * delta;
      }
      __syncthreads();
    }
#pragma unroll
    for (int i = 0; i < 32; ++i) cur[i] = nxt[i];
  }
}

__device__ void phase3(const Params& p, char* smem, int bid, int nb) {
  for (int u = bid; u < 256; u += nb) {
    int uu = u;
    if (nb == 256) {
      const int xcd = u & 7, j = u >> 3;
      uu = ((xcd * 8 + (j >> 2)) << 2) | (j & 3);
    }
    if (uu < 128) scan_unit<0>(p, smem, uu); else scan_unit<1>(p, smem, uu - 128);
    if (DUP_MASK & 256) { if (uu < 128) scan_unit<0>(p, smem, uu); else scan_unit<1>(p, smem, uu - 128); }
  }
  if (nb == 256) sample_block4(p, smem, bid);
  else for (int it = bid; it < 1024; it += nb) sample_item(p, smem, it);
}

__device__ void phase4(const Params& p, int bid, int nb) {
  const int tid = opaque_tid(), lane = tid & 63, w = tid >> 6;
  const float* OPRE = (const float*)(p.ws + W_PQ);
  const u16* GATES = (const u16*)(p.ws + W_GATES);
  u16* A2 = (u16*)(p.ws + W_QS);
  for (int g = bid; g < MT / 8; g += nb) {
    const int row = g * 8 + w;
#pragma unroll
    for (int i = 0; i < 4; ++i) {
      const int col = i * 256 + lane * 4;
      const float4 v = *(const float4*)(OPRE + (size_t)row * 1024 + col);
      float ss = v.x * v.x + v.y * v.y + v.z * v.z + v.w * v.w;
#pragma unroll
      for (int o = 16; o > 0; o >>= 1) ss += __shfl_xor(ss, o, 64);
      const float rstd = rsqrtf(ss * (1.f / 128.f) + EPS);
      const int cn = col & 127;
      const float4 nw = *(const float4*)((col < 512 ? p.hg_norm : p.gdn_norm) + cn);
      const uint2 gt = *(const uint2*)(GATES + (size_t)row * 1024 + col);
      const float g0 = bf2f((u16)(gt.x & 0xffff)), g1 = bf2f((u16)(gt.x >> 16));
      const float g2 = bf2f((u16)(gt.y & 0xffff)), g3 = bf2f((u16)(gt.y >> 16));
      *(uint2*)(A2 + (size_t)row * LDK + col) =
          make_uint2(pack2(v.x * rstd * nw.x * g0, v.y * rstd * nw.y * g1), pack2(v.z * rstd * nw.z * g2, v.w * rstd * nw.w * g3));
    }
  }
}

__device__ void phase6(const Params& p, int bid, int nb) {
  const int tid = opaque_tid(), lane = tid & 63, w = tid >> 6;
  for (int g = bid; g < MT / 8; g += nb) {
    const int row = g * 8 + w;
    float* y = row < MP ? p.out + O_YP + (size_t)row * 1024 : p.out + O_YS + (size_t)(row - MP) * 1024;
    float4 xv[4];
    float ss = 0.f;
#pragma unroll
    for (int i = 0; i < 4; ++i) {
      xv[i] = *(const float4*)(y + i * 256 + lane * 4);
      ss += xv[i].x * xv[i].x + xv[i].y * xv[i].y + xv[i].z * xv[i].z + xv[i].w * xv[i].w;
    }
    ss = wave_sum(ss);
    const float rstd = rsqrtf(ss * (1.f / 1024.f) + EPS);
#pragma unroll
    for (int i = 0; i < 4; ++i) {
      const float4 nw = *(const float4*)(p.final_norm + i * 256 + lane * 4);
      float4 o;
      o.x = xv[i].x * rstd * nw.x; o.y = xv[i].y * rstd * nw.y; o.z = xv[i].z * rstd * nw.z; o.w = xv[i].w * rstd * nw.w;
      *(float4*)(y + i * 256 + lane * 4) = o;
    }
  }
}

template <int PH>
__device__ __forceinline__ void run_phase(const Params& p, char* smem, int bid, int nb) {
  if (PH == 0) phase0(p, smem, bid, nb);
  else if (PH == 1) gemm_phase<0>(p, (const u16*)(p.ws + W_H), (const u16*)(p.ws + W_WINT), 16, smem, bid, nb);
  else if (PH == 2) phase2(p, smem, bid, nb);
  else if (PH == 3) phase3(p, smem, bid, nb);
  else if (PH == 4) phase4(p, bid, nb);
  else if (PH == 5) gemm_phase<1>(p, (const u16*)(p.ws + W_QS), (const u16*)(p.ws + W_WOUTT), 4, smem, bid, nb);
  else phase6(p, bid, nb);
}

#if MEGA
__global__ void __launch_bounds__(NTH) mega_kernel(Params p) {
  extern __shared__ __attribute__((aligned(16))) char smem[];
  cg::grid_group grid = cg::this_grid();
  const int bid = blockIdx.x, nb = gridDim.x;
#define RUNP(k) run_phase<k>(p, smem, bid, nb); grid.sync(); if (DUP_MASK & (1 << k)) { run_phase<k>(p, smem, bid, nb); grid.sync(); }
  RUNP(0) RUNP(1) RUNP(2) RUNP(3) RUNP(4) RUNP(5)
#undef RUNP
  run_phase<6>(p, smem, bid, nb);
}
#else
template <int PH>
__global__ void __launch_bounds__(NTH) phase_kernel(Params p) {
  extern __shared__ __attribute__((aligned(16))) char smem[];
  run_phase<PH>(p, smem, blockIdx.x, gridDim.x);
}
template <int PH>
static void launch_phase(const Params& p, int grid, hipStream_t stream) {
  hipFuncSetAttribute((const void*)phase_kernel<PH>, hipFuncAttributeMaxDynamicSharedMemorySize, (int)LDS_BYTES);
  hipLaunchKernelGGL(phase_kernel<PH>, dim3(grid), dim3(NTH), LDS_BYTES, stream, p);
}
#endif

extern "C" void kernel_launch(void* const* d_in, const int* in_sizes, int n_in, void* d_out, int out_size,
                              void* d_ws, size_t ws_size, hipStream_t stream) {
  Params p{};
  p.x_prompt = (const float*)d_in[0];
  p.x_sample = (const float*)d_in[1];
  p.state_hgrn = (const float*)d_in[2];
  p.state_gdn = (const float*)d_in[3];
  p.state_conv = (const float*)d_in[4];
  p.norm_w = (const float*)d_in[5];
  p.w_in = (const float*)d_in[6];
  p.lb_logits = (const float*)d_in[7];
  p.conv_w = (const float*)d_in[8];
  p.a_log = (const float*)d_in[9];
  p.dt_bias = (const float*)d_in[10];
  p.hg_norm = (const float*)d_in[11];
  p.gdn_norm = (const float*)d_in[12];
  p.w_out = (const float*)d_in[13];
  p.final_norm = (const float*)d_in[14];
  p.out = (float*)d_out;
  p.ws = (char*)d_ws;
  if (ws_size < W_END) { fprintf(stderr, "workspace too small: %zu < %zu\n", ws_size, (size_t)W_END); return; }
#if MEGA
  static int grid_blocks = 0;
  if (!grid_blocks) {
    int dev = 0, cus = 0, per_cu = 0;
    hipGetDevice(&dev);
    hipDeviceGetAttribute(&cus, hipDeviceAttributeMultiprocessorCount, dev);
    hipFuncSetAttribute((const void*)mega_kernel, hipFuncAttributeMaxDynamicSharedMemorySize, (int)LDS_BYTES);
    hipOccupancyMaxActiveBlocksPerMultiprocessor(&per_cu, mega_kernel, NTH, LDS_BYTES);
    if (per_cu < 1) per_cu = 1;
    grid_blocks = cus * per_cu;
  }
  void* args[] = {&p};
  hipError_t e = hipLaunchCooperativeKernel((void*)mega_kernel, dim3(grid_blocks), dim3(NTH), args, LDS_BYTES, stream);
  if (e != hipSuccess) fprintf(stderr, "cooperative launch failed: %s (grid %d)\n", hipGetErrorString(e), grid_blocks);
#else
  const int grid = 256;
  launch_phase<0>(p, grid, stream);
  launch_phase<1>(p, grid, stream);
  launch_phase<2>(p, grid, stream);
  launch_phase<3>(p, grid, stream);
  launch_phase<4>(p, grid, stream);
  launch_phase<5>(p, grid, stream);
  launch_phase<6>(p, grid, stream);
#endif
}
```

```cpp
#include <hip/hip_runtime.h>
#include <hip/hip_cooperative_groups.h>
#include <cstdio>
namespace cg = cooperative_groups;

#ifndef MEGA
#define MEGA 1
#define DUP_MASK 0
#endif

typedef unsigned short u16;
using bf16x8 = __attribute__((ext_vector_type(8))) short;
using f32x4 = __attribute__((ext_vector_type(4))) float;
using u32x4 = __attribute__((ext_vector_type(4))) unsigned;
using u32x2 = __attribute__((ext_vector_type(2))) unsigned;

#define NTH 512
constexpr int MP = 16384, MS = 128, MT = 16512, DM = 1024, DIN = 4104, PQW = 2560;
constexpr float EPS = 1e-6f;
constexpr int LDK = 1088;
constexpr size_t LDS_BYTES = 139264;

constexpr size_t O_YP = 0, O_YS = 16777216, O_HGP = 16908288, O_GDP = 17432576, O_CVP = 17956864,
                 O_HGS = 17993728, O_GDS = 26382336, O_CVS = 34770944;
constexpr size_t W_WINT = 0;
constexpr size_t W_WOUTT = W_WINT + (size_t)4096 * LDK * 2;
constexpr size_t W_BETA = W_WOUTT + (size_t)1024 * LDK * 2;
constexpr size_t W_GDEC = W_BETA + 264192;
constexpr size_t W_DVEC = W_GDEC + 264192;
constexpr size_t W_DSC = W_DVEC + 1048576;
constexpr size_t W_PQ = W_DSC + 4096;
constexpr size_t W_GATES = W_PQ + 84541440;
constexpr size_t W_H = W_GATES + 33816576;
constexpr size_t W_QS = W_H + (size_t)MT * LDK * 2;
constexpr size_t W_MNEG = W_QS + 33554432;
constexpr size_t W_LF = W_MNEG + 33554432;
constexpr size_t W_END = W_LF + 33816576;

struct Params {
  const float *x_prompt, *x_sample, *state_hgrn, *state_gdn, *state_conv, *norm_w, *w_in, *lb_logits,
      *conv_w, *a_log, *dt_bias, *hg_norm, *gdn_norm, *w_out, *final_norm;
  float* out;
  char* ws;
};

__device__ __forceinline__ int opaque_tid() { int t = threadIdx.x; asm volatile("" : "+v"(t)); return t; }
typedef __bf16 bf16x2_t __attribute__((ext_vector_type(2)));
typedef float f32x2_t __attribute__((ext_vector_type(2)));
__device__ __forceinline__ u16 f2bf(float x) { return __builtin_bit_cast(u16, (__bf16)x); }
__device__ __forceinline__ float bf2f(u16 h) { return __uint_as_float(((unsigned)h) << 16); }
__device__ __forceinline__ unsigned pack2(float a, float b) {
  f32x2_t v = {a, b};
  return __builtin_bit_cast(unsigned, __builtin_convertvector(v, bf16x2_t));
}
template <int CTRL, int ROWMASK>
__device__ __forceinline__ float dpp_mov(float v) {
  return __builtin_bit_cast(float, __builtin_amdgcn_update_dpp(0, __builtin_bit_cast(int, v), CTRL, ROWMASK, 0xf, false));
}
__device__ __forceinline__ float wave_sum(float v) {
  v += dpp_mov<0xB1, 0xf>(v);
  v += dpp_mov<0x4E, 0xf>(v);
  v += dpp_mov<0x141, 0xf>(v);
  v += dpp_mov<0x140, 0xf>(v);
  v += dpp_mov<0x142, 0xa>(v);
  v += dpp_mov<0x143, 0xc>(v);
  return __builtin_bit_cast(float, __builtin_amdgcn_readlane(__builtin_bit_cast(int, v), 63));
}
__device__ __forceinline__ float sigmoidf_(float x) { return 1.f / (1.f + __expf(-x)); }
__device__ __forceinline__ float siluf_(float x) { return x / (1.f + __expf(-x)); }
__device__ __forceinline__ f32x4 mfma16(bf16x8 a, bf16x8 b, f32x4 c) {
  return __builtin_amdgcn_mfma_f32_16x16x32_bf16(a, b, c, 0, 0, 0);
}
__device__ __forceinline__ bf16x8 frag(const u16* base, int row0, int stride, int koff, int lane) {
  return *(const bf16x8*)(base + (row0 + (lane & 15)) * stride + koff + (lane >> 4) * 8);
}

__device__ __forceinline__ void quad_transpose(float (&v)[4], int lane) {
  {
    const bool b = lane & 1;
    float s0 = b ? v[0] : v[1], s1 = b ? v[2] : v[3];
    float r0 = dpp_mov<0xB1, 0xf>(s0), r1 = dpp_mov<0xB1, 0xf>(s1);
    if (b) { v[0] = r0; v[2] = r1; } else { v[1] = r0; v[3] = r1; }
  }
  {
    const bool b = lane & 2;
    float s0 = b ? v[0] : v[2], s1 = b ? v[1] : v[3];
    float r0 = dpp_mov<0x4E, 0xf>(s0), r1 = dpp_mov<0x4E, 0xf>(s1);
    if (b) { v[0] = r0; v[1] = r1; } else { v[2] = r0; v[3] = r1; }
  }
}
__device__ __forceinline__ void store4_bf16(u16* dst, const float (&v)[4]) {
  *(u32x2*)dst = u32x2{pack2(v[0], v[1]), pack2(v[2], v[3])};
}
__device__ void phase0(const Params& p, char* smem, int bid, int nb) {
  const int tid = opaque_tid(), lane = tid & 63, w = tid >> 6;
  u16* WinT = (u16*)(p.ws + W_WINT);
  u16* WoutT = (u16*)(p.ws + W_WOUTT);
  u16* H = (u16*)(p.ws + W_H);
  float* BETA = (float*)(p.ws + W_BETA);
  float* GDEC = (float*)(p.ws + W_GDEC);
  float* tl = (float*)smem;
  for (int t = bid; t < 1280; t += nb) {
    const float* src; int sstride; u16* dst; int kt, nt;
    if (t < 1024) { src = p.w_in; sstride = DIN; dst = WinT; kt = t >> 6; nt = t & 63; }
    else { int u = t - 1024; src = p.w_out; sstride = 1024; dst = WoutT; kt = u >> 4; nt = u & 15; }
#pragma unroll
    for (int i = 0; i < 8; ++i) {
      int idx = tid + 512 * i; int kk = idx >> 6, nn = idx & 63;
      tl[kk * 65 + nn] = src[(size_t)(kt * 64 + kk) * sstride + nt * 64 + nn];
    }
    __syncthreads();
    {
      int nn = tid >> 3, k8 = (tid & 7) * 8;
      unsigned pk[4];
#pragma unroll
      for (int e = 0; e < 4; ++e) pk[e] = pack2(tl[(k8 + 2 * e) * 65 + nn], tl[(k8 + 2 * e + 1) * 65 + nn]);
      *(uint4*)(dst + (size_t)(nt * 64 + nn) * LDK + kt * 64 + k8) = make_uint4(pk[0], pk[1], pk[2], pk[3]);
    }
    __syncthreads();
  }
  float* W8s = (float*)smem;
  for (int idx = tid; idx < 8192; idx += 512) {
    int j = idx & 7, k = idx >> 3;
    W8s[j * 1024 + k] = p.w_in[(size_t)k * DIN + 4096 + j];
  }
  __syncthreads();
  for (int g = bid; g < MT / 8; g += nb) {
    int row = g * 8 + w;
    const float* x = row < MP ? p.x_prompt + (size_t)row * 1024 : p.x_sample + (size_t)(row - MP) * 1024;
    float4 xv[4];
    float ss = 0.f;
#pragma unroll
    for (int i = 0; i < 4; ++i) {
      xv[i] = *(const float4*)(x + i * 256 + lane * 4);
      ss += xv[i].x * xv[i].x + xv[i].y * xv[i].y + xv[i].z * xv[i].z + xv[i].w * xv[i].w;
    }
    ss = wave_sum(ss);
    float rstd = rsqrtf(ss * (1.f / 1024.f) + EPS);
    float d0 = 0, d1 = 0, d2 = 0, d3 = 0, d4 = 0, d5 = 0, d6 = 0, d7 = 0;
#pragma unroll
    for (int i = 0; i < 4; ++i) {
      float4 nw = *(const float4*)(p.norm_w + i * 256 + lane * 4);
      float4 hv;
      hv.x = xv[i].x * rstd * nw.x; hv.y = xv[i].y * rstd * nw.y; hv.z = xv[i].z * rstd * nw.z; hv.w = xv[i].w * rstd * nw.w;
      *(uint2*)(H + (size_t)row * LDK + i * 256 + lane * 4) = make_uint2(pack2(hv.x, hv.y), pack2(hv.z, hv.w));
#define GDOT(j, dj) { float4 wv = *(const float4*)(W8s + j * 1024 + i * 256 + lane * 4); dj += hv.x * wv.x + hv.y * wv.y + hv.z * wv.z + hv.w * wv.w; }
      GDOT(0, d0) GDOT(1, d1) GDOT(2, d2) GDOT(3, d3) GDOT(4, d4) GDOT(5, d5) GDOT(6, d6) GDOT(7, d7)
#undef GDOT
    }
    d0 = wave_sum(d0); d1 = wave_sum(d1); d2 = wave_sum(d2); d3 = wave_sum(d3);
    d4 = wave_sum(d4); d5 = wave_sum(d5); d6 = wave_sum(d6); d7 = wave_sum(d7);
    if (lane < 4) {
      float gb = lane == 0 ? d0 : lane == 1 ? d1 : lane == 2 ? d2 : d3;
      float ga = lane == 0 ? d4 : lane == 1 ? d5 : lane == 2 ? d6 : d7;
      BETA[row * 4 + lane] = 1.f / (1.f + expf(-gb));
      float z = ga + p.dt_bias[lane];
      float sp = z > 20.f ? z : log1pf(expf(z));
      GDEC[row * 4 + lane] = -expf(p.a_log[lane]) * sp;
    }
  }
  __syncthreads();
}

__device__ __forceinline__ int lds_byte2(int r, int c) {
  int st = (r >> 4) * 2 + (c >> 5), ob = (r & 15) * 64 + (c & 31) * 2;
  return st * 1024 + (ob ^ (((ob >> 9) & 1) << 5));
}
__device__ __forceinline__ void stage_rc2(int b, int& R, int& C) {
  int st = b >> 10, sb = b & 1023, swz = sb ^ (((sb >> 9) & 1) << 5);
  R = (st >> 1) * 16 + swz / 64;
  C = (st & 1) * 32 + (swz % 64) / 2;
}
template <int EPI, int SEC>
__device__ __forceinline__ void epi_store4(const Params& p, int row, int col4, const float (&v)[4]) {
  if (EPI == 0) {
    u16* PQ = (u16*)(p.ws + W_PQ);
    u16* GATES = (u16*)(p.ws + W_GATES);
    float* LF = (float*)(p.ws + W_LF);
    const int sec = SEC >= 0 ? SEC : (col4 >> 9);
    if (sec == 0) {
      *(uint2*)(PQ + (size_t)row * PQW + col4) = make_uint2(pack2(v[0], v[1]), pack2(v[2], v[3]));
    } else if (sec == 1) {
      const int cc = col4 - 512;
      const f32x4 l0 = *(const f32x4*)(p.lb_logits + cc), l1 = *(const f32x4*)(p.lb_logits + 512 + cc);
      f32x4 o;
#pragma unroll
      for (int i = 0; i < 4; ++i) {
        const float lbv = 1.f / (1.f + __expf(l1[i] - l0[i]));
        o[i] = __logf(lbv + (1.f - lbv) / (1.f + __expf(-v[i])));
      }
      *(f32x4*)(LF + (size_t)row * 512 + cc) = o;
    } else if (sec == 2) {
      *(uint2*)(PQ + (size_t)row * PQW + 512 + (col4 - 1024)) = make_uint2(pack2(v[0], v[1]), pack2(v[2], v[3]));
    } else if (sec == 3 || sec == 7) {
      const int cc = sec == 3 ? col4 - 1536 : 512 + col4 - 3584;
      *(uint2*)(GATES + (size_t)row * 1024 + cc) =
          make_uint2(pack2(v[0] / (1.f + __expf(-v[0])), v[1] / (1.f + __expf(-v[1]))),
                     pack2(v[2] / (1.f + __expf(-v[2])), v[3] / (1.f + __expf(-v[3]))));
    } else {
      const int cc = col4 - 2048;
      *(uint2*)(PQ + (size_t)row * PQW + 1024 + cc) = make_uint2(pack2(v[0], v[1]), pack2(v[2], v[3]));
      if (row < MP) {
        const int tt = row & 2047;
        if (tt >= 2045) *(f32x4*)(p.out + O_CVP + (size_t)((row >> 11) * 3 + (tt - 2045)) * 1536 + cc) = f32x4{v[0], v[1], v[2], v[3]};
      } else {
        *(f32x4*)(p.out + O_CVS + (size_t)((row - MP) * 3 + 2) * 1536 + cc) = f32x4{v[0], v[1], v[2], v[3]};
      }
    }
  } else {
    const float* xr = row < MP ? p.x_prompt + (size_t)row * 1024 : p.x_sample + (size_t)(row - MP) * 1024;
    float* yr = row < MP ? p.out + O_YP + (size_t)row * 1024 : p.out + O_YS + (size_t)(row - MP) * 1024;
    const f32x4 xv = *(const f32x4*)(xr + col4);
    *(f32x4*)(yr + col4) = f32x4{xv[0] + v[0], xv[1] + v[1], xv[2] + v[2], xv[3] + v[3]};
  }
}

template <int EPI>
__device__ void gemm_phase(const Params& p, const u16* __restrict__ A, const u16* __restrict__ Bt, int ntn,
                           char* smem, int bid, int nb) {
  const int tid = opaque_tid(), lane = tid & 63, wid = tid >> 6;
  const int wr = wid >> 2, wc = wid & 3, fr = lane & 15, fq = lane >> 4;
  constexpr int TILE_B = 256 * 64 * 2, STAGE_B = 2 * TILE_B;
  int sR0, sC0;
  stage_rc2(wid * 1024 + lane * 16, sR0, sC0);
  const unsigned goff = (unsigned)(sR0 * LDK + sC0);
  const unsigned lbase = (unsigned)(size_t)smem + (unsigned)(wid * 1024);
  const int aoff = (wr * 16) * 1024 + ((fr * 64 + fq * 16) ^ ((((fr * 64 + fq * 16) >> 9) & 1) << 5));
  const int boff = TILE_B + (wc * 8) * 1024 + ((fr * 64 + fq * 16) ^ ((((fr * 64 + fq * 16) >> 9) & 1) << 5));
  const int ntiles = 64 * ntn;
  auto tile_mn = [&](int tile, int& tm, int& tn) {
    const int rnd = tile >> 8, t = tile & 255, xcd = t & 7, j = t >> 3;
    if (ntn == 16) { tm = rnd * 16 + (xcd >> 1) * 4 + (j & 3); tn = (xcd & 1) * 8 + (j >> 2); }
    else { tm = xcd * 8 + (j & 7); tn = j >> 3; }
  };
  bool staged = false;
  for (int tile = bid; tile < ntiles; tile += nb) {
    int tm, tn;
    tile_mn(tile, tm, tn);
    const u16* Ab = A + (size_t)tm * 256 * LDK;
    const u16* Bb = Bt + (size_t)tn * 256 * LDK;
    f32x4 acc[8][4];
#pragma unroll
    for (int m = 0; m < 8; ++m)
#pragma unroll
      for (int n = 0; n < 4; ++n) acc[m][n] = f32x4{0.f, 0.f, 0.f, 0.f};
#define G_STAGE(buf, kt) { _Pragma("unroll") for (int i = 0; i < 4; ++i) { \
      __builtin_amdgcn_global_load_lds((const unsigned*)(Ab + (goff + (unsigned)(i * 64 * LDK + (kt) * 64))), \
          (__attribute__((address_space(3))) unsigned*)(lbase + (buf) * STAGE_B + i * 8192), 16, 0, 0); \
      __builtin_amdgcn_global_load_lds((const unsigned*)(Bb + (goff + (unsigned)(i * 64 * LDK + (kt) * 64))), \
          (__attribute__((address_space(3))) unsigned*)(lbase + (buf) * STAGE_B + TILE_B + i * 8192), 16, 0, 0); } }
    if (!staged) G_STAGE(0, 0);
    asm volatile("s_waitcnt vmcnt(0)" ::: "memory");
    __syncthreads();
    for (int t = 0; t < 16; ++t) {
      const int cur = t & 1;
      if (t + 1 < 16) G_STAGE(cur ^ 1, t + 1);
      const char* sA = smem + cur * STAGE_B + aoff;
      const char* sB = smem + cur * STAGE_B + boff;
#pragma unroll
      for (int ks = 0; ks < 2; ++ks) {
        bf16x8 At[8], Bf[4];
#pragma unroll
        for (int m = 0; m < 8; ++m) At[m] = *(const bf16x8*)(sA + (m * 2 + ks) * 1024);
#pragma unroll
        for (int n = 0; n < 4; ++n) Bf[n] = *(const bf16x8*)(sB + (n * 2 + ks) * 1024);
#pragma unroll
        for (int m = 0; m < 8; ++m)
#pragma unroll
          for (int n = 0; n < 4; ++n) acc[m][n] = mfma16(At[m], Bf[n], acc[m][n]);
        __builtin_amdgcn_sched_barrier(0);
      }
      asm volatile("s_waitcnt vmcnt(0)" ::: "memory");
      __syncthreads();
    }
    staged = false;
    if (tile + nb < ntiles) {
      int tm2, tn2;
      tile_mn(tile + nb, tm2, tn2);
      const u16* Ab2 = A + (size_t)tm2 * 256 * LDK;
      const u16* Bb2 = Bt + (size_t)tn2 * 256 * LDK;
      { const u16* Ab = Ab2; const u16* Bb = Bb2; G_STAGE(0, 0); }
      staged = true;
    }
#undef G_STAGE
    {
      int t2 = threadIdx.x;
      asm volatile("" : "+v"(t2));
      const int lane2 = t2 & 63, wid2 = t2 >> 6;
      const int rbase = tm * 256 + (wid2 >> 2) * 128 + (lane2 >> 4) * 4 + (lane2 & 3);
      const int cbase = tn * 256 + (wid2 & 3) * 64 + (lane2 & 12);
#define EPI_LOOP(SEC) { _Pragma("unroll") for (int m = 0; m < 8; ++m) { _Pragma("unroll") for (int n = 0; n < 4; ++n) { \
          float v[4] = {acc[m][n][0], acc[m][n][1], acc[m][n][2], acc[m][n][3]}; \
          quad_transpose(v, lane2); \
          epi_store4<EPI, SEC>(p, rbase + m * 16, cbase + n * 16, v); } } }
      if (EPI == 0) {
        const int sec = tn >> 1;
        if (sec == 0) EPI_LOOP(0) else if (sec == 1) EPI_LOOP(1) else if (sec == 2) EPI_LOOP(2)
        else if (sec == 3) EPI_LOOP(3) else if (sec == 7) EPI_LOOP(7) else EPI_LOOP(4)
      } else EPI_LOOP(0)
#undef EPI_LOOP
    }
  }
  const int nunits = ntn * 16;
  int t3 = threadIdx.x;
  asm volatile("" : "+v"(t3));
  for (int u = bid; u < nunits; u += nb) {
    const int lane = t3 & 63, wid = t3 >> 6, fr = lane & 15, fq = lane >> 4;
    const u16* ar = A + (size_t)(MP + wid * 16 + fr) * LDK + fq * 8;
    const u16* br = Bt + (size_t)(u * 16 + fr) * LDK + fq * 8;
    f32x4 acc0 = {0.f, 0.f, 0.f, 0.f}, acc1 = {0.f, 0.f, 0.f, 0.f};
#pragma unroll 4
    for (int ks = 0; ks < 32; ks += 2) {
      const bf16x8 a0 = *(const bf16x8*)(ar + ks * 32), b0 = *(const bf16x8*)(br + ks * 32);
      const bf16x8 a1 = *(const bf16x8*)(ar + ks * 32 + 32), b1 = *(const bf16x8*)(br + ks * 32 + 32);
      acc0 = mfma16(a0, b0, acc0);
      acc1 = mfma16(a1, b1, acc1);
    }
    float v[4] = {acc0[0] + acc1[0], acc0[1] + acc1[1], acc0[2] + acc1[2], acc0[3] + acc1[3]};
    quad_transpose(v, lane);
    epi_store4<EPI, -1>(p, MP + wid * 16 + fq * 4 + (lane & 3), u * 16 + (fr & ~3), v);
  }
  __syncthreads();
}

__device__ void hgrn_item(const Params& p, char* smem, int idx) {
  const int tid = opaque_tid(), lane = tid & 63, w = tid >> 6;
  const int lr = lane & 15, lq = lane >> 4;
  const int h = idx & 3, c = (idx >> 2) & 31, b = idx >> 7;
  const int r0 = b * 2048 + c * 64;
  const u16* PQ = (const u16*)(p.ws + W_PQ);
  const float* LF = (const float*)(p.ws + W_LF);
  u16* QS = (u16*)(p.ws + W_QS);
  u16* O0 = (u16*)(p.ws + W_H);
  u16* NB = (u16*)(p.out);
  float* DVEC = (float*)(p.ws + W_DVEC);
  u16* qt = (u16*)smem;
  u16* kt = qt + 64 * 136;
  u16* ktT = kt + 64 * 136;
  u16* vT = ktT + 128 * 72;
  u16* sc = vT + 128 * 72;
  float* ps = (float*)(sc + 64 * 72);
  const int col = tid & 127, part = tid >> 7;
  float lfv[16], bcum[16];
  {
    const float* lfp = LF + (size_t)(r0 + part * 16) * 512 + h * 128 + col;
#pragma unroll
    for (int i = 0; i < 16; ++i) lfv[i] = lfp[(size_t)i * 512];
    float run = 0.f;
#pragma unroll
    for (int i = 0; i < 16; ++i) { run += lfv[i]; bcum[i] = run; }
    ps[part * 128 + col] = run;
  }
  u16 qraw[16], vraw[16];
  {
    const u16* qp0 = PQ + (size_t)(r0 + part * 16) * PQW + h * 128 + col;
#pragma unroll
    for (int i = 0; i < 16; ++i) { qraw[i] = qp0[(size_t)i * PQW]; vraw[i] = qp0[(size_t)i * PQW + 512]; }
  }
  __syncthreads();
  {
    float off = 0.f, blast = 0.f;
#pragma unroll
    for (int pp = 0; pp < 4; ++pp) { float t = ps[pp * 128 + col]; blast += t; if (pp < part) off += t; }
    u16* qsout = QS + ((size_t)idx * 64 + part * 16) * 128 + col;
#pragma unroll
    for (int i = 0; i < 16; ++i) {
      const float bb = bcum[i] + off;
      const int row = part * 16 + i;
      const float q = bf2f(qraw[i]);
      const u16 v = vraw[i];
      qsout[i * 128] = f2bf(q * __expf(bb));
      qt[row * 136 + col] = f2bf(q * __expf(bb - blast));
      const float kk = (1.f - __expf(lfv[i])) * __expf(blast - bb);
      const u16 kbv = f2bf(kk);
      kt[row * 136 + col] = kbv;
      ktT[col * 72 + row] = kbv;
      vT[col * 72 + row] = v;
    }
    if (part == 0) DVEC[idx * 128 + col] = __expf(blast);
  }
  __syncthreads();
  {
    const int tr = w >> 1;
    bf16x8 a[4];
#pragma unroll
    for (int ks = 0; ks < 4; ++ks) a[ks] = frag(qt, tr * 16, 136, ks * 32, lane);
#pragma unroll
    for (int tci = 0; tci < 2; ++tci) {
      const int tc = (w & 1) * 2 + tci;
      f32x4 acc = {0.f, 0.f, 0.f, 0.f};
#pragma unroll
      for (int ks = 0; ks < 4; ++ks) acc = mfma16(a[ks], frag(kt, tc * 16, 136, ks * 32, lane), acc);
#pragma unroll
      for (int j = 0; j < 4; ++j) {
        const int t = tr * 16 + lq * 4 + j, s = tc * 16 + lr;
        sc[t * 72 + s] = f2bf(t >= s ? acc[j] : 0.f);
      }
    }
  }
  __syncthreads();
  {
    const int tr = w >> 1;
    const bf16x8 a0 = frag(sc, tr * 16, 72, 0, lane), a1 = frag(sc, tr * 16, 72, 32, lane);
#pragma unroll
    for (int tci = 0; tci < 4; ++tci) {
      const int tc = (w & 1) * 4 + tci;
      f32x4 acc = {0.f, 0.f, 0.f, 0.f};
      acc = mfma16(a0, frag(vT, tc * 16, 72, 0, lane), acc);
      acc = mfma16(a1, frag(vT, tc * 16, 72, 32, lane), acc);
      {
        float v[4] = {acc[0], acc[1], acc[2], acc[3]};
        quad_transpose(v, lane);
        store4_bf16(O0 + ((size_t)idx * 64 + tr * 16 + lq * 4 + (lane & 3)) * 128 + tc * 16 + (lr & 12), v);
      }
    }
  }
  {
    const int tr = w;
    const bf16x8 a0 = frag(ktT, tr * 16, 72, 0, lane), a1 = frag(ktT, tr * 16, 72, 32, lane);
#pragma unroll
    for (int tc = 0; tc < 8; ++tc) {
      f32x4 acc = {0.f, 0.f, 0.f, 0.f};
      acc = mfma16(a0, frag(vT, tc * 16, 72, 0, lane), acc);
      acc = mfma16(a1, frag(vT, tc * 16, 72, 32, lane), acc);
      {
        float v[4] = {acc[0], acc[1], acc[2], acc[3]};
        quad_transpose(v, lane);
        store4_bf16(NB + ((size_t)idx * 128 + tr * 16 + lq * 4 + (lane & 3)) * 128 + tc * 16 + (lr & 12), v);
      }
    }
  }
  __syncthreads();
}

template <int J>
struct SolveCol {
  static __device__ __forceinline__ void run(f32x4 (&x)[16], const float* AT) {
    if constexpr (J < 63) {
      const float xj = x[J / 4][J % 4];
#pragma unroll
      for (int B = (J + 1) / 4; B < 16; ++B) {
        const f32x4 av = *(const f32x4*)(AT + J * 64 + B * 4);
        x[B] -= av * xj;
      }
      if ((J & 3) == 3) __builtin_amdgcn_sched_barrier(0);
      SolveCol<J + 1>::run(x, AT);
    }
  }
};

__device__ void gdn_item(const Params& p, char* smem, int idx) {
  const int tid = opaque_tid(), lane = tid & 63, w = tid >> 6;
  const int lr = lane & 15, lq = lane >> 4;
  const int h = idx & 3, c = (idx >> 2) & 31, b = idx >> 7;
  const int r0 = b * 2048 + c * 64;
  const u16* PQ = (const u16*)(p.ws + W_PQ);
  const float* BETA = (const float*)(p.ws + W_BETA);
  const float* GDEC = (const float*)(p.ws + W_GDEC);
  u16* QS = (u16*)(p.ws + W_QS);
  u16* O0 = (u16*)(p.ws + W_H);
  u16* NB = (u16*)(p.out);
  u16* MNEG = (u16*)(p.ws + W_MNEG);
  float* DSC = (float*)(p.ws + W_DSC);
  u16* kb = (u16*)smem;
  u16* qb = kb + 64 * 136;
  u16* vS = qb + 64 * 136;
  float* Asol = (float*)(vS + 64 * 128);
  u16* attn = (u16*)(Asol + 64 * 64);
  u16* khT = attn + 64 * 72;
  u16* WT = khT + 128 * 72;
  u16* U0T = WT + 128 * 72;
  float* gc = (float*)(U0T + 128 * 72);
  float* bet = gc + 64;

  if (w == 0) {
    float g = GDEC[(size_t)(r0 + lane) * 4 + h];
#pragma unroll
    for (int o = 1; o < 64; o <<= 1) { float t = __shfl_up(g, o, 64); if (lane >= o) g += t; }
    gc[lane] = g;
    bet[lane] = BETA[(size_t)(r0 + lane) * 4 + h];
  }
  {
    const int chq = 1024 + h * 128 + 2 * lane;
    const int cwq = h * 128 + 2 * lane;
    float cw[3][4][2];
#pragma unroll
    for (int ty = 0; ty < 3; ++ty)
#pragma unroll
      for (int j = 0; j < 4; ++j) {
        float2 t2 = *(const float2*)(p.conv_w + j * 1536 + ty * 512 + cwq);
        cw[ty][j][0] = t2.x; cw[ty][j][1] = t2.y;
      }
    float win[3][3][2];
    const int t0 = w * 8;
#pragma unroll
    for (int a = 0; a < 3; ++a) {
      const int rr = t0 - 3 + a;
      const bool valid = (c > 0) || (rr >= 0);
#pragma unroll
      for (int ty = 0; ty < 3; ++ty) {
        unsigned u = 0;
        if (valid) u = *(const unsigned*)(PQ + (ptrdiff_t)(r0 + rr) * PQW + chq + ty * 512);
        win[ty][a][0] = bf2f((u16)(u & 0xffff)); win[ty][a][1] = bf2f((u16)(u >> 16));
      }
    }
#pragma unroll
    for (int tt = 0; tt < 8; ++tt) {
      const int t = t0 + tt;
      float cv[3][2];
#pragma unroll
      for (int ty = 0; ty < 3; ++ty) {
        unsigned u = *(const unsigned*)(PQ + (size_t)(r0 + t) * PQW + chq + ty * 512);
        float c0 = bf2f((u16)(u & 0xffff)), c1 = bf2f((u16)(u >> 16));
        float s0 = cw[ty][0][0] * win[ty][0][0] + cw[ty][1][0] * win[ty][1][0] + cw[ty][2][0] * win[ty][2][0] + cw[ty][3][0] * c0;
        float s1 = cw[ty][0][1] * win[ty][0][1] + cw[ty][1][1] * win[ty][1][1] + cw[ty][2][1] * win[ty][2][1] + cw[ty][3][1] * c1;
        win[ty][0][0] = win[ty][1][0]; win[ty][0][1] = win[ty][1][1];
        win[ty][1][0] = win[ty][2][0]; win[ty][1][1] = win[ty][2][1];
        win[ty][2][0] = c0; win[ty][2][1] = c1;
        cv[ty][0] = siluf_(s0); cv[ty][1] = siluf_(s1);
      }
      float ssq = wave_sum(cv[0][0] * cv[0][0] + cv[0][1] * cv[0][1]);
      float ssk = wave_sum(cv[1][0] * cv[1][0] + cv[1][1] * cv[1][1]);
      const float rq = rsqrtf(ssq + EPS) * 0.08838834764831845f;
      const float rk = rsqrtf(ssk + EPS);
      *(unsigned*)(qb + t * 136 + 2 * lane) = pack2(cv[0][0] * rq, cv[0][1] * rq);
      *(unsigned*)(kb + t * 136 + 2 * lane) = pack2(cv[1][0] * rk, cv[1][1] * rk);
      *(unsigned*)(vS + t * 128 + 2 * lane) = pack2(cv[2][0], cv[2][1]);
    }
  }
  __syncthreads();
  {
    const int which = w >> 2, tr = w & 3;
    const u16* Asrc = which ? qb : kb;
    bf16x8 a[4];
#pragma unroll
    for (int ks = 0; ks < 4; ++ks) a[ks] = frag(Asrc, tr * 16, 136, ks * 32, lane);
#pragma unroll
    for (int tc = 0; tc < 4; ++tc) {
      f32x4 acc = {0.f, 0.f, 0.f, 0.f};
#pragma unroll
      for (int ks = 0; ks < 4; ++ks) acc = mfma16(a[ks], frag(kb, tc * 16, 136, ks * 32, lane), acc);
#pragma unroll
      for (int j = 0; j < 4; ++j) {
        const int t = tr * 16 + lq * 4 + j, s = tc * 16 + lr;
        const float L = __expf(fminf(gc[t] - gc[s], 0.f));
        if (which == 0) Asol[s * 64 + t] = (t > s) ? bet[t] * acc[j] * L : 0.f;
        else attn[t * 72 + s] = f2bf((t >= s) ? acc[j] * L : 0.f);
      }
    }
  }
  __syncthreads();
  if (tid < 256) {
    f32x4 x[16];
    if (tid < 128) {
#pragma unroll
      for (int s = 0; s < 64; ++s) { x[s >> 2][s & 3] = bf2f(vS[s * 128 + tid]) * bet[s]; if ((s & 7) == 7) __builtin_amdgcn_sched_barrier(0); }
    } else {
#pragma unroll
      for (int s = 0; s < 64; ++s) { x[s >> 2][s & 3] = bf2f(kb[s * 136 + tid - 128]) * bet[s] * __expf(gc[s]); if ((s & 7) == 7) __builtin_amdgcn_sched_barrier(0); }
    }
    SolveCol<0>::run(x, Asol);
    u16* dst = (tid < 128) ? (U0T + tid * 72) : (WT + (tid - 128) * 72);
#pragma unroll
    for (int s8 = 0; s8 < 8; ++s8) {
      *(u32x4*)(dst + s8 * 8) = u32x4{pack2(x[2 * s8][0], x[2 * s8][1]), pack2(x[2 * s8][2], x[2 * s8][3]),
                                      pack2(x[2 * s8 + 1][0], x[2 * s8 + 1][1]), pack2(x[2 * s8 + 1][2], x[2 * s8 + 1][3])};
    }
  } else {
    const float glast = gc[63];
    const int e0 = tid - 256;
#pragma unroll 4
    for (int i = 0; i < 32; ++i) {
      const int e = e0 + 256 * i;
      const int s = e & 63, kd = e >> 6;
      khT[kd * 72 + s] = f2bf(bf2f(kb[s * 136 + kd]) * __expf(glast - gc[s]));
    }
  }
  __syncthreads();
  {
    const int tr = w & 3, half = w >> 2;
    const u16* Bsrc = half ? U0T : WT;
    const bf16x8 a0 = frag(attn, tr * 16, 72, 0, lane), a1 = frag(attn, tr * 16, 72, 32, lane);
#pragma unroll 2
    for (int tc = 0; tc < 8; ++tc) {
      f32x4 acc = {0.f, 0.f, 0.f, 0.f};
      acc = mfma16(a0, frag(Bsrc, tc * 16, 72, 0, lane), acc);
      acc = mfma16(a1, frag(Bsrc, tc * 16, 72, 32, lane), acc);
      {
        float v[4];
#pragma unroll
        for (int j = 0; j < 4; ++j) {
          const int t = tr * 16 + lq * 4 + j, n = tc * 16 + lr;
          v[j] = half == 0 ? bf2f(qb[t * 136 + n]) * __expf(gc[t]) - acc[j] : acc[j];
        }
        quad_transpose(v, lane);
        const size_t o = ((size_t)(1024 + idx) * 64 + tr * 16 + lq * 4 + (lane & 3)) * 128 + tc * 16 + (lr & 12);
        store4_bf16((half == 0 ? QS : O0) + o, v);
      }
    }
  }
  {
    const int tr = w;
    const bf16x8 a0 = frag(khT, tr * 16, 72, 0, lane), a1 = frag(khT, tr * 16, 72, 32, lane);
#pragma unroll 2
    for (int tc = 0; tc < 16; ++tc) {
      const u16* Bsrc = tc < 8 ? WT : U0T;
      const int tcc = tc & 7;
      f32x4 acc = {0.f, 0.f, 0.f, 0.f};
      acc = mfma16(a0, frag(Bsrc, tcc * 16, 72, 0, lane), acc);
      acc = mfma16(a1, frag(Bsrc, tcc * 16, 72, 32, lane), acc);
      {
        float v[4];
#pragma unroll
        for (int j = 0; j < 4; ++j) v[j] = tc < 8 ? -acc[j] : acc[j];
        quad_transpose(v, lane);
        const size_t o = (size_t)(tr * 16 + lq * 4 + (lane & 3)) * 128 + tcc * 16 + (lr & 12);
        store4_bf16((tc < 8 ? MNEG + (size_t)idx * 16384 : NB + (size_t)(1024 + idx) * 16384) + o, v);
      }
    }
  }
  if (tid < 128) ((float*)(p.ws + W_DVEC))[(size_t)(1024 + idx) * 128 + tid] = __expf(gc[63]);
  __syncthreads();
}

__device__ void phase2(const Params& p, char* smem, int bid, int nb) {
  for (int it = bid; it < 2048; it += nb) {
    if (it >= 1024) { gdn_item(p, smem, it - 1024); if (DUP_MASK & 2048) gdn_item(p, smem, it - 1024); }
    else { hgrn_item(p, smem, it); if (DUP_MASK & 1024) hgrn_item(p, smem, it); }
  }
}

struct ScanRegs {
  bf16x8 Aq[4];
  bf16x8 Am[4];
  u32x2 o0, nn0, nn1;
  f32x4 dd;
};
#define RAW_BARRIER() do { asm volatile("s_waitcnt lgkmcnt(0)" ::: "memory"); __builtin_amdgcn_s_barrier(); asm volatile("" ::: "memory"); } while (0)

template <int TYPE>
__device__ __forceinline__ void scan_load(ScanRegs& r, const Params& p, int idx, unsigned qoff, unsigned ooff, unsigned moff,
                                          unsigned noff, unsigned doff) {
  const int ii = __builtin_amdgcn_readfirstlane(idx);
  const int ti = TYPE * 1024 + ii;
  const u16* QSb = (const u16*)(p.ws + W_QS) + (size_t)ti * 8192;
  const u16* O0b = (const u16*)(p.ws + W_H) + (size_t)ti * 8192;
  const u16* NBb = (const u16*)(p.out) + (size_t)ti * 16384;
#pragma unroll
  for (int ks = 0; ks < 4; ++ks) r.Aq[ks] = *(const bf16x8*)(QSb + (qoff + ks * 32));
  r.o0 = *(const u32x2*)(O0b + ooff);
  r.nn0 = *(const u32x2*)(NBb + noff);
  r.nn1 = *(const u32x2*)(NBb + (noff + 16));
  if (TYPE == 1) {
    const u16* Mb = (const u16*)(p.ws + W_MNEG) + (size_t)ii * 16384;
#pragma unroll
    for (int ks = 0; ks < 4; ++ks) r.Am[ks] = *(const bf16x8*)(Mb + (moff + ks * 32));
  }
  r.dd = *(const f32x4*)((const float*)(p.ws + W_DVEC) + (size_t)ti * 128 + doff);
}
__device__ __forceinline__ void unpack4(u32x2 u, float (&v)[4]) {
  v[0] = bf2f((u16)(u[0] & 0xffff)); v[1] = bf2f((u16)(u[0] >> 16));
  v[2] = bf2f((u16)(u[1] & 0xffff)); v[3] = bf2f((u16)(u[1] >> 16));
}

template <int TYPE>
__device__ void scan_unit(const Params& p, char* smem, int rem) {
  const int tid = opaque_tid(), lane = tid & 63, w = tid >> 6;
  const int lr = lane & 15, lq = lane >> 4;
  const int b = rem >> 4, h = (rem >> 2) & 3, vs2 = rem & 3;
  const int tr = lq * 4 + (lane & 3), tc4 = lr & 12;
  const int otr = w & 3, otc = w >> 2;
  float* OPRE = (float*)(p.ws + W_PQ);
  u16* SbT = (u16*)smem;
  for (int i = tid; i < 2 * 32 * 136; i += 512) SbT[i] = 0;
  f32x4 S0 = {0.f, 0.f, 0.f, 0.f}, S1 = {0.f, 0.f, 0.f, 0.f};
  const unsigned qoff = (unsigned)((otr * 16 + lr) * 128 + lq * 8);
  const unsigned ooff = (unsigned)((otr * 16 + tr) * 128 + vs2 * 32 + otc * 16 + tc4);
  const unsigned moff = (unsigned)((w * 16 + lr) * 128 + lq * 8);
  const unsigned noff = (unsigned)((w * 16 + tr) * 128 + vs2 * 32 + tc4);
  const unsigned doff = (unsigned)(w * 16 + lq * 4);
  float* const orow = OPRE + (size_t)(b * 2048 + otr * 16 + tr) * 1024 + TYPE * 512 + h * 128 + vs2 * 32 + otc * 16 + tc4;
  ScanRegs r0, r1, r2, r3;
  const int idx0 = (b * 32) * 4 + h;
  scan_load<TYPE>(r0, p, idx0 + 0, qoff, ooff, moff, noff, doff);
  scan_load<TYPE>(r1, p, idx0 + 4, qoff, ooff, moff, noff, doff);
  scan_load<TYPE>(r2, p, idx0 + 8, qoff, ooff, moff, noff, doff);
  scan_load<TYPE>(r3, p, idx0 + 12, qoff, ooff, moff, noff, doff);
  __builtin_amdgcn_sched_barrier(0);
#define SCAN_STEP(R, c) { \
    RAW_BARRIER(); \
    const u16* Sb = SbT + ((c) & 1) * 32 * 136 + lr * 136 + lq * 8; \
    bf16x8 B0[4], B1[4], Bo[4]; \
    _Pragma("unroll") for (int ks = 0; ks < 4; ++ks) { \
      B0[ks] = *(const bf16x8*)(Sb + ks * 32); \
      B1[ks] = *(const bf16x8*)(Sb + 16 * 136 + ks * 32); \
      Bo[ks] = *(const bf16x8*)(Sb + otc * 16 * 136 + ks * 32); } \
    { \
      float ov[4]; unpack4(R.o0, ov); quad_transpose(ov, lane); \
      f32x4 acc = {ov[0], ov[1], ov[2], ov[3]}; \
      _Pragma("unroll") for (int ks = 0; ks < 4; ++ks) acc = mfma16(R.Aq[ks], Bo[ks], acc); \
      float o[4] = {acc[0], acc[1], acc[2], acc[3]}; \
      quad_transpose(o, lane); \
      *(f32x4*)(orow + (size_t)(c) * 65536) = f32x4{o[0], o[1], o[2], o[3]}; \
    } \
    float n0[4], n1[4]; unpack4(R.nn0, n0); unpack4(R.nn1, n1); \
    quad_transpose(n0, lane); quad_transpose(n1, lane); \
    f32x4 T0, T1; \
    _Pragma("unroll") for (int j = 0; j < 4; ++j) { T0[j] = R.dd[j] * S0[j] + n0[j]; T1[j] = R.dd[j] * S1[j] + n1[j]; } \
    if (TYPE == 1) { _Pragma("unroll") for (int ks = 0; ks < 4; ++ks) { T0 = mfma16(R.Am[ks], B0[ks], T0); T1 = mfma16(R.Am[ks], B1[ks], T1); } } \
    S0 = T0; S1 = T1; \
    u16* Sw = SbT + (((c) + 1) & 1) * 32 * 136 + lr * 136 + w * 16 + lq * 4; \
    *(u32x2*)(Sw) = u32x2{pack2(S0[0], S0[1]), pack2(S0[2], S0[3])}; \
    *(u32x2*)(Sw + 16 * 136) = u32x2{pack2(S1[0], S1[1]), pack2(S1[2], S1[3])}; \
    __builtin_amdgcn_sched_barrier(0); \
    scan_load<TYPE>(R, p, idx0 + (((c) + 4 < 32) ? (c) + 4 : 31) * 4, qoff, ooff, moff, noff, doff); \
    __builtin_amdgcn_sched_barrier(0); \
  }
  for (int c0 = 0; c0 < 32; c0 += 4) {
    SCAN_STEP(r0, c0)
    SCAN_STEP(r1, c0 + 1)
    SCAN_STEP(r2, c0 + 2)
    SCAN_STEP(r3, c0 + 3)
  }
#undef SCAN_STEP
  float* so = p.out + (TYPE ? O_GDP : O_HGP) + (size_t)(b * 4 + h) * 16384 + (w * 16 + tr) * 128 + vs2 * 32 + tc4;
  {
    float sv[4] = {S0[0], S0[1], S0[2], S0[3]};
    quad_transpose(sv, lane);
    *(f32x4*)(so) = f32x4{sv[0], sv[1], sv[2], sv[3]};
    float sw[4] = {S1[0], S1[1], S1[2], S1[3]};
    quad_transpose(sw, lane);
    *(f32x4*)(so + 16) = f32x4{sw[0], sw[1], sw[2], sw[3]};
  }
  __syncthreads();
}

__device__ void sample_item(const Params& p, char* smem, int it) {
  const int tid = opaque_tid(), lane = tid & 63, w = tid >> 6;
  const int type = it >> 9, b = (it >> 2) & 127, h = it & 3;
  const int row = MP + b;
  const u16* PQ = (const u16*)(p.ws + W_PQ);
  const float* LF = (const float*)(p.ws + W_LF);
  const float* BETA = (const float*)(p.ws + W_BETA);
  const float* GDEC = (const float*)(p.ws + W_GDEC);
  float* OPRE = (float*)(p.ws + W_PQ);
  float* fq = (float*)smem;
  float* fk = fq + 128;
  float* fv = fk + 128;
  float* fe = fv + 128;
  float* red = fe + 128;
  float* sc = red + 1024;
  const int n = tid & 127, kp = tid >> 7;
  if (type == 0) {
    if (tid < 128) {
      const float lf = LF[(size_t)row * 512 + h * 128 + tid];
      const float f = __expf(lf);
      fe[tid] = f;
      fk[tid] = 1.f - f;
      fq[tid] = bf2f(PQ[(size_t)row * PQW + h * 128 + tid]);
      fv[tid] = bf2f(PQ[(size_t)row * PQW + 512 + h * 128 + tid]);
    }
    __syncthreads();
    const float* S = p.state_hgrn + ((size_t)(b * 4 + h) * 128) * 128;
    float* So = p.out + O_HGS + ((size_t)(b * 4 + h) * 128) * 128;
    const float vn = fv[n];
    float o = 0.f;
#pragma unroll
    for (int i = 0; i < 32; ++i) {
      const int k = kp * 32 + i;
      const float sn = fe[k] * S[k * 128 + n] + fk[k] * vn;
      So[k * 128 + n] = sn;
      o += fq[k] * sn;
    }
    red[kp * 128 + n] = o;
    __syncthreads();
    if (tid < 128) OPRE[(size_t)row * 1024 + h * 128 + tid] = red[tid] + red[128 + tid] + red[256 + tid] + red[384 + tid];
    __syncthreads();
  } else {
    const float* cprev = p.state_conv + (size_t)b * 3 * 1536;
    if (tid < 384) {
      const int ty = tid >> 7, cc = tid & 127;
      const int ch = ty * 512 + h * 128 + cc;
      const float p0 = cprev[ch], p1 = cprev[1536 + ch], p2 = cprev[3072 + ch];
      const float nw = bf2f(PQ[(size_t)row * PQW + 1024 + ch]);
      const float s = p.conv_w[ch] * p0 + p.conv_w[1536 + ch] * p1 + p.conv_w[3072 + ch] * p2 + p.conv_w[4608 + ch] * nw;
      fq[ty * 128 + cc] = siluf_(s);
      p.out[O_CVS + (size_t)(b * 3 + 0) * 1536 + ch] = p1;
      p.out[O_CVS + (size_t)(b * 3 + 1) * 1536 + ch] = p2;
    }
    __syncthreads();
    if (w < 2) {
      const float a0 = fq[w * 128 + lane], a1 = fq[w * 128 + 64 + lane];
      const float ss = wave_sum(a0 * a0 + a1 * a1);
      if (lane == 0) sc[w] = ss;
    }
    __syncthreads();
    const float rq = rsqrtf(sc[0] + EPS) * 0.08838834764831845f;
    const float rk = rsqrtf(sc[1] + EPS);
    __syncthreads();
    if (tid < 128) fq[tid] *= rq;
    else if (tid < 256) fk[tid - 128] *= rk;
    __syncthreads();
    if (w == 0) {
      const float qk = wave_sum(fq[lane] * fk[lane] + fq[64 + lane] * fk[64 + lane]);
      if (lane == 0) sc[2] = qk;
    }
    const float eg = __expf(GDEC[(size_t)row * 4 + h]);
    const float beta = BETA[(size_t)row * 4 + h];
    const float* S = p.state_gdn + ((size_t)(b * 4 + h) * 128) * 128;
    float* So = p.out + O_GDS + ((size_t)(b * 4 + h) * 128) * 128;
    float sd[32];
    float ks_ = 0.f, qs_ = 0.f;
#pragma unroll
    for (int i = 0; i < 32; ++i) {
      const int k = kp * 32 + i;
      sd[i] = eg * S[k * 128 + n];
      ks_ += fk[k] * sd[i];
      qs_ += fq[k] * sd[i];
    }
    red[kp * 128 + n] = ks_;
    red[512 + kp * 128 + n] = qs_;
    __syncthreads();
    const float kS = red[n] + red[128 + n] + red[256 + n] + red[384 + n];
    const float delta = (fv[n] - kS) * beta;
#pragma unroll
    for (int i = 0; i < 32; ++i) {
      const int k = kp * 32 + i;
      So[k * 128 + n] = sd[i] + fk[k] * delta;
    }
    if (tid < 128) {
      const float qS = red[512 + n] + red[640 + n] + red[768 + n] + red[896 + n];
      OPRE[(size_t)row * 1024 + 512 + h * 128 + n] = qS + sc[2] * delta;
    }
    __syncthreads();
  }
}

__device__ void sample_block4(const Params& p, char* smem, int bid) {
  const int tid = opaque_tid(), lane = tid & 63, w = tid >> 6;
  const u16* PQ = (const u16*)(p.ws + W_PQ);
  const float* LF = (const float*)(p.ws + W_LF);
  const float* BETA = (const float*)(p.ws + W_BETA);
  const float* GDEC = (const float*)(p.ws + W_GDEC);
  float* OPRE = (float*)(p.ws + W_PQ);
  float* vec = (float*)smem;
  float* red = vec + 2048;
  float* sc = red + 1024;
  if (tid < 256) {
    const int j = tid >> 7, c = tid & 127;
    const int it = bid + 256 * j, b = (it >> 2) & 127, h = it & 3, row = MP + b;
    const float f = __expf(LF[(size_t)row * 512 + h * 128 + c]);
    vec[(j * 4 + 0) * 128 + c] = bf2f(PQ[(size_t)row * PQW + h * 128 + c]);
    vec[(j * 4 + 1) * 128 + c] = 1.f - f;
    vec[(j * 4 + 2) * 128 + c] = bf2f(PQ[(size_t)row * PQW + 512 + h * 128 + c]);
    vec[(j * 4 + 3) * 128 + c] = f;
  }
  for (int e = tid; e < 768; e += 512) {
    const int j = 2 + e / 384, r = e % 384, ty = r >> 7, cc = r & 127;
    const int it = bid + 256 * j, b = (it >> 2) & 127, h = it & 3, row = MP + b;
    const int ch = ty * 512 + h * 128 + cc;
    const float* cprev = p.state_conv + (size_t)b * 3 * 1536;
    const float p0 = cprev[ch], p1 = cprev[1536 + ch], p2 = cprev[3072 + ch];
    const float nw = bf2f(PQ[(size_t)row * PQW + 1024 + ch]);
    const float s = p.conv_w[ch] * p0 + p.conv_w[1536 + ch] * p1 + p.conv_w[3072 + ch] * p2 + p.conv_w[4608 + ch] * nw;
    vec[(j * 4 + ty) * 128 + cc] = siluf_(s);
    p.out[O_CVS + (size_t)(b * 3 + 0) * 1536 + ch] = p1;
    p.out[O_CVS + (size_t)(b * 3 + 1) * 1536 + ch] = p2;
  }
  __syncthreads();
  if (w < 4) {
    const int j = 2 + (w >> 1), which = w & 1;
    const float a0 = vec[(j * 4 + which) * 128 + lane], a1 = vec[(j * 4 + which) * 128 + 64 + lane];
    const float ss = wave_sum(a0 * a0 + a1 * a1);
    if (lane == 0) sc[j * 4 + which] = ss;
  }
  __syncthreads();
  {
    const int j = 2 + (tid >> 8), which = (tid >> 7) & 1, c = tid & 127;
    const float r = which == 0 ? rsqrtf(sc[j * 4 + 0] + EPS) * 0.08838834764831845f : rsqrtf(sc[j * 4 + 1] + EPS);
    vec[(j * 4 + which) * 128 + c] *= r;
  }
  __syncthreads();
  if (w < 2) {
    const int j = 2 + w;
    const float qk = wave_sum(vec[(j * 4 + 0) * 128 + lane] * vec[(j * 4 + 1) * 128 + lane] +
                              vec[(j * 4 + 0) * 128 + 64 + lane] * vec[(j * 4 + 1) * 128 + 64 + lane]);
    if (lane == 0) sc[j * 4 + 2] = qk;
  }
  __syncthreads();
  const int n = tid & 127, kp = tid >> 7;
  float cur[32], nxt[32];
  {
    const int it = bid, b = (it >> 2) & 127, h = it & 3;
    const float* S = p.state_hgrn + ((size_t)(b * 4 + h) * 128) * 128;
#pragma unroll
    for (int i = 0; i < 32; ++i) cur[i] = S[(kp * 32 + i) * 128 + n];
  }
#pragma unroll
  for (int j = 0; j < 4; ++j) {
    const int it = bid + 256 * j, b = (it >> 2) & 127, h = it & 3, row = MP + b;
    if (j < 3) {
      const int it2 = bid + 256 * (j + 1), b2 = (it2 >> 2) & 127, h2 = it2 & 3;
      const float* S2 = ((j + 1) < 2 ? p.state_hgrn : p.state_gdn) + ((size_t)(b2 * 4 + h2) * 128) * 128;
#pragma unroll
      for (int i = 0; i < 32; ++i) nxt[i] = S2[(kp * 32 + i) * 128 + n];
    }
    const float* fq = vec + (j * 4 + 0) * 128;
    const float* fk = vec + (j * 4 + 1) * 128;
    const float* fv = vec + (j * 4 + 2) * 128;
    const float* fe = vec + (j * 4 + 3) * 128;
    if (j < 2) {
      float* So = p.out + O_HGS + ((size_t)(b * 4 + h) * 128) * 128;
      const float vn = fv[n];
      float o = 0.f;
#pragma unroll
      for (int i = 0; i < 32; ++i) {
        const int k = kp * 32 + i;
        const float sn = fe[k] * cur[i] + fk[k] * vn;
        So[k * 128 + n] = sn;
        o += fq[k] * sn;
      }
      red[kp * 128 + n] = o;
      __syncthreads();
      if (tid < 128) OPRE[(size_t)row * 1024 + h * 128 + tid] = red[tid] + red[128 + tid] + red[256 + tid] + red[384 + tid];
      __syncthreads();
    } else {
      float* So = p.out + O_GDS + ((size_t)(b * 4 + h) * 128) * 128;
      const float eg = __expf(GDEC[(size_t)row * 4 + h]);
      const float beta = BETA[(size_t)row * 4 + h];
      float ks_ = 0.f, qs_ = 0.f;
#pragma unroll
      for (int i = 0; i < 32; ++i) {
        const int k = kp * 32 + i;
        cur[i] *= eg;
        ks_ += fk[k] * cur[i];
        qs_ += fq[k] * cur[i];
      }
      red[kp * 128 + n] = ks_;
      red[512 + kp * 128 + n] = qs_;
      __syncthreads();
      const float kS = red[n] + red[128 + n] + red[256 + n] + red[384 + n];
      const float delta = (fv[n] - kS) * beta;
#pragma unroll
      for (int i = 0; i < 32; ++i) {
        const int k = kp * 32 + i;
        So[k * 128 + n] = cur[i] + fk[k] * delta;
      }
      if (tid < 128) {
        const float qS = red[512 + n] + red[640 + n] + red[768 + n] + red[896 + n];
        OPRE[(size_t)row * 1024 + 512 + h * 128 + n] = qS + sc[j * 4 + 2] * delta;
      }
      __syncthreads();
    }
#pragma unroll
    for (int i = 0; i < 32; ++i) cur[i] = nxt[i];
  }
}

__device__ void phase3(const Params& p, char* smem, int bid, int nb) {
  for (int u = bid; u < 256; u += nb) {
    int uu = u;
    if (nb == 256) {
      const int xcd = u & 7, j = u >> 3;
      uu = ((xcd * 8 + (j >> 2)) << 2) | (j & 3);
    }
    if (uu < 128) scan_unit<0>(p, smem, uu); else scan_unit<1>(p, smem, uu - 128);
    if (DUP_MASK & 256) { if (uu < 128) scan_unit<0>(p, smem, uu); else scan_unit<1>(p, smem, uu - 128); }
  }
  if (nb == 256) sample_block4(p, smem, bid);
  else for (int it = bid; it < 1024; it += nb) sample_item(p, smem, it);
}

__device__ void phase4(const Params& p, int bid, int nb) {
  const int tid = opaque_tid(), lane = tid & 63, w = tid >> 6;
  const float* OPRE = (const float*)(p.ws + W_PQ);
  const u16* GATES = (const u16*)(p.ws + W_GATES);
  u16* A2 = (u16*)(p.ws + W_QS);
  constexpr int NG = MT / 8;
  for (int g = bid; g < NG; g += 2 * nb) {
    const bool two = (g + nb) < NG;
    const int rows[2] = {g * 8 + w, (two ? g + nb : g) * 8 + w};
    f32x4 v[2][4];
    u32x2 gt[2][4];
#pragma unroll
    for (int r = 0; r < 2; ++r)
#pragma unroll
      for (int i = 0; i < 4; ++i) {
        const int col = i * 256 + lane * 4;
        v[r][i] = *(const f32x4*)(OPRE + (size_t)rows[r] * 1024 + col);
        gt[r][i] = *(const u32x2*)(GATES + (size_t)rows[r] * 1024 + col);
      }
#pragma unroll
    for (int r = 0; r < 2; ++r) {
      if (r == 1 && !two) break;
#pragma unroll
      for (int i = 0; i < 4; ++i) {
        const int col = i * 256 + lane * 4;
        float ss = v[r][i][0] * v[r][i][0] + v[r][i][1] * v[r][i][1] + v[r][i][2] * v[r][i][2] + v[r][i][3] * v[r][i][3];
        ss += dpp_mov<0xB1, 0xf>(ss);
        ss += dpp_mov<0x4E, 0xf>(ss);
        ss += dpp_mov<0x141, 0xf>(ss);
        ss += dpp_mov<0x140, 0xf>(ss);
        ss += __shfl_xor(ss, 16, 64);
        const float rstd = rsqrtf(ss * (1.f / 128.f) + EPS);
        const f32x4 nw = *(const f32x4*)((col < 512 ? p.hg_norm : p.gdn_norm) + (col & 127));
        float gg[4];
        unpack4(gt[r][i], gg);
        *(u32x2*)(A2 + (size_t)rows[r] * LDK + col) =
            u32x2{pack2(v[r][i][0] * rstd * nw[0] * gg[0], v[r][i][1] * rstd * nw[1] * gg[1]),
                  pack2(v[r][i][2] * rstd * nw[2] * gg[2], v[r][i][3] * rstd * nw[3] * gg[3])};
      }
    }
  }
}

__device__ void phase6(const Params& p, int bid, int nb) {
  const int tid = opaque_tid(), lane = tid & 63, w = tid >> 6;
  constexpr int NG = MT / 8;
  for (int g = bid; g < NG; g += 2 * nb) {
    const bool two = (g + nb) < NG;
    const int rows[2] = {g * 8 + w, (two ? g + nb : g) * 8 + w};
    float* y[2];
    float4 xv[2][4];
    float ss[2] = {0.f, 0.f};
#pragma unroll
    for (int r = 0; r < 2; ++r) {
      y[r] = rows[r] < MP ? p.out + O_YP + (size_t)rows[r] * 1024 : p.out + O_YS + (size_t)(rows[r] - MP) * 1024;
#pragma unroll
      for (int i = 0; i < 4; ++i) xv[r][i] = *(const float4*)(y[r] + i * 256 + lane * 4);
    }
#pragma unroll
    for (int r = 0; r < 2; ++r) {
#pragma unroll
      for (int i = 0; i < 4; ++i) ss[r] += xv[r][i].x * xv[r][i].x + xv[r][i].y * xv[r][i].y + xv[r][i].z * xv[r][i].z + xv[r][i].w * xv[r][i].w;
      ss[r] = wave_sum(ss[r]);
    }
#pragma unroll
    for (int r = 0; r < 2; ++r) {
      if (r == 1 && !two) break;
      const float rstd = rsqrtf(ss[r] * (1.f / 1024.f) + EPS);
#pragma unroll
      for (int i = 0; i < 4; ++i) {
        const float4 nw = *(const float4*)(p.final_norm + i * 256 + lane * 4);
        float4 o;
        o.x = xv[r][i].x * rstd * nw.x; o.y = xv[r][i].y * rstd * nw.y; o.z = xv[r][i].z * rstd * nw.z; o.w = xv[r][i].w * rstd * nw.w;
        *(float4*)(y[r] + i * 256 + lane * 4) = o;
      }
    }
  }
}

template <int PH>
__device__ __forceinline__ void run_phase(const Params& p, char* smem, int bid, int nb) {
  if (PH == 0) phase0(p, smem, bid, nb);
  else if (PH == 1) gemm_phase<0>(p, (const u16*)(p.ws + W_H), (const u16*)(p.ws + W_WINT), 16, smem, bid, nb);
  else if (PH == 2) phase2(p, smem, bid, nb);
  else if (PH == 3) phase3(p, smem, bid, nb);
  else if (PH == 4) phase4(p, bid, nb);
  else if (PH == 5) gemm_phase<1>(p, (const u16*)(p.ws + W_QS), (const u16*)(p.ws + W_WOUTT), 4, smem, bid, nb);
  else phase6(p, bid, nb);
}

#if MEGA
__global__ void __launch_bounds__(NTH) mega_kernel(Params p) {
  extern __shared__ __attribute__((aligned(16))) char smem[];
  cg::grid_group grid = cg::this_grid();
  const int bid = blockIdx.x, nb = gridDim.x;
#define RUNP(k) run_phase<k>(p, smem, bid, nb); grid.sync(); if (DUP_MASK & (1 << k)) { run_phase<k>(p, smem, bid, nb); grid.sync(); }
  RUNP(0) RUNP(1) RUNP(2) RUNP(3) RUNP(4) RUNP(5)
#undef RUNP
  run_phase<6>(p, smem, bid, nb);
}
#else
template <int PH>
__global__ void __launch_bounds__(NTH) phase_kernel(Params p) {
  extern __shared__ __attribute__((aligned(16))) char smem[];
  run_phase<PH>(p, smem, blockIdx.x, gridDim.x);
}
template <int PH>
static void launch_phase(const Params& p, int grid, hipStream_t stream) {
  hipFuncSetAttribute((const void*)phase_kernel<PH>, hipFuncAttributeMaxDynamicSharedMemorySize, (int)LDS_BYTES);
  hipLaunchKernelGGL(phase_kernel<PH>, dim3(grid), dim3(NTH), LDS_BYTES, stream, p);
}
#endif

extern "C" void kernel_launch(void* const* d_in, const int* in_sizes, int n_in, void* d_out, int out_size,
                              void* d_ws, size_t ws_size, hipStream_t stream) {
  Params p{};
  p.x_prompt = (const float*)d_in[0];
  p.x_sample = (const float*)d_in[1];
  p.state_hgrn = (const float*)d_in[2];
  p.state_gdn = (const float*)d_in[3];
  p.state_conv = (const float*)d_in[4];
  p.norm_w = (const float*)d_in[5];
  p.w_in = (const float*)d_in[6];
  p.lb_logits = (const float*)d_in[7];
  p.conv_w = (const float*)d_in[8];
  p.a_log = (const float*)d_in[9];
  p.dt_bias = (const float*)d_in[10];
  p.hg_norm = (const float*)d_in[11];
  p.gdn_norm = (const float*)d_in[12];
  p.w_out = (const float*)d_in[13];
  p.final_norm = (const float*)d_in[14];
  p.out = (float*)d_out;
  p.ws = (char*)d_ws;
  if (ws_size < W_END) { fprintf(stderr, "workspace too small: %zu < %zu\n", ws_size, (size_t)W_END); return; }
#if MEGA
  static int grid_blocks = 0;
  if (!grid_blocks) {
    int dev = 0, cus = 0, per_cu = 0;
    hipGetDevice(&dev);
    hipDeviceGetAttribute(&cus, hipDeviceAttributeMultiprocessorCount, dev);
    hipFuncSetAttribute((const void*)mega_kernel, hipFuncAttributeMaxDynamicSharedMemorySize, (int)LDS_BYTES);
    hipOccupancyMaxActiveBlocksPerMultiprocessor(&per_cu, mega_kernel, NTH, LDS_BYTES);
    if (per_cu < 1) per_cu = 1;
    grid_blocks = cus * per_cu;
  }
  void* args[] = {&p};
  hipError_t e = hipLaunchCooperativeKernel((void*)mega_kernel, dim3(grid_blocks), dim3(NTH), args, LDS_BYTES, stream);
  if (e != hipSuccess) fprintf(stderr, "cooperative launch failed: %s (grid %d)\n", hipGetErrorString(e), grid_blocks);
#else
  const int grid = 256;
  launch_phase<0>(p, grid, stream);
  launch_phase<1>(p, grid, stream);
  launch_phase<2>(p, grid, stream);
  launch_phase<3>(p, grid, stream);
  launch_phase<4>(p, grid, stream);
  launch_phase<5>(p, grid, stream);
  launch_phase<6>(p, grid, stream);
#endif
}
```

```cpp
#include <hip/hip_runtime.h>
#include <hip/hip_cooperative_groups.h>
#include <cstdio>
namespace cg = cooperative_groups;

#ifndef MEGA
#define MEGA 1
#define DUP_MASK 0
#endif

typedef unsigned short u16;
using bf16x8 = __attribute__((ext_vector_type(8))) short;
using f32x4 = __attribute__((ext_vector_type(4))) float;
using u32x4 = __attribute__((ext_vector_type(4))) unsigned;
using u32x2 = __attribute__((ext_vector_type(2))) unsigned;

#define NTH 512
constexpr int MP = 16384, MS = 128, MT = 16512, DM = 1024, DIN = 4104, PQW = 2560;
constexpr float EPS = 1e-6f;
constexpr int LDK = 1088;
constexpr size_t LDS_BYTES = 139264;

constexpr size_t O_YP = 0, O_YS = 16777216, O_HGP = 16908288, O_GDP = 17432576, O_CVP = 17956864,
                 O_HGS = 17993728, O_GDS = 26382336, O_CVS = 34770944;
constexpr size_t W_WINT = 0;
constexpr size_t W_WOUTT = W_WINT + (size_t)4096 * LDK * 2;
constexpr size_t W_BETA = W_WOUTT + (size_t)1024 * LDK * 2;
constexpr size_t W_GDEC = W_BETA + 264192;
constexpr size_t W_DVEC = W_GDEC + 264192;
constexpr size_t W_DSC = W_DVEC + 1048576;
constexpr size_t W_PQ = W_DSC + 4096;
constexpr size_t W_GATES = W_PQ + 84541440;
constexpr size_t W_H = W_GATES + 33816576;
constexpr size_t W_QS = W_H + (size_t)MT * LDK * 2;
constexpr size_t W_MNEG = W_QS + 33554432;
constexpr size_t W_LF = W_MNEG + 33554432;
constexpr size_t W_END = W_LF + 33816576;

struct Params {
  const float *x_prompt, *x_sample, *state_hgrn, *state_gdn, *state_conv, *norm_w, *w_in, *lb_logits,
      *conv_w, *a_log, *dt_bias, *hg_norm, *gdn_norm, *w_out, *final_norm;
  float* out;
  char* ws;
};

__device__ __forceinline__ int opaque_tid() { int t = threadIdx.x; asm volatile("" : "+v"(t)); return t; }
typedef __bf16 bf16x2_t __attribute__((ext_vector_type(2)));
typedef float f32x2_t __attribute__((ext_vector_type(2)));
__device__ __forceinline__ u16 f2bf(float x) { return __builtin_bit_cast(u16, (__bf16)x); }
__device__ __forceinline__ float bf2f(u16 h) { return __uint_as_float(((unsigned)h) << 16); }
__device__ __forceinline__ unsigned pack2(float a, float b) {
  f32x2_t v = {a, b};
  return __builtin_bit_cast(unsigned, __builtin_convertvector(v, bf16x2_t));
}
template <int CTRL, int ROWMASK>
__device__ __forceinline__ float dpp_mov(float v) {
  return __builtin_bit_cast(float, __builtin_amdgcn_update_dpp(0, __builtin_bit_cast(int, v), CTRL, ROWMASK, 0xf, false));
}
__device__ __forceinline__ float wave_sum(float v) {
  v += dpp_mov<0xB1, 0xf>(v);
  v += dpp_mov<0x4E, 0xf>(v);
  v += dpp_mov<0x141, 0xf>(v);
  v += dpp_mov<0x140, 0xf>(v);
  v += dpp_mov<0x142, 0xa>(v);
  v += dpp_mov<0x143, 0xc>(v);
  return __builtin_bit_cast(float, __builtin_amdgcn_readlane(__builtin_bit_cast(int, v), 63));
}
__device__ __forceinline__ float sigmoidf_(float x) { return 1.f / (1.f + __expf(-x)); }
__device__ __forceinline__ float siluf_(float x) { return x / (1.f + __expf(-x)); }
__device__ __forceinline__ f32x4 mfma16(bf16x8 a, bf16x8 b, f32x4 c) {
  return __builtin_amdgcn_mfma_f32_16x16x32_bf16(a, b, c, 0, 0, 0);
}
__device__ __forceinline__ bf16x8 frag(const u16* base, int row0, int stride, int koff, int lane) {
  return *(const bf16x8*)(base + (row0 + (lane & 15)) * stride + koff + (lane >> 4) * 8);
}

__device__ __forceinline__ void quad_transpose(float (&v)[4], int lane) {
  {
    const bool b = lane & 1;
    float s0 = b ? v[0] : v[1], s1 = b ? v[2] : v[3];
    float r0 = dpp_mov<0xB1, 0xf>(s0), r1 = dpp_mov<0xB1, 0xf>(s1);
    if (b) { v[0] = r0; v[2] = r1; } else { v[1] = r0; v[3] = r1; }
  }
  {
    const bool b = lane & 2;
    float s0 = b ? v[0] : v[2], s1 = b ? v[1] : v[3];
    float r0 = dpp_mov<0x4E, 0xf>(s0), r1 = dpp_mov<0x4E, 0xf>(s1);
    if (b) { v[0] = r0; v[1] = r1; } else { v[2] = r0; v[3] = r1; }
  }
}
__device__ __forceinline__ void store4_bf16(u16* dst, const float (&v)[4]) {
  *(u32x2*)dst = u32x2{pack2(v[0], v[1]), pack2(v[2], v[3])};
}
__device__ void phase0(const Params& p, char* smem, int bid, int nb) {
  const int tid = opaque_tid(), lane = tid & 63, w = tid >> 6;
  u16* WinT = (u16*)(p.ws + W_WINT);
  u16* WoutT = (u16*)(p.ws + W_WOUTT);
  u16* H = (u16*)(p.ws + W_H);
  float* BETA = (float*)(p.ws + W_BETA);
  float* GDEC = (float*)(p.ws + W_GDEC);
  float* tl = (float*)smem;
  for (int t = bid; t < 1280; t += nb) {
    const float* src; int sstride; u16* dst; int kt, nt;
    if (t < 1024) { src = p.w_in; sstride = DIN; dst = WinT; kt = t >> 6; nt = t & 63; }
    else { int u = t - 1024; src = p.w_out; sstride = 1024; dst = WoutT; kt = u >> 4; nt = u & 15; }
#pragma unroll
    for (int i = 0; i < 8; ++i) {
      int idx = tid + 512 * i; int kk = idx >> 6, nn = idx & 63;
      tl[kk * 65 + nn] = src[(size_t)(kt * 64 + kk) * sstride + nt * 64 + nn];
    }
    __syncthreads();
    {
      int nn = tid >> 3, k8 = (tid & 7) * 8;
      unsigned pk[4];
#pragma unroll
      for (int e = 0; e < 4; ++e) pk[e] = pack2(tl[(k8 + 2 * e) * 65 + nn], tl[(k8 + 2 * e + 1) * 65 + nn]);
      *(uint4*)(dst + (size_t)(nt * 64 + nn) * LDK + kt * 64 + k8) = make_uint4(pk[0], pk[1], pk[2], pk[3]);
    }
    __syncthreads();
  }
  float* W8s = (float*)smem;
  for (int idx = tid; idx < 8192; idx += 512) {
    int j = idx & 7, k = idx >> 3;
    W8s[j * 1024 + k] = p.w_in[(size_t)k * DIN + 4096 + j];
  }
  __syncthreads();
  for (int g = bid; g < MT / 8; g += nb) {
    int row = g * 8 + w;
    const float* x = row < MP ? p.x_prompt + (size_t)row * 1024 : p.x_sample + (size_t)(row - MP) * 1024;
    float4 xv[4];
    float ss = 0.f;
#pragma unroll
    for (int i = 0; i < 4; ++i) {
      xv[i] = *(const float4*)(x + i * 256 + lane * 4);
      ss += xv[i].x * xv[i].x + xv[i].y * xv[i].y + xv[i].z * xv[i].z + xv[i].w * xv[i].w;
    }
    ss = wave_sum(ss);
    float rstd = rsqrtf(ss * (1.f / 1024.f) + EPS);
    float d0 = 0, d1 = 0, d2 = 0, d3 = 0, d4 = 0, d5 = 0, d6 = 0, d7 = 0;
#pragma unroll
    for (int i = 0; i < 4; ++i) {
      float4 nw = *(const float4*)(p.norm_w + i * 256 + lane * 4);
      float4 hv;
      hv.x = xv[i].x * rstd * nw.x; hv.y = xv[i].y * rstd * nw.y; hv.z = xv[i].z * rstd * nw.z; hv.w = xv[i].w * rstd * nw.w;
      *(uint2*)(H + (size_t)row * LDK + i * 256 + lane * 4) = make_uint2(pack2(hv.x, hv.y), pack2(hv.z, hv.w));
#define GDOT(j, dj) { float4 wv = *(const float4*)(W8s + j * 1024 + i * 256 + lane * 4); dj += hv.x * wv.x + hv.y * wv.y + hv.z * wv.z + hv.w * wv.w; }
      GDOT(0, d0) GDOT(1, d1) GDOT(2, d2) GDOT(3, d3) GDOT(4, d4) GDOT(5, d5) GDOT(6, d6) GDOT(7, d7)
#undef GDOT
    }
    d0 = wave_sum(d0); d1 = wave_sum(d1); d2 = wave_sum(d2); d3 = wave_sum(d3);
    d4 = wave_sum(d4); d5 = wave_sum(d5); d6 = wave_sum(d6); d7 = wave_sum(d7);
    if (lane < 4) {
      float gb = lane == 0 ? d0 : lane == 1 ? d1 : lane == 2 ? d2 : d3;
      float ga = lane == 0 ? d4 : lane == 1 ? d5 : lane == 2 ? d6 : d7;
      BETA[row * 4 + lane] = 1.f / (1.f + expf(-gb));
      float z = ga + p.dt_bias[lane];
      float sp = z > 20.f ? z : log1pf(expf(z));
      GDEC[row * 4 + lane] = -expf(p.a_log[lane]) * sp;
    }
  }
  __syncthreads();
}

__device__ __forceinline__ int lds_byte2(int r, int c) {
  int st = (r >> 4) * 2 + (c >> 5), ob = (r & 15) * 64 + (c & 31) * 2;
  return st * 1024 + (ob ^ (((ob >> 9) & 1) << 5));
}
__device__ __forceinline__ void stage_rc2(int b, int& R, int& C) {
  int st = b >> 10, sb = b & 1023, swz = sb ^ (((sb >> 9) & 1) << 5);
  R = (st >> 1) * 16 + swz / 64;
  C = (st & 1) * 32 + (swz % 64) / 2;
}
template <int EPI, int SEC>
__device__ __forceinline__ void epi_store4(const Params& p, int row, int col4, const float (&v)[4]) {
  if (EPI == 0) {
    u16* PQ = (u16*)(p.ws + W_PQ);
    u16* GATES = (u16*)(p.ws + W_GATES);
    float* LF = (float*)(p.ws + W_LF);
    const int sec = SEC >= 0 ? SEC : (col4 >> 9);
    if (sec == 0) {
      *(uint2*)(PQ + (size_t)row * PQW + col4) = make_uint2(pack2(v[0], v[1]), pack2(v[2], v[3]));
    } else if (sec == 1) {
      const int cc = col4 - 512;
      const f32x4 l0 = *(const f32x4*)(p.lb_logits + cc), l1 = *(const f32x4*)(p.lb_logits + 512 + cc);
      f32x4 o;
#pragma unroll
      for (int i = 0; i < 4; ++i) {
        const float lbv = 1.f / (1.f + __expf(l1[i] - l0[i]));
        o[i] = __logf(lbv + (1.f - lbv) / (1.f + __expf(-v[i])));
      }
      *(f32x4*)(LF + (size_t)row * 512 + cc) = o;
    } else if (sec == 2) {
      *(uint2*)(PQ + (size_t)row * PQW + 512 + (col4 - 1024)) = make_uint2(pack2(v[0], v[1]), pack2(v[2], v[3]));
    } else if (sec == 3 || sec == 7) {
      const int cc = sec == 3 ? col4 - 1536 : 512 + col4 - 3584;
      *(uint2*)(GATES + (size_t)row * 1024 + cc) =
          make_uint2(pack2(v[0] / (1.f + __expf(-v[0])), v[1] / (1.f + __expf(-v[1]))),
                     pack2(v[2] / (1.f + __expf(-v[2])), v[3] / (1.f + __expf(-v[3]))));
    } else {
      const int cc = col4 - 2048;
      *(uint2*)(PQ + (size_t)row * PQW + 1024 + cc) = make_uint2(pack2(v[0], v[1]), pack2(v[2], v[3]));
      if (row < MP) {
        const int tt = row & 2047;
        if (tt >= 2045) *(f32x4*)(p.out + O_CVP + (size_t)((row >> 11) * 3 + (tt - 2045)) * 1536 + cc) = f32x4{v[0], v[1], v[2], v[3]};
      } else {
        *(f32x4*)(p.out + O_CVS + (size_t)((row - MP) * 3 + 2) * 1536 + cc) = f32x4{v[0], v[1], v[2], v[3]};
      }
    }
  } else {
    const float* xr = row < MP ? p.x_prompt + (size_t)row * 1024 : p.x_sample + (size_t)(row - MP) * 1024;
    float* yr = row < MP ? p.out + O_YP + (size_t)row * 1024 : p.out + O_YS + (size_t)(row - MP) * 1024;
    const f32x4 xv = *(const f32x4*)(xr + col4);
    *(f32x4*)(yr + col4) = f32x4{xv[0] + v[0], xv[1] + v[1], xv[2] + v[2], xv[3] + v[3]};
  }
}

template <int EPI>
__device__ void gemm_phase(const Params& p, const u16* __restrict__ A, const u16* __restrict__ Bt, int ntn,
                           char* smem, int bid, int nb) {
  const int tid = opaque_tid(), lane = tid & 63, wid = tid >> 6;
  const int wr = wid >> 2, wc = wid & 3, fr = lane & 15, fq = lane >> 4;
  constexpr int TILE_B = 256 * 64 * 2, STAGE_B = 2 * TILE_B;
  int sR0, sC0;
  stage_rc2(wid * 1024 + lane * 16, sR0, sC0);
  const unsigned goff = (unsigned)(sR0 * LDK + sC0);
  const unsigned lbase = (unsigned)(size_t)smem + (unsigned)(wid * 1024);
  const int aoff = (wr * 16) * 1024 + ((fr * 64 + fq * 16) ^ ((((fr * 64 + fq * 16) >> 9) & 1) << 5));
  const int boff = TILE_B + (wc * 8) * 1024 + ((fr * 64 + fq * 16) ^ ((((fr * 64 + fq * 16) >> 9) & 1) << 5));
  const int ntiles = 64 * ntn;
  auto tile_mn = [&](int tile, int& tm, int& tn) {
    const int rnd = tile >> 8, t = tile & 255, xcd = t & 7, j = t >> 3;
    if (ntn == 16) { tm = rnd * 16 + (xcd >> 1) * 4 + (j & 3); tn = (xcd & 1) * 8 + (j >> 2); }
    else { tm = xcd * 8 + (j & 7); tn = j >> 3; }
  };
  bool staged = false;
  for (int tile = bid; tile < ntiles; tile += nb) {
    int tm, tn;
    tile_mn(tile, tm, tn);
    const u16* Ab = A + (size_t)tm * 256 * LDK;
    const u16* Bb = Bt + (size_t)tn * 256 * LDK;
    f32x4 acc[8][4];
#pragma unroll
    for (int m = 0; m < 8; ++m)
#pragma unroll
      for (int n = 0; n < 4; ++n) acc[m][n] = f32x4{0.f, 0.f, 0.f, 0.f};
#define G_STAGE(buf, kt) { _Pragma("unroll") for (int i = 0; i < 4; ++i) { \
      __builtin_amdgcn_global_load_lds((const unsigned*)(Ab + (goff + (unsigned)(i * 64 * LDK + (kt) * 64))), \
          (__attribute__((address_space(3))) unsigned*)(lbase + (buf) * STAGE_B + i * 8192), 16, 0, 0); \
      __builtin_amdgcn_global_load_lds((const unsigned*)(Bb + (goff + (unsigned)(i * 64 * LDK + (kt) * 64))), \
          (__attribute__((address_space(3))) unsigned*)(lbase + (buf) * STAGE_B + TILE_B + i * 8192), 16, 0, 0); } }
    if (!staged) G_STAGE(0, 0);
    asm volatile("s_waitcnt vmcnt(0)" ::: "memory");
    __syncthreads();
    for (int t = 0; t < 16; ++t) {
      const int cur = t & 1;
      if (t + 1 < 16) G_STAGE(cur ^ 1, t + 1);
      const char* sA = smem + cur * STAGE_B + aoff;
      const char* sB = smem + cur * STAGE_B + boff;
#pragma unroll
      for (int ks = 0; ks < 2; ++ks) {
        bf16x8 At[8], Bf[4];
#pragma unroll
        for (int m = 0; m < 8; ++m) At[m] = *(const bf16x8*)(sA + (m * 2 + ks) * 1024);
#pragma unroll
        for (int n = 0; n < 4; ++n) Bf[n] = *(const bf16x8*)(sB + (n * 2 + ks) * 1024);
#pragma unroll
        for (int m = 0; m < 8; ++m)
#pragma unroll
          for (int n = 0; n < 4; ++n) acc[m][n] = mfma16(At[m], Bf[n], acc[m][n]);
        __builtin_amdgcn_sched_barrier(0);
      }
      asm volatile("s_waitcnt vmcnt(0)" ::: "memory");
      __syncthreads();
    }
    staged = false;
    if (tile + nb < ntiles) {
      int tm2, tn2;
      tile_mn(tile + nb, tm2, tn2);
      const u16* Ab2 = A + (size_t)tm2 * 256 * LDK;
      const u16* Bb2 = Bt + (size_t)tn2 * 256 * LDK;
      { const u16* Ab = Ab2; const u16* Bb = Bb2; G_STAGE(0, 0); }
      staged = true;
    }
#undef G_STAGE
    {
      int t2 = threadIdx.x;
      asm volatile("" : "+v"(t2));
      const int lane2 = t2 & 63, wid2 = t2 >> 6;
      const int rbase = tm * 256 + (wid2 >> 2) * 128 + (lane2 >> 4) * 4 + (lane2 & 3);
      const int cbase = tn * 256 + (wid2 & 3) * 64 + (lane2 & 12);
#define EPI_LOOP(SEC) { _Pragma("unroll") for (int m = 0; m < 8; ++m) { _Pragma("unroll") for (int n = 0; n < 4; ++n) { \
          float v[4] = {acc[m][n][0], acc[m][n][1], acc[m][n][2], acc[m][n][3]}; \
          quad_transpose(v, lane2); \
          epi_store4<EPI, SEC>(p, rbase + m * 16, cbase + n * 16, v); } } }
      if (EPI == 0) {
        const int sec = tn >> 1;
        if (sec == 0) EPI_LOOP(0) else if (sec == 1) EPI_LOOP(1) else if (sec == 2) EPI_LOOP(2)
        else if (sec == 3) EPI_LOOP(3) else if (sec == 7) EPI_LOOP(7) else EPI_LOOP(4)
      } else EPI_LOOP(0)
#undef EPI_LOOP
    }
  }
  const int nunits = ntn * 16;
  int t3 = threadIdx.x;
  asm volatile("" : "+v"(t3));
  for (int u = bid; u < nunits; u += nb) {
    const int lane = t3 & 63, wid = t3 >> 6, fr = lane & 15, fq = lane >> 4;
    const u16* ar = A + (size_t)(MP + wid * 16 + fr) * LDK + fq * 8;
    const u16* br = Bt + (size_t)(u * 16 + fr) * LDK + fq * 8;
    f32x4 acc0 = {0.f, 0.f, 0.f, 0.f}, acc1 = {0.f, 0.f, 0.f, 0.f};
#pragma unroll 4
    for (int ks = 0; ks < 32; ks += 2) {
      const bf16x8 a0 = *(const bf16x8*)(ar + ks * 32), b0 = *(const bf16x8*)(br + ks * 32);
      const bf16x8 a1 = *(const bf16x8*)(ar + ks * 32 + 32), b1 = *(const bf16x8*)(br + ks * 32 + 32);
      acc0 = mfma16(a0, b0, acc0);
      acc1 = mfma16(a1, b1, acc1);
    }
    float v[4] = {acc0[0] + acc1[0], acc0[1] + acc1[1], acc0[2] + acc1[2], acc0[3] + acc1[3]};
    quad_transpose(v, lane);
    epi_store4<EPI, -1>(p, MP + wid * 16 + fq * 4 + (lane & 3), u * 16 + (fr & ~3), v);
  }
  __syncthreads();
}

__device__ void hgrn_item(const Params& p, char* smem, int idx) {
  const int tid = opaque_tid(), lane = tid & 63, w = tid >> 6;
  const int lr = lane & 15, lq = lane >> 4;
  const int h = idx & 3, c = (idx >> 2) & 31, b = idx >> 7;
  const int r0 = b * 2048 + c * 64;
  const u16* PQ = (const u16*)(p.ws + W_PQ);
  const float* LF = (const float*)(p.ws + W_LF);
  u16* QS = (u16*)(p.ws + W_QS);
  u16* O0 = (u16*)(p.ws + W_H);
  u16* NB = (u16*)(p.out);
  float* DVEC = (float*)(p.ws + W_DVEC);
  u16* qt = (u16*)smem;
  u16* kt = qt + 64 * 136;
  u16* ktT = kt + 64 * 136;
  u16* vT = ktT + 128 * 72;
  u16* sc = vT + 128 * 72;
  float* ps = (float*)(sc + 64 * 72);
  const int col = tid & 127, part = tid >> 7;
  float lfv[16], bcum[16];
  {
    const float* lfp = LF + (size_t)(r0 + part * 16) * 512 + h * 128 + col;
#pragma unroll
    for (int i = 0; i < 16; ++i) lfv[i] = lfp[(size_t)i * 512];
    float run = 0.f;
#pragma unroll
    for (int i = 0; i < 16; ++i) { run += lfv[i]; bcum[i] = run; }
    ps[part * 128 + col] = run;
  }
  u16 qraw[16], vraw[16];
  {
    const u16* qp0 = PQ + (size_t)(r0 + part * 16) * PQW + h * 128 + col;
#pragma unroll
    for (int i = 0; i < 16; ++i) { qraw[i] = qp0[(size_t)i * PQW]; vraw[i] = qp0[(size_t)i * PQW + 512]; }
  }
  __syncthreads();
  {
    float off = 0.f, blast = 0.f;
#pragma unroll
    for (int pp = 0; pp < 4; ++pp) { float t = ps[pp * 128 + col]; blast += t; if (pp < part) off += t; }
    u16* qsout = QS + ((size_t)idx * 64 + part * 16) * 128 + col;
#pragma unroll
    for (int i = 0; i < 16; ++i) {
      const float bb = bcum[i] + off;
      const int row = part * 16 + i;
      const float q = bf2f(qraw[i]);
      const u16 v = vraw[i];
      qsout[i * 128] = f2bf(q * __expf(bb));
      qt[row * 136 + col] = f2bf(q * __expf(bb - blast));
      const float kk = (1.f - __expf(lfv[i])) * __expf(blast - bb);
      const u16 kbv = f2bf(kk);
      kt[row * 136 + col] = kbv;
      ktT[col * 72 + row] = kbv;
      vT[col * 72 + row] = v;
    }
    if (part == 0) DVEC[idx * 128 + col] = __expf(blast);
  }
  __syncthreads();
  {
    const int tr = w >> 1;
    bf16x8 a[4];
#pragma unroll
    for (int ks = 0; ks < 4; ++ks) a[ks] = frag(qt, tr * 16, 136, ks * 32, lane);
#pragma unroll
    for (int tci = 0; tci < 2; ++tci) {
      const int tc = (w & 1) * 2 + tci;
      f32x4 acc = {0.f, 0.f, 0.f, 0.f};
#pragma unroll
      for (int ks = 0; ks < 4; ++ks) acc = mfma16(a[ks], frag(kt, tc * 16, 136, ks * 32, lane), acc);
#pragma unroll
      for (int j = 0; j < 4; ++j) {
        const int t = tr * 16 + lq * 4 + j, s = tc * 16 + lr;
        sc[t * 72 + s] = f2bf(t >= s ? acc[j] : 0.f);
      }
    }
  }
  __syncthreads();
  {
    const int tr = w >> 1;
    const bf16x8 a0 = frag(sc, tr * 16, 72, 0, lane), a1 = frag(sc, tr * 16, 72, 32, lane);
#pragma unroll
    for (int tci = 0; tci < 4; ++tci) {
      const int tc = (w & 1) * 4 + tci;
      f32x4 acc = {0.f, 0.f, 0.f, 0.f};
      acc = mfma16(a0, frag(vT, tc * 16, 72, 0, lane), acc);
      acc = mfma16(a1, frag(vT, tc * 16, 72, 32, lane), acc);
      {
        float v[4] = {acc[0], acc[1], acc[2], acc[3]};
        quad_transpose(v, lane);
        store4_bf16(O0 + ((size_t)idx * 64 + tr * 16 + lq * 4 + (lane & 3)) * 128 + tc * 16 + (lr & 12), v);
      }
    }
  }
  {
    const int tr = w;
    const bf16x8 a0 = frag(ktT, tr * 16, 72, 0, lane), a1 = frag(ktT, tr * 16, 72, 32, lane);
#pragma unroll
    for (int tc = 0; tc < 8; ++tc) {
      f32x4 acc = {0.f, 0.f, 0.f, 0.f};
      acc = mfma16(a0, frag(vT, tc * 16, 72, 0, lane), acc);
      acc = mfma16(a1, frag(vT, tc * 16, 72, 32, lane), acc);
      {
        float v[4] = {acc[0], acc[1], acc[2], acc[3]};
        quad_transpose(v, lane);
        store4_bf16(NB + ((size_t)idx * 128 + tr * 16 + lq * 4 + (lane & 3)) * 128 + tc * 16 + (lr & 12), v);
      }
    }
  }
  __syncthreads();
}

template <int J>
struct SolveCol {
  static __device__ __forceinline__ void run(f32x4 (&x)[16], const float* AT) {
    if constexpr (J < 63) {
      const float xj = x[J / 4][J % 4];
#pragma unroll
      for (int B = (J + 1) / 4; B < 16; ++B) {
        const f32x4 av = *(const f32x4*)(AT + J * 64 + B * 4);
        x[B] -= av * xj;
      }
      if ((J & 3) == 3) __builtin_amdgcn_sched_barrier(0);
      SolveCol<J + 1>::run(x, AT);
    }
  }
};

__device__ void gdn_item(const Params& p, char* smem, int idx) {
  const int tid = opaque_tid(), lane = tid & 63, w = tid >> 6;
  const int lr = lane & 15, lq = lane >> 4;
  const int h = idx & 3, c = (idx >> 2) & 31, b = idx >> 7;
  const int r0 = b * 2048 + c * 64;
  const u16* PQ = (const u16*)(p.ws + W_PQ);
  const float* BETA = (const float*)(p.ws + W_BETA);
  const float* GDEC = (const float*)(p.ws + W_GDEC);
  u16* QS = (u16*)(p.ws + W_QS);
  u16* O0 = (u16*)(p.ws + W_H);
  u16* NB = (u16*)(p.out);
  u16* MNEG = (u16*)(p.ws + W_MNEG);
  float* DSC = (float*)(p.ws + W_DSC);
  u16* kb = (u16*)smem;
  u16* qb = kb + 64 * 136;
  u16* vS = qb + 64 * 136;
  float* Asol = (float*)(vS + 64 * 128);
  u16* attn = (u16*)(Asol + 64 * 64);
  u16* khT = attn + 64 * 72;
  u16* WT = khT + 128 * 72;
  u16* U0T = WT + 128 * 72;
  float* gc = (float*)(U0T + 128 * 72);
  float* bet = gc + 64;

  if (w == 0) {
    float g = GDEC[(size_t)(r0 + lane) * 4 + h];
#pragma unroll
    for (int o = 1; o < 64; o <<= 1) { float t = __shfl_up(g, o, 64); if (lane >= o) g += t; }
    gc[lane] = g;
    bet[lane] = BETA[(size_t)(r0 + lane) * 4 + h];
  }
  {
    const int chq = 1024 + h * 128 + 2 * lane;
    const int cwq = h * 128 + 2 * lane;
    float cw[3][4][2];
#pragma unroll
    for (int ty = 0; ty < 3; ++ty)
#pragma unroll
      for (int j = 0; j < 4; ++j) {
        float2 t2 = *(const float2*)(p.conv_w + j * 1536 + ty * 512 + cwq);
        cw[ty][j][0] = t2.x; cw[ty][j][1] = t2.y;
      }
    float win[3][3][2];
    const int t0 = w * 8;
#pragma unroll
    for (int a = 0; a < 3; ++a) {
      const int rr = t0 - 3 + a;
      const bool valid = (c > 0) || (rr >= 0);
#pragma unroll
      for (int ty = 0; ty < 3; ++ty) {
        unsigned u = 0;
        if (valid) u = *(const unsigned*)(PQ + (ptrdiff_t)(r0 + rr) * PQW + chq + ty * 512);
        win[ty][a][0] = bf2f((u16)(u & 0xffff)); win[ty][a][1] = bf2f((u16)(u >> 16));
      }
    }
#pragma unroll
    for (int tt = 0; tt < 8; ++tt) {
      const int t = t0 + tt;
      float cv[3][2];
#pragma unroll
      for (int ty = 0; ty < 3; ++ty) {
        unsigned u = *(const unsigned*)(PQ + (size_t)(r0 + t) * PQW + chq + ty * 512);
        float c0 = bf2f((u16)(u & 0xffff)), c1 = bf2f((u16)(u >> 16));
        float s0 = cw[ty][0][0] * win[ty][0][0] + cw[ty][1][0] * win[ty][1][0] + cw[ty][2][0] * win[ty][2][0] + cw[ty][3][0] * c0;
        float s1 = cw[ty][0][1] * win[ty][0][1] + cw[ty][1][1] * win[ty][1][1] + cw[ty][2][1] * win[ty][2][1] + cw[ty][3][1] * c1;
        win[ty][0][0] = win[ty][1][0]; win[ty][0][1] = win[ty][1][1];
        win[ty][1][0] = win[ty][2][0]; win[ty][1][1] = win[ty][2][1];
        win[ty][2][0] = c0; win[ty][2][1] = c1;
        cv[ty][0] = siluf_(s0); cv[ty][1] = siluf_(s1);
      }
      float ssq = wave_sum(cv[0][0] * cv[0][0] + cv[0][1] * cv[0][1]);
      float ssk = wave_sum(cv[1][0] * cv[1][0] + cv[1][1] * cv[1][1]);
      const float rq = rsqrtf(ssq + EPS) * 0.08838834764831845f;
      const float rk = rsqrtf(ssk + EPS);
      *(unsigned*)(qb + t * 136 + 2 * lane) = pack2(cv[0][0] * rq, cv[0][1] * rq);
      *(unsigned*)(kb + t * 136 + 2 * lane) = pack2(cv[1][0] * rk, cv[1][1] * rk);
      *(unsigned*)(vS + t * 128 + 2 * lane) = pack2(cv[2][0], cv[2][1]);
    }
  }
  __syncthreads();
  {
    const int which = w >> 2, tr = w & 3;
    const u16* Asrc = which ? qb : kb;
    bf16x8 a[4];
#pragma unroll
    for (int ks = 0; ks < 4; ++ks) a[ks] = frag(Asrc, tr * 16, 136, ks * 32, lane);
#pragma unroll
    for (int tc = 0; tc < 4; ++tc) {
      f32x4 acc = {0.f, 0.f, 0.f, 0.f};
#pragma unroll
      for (int ks = 0; ks < 4; ++ks) acc = mfma16(a[ks], frag(kb, tc * 16, 136, ks * 32, lane), acc);
#pragma unroll
      for (int j = 0; j < 4; ++j) {
        const int t = tr * 16 + lq * 4 + j, s = tc * 16 + lr;
        const float L = __expf(fminf(gc[t] - gc[s], 0.f));
        if (which == 0) Asol[s * 64 + t] = (t > s) ? bet[t] * acc[j] * L : 0.f;
        else attn[t * 72 + s] = f2bf((t >= s) ? acc[j] * L : 0.f);
      }
    }
  }
  __syncthreads();
  if (tid < 256) {
    f32x4 x[16];
    if (tid < 128) {
#pragma unroll
      for (int s = 0; s < 64; ++s) { x[s >> 2][s & 3] = bf2f(vS[s * 128 + tid]) * bet[s]; if ((s & 7) == 7) __builtin_amdgcn_sched_barrier(0); }
    } else {
#pragma unroll
      for (int s = 0; s < 64; ++s) { x[s >> 2][s & 3] = bf2f(kb[s * 136 + tid - 128]) * bet[s] * __expf(gc[s]); if ((s & 7) == 7) __builtin_amdgcn_sched_barrier(0); }
    }
    SolveCol<0>::run(x, Asol);
    u16* dst = (tid < 128) ? (U0T + tid * 72) : (WT + (tid - 128) * 72);
#pragma unroll
    for (int s8 = 0; s8 < 8; ++s8) {
      *(u32x4*)(dst + s8 * 8) = u32x4{pack2(x[2 * s8][0], x[2 * s8][1]), pack2(x[2 * s8][2], x[2 * s8][3]),
                                      pack2(x[2 * s8 + 1][0], x[2 * s8 + 1][1]), pack2(x[2 * s8 + 1][2], x[2 * s8 + 1][3])};
    }
  } else {
    const float glast = gc[63];
    const int e0 = tid - 256;
#pragma unroll 4
    for (int i = 0; i < 32; ++i) {
      const int e = e0 + 256 * i;
      const int s = e & 63, kd = e >> 6;
      khT[kd * 72 + s] = f2bf(bf2f(kb[s * 136 + kd]) * __expf(glast - gc[s]));
    }
  }
  __syncthreads();
  {
    const int tr = w & 3, half = w >> 2;
    const u16* Bsrc = half ? U0T : WT;
    const bf16x8 a0 = frag(attn, tr * 16, 72, 0, lane), a1 = frag(attn, tr * 16, 72, 32, lane);
#pragma unroll 2
    for (int tc = 0; tc < 8; ++tc) {
      f32x4 acc = {0.f, 0.f, 0.f, 0.f};
      acc = mfma16(a0, frag(Bsrc, tc * 16, 72, 0, lane), acc);
      acc = mfma16(a1, frag(Bsrc, tc * 16, 72, 32, lane), acc);
      {
        float v[4];
#pragma unroll
        for (int j = 0; j < 4; ++j) {
          const int t = tr * 16 + lq * 4 + j, n = tc * 16 + lr;
          v[j] = half == 0 ? bf2f(qb[t * 136 + n]) * __expf(gc[t]) - acc[j] : acc[j];
        }
        quad_transpose(v, lane);
        const size_t o = ((size_t)(1024 + idx) * 64 + tr * 16 + lq * 4 + (lane & 3)) * 128 + tc * 16 + (lr & 12);
        store4_bf16((half == 0 ? QS : O0) + o, v);
      }
    }
  }
  {
    const int tr = w;
    const bf16x8 a0 = frag(khT, tr * 16, 72, 0, lane), a1 = frag(khT, tr * 16, 72, 32, lane);
#pragma unroll 2
    for (int tc = 0; tc < 16; ++tc) {
      const u16* Bsrc = tc < 8 ? WT : U0T;
      const int tcc = tc & 7;
      f32x4 acc = {0.f, 0.f, 0.f, 0.f};
      acc = mfma16(a0, frag(Bsrc, tcc * 16, 72, 0, lane), acc);
      acc = mfma16(a1, frag(Bsrc, tcc * 16, 72, 32, lane), acc);
      {
        float v[4];
#pragma unroll
        for (int j = 0; j < 4; ++j) v[j] = tc < 8 ? -acc[j] : acc[j];
        quad_transpose(v, lane);
        const size_t o = (size_t)(tr * 16 + lq * 4 + (lane & 3)) * 128 + tcc * 16 + (lr & 12);
        store4_bf16((tc < 8 ? MNEG + (size_t)idx * 16384 : NB + (size_t)(1024 + idx) * 16384) + o, v);
      }
    }
  }
  if (tid < 128) ((float*)(p.ws + W_DVEC))[(size_t)(1024 + idx) * 128 + tid] = __expf(gc[63]);
  __syncthreads();
}

__device__ void phase2(const Params& p, char* smem, int bid, int nb) {
  for (int it = bid; it < 2048; it += nb) {
    if (it >= 1024) { gdn_item(p, smem, it - 1024); if (DUP_MASK & 2048) gdn_item(p, smem, it - 1024); }
    else { hgrn_item(p, smem, it); if (DUP_MASK & 1024) hgrn_item(p, smem, it); }
  }
}

struct ScanRegs {
  bf16x8 Aq[4];
  bf16x8 Am[4];
  u32x2 o0, nn0, nn1;
  f32x4 dd;
};
#define RAW_BARRIER() do { asm volatile("s_waitcnt lgkmcnt(0)" ::: "memory"); __builtin_amdgcn_s_barrier(); asm volatile("" ::: "memory"); } while (0)

template <int TYPE>
__device__ __forceinline__ void scan_load(ScanRegs& r, const Params& p, int idx, unsigned qoff, unsigned ooff, unsigned moff,
                                          unsigned noff, unsigned doff) {
  const int ii = __builtin_amdgcn_readfirstlane(idx);
  const int ti = TYPE * 1024 + ii;
  const u16* QSb = (const u16*)(p.ws + W_QS) + (size_t)ti * 8192;
  const u16* O0b = (const u16*)(p.ws + W_H) + (size_t)ti * 8192;
  const u16* NBb = (const u16*)(p.out) + (size_t)ti * 16384;
#pragma unroll
  for (int ks = 0; ks < 4; ++ks) r.Aq[ks] = *(const bf16x8*)(QSb + (qoff + ks * 32));
  r.o0 = *(const u32x2*)(O0b + ooff);
  r.nn0 = *(const u32x2*)(NBb + noff);
  r.nn1 = *(const u32x2*)(NBb + (noff + 16));
  if (TYPE == 1) {
    const u16* Mb = (const u16*)(p.ws + W_MNEG) + (size_t)ii * 16384;
#pragma unroll
    for (int ks = 0; ks < 4; ++ks) r.Am[ks] = *(const bf16x8*)(Mb + (moff + ks * 32));
  }
  r.dd = *(const f32x4*)((const float*)(p.ws + W_DVEC) + (size_t)ti * 128 + doff);
}
__device__ __forceinline__ void unpack4(u32x2 u, float (&v)[4]) {
  v[0] = bf2f((u16)(u[0] & 0xffff)); v[1] = bf2f((u16)(u[0] >> 16));
  v[2] = bf2f((u16)(u[1] & 0xffff)); v[3] = bf2f((u16)(u[1] >> 16));
}

template <int TYPE>
__device__ void scan_unit(const Params& p, char* smem, int rem) {
  const int tid = opaque_tid(), lane = tid & 63, w = tid >> 6;
  const int lr = lane & 15, lq = lane >> 4;
  const int b = rem >> 4, h = (rem >> 2) & 3, vs2 = rem & 3;
  const int tr = lq * 4 + (lane & 3), tc4 = lr & 12;
  const int otr = w & 3, otc = w >> 2;
  float* OPRE = (float*)(p.ws + W_PQ);
  u16* SbT = (u16*)smem;
  for (int i = tid; i < 2 * 32 * 136; i += 512) SbT[i] = 0;
  f32x4 S0 = {0.f, 0.f, 0.f, 0.f}, S1 = {0.f, 0.f, 0.f, 0.f};
  const unsigned qoff = (unsigned)((otr * 16 + lr) * 128 + lq * 8);
  const unsigned ooff = (unsigned)((otr * 16 + tr) * 128 + vs2 * 32 + otc * 16 + tc4);
  const unsigned moff = (unsigned)((w * 16 + lr) * 128 + lq * 8);
  const unsigned noff = (unsigned)((w * 16 + tr) * 128 + vs2 * 32 + tc4);
  const unsigned doff = (unsigned)(w * 16 + lq * 4);
  float* const orow = OPRE + (size_t)(b * 2048 + otr * 16 + tr) * 1024 + TYPE * 512 + h * 128 + vs2 * 32 + otc * 16 + tc4;
  ScanRegs r0, r1, r2, r3;
  const int idx0 = (b * 32) * 4 + h;
  scan_load<TYPE>(r0, p, idx0 + 0, qoff, ooff, moff, noff, doff);
  scan_load<TYPE>(r1, p, idx0 + 4, qoff, ooff, moff, noff, doff);
  scan_load<TYPE>(r2, p, idx0 + 8, qoff, ooff, moff, noff, doff);
  scan_load<TYPE>(r3, p, idx0 + 12, qoff, ooff, moff, noff, doff);
  __builtin_amdgcn_sched_barrier(0);
#define SCAN_STEP(R, c) { \
    RAW_BARRIER(); \
    const u16* Sb = SbT + ((c) & 1) * 32 * 136 + lr * 136 + lq * 8; \
    bf16x8 B0[4], B1[4], Bo[4]; \
    _Pragma("unroll") for (int ks = 0; ks < 4; ++ks) { \
      B0[ks] = *(const bf16x8*)(Sb + ks * 32); \
      B1[ks] = *(const bf16x8*)(Sb + 16 * 136 + ks * 32); \
      Bo[ks] = *(const bf16x8*)(Sb + otc * 16 * 136 + ks * 32); } \
    { \
      float ov[4]; unpack4(R.o0, ov); quad_transpose(ov, lane); \
      f32x4 acc = {ov[0], ov[1], ov[2], ov[3]}; \
      _Pragma("unroll") for (int ks = 0; ks < 4; ++ks) acc = mfma16(R.Aq[ks], Bo[ks], acc); \
      float o[4] = {acc[0], acc[1], acc[2], acc[3]}; \
      quad_transpose(o, lane); \
      *(f32x4*)(orow + (size_t)(c) * 65536) = f32x4{o[0], o[1], o[2], o[3]}; \
    } \
    float n0[4], n1[4]; unpack4(R.nn0, n0); unpack4(R.nn1, n1); \
    quad_transpose(n0, lane); quad_transpose(n1, lane); \
    f32x4 T0, T1; \
    _Pragma("unroll") for (int j = 0; j < 4; ++j) { T0[j] = R.dd[j] * S0[j] + n0[j]; T1[j] = R.dd[j] * S1[j] + n1[j]; } \
    if (TYPE == 1) { _Pragma("unroll") for (int ks = 0; ks < 4; ++ks) { T0 = mfma16(R.Am[ks], B0[ks], T0); T1 = mfma16(R.Am[ks], B1[ks], T1); } } \
    S0 = T0; S1 = T1; \
    u16* Sw = SbT + (((c) + 1) & 1) * 32 * 136 + lr * 136 + w * 16 + lq * 4; \
    *(u32x2*)(Sw) = u32x2{pack2(S0[0], S0[1]), pack2(S0[2], S0[3])}; \
    *(u32x2*)(Sw + 16 * 136) = u32x2{pack2(S1[0], S1[1]), pack2(S1[2], S1[3])}; \
    __builtin_amdgcn_sched_barrier(0); \
    scan_load<TYPE>(R, p, idx0 + (((c) + 4 < 32) ? (c) + 4 : 31) * 4, qoff, ooff, moff, noff, doff); \
    __builtin_amdgcn_sched_barrier(0); \
  }
  for (int c0 = 0; c0 < 32; c0 += 4) {
    SCAN_STEP(r0, c0)
    SCAN_STEP(r1, c0 + 1)
    SCAN_STEP(r2, c0 + 2)
    SCAN_STEP(r3, c0 + 3)
  }
#undef SCAN_STEP
  float* so = p.out + (TYPE ? O_GDP : O_HGP) + (size_t)(b * 4 + h) * 16384 + (w * 16 + tr) * 128 + vs2 * 32 + tc4;
  {
    float sv[4] = {S0[0], S0[1], S0[2], S0[3]};
    quad_transpose(sv, lane);
    *(f32x4*)(so) = f32x4{sv[0], sv[1], sv[2], sv[3]};
    float sw[4] = {S1[0], S1[1], S1[2], S1[3]};
    quad_transpose(sw, lane);
    *(f32x4*)(so + 16) = f32x4{sw[0], sw[1], sw[2], sw[3]};
  }
  __syncthreads();
}

__device__ void sample_item(const Params& p, char* smem, int it) {
  const int tid = opaque_tid(), lane = tid & 63, w = tid >> 6;
  const int type = it >> 9, b = (it >> 2) & 127, h = it & 3;
  const int row = MP + b;
  const u16* PQ = (const u16*)(p.ws + W_PQ);
  const float* LF = (const float*)(p.ws + W_LF);
  const float* BETA = (const float*)(p.ws + W_BETA);
  const float* GDEC = (const float*)(p.ws + W_GDEC);
  float* OPRE = (float*)(p.ws + W_PQ);
  float* fq = (float*)smem;
  float* fk = fq + 128;
  float* fv = fk + 128;
  float* fe = fv + 128;
  float* red = fe + 128;
  float* sc = red + 1024;
  const int n = tid & 127, kp = tid >> 7;
  if (type == 0) {
    if (tid < 128) {
      const float lf = LF[(size_t)row * 512 + h * 128 + tid];
      const float f = __expf(lf);
      fe[tid] = f;
      fk[tid] = 1.f - f;
      fq[tid] = bf2f(PQ[(size_t)row * PQW + h * 128 + tid]);
      fv[tid] = bf2f(PQ[(size_t)row * PQW + 512 + h * 128 + tid]);
    }
    __syncthreads();
    const float* S = p.state_hgrn + ((size_t)(b * 4 + h) * 128) * 128;
    float* So = p.out + O_HGS + ((size_t)(b * 4 + h) * 128) * 128;
    const float vn = fv[n];
    float o = 0.f;
#pragma unroll
    for (int i = 0; i < 32; ++i) {
      const int k = kp * 32 + i;
      const float sn = fe[k] * S[k * 128 + n] + fk[k] * vn;
      So[k * 128 + n] = sn;
      o += fq[k] * sn;
    }
    red[kp * 128 + n] = o;
    __syncthreads();
    if (tid < 128) OPRE[(size_t)row * 1024 + h * 128 + tid] = red[tid] + red[128 + tid] + red[256 + tid] + red[384 + tid];
    __syncthreads();
  } else {
    const float* cprev = p.state_conv + (size_t)b * 3 * 1536;
    if (tid < 384) {
      const int ty = tid >> 7, cc = tid & 127;
      const int ch = ty * 512 + h * 128 + cc;
      const float p0 = cprev[ch], p1 = cprev[1536 + ch], p2 = cprev[3072 + ch];
      const float nw = bf2f(PQ[(size_t)row * PQW + 1024 + ch]);
      const float s = p.conv_w[ch] * p0 + p.conv_w[1536 + ch] * p1 + p.conv_w[3072 + ch] * p2 + p.conv_w[4608 + ch] * nw;
      fq[ty * 128 + cc] = siluf_(s);
      p.out[O_CVS + (size_t)(b * 3 + 0) * 1536 + ch] = p1;
      p.out[O_CVS + (size_t)(b * 3 + 1) * 1536 + ch] = p2;
    }
    __syncthreads();
    if (w < 2) {
      const float a0 = fq[w * 128 + lane], a1 = fq[w * 128 + 64 + lane];
      const float ss = wave_sum(a0 * a0 + a1 * a1);
      if (lane == 0) sc[w] = ss;
    }
    __syncthreads();
    const float rq = rsqrtf(sc[0] + EPS) * 0.08838834764831845f;
    const float rk = rsqrtf(sc[1] + EPS);
    __syncthreads();
    if (tid < 128) fq[tid] *= rq;
    else if (tid < 256) fk[tid - 128] *= rk;
    __syncthreads();
    if (w == 0) {
      const float qk = wave_sum(fq[lane] * fk[lane] + fq[64 + lane] * fk[64 + lane]);
      if (lane == 0) sc[2] = qk;
    }
    const float eg = __expf(GDEC[(size_t)row * 4 + h]);
    const float beta = BETA[(size_t)row * 4 + h];
    const float* S = p.state_gdn + ((size_t)(b * 4 + h) * 128) * 128;
    float* So = p.out + O_GDS + ((size_t)(b * 4 + h) * 128) * 128;
    float sd[32];
    float ks_ = 0.f, qs_ = 0.f;
#pragma unroll
    for (int i = 0; i < 32; ++i) {
      const int k = kp * 32 + i;
      sd[i] = eg * S[k * 128 + n];
      ks_ += fk[k] * sd[i];
      qs_ += fq[k] * sd[i];
    }
    red[kp * 128 + n] = ks_;
    red[512 + kp * 128 + n] = qs_;
    __syncthreads();
    const float kS = red[n] + red[128 + n] + red[256 + n] + red[384 + n];
    const float delta = (fv[n] - kS) * beta;
#pragma unroll
    for (int i = 0; i < 32; ++i) {
      const int k = kp * 32 + i;
      So[k * 128 + n] = sd[i] + fk[k] * delta;
    }
    if (tid < 128) {
      const float qS = red[512 + n] + red[640 + n] + red[768 + n] + red[896 + n];
      OPRE[(size_t)row * 1024 + 512 + h * 128 + n] = qS + sc[2] * delta;
    }
    __syncthreads();
  }
}

__device__ void sample_block4(const Params& p, char* smem, int bid) {
  const int tid = opaque_tid(), lane = tid & 63, w = tid >> 6;
  const u16* PQ = (const u16*)(p.ws + W_PQ);
  const float* LF = (const float*)(p.ws + W_LF);
  const float* BETA = (const float*)(p.ws + W_BETA);
  const float* GDEC = (const float*)(p.ws + W_GDEC);
  float* OPRE = (float*)(p.ws + W_PQ);
  float* vec = (float*)smem;
  float* red = vec + 2048;
  float* sc = red + 1024;
  if (tid < 256) {
    const int j = tid >> 7, c = tid & 127;
    const int it = bid + 256 * j, b = (it >> 2) & 127, h = it & 3, row = MP + b;
    const float f = __expf(LF[(size_t)row * 512 + h * 128 + c]);
    vec[(j * 4 + 0) * 128 + c] = bf2f(PQ[(size_t)row * PQW + h * 128 + c]);
    vec[(j * 4 + 1) * 128 + c] = 1.f - f;
    vec[(j * 4 + 2) * 128 + c] = bf2f(PQ[(size_t)row * PQW + 512 + h * 128 + c]);
    vec[(j * 4 + 3) * 128 + c] = f;
  }
  for (int e = tid; e < 768; e += 512) {
    const int j = 2 + e / 384, r = e % 384, ty = r >> 7, cc = r & 127;
    const int it = bid + 256 * j, b = (it >> 2) & 127, h = it & 3, row = MP + b;
    const int ch = ty * 512 + h * 128 + cc;
    const float* cprev = p.state_conv + (size_t)b * 3 * 1536;
    const float p0 = cprev[ch], p1 = cprev[1536 + ch], p2 = cprev[3072 + ch];
    const float nw = bf2f(PQ[(size_t)row * PQW + 1024 + ch]);
    const float s = p.conv_w[ch] * p0 + p.conv_w[1536 + ch] * p1 + p.conv_w[3072 + ch] * p2 + p.conv_w[4608 + ch] * nw;
    vec[(j * 4 + ty) * 128 + cc] = siluf_(s);
    p.out[O_CVS + (size_t)(b * 3 + 0) * 1536 + ch] = p1;
    p.out[O_CVS + (size_t)(b * 3 + 1) * 1536 + ch] = p2;
  }
  __syncthreads();
  if (w < 4) {
    const int j = 2 + (w >> 1), which = w & 1;
    const float a0 = vec[(j * 4 + which) * 128 + lane], a1 = vec[(j * 4 + which) * 128 + 64 + lane];
    const float ss = wave_sum(a0 * a0 + a1 * a1);
    if (lane == 0) sc[j * 4 + which] = ss;
  }
  __syncthreads();
  {
    const int j = 2 + (tid >> 8), which = (tid >> 7) & 1, c = tid & 127;
    const float r = which == 0 ? rsqrtf(sc[j * 4 + 0] + EPS) * 0.08838834764831845f : rsqrtf(sc[j * 4 + 1] + EPS);
    vec[(j * 4 + which) * 128 + c] *= r;
  }
  __syncthreads();
  if (w < 2) {
    const int j = 2 + w;
    const float qk = wave_sum(vec[(j * 4 + 0) * 128 + lane] * vec[(j * 4 + 1) * 128 + lane] +
                              vec[(j * 4 + 0) * 128 + 64 + lane] * vec[(j * 4 + 1) * 128 + 64 + lane]);
    if (lane == 0) sc[j * 4 + 2] = qk;
  }
  __syncthreads();
  const int n = tid & 127, kp = tid >> 7;
  float cur[32], nxt[32];
  {
    const int it = bid, b = (it >> 2) & 127, h = it & 3;
    const float* S = p.state_hgrn + ((size_t)(b * 4 + h) * 128) * 128;
#pragma unroll
    for (int i = 0; i < 32; ++i) cur[i] = S[(kp * 32 + i) * 128 + n];
  }
#pragma unroll
  for (int j = 0; j < 4; ++j) {
    const int it = bid + 256 * j, b = (it >> 2) & 127, h = it & 3, row = MP + b;
    if (j < 3) {
      const int it2 = bid + 256 * (j + 1), b2 = (it2 >> 2) & 127, h2 = it2 & 3;
      const float* S2 = ((j + 1) < 2 ? p.state_hgrn : p.state_gdn) + ((size_t)(b2 * 4 + h2) * 128) * 128;
#pragma unroll
      for (int i = 0; i < 32; ++i) nxt[i] = S2[(kp * 32 + i) * 128 + n];
    }
    const float* fq = vec + (j * 4 + 0) * 128;
    const float* fk = vec + (j * 4 + 1) * 128;
    const float* fv = vec + (j * 4 + 2) * 128;
    const float* fe = vec + (j * 4 + 3) * 128;
    if (j < 2) {
      float* So = p.out + O_HGS + ((size_t)(b * 4 + h) * 128) * 128;
      const float vn = fv[n];
      float o = 0.f;
#pragma unroll
      for (int i = 0; i < 32; ++i) {
        const int k = kp * 32 + i;
        const float sn = fe[k] * cur[i] + fk[k] * vn;
        So[k * 128 + n] = sn;
        o += fq[k] * sn;
      }
      red[kp * 128 + n] = o;
      __syncthreads();
      if (tid < 128) OPRE[(size_t)row * 1024 + h * 128 + tid] = red[tid] + red[128 + tid] + red[256 + tid] + red[384 + tid];
      __syncthreads();
    } else {
      float* So = p.out + O_GDS + ((size_t)(b * 4 + h) * 128) * 128;
      const float eg = __expf(GDEC[(size_t)row * 4 + h]);
      const float beta = BETA[(size_t)row * 4 + h];
      float ks_ = 0.f, qs_ = 0.f;
#pragma unroll
      for (int i = 0; i < 32; ++i) {
        const int k = kp * 32 + i;
        cur[i] *= eg;
        ks_ += fk[k] * cur[i];
        qs_ += fq[k] * cur[i];
      }
      red[kp * 128 + n] = ks_;
      red[512 + kp * 128 + n] = qs_;
      __syncthreads();
      const float kS = red[n] + red[128 + n] + red[256 + n] + red[384 + n];
      const float delta = (fv[n] - kS) * beta;
#pragma unroll
      for (int i = 0; i < 32; ++i) {
        const int k = kp * 32 + i;
        So[k * 128 + n] = cur[i] + fk[k] * delta;
      }
      if (tid < 128) {
        const float qS = red[512 + n] + red[640 + n] + red[768 + n] + red[896 + n];
        OPRE[(size_t)row * 1024 + 512 + h * 128 + n] = qS + sc[j * 4 + 2] * delta;
      }
      __syncthreads();
    }
#pragma unroll
    for (int i = 0; i < 32; ++i) cur[i] = nxt[i];
  }
}

__device__ void phase3(const Params& p, char* smem, int bid, int nb) {
  for (int u = bid; u < 256; u += nb) {
    int uu = u;
    if (nb == 256) {
      const int xcd = u & 7, j = u >> 3;
      uu = ((xcd * 8 + (j >> 2)) << 2) | (j & 3);
    }
    if (uu < 128) scan_unit<0>(p, smem, uu); else scan_unit<1>(p, smem, uu - 128);
    if (DUP_MASK & 256) { if (uu < 128) scan_unit<0>(p, smem, uu); else scan_unit<1>(p, smem, uu - 128); }
  }
  if (nb == 256) {
    if ((bid & 7) < 4) {
      const int rank = (bid >> 3) * 4 + (bid & 3);
      sample_block4(p, smem, rank);
      sample_block4(p, smem, rank + 128);
    }
  } else {
    for (int it = bid; it < 1024; it += nb) sample_item(p, smem, it);
  }
}

__device__ void phase4(const Params& p, int bid, int nb) {
  const int tid = opaque_tid(), lane = tid & 63, w = tid >> 6;
  const float* OPRE = (const float*)(p.ws + W_PQ);
  const u16* GATES = (const u16*)(p.ws + W_GATES);
  u16* A2 = (u16*)(p.ws + W_QS);
  constexpr int NG = MT / 8;
  for (int g = bid; g < NG; g += 2 * nb) {
    const bool two = (g + nb) < NG;
    const int rows[2] = {g * 8 + w, (two ? g + nb : g) * 8 + w};
    f32x4 v[2][4];
    u32x2 gt[2][4];
#pragma unroll
    for (int r = 0; r < 2; ++r)
#pragma unroll
      for (int i = 0; i < 4; ++i) {
        const int col = i * 256 + lane * 4;
        v[r][i] = *(const f32x4*)(OPRE + (size_t)rows[r] * 1024 + col);
        gt[r][i] = *(const u32x2*)(GATES + (size_t)rows[r] * 1024 + col);
      }
#pragma unroll
    for (int r = 0; r < 2; ++r) {
      if (r == 1 && !two) break;
#pragma unroll
      for (int i = 0; i < 4; ++i) {
        const int col = i * 256 + lane * 4;
        float ss = v[r][i][0] * v[r][i][0] + v[r][i][1] * v[r][i][1] + v[r][i][2] * v[r][i][2] + v[r][i][3] * v[r][i][3];
        ss += dpp_mov<0xB1, 0xf>(ss);
        ss += dpp_mov<0x4E, 0xf>(ss);
        ss += dpp_mov<0x141, 0xf>(ss);
        ss += dpp_mov<0x140, 0xf>(ss);
        ss += __shfl_xor(ss, 16, 64);
        const float rstd = rsqrtf(ss * (1.f / 128.f) + EPS);
        const f32x4 nw = *(const f32x4*)((col < 512 ? p.hg_norm : p.gdn_norm) + (col & 127));
        float gg[4];
        unpack4(gt[r][i], gg);
        *(u32x2*)(A2 + (size_t)rows[r] * LDK + col) =
            u32x2{pack2(v[r][i][0] * rstd * nw[0] * gg[0], v[r][i][1] * rstd * nw[1] * gg[1]),
                  pack2(v[r][i][2] * rstd * nw[2] * gg[2], v[r][i][3] * rstd * nw[3] * gg[3])};
      }
    }
  }
}

__device__ void phase6(const Params& p, int bid, int nb) {
  const int tid = opaque_tid(), lane = tid & 63, w = tid >> 6;
  constexpr int NG = MT / 8;
  for (int g = bid; g < NG; g += 2 * nb) {
    const bool two = (g + nb) < NG;
    const int rows[2] = {g * 8 + w, (two ? g + nb : g) * 8 + w};
    float* y[2];
    float4 xv[2][4];
    float ss[2] = {0.f, 0.f};
#pragma unroll
    for (int r = 0; r < 2; ++r) {
      y[r] = rows[r] < MP ? p.out + O_YP + (size_t)rows[r] * 1024 : p.out + O_YS + (size_t)(rows[r] - MP) * 1024;
#pragma unroll
      for (int i = 0; i < 4; ++i) xv[r][i] = *(const float4*)(y[r] + i * 256 + lane * 4);
    }
#pragma unroll
    for (int r = 0; r < 2; ++r) {
#pragma unroll
      for (int i = 0; i < 4; ++i) ss[r] += xv[r][i].x * xv[r][i].x + xv[r][i].y * xv[r][i].y + xv[r][i].z * xv[r][i].z + xv[r][i].w * xv[r][i].w;
      ss[r] = wave_sum(ss[r]);
    }
#pragma unroll
    for (int r = 0; r < 2; ++r) {
      if (r == 1 && !two) break;
      const float rstd = rsqrtf(ss[r] * (1.f / 1024.f) + EPS);
#pragma unroll
      for (int i = 0; i < 4; ++i) {
        const float4 nw = *(const float4*)(p.final_norm + i * 256 + lane * 4);
        float4 o;
        o.x = xv[r][i].x * rstd * nw.x; o.y = xv[r][i].y * rstd * nw.y; o.z = xv[r][i].z * rstd * nw.z; o.w = xv[r][i].w * rstd * nw.w;
        *(float4*)(y[r] + i * 256 + lane * 4) = o;
      }
    }
  }
}

template <int PH>
__device__ __forceinline__ void run_phase(const Params& p, char* smem, int bid, int nb) {
  if (PH == 0) phase0(p, smem, bid, nb);
  else if (PH == 1) gemm_phase<0>(p, (const u16*)(p.ws + W_H), (const u16*)(p.ws + W_WINT), 16, smem, bid, nb);
  else if (PH == 2) phase2(p, smem, bid, nb);
  else if (PH == 3) phase3(p, smem, bid, nb);
  else if (PH == 4) phase4(p, bid, nb);
  else if (PH == 5) gemm_phase<1>(p, (const u16*)(p.ws + W_QS), (const u16*)(p.ws + W_WOUTT), 4, smem, bid, nb);
  else phase6(p, bid, nb);
}

#if MEGA
__global__ void __launch_bounds__(NTH) mega_kernel(Params p) {
  extern __shared__ __attribute__((aligned(16))) char smem[];
  cg::grid_group grid = cg::this_grid();
  const int bid = blockIdx.x, nb = gridDim.x;
#define RUNP(k) run_phase<k>(p, smem, bid, nb); grid.sync(); if (DUP_MASK & (1 << k)) { run_phase<k>(p, smem, bid, nb); grid.sync(); }
  RUNP(0) RUNP(1) RUNP(2) RUNP(3) RUNP(4) RUNP(5)
#undef RUNP
  run_phase<6>(p, smem, bid, nb);
}
#else
template <int PH>
__global__ void __launch_bounds__(NTH) phase_kernel(Params p) {
  extern __shared__ __attribute__((aligned(16))) char smem[];
  run_phase<PH>(p, smem, blockIdx.x, gridDim.x);
}
template <int PH>
static void launch_phase(const Params& p, int grid, hipStream_t stream) {
  hipFuncSetAttribute((const void*)phase_kernel<PH>, hipFuncAttributeMaxDynamicSharedMemorySize, (int)LDS_BYTES);
  hipLaunchKernelGGL(phase_kernel<PH>, dim3(grid), dim3(NTH), LDS_BYTES, stream, p);
}
#endif

extern "C" void kernel_launch(void* const* d_in, const int* in_sizes, int n_in, void* d_out, int out_size,
                              void* d_ws, size_t ws_size, hipStream_t stream) {
  Params p{};
  p.x_prompt = (const float*)d_in[0];
  p.x_sample = (const float*)d_in[1];
  p.state_hgrn = (const float*)d_in[2];
  p.state_gdn = (const float*)d_in[3];
  p.state_conv = (const float*)d_in[4];
  p.norm_w = (const float*)d_in[5];
  p.w_in = (const float*)d_in[6];
  p.lb_logits = (const float*)d_in[7];
  p.conv_w = (const float*)d_in[8];
  p.a_log = (const float*)d_in[9];
  p.dt_bias = (const float*)d_in[10];
  p.hg_norm = (const float*)d_in[11];
  p.gdn_norm = (const float*)d_in[12];
  p.w_out = (const float*)d_in[13];
  p.final_norm = (const float*)d_in[14];
  p.out = (float*)d_out;
  p.ws = (char*)d_ws;
  if (ws_size < W_END) { fprintf(stderr, "workspace too small: %zu < %zu\n", ws_size, (size_t)W_END); return; }
#if MEGA
  static int grid_blocks = 0;
  if (!grid_blocks) {
    int dev = 0, cus = 0, per_cu = 0;
    hipGetDevice(&dev);
    hipDeviceGetAttribute(&cus, hipDeviceAttributeMultiprocessorCount, dev);
    hipFuncSetAttribute((const void*)mega_kernel, hipFuncAttributeMaxDynamicSharedMemorySize, (int)LDS_BYTES);
    hipOccupancyMaxActiveBlocksPerMultiprocessor(&per_cu, mega_kernel, NTH, LDS_BYTES);
    if (per_cu < 1) per_cu = 1;
    grid_blocks = cus * per_cu;
  }
  void* args[] = {&p};
  hipError_t e = hipLaunchCooperativeKernel((void*)mega_kernel, dim3(grid_blocks), dim3(NTH), args, LDS_BYTES, stream);
  if (e != hipSuccess) fprintf(stderr, "cooperative launch failed: %s (grid %d)\n", hipGetErrorString(e), grid_blocks);
#else
  const int grid = 256;
  launch_phase<0>(p, grid, stream);
  launch_phase<1>(p, grid, stream);
  launch_phase<2>(p, grid, stream);
  launch_phase<3>(p, grid, stream);
  launch_phase<4>(p, grid, stream);
  launch_phase<5>(p, grid, stream);
  launch_phase<6>(p, grid, stream);
#endif
}
```

```cpp
#include <hip/hip_runtime.h>
#include <hip/hip_cooperative_groups.h>
#include <cstdio>
namespace cg = cooperative_groups;

#ifndef MEGA
#define MEGA 1
#define DUP_MASK 0
#endif

typedef unsigned short u16;
using bf16x8 = __attribute__((ext_vector_type(8))) short;
using f32x4 = __attribute__((ext_vector_type(4))) float;
using u32x4 = __attribute__((ext_vector_type(4))) unsigned;
using u32x2 = __attribute__((ext_vector_type(2))) unsigned;

#define NTH 512
constexpr int MP = 16384, MS = 128, MT = 16512, DM = 1024, DIN = 4104, PQW = 2560;
constexpr float EPS = 1e-6f;
constexpr int LDK = 1088;
constexpr size_t LDS_BYTES = 139264;

constexpr size_t O_YP = 0, O_YS = 16777216, O_HGP = 16908288, O_GDP = 17432576, O_CVP = 17956864,
                 O_HGS = 17993728, O_GDS = 26382336, O_CVS = 34770944;
constexpr size_t W_WINT = 0;
constexpr size_t W_WOUTT = W_WINT + (size_t)4096 * LDK * 2;
constexpr size_t W_BETA = W_WOUTT + (size_t)1024 * LDK * 2;
constexpr size_t W_GDEC = W_BETA + 264192;
constexpr size_t W_DVEC = W_GDEC + 264192;
constexpr size_t W_DSC = W_DVEC + 1048576;
constexpr size_t W_PQ = W_DSC + 4096;
constexpr size_t W_GATES = W_PQ + 84541440;
constexpr size_t W_H = W_GATES + 33816576;
constexpr size_t W_QS = W_H + (size_t)MT * LDK * 2;
constexpr size_t W_MNEG = W_QS + 33554432;
constexpr size_t W_LF = W_MNEG + 33554432;
constexpr size_t W_END = W_LF + 33816576;

struct Params {
  const float *x_prompt, *x_sample, *state_hgrn, *state_gdn, *state_conv, *norm_w, *w_in, *lb_logits,
      *conv_w, *a_log, *dt_bias, *hg_norm, *gdn_norm, *w_out, *final_norm;
  float* out;
  char* ws;
};

__device__ __forceinline__ int opaque_tid() { int t = threadIdx.x; asm volatile("" : "+v"(t)); return t; }
typedef __bf16 bf16x2_t __attribute__((ext_vector_type(2)));
typedef float f32x2_t __attribute__((ext_vector_type(2)));
__device__ __forceinline__ u16 f2bf(float x) { return __builtin_bit_cast(u16, (__bf16)x); }
__device__ __forceinline__ float bf2f(u16 h) { return __uint_as_float(((unsigned)h) << 16); }
__device__ __forceinline__ unsigned pack2(float a, float b) {
  f32x2_t v = {a, b};
  return __builtin_bit_cast(unsigned, __builtin_convertvector(v, bf16x2_t));
}
template <int CTRL, int ROWMASK>
__device__ __forceinline__ float dpp_mov(float v) {
  return __builtin_bit_cast(float, __builtin_amdgcn_update_dpp(0, __builtin_bit_cast(int, v), CTRL, ROWMASK, 0xf, false));
}
__device__ __forceinline__ float wave_sum(float v) {
  v += dpp_mov<0xB1, 0xf>(v);
  v += dpp_mov<0x4E, 0xf>(v);
  v += dpp_mov<0x141, 0xf>(v);
  v += dpp_mov<0x140, 0xf>(v);
  v += dpp_mov<0x142, 0xa>(v);
  v += dpp_mov<0x143, 0xc>(v);
  return __builtin_bit_cast(float, __builtin_amdgcn_readlane(__builtin_bit_cast(int, v), 63));
}
__device__ __forceinline__ float sigmoidf_(float x) { return 1.f / (1.f + __expf(-x)); }
__device__ __forceinline__ float siluf_(float x) { return x / (1.f + __expf(-x)); }
__device__ __forceinline__ f32x4 mfma16(bf16x8 a, bf16x8 b, f32x4 c) {
  return __builtin_amdgcn_mfma_f32_16x16x32_bf16(a, b, c, 0, 0, 0);
}
__device__ __forceinline__ bf16x8 frag(const u16* base, int row0, int stride, int koff, int lane) {
  return *(const bf16x8*)(base + (row0 + (lane & 15)) * stride + koff + (lane >> 4) * 8);
}

__device__ __forceinline__ void quad_transpose(float (&v)[4], int lane) {
  {
    const bool b = lane & 1;
    float s0 = b ? v[0] : v[1], s1 = b ? v[2] : v[3];
    float r0 = dpp_mov<0xB1, 0xf>(s0), r1 = dpp_mov<0xB1, 0xf>(s1);
    if (b) { v[0] = r0; v[2] = r1; } else { v[1] = r0; v[3] = r1; }
  }
  {
    const bool b = lane & 2;
    float s0 = b ? v[0] : v[2], s1 = b ? v[1] : v[3];
    float r0 = dpp_mov<0x4E, 0xf>(s0), r1 = dpp_mov<0x4E, 0xf>(s1);
    if (b) { v[0] = r0; v[1] = r1; } else { v[2] = r0; v[3] = r1; }
  }
}
__device__ __forceinline__ void store4_bf16(u16* dst, const float (&v)[4]) {
  *(u32x2*)dst = u32x2{pack2(v[0], v[1]), pack2(v[2], v[3])};
}
__device__ void phase0(const Params& p, char* smem, int bid, int nb) {
  const int tid = opaque_tid(), lane = tid & 63, w = tid >> 6;
  u16* WinT = (u16*)(p.ws + W_WINT);
  u16* WoutT = (u16*)(p.ws + W_WOUTT);
  u16* H = (u16*)(p.ws + W_H);
  float* BETA = (float*)(p.ws + W_BETA);
  float* GDEC = (float*)(p.ws + W_GDEC);
  float* tl = (float*)smem;
  for (int t = bid; t < 1280; t += nb) {
    const float* src; int sstride; u16* dst; int kt, nt;
    if (t < 1024) { src = p.w_in; sstride = DIN; dst = WinT; kt = t >> 6; nt = t & 63; }
    else { int u = t - 1024; src = p.w_out; sstride = 1024; dst = WoutT; kt = u >> 4; nt = u & 15; }
#pragma unroll
    for (int i = 0; i < 8; ++i) {
      int idx = tid + 512 * i; int kk = idx >> 6, nn = idx & 63;
      tl[kk * 65 + nn] = src[(size_t)(kt * 64 + kk) * sstride + nt * 64 + nn];
    }
    __syncthreads();
    {
      int nn = tid >> 3, k8 = (tid & 7) * 8;
      unsigned pk[4];
#pragma unroll
      for (int e = 0; e < 4; ++e) pk[e] = pack2(tl[(k8 + 2 * e) * 65 + nn], tl[(k8 + 2 * e + 1) * 65 + nn]);
      *(uint4*)(dst + (size_t)(nt * 64 + nn) * LDK + kt * 64 + k8) = make_uint4(pk[0], pk[1], pk[2], pk[3]);
    }
    __syncthreads();
  }
  float* W8s = (float*)smem;
  for (int idx = tid; idx < 8192; idx += 512) {
    int j = idx & 7, k = idx >> 3;
    W8s[j * 1024 + k] = p.w_in[(size_t)k * DIN + 4096 + j];
  }
  __syncthreads();
  for (int g = bid; g < MT / 8; g += nb) {
    int row = g * 8 + w;
    const float* x = row < MP ? p.x_prompt + (size_t)row * 1024 : p.x_sample + (size_t)(row - MP) * 1024;
    float4 xv[4];
    float ss = 0.f;
#pragma unroll
    for (int i = 0; i < 4; ++i) {
      xv[i] = *(const float4*)(x + i * 256 + lane * 4);
      ss += xv[i].x * xv[i].x + xv[i].y * xv[i].y + xv[i].z * xv[i].z + xv[i].w * xv[i].w;
    }
    ss = wave_sum(ss);
    float rstd = rsqrtf(ss * (1.f / 1024.f) + EPS);
    float d0 = 0, d1 = 0, d2 = 0, d3 = 0, d4 = 0, d5 = 0, d6 = 0, d7 = 0;
#pragma unroll
    for (int i = 0; i < 4; ++i) {
      float4 nw = *(const float4*)(p.norm_w + i * 256 + lane * 4);
      float4 hv;
      hv.x = xv[i].x * rstd * nw.x; hv.y = xv[i].y * rstd * nw.y; hv.z = xv[i].z * rstd * nw.z; hv.w = xv[i].w * rstd * nw.w;
      *(uint2*)(H + (size_t)row * LDK + i * 256 + lane * 4) = make_uint2(pack2(hv.x, hv.y), pack2(hv.z, hv.w));
#define GDOT(j, dj) { float4 wv = *(const float4*)(W8s + j * 1024 + i * 256 + lane * 4); dj += hv.x * wv.x + hv.y * wv.y + hv.z * wv.z + hv.w * wv.w; }
      GDOT(0, d0) GDOT(1, d1) GDOT(2, d2) GDOT(3, d3) GDOT(4, d4) GDOT(5, d5) GDOT(6, d6) GDOT(7, d7)
#undef GDOT
    }
    d0 = wave_sum(d0); d1 = wave_sum(d1); d2 = wave_sum(d2); d3 = wave_sum(d3);
    d4 = wave_sum(d4); d5 = wave_sum(d5); d6 = wave_sum(d6); d7 = wave_sum(d7);
    if (lane < 4) {
      float gb = lane == 0 ? d0 : lane == 1 ? d1 : lane == 2 ? d2 : d3;
      float ga = lane == 0 ? d4 : lane == 1 ? d5 : lane == 2 ? d6 : d7;
      BETA[row * 4 + lane] = 1.f / (1.f + expf(-gb));
      float z = ga + p.dt_bias[lane];
      float sp = z > 20.f ? z : log1pf(expf(z));
      GDEC[row * 4 + lane] = -expf(p.a_log[lane]) * sp;
    }
  }
  __syncthreads();
}

__device__ __forceinline__ int lds_byte2(int r, int c) {
  int st = (r >> 4) * 2 + (c >> 5), ob = (r & 15) * 64 + (c & 31) * 2;
  return st * 1024 + (ob ^ (((ob >> 9) & 1) << 5));
}
__device__ __forceinline__ void stage_rc2(int b, int& R, int& C) {
  int st = b >> 10, sb = b & 1023, swz = sb ^ (((sb >> 9) & 1) << 5);
  R = (st >> 1) * 16 + swz / 64;
  C = (st & 1) * 32 + (swz % 64) / 2;
}
template <int EPI, int SEC>
__device__ __forceinline__ void epi_store4(const Params& p, int row, int col4, const float (&v)[4]) {
  if (EPI == 0) {
    u16* PQ = (u16*)(p.ws + W_PQ);
    u16* GATES = (u16*)(p.ws + W_GATES);
    float* LF = (float*)(p.ws + W_LF);
    const int sec = SEC >= 0 ? SEC : (col4 >> 9);
    if (sec == 0) {
      *(uint2*)(PQ + (size_t)row * PQW + col4) = make_uint2(pack2(v[0], v[1]), pack2(v[2], v[3]));
    } else if (sec == 1) {
      const int cc = col4 - 512;
      const f32x4 l0 = *(const f32x4*)(p.lb_logits + cc), l1 = *(const f32x4*)(p.lb_logits + 512 + cc);
      f32x4 o;
#pragma unroll
      for (int i = 0; i < 4; ++i) {
        const float lbv = 1.f / (1.f + __expf(l1[i] - l0[i]));
        o[i] = __logf(lbv + (1.f - lbv) / (1.f + __expf(-v[i])));
      }
      *(f32x4*)(LF + (size_t)row * 512 + cc) = o;
    } else if (sec == 2) {
      *(uint2*)(PQ + (size_t)row * PQW + 512 + (col4 - 1024)) = make_uint2(pack2(v[0], v[1]), pack2(v[2], v[3]));
    } else if (sec == 3 || sec == 7) {
      const int cc = sec == 3 ? col4 - 1536 : 512 + col4 - 3584;
      *(uint2*)(GATES + (size_t)row * 1024 + cc) =
          make_uint2(pack2(v[0] / (1.f + __expf(-v[0])), v[1] / (1.f + __expf(-v[1]))),
                     pack2(v[2] / (1.f + __expf(-v[2])), v[3] / (1.f + __expf(-v[3]))));
    } else {
      const int cc = col4 - 2048;
      *(uint2*)(PQ + (size_t)row * PQW + 1024 + cc) = make_uint2(pack2(v[0], v[1]), pack2(v[2], v[3]));
      if (row < MP) {
        const int tt = row & 2047;
        if (tt >= 2045) *(f32x4*)(p.out + O_CVP + (size_t)((row >> 11) * 3 + (tt - 2045)) * 1536 + cc) = f32x4{v[0], v[1], v[2], v[3]};
      } else {
        *(f32x4*)(p.out + O_CVS + (size_t)((row - MP) * 3 + 2) * 1536 + cc) = f32x4{v[0], v[1], v[2], v[3]};
      }
    }
  } else {
    const float* xr = row < MP ? p.x_prompt + (size_t)row * 1024 : p.x_sample + (size_t)(row - MP) * 1024;
    float* yr = row < MP ? p.out + O_YP + (size_t)row * 1024 : p.out + O_YS + (size_t)(row - MP) * 1024;
    const f32x4 xv = *(const f32x4*)(xr + col4);
    *(f32x4*)(yr + col4) = f32x4{xv[0] + v[0], xv[1] + v[1], xv[2] + v[2], xv[3] + v[3]};
  }
}

template <int EPI>
__device__ void gemm_phase(const Params& p, const u16* __restrict__ A, const u16* __restrict__ Bt, int ntn,
                           char* smem, int bid, int nb) {
  const int tid = opaque_tid(), lane = tid & 63, wid = tid >> 6;
  const int wr = wid >> 2, wc = wid & 3, fr = lane & 15, fq = lane >> 4;
  constexpr int TILE_B = 256 * 64 * 2, STAGE_B = 2 * TILE_B;
  int sR0, sC0;
  stage_rc2(wid * 1024 + lane * 16, sR0, sC0);
  const unsigned goff = (unsigned)(sR0 * LDK + sC0);
  const unsigned lbase = (unsigned)(size_t)smem + (unsigned)(wid * 1024);
  const int aoff = (wr * 16) * 1024 + ((fr * 64 + fq * 16) ^ ((((fr * 64 + fq * 16) >> 9) & 1) << 5));
  const int boff = TILE_B + (wc * 8) * 1024 + ((fr * 64 + fq * 16) ^ ((((fr * 64 + fq * 16) >> 9) & 1) << 5));
  const int ntiles = 64 * ntn;
  auto tile_mn = [&](int tile, int& tm, int& tn) {
    const int rnd = tile >> 8, t = tile & 255, xcd = t & 7, j = t >> 3;
    if (ntn == 16) { tm = rnd * 16 + (xcd >> 1) * 4 + (j & 3); tn = (xcd & 1) * 8 + (j >> 2); }
    else { tm = xcd * 8 + (j & 7); tn = j >> 3; }
  };
  bool staged = false;
  for (int tile = bid; tile < ntiles; tile += nb) {
    int tm, tn;
    tile_mn(tile, tm, tn);
    const u16* Ab = A + (size_t)tm * 256 * LDK;
    const u16* Bb = Bt + (size_t)tn * 256 * LDK;
    f32x4 acc[8][4];
#pragma unroll
    for (int m = 0; m < 8; ++m)
#pragma unroll
      for (int n = 0; n < 4; ++n) acc[m][n] = f32x4{0.f, 0.f, 0.f, 0.f};
#define G_STAGE(buf, kt) { _Pragma("unroll") for (int i = 0; i < 4; ++i) { \
      __builtin_amdgcn_global_load_lds((const unsigned*)(Ab + (goff + (unsigned)(i * 64 * LDK + (kt) * 64))), \
          (__attribute__((address_space(3))) unsigned*)(lbase + (buf) * STAGE_B + i * 8192), 16, 0, 0); \
      __builtin_amdgcn_global_load_lds((const unsigned*)(Bb + (goff + (unsigned)(i * 64 * LDK + (kt) * 64))), \
          (__attribute__((address_space(3))) unsigned*)(lbase + (buf) * STAGE_B + TILE_B + i * 8192), 16, 0, 0); } }
    if (!staged) G_STAGE(0, 0);
    asm volatile("s_waitcnt vmcnt(0)" ::: "memory");
    __syncthreads();
    for (int t = 0; t < 16; ++t) {
      const int cur = t & 1;
      if (t + 1 < 16) G_STAGE(cur ^ 1, t + 1);
      const char* sA = smem + cur * STAGE_B + aoff;
      const char* sB = smem + cur * STAGE_B + boff;
#pragma unroll
      for (int ks = 0; ks < 2; ++ks) {
        bf16x8 At[8], Bf[4];
#pragma unroll
        for (int m = 0; m < 8; ++m) At[m] = *(const bf16x8*)(sA + (m * 2 + ks) * 1024);
#pragma unroll
        for (int n = 0; n < 4; ++n) Bf[n] = *(const bf16x8*)(sB + (n * 2 + ks) * 1024);
#pragma unroll
        for (int m = 0; m < 8; ++m)
#pragma unroll
          for (int n = 0; n < 4; ++n) acc[m][n] = mfma16(At[m], Bf[n], acc[m][n]);
        __builtin_amdgcn_sched_barrier(0);
      }
      asm volatile("s_waitcnt vmcnt(0)" ::: "memory");
      __syncthreads();
    }
    staged = false;
    if (tile + nb < ntiles) {
      int tm2, tn2;
      tile_mn(tile + nb, tm2, tn2);
      const u16* Ab2 = A + (size_t)tm2 * 256 * LDK;
      const u16* Bb2 = Bt + (size_t)tn2 * 256 * LDK;
      { const u16* Ab = Ab2; const u16* Bb = Bb2; G_STAGE(0, 0); }
      staged = true;
    }
#undef G_STAGE
    {
      int t2 = threadIdx.x;
      asm volatile("" : "+v"(t2));
      const int lane2 = t2 & 63, wid2 = t2 >> 6;
      const int rbase = tm * 256 + (wid2 >> 2) * 128 + (lane2 >> 4) * 4 + (lane2 & 3);
      const int cbase = tn * 256 + (wid2 & 3) * 64 + (lane2 & 12);
#define EPI_LOOP(SEC) { _Pragma("unroll") for (int m = 0; m < 8; ++m) { _Pragma("unroll") for (int n = 0; n < 4; ++n) { \
          float v[4] = {acc[m][n][0], acc[m][n][1], acc[m][n][2], acc[m][n][3]}; \
          quad_transpose(v, lane2); \
          epi_store4<EPI, SEC>(p, rbase + m * 16, cbase + n * 16, v); } } }
      if (EPI == 0) {
        const int sec = tn >> 1;
        if (sec == 0) EPI_LOOP(0) else if (sec == 1) EPI_LOOP(1) else if (sec == 2) EPI_LOOP(2)
        else if (sec == 3) EPI_LOOP(3) else if (sec == 7) EPI_LOOP(7) else EPI_LOOP(4)
      } else EPI_LOOP(0)
#undef EPI_LOOP
    }
  }
  const int nunits = ntn * 16;
  int t3 = threadIdx.x;
  asm volatile("" : "+v"(t3));
  for (int u = bid; u < nunits; u += nb) {
    const int lane = t3 & 63, wid = t3 >> 6, fr = lane & 15, fq = lane >> 4;
    const u16* ar = A + (size_t)(MP + wid * 16 + fr) * LDK + fq * 8;
    const u16* br = Bt + (size_t)(u * 16 + fr) * LDK + fq * 8;
    f32x4 acc0 = {0.f, 0.f, 0.f, 0.f}, acc1 = {0.f, 0.f, 0.f, 0.f};
#pragma unroll 4
    for (int ks = 0; ks < 32; ks += 2) {
      const bf16x8 a0 = *(const bf16x8*)(ar + ks * 32), b0 = *(const bf16x8*)(br + ks * 32);
      const bf16x8 a1 = *(const bf16x8*)(ar + ks * 32 + 32), b1 = *(const bf16x8*)(br + ks * 32 + 32);
      acc0 = mfma16(a0, b0, acc0);
      acc1 = mfma16(a1, b1, acc1);
    }
    float v[4] = {acc0[0] + acc1[0], acc0[1] + acc1[1], acc0[2] + acc1[2], acc0[3] + acc1[3]};
    quad_transpose(v, lane);
    epi_store4<EPI, -1>(p, MP + wid * 16 + fq * 4 + (lane & 3), u * 16 + (fr & ~3), v);
  }
  __syncthreads();
}

__device__ void hgrn_item(const Params& p, char* smem, int idx) {
  const int tid = opaque_tid(), lane = tid & 63, w = tid >> 6;
  const int lr = lane & 15, lq = lane >> 4;
  const int h = idx & 3, c = (idx >> 2) & 31, b = idx >> 7;
  const int r0 = b * 2048 + c * 64;
  const u16* PQ = (const u16*)(p.ws + W_PQ);
  const float* LF = (const float*)(p.ws + W_LF);
  u16* QS = (u16*)(p.ws + W_QS);
  u16* O0 = (u16*)(p.ws + W_H);
  u16* NB = (u16*)(p.out);
  float* DVEC = (float*)(p.ws + W_DVEC);
  u16* qt = (u16*)smem;
  u16* kt = qt + 64 * 136;
  u16* ktT = kt + 64 * 136;
  u16* vT = ktT + 128 * 72;
  u16* sc = vT + 128 * 72;
  float* ps = (float*)(sc + 64 * 72);
  const int col = tid & 127, part = tid >> 7;
  float lfv[16], bcum[16];
  {
    const float* lfp = LF + (size_t)(r0 + part * 16) * 512 + h * 128 + col;
#pragma unroll
    for (int i = 0; i < 16; ++i) lfv[i] = lfp[(size_t)i * 512];
    float run = 0.f;
#pragma unroll
    for (int i = 0; i < 16; ++i) { run += lfv[i]; bcum[i] = run; }
    ps[part * 128 + col] = run;
  }
  u16 qraw[16], vraw[16];
  {
    const u16* qp0 = PQ + (size_t)(r0 + part * 16) * PQW + h * 128 + col;
#pragma unroll
    for (int i = 0; i < 16; ++i) { qraw[i] = qp0[(size_t)i * PQW]; vraw[i] = qp0[(size_t)i * PQW + 512]; }
  }
  __syncthreads();
  {
    float off = 0.f, blast = 0.f;
#pragma unroll
    for (int pp = 0; pp < 4; ++pp) { float t = ps[pp * 128 + col]; blast += t; if (pp < part) off += t; }
    u16* qsout = QS + ((size_t)idx * 64 + part * 16) * 128 + col;
#pragma unroll
    for (int i = 0; i < 16; ++i) {
      const float bb = bcum[i] + off;
      const int row = part * 16 + i;
      const float q = bf2f(qraw[i]);
      const u16 v = vraw[i];
      qsout[i * 128] = f2bf(q * __expf(bb));
      qt[row * 136 + col] = f2bf(q * __expf(bb - blast));
      const float kk = (1.f - __expf(lfv[i])) * __expf(blast - bb);
      const u16 kbv = f2bf(kk);
      kt[row * 136 + col] = kbv;
      ktT[col * 72 + row] = kbv;
      vT[col * 72 + row] = v;
    }
    if (part == 0) DVEC[idx * 128 + col] = __expf(blast);
  }
  __syncthreads();
  {
    const int tr = w >> 1;
    bf16x8 a[4];
#pragma unroll
    for (int ks = 0; ks < 4; ++ks) a[ks] = frag(qt, tr * 16, 136, ks * 32, lane);
#pragma unroll
    for (int tci = 0; tci < 2; ++tci) {
      const int tc = (w & 1) * 2 + tci;
      f32x4 acc = {0.f, 0.f, 0.f, 0.f};
#pragma unroll
      for (int ks = 0; ks < 4; ++ks) acc = mfma16(a[ks], frag(kt, tc * 16, 136, ks * 32, lane), acc);
#pragma unroll
      for (int j = 0; j < 4; ++j) {
        const int t = tr * 16 + lq * 4 + j, s = tc * 16 + lr;
        sc[t * 72 + s] = f2bf(t >= s ? acc[j] : 0.f);
      }
    }
  }
  __syncthreads();
  {
    const int tr = w >> 1;
    const bf16x8 a0 = frag(sc, tr * 16, 72, 0, lane), a1 = frag(sc, tr * 16, 72, 32, lane);
#pragma unroll
    for (int tci = 0; tci < 4; ++tci) {
      const int tc = (w & 1) * 4 + tci;
      f32x4 acc = {0.f, 0.f, 0.f, 0.f};
      acc = mfma16(a0, frag(vT, tc * 16, 72, 0, lane), acc);
      acc = mfma16(a1, frag(vT, tc * 16, 72, 32, lane), acc);
      {
        float v[4] = {acc[0], acc[1], acc[2], acc[3]};
        quad_transpose(v, lane);
        store4_bf16(O0 + ((size_t)idx * 64 + tr * 16 + lq * 4 + (lane & 3)) * 128 + tc * 16 + (lr & 12), v);
      }
    }
  }
  {
    const int tr = w;
    const bf16x8 a0 = frag(ktT, tr * 16, 72, 0, lane), a1 = frag(ktT, tr * 16, 72, 32, lane);
#pragma unroll
    for (int tc = 0; tc < 8; ++tc) {
      f32x4 acc = {0.f, 0.f, 0.f, 0.f};
      acc = mfma16(a0, frag(vT, tc * 16, 72, 0, lane), acc);
      acc = mfma16(a1, frag(vT, tc * 16, 72, 32, lane), acc);
      {
        float v[4] = {acc[0], acc[1], acc[2], acc[3]};
        quad_transpose(v, lane);
        store4_bf16(NB + ((size_t)idx * 128 + tr * 16 + lq * 4 + (lane & 3)) * 128 + tc * 16 + (lr & 12), v);
      }
    }
  }
  __syncthreads();
}

template <int J>
struct SolveCol {
  static __device__ __forceinline__ void run(f32x4 (&x)[16], const float* AT) {
    if constexpr (J < 63) {
      const float xj = x[J / 4][J % 4];
#pragma unroll
      for (int B = (J + 1) / 4; B < 16; ++B) {
        const f32x4 av = *(const f32x4*)(AT + J * 64 + B * 4);
        x[B] -= av * xj;
      }
      if ((J & 3) == 3) __builtin_amdgcn_sched_barrier(0);
      SolveCol<J + 1>::run(x, AT);
    }
  }
};

__device__ void gdn_item(const Params& p, char* smem, int idx) {
  const int tid = opaque_tid(), lane = tid & 63, w = tid >> 6;
  const int lr = lane & 15, lq = lane >> 4;
  const int h = idx & 3, c = (idx >> 2) & 31, b = idx >> 7;
  const int r0 = b * 2048 + c * 64;
  const u16* PQ = (const u16*)(p.ws + W_PQ);
  const float* BETA = (const float*)(p.ws + W_BETA);
  const float* GDEC = (const float*)(p.ws + W_GDEC);
  u16* QS = (u16*)(p.ws + W_QS);
  u16* O0 = (u16*)(p.ws + W_H);
  u16* NB = (u16*)(p.out);
  u16* MNEG = (u16*)(p.ws + W_MNEG);
  float* DSC = (float*)(p.ws + W_DSC);
  u16* kb = (u16*)smem;
  u16* qb = kb + 64 * 136;
  u16* vS = qb + 64 * 136;
  float* Asol = (float*)(vS + 64 * 128);
  u16* attn = (u16*)(Asol + 64 * 64);
  u16* khT = attn + 64 * 72;
  u16* WT = khT + 128 * 72;
  u16* U0T = WT + 128 * 72;
  float* gc = (float*)(U0T + 128 * 72);
  float* bet = gc + 64;

  if (w == 0) {
    float g = GDEC[(size_t)(r0 + lane) * 4 + h];
#pragma unroll
    for (int o = 1; o < 64; o <<= 1) { float t = __shfl_up(g, o, 64); if (lane >= o) g += t; }
    gc[lane] = g;
    bet[lane] = BETA[(size_t)(r0 + lane) * 4 + h];
  }
  {
    const int chq = 1024 + h * 128 + 2 * lane;
    const int cwq = h * 128 + 2 * lane;
    float cw[3][4][2];
#pragma unroll
    for (int ty = 0; ty < 3; ++ty)
#pragma unroll
      for (int j = 0; j < 4; ++j) {
        float2 t2 = *(const float2*)(p.conv_w + j * 1536 + ty * 512 + cwq);
        cw[ty][j][0] = t2.x; cw[ty][j][1] = t2.y;
      }
    float win[3][3][2];
    const int t0 = w * 8;
#pragma unroll
    for (int a = 0; a < 3; ++a) {
      const int rr = t0 - 3 + a;
      const bool valid = (c > 0) || (rr >= 0);
#pragma unroll
      for (int ty = 0; ty < 3; ++ty) {
        unsigned u = 0;
        if (valid) u = *(const unsigned*)(PQ + (ptrdiff_t)(r0 + rr) * PQW + chq + ty * 512);
        win[ty][a][0] = bf2f((u16)(u & 0xffff)); win[ty][a][1] = bf2f((u16)(u >> 16));
      }
    }
#pragma unroll
    for (int tt = 0; tt < 8; ++tt) {
      const int t = t0 + tt;
      float cv[3][2];
#pragma unroll
      for (int ty = 0; ty < 3; ++ty) {
        unsigned u = *(const unsigned*)(PQ + (size_t)(r0 + t) * PQW + chq + ty * 512);
        float c0 = bf2f((u16)(u & 0xffff)), c1 = bf2f((u16)(u >> 16));
        float s0 = cw[ty][0][0] * win[ty][0][0] + cw[ty][1][0] * win[ty][1][0] + cw[ty][2][0] * win[ty][2][0] + cw[ty][3][0] * c0;
        float s1 = cw[ty][0][1] * win[ty][0][1] + cw[ty][1][1] * win[ty][1][1] + cw[ty][2][1] * win[ty][2][1] + cw[ty][3][1] * c1;
        win[ty][0][0] = win[ty][1][0]; win[ty][0][1] = win[ty][1][1];
        win[ty][1][0] = win[ty][2][0]; win[ty][1][1] = win[ty][2][1];
        win[ty][2][0] = c0; win[ty][2][1] = c1;
        cv[ty][0] = siluf_(s0); cv[ty][1] = siluf_(s1);
      }
      float ssq = wave_sum(cv[0][0] * cv[0][0] + cv[0][1] * cv[0][1]);
      float ssk = wave_sum(cv[1][0] * cv[1][0] + cv[1][1] * cv[1][1]);
      const float rq = rsqrtf(ssq + EPS) * 0.08838834764831845f;
      const float rk = rsqrtf(ssk + EPS);
      *(unsigned*)(qb + t * 136 + 2 * lane) = pack2(cv[0][0] * rq, cv[0][1] * rq);
      *(unsigned*)(kb + t * 136 + 2 * lane) = pack2(cv[1][0] * rk, cv[1][1] * rk);
      *(unsigned*)(vS + t * 128 + 2 * lane) = pack2(cv[2][0], cv[2][1]);
    }
  }
  __syncthreads();
  {
    const int which = w >> 2, tr = w & 3;
    const u16* Asrc = which ? qb : kb;
    bf16x8 a[4];
#pragma unroll
    for (int ks = 0; ks < 4; ++ks) a[ks] = frag(Asrc, tr * 16, 136, ks * 32, lane);
#pragma unroll
    for (int tc = 0; tc < 4; ++tc) {
      f32x4 acc = {0.f, 0.f, 0.f, 0.f};
#pragma unroll
      for (int ks = 0; ks < 4; ++ks) acc = mfma16(a[ks], frag(kb, tc * 16, 136, ks * 32, lane), acc);
#pragma unroll
      for (int j = 0; j < 4; ++j) {
        const int t = tr * 16 + lq * 4 + j, s = tc * 16 + lr;
        const float L = __expf(fminf(gc[t] - gc[s], 0.f));
        if (which == 0) Asol[s * 64 + t] = (t > s) ? bet[t] * acc[j] * L : 0.f;
        else attn[t * 72 + s] = f2bf((t >= s) ? acc[j] * L : 0.f);
      }
    }
  }
  __syncthreads();
  if (tid < 256) {
    f32x4 x[16];
    if (tid < 128) {
#pragma unroll
      for (int s = 0; s < 64; ++s) { x[s >> 2][s & 3] = bf2f(vS[s * 128 + tid]) * bet[s]; if ((s & 7) == 7) __builtin_amdgcn_sched_barrier(0); }
    } else {
#pragma unroll
      for (int s = 0; s < 64; ++s) { x[s >> 2][s & 3] = bf2f(kb[s * 136 + tid - 128]) * bet[s] * __expf(gc[s]); if ((s & 7) == 7) __builtin_amdgcn_sched_barrier(0); }
    }
    SolveCol<0>::run(x, Asol);
    u16* dst = (tid < 128) ? (U0T + tid * 72) : (WT + (tid - 128) * 72);
#pragma unroll
    for (int s8 = 0; s8 < 8; ++s8) {
      *(u32x4*)(dst + s8 * 8) = u32x4{pack2(x[2 * s8][0], x[2 * s8][1]), pack2(x[2 * s8][2], x[2 * s8][3]),
                                      pack2(x[2 * s8 + 1][0], x[2 * s8 + 1][1]), pack2(x[2 * s8 + 1][2], x[2 * s8 + 1][3])};
    }
  } else {
    const float glast = gc[63];
    const int e0 = tid - 256;
#pragma unroll 4
    for (int i = 0; i < 32; ++i) {
      const int e = e0 + 256 * i;
      const int s = e & 63, kd = e >> 6;
      khT[kd * 72 + s] = f2bf(bf2f(kb[s * 136 + kd]) * __expf(glast - gc[s]));
    }
  }
  __syncthreads();
  {
    const int tr = w & 3, half = w >> 2;
    const u16* Bsrc = half ? U0T : WT;
    const bf16x8 a0 = frag(attn, tr * 16, 72, 0, lane), a1 = frag(attn, tr * 16, 72, 32, lane);
#pragma unroll 2
    for (int tc = 0; tc < 8; ++tc) {
      f32x4 acc = {0.f, 0.f, 0.f, 0.f};
      acc = mfma16(a0, frag(Bsrc, tc * 16, 72, 0, lane), acc);
      acc = mfma16(a1, frag(Bsrc, tc * 16, 72, 32, lane), acc);
      {
        float v[4];
#pragma unroll
        for (int j = 0; j < 4; ++j) {
          const int t = tr * 16 + lq * 4 + j, n = tc * 16 + lr;
          v[j] = half == 0 ? bf2f(qb[t * 136 + n]) * __expf(gc[t]) - acc[j] : acc[j];
        }
        quad_transpose(v, lane);
        const size_t o = ((size_t)(1024 + idx) * 64 + tr * 16 + lq * 4 + (lane & 3)) * 128 + tc * 16 + (lr & 12);
        store4_bf16((half == 0 ? QS : O0) + o, v);
      }
    }
  }
  {
    const int tr = w;
    const bf16x8 a0 = frag(khT, tr * 16, 72, 0, lane), a1 = frag(khT, tr * 16, 72, 32, lane);
#pragma unroll 2
    for (int tc = 0; tc < 16; ++tc) {
      const u16* Bsrc = tc < 8 ? WT : U0T;
      const int tcc = tc & 7;
      f32x4 acc = {0.f, 0.f, 0.f, 0.f};
      acc = mfma16(a0, frag(Bsrc, tcc * 16, 72, 0, lane), acc);
      acc = mfma16(a1, frag(Bsrc, tcc * 16, 72, 32, lane), acc);
      {
        float v[4];
#pragma unroll
        for (int j = 0; j < 4; ++j) v[j] = tc < 8 ? -acc[j] : acc[j];
        quad_transpose(v, lane);
        const size_t o = (size_t)(tr * 16 + lq * 4 + (lane & 3)) * 128 + tcc * 16 + (lr & 12);
        store4_bf16((tc < 8 ? MNEG + (size_t)idx * 16384 : NB + (size_t)(1024 + idx) * 16384) + o, v);
      }
    }
  }
  if (tid < 128) ((float*)(p.ws + W_DVEC))[(size_t)(1024 + idx) * 128 + tid] = __expf(gc[63]);
  __syncthreads();
}

__device__ void phase2(const Params& p, char* smem, int bid, int nb) {
  for (int it = bid; it < 2048; it += nb) {
    if (it >= 1024) { gdn_item(p, smem, it - 1024); if (DUP_MASK & 2048) gdn_item(p, smem, it - 1024); }
    else { hgrn_item(p, smem, it); if (DUP_MASK & 1024) hgrn_item(p, smem, it); }
  }
}

struct ScanRegs {
  bf16x8 Aq[4];
  bf16x8 Am[4];
  u32x2 o0, nn0, nn1;
  f32x4 dd;
};
#define RAW_BARRIER() do { asm volatile("s_waitcnt lgkmcnt(0)" ::: "memory"); __builtin_amdgcn_s_barrier(); asm volatile("" ::: "memory"); } while (0)

template <int TYPE>
__device__ __forceinline__ void scan_load(ScanRegs& r, const Params& p, int idx, unsigned qoff, unsigned ooff, unsigned moff,
                                          unsigned noff, unsigned doff) {
  const int ii = __builtin_amdgcn_readfirstlane(idx);
  const int ti = TYPE * 1024 + ii;
  const u16* QSb = (const u16*)(p.ws + W_QS) + (size_t)ti * 8192;
  const u16* O0b = (const u16*)(p.ws + W_H) + (size_t)ti * 8192;
  const u16* NBb = (const u16*)(p.out) + (size_t)ti * 16384;
#pragma unroll
  for (int ks = 0; ks < 4; ++ks) r.Aq[ks] = *(const bf16x8*)(QSb + (qoff + ks * 32));
  r.o0 = *(const u32x2*)(O0b + ooff);
  r.nn0 = *(const u32x2*)(NBb + noff);
  r.nn1 = *(const u32x2*)(NBb + (noff + 16));
  if (TYPE == 1) {
    const u16* Mb = (const u16*)(p.ws + W_MNEG) + (size_t)ii * 16384;
#pragma unroll
    for (int ks = 0; ks < 4; ++ks) r.Am[ks] = *(const bf16x8*)(Mb + (moff + ks * 32));
  }
  r.dd = *(const f32x4*)((const float*)(p.ws + W_DVEC) + (size_t)ti * 128 + doff);
}
__device__ __forceinline__ void unpack4(u32x2 u, float (&v)[4]) {
  v[0] = bf2f((u16)(u[0] & 0xffff)); v[1] = bf2f((u16)(u[0] >> 16));
  v[2] = bf2f((u16)(u[1] & 0xffff)); v[3] = bf2f((u16)(u[1] >> 16));
}

template <int TYPE>
__device__ void scan_unit(const Params& p, char* smem, int rem) {
  const int tid = opaque_tid(), lane = tid & 63, w = tid >> 6;
  const int lr = lane & 15, lq = lane >> 4;
  const int b = rem >> 4, h = (rem >> 2) & 3, vs2 = rem & 3;
  const int tr = lq * 4 + (lane & 3), tc4 = lr & 12;
  const int otr = w & 3, otc = w >> 2;
  float* OPRE = (float*)(p.ws + W_PQ);
  u16* SbT = (u16*)smem;
  for (int i = tid; i < 2 * 32 * 136; i += 512) SbT[i] = 0;
  f32x4 S0 = {0.f, 0.f, 0.f, 0.f}, S1 = {0.f, 0.f, 0.f, 0.f};
  const unsigned qoff = (unsigned)((otr * 16 + lr) * 128 + lq * 8);
  const unsigned ooff = (unsigned)((otr * 16 + tr) * 128 + vs2 * 32 + otc * 16 + tc4);
  const unsigned moff = (unsigned)((w * 16 + lr) * 128 + lq * 8);
  const unsigned noff = (unsigned)((w * 16 + tr) * 128 + vs2 * 32 + tc4);
  const unsigned doff = (unsigned)(w * 16 + lq * 4);
  float* const orow = OPRE + (size_t)(b * 2048 + otr * 16 + tr) * 1024 + TYPE * 512 + h * 128 + vs2 * 32 + otc * 16 + tc4;
  ScanRegs r0, r1, r2, r3;
  const int idx0 = (b * 32) * 4 + h;
  scan_load<TYPE>(r0, p, idx0 + 0, qoff, ooff, moff, noff, doff);
  scan_load<TYPE>(r1, p, idx0 + 4, qoff, ooff, moff, noff, doff);
  scan_load<TYPE>(r2, p, idx0 + 8, qoff, ooff, moff, noff, doff);
  scan_load<TYPE>(r3, p, idx0 + 12, qoff, ooff, moff, noff, doff);
  __builtin_amdgcn_sched_barrier(0);
#define SCAN_STEP(R, c) { \
    RAW_BARRIER(); \
    const u16* Sb = SbT + ((c) & 1) * 32 * 136 + lr * 136 + lq * 8; \
    bf16x8 B0[4], B1[4], Bo[4]; \
    _Pragma("unroll") for (int ks = 0; ks < 4; ++ks) { \
      B0[ks] = *(const bf16x8*)(Sb + ks * 32); \
      B1[ks] = *(const bf16x8*)(Sb + 16 * 136 + ks * 32); \
      Bo[ks] = *(const bf16x8*)(Sb + otc * 16 * 136 + ks * 32); } \
    { \
      float ov[4]; unpack4(R.o0, ov); quad_transpose(ov, lane); \
      f32x4 acc = {ov[0], ov[1], ov[2], ov[3]}; \
      _Pragma("unroll") for (int ks = 0; ks < 4; ++ks) acc = mfma16(R.Aq[ks], Bo[ks], acc); \
      float o[4] = {acc[0], acc[1], acc[2], acc[3]}; \
      quad_transpose(o, lane); \
      *(f32x4*)(orow + (size_t)(c) * 65536) = f32x4{o[0], o[1], o[2], o[3]}; \
    } \
    float n0[4], n1[4]; unpack4(R.nn0, n0); unpack4(R.nn1, n1); \
    quad_transpose(n0, lane); quad_transpose(n1, lane); \
    f32x4 T0, T1; \
    _Pragma("unroll") for (int j = 0; j < 4; ++j) { T0[j] = R.dd[j] * S0[j] + n0[j]; T1[j] = R.dd[j] * S1[j] + n1[j]; } \
    if (TYPE == 1) { _Pragma("unroll") for (int ks = 0; ks < 4; ++ks) { T0 = mfma16(R.Am[ks], B0[ks], T0); T1 = mfma16(R.Am[ks], B1[ks], T1); } } \
    S0 = T0; S1 = T1; \
    u16* Sw = SbT + (((c) + 1) & 1) * 32 * 136 + lr * 136 + w * 16 + lq * 4; \
    *(u32x2*)(Sw) = u32x2{pack2(S0[0], S0[1]), pack2(S0[2], S0[3])}; \
    *(u32x2*)(Sw + 16 * 136) = u32x2{pack2(S1[0], S1[1]), pack2(S1[2], S1[3])}; \
    __builtin_amdgcn_sched_barrier(0); \
    scan_load<TYPE>(R, p, idx0 + (((c) + 4 < 32) ? (c) + 4 : 31) * 4, qoff, ooff, moff, noff, doff); \
    __builtin_amdgcn_sched_barrier(0); \
  }
  for (int c0 = 0; c0 < 32; c0 += 4) {
    SCAN_STEP(r0, c0)
    SCAN_STEP(r1, c0 + 1)
    SCAN_STEP(r2, c0 + 2)
    SCAN_STEP(r3, c0 + 3)
  }
#undef SCAN_STEP
  float* so = p.out + (TYPE ? O_GDP : O_HGP) + (size_t)(b * 4 + h) * 16384 + (w * 16 + tr) * 128 + vs2 * 32 + tc4;
  {
    float sv[4] = {S0[0], S0[1], S0[2], S0[3]};
    quad_transpose(sv, lane);
    *(f32x4*)(so) = f32x4{sv[0], sv[1], sv[2], sv[3]};
    float sw[4] = {S1[0], S1[1], S1[2], S1[3]};
    quad_transpose(sw, lane);
    *(f32x4*)(so + 16) = f32x4{sw[0], sw[1], sw[2], sw[3]};
  }
  __syncthreads();
}

__device__ void sample_item(const Params& p, char* smem, int it) {
  const int tid = opaque_tid(), lane = tid & 63, w = tid >> 6;
  const int type = it >> 9, b = (it >> 2) & 127, h = it & 3;
  const int row = MP + b;
  const u16* PQ = (const u16*)(p.ws + W_PQ);
  const float* LF = (const float*)(p.ws + W_LF);
  const float* BETA = (const float*)(p.ws + W_BETA);
  const float* GDEC = (const float*)(p.ws + W_GDEC);
  float* OPRE = (float*)(p.ws + W_PQ);
  float* fq = (float*)smem;
  float* fk = fq + 128;
  float* fv = fk + 128;
  float* fe = fv + 128;
  float* red = fe + 128;
  float* sc = red + 1024;
  const int n = tid & 127, kp = tid >> 7;
  if (type == 0) {
    if (tid < 128) {
      const float lf = LF[(size_t)row * 512 + h * 128 + tid];
      const float f = __expf(lf);
      fe[tid] = f;
      fk[tid] = 1.f - f;
      fq[tid] = bf2f(PQ[(size_t)row * PQW + h * 128 + tid]);
      fv[tid] = bf2f(PQ[(size_t)row * PQW + 512 + h * 128 + tid]);
    }
    __syncthreads();
    const float* S = p.state_hgrn + ((size_t)(b * 4 + h) * 128) * 128;
    float* So = p.out + O_HGS + ((size_t)(b * 4 + h) * 128) * 128;
    const float vn = fv[n];
    float o = 0.f;
#pragma unroll
    for (int i = 0; i < 32; ++i) {
      const int k = kp * 32 + i;
      const float sn = fe[k] * S[k * 128 + n] + fk[k] * vn;
      So[k * 128 + n] = sn;
      o += fq[k] * sn;
    }
    red[kp * 128 + n] = o;
    __syncthreads();
    if (tid < 128) OPRE[(size_t)row * 1024 + h * 128 + tid] = red[tid] + red[128 + tid] + red[256 + tid] + red[384 + tid];
    __syncthreads();
  } else {
    const float* cprev = p.state_conv + (size_t)b * 3 * 1536;
    if (tid < 384) {
      const int ty = tid >> 7, cc = tid & 127;
      const int ch = ty * 512 + h * 128 + cc;
      const float p0 = cprev[ch], p1 = cprev[1536 + ch], p2 = cprev[3072 + ch];
      const float nw = bf2f(PQ[(size_t)row * PQW + 1024 + ch]);
      const float s = p.conv_w[ch] * p0 + p.conv_w[1536 + ch] * p1 + p.conv_w[3072 + ch] * p2 + p.conv_w[4608 + ch] * nw;
      fq[ty * 128 + cc] = siluf_(s);
      p.out[O_CVS + (size_t)(b * 3 + 0) * 1536 + ch] = p1;
      p.out[O_CVS + (size_t)(b * 3 + 1) * 1536 + ch] = p2;
    }
    __syncthreads();
    if (w < 2) {
      const float a0 = fq[w * 128 + lane], a1 = fq[w * 128 + 64 + lane];
      const float ss = wave_sum(a0 * a0 + a1 * a1);
      if (lane == 0) sc[w] = ss;
    }
    __syncthreads();
    const float rq = rsqrtf(sc[0] + EPS) * 0.08838834764831845f;
    const float rk = rsqrtf(sc[1] + EPS);
    __syncthreads();
    if (tid < 128) fq[tid] *= rq;
    else if (tid < 256) fk[tid - 128] *= rk;
    __syncthreads();
    if (w == 0) {
      const float qk = wave_sum(fq[lane] * fk[lane] + fq[64 + lane] * fk[64 + lane]);
      if (lane == 0) sc[2] = qk;
    }
    const float eg = __expf(GDEC[(size_t)row * 4 + h]);
    const float beta = BETA[(size_t)row * 4 + h];
    const float* S = p.state_gdn + ((size_t)(b * 4 + h) * 128) * 128;
    float* So = p.out + O_GDS + ((size_t)(b * 4 + h) * 128) * 128;
    float sd[32];
    float ks_ = 0.f, qs_ = 0.f;
#pragma unroll
    for (int i = 0; i < 32; ++i) {
      const int k = kp * 32 + i;
      sd[i] = eg * S[k * 128 + n];
      ks_ += fk[k] * sd[i];
      qs_ += fq[k] * sd[i];
    }
    red[kp * 128 + n] = ks_;
    red[512 + kp * 128 + n] = qs_;
    __syncthreads();
    const float kS = red[n] + red[128 + n] + red[256 + n] + red[384 + n];
    const float delta = (fv[n] - kS) * beta;
#pragma unroll
    for (int i = 0; i < 32; ++i) {
      const int k = kp * 32 + i;
      So[k * 128 + n] = sd[i] + fk[k] * delta;
    }
    if (tid < 128) {
      const float qS = red[512 + n] + red[640 + n] + red[768 + n] + red[896 + n];
      OPRE[(size_t)row * 1024 + 512 + h * 128 + n] = qS + sc[2] * delta;
    }
    __syncthreads();
  }
}

__device__ void sample_block4(const Params& p, char* smem, int bid) {
  const int tid = opaque_tid(), lane = tid & 63, w = tid >> 6;
  const u16* PQ = (const u16*)(p.ws + W_PQ);
  const float* LF = (const float*)(p.ws + W_LF);
  const float* BETA = (const float*)(p.ws + W_BETA);
  const float* GDEC = (const float*)(p.ws + W_GDEC);
  float* OPRE = (float*)(p.ws + W_PQ);
  float* vec = (float*)smem;
  float* red = vec + 2048;
  float* sc = red + 1024;
  if (tid < 256) {
    const int j = tid >> 7, c = tid & 127;
    const int it = bid + 256 * j, b = (it >> 2) & 127, h = it & 3, row = MP + b;
    const float f = __expf(LF[(size_t)row * 512 + h * 128 + c]);
    vec[(j * 4 + 0) * 128 + c] = bf2f(PQ[(size_t)row * PQW + h * 128 + c]);
    vec[(j * 4 + 1) * 128 + c] = 1.f - f;
    vec[(j * 4 + 2) * 128 + c] = bf2f(PQ[(size_t)row * PQW + 512 + h * 128 + c]);
    vec[(j * 4 + 3) * 128 + c] = f;
  }
  for (int e = tid; e < 768; e += 512) {
    const int j = 2 + e / 384, r = e % 384, ty = r >> 7, cc = r & 127;
    const int it = bid + 256 * j, b = (it >> 2) & 127, h = it & 3, row = MP + b;
    const int ch = ty * 512 + h * 128 + cc;
    const float* cprev = p.state_conv + (size_t)b * 3 * 1536;
    const float p0 = cprev[ch], p1 = cprev[1536 + ch], p2 = cprev[3072 + ch];
    const float nw = bf2f(PQ[(size_t)row * PQW + 1024 + ch]);
    const float s = p.conv_w[ch] * p0 + p.conv_w[1536 + ch] * p1 + p.conv_w[3072 + ch] * p2 + p.conv_w[4608 + ch] * nw;
    vec[(j * 4 + ty) * 128 + cc] = siluf_(s);
    p.out[O_CVS + (size_t)(b * 3 + 0) * 1536 + ch] = p1;
    p.out[O_CVS + (size_t)(b * 3 + 1) * 1536 + ch] = p2;
  }
  __syncthreads();
  if (w < 4) {
    const int j = 2 + (w >> 1), which = w & 1;
    const float a0 = vec[(j * 4 + which) * 128 + lane], a1 = vec[(j * 4 + which) * 128 + 64 + lane];
    const float ss = wave_sum(a0 * a0 + a1 * a1);
    if (lane == 0) sc[j * 4 + which] = ss;
  }
  __syncthreads();
  {
    const int j = 2 + (tid >> 8), which = (tid >> 7) & 1, c = tid & 127;
    const float r = which == 0 ? rsqrtf(sc[j * 4 + 0] + EPS) * 0.08838834764831845f : rsqrtf(sc[j * 4 + 1] + EPS);
    vec[(j * 4 + which) * 128 + c] *= r;
  }
  __syncthreads();
  if (w < 2) {
    const int j = 2 + w;
    const float qk = wave_sum(vec[(j * 4 + 0) * 128 + lane] * vec[(j * 4 + 1) * 128 + lane] +
                              vec[(j * 4 + 0) * 128 + 64 + lane] * vec[(j * 4 + 1) * 128 + 64 + lane]);
    if (lane == 0) sc[j * 4 + 2] = qk;
  }
  __syncthreads();
  const int n = tid & 127, kp = tid >> 7;
  float cur[32], nxt[32];
  {
    const int it = bid, b = (it >> 2) & 127, h = it & 3;
    const float* S = p.state_hgrn + ((size_t)(b * 4 + h) * 128) * 128;
#pragma unroll
    for (int i = 0; i < 32; ++i) cur[i] = S[(kp * 32 + i) * 128 + n];
  }
#pragma unroll
  for (int j = 0; j < 4; ++j) {
    const int it = bid + 256 * j, b = (it >> 2) & 127, h = it & 3, row = MP + b;
    if (j < 3) {
      const int it2 = bid + 256 * (j + 1), b2 = (it2 >> 2) & 127, h2 = it2 & 3;
      const float* S2 = ((j + 1) < 2 ? p.state_hgrn : p.state_gdn) + ((size_t)(b2 * 4 + h2) * 128) * 128;
#pragma unroll
      for (int i = 0; i < 32; ++i) nxt[i] = S2[(kp * 32 + i) * 128 + n];
    }
    const float* fq = vec + (j * 4 + 0) * 128;
    const float* fk = vec + (j * 4 + 1) * 128;
    const float* fv = vec + (j * 4 + 2) * 128;
    const float* fe = vec + (j * 4 + 3) * 128;
    if (j < 2) {
      float* So = p.out + O_HGS + ((size_t)(b * 4 + h) * 128) * 128;
      const float vn = fv[n];
      float o = 0.f;
#pragma unroll
      for (int i = 0; i < 32; ++i) {
        const int k = kp * 32 + i;
        const float sn = fe[k] * cur[i] + fk[k] * vn;
        So[k * 128 + n] = sn;
        o += fq[k] * sn;
      }
      red[kp * 128 + n] = o;
      __syncthreads();
      if (tid < 128) OPRE[(size_t)row * 1024 + h * 128 + tid] = red[tid] + red[128 + tid] + red[256 + tid] + red[384 + tid];
      __syncthreads();
    } else {
      float* So = p.out + O_GDS + ((size_t)(b * 4 + h) * 128) * 128;
      const float eg = __expf(GDEC[(size_t)row * 4 + h]);
      const float beta = BETA[(size_t)row * 4 + h];
      float ks_ = 0.f, qs_ = 0.f;
#pragma unroll
      for (int i = 0; i < 32; ++i) {
        const int k = kp * 32 + i;
        cur[i] *= eg;
        ks_ += fk[k] * cur[i];
        qs_ += fq[k] * cur[i];
      }
      red[kp * 128 + n] = ks_;
      red[512 + kp * 128 + n] = qs_;
      __syncthreads();
      const float kS = red[n] + red[128 + n] + red[256 + n] + red[384 + n];
      const float delta = (fv[n] - kS) * beta;
#pragma unroll
      for (int i = 0; i < 32; ++i) {
        const int k = kp * 32 + i;
        So[k * 128 + n] = cur[i] + fk[k] * delta;
      }
      if (tid < 128) {
        const float qS = red[512 + n] + red[640 + n] + red[768 + n] + red[896 + n];
        OPRE[(size_t)row * 1024 + 512 + h * 128 + n] = qS + sc[j * 4 + 2] * delta;
      }
      __syncthreads();
    }
#pragma unroll
    for (int i = 0; i < 32; ++i) cur[i] = nxt[i];
  }
}

__device__ void phase3(const Params& p, char* smem, int bid, int nb) {
  for (int u = bid; u < 256; u += nb) {
    int uu = u;
    if (nb == 256) {
      const int xcd = u & 7, j = u >> 3;
      uu = ((xcd * 8 + (j >> 2)) << 2) | (j & 3);
    }
    if (uu < 128) scan_unit<0>(p, smem, uu); else scan_unit<1>(p, smem, uu - 128);
    if (DUP_MASK & 256) { if (uu < 128) scan_unit<0>(p, smem, uu); else scan_unit<1>(p, smem, uu - 128); }
  }
  if (nb == 256) {
    if ((bid & 7) < 4) {
      const int rank = (bid >> 3) * 4 + (bid & 3);
      sample_block4(p, smem, rank);
      sample_block4(p, smem, rank + 128);
    }
  } else {
    for (int it = bid; it < 1024; it += nb) sample_item(p, smem, it);
  }
}

__device__ void phase4(const Params& p, int bid, int nb) {
  const int tid = opaque_tid(), lane = tid & 63, w = tid >> 6;
  const float* OPRE = (const float*)(p.ws + W_PQ);
  const u16* GATES = (const u16*)(p.ws + W_GATES);
  u16* A2 = (u16*)(p.ws + W_QS);
  constexpr int NG = MT / 8;
  for (int g = bid; g < NG; g += 2 * nb) {
    const bool two = (g + nb) < NG;
    const int rows[2] = {g * 8 + w, (two ? g + nb : g) * 8 + w};
    f32x4 v[2][4];
    u32x2 gt[2][4];
#pragma unroll
    for (int r = 0; r < 2; ++r)
#pragma unroll
      for (int i = 0; i < 4; ++i) {
        const int col = i * 256 + lane * 4;
        v[r][i] = *(const f32x4*)(OPRE + (size_t)rows[r] * 1024 + col);
        gt[r][i] = *(const u32x2*)(GATES + (size_t)rows[r] * 1024 + col);
      }
#pragma unroll
    for (int r = 0; r < 2; ++r) {
      if (r == 1 && !two) break;
#pragma unroll
      for (int i = 0; i < 4; ++i) {
        const int col = i * 256 + lane * 4;
        float ss = v[r][i][0] * v[r][i][0] + v[r][i][1] * v[r][i][1] + v[r][i][2] * v[r][i][2] + v[r][i][3] * v[r][i][3];
        ss += dpp_mov<0xB1, 0xf>(ss);
        ss += dpp_mov<0x4E, 0xf>(ss);
        ss += dpp_mov<0x141, 0xf>(ss);
        ss += dpp_mov<0x140, 0xf>(ss);
        ss += __shfl_xor(ss, 16, 64);
        const float rstd = rsqrtf(ss * (1.f / 128.f) + EPS);
        const f32x4 nw = *(const f32x4*)((col < 512 ? p.hg_norm : p.gdn_norm) + (col & 127));
        float gg[4];
        unpack4(gt[r][i], gg);
        *(u32x2*)(A2 + (size_t)rows[r] * LDK + col) =
            u32x2{pack2(v[r][i][0] * rstd * nw[0] * gg[0], v[r][i][1] * rstd * nw[1] * gg[1]),
                  pack2(v[r][i][2] * rstd * nw[2] * gg[2], v[r][i][3] * rstd * nw[3] * gg[3])};
      }
    }
  }
}

__device__ void phase6(const Params& p, int bid, int nb) {
  const int tid = opaque_tid(), lane = tid & 63, w = tid >> 6;
  constexpr int NG = MT / 8, NR = 4;
  for (int g = bid; g < NG; g += NR * nb) {
    float* y[NR];
    bool ok[NR];
    float4 xv[NR][4];
    float ss[NR];
#pragma unroll
    for (int r = 0; r < NR; ++r) {
      ok[r] = (g + r * nb) < NG;
      const int row = (ok[r] ? g + r * nb : g) * 8 + w;
      y[r] = row < MP ? p.out + O_YP + (size_t)row * 1024 : p.out + O_YS + (size_t)(row - MP) * 1024;
#pragma unroll
      for (int i = 0; i < 4; ++i) xv[r][i] = *(const float4*)(y[r] + i * 256 + lane * 4);
    }
#pragma unroll
    for (int r = 0; r < NR; ++r) {
      ss[r] = 0.f;
#pragma unroll
      for (int i = 0; i < 4; ++i) ss[r] += xv[r][i].x * xv[r][i].x + xv[r][i].y * xv[r][i].y + xv[r][i].z * xv[r][i].z + xv[r][i].w * xv[r][i].w;
      ss[r] = wave_sum(ss[r]);
    }
#pragma unroll
    for (int r = 0; r < NR; ++r) {
      if (ok[r]) {
        const float rstd = rsqrtf(ss[r] * (1.f / 1024.f) + EPS);
#pragma unroll
        for (int i = 0; i < 4; ++i) {
          const float4 nw = *(const float4*)(p.final_norm + i * 256 + lane * 4);
          float4 o;
          o.x = xv[r][i].x * rstd * nw.x; o.y = xv[r][i].y * rstd * nw.y; o.z = xv[r][i].z * rstd * nw.z; o.w = xv[r][i].w * rstd * nw.w;
          *(float4*)(y[r] + i * 256 + lane * 4) = o;
        }
      }
    }
  }
}

template <int PH>
__device__ __forceinline__ void run_phase(const Params& p, char* smem, int bid, int nb) {
  if (PH == 0) phase0(p, smem, bid, nb);
  else if (PH == 1) gemm_phase<0>(p, (const u16*)(p.ws + W_H), (const u16*)(p.ws + W_WINT), 16, smem, bid, nb);
  else if (PH == 2) phase2(p, smem, bid, nb);
  else if (PH == 3) phase3(p, smem, bid, nb);
  else if (PH == 4) phase4(p, bid, nb);
  else if (PH == 5) gemm_phase<1>(p, (const u16*)(p.ws + W_QS), (const u16*)(p.ws + W_WOUTT), 4, smem, bid, nb);
  else phase6(p, bid, nb);
}

#if MEGA
__global__ void __launch_bounds__(NTH) mega_kernel(Params p) {
  extern __shared__ __attribute__((aligned(16))) char smem[];
  cg::grid_group grid = cg::this_grid();
  const int bid = blockIdx.x, nb = gridDim.x;
#define RUNP(k) run_phase<k>(p, smem, bid, nb); grid.sync(); if (DUP_MASK & (1 << k)) { run_phase<k>(p, smem, bid, nb); grid.sync(); }
  RUNP(0) RUNP(1) RUNP(2) RUNP(3) RUNP(4) RUNP(5)
#undef RUNP
  run_phase<6>(p, smem, bid, nb);
}
#else
template <int PH>
__global__ void __launch_bounds__(NTH) phase_kernel(Params p) {
  extern __shared__ __attribute__((aligned(16))) char smem[];
  run_phase<PH>(p, smem, blockIdx.x, gridDim.x);
}
template <int PH>
static void launch_phase(const Params& p, int grid, hipStream_t stream) {
  hipFuncSetAttribute((const void*)phase_kernel<PH>, hipFuncAttributeMaxDynamicSharedMemorySize, (int)LDS_BYTES);
  hipLaunchKernelGGL(phase_kernel<PH>, dim3(grid), dim3(NTH), LDS_BYTES, stream, p);
}
#endif

extern "C" void kernel_launch(void* const* d_in, const int* in_sizes, int n_in, void* d_out, int out_size,
                              void* d_ws, size_t ws_size, hipStream_t stream) {
  Params p{};
  p.x_prompt = (const float*)d_in[0];
  p.x_sample = (const float*)d_in[1];
  p.state_hgrn = (const float*)d_in[2];
  p.state_gdn = (const float*)d_in[3];
  p.state_conv = (const float*)d_in[4];
  p.norm_w = (const float*)d_in[5];
  p.w_in = (const float*)d_in[6];
  p.lb_logits = (const float*)d_in[7];
  p.conv_w = (const float*)d_in[8];
  p.a_log = (const float*)d_in[9];
  p.dt_bias = (const float*)d_in[10];
  p.hg_norm = (const float*)d_in[11];
  p.gdn_norm = (const float*)d_in[12];
  p.w_out = (const float*)d_in[13];
  p.final_norm = (const float*)d_in[14];
  p.out = (float*)d_out;
  p.ws = (char*)d_ws;
  if (ws_size < W_END) { fprintf(stderr, "workspace too small: %zu < %zu\n", ws_size, (size_t)W_END); return; }
#if MEGA
  static int grid_blocks = 0;
  if (!grid_blocks) {
    int dev = 0, cus = 0, per_cu = 0;
    hipGetDevice(&dev);
    hipDeviceGetAttribute(&cus, hipDeviceAttributeMultiprocessorCount, dev);
    hipFuncSetAttribute((const void*)mega_kernel, hipFuncAttributeMaxDynamicSharedMemorySize, (int)LDS_BYTES);
    hipOccupancyMaxActiveBlocksPerMultiprocessor(&per_cu, mega_kernel, NTH, LDS_BYTES);
    if (per_cu < 1) per_cu = 1;
    grid_blocks = cus * per_cu;
  }
  void* args[] = {&p};
  hipError_t e = hipLaunchCooperativeKernel((void*)mega_kernel, dim3(grid_blocks), dim3(NTH), args, LDS_BYTES, stream);
  if (e != hipSuccess) fprintf(stderr, "cooperative launch failed: %s (grid %d)\n", hipGetErrorString(e), grid_blocks);
#else
  const int grid = 256;
  launch_phase<0>(p, grid, stream);
  launch_phase<1>(p, grid, stream);
  launch_phase<2>(p, grid, stream);
  launch_phase<3>(p, grid, stream);
  launch_phase<4>(p, grid, stream);
  launch_phase<5>(p, grid, stream);
  launch_phase<6>(p, grid, stream);
#endif
}
```

```cpp
#include <hip/hip_runtime.h>
#include <hip/hip_cooperative_groups.h>
#include <cstdio>
namespace cg = cooperative_groups;

#ifndef MEGA
#define MEGA 1
#define PROBE_GEMM 0
#define DUP_MASK 0
#endif

typedef unsigned short u16;
using bf16x8 = __attribute__((ext_vector_type(8))) short;
using f32x4 = __attribute__((ext_vector_type(4))) float;
using u32x4 = __attribute__((ext_vector_type(4))) unsigned;
using u32x2 = __attribute__((ext_vector_type(2))) unsigned;

#define NTH 512
constexpr int MP = 16384, MS = 128, MT = 16512, DM = 1024, DIN = 4104, PQW = 2560;
constexpr float EPS = 1e-6f;
constexpr int LDK = 1088;
constexpr size_t LDS_BYTES = 139264;

constexpr size_t O_YP = 0, O_YS = 16777216, O_HGP = 16908288, O_GDP = 17432576, O_CVP = 17956864,
                 O_HGS = 17993728, O_GDS = 26382336, O_CVS = 34770944;
constexpr size_t W_WINT = 0;
constexpr size_t W_WOUTT = W_WINT + (size_t)4096 * LDK * 2;
constexpr size_t W_BETA = W_WOUTT + (size_t)1024 * LDK * 2;
constexpr size_t W_GDEC = W_BETA + 264192;
constexpr size_t W_DVEC = W_GDEC + 264192;
constexpr size_t W_DSC = W_DVEC + 1048576;
constexpr size_t W_PQ = W_DSC + 4096;
constexpr size_t W_GATES = W_PQ + 84541440;
constexpr size_t W_H = W_GATES + 33816576;
constexpr size_t W_QS = W_H + (size_t)MT * LDK * 2;
constexpr size_t W_MNEG = W_QS + 33554432;
constexpr size_t W_LF = W_MNEG + 33554432;
constexpr size_t W_END = W_LF + 33816576;

struct Params {
  const float *x_prompt, *x_sample, *state_hgrn, *state_gdn, *state_conv, *norm_w, *w_in, *lb_logits,
      *conv_w, *a_log, *dt_bias, *hg_norm, *gdn_norm, *w_out, *final_norm;
  float* out;
  char* ws;
};

__device__ __forceinline__ int opaque_tid() { int t = threadIdx.x; asm volatile("" : "+v"(t)); return t; }
typedef __bf16 bf16x2_t __attribute__((ext_vector_type(2)));
typedef float f32x2_t __attribute__((ext_vector_type(2)));
__device__ __forceinline__ u16 f2bf(float x) { return __builtin_bit_cast(u16, (__bf16)x); }
__device__ __forceinline__ float bf2f(u16 h) { return __uint_as_float(((unsigned)h) << 16); }
__device__ __forceinline__ unsigned pack2(float a, float b) {
  f32x2_t v = {a, b};
  return __builtin_bit_cast(unsigned, __builtin_convertvector(v, bf16x2_t));
}
template <int CTRL, int ROWMASK>
__device__ __forceinline__ float dpp_mov(float v) {
  return __builtin_bit_cast(float, __builtin_amdgcn_update_dpp(0, __builtin_bit_cast(int, v), CTRL, ROWMASK, 0xf, false));
}
__device__ __forceinline__ float wave_sum(float v) {
  v += dpp_mov<0xB1, 0xf>(v);
  v += dpp_mov<0x4E, 0xf>(v);
  v += dpp_mov<0x141, 0xf>(v);
  v += dpp_mov<0x140, 0xf>(v);
  v += dpp_mov<0x142, 0xa>(v);
  v += dpp_mov<0x143, 0xc>(v);
  return __builtin_bit_cast(float, __builtin_amdgcn_readlane(__builtin_bit_cast(int, v), 63));
}
__device__ __forceinline__ float sigmoidf_(float x) { return 1.f / (1.f + __expf(-x)); }
__device__ __forceinline__ float siluf_(float x) { return x / (1.f + __expf(-x)); }
__device__ __forceinline__ f32x4 mfma16(bf16x8 a, bf16x8 b, f32x4 c) {
  return __builtin_amdgcn_mfma_f32_16x16x32_bf16(a, b, c, 0, 0, 0);
}
__device__ __forceinline__ bf16x8 frag(const u16* base, int row0, int stride, int koff, int lane) {
  return *(const bf16x8*)(base + (row0 + (lane & 15)) * stride + koff + (lane >> 4) * 8);
}

__device__ __forceinline__ void quad_transpose(float (&v)[4], int lane) {
  {
    const bool b = lane & 1;
    float s0 = b ? v[0] : v[1], s1 = b ? v[2] : v[3];
    float r0 = dpp_mov<0xB1, 0xf>(s0), r1 = dpp_mov<0xB1, 0xf>(s1);
    if (b) { v[0] = r0; v[2] = r1; } else { v[1] = r0; v[3] = r1; }
  }
  {
    const bool b = lane & 2;
    float s0 = b ? v[0] : v[2], s1 = b ? v[1] : v[3];
    float r0 = dpp_mov<0x4E, 0xf>(s0), r1 = dpp_mov<0x4E, 0xf>(s1);
    if (b) { v[0] = r0; v[1] = r1; } else { v[2] = r0; v[3] = r1; }
  }
}
__device__ __forceinline__ void store4_bf16(u16* dst, const float (&v)[4]) {
  *(u32x2*)dst = u32x2{pack2(v[0], v[1]), pack2(v[2], v[3])};
}
__device__ void phase0(const Params& p, char* smem, int bid, int nb) {
  const int tid = opaque_tid(), lane = tid & 63, w = tid >> 6;
  u16* WinT = (u16*)(p.ws + W_WINT);
  u16* WoutT = (u16*)(p.ws + W_WOUTT);
  u16* H = (u16*)(p.ws + W_H);
  float* BETA = (float*)(p.ws + W_BETA);
  float* GDEC = (float*)(p.ws + W_GDEC);
  float* tl = (float*)smem;
  for (int t = bid; t < 1280; t += nb) {
    const float* src; int sstride; u16* dst; int kt, nt;
    if (t < 1024) { src = p.w_in; sstride = DIN; dst = WinT; kt = t >> 6; nt = t & 63; }
    else { int u = t - 1024; src = p.w_out; sstride = 1024; dst = WoutT; kt = u >> 4; nt = u & 15; }
#pragma unroll
    for (int i = 0; i < 8; ++i) {
      int idx = tid + 512 * i; int kk = idx >> 6, nn = idx & 63;
      tl[kk * 65 + nn] = src[(size_t)(kt * 64 + kk) * sstride + nt * 64 + nn];
    }
    __syncthreads();
    {
      int nn = tid >> 3, k8 = (tid & 7) * 8;
      unsigned pk[4];
#pragma unroll
      for (int e = 0; e < 4; ++e) pk[e] = pack2(tl[(k8 + 2 * e) * 65 + nn], tl[(k8 + 2 * e + 1) * 65 + nn]);
      *(uint4*)(dst + (size_t)(nt * 64 + nn) * LDK + kt * 64 + k8) = make_uint4(pk[0], pk[1], pk[2], pk[3]);
    }
    __syncthreads();
  }
  float* W8s = (float*)smem;
  for (int idx = tid; idx < 8192; idx += 512) {
    int j = idx & 7, k = idx >> 3;
    W8s[j * 1024 + k] = p.w_in[(size_t)k * DIN + 4096 + j];
  }
  __syncthreads();
  for (int g = bid; g < MT / 8; g += nb) {
    int row = g * 8 + w;
    const float* x = row < MP ? p.x_prompt + (size_t)row * 1024 : p.x_sample + (size_t)(row - MP) * 1024;
    float4 xv[4];
    float ss = 0.f;
#pragma unroll
    for (int i = 0; i < 4; ++i) {
      xv[i] = *(const float4*)(x + i * 256 + lane * 4);
      ss += xv[i].x * xv[i].x + xv[i].y * xv[i].y + xv[i].z * xv[i].z + xv[i].w * xv[i].w;
    }
    ss = wave_sum(ss);
    float rstd = rsqrtf(ss * (1.f / 1024.f) + EPS);
    float d0 = 0, d1 = 0, d2 = 0, d3 = 0, d4 = 0, d5 = 0, d6 = 0, d7 = 0;
#pragma unroll
    for (int i = 0; i < 4; ++i) {
      float4 nw = *(const float4*)(p.norm_w + i * 256 + lane * 4);
      float4 hv;
      hv.x = xv[i].x * rstd * nw.x; hv.y = xv[i].y * rstd * nw.y; hv.z = xv[i].z * rstd * nw.z; hv.w = xv[i].w * rstd * nw.w;
      *(uint2*)(H + (size_t)row * LDK + i * 256 + lane * 4) = make_uint2(pack2(hv.x, hv.y), pack2(hv.z, hv.w));
#define GDOT(j, dj) { float4 wv = *(const float4*)(W8s + j * 1024 + i * 256 + lane * 4); dj += hv.x * wv.x + hv.y * wv.y + hv.z * wv.z + hv.w * wv.w; }
      GDOT(0, d0) GDOT(1, d1) GDOT(2, d2) GDOT(3, d3) GDOT(4, d4) GDOT(5, d5) GDOT(6, d6) GDOT(7, d7)
#undef GDOT
    }
    d0 = wave_sum(d0); d1 = wave_sum(d1); d2 = wave_sum(d2); d3 = wave_sum(d3);
    d4 = wave_sum(d4); d5 = wave_sum(d5); d6 = wave_sum(d6); d7 = wave_sum(d7);
    if (lane < 4) {
      float gb = lane == 0 ? d0 : lane == 1 ? d1 : lane == 2 ? d2 : d3;
      float ga = lane == 0 ? d4 : lane == 1 ? d5 : lane == 2 ? d6 : d7;
      BETA[row * 4 + lane] = 1.f / (1.f + expf(-gb));
      float z = ga + p.dt_bias[lane];
      float sp = z > 20.f ? z : log1pf(expf(z));
      GDEC[row * 4 + lane] = -expf(p.a_log[lane]) * sp;
    }
  }
  __syncthreads();
}

__device__ __forceinline__ int lds_byte2(int r, int c) {
  int st = (r >> 4) * 2 + (c >> 5), ob = (r & 15) * 64 + (c & 31) * 2;
  return st * 1024 + (ob ^ (((ob >> 9) & 1) << 5));
}
__device__ __forceinline__ void stage_rc2(int b, int& R, int& C) {
  int st = b >> 10, sb = b & 1023, swz = sb ^ (((sb >> 9) & 1) << 5);
  R = (st >> 1) * 16 + swz / 64;
  C = (st & 1) * 32 + (swz % 64) / 2;
}
template <int EPI, int SEC>
__device__ __forceinline__ void epi_store4(const Params& p, int row, int col4, const float (&v)[4]) {
  if (EPI == 0) {
    u16* PQ = (u16*)(p.ws + W_PQ);
    u16* GATES = (u16*)(p.ws + W_GATES);
    float* LF = (float*)(p.ws + W_LF);
    const int sec = SEC >= 0 ? SEC : (col4 >> 9);
    if (sec == 0) {
      *(uint2*)(PQ + (size_t)row * PQW + col4) = make_uint2(pack2(v[0], v[1]), pack2(v[2], v[3]));
    } else if (sec == 1) {
      const int cc = col4 - 512;
      const f32x4 l0 = *(const f32x4*)(p.lb_logits + cc), l1 = *(const f32x4*)(p.lb_logits + 512 + cc);
      f32x4 o;
#pragma unroll
      for (int i = 0; i < 4; ++i) {
        const float lbv = 1.f / (1.f + __expf(l1[i] - l0[i]));
        o[i] = __logf(lbv + (1.f - lbv) / (1.f + __expf(-v[i])));
      }
      *(f32x4*)(LF + (size_t)row * 512 + cc) = o;
    } else if (sec == 2) {
      *(uint2*)(PQ + (size_t)row * PQW + 512 + (col4 - 1024)) = make_uint2(pack2(v[0], v[1]), pack2(v[2], v[3]));
    } else if (sec == 3 || sec == 7) {
      const int cc = sec == 3 ? col4 - 1536 : 512 + col4 - 3584;
      *(uint2*)(GATES + (size_t)row * 1024 + cc) =
          make_uint2(pack2(v[0] / (1.f + __expf(-v[0])), v[1] / (1.f + __expf(-v[1]))),
                     pack2(v[2] / (1.f + __expf(-v[2])), v[3] / (1.f + __expf(-v[3]))));
    } else {
      const int cc = col4 - 2048;
      *(uint2*)(PQ + (size_t)row * PQW + 1024 + cc) = make_uint2(pack2(v[0], v[1]), pack2(v[2], v[3]));
      if (row < MP) {
        const int tt = row & 2047;
        if (tt >= 2045) *(f32x4*)(p.out + O_CVP + (size_t)((row >> 11) * 3 + (tt - 2045)) * 1536 + cc) = f32x4{v[0], v[1], v[2], v[3]};
      } else {
        *(f32x4*)(p.out + O_CVS + (size_t)((row - MP) * 3 + 2) * 1536 + cc) = f32x4{v[0], v[1], v[2], v[3]};
      }
    }
  } else {
    const float* xr = row < MP ? p.x_prompt + (size_t)row * 1024 : p.x_sample + (size_t)(row - MP) * 1024;
    float* yr = row < MP ? p.out + O_YP + (size_t)row * 1024 : p.out + O_YS + (size_t)(row - MP) * 1024;
    const f32x4 xv = *(const f32x4*)(xr + col4);
    *(f32x4*)(yr + col4) = f32x4{xv[0] + v[0], xv[1] + v[1], xv[2] + v[2], xv[3] + v[3]};
  }
}

template <int EPI, int MODE = 0>
__device__ void gemm_phase(const Params& p, const u16* __restrict__ A, const u16* __restrict__ Bt, int ntn,
                           char* smem, int bid, int nb) {
  const int tid = opaque_tid(), lane = tid & 63, wid = tid >> 6;
  const int wr = wid >> 2, wc = wid & 3, fr = lane & 15, fq = lane >> 4;
  constexpr int TILE_B = 256 * 64 * 2, STAGE_B = 2 * TILE_B;
  int sR0, sC0;
  stage_rc2(wid * 1024 + lane * 16, sR0, sC0);
  const unsigned goff = (unsigned)(sR0 * LDK + sC0);
  const unsigned lbase = (unsigned)(size_t)smem + (unsigned)(wid * 1024);
  const int aoff = (wr * 16) * 1024 + ((fr * 64 + fq * 16) ^ ((((fr * 64 + fq * 16) >> 9) & 1) << 5));
  const int boff = TILE_B + (wc * 8) * 1024 + ((fr * 64 + fq * 16) ^ ((((fr * 64 + fq * 16) >> 9) & 1) << 5));
  const int ntiles = 64 * ntn;
  auto tile_mn = [&](int tile, int& tm, int& tn) {
    const int rnd = tile >> 8, t = tile & 255, xcd = t & 7, j = t >> 3;
    if (ntn == 16) { tm = rnd * 16 + (xcd >> 1) * 4 + (j & 3); tn = ((xcd & 1) * 8 + (j >> 2) + (rnd & 1) * 2 + (rnd >> 1) * 8) & 15; }
    else { tm = xcd * 8 + (j & 7); tn = j >> 3; }
  };
  bool staged = false;
  for (int tile = bid; tile < ntiles; tile += nb) {
    int tm, tn;
    tile_mn(tile, tm, tn);
    const u16* Ab = A + (size_t)tm * 256 * LDK;
    const u16* Bb = Bt + (size_t)tn * 256 * LDK;
    f32x4 acc[8][4];
#pragma unroll
    for (int m = 0; m < 8; ++m)
#pragma unroll
      for (int n = 0; n < 4; ++n) acc[m][n] = f32x4{0.f, 0.f, 0.f, 0.f};
#define G_STAGE(buf, kt) { _Pragma("unroll") for (int i = 0; i < 4; ++i) { \
      __builtin_amdgcn_global_load_lds((const unsigned*)(Ab + (goff + (unsigned)(i * 64 * LDK + (kt) * 64))), \
          (__attribute__((address_space(3))) unsigned*)(lbase + (buf) * STAGE_B + i * 8192), 16, 0, 0); \
      __builtin_amdgcn_global_load_lds((const unsigned*)(Bb + (goff + (unsigned)(i * 64 * LDK + (kt) * 64))), \
          (__attribute__((address_space(3))) unsigned*)(lbase + (buf) * STAGE_B + TILE_B + i * 8192), 16, 0, 0); } }
    if (!staged) G_STAGE(0, 0);
    asm volatile("s_waitcnt vmcnt(0)" ::: "memory");
    __syncthreads();
    for (int t = 0; t < 16; ++t) {
      const int cur = t & 1;
      if (MODE != 2) { if (t + 1 < 16) G_STAGE(cur ^ 1, t + 1); }
      const char* sA = smem + cur * STAGE_B + aoff;
      const char* sB = smem + cur * STAGE_B + boff;
#pragma unroll
      for (int ks = 0; ks < 2; ++ks) {
        bf16x8 At[8], Bf[4];
#pragma unroll
        for (int m = 0; m < 8; ++m) At[m] = *(const bf16x8*)(sA + (m * 2 + ks) * 1024);
#pragma unroll
        for (int n = 0; n < 4; ++n) Bf[n] = *(const bf16x8*)(sB + (n * 2 + ks) * 1024);
        if (MODE != 3) {
#pragma unroll
          for (int m = 0; m < 8; ++m)
#pragma unroll
            for (int n = 0; n < 4; ++n) acc[m][n] = mfma16(At[m], Bf[n], acc[m][n]);
        } else {
#pragma unroll
          for (int m = 0; m < 8; ++m) acc[m][0][0] += __builtin_bit_cast(float, (int)At[m][0]);
#pragma unroll
          for (int n = 0; n < 4; ++n) acc[0][n][1] += __builtin_bit_cast(float, (int)Bf[n][0]);
        }
        __builtin_amdgcn_sched_barrier(0);
      }
      asm volatile("s_waitcnt vmcnt(0)" ::: "memory");
      __syncthreads();
    }
    staged = false;
    if (tile + nb < ntiles) {
      int tm2, tn2;
      tile_mn(tile + nb, tm2, tn2);
      const u16* Ab2 = A + (size_t)tm2 * 256 * LDK;
      const u16* Bb2 = Bt + (size_t)tn2 * 256 * LDK;
      { const u16* Ab = Ab2; const u16* Bb = Bb2; G_STAGE(0, 0); }
      staged = true;
    }
#undef G_STAGE
    if (MODE != 0 && MODE != 5) {
      float chk = 0.f;
#pragma unroll
      for (int m = 0; m < 8; ++m)
#pragma unroll
        for (int n = 0; n < 4; ++n) chk += acc[m][n][0] + acc[m][n][1] + acc[m][n][2] + acc[m][n][3];
      if (chk == 1.2345e-30f) p.out[0] = chk;
    } else
    {
      int t2 = threadIdx.x;
      asm volatile("" : "+v"(t2));
      const int lane2 = t2 & 63, wid2 = t2 >> 6;
      const int rbase = tm * 256 + (wid2 >> 2) * 128 + (lane2 >> 4) * 4 + (lane2 & 3);
      const int cbase = tn * 256 + (wid2 & 3) * 64 + (lane2 & 12);
#define EPI_LOOP(SEC) { _Pragma("unroll") for (int m = 0; m < 8; ++m) { _Pragma("unroll") for (int n = 0; n < 4; ++n) { \
          float v[4] = {acc[m][n][0], acc[m][n][1], acc[m][n][2], acc[m][n][3]}; \
          quad_transpose(v, lane2); \
          epi_store4<EPI, SEC>(p, rbase + m * 16, cbase + n * 16, v); } } }
      if (EPI == 0) {
        const int sec = tn >> 1;
        if (sec == 1) {
          float* LF = (float*)(p.ws + W_LF);
          float lbv[4][4];
#pragma unroll
          for (int n = 0; n < 4; ++n) {
            const int cc = cbase + n * 16 - 512;
            const f32x4 l0 = *(const f32x4*)(p.lb_logits + cc), l1 = *(const f32x4*)(p.lb_logits + 512 + cc);
#pragma unroll
            for (int e = 0; e < 4; ++e) lbv[n][e] = 1.f / (1.f + __expf(l1[e] - l0[e]));
          }
#pragma unroll
          for (int m = 0; m < 8; ++m)
#pragma unroll
            for (int n = 0; n < 4; ++n) {
              float v[4] = {acc[m][n][0], acc[m][n][1], acc[m][n][2], acc[m][n][3]};
              quad_transpose(v, lane2);
              f32x4 o;
#pragma unroll
              for (int e = 0; e < 4; ++e) o[e] = __logf(lbv[n][e] + (1.f - lbv[n][e]) * __builtin_amdgcn_rcpf(1.f + __expf(-v[e])));
              *(f32x4*)(LF + (size_t)(rbase + m * 16) * 512 + (cbase + n * 16 - 512)) = o;
            }
        } else {
          const bool gate = (sec == 3 || sec == 7);
          u16* dstb; int dstride, dcol;
          const int c0 = tn * 256 + (wid2 & 3) * 64;
          if (gate) { dstb = (u16*)(p.ws + W_GATES); dstride = 1024; dcol = sec == 3 ? c0 - 1536 : 512 + c0 - 3584; }
          else { dstb = (u16*)(p.ws + W_PQ); dstride = PQW; dcol = sec == 0 ? c0 : sec == 2 ? 512 + c0 - 1024 : 1024 + c0 - 2048; }
          char* ebuf = smem + STAGE_B + wid2 * 8192;
          const int wrow = (lane2 >> 4) * 4 + (lane2 & 3), wcol = (lane2 & 12);
          const int row00 = tm * 256 + (wid2 >> 2) * 128;
#pragma unroll
          for (int hf = 0; hf < 2; ++hf) {
#pragma unroll
            for (int m = 0; m < 4; ++m)
#pragma unroll
              for (int n = 0; n < 4; ++n) {
                float v[4] = {acc[hf * 4 + m][n][0], acc[hf * 4 + m][n][1], acc[hf * 4 + m][n][2], acc[hf * 4 + m][n][3]};
                if (gate) {
#pragma unroll
                  for (int e = 0; e < 4; ++e) v[e] = v[e] / (1.f + __expf(-v[e]));
                }
                quad_transpose(v, lane2);
                const int rl = m * 16 + wrow, cl = n * 16 + wcol;
                *(u32x2*)(ebuf + rl * 128 + ((cl * 2) ^ ((rl & 7) << 4))) = u32x2{pack2(v[0], v[1]), pack2(v[2], v[3])};
                if (sec >= 4 && sec <= 6) {
                  const int row = row00 + hf * 64 + rl, cc = c0 - 2048 + cl;
                  const int tt = row & 2047;
                  if (tt >= 2045) *(f32x4*)(p.out + O_CVP + (size_t)((row >> 11) * 3 + (tt - 2045)) * 1536 + cc) = f32x4{v[0], v[1], v[2], v[3]};
                }
              }
            asm volatile("s_waitcnt lgkmcnt(0)" ::: "memory");
#pragma unroll
            for (int i = 0; i < 8; ++i) {
              const int rl = i * 8 + (lane2 >> 3), ch = lane2 & 7;
              const u32x4 d = *(const u32x4*)(ebuf + rl * 128 + ((ch ^ (rl & 7)) << 4));
              *(u32x4*)(dstb + (size_t)(row00 + hf * 64 + rl) * dstride + dcol + ch * 8) = d;
            }
            asm volatile("s_waitcnt lgkmcnt(0)" ::: "memory");
          }
        }
      } else EPI_LOOP(0)
#undef EPI_LOOP
    }
  }
  const int nunits = MODE == 0 ? ntn * 16 : 0;
  int t3 = threadIdx.x;
  asm volatile("" : "+v"(t3));
  for (int u = bid; u < nunits; u += nb) {
    const int lane = t3 & 63, wid = t3 >> 6, fr = lane & 15, fq = lane >> 4;
    const u16* ar = A + (size_t)(MP + wid * 16 + fr) * LDK + fq * 8;
    const u16* br = Bt + (size_t)(u * 16 + fr) * LDK + fq * 8;
    f32x4 acc0 = {0.f, 0.f, 0.f, 0.f}, acc1 = {0.f, 0.f, 0.f, 0.f};
#pragma unroll 4
    for (int ks = 0; ks < 32; ks += 2) {
      const bf16x8 a0 = *(const bf16x8*)(ar + ks * 32), b0 = *(const bf16x8*)(br + ks * 32);
      const bf16x8 a1 = *(const bf16x8*)(ar + ks * 32 + 32), b1 = *(const bf16x8*)(br + ks * 32 + 32);
      acc0 = mfma16(a0, b0, acc0);
      acc1 = mfma16(a1, b1, acc1);
    }
    float v[4] = {acc0[0] + acc1[0], acc0[1] + acc1[1], acc0[2] + acc1[2], acc0[3] + acc1[3]};
    quad_transpose(v, lane);
    epi_store4<EPI, -1>(p, MP + wid * 16 + fq * 4 + (lane & 3), u * 16 + (fr & ~3), v);
  }
  __syncthreads();
}

__device__ void hgrn_item(const Params& p, char* smem, int idx) {
  const int tid = opaque_tid(), lane = tid & 63, w = tid >> 6;
  const int lr = lane & 15, lq = lane >> 4;
  const int h = idx & 3, c = (idx >> 2) & 31, b = idx >> 7;
  const int r0 = b * 2048 + c * 64;
  const u16* PQ = (const u16*)(p.ws + W_PQ);
  const float* LF = (const float*)(p.ws + W_LF);
  u16* QS = (u16*)(p.ws + W_QS);
  u16* O0 = (u16*)(p.ws + W_H);
  u16* NB = (u16*)(p.out);
  float* DVEC = (float*)(p.ws + W_DVEC);
  u16* qt = (u16*)smem;
  u16* kt = qt + 64 * 136;
  u16* ktT = kt + 64 * 136;
  u16* vT = ktT + 128 * 72;
  u16* sc = vT + 128 * 72;
  float* ps = (float*)(sc + 64 * 72);
  const int col = tid & 127, part = tid >> 7;
  float lfv[16], bcum[16];
  {
    const float* lfp = LF + (size_t)(r0 + part * 16) * 512 + h * 128 + col;
#pragma unroll
    for (int i = 0; i < 16; ++i) lfv[i] = lfp[(size_t)i * 512];
    float run = 0.f;
#pragma unroll
    for (int i = 0; i < 16; ++i) { run += lfv[i]; bcum[i] = run; }
    ps[part * 128 + col] = run;
  }
  u16 qraw[16], vraw[16];
  {
    const u16* qp0 = PQ + (size_t)(r0 + part * 16) * PQW + h * 128 + col;
#pragma unroll
    for (int i = 0; i < 16; ++i) { qraw[i] = qp0[(size_t)i * PQW]; vraw[i] = qp0[(size_t)i * PQW + 512]; }
  }
  __syncthreads();
  {
    float off = 0.f, blast = 0.f;
#pragma unroll
    for (int pp = 0; pp < 4; ++pp) { float t = ps[pp * 128 + col]; blast += t; if (pp < part) off += t; }
    u16* qsout = QS + ((size_t)idx * 64 + part * 16) * 128 + col;
#pragma unroll
    for (int i = 0; i < 16; ++i) {
      const float bb = bcum[i] + off;
      const int row = part * 16 + i;
      const float q = bf2f(qraw[i]);
      const u16 v = vraw[i];
      qsout[i * 128] = f2bf(q * __expf(bb));
      qt[row * 136 + col] = f2bf(q * __expf(bb - blast));
      const float kk = (1.f - __expf(lfv[i])) * __expf(blast - bb);
      const u16 kbv = f2bf(kk);
      kt[row * 136 + col] = kbv;
      ktT[col * 72 + row] = kbv;
      vT[col * 72 + row] = v;
    }
    if (part == 0) DVEC[idx * 128 + col] = __expf(blast);
  }
  __syncthreads();
  {
    const int tr = w >> 1;
    bf16x8 a[4];
#pragma unroll
    for (int ks = 0; ks < 4; ++ks) a[ks] = frag(qt, tr * 16, 136, ks * 32, lane);
#pragma unroll
    for (int tci = 0; tci < 2; ++tci) {
      const int tc = (w & 1) * 2 + tci;
      f32x4 acc = {0.f, 0.f, 0.f, 0.f};
#pragma unroll
      for (int ks = 0; ks < 4; ++ks) acc = mfma16(a[ks], frag(kt, tc * 16, 136, ks * 32, lane), acc);
#pragma unroll
      for (int j = 0; j < 4; ++j) {
        const int t = tr * 16 + lq * 4 + j, s = tc * 16 + lr;
        sc[t * 72 + s] = f2bf(t >= s ? acc[j] : 0.f);
      }
    }
  }
  __syncthreads();
  {
    const int tr = w >> 1;
    const bf16x8 a0 = frag(sc, tr * 16, 72, 0, lane), a1 = frag(sc, tr * 16, 72, 32, lane);
#pragma unroll
    for (int tci = 0; tci < 4; ++tci) {
      const int tc = (w & 1) * 4 + tci;
      f32x4 acc = {0.f, 0.f, 0.f, 0.f};
      acc = mfma16(a0, frag(vT, tc * 16, 72, 0, lane), acc);
      acc = mfma16(a1, frag(vT, tc * 16, 72, 32, lane), acc);
      {
        float v[4] = {acc[0], acc[1], acc[2], acc[3]};
        quad_transpose(v, lane);
        store4_bf16(O0 + ((size_t)idx * 64 + tr * 16 + lq * 4 + (lane & 3)) * 128 + tc * 16 + (lr & 12), v);
      }
    }
  }
  {
    const int tr = w;
    const bf16x8 a0 = frag(ktT, tr * 16, 72, 0, lane), a1 = frag(ktT, tr * 16, 72, 32, lane);
#pragma unroll
    for (int tc = 0; tc < 8; ++tc) {
      f32x4 acc = {0.f, 0.f, 0.f, 0.f};
      acc = mfma16(a0, frag(vT, tc * 16, 72, 0, lane), acc);
      acc = mfma16(a1, frag(vT, tc * 16, 72, 32, lane), acc);
      {
        float v[4] = {acc[0], acc[1], acc[2], acc[3]};
        quad_transpose(v, lane);
        store4_bf16(NB + ((size_t)idx * 128 + tr * 16 + lq * 4 + (lane & 3)) * 128 + tc * 16 + (lr & 12), v);
      }
    }
  }
  __syncthreads();
}

template <int J>
struct SolveCol {
  static __device__ __forceinline__ void run(f32x4 (&x)[16], const float* AT) {
    if constexpr (J < 63) {
      const float xj = x[J / 4][J % 4];
#pragma unroll
      for (int B = (J + 1) / 4; B < 16; ++B) {
        const f32x4 av = *(const f32x4*)(AT + J * 64 + B * 4);
        x[B] -= av * xj;
      }
      if ((J & 3) == 3) __builtin_amdgcn_sched_barrier(0);
      SolveCol<J + 1>::run(x, AT);
    }
  }
};

__device__ void gdn_item(const Params& p, char* smem, int idx) {
  const int tid = opaque_tid(), lane = tid & 63, w = tid >> 6;
  const int lr = lane & 15, lq = lane >> 4;
  const int h = idx & 3, c = (idx >> 2) & 31, b = idx >> 7;
  const int r0 = b * 2048 + c * 64;
  const u16* PQ = (const u16*)(p.ws + W_PQ);
  const float* BETA = (const float*)(p.ws + W_BETA);
  const float* GDEC = (const float*)(p.ws + W_GDEC);
  u16* QS = (u16*)(p.ws + W_QS);
  u16* O0 = (u16*)(p.ws + W_H);
  u16* NB = (u16*)(p.out);
  u16* MNEG = (u16*)(p.ws + W_MNEG);
  float* DSC = (float*)(p.ws + W_DSC);
  u16* kb = (u16*)smem;
  u16* qb = kb + 64 * 136;
  u16* vS = qb + 64 * 136;
  float* Asol = (float*)(vS + 64 * 128);
  u16* attn = (u16*)(Asol + 64 * 64);
  u16* khT = attn + 64 * 72;
  u16* WT = khT + 128 * 72;
  u16* U0T = WT + 128 * 72;
  float* gc = (float*)(U0T + 128 * 72);
  float* bet = gc + 64;

  if (w == 0) {
    float g = GDEC[(size_t)(r0 + lane) * 4 + h];
#pragma unroll
    for (int o = 1; o < 64; o <<= 1) { float t = __shfl_up(g, o, 64); if (lane >= o) g += t; }
    gc[lane] = g;
    bet[lane] = BETA[(size_t)(r0 + lane) * 4 + h];
  }
  {
    const int chq = 1024 + h * 128 + 2 * lane;
    const int cwq = h * 128 + 2 * lane;
    float cw[3][4][2];
#pragma unroll
    for (int ty = 0; ty < 3; ++ty)
#pragma unroll
      for (int j = 0; j < 4; ++j) {
        float2 t2 = *(const float2*)(p.conv_w + j * 1536 + ty * 512 + cwq);
        cw[ty][j][0] = t2.x; cw[ty][j][1] = t2.y;
      }
    float win[3][3][2];
    const int t0 = w * 8;
#pragma unroll
    for (int a = 0; a < 3; ++a) {
      const int rr = t0 - 3 + a;
      const bool valid = (c > 0) || (rr >= 0);
#pragma unroll
      for (int ty = 0; ty < 3; ++ty) {
        unsigned u = 0;
        if (valid) u = *(const unsigned*)(PQ + (ptrdiff_t)(r0 + rr) * PQW + chq + ty * 512);
        win[ty][a][0] = bf2f((u16)(u & 0xffff)); win[ty][a][1] = bf2f((u16)(u >> 16));
      }
    }
#pragma unroll
    for (int tt = 0; tt < 8; ++tt) {
      const int t = t0 + tt;
      float cv[3][2];
#pragma unroll
      for (int ty = 0; ty < 3; ++ty) {
        unsigned u = *(const unsigned*)(PQ + (size_t)(r0 + t) * PQW + chq + ty * 512);
        float c0 = bf2f((u16)(u & 0xffff)), c1 = bf2f((u16)(u >> 16));
        float s0 = cw[ty][0][0] * win[ty][0][0] + cw[ty][1][0] * win[ty][1][0] + cw[ty][2][0] * win[ty][2][0] + cw[ty][3][0] * c0;
        float s1 = cw[ty][0][1] * win[ty][0][1] + cw[ty][1][1] * win[ty][1][1] + cw[ty][2][1] * win[ty][2][1] + cw[ty][3][1] * c1;
        win[ty][0][0] = win[ty][1][0]; win[ty][0][1] = win[ty][1][1];
        win[ty][1][0] = win[ty][2][0]; win[ty][1][1] = win[ty][2][1];
        win[ty][2][0] = c0; win[ty][2][1] = c1;
        cv[ty][0] = siluf_(s0); cv[ty][1] = siluf_(s1);
      }
      float ssq = wave_sum(cv[0][0] * cv[0][0] + cv[0][1] * cv[0][1]);
      float ssk = wave_sum(cv[1][0] * cv[1][0] + cv[1][1] * cv[1][1]);
      const float rq = rsqrtf(ssq + EPS) * 0.08838834764831845f;
      const float rk = rsqrtf(ssk + EPS);
      *(unsigned*)(qb + t * 136 + 2 * lane) = pack2(cv[0][0] * rq, cv[0][1] * rq);
      *(unsigned*)(kb + t * 136 + 2 * lane) = pack2(cv[1][0] * rk, cv[1][1] * rk);
      *(unsigned*)(vS + t * 128 + 2 * lane) = pack2(cv[2][0], cv[2][1]);
    }
  }
  __syncthreads();
  {
    const int which = w >> 2, tr = w & 3;
    const u16* Asrc = which ? qb : kb;
    bf16x8 a[4];
#pragma unroll
    for (int ks = 0; ks < 4; ++ks) a[ks] = frag(Asrc, tr * 16, 136, ks * 32, lane);
#pragma unroll
    for (int tc = 0; tc < 4; ++tc) {
      f32x4 acc = {0.f, 0.f, 0.f, 0.f};
#pragma unroll
      for (int ks = 0; ks < 4; ++ks) acc = mfma16(a[ks], frag(kb, tc * 16, 136, ks * 32, lane), acc);
#pragma unroll
      for (int j = 0; j < 4; ++j) {
        const int t = tr * 16 + lq * 4 + j, s = tc * 16 + lr;
        const float L = __expf(fminf(gc[t] - gc[s], 0.f));
        if (which == 0) Asol[s * 64 + t] = (t > s) ? bet[t] * acc[j] * L : 0.f;
        else attn[t * 72 + s] = f2bf((t >= s) ? acc[j] * L : 0.f);
      }
    }
  }
  __syncthreads();
  if (tid < 256) {
    f32x4 x[16];
    if (tid < 128) {
#pragma unroll
      for (int s = 0; s < 64; ++s) { x[s >> 2][s & 3] = bf2f(vS[s * 128 + tid]) * bet[s]; if ((s & 7) == 7) __builtin_amdgcn_sched_barrier(0); }
    } else {
#pragma unroll
      for (int s = 0; s < 64; ++s) { x[s >> 2][s & 3] = bf2f(kb[s * 136 + tid - 128]) * bet[s] * __expf(gc[s]); if ((s & 7) == 7) __builtin_amdgcn_sched_barrier(0); }
    }
    SolveCol<0>::run(x, Asol);
    u16* dst = (tid < 128) ? (U0T + tid * 72) : (WT + (tid - 128) * 72);
#pragma unroll
    for (int s8 = 0; s8 < 8; ++s8) {
      *(u32x4*)(dst + s8 * 8) = u32x4{pack2(x[2 * s8][0], x[2 * s8][1]), pack2(x[2 * s8][2], x[2 * s8][3]),
                                      pack2(x[2 * s8 + 1][0], x[2 * s8 + 1][1]), pack2(x[2 * s8 + 1][2], x[2 * s8 + 1][3])};
    }
  } else {
    const float glast = gc[63];
    const int e0 = tid - 256;
#pragma unroll 4
    for (int i = 0; i < 32; ++i) {
      const int e = e0 + 256 * i;
      const int s = e & 63, kd = e >> 6;
      khT[kd * 72 + s] = f2bf(bf2f(kb[s * 136 + kd]) * __expf(glast - gc[s]));
    }
  }
  __syncthreads();
  {
    const int tr = w & 3, half = w >> 2;
    const u16* Bsrc = half ? U0T : WT;
    const bf16x8 a0 = frag(attn, tr * 16, 72, 0, lane), a1 = frag(attn, tr * 16, 72, 32, lane);
#pragma unroll 2
    for (int tc = 0; tc < 8; ++tc) {
      f32x4 acc = {0.f, 0.f, 0.f, 0.f};
      acc = mfma16(a0, frag(Bsrc, tc * 16, 72, 0, lane), acc);
      acc = mfma16(a1, frag(Bsrc, tc * 16, 72, 32, lane), acc);
      {
        float v[4];
#pragma unroll
        for (int j = 0; j < 4; ++j) {
          const int t = tr * 16 + lq * 4 + j, n = tc * 16 + lr;
          v[j] = half == 0 ? bf2f(qb[t * 136 + n]) * __expf(gc[t]) - acc[j] : acc[j];
        }
        quad_transpose(v, lane);
        const size_t o = ((size_t)(1024 + idx) * 64 + tr * 16 + lq * 4 + (lane & 3)) * 128 + tc * 16 + (lr & 12);
        store4_bf16((half == 0 ? QS : O0) + o, v);
      }
    }
  }
  {
    const int tr = w;
    const bf16x8 a0 = frag(khT, tr * 16, 72, 0, lane), a1 = frag(khT, tr * 16, 72, 32, lane);
#pragma unroll 2
    for (int tc = 0; tc < 16; ++tc) {
      const u16* Bsrc = tc < 8 ? WT : U0T;
      const int tcc = tc & 7;
      f32x4 acc = {0.f, 0.f, 0.f, 0.f};
      acc = mfma16(a0, frag(Bsrc, tcc * 16, 72, 0, lane), acc);
      acc = mfma16(a1, frag(Bsrc, tcc * 16, 72, 32, lane), acc);
      {
        float v[4];
#pragma unroll
        for (int j = 0; j < 4; ++j) v[j] = tc < 8 ? -acc[j] : acc[j];
        quad_transpose(v, lane);
        const size_t o = (size_t)(tr * 16 + lq * 4 + (lane & 3)) * 128 + tcc * 16 + (lr & 12);
        store4_bf16((tc < 8 ? MNEG + (size_t)idx * 16384 : NB + (size_t)(1024 + idx) * 16384) + o, v);
      }
    }
  }
  if (tid < 128) ((float*)(p.ws + W_DVEC))[(size_t)(1024 + idx) * 128 + tid] = __expf(gc[63]);
  __syncthreads();
}

__device__ void phase2(const Params& p, char* smem, int bid, int nb) {
  for (int it = bid; it < 2048; it += nb) {
    if (it >= 1024) { gdn_item(p, smem, it - 1024); if (DUP_MASK & 2048) gdn_item(p, smem, it - 1024); }
    else { hgrn_item(p, smem, it); if (DUP_MASK & 1024) hgrn_item(p, smem, it); }
  }
}

struct ScanRegs {
  bf16x8 Aq[4];
  bf16x8 Am[4];
  u32x2 o0, nn0, nn1;
  f32x4 dd;
};
#define RAW_BARRIER() do { asm volatile("s_waitcnt lgkmcnt(0)" ::: "memory"); __builtin_amdgcn_s_barrier(); asm volatile("" ::: "memory"); } while (0)

template <int TYPE>
__device__ __forceinline__ void scan_load(ScanRegs& r, const Params& p, int idx, unsigned qoff, unsigned ooff, unsigned moff,
                                          unsigned noff, unsigned doff) {
  const int ii = __builtin_amdgcn_readfirstlane(idx);
  const int ti = TYPE * 1024 + ii;
  const u16* QSb = (const u16*)(p.ws + W_QS) + (size_t)ti * 8192;
  const u16* O0b = (const u16*)(p.ws + W_H) + (size_t)ti * 8192;
  const u16* NBb = (const u16*)(p.out) + (size_t)ti * 16384;
#pragma unroll
  for (int ks = 0; ks < 4; ++ks) r.Aq[ks] = *(const bf16x8*)(QSb + (qoff + ks * 32));
  r.o0 = *(const u32x2*)(O0b + ooff);
  r.nn0 = *(const u32x2*)(NBb + noff);
  r.nn1 = *(const u32x2*)(NBb + (noff + 16));
  if (TYPE == 1) {
    const u16* Mb = (const u16*)(p.ws + W_MNEG) + (size_t)ii * 16384;
#pragma unroll
    for (int ks = 0; ks < 4; ++ks) r.Am[ks] = *(const bf16x8*)(Mb + (moff + ks * 32));
  }
  r.dd = *(const f32x4*)((const float*)(p.ws + W_DVEC) + (size_t)ti * 128 + doff);
}
__device__ __forceinline__ void unpack4(u32x2 u, float (&v)[4]) {
  v[0] = bf2f((u16)(u[0] & 0xffff)); v[1] = bf2f((u16)(u[0] >> 16));
  v[2] = bf2f((u16)(u[1] & 0xffff)); v[3] = bf2f((u16)(u[1] >> 16));
}

template <int TYPE>
__device__ void scan_unit(const Params& p, char* smem, int rem) {
  const int tid = opaque_tid(), lane = tid & 63, w = tid >> 6;
  const int lr = lane & 15, lq = lane >> 4;
  const int b = rem >> 4, h = (rem >> 2) & 3, vs2 = rem & 3;
  const int tr = lq * 4 + (lane & 3), tc4 = lr & 12;
  const int otr = w & 3, otc = w >> 2;
  float* OPRE = (float*)(p.ws + W_PQ);
  u16* SbT = (u16*)smem;
  for (int i = tid; i < 2 * 32 * 136; i += 512) SbT[i] = 0;
  f32x4 S0 = {0.f, 0.f, 0.f, 0.f}, S1 = {0.f, 0.f, 0.f, 0.f};
  const unsigned qoff = (unsigned)((otr * 16 + lr) * 128 + lq * 8);
  const unsigned ooff = (unsigned)((otr * 16 + tr) * 128 + vs2 * 32 + otc * 16 + tc4);
  const unsigned moff = (unsigned)((w * 16 + lr) * 128 + lq * 8);
  const unsigned noff = (unsigned)((w * 16 + tr) * 128 + vs2 * 32 + tc4);
  const unsigned doff = (unsigned)(w * 16 + lq * 4);
  float* const orow = OPRE + (size_t)(b * 2048 + otr * 16 + tr) * 1024 + TYPE * 512 + h * 128 + vs2 * 32 + otc * 16 + tc4;
  ScanRegs r0, r1, r2, r3;
  const int idx0 = (b * 32) * 4 + h;
  scan_load<TYPE>(r0, p, idx0 + 0, qoff, ooff, moff, noff, doff);
  scan_load<TYPE>(r1, p, idx0 + 4, qoff, ooff, moff, noff, doff);
  scan_load<TYPE>(r2, p, idx0 + 8, qoff, ooff, moff, noff, doff);
  scan_load<TYPE>(r3, p, idx0 + 12, qoff, ooff, moff, noff, doff);
  __builtin_amdgcn_sched_barrier(0);
#define SCAN_STEP(R, c) { \
    RAW_BARRIER(); \
    const u16* Sb = SbT + ((c) & 1) * 32 * 136 + lr * 136 + lq * 8; \
    bf16x8 B0[4], B1[4], Bo[4]; \
    _Pragma("unroll") for (int ks = 0; ks < 4; ++ks) { \
      B0[ks] = *(const bf16x8*)(Sb + ks * 32); \
      B1[ks] = *(const bf16x8*)(Sb + 16 * 136 + ks * 32); \
      Bo[ks] = *(const bf16x8*)(Sb + otc * 16 * 136 + ks * 32); } \
    { \
      float ov[4]; unpack4(R.o0, ov); quad_transpose(ov, lane); \
      f32x4 acc = {ov[0], ov[1], ov[2], ov[3]}; \
      _Pragma("unroll") for (int ks = 0; ks < 4; ++ks) acc = mfma16(R.Aq[ks], Bo[ks], acc); \
      float o[4] = {acc[0], acc[1], acc[2], acc[3]}; \
      quad_transpose(o, lane); \
      *(f32x4*)(orow + (size_t)(c) * 65536) = f32x4{o[0], o[1], o[2], o[3]}; \
    } \
    float n0[4], n1[4]; unpack4(R.nn0, n0); unpack4(R.nn1, n1); \
    quad_transpose(n0, lane); quad_transpose(n1, lane); \
    f32x4 T0, T1; \
    _Pragma("unroll") for (int j = 0; j < 4; ++j) { T0[j] = R.dd[j] * S0[j] + n0[j]; T1[j] = R.dd[j] * S1[j] + n1[j]; } \
    if (TYPE == 1) { _Pragma("unroll") for (int ks = 0; ks < 4; ++ks) { T0 = mfma16(R.Am[ks], B0[ks], T0); T1 = mfma16(R.Am[ks], B1[ks], T1); } } \
    S0 = T0; S1 = T1; \
    u16* Sw = SbT + (((c) + 1) & 1) * 32 * 136 + lr * 136 + w * 16 + lq * 4; \
    *(u32x2*)(Sw) = u32x2{pack2(S0[0], S0[1]), pack2(S0[2], S0[3])}; \
    *(u32x2*)(Sw + 16 * 136) = u32x2{pack2(S1[0], S1[1]), pack2(S1[2], S1[3])}; \
    __builtin_amdgcn_sched_barrier(0); \
    scan_load<TYPE>(R, p, idx0 + (((c) + 4 < 32) ? (c) + 4 : 31) * 4, qoff, ooff, moff, noff, doff); \
    __builtin_amdgcn_sched_barrier(0); \
  }
  for (int c0 = 0; c0 < 32; c0 += 4) {
    SCAN_STEP(r0, c0)
    SCAN_STEP(r1, c0 + 1)
    SCAN_STEP(r2, c0 + 2)
    SCAN_STEP(r3, c0 + 3)
  }
#undef SCAN_STEP
  float* so = p.out + (TYPE ? O_GDP : O_HGP) + (size_t)(b * 4 + h) * 16384 + (w * 16 + tr) * 128 + vs2 * 32 + tc4;
  {
    float sv[4] = {S0[0], S0[1], S0[2], S0[3]};
    quad_transpose(sv, lane);
    *(f32x4*)(so) = f32x4{sv[0], sv[1], sv[2], sv[3]};
    float sw[4] = {S1[0], S1[1], S1[2], S1[3]};
    quad_transpose(sw, lane);
    *(f32x4*)(so + 16) = f32x4{sw[0], sw[1], sw[2], sw[3]};
  }
  __syncthreads();
}

__device__ void sample_item(const Params& p, char* smem, int it) {
  const int tid = opaque_tid(), lane = tid & 63, w = tid >> 6;
  const int type = it >> 9, b = (it >> 2) & 127, h = it & 3;
  const int row = MP + b;
  const u16* PQ = (const u16*)(p.ws + W_PQ);
  const float* LF = (const float*)(p.ws + W_LF);
  const float* BETA = (const float*)(p.ws + W_BETA);
  const float* GDEC = (const float*)(p.ws + W_GDEC);
  float* OPRE = (float*)(p.ws + W_PQ);
  float* fq = (float*)smem;
  float* fk = fq + 128;
  float* fv = fk + 128;
  float* fe = fv + 128;
  float* red = fe + 128;
  float* sc = red + 1024;
  const int n = tid & 127, kp = tid >> 7;
  if (type == 0) {
    if (tid < 128) {
      const float lf = LF[(size_t)row * 512 + h * 128 + tid];
      const float f = __expf(lf);
      fe[tid] = f;
      fk[tid] = 1.f - f;
      fq[tid] = bf2f(PQ[(size_t)row * PQW + h * 128 + tid]);
      fv[tid] = bf2f(PQ[(size_t)row * PQW + 512 + h * 128 + tid]);
    }
    __syncthreads();
    const float* S = p.state_hgrn + ((size_t)(b * 4 + h) * 128) * 128;
    float* So = p.out + O_HGS + ((size_t)(b * 4 + h) * 128) * 128;
    const float vn = fv[n];
    float o = 0.f;
#pragma unroll
    for (int i = 0; i < 32; ++i) {
      const int k = kp * 32 + i;
      const float sn = fe[k] * S[k * 128 + n] + fk[k] * vn;
      So[k * 128 + n] = sn;
      o += fq[k] * sn;
    }
    red[kp * 128 + n] = o;
    __syncthreads();
    if (tid < 128) OPRE[(size_t)row * 1024 + h * 128 + tid] = red[tid] + red[128 + tid] + red[256 + tid] + red[384 + tid];
    __syncthreads();
  } else {
    const float* cprev = p.state_conv + (size_t)b * 3 * 1536;
    if (tid < 384) {
      const int ty = tid >> 7, cc = tid & 127;
      const int ch = ty * 512 + h * 128 + cc;
      const float p0 = cprev[ch], p1 = cprev[1536 + ch], p2 = cprev[3072 + ch];
      const float nw = bf2f(PQ[(size_t)row * PQW + 1024 + ch]);
      const float s = p.conv_w[ch] * p0 + p.conv_w[1536 + ch] * p1 + p.conv_w[3072 + ch] * p2 + p.conv_w[4608 + ch] * nw;
      fq[ty * 128 + cc] = siluf_(s);
      p.out[O_CVS + (size_t)(b * 3 + 0) * 1536 + ch] = p1;
      p.out[O_CVS + (size_t)(b * 3 + 1) * 1536 + ch] = p2;
    }
    __syncthreads();
    if (w < 2) {
      const float a0 = fq[w * 128 + lane], a1 = fq[w * 128 + 64 + lane];
      const float ss = wave_sum(a0 * a0 + a1 * a1);
      if (lane == 0) sc[w] = ss;
    }
    __syncthreads();
    const float rq = rsqrtf(sc[0] + EPS) * 0.08838834764831845f;
    const float rk = rsqrtf(sc[1] + EPS);
    __syncthreads();
    if (tid < 128) fq[tid] *= rq;
    else if (tid < 256) fk[tid - 128] *= rk;
    __syncthreads();
    if (w == 0) {
      const float qk = wave_sum(fq[lane] * fk[lane] + fq[64 + lane] * fk[64 + lane]);
      if (lane == 0) sc[2] = qk;
    }
    const float eg = __expf(GDEC[(size_t)row * 4 + h]);
    const float beta = BETA[(size_t)row * 4 + h];
    const float* S = p.state_gdn + ((size_t)(b * 4 + h) * 128) * 128;
    float* So = p.out + O_GDS + ((size_t)(b * 4 + h) * 128) * 128;
    float sd[32];
    float ks_ = 0.f, qs_ = 0.f;
#pragma unroll
    for (int i = 0; i < 32; ++i) {
      const int k = kp * 32 + i;
      sd[i] = eg * S[k * 128 + n];
      ks_ += fk[k] * sd[i];
      qs_ += fq[k] * sd[i];
    }
    red[kp * 128 + n] = ks_;
    red[512 + kp * 128 + n] = qs_;
    __syncthreads();
    const float kS = red[n] + red[128 + n] + red[256 + n] + red[384 + n];
    const float delta = (fv[n] - kS) * beta;
#pragma unroll
    for (int i = 0; i < 32; ++i) {
      const int k = kp * 32 + i;
      So[k * 128 + n] = sd[i] + fk[k] * delta;
    }
    if (tid < 128) {
      const float qS = red[512 + n] + red[640 + n] + red[768 + n] + red[896 + n];
      OPRE[(size_t)row * 1024 + 512 + h * 128 + n] = qS + sc[2] * delta;
    }
    __syncthreads();
  }
}

__device__ void sample_block4(const Params& p, char* smem, int bid) {
  const int tid = opaque_tid(), lane = tid & 63, w = tid >> 6;
  const u16* PQ = (const u16*)(p.ws + W_PQ);
  const float* LF = (const float*)(p.ws + W_LF);
  const float* BETA = (const float*)(p.ws + W_BETA);
  const float* GDEC = (const float*)(p.ws + W_GDEC);
  float* OPRE = (float*)(p.ws + W_PQ);
  float* vec = (float*)smem;
  float* red = vec + 2048;
  float* sc = red + 1024;
  if (tid < 256) {
    const int j = tid >> 7, c = tid & 127;
    const int it = bid + 256 * j, b = (it >> 2) & 127, h = it & 3, row = MP + b;
    const float f = __expf(LF[(size_t)row * 512 + h * 128 + c]);
    vec[(j * 4 + 0) * 128 + c] = bf2f(PQ[(size_t)row * PQW + h * 128 + c]);
    vec[(j * 4 + 1) * 128 + c] = 1.f - f;
    vec[(j * 4 + 2) * 128 + c] = bf2f(PQ[(size_t)row * PQW + 512 + h * 128 + c]);
    vec[(j * 4 + 3) * 128 + c] = f;
  }
  for (int e = tid; e < 768; e += 512) {
    const int j = 2 + e / 384, r = e % 384, ty = r >> 7, cc = r & 127;
    const int it = bid + 256 * j, b = (it >> 2) & 127, h = it & 3, row = MP + b;
    const int ch = ty * 512 + h * 128 + cc;
    const float* cprev = p.state_conv + (size_t)b * 3 * 1536;
    const float p0 = cprev[ch], p1 = cprev[1536 + ch], p2 = cprev[3072 + ch];
    const float nw = bf2f(PQ[(size_t)row * PQW + 1024 + ch]);
    const float s = p.conv_w[ch] * p0 + p.conv_w[1536 + ch] * p1 + p.conv_w[3072 + ch] * p2 + p.conv_w[4608 + ch] * nw;
    vec[(j * 4 + ty) * 128 + cc] = siluf_(s);
    p.out[O_CVS + (size_t)(b * 3 + 0) * 1536 + ch] = p1;
    p.out[O_CVS + (size_t)(b * 3 + 1) * 1536 + ch] = p2;
  }
  __syncthreads();
  if (w < 4) {
    const int j = 2 + (w >> 1), which = w & 1;
    const float a0 = vec[(j * 4 + which) * 128 + lane], a1 = vec[(j * 4 + which) * 128 + 64 + lane];
    const float ss = wave_sum(a0 * a0 + a1 * a1);
    if (lane == 0) sc[j * 4 + which] = ss;
  }
  __syncthreads();
  {
    const int j = 2 + (tid >> 8), which = (tid >> 7) & 1, c = tid & 127;
    const float r = which == 0 ? rsqrtf(sc[j * 4 + 0] + EPS) * 0.08838834764831845f : rsqrtf(sc[j * 4 + 1] + EPS);
    vec[(j * 4 + which) * 128 + c] *= r;
  }
  __syncthreads();
  if (w < 2) {
    const int j = 2 + w;
    const float qk = wave_sum(vec[(j * 4 + 0) * 128 + lane] * vec[(j * 4 + 1) * 128 + lane] +
                              vec[(j * 4 + 0) * 128 + 64 + lane] * vec[(j * 4 + 1) * 128 + 64 + lane]);
    if (lane == 0) sc[j * 4 + 2] = qk;
  }
  __syncthreads();
  const int n = tid & 127, kp = tid >> 7;
  float cur[32], nxt[32];
  {
    const int it = bid, b = (it >> 2) & 127, h = it & 3;
    const float* S = p.state_hgrn + ((size_t)(b * 4 + h) * 128) * 128;
#pragma unroll
    for (int i = 0; i < 32; ++i) cur[i] = S[(kp * 32 + i) * 128 + n];
  }
#pragma unroll
  for (int j = 0; j < 4; ++j) {
    const int it = bid + 256 * j, b = (it >> 2) & 127, h = it & 3, row = MP + b;
    if (j < 3) {
      const int it2 = bid + 256 * (j + 1), b2 = (it2 >> 2) & 127, h2 = it2 & 3;
      const float* S2 = ((j + 1) < 2 ? p.state_hgrn : p.state_gdn) + ((size_t)(b2 * 4 + h2) * 128) * 128;
#pragma unroll
      for (int i = 0; i < 32; ++i) nxt[i] = S2[(kp * 32 + i) * 128 + n];
    }
    const float* fq = vec + (j * 4 + 0) * 128;
    const float* fk = vec + (j * 4 + 1) * 128;
    const float* fv = vec + (j * 4 + 2) * 128;
    const float* fe = vec + (j * 4 + 3) * 128;
    if (j < 2) {
      float* So = p.out + O_HGS + ((size_t)(b * 4 + h) * 128) * 128;
      const float vn = fv[n];
      float o = 0.f;
#pragma unroll
      for (int i = 0; i < 32; ++i) {
        const int k = kp * 32 + i;
        const float sn = fe[k] * cur[i] + fk[k] * vn;
        So[k * 128 + n] = sn;
        o += fq[k] * sn;
      }
      red[kp * 128 + n] = o;
      __syncthreads();
      if (tid < 128) OPRE[(size_t)row * 1024 + h * 128 + tid] = red[tid] + red[128 + tid] + red[256 + tid] + red[384 + tid];
      __syncthreads();
    } else {
      float* So = p.out + O_GDS + ((size_t)(b * 4 + h) * 128) * 128;
      const float eg = __expf(GDEC[(size_t)row * 4 + h]);
      const float beta = BETA[(size_t)row * 4 + h];
      float ks_ = 0.f, qs_ = 0.f;
#pragma unroll
      for (int i = 0; i < 32; ++i) {
        const int k = kp * 32 + i;
        cur[i] *= eg;
        ks_ += fk[k] * cur[i];
        qs_ += fq[k] * cur[i];
      }
      red[kp * 128 + n] = ks_;
      red[512 + kp * 128 + n] = qs_;
      __syncthreads();
      const float kS = red[n] + red[128 + n] + red[256 + n] + red[384 + n];
      const float delta = (fv[n] - kS) * beta;
#pragma unroll
      for (int i = 0; i < 32; ++i) {
        const int k = kp * 32 + i;
        So[k * 128 + n] = cur[i] + fk[k] * delta;
      }
      if (tid < 128) {
        const float qS = red[512 + n] + red[640 + n] + red[768 + n] + red[896 + n];
        OPRE[(size_t)row * 1024 + 512 + h * 128 + n] = qS + sc[j * 4 + 2] * delta;
      }
      __syncthreads();
    }
#pragma unroll
    for (int i = 0; i < 32; ++i) cur[i] = nxt[i];
  }
}

__device__ void phase3(const Params& p, char* smem, int bid, int nb) {
  for (int u = bid; u < 256; u += nb) {
    int uu = u;
    if (nb == 256) {
      const int xcd = u & 7, j = u >> 3;
      uu = ((xcd * 8 + (j >> 2)) << 2) | (j & 3);
    }
    if (uu < 128) scan_unit<0>(p, smem, uu); else scan_unit<1>(p, smem, uu - 128);
    if (DUP_MASK & 256) { if (uu < 128) scan_unit<0>(p, smem, uu); else scan_unit<1>(p, smem, uu - 128); }
  }
  if (nb == 256) {
    if ((bid & 7) < 4) {
      const int rank = (bid >> 3) * 4 + (bid & 3);
      sample_block4(p, smem, rank);
      sample_block4(p, smem, rank + 128);
    }
  } else {
    for (int it = bid; it < 1024; it += nb) sample_item(p, smem, it);
  }
}

__device__ void phase4(const Params& p, int bid, int nb) {
  const int tid = opaque_tid(), lane = tid & 63, w = tid >> 6;
  const float* OPRE = (const float*)(p.ws + W_PQ);
  const u16* GATES = (const u16*)(p.ws + W_GATES);
  u16* A2 = (u16*)(p.ws + W_QS);
  constexpr int NG = MT / 8;
  for (int g = bid; g < NG; g += 2 * nb) {
    const bool two = (g + nb) < NG;
    const int rows[2] = {g * 8 + w, (two ? g + nb : g) * 8 + w};
    f32x4 v[2][4];
    u32x2 gt[2][4];
#pragma unroll
    for (int r = 0; r < 2; ++r)
#pragma unroll
      for (int i = 0; i < 4; ++i) {
        const int col = i * 256 + lane * 4;
        v[r][i] = *(const f32x4*)(OPRE + (size_t)rows[r] * 1024 + col);
        gt[r][i] = *(const u32x2*)(GATES + (size_t)rows[r] * 1024 + col);
      }
#pragma unroll
    for (int r = 0; r < 2; ++r) {
      if (r == 1 && !two) break;
#pragma unroll
      for (int i = 0; i < 4; ++i) {
        const int col = i * 256 + lane * 4;
        float ss = v[r][i][0] * v[r][i][0] + v[r][i][1] * v[r][i][1] + v[r][i][2] * v[r][i][2] + v[r][i][3] * v[r][i][3];
        ss += dpp_mov<0xB1, 0xf>(ss);
        ss += dpp_mov<0x4E, 0xf>(ss);
        ss += dpp_mov<0x141, 0xf>(ss);
        ss += dpp_mov<0x140, 0xf>(ss);
        ss += __shfl_xor(ss, 16, 64);
        const float rstd = rsqrtf(ss * (1.f / 128.f) + EPS);
        const f32x4 nw = *(const f32x4*)((col < 512 ? p.hg_norm : p.gdn_norm) + (col & 127));
        float gg[4];
        unpack4(gt[r][i], gg);
        *(u32x2*)(A2 + (size_t)rows[r] * LDK + col) =
            u32x2{pack2(v[r][i][0] * rstd * nw[0] * gg[0], v[r][i][1] * rstd * nw[1] * gg[1]),
                  pack2(v[r][i][2] * rstd * nw[2] * gg[2], v[r][i][3] * rstd * nw[3] * gg[3])};
      }
    }
  }
}

__device__ void phase6(const Params& p, int bid, int nb) {
  const int tid = opaque_tid(), lane = tid & 63, w = tid >> 6;
  constexpr int NG = MT / 8, NR = 4;
  for (int g = bid; g < NG; g += NR * nb) {
    float* y[NR];
    bool ok[NR];
    float4 xv[NR][4];
    float ss[NR];
#pragma unroll
    for (int r = 0; r < NR; ++r) {
      ok[r] = (g + r * nb) < NG;
      const int row = (ok[r] ? g + r * nb : g) * 8 + w;
      y[r] = row < MP ? p.out + O_YP + (size_t)row * 1024 : p.out + O_YS + (size_t)(row - MP) * 1024;
#pragma unroll
      for (int i = 0; i < 4; ++i) xv[r][i] = *(const float4*)(y[r] + i * 256 + lane * 4);
    }
#pragma unroll
    for (int r = 0; r < NR; ++r) {
      ss[r] = 0.f;
#pragma unroll
      for (int i = 0; i < 4; ++i) ss[r] += xv[r][i].x * xv[r][i].x + xv[r][i].y * xv[r][i].y + xv[r][i].z * xv[r][i].z + xv[r][i].w * xv[r][i].w;
      ss[r] = wave_sum(ss[r]);
    }
#pragma unroll
    for (int r = 0; r < NR; ++r) {
      if (ok[r]) {
        const float rstd = rsqrtf(ss[r] * (1.f / 1024.f) + EPS);
#pragma unroll
        for (int i = 0; i < 4; ++i) {
          const float4 nw = *(const float4*)(p.final_norm + i * 256 + lane * 4);
          float4 o;
          o.x = xv[r][i].x * rstd * nw.x; o.y = xv[r][i].y * rstd * nw.y; o.z = xv[r][i].z * rstd * nw.z; o.w = xv[r][i].w * rstd * nw.w;
          *(float4*)(y[r] + i * 256 + lane * 4) = o;
        }
      }
    }
  }
}

template <int PH>
__device__ __forceinline__ void run_phase(const Params& p, char* smem, int bid, int nb) {
  if (PH == 0) phase0(p, smem, bid, nb);
  else if (PH == 1) gemm_phase<0>(p, (const u16*)(p.ws + W_H), (const u16*)(p.ws + W_WINT), 16, smem, bid, nb);
  else if (PH == 2) phase2(p, smem, bid, nb);
  else if (PH == 3) phase3(p, smem, bid, nb);
  else if (PH == 4) phase4(p, bid, nb);
  else if (PH == 5) gemm_phase<1>(p, (const u16*)(p.ws + W_QS), (const u16*)(p.ws + W_WOUTT), 4, smem, bid, nb);
  else phase6(p, bid, nb);
}

#if MEGA
__global__ void __launch_bounds__(NTH) mega_kernel(Params p) {
  extern __shared__ __attribute__((aligned(16))) char smem[];
  cg::grid_group grid = cg::this_grid();
  const int bid = blockIdx.x, nb = gridDim.x;
#define RUNP(k) run_phase<k>(p, smem, bid, nb); grid.sync(); if (DUP_MASK & (1 << k)) { run_phase<k>(p, smem, bid, nb); grid.sync(); }
  RUNP(0) RUNP(1)
  if (PROBE_GEMM) { gemm_phase<0, PROBE_GEMM>(p, (const u16*)(p.ws + W_H), (const u16*)(p.ws + W_WINT), 16, smem, bid, nb); grid.sync(); }
  RUNP(2) RUNP(3) RUNP(4) RUNP(5)
#undef RUNP
  run_phase<6>(p, smem, bid, nb);
}
#else
template <int PH>
__global__ void __launch_bounds__(NTH) phase_kernel(Params p) {
  extern __shared__ __attribute__((aligned(16))) char smem[];
  run_phase<PH>(p, smem, blockIdx.x, gridDim.x);
}
template <int PH>
static void launch_phase(const Params& p, int grid, hipStream_t stream) {
  hipFuncSetAttribute((const void*)phase_kernel<PH>, hipFuncAttributeMaxDynamicSharedMemorySize, (int)LDS_BYTES);
  hipLaunchKernelGGL(phase_kernel<PH>, dim3(grid), dim3(NTH), LDS_BYTES, stream, p);
}
#endif

extern "C" void kernel_launch(void* const* d_in, const int* in_sizes, int n_in, void* d_out, int out_size,
                              void* d_ws, size_t ws_size, hipStream_t stream) {
  Params p{};
  p.x_prompt = (const float*)d_in[0];
  p.x_sample = (const float*)d_in[1];
  p.state_hgrn = (const float*)d_in[2];
  p.state_gdn = (const float*)d_in[3];
  p.state_conv = (const float*)d_in[4];
  p.norm_w = (const float*)d_in[5];
  p.w_in = (const float*)d_in[6];
  p.lb_logits = (const float*)d_in[7];
  p.conv_w = (const float*)d_in[8];
  p.a_log = (const float*)d_in[9];
  p.dt_bias = (const float*)d_in[10];
  p.hg_norm = (const float*)d_in[11];
  p.gdn_norm = (const float*)d_in[12];
  p.w_out = (const float*)d_in[13];
  p.final_norm = (const float*)d_in[14];
  p.out = (float*)d_out;
  p.ws = (char*)d_ws;
  if (ws_size < W_END) { fprintf(stderr, "workspace too small: %zu < %zu\n", ws_size, (size_t)W_END); return; }
#if MEGA
  static int grid_blocks = 0;
  if (!grid_blocks) {
    int dev = 0, cus = 0, per_cu = 0;
    hipGetDevice(&dev);
    hipDeviceGetAttribute(&cus, hipDeviceAttributeMultiprocessorCount, dev);
    hipFuncSetAttribute((const void*)mega_kernel, hipFuncAttributeMaxDynamicSharedMemorySize, (int)LDS_BYTES);
    hipOccupancyMaxActiveBlocksPerMultiprocessor(&per_cu, mega_kernel, NTH, LDS_BYTES);
    if (per_cu < 1) per_cu = 1;
    grid_blocks = cus * per_cu;
  }
  void* args[] = {&p};
  hipError_t e = hipLaunchCooperativeKernel((void*)mega_kernel, dim3(grid_blocks), dim3(NTH), args, LDS_BYTES, stream);
  if (e != hipSuccess) fprintf(stderr, "cooperative launch failed: %s (grid %d)\n", hipGetErrorString(e), grid_blocks);
#else
  const int grid = 256;
  launch_phase<0>(p, grid, stream);
  launch_phase<1>(p, grid, stream);
  launch_phase<2>(p, grid, stream);
  launch_phase<3>(p, grid, stream);
  launch_phase<4>(p, grid, stream);
  launch_phase<5>(p, grid, stream);
  launch_phase<6>(p, grid, stream);
#endif
}
```

```cpp
#include <hip/hip_runtime.h>
#include <hip/hip_cooperative_groups.h>
#include <cstdio>
namespace cg = cooperative_groups;

#ifndef MEGA
#define MEGA 1
#define PROBE_GEMM 0
#define PROBE_SYNC 0
#define PROBE_G 0
#define DUP_MASK 0
#endif

typedef unsigned short u16;
using bf16x8 = __attribute__((ext_vector_type(8))) short;
using f32x4 = __attribute__((ext_vector_type(4))) float;
using u32x4 = __attribute__((ext_vector_type(4))) unsigned;
using u32x2 = __attribute__((ext_vector_type(2))) unsigned;

#define NTH 512
constexpr int MP = 16384, MS = 128, MT = 16512, DM = 1024, DIN = 4104, PQW = 2560;
constexpr float EPS = 1e-6f;
constexpr int LDK = 1088;
constexpr size_t LDS_BYTES = 139264;

constexpr size_t O_YP = 0, O_YS = 16777216, O_HGP = 16908288, O_GDP = 17432576, O_CVP = 17956864,
                 O_HGS = 17993728, O_GDS = 26382336, O_CVS = 34770944;
constexpr size_t W_WINT = 0;
constexpr size_t W_WOUTT = W_WINT + (size_t)4096 * LDK * 2;
constexpr size_t W_BETA = W_WOUTT + (size_t)1024 * LDK * 2;
constexpr size_t W_GDEC = W_BETA + 264192;
constexpr size_t W_DVEC = W_GDEC + 264192;
constexpr size_t W_DSC = W_DVEC + 1048576;
constexpr size_t W_PQ = W_DSC + 4096;
constexpr size_t W_GATES = W_PQ + 84541440;
constexpr size_t W_H = W_GATES + 33816576;
constexpr size_t W_QS = W_H + (size_t)MT * LDK * 2;
constexpr size_t W_MNEG = W_QS + 33554432;
constexpr size_t W_LF = W_MNEG + 33554432;
constexpr size_t W_BAR = W_LF + 33816576;
constexpr size_t W_END = W_BAR + 16384;

struct Params {
  const float *x_prompt, *x_sample, *state_hgrn, *state_gdn, *state_conv, *norm_w, *w_in, *lb_logits,
      *conv_w, *a_log, *dt_bias, *hg_norm, *gdn_norm, *w_out, *final_norm;
  float* out;
  char* ws;
};

__device__ __forceinline__ int opaque_tid() { int t = threadIdx.x; asm volatile("" : "+v"(t)); return t; }
typedef __bf16 bf16x2_t __attribute__((ext_vector_type(2)));
typedef float f32x2_t __attribute__((ext_vector_type(2)));
__device__ __forceinline__ u16 f2bf(float x) { return __builtin_bit_cast(u16, (__bf16)x); }
__device__ __forceinline__ float bf2f(u16 h) { return __uint_as_float(((unsigned)h) << 16); }
__device__ __forceinline__ unsigned pack2(float a, float b) {
  f32x2_t v = {a, b};
  return __builtin_bit_cast(unsigned, __builtin_convertvector(v, bf16x2_t));
}
template <int CTRL, int ROWMASK>
__device__ __forceinline__ float dpp_mov(float v) {
  return __builtin_bit_cast(float, __builtin_amdgcn_update_dpp(0, __builtin_bit_cast(int, v), CTRL, ROWMASK, 0xf, false));
}
__device__ __forceinline__ float wave_sum(float v) {
  v += dpp_mov<0xB1, 0xf>(v);
  v += dpp_mov<0x4E, 0xf>(v);
  v += dpp_mov<0x141, 0xf>(v);
  v += dpp_mov<0x140, 0xf>(v);
  v += dpp_mov<0x142, 0xa>(v);
  v += dpp_mov<0x143, 0xc>(v);
  return __builtin_bit_cast(float, __builtin_amdgcn_readlane(__builtin_bit_cast(int, v), 63));
}
__device__ __forceinline__ float sigmoidf_(float x) { return 1.f / (1.f + __expf(-x)); }
__device__ __forceinline__ float siluf_(float x) { return x / (1.f + __expf(-x)); }
__device__ __forceinline__ f32x4 mfma16(bf16x8 a, bf16x8 b, f32x4 c) {
  return __builtin_amdgcn_mfma_f32_16x16x32_bf16(a, b, c, 0, 0, 0);
}
__device__ __forceinline__ bf16x8 frag(const u16* base, int row0, int stride, int koff, int lane) {
  return *(const bf16x8*)(base + (row0 + (lane & 15)) * stride + koff + (lane >> 4) * 8);
}

__device__ __forceinline__ void quad_transpose(float (&v)[4], int lane) {
  {
    const bool b = lane & 1;
    float s0 = b ? v[0] : v[1], s1 = b ? v[2] : v[3];
    float r0 = dpp_mov<0xB1, 0xf>(s0), r1 = dpp_mov<0xB1, 0xf>(s1);
    if (b) { v[0] = r0; v[2] = r1; } else { v[1] = r0; v[3] = r1; }
  }
  {
    const bool b = lane & 2;
    float s0 = b ? v[0] : v[2], s1 = b ? v[1] : v[3];
    float r0 = dpp_mov<0x4E, 0xf>(s0), r1 = dpp_mov<0x4E, 0xf>(s1);
    if (b) { v[0] = r0; v[1] = r1; } else { v[2] = r0; v[3] = r1; }
  }
}
__device__ __forceinline__ void store4_bf16(u16* dst, const float (&v)[4]) {
  *(u32x2*)dst = u32x2{pack2(v[0], v[1]), pack2(v[2], v[3])};
}
__device__ void phase0(const Params& p, char* smem, int bid, int nb) {
  const int tid = opaque_tid(), lane = tid & 63, w = tid >> 6;
  u16* WinT = (u16*)(p.ws + W_WINT);
  u16* WoutT = (u16*)(p.ws + W_WOUTT);
  u16* H = (u16*)(p.ws + W_H);
  float* BETA = (float*)(p.ws + W_BETA);
  float* GDEC = (float*)(p.ws + W_GDEC);
  float* tl = (float*)smem;
  for (int t = bid; t < 1280; t += nb) {
    const float* src; int sstride; u16* dst; int kt, nt;
    if (t < 1024) { src = p.w_in; sstride = DIN; dst = WinT; kt = t >> 6; nt = t & 63; }
    else { int u = t - 1024; src = p.w_out; sstride = 1024; dst = WoutT; kt = u >> 4; nt = u & 15; }
#pragma unroll
    for (int i = 0; i < 8; ++i) {
      int idx = tid + 512 * i; int kk = idx >> 6, nn = idx & 63;
      tl[kk * 65 + nn] = src[(size_t)(kt * 64 + kk) * sstride + nt * 64 + nn];
    }
    __syncthreads();
    {
      int nn = tid >> 3, k8 = (tid & 7) * 8;
      unsigned pk[4];
#pragma unroll
      for (int e = 0; e < 4; ++e) pk[e] = pack2(tl[(k8 + 2 * e) * 65 + nn], tl[(k8 + 2 * e + 1) * 65 + nn]);
      *(uint4*)(dst + (size_t)(nt * 64 + nn) * LDK + kt * 64 + k8) = make_uint4(pk[0], pk[1], pk[2], pk[3]);
    }
    __syncthreads();
  }
  float* W8s = (float*)smem;
  for (int idx = tid; idx < 8192; idx += 512) {
    int j = idx & 7, k = idx >> 3;
    W8s[j * 1024 + k] = p.w_in[(size_t)k * DIN + 4096 + j];
  }
  __syncthreads();
  for (int g = bid; g < MT / 8; g += nb) {
    int row = g * 8 + w;
    const float* x = row < MP ? p.x_prompt + (size_t)row * 1024 : p.x_sample + (size_t)(row - MP) * 1024;
    float4 xv[4];
    float ss = 0.f;
#pragma unroll
    for (int i = 0; i < 4; ++i) {
      xv[i] = *(const float4*)(x + i * 256 + lane * 4);
      ss += xv[i].x * xv[i].x + xv[i].y * xv[i].y + xv[i].z * xv[i].z + xv[i].w * xv[i].w;
    }
    ss = wave_sum(ss);
    float rstd = rsqrtf(ss * (1.f / 1024.f) + EPS);
    float d0 = 0, d1 = 0, d2 = 0, d3 = 0, d4 = 0, d5 = 0, d6 = 0, d7 = 0;
#pragma unroll
    for (int i = 0; i < 4; ++i) {
      float4 nw = *(const float4*)(p.norm_w + i * 256 + lane * 4);
      float4 hv;
      hv.x = xv[i].x * rstd * nw.x; hv.y = xv[i].y * rstd * nw.y; hv.z = xv[i].z * rstd * nw.z; hv.w = xv[i].w * rstd * nw.w;
      *(uint2*)(H + (size_t)row * LDK + i * 256 + lane * 4) = make_uint2(pack2(hv.x, hv.y), pack2(hv.z, hv.w));
#define GDOT(j, dj) { float4 wv = *(const float4*)(W8s + j * 1024 + i * 256 + lane * 4); dj += hv.x * wv.x + hv.y * wv.y + hv.z * wv.z + hv.w * wv.w; }
      GDOT(0, d0) GDOT(1, d1) GDOT(2, d2) GDOT(3, d3) GDOT(4, d4) GDOT(5, d5) GDOT(6, d6) GDOT(7, d7)
#undef GDOT
    }
    d0 = wave_sum(d0); d1 = wave_sum(d1); d2 = wave_sum(d2); d3 = wave_sum(d3);
    d4 = wave_sum(d4); d5 = wave_sum(d5); d6 = wave_sum(d6); d7 = wave_sum(d7);
    if (lane < 4) {
      float gb = lane == 0 ? d0 : lane == 1 ? d1 : lane == 2 ? d2 : d3;
      float ga = lane == 0 ? d4 : lane == 1 ? d5 : lane == 2 ? d6 : d7;
      BETA[row * 4 + lane] = 1.f / (1.f + expf(-gb));
      float z = ga + p.dt_bias[lane];
      float sp = z > 20.f ? z : log1pf(expf(z));
      GDEC[row * 4 + lane] = -expf(p.a_log[lane]) * sp;
    }
  }
  __syncthreads();
}

__device__ __forceinline__ int lds_byte2(int r, int c) {
  int st = (r >> 4) * 2 + (c >> 5), ob = (r & 15) * 64 + (c & 31) * 2;
  return st * 1024 + (ob ^ (((ob >> 9) & 1) << 5));
}
__device__ __forceinline__ void stage_rc2(int b, int& R, int& C) {
  int st = b >> 10, sb = b & 1023, swz = sb ^ (((sb >> 9) & 1) << 5);
  R = (st >> 1) * 16 + swz / 64;
  C = (st & 1) * 32 + (swz % 64) / 2;
}
template <int EPI, int SEC>
__device__ __forceinline__ void epi_store4(const Params& p, int row, int col4, const float (&v)[4]) {
  if (EPI == 0) {
    u16* PQ = (u16*)(p.ws + W_PQ);
    u16* GATES = (u16*)(p.ws + W_GATES);
    float* LF = (float*)(p.ws + W_LF);
    const int sec = SEC >= 0 ? SEC : (col4 >> 9);
    if (sec == 0) {
      *(uint2*)(PQ + (size_t)row * PQW + col4) = make_uint2(pack2(v[0], v[1]), pack2(v[2], v[3]));
    } else if (sec == 1) {
      const int cc = col4 - 512;
      const f32x4 l0 = *(const f32x4*)(p.lb_logits + cc), l1 = *(const f32x4*)(p.lb_logits + 512 + cc);
      f32x4 o;
#pragma unroll
      for (int i = 0; i < 4; ++i) {
        const float lbv = 1.f / (1.f + __expf(l1[i] - l0[i]));
        o[i] = __logf(lbv + (1.f - lbv) / (1.f + __expf(-v[i])));
      }
      *(f32x4*)(LF + (size_t)row * 512 + cc) = o;
    } else if (sec == 2) {
      *(uint2*)(PQ + (size_t)row * PQW + 512 + (col4 - 1024)) = make_uint2(pack2(v[0], v[1]), pack2(v[2], v[3]));
    } else if (sec == 3 || sec == 7) {
      const int cc = sec == 3 ? col4 - 1536 : 512 + col4 - 3584;
      *(uint2*)(GATES + (size_t)row * 1024 + cc) =
          make_uint2(pack2(v[0] / (1.f + __expf(-v[0])), v[1] / (1.f + __expf(-v[1]))),
                     pack2(v[2] / (1.f + __expf(-v[2])), v[3] / (1.f + __expf(-v[3]))));
    } else {
      const int cc = col4 - 2048;
      *(uint2*)(PQ + (size_t)row * PQW + 1024 + cc) = make_uint2(pack2(v[0], v[1]), pack2(v[2], v[3]));
      if (row < MP) {
        const int tt = row & 2047;
        if (tt >= 2045) *(f32x4*)(p.out + O_CVP + (size_t)((row >> 11) * 3 + (tt - 2045)) * 1536 + cc) = f32x4{v[0], v[1], v[2], v[3]};
      } else {
        *(f32x4*)(p.out + O_CVS + (size_t)((row - MP) * 3 + 2) * 1536 + cc) = f32x4{v[0], v[1], v[2], v[3]};
      }
    }
  } else {
    const float* xr = row < MP ? p.x_prompt + (size_t)row * 1024 : p.x_sample + (size_t)(row - MP) * 1024;
    float* yr = row < MP ? p.out + O_YP + (size_t)row * 1024 : p.out + O_YS + (size_t)(row - MP) * 1024;
    const f32x4 xv = *(const f32x4*)(xr + col4);
    *(f32x4*)(yr + col4) = f32x4{xv[0] + v[0], xv[1] + v[1], xv[2] + v[2], xv[3] + v[3]};
  }
}

template <int EPI, int MODE = 0>
__device__ void gemm_phase(const Params& p, const u16* __restrict__ A, const u16* __restrict__ Bt, int ntn,
                           char* smem, int bid, int nb) {
  const int tid = opaque_tid(), lane = tid & 63, wid = tid >> 6;
  const int wr = wid >> 2, wc = wid & 3, fr = lane & 15, fq = lane >> 4;
  constexpr int TILE_B = 256 * 64 * 2, STAGE_B = 2 * TILE_B;
  int sR0, sC0;
  stage_rc2(wid * 1024 + lane * 16, sR0, sC0);
  const unsigned goff = (unsigned)(sR0 * LDK + sC0);
  const unsigned lbase = (unsigned)(size_t)smem + (unsigned)(wid * 1024);
  const int aoff = (wr * 16) * 1024 + ((fr * 64 + fq * 16) ^ ((((fr * 64 + fq * 16) >> 9) & 1) << 5));
  const int boff = TILE_B + (wc * 8) * 1024 + ((fr * 64 + fq * 16) ^ ((((fr * 64 + fq * 16) >> 9) & 1) << 5));
  const int ntiles = 64 * ntn;
  auto tile_mn = [&](int tile, int& tm, int& tn) {
    const int rnd = tile >> 8, t = tile & 255, xcd = t & 7, j = t >> 3;
    if (ntn == 16) { tm = rnd * 16 + (xcd >> 1) * 4 + (j & 3); tn = ((xcd & 1) * 8 + (j >> 2) + (rnd & 1) * 2 + (rnd >> 1) * 8) & 15; }
    else { tm = xcd * 8 + (j & 7); tn = j >> 3; }
  };
  bool staged = false;
  for (int tile = bid; tile < ntiles; tile += nb) {
    int tm, tn;
    tile_mn(tile, tm, tn);
    const u16* Ab = A + (size_t)tm * 256 * LDK;
    const u16* Bb = Bt + (size_t)tn * 256 * LDK;
    f32x4 acc[8][4];
#pragma unroll
    for (int m = 0; m < 8; ++m)
#pragma unroll
      for (int n = 0; n < 4; ++n) acc[m][n] = f32x4{0.f, 0.f, 0.f, 0.f};
#define G_STAGE(buf, kt) { _Pragma("unroll") for (int i = 0; i < 4; ++i) { \
      __builtin_amdgcn_global_load_lds((const unsigned*)(Ab + (goff + (unsigned)(i * 64 * LDK + (kt) * 64))), \
          (__attribute__((address_space(3))) unsigned*)(lbase + (buf) * STAGE_B + i * 8192), 16, 0, 0); \
      __builtin_amdgcn_global_load_lds((const unsigned*)(Bb + (goff + (unsigned)(i * 64 * LDK + (kt) * 64))), \
          (__attribute__((address_space(3))) unsigned*)(lbase + (buf) * STAGE_B + TILE_B + i * 8192), 16, 0, 0); } }
    if (!staged) G_STAGE(0, 0);
    asm volatile("s_waitcnt vmcnt(0)" ::: "memory");
    __syncthreads();
    for (int t = 0; t < 16; ++t) {
      const int cur = t & 1;
      if (MODE != 2) { if (t + 1 < 16) G_STAGE(cur ^ 1, t + 1); }
      const char* sA = smem + cur * STAGE_B + aoff;
      const char* sB = smem + cur * STAGE_B + boff;
#pragma unroll
      for (int ks = 0; ks < 2; ++ks) {
        bf16x8 At[8], Bf[4];
#pragma unroll
        for (int m = 0; m < 8; ++m) At[m] = *(const bf16x8*)(sA + (m * 2 + ks) * 1024);
#pragma unroll
        for (int n = 0; n < 4; ++n) Bf[n] = *(const bf16x8*)(sB + (n * 2 + ks) * 1024);
        if (MODE != 3) {
#pragma unroll
          for (int m = 0; m < 8; ++m)
#pragma unroll
            for (int n = 0; n < 4; ++n) acc[m][n] = mfma16(At[m], Bf[n], acc[m][n]);
        } else {
#pragma unroll
          for (int m = 0; m < 8; ++m) acc[m][0][0] += __builtin_bit_cast(float, (int)At[m][0]);
#pragma unroll
          for (int n = 0; n < 4; ++n) acc[0][n][1] += __builtin_bit_cast(float, (int)Bf[n][0]);
        }
        __builtin_amdgcn_sched_barrier(0);
      }
      asm volatile("s_waitcnt vmcnt(0)" ::: "memory");
      __syncthreads();
    }
    staged = false;
    if (tile + nb < ntiles) {
      int tm2, tn2;
      tile_mn(tile + nb, tm2, tn2);
      const u16* Ab2 = A + (size_t)tm2 * 256 * LDK;
      const u16* Bb2 = Bt + (size_t)tn2 * 256 * LDK;
      { const u16* Ab = Ab2; const u16* Bb = Bb2; G_STAGE(0, 0); }
      staged = true;
    }
#undef G_STAGE
    if (MODE != 0 && MODE != 5) {
      float chk = 0.f;
#pragma unroll
      for (int m = 0; m < 8; ++m)
#pragma unroll
        for (int n = 0; n < 4; ++n) chk += acc[m][n][0] + acc[m][n][1] + acc[m][n][2] + acc[m][n][3];
      if (chk == 1.2345e-30f) p.out[0] = chk;
    } else
    {
      int t2 = threadIdx.x;
      asm volatile("" : "+v"(t2));
      const int lane2 = t2 & 63, wid2 = t2 >> 6;
      const int rbase = tm * 256 + (wid2 >> 2) * 128 + (lane2 >> 4) * 4 + (lane2 & 3);
      const int cbase = tn * 256 + (wid2 & 3) * 64 + (lane2 & 12);
#define EPI_LOOP(SEC) { _Pragma("unroll") for (int m = 0; m < 8; ++m) { _Pragma("unroll") for (int n = 0; n < 4; ++n) { \
          float v[4] = {acc[m][n][0], acc[m][n][1], acc[m][n][2], acc[m][n][3]}; \
          quad_transpose(v, lane2); \
          epi_store4<EPI, SEC>(p, rbase + m * 16, cbase + n * 16, v); } } }
      if (EPI == 0) {
        const int sec = tn >> 1;
        if (sec == 1) {
          float* LF = (float*)(p.ws + W_LF);
          float lbv[4][4];
#pragma unroll
          for (int n = 0; n < 4; ++n) {
            const int cc = cbase + n * 16 - 512;
            const f32x4 l0 = *(const f32x4*)(p.lb_logits + cc), l1 = *(const f32x4*)(p.lb_logits + 512 + cc);
#pragma unroll
            for (int e = 0; e < 4; ++e) lbv[n][e] = 1.f / (1.f + __expf(l1[e] - l0[e]));
          }
#pragma unroll
          for (int m = 0; m < 8; ++m)
#pragma unroll
            for (int n = 0; n < 4; ++n) {
              float v[4] = {acc[m][n][0], acc[m][n][1], acc[m][n][2], acc[m][n][3]};
              quad_transpose(v, lane2);
              f32x4 o;
#pragma unroll
              for (int e = 0; e < 4; ++e) o[e] = __logf(lbv[n][e] + (1.f - lbv[n][e]) * __builtin_amdgcn_rcpf(1.f + __expf(-v[e])));
              *(f32x4*)(LF + (size_t)(rbase + m * 16) * 512 + (cbase + n * 16 - 512)) = o;
            }
        } else {
          const bool gate = (sec == 3 || sec == 7);
          u16* dstb; int dstride, dcol;
          const int c0 = tn * 256 + (wid2 & 3) * 64;
          if (gate) { dstb = (u16*)(p.ws + W_GATES); dstride = 1024; dcol = sec == 3 ? c0 - 1536 : 512 + c0 - 3584; }
          else { dstb = (u16*)(p.ws + W_PQ); dstride = PQW; dcol = sec == 0 ? c0 : sec == 2 ? 512 + c0 - 1024 : 1024 + c0 - 2048; }
          char* ebuf = smem + STAGE_B + wid2 * 8192;
          const int wrow = (lane2 >> 4) * 4 + (lane2 & 3), wcol = (lane2 & 12);
          const int row00 = tm * 256 + (wid2 >> 2) * 128;
#pragma unroll
          for (int hf = 0; hf < 2; ++hf) {
#pragma unroll
            for (int m = 0; m < 4; ++m)
#pragma unroll
              for (int n = 0; n < 4; ++n) {
                float v[4] = {acc[hf * 4 + m][n][0], acc[hf * 4 + m][n][1], acc[hf * 4 + m][n][2], acc[hf * 4 + m][n][3]};
                if (gate) {
#pragma unroll
                  for (int e = 0; e < 4; ++e) v[e] = v[e] / (1.f + __expf(-v[e]));
                }
                quad_transpose(v, lane2);
                const int rl = m * 16 + wrow, cl = n * 16 + wcol;
                *(u32x2*)(ebuf + rl * 128 + ((cl * 2) ^ ((rl & 7) << 4))) = u32x2{pack2(v[0], v[1]), pack2(v[2], v[3])};
                if (sec >= 4 && sec <= 6) {
                  const int row = row00 + hf * 64 + rl, cc = c0 - 2048 + cl;
                  const int tt = row & 2047;
                  if (tt >= 2045) *(f32x4*)(p.out + O_CVP + (size_t)((row >> 11) * 3 + (tt - 2045)) * 1536 + cc) = f32x4{v[0], v[1], v[2], v[3]};
                }
              }
            asm volatile("s_waitcnt lgkmcnt(0)" ::: "memory");
#pragma unroll
            for (int i = 0; i < 8; ++i) {
              const int rl = i * 8 + (lane2 >> 3), ch = lane2 & 7;
              const u32x4 d = *(const u32x4*)(ebuf + rl * 128 + ((ch ^ (rl & 7)) << 4));
              *(u32x4*)(dstb + (size_t)(row00 + hf * 64 + rl) * dstride + dcol + ch * 8) = d;
            }
            asm volatile("s_waitcnt lgkmcnt(0)" ::: "memory");
          }
        }
      } else EPI_LOOP(0)
#undef EPI_LOOP
    }
  }
  const int nunits = MODE == 0 ? ntn * 16 : 0;
  int t3 = threadIdx.x;
  asm volatile("" : "+v"(t3));
  for (int u = bid; u < nunits; u += nb) {
    const int lane = t3 & 63, wid = t3 >> 6, fr = lane & 15, fq = lane >> 4;
    const u16* ar = A + (size_t)(MP + wid * 16 + fr) * LDK + fq * 8;
    const u16* br = Bt + (size_t)(u * 16 + fr) * LDK + fq * 8;
    f32x4 acc0 = {0.f, 0.f, 0.f, 0.f}, acc1 = {0.f, 0.f, 0.f, 0.f};
#pragma unroll 4
    for (int ks = 0; ks < 32; ks += 2) {
      const bf16x8 a0 = *(const bf16x8*)(ar + ks * 32), b0 = *(const bf16x8*)(br + ks * 32);
      const bf16x8 a1 = *(const bf16x8*)(ar + ks * 32 + 32), b1 = *(const bf16x8*)(br + ks * 32 + 32);
      acc0 = mfma16(a0, b0, acc0);
      acc1 = mfma16(a1, b1, acc1);
    }
    float v[4] = {acc0[0] + acc1[0], acc0[1] + acc1[1], acc0[2] + acc1[2], acc0[3] + acc1[3]};
    quad_transpose(v, lane);
    epi_store4<EPI, -1>(p, MP + wid * 16 + fq * 4 + (lane & 3), u * 16 + (fr & ~3), v);
  }
  __syncthreads();
}

#define RAW_BARRIER() do { asm volatile("s_waitcnt lgkmcnt(0)" ::: "memory"); __builtin_amdgcn_s_barrier(); asm volatile("" ::: "memory"); } while (0)
__device__ void hgrn_item(const Params& p, char* smem, int idx) {
  const int tid = opaque_tid(), lane = tid & 63, w = tid >> 6;
  const int lr = lane & 15, lq = lane >> 4;
  const int h = idx & 3, c = (idx >> 2) & 31, b = idx >> 7;
  const int r0 = b * 2048 + c * 64;
  const u16* PQ = (const u16*)(p.ws + W_PQ);
  const float* LF = (const float*)(p.ws + W_LF);
  u16* QS = (u16*)(p.ws + W_QS);
  u16* O0 = (u16*)(p.ws + W_H);
  u16* NB = (u16*)(p.out);
  float* DVEC = (float*)(p.ws + W_DVEC);
  u16* qt = (u16*)smem;
  u16* kt = qt + 64 * 136;
  u16* ktT = kt + 64 * 136;
  u16* vT = ktT + 128 * 72;
  u16* sc = vT + 128 * 72;
  float* ps = (float*)(sc + 64 * 72);
  const int col = tid & 127, part = tid >> 7;
  float lfv[16], bcum[16];
  {
    const float* lfp = LF + (size_t)(r0 + part * 16) * 512 + h * 128 + col;
#pragma unroll
    for (int i = 0; i < 16; ++i) lfv[i] = lfp[(size_t)i * 512];
    float run = 0.f;
#pragma unroll
    for (int i = 0; i < 16; ++i) { run += lfv[i]; bcum[i] = run; }
    ps[part * 128 + col] = run;
  }
  u16 qraw[16], vraw[16];
  {
    const u16* qp0 = PQ + (size_t)(r0 + part * 16) * PQW + h * 128 + col;
#pragma unroll
    for (int i = 0; i < 16; ++i) { qraw[i] = qp0[(size_t)i * PQW]; vraw[i] = qp0[(size_t)i * PQW + 512]; }
  }
  RAW_BARRIER();
  {
    float off = 0.f, blast = 0.f;
#pragma unroll
    for (int pp = 0; pp < 4; ++pp) { float t = ps[pp * 128 + col]; blast += t; if (pp < part) off += t; }
    u16* qsout = QS + ((size_t)idx * 64 + part * 16) * 128 + col;
#pragma unroll
    for (int i = 0; i < 16; ++i) {
      const float bb = bcum[i] + off;
      const int row = part * 16 + i;
      const float q = bf2f(qraw[i]);
      const u16 v = vraw[i];
      qsout[i * 128] = f2bf(q * __expf(bb));
      qt[row * 136 + col] = f2bf(q * __expf(bb - blast));
      const float kk = (1.f - __expf(lfv[i])) * __expf(blast - bb);
      const u16 kbv = f2bf(kk);
      kt[row * 136 + col] = kbv;
      ktT[col * 72 + row] = kbv;
      vT[col * 72 + row] = v;
    }
    if (part == 0) DVEC[idx * 128 + col] = __expf(blast);
  }
  RAW_BARRIER();
  {
    const int tr = w >> 1;
    bf16x8 a[4];
#pragma unroll
    for (int ks = 0; ks < 4; ++ks) a[ks] = frag(qt, tr * 16, 136, ks * 32, lane);
#pragma unroll
    for (int tci = 0; tci < 2; ++tci) {
      const int tc = (w & 1) * 2 + tci;
      f32x4 acc = {0.f, 0.f, 0.f, 0.f};
#pragma unroll
      for (int ks = 0; ks < 4; ++ks) acc = mfma16(a[ks], frag(kt, tc * 16, 136, ks * 32, lane), acc);
#pragma unroll
      for (int j = 0; j < 4; ++j) {
        const int t = tr * 16 + lq * 4 + j, s = tc * 16 + lr;
        sc[t * 72 + s] = f2bf(t >= s ? acc[j] : 0.f);
      }
    }
  }
  RAW_BARRIER();
  {
    const int tr = w >> 1;
    const bf16x8 a0 = frag(sc, tr * 16, 72, 0, lane), a1 = frag(sc, tr * 16, 72, 32, lane);
#pragma unroll
    for (int tci = 0; tci < 4; ++tci) {
      const int tc = (w & 1) * 4 + tci;
      f32x4 acc = {0.f, 0.f, 0.f, 0.f};
      acc = mfma16(a0, frag(vT, tc * 16, 72, 0, lane), acc);
      acc = mfma16(a1, frag(vT, tc * 16, 72, 32, lane), acc);
      {
        float v[4] = {acc[0], acc[1], acc[2], acc[3]};
        quad_transpose(v, lane);
        store4_bf16(O0 + ((size_t)idx * 64 + tr * 16 + lq * 4 + (lane & 3)) * 128 + tc * 16 + (lr & 12), v);
      }
    }
  }
  {
    const int tr = w;
    const bf16x8 a0 = frag(ktT, tr * 16, 72, 0, lane), a1 = frag(ktT, tr * 16, 72, 32, lane);
#pragma unroll
    for (int tc = 0; tc < 8; ++tc) {
      f32x4 acc = {0.f, 0.f, 0.f, 0.f};
      acc = mfma16(a0, frag(vT, tc * 16, 72, 0, lane), acc);
      acc = mfma16(a1, frag(vT, tc * 16, 72, 32, lane), acc);
      {
        float v[4] = {acc[0], acc[1], acc[2], acc[3]};
        quad_transpose(v, lane);
        store4_bf16(NB + ((size_t)idx * 128 + tr * 16 + lq * 4 + (lane & 3)) * 128 + tc * 16 + (lr & 12), v);
      }
    }
  }
  RAW_BARRIER();
}

template <int J>
struct SolveCol {
  static __device__ __forceinline__ void run(f32x4 (&x)[16], const f32x4 (&a)[16], const float* AT) {
    if constexpr (J < 63) {
      f32x4 an[16];
      if constexpr (J + 1 < 63) {
#pragma unroll
        for (int B = (J + 2) / 4; B < 16; ++B) an[B] = *(const f32x4*)(AT + (J + 1) * 64 + B * 4);
      }
      __builtin_amdgcn_sched_barrier(0);
      const float xj = x[J / 4][J % 4];
#pragma unroll
      for (int B = (J + 1) / 4; B < 16; ++B) x[B] -= a[B] * xj;
      __builtin_amdgcn_sched_barrier(0);
      SolveCol<J + 1>::run(x, an, AT);
    }
  }
};

__device__ void gdn_item(const Params& p, char* smem, int idx) {
  const int tid = opaque_tid(), lane = tid & 63, w = tid >> 6;
  const int lr = lane & 15, lq = lane >> 4;
  const int h = idx & 3, c = (idx >> 2) & 31, b = idx >> 7;
  const int r0 = b * 2048 + c * 64;
  const u16* PQ = (const u16*)(p.ws + W_PQ);
  const float* BETA = (const float*)(p.ws + W_BETA);
  const float* GDEC = (const float*)(p.ws + W_GDEC);
  u16* QS = (u16*)(p.ws + W_QS);
  u16* O0 = (u16*)(p.ws + W_H);
  u16* NB = (u16*)(p.out);
  u16* MNEG = (u16*)(p.ws + W_MNEG);
  float* DSC = (float*)(p.ws + W_DSC);
  u16* kb = (u16*)smem;
  u16* qb = kb + 64 * 136;
  u16* vS = qb + 64 * 136;
  float* Asol = (float*)(vS + 64 * 128);
  u16* attn = (u16*)(Asol + 64 * 64);
  u16* khT = attn + 64 * 72;
  u16* WT = khT + 128 * 72;
  u16* U0T = WT + 128 * 72;
  float* gc = (float*)(U0T + 128 * 72);
  float* bet = gc + 64;

  if (w == 0) {
    float g = GDEC[(size_t)(r0 + lane) * 4 + h];
#pragma unroll
    for (int o = 1; o < 64; o <<= 1) { float t = __shfl_up(g, o, 64); if (lane >= o) g += t; }
    gc[lane] = g;
    bet[lane] = BETA[(size_t)(r0 + lane) * 4 + h];
  }
  for (int rep_ = 0; rep_ < ((PROBE_G & 1) ? 2 : 1); ++rep_)
  {
    const int chq = 1024 + h * 128 + 2 * lane;
    const int cwq = h * 128 + 2 * lane;
    float cw[3][4][2];
#pragma unroll
    for (int ty = 0; ty < 3; ++ty)
#pragma unroll
      for (int j = 0; j < 4; ++j) {
        float2 t2 = *(const float2*)(p.conv_w + j * 1536 + ty * 512 + cwq);
        cw[ty][j][0] = t2.x; cw[ty][j][1] = t2.y;
      }
    float win[3][3][2];
    const int t0 = w * 8;
#pragma unroll
    for (int a = 0; a < 3; ++a) {
      const int rr = t0 - 3 + a;
      const bool valid = (c > 0) || (rr >= 0);
#pragma unroll
      for (int ty = 0; ty < 3; ++ty) {
        unsigned u = 0;
        if (valid) u = *(const unsigned*)(PQ + (ptrdiff_t)(r0 + rr) * PQW + chq + ty * 512);
        win[ty][a][0] = bf2f((u16)(u & 0xffff)); win[ty][a][1] = bf2f((u16)(u >> 16));
      }
    }
#pragma unroll
    for (int tt = 0; tt < 8; ++tt) {
      const int t = t0 + tt;
      float cv[3][2];
#pragma unroll
      for (int ty = 0; ty < 3; ++ty) {
        unsigned u = *(const unsigned*)(PQ + (size_t)(r0 + t) * PQW + chq + ty * 512);
        float c0 = bf2f((u16)(u & 0xffff)), c1 = bf2f((u16)(u >> 16));
        float s0 = cw[ty][0][0] * win[ty][0][0] + cw[ty][1][0] * win[ty][1][0] + cw[ty][2][0] * win[ty][2][0] + cw[ty][3][0] * c0;
        float s1 = cw[ty][0][1] * win[ty][0][1] + cw[ty][1][1] * win[ty][1][1] + cw[ty][2][1] * win[ty][2][1] + cw[ty][3][1] * c1;
        win[ty][0][0] = win[ty][1][0]; win[ty][0][1] = win[ty][1][1];
        win[ty][1][0] = win[ty][2][0]; win[ty][1][1] = win[ty][2][1];
        win[ty][2][0] = c0; win[ty][2][1] = c1;
        cv[ty][0] = siluf_(s0); cv[ty][1] = siluf_(s1);
      }
      float ssq = wave_sum(cv[0][0] * cv[0][0] + cv[0][1] * cv[0][1]);
      float ssk = wave_sum(cv[1][0] * cv[1][0] + cv[1][1] * cv[1][1]);
      const float rq = rsqrtf(ssq + EPS) * 0.08838834764831845f;
      const float rk = rsqrtf(ssk + EPS);
      *(unsigned*)(qb + t * 136 + 2 * lane) = pack2(cv[0][0] * rq, cv[0][1] * rq);
      *(unsigned*)(kb + t * 136 + 2 * lane) = pack2(cv[1][0] * rk, cv[1][1] * rk);
      *(unsigned*)(vS + t * 128 + 2 * lane) = pack2(cv[2][0], cv[2][1]);
    }
  }
  RAW_BARRIER();
  {
    const int which = w >> 2, tr = w & 3;
    const u16* Asrc = which ? qb : kb;
    bf16x8 a[4];
#pragma unroll
    for (int ks = 0; ks < 4; ++ks) a[ks] = frag(Asrc, tr * 16, 136, ks * 32, lane);
#pragma unroll
    for (int tc = 0; tc < 4; ++tc) {
      f32x4 acc = {0.f, 0.f, 0.f, 0.f};
#pragma unroll
      for (int ks = 0; ks < 4; ++ks) acc = mfma16(a[ks], frag(kb, tc * 16, 136, ks * 32, lane), acc);
#pragma unroll
      for (int j = 0; j < 4; ++j) {
        const int t = tr * 16 + lq * 4 + j, s = tc * 16 + lr;
        const float L = __expf(fminf(gc[t] - gc[s], 0.f));
        if (which == 0) Asol[s * 64 + t] = (t > s) ? bet[t] * acc[j] * L : 0.f;
        else attn[t * 72 + s] = f2bf((t >= s) ? acc[j] * L : 0.f);
      }
    }
  }
  RAW_BARRIER();
  for (int rep_ = 0; rep_ < ((PROBE_G & 2) ? 2 : 1); ++rep_) {
  if (tid < 256) {
    f32x4 x[16];
    if (tid < 128) {
#pragma unroll
      for (int s = 0; s < 64; ++s) { x[s >> 2][s & 3] = bf2f(vS[s * 128 + tid]) * bet[s]; if ((s & 7) == 7) __builtin_amdgcn_sched_barrier(0); }
    } else {
#pragma unroll
      for (int s = 0; s < 64; ++s) { x[s >> 2][s & 3] = bf2f(kb[s * 136 + tid - 128]) * bet[s] * __expf(gc[s]); if ((s & 7) == 7) __builtin_amdgcn_sched_barrier(0); }
    }
    {
      f32x4 a0[16];
#pragma unroll
      for (int B = 0; B < 16; ++B) a0[B] = *(const f32x4*)(Asol + B * 4);
      SolveCol<0>::run(x, a0, Asol);
    }
    u16* dst = (tid < 128) ? (U0T + tid * 72) : (WT + (tid - 128) * 72);
#pragma unroll
    for (int s8 = 0; s8 < 8; ++s8) {
      *(u32x4*)(dst + s8 * 8) = u32x4{pack2(x[2 * s8][0], x[2 * s8][1]), pack2(x[2 * s8][2], x[2 * s8][3]),
                                      pack2(x[2 * s8 + 1][0], x[2 * s8 + 1][1]), pack2(x[2 * s8 + 1][2], x[2 * s8 + 1][3])};
    }
  } else {
    const float glast = gc[63];
    const int e0 = tid - 256;
#pragma unroll 4
    for (int i = 0; i < 32; ++i) {
      const int e = e0 + 256 * i;
      const int s = e & 63, kd = e >> 6;
      khT[kd * 72 + s] = f2bf(bf2f(kb[s * 136 + kd]) * __expf(glast - gc[s]));
    }
  }
  RAW_BARRIER();
  }
  for (int rep_ = 0; rep_ < ((PROBE_G & 4) ? 2 : 1); ++rep_) {
  {
    const int tr = w & 3, half = w >> 2;
    const u16* Bsrc = half ? U0T : WT;
    const bf16x8 a0 = frag(attn, tr * 16, 72, 0, lane), a1 = frag(attn, tr * 16, 72, 32, lane);
#pragma unroll 2
    for (int tc = 0; tc < 8; ++tc) {
      f32x4 acc = {0.f, 0.f, 0.f, 0.f};
      acc = mfma16(a0, frag(Bsrc, tc * 16, 72, 0, lane), acc);
      acc = mfma16(a1, frag(Bsrc, tc * 16, 72, 32, lane), acc);
      {
        float v[4];
#pragma unroll
        for (int j = 0; j < 4; ++j) {
          const int t = tr * 16 + lq * 4 + j, n = tc * 16 + lr;
          v[j] = half == 0 ? bf2f(qb[t * 136 + n]) * __expf(gc[t]) - acc[j] : acc[j];
        }
        quad_transpose(v, lane);
        const size_t o = ((size_t)(1024 + idx) * 64 + tr * 16 + lq * 4 + (lane & 3)) * 128 + tc * 16 + (lr & 12);
        store4_bf16((half == 0 ? QS : O0) + o, v);
      }
    }
  }
  {
    const int tr = w;
    const bf16x8 a0 = frag(khT, tr * 16, 72, 0, lane), a1 = frag(khT, tr * 16, 72, 32, lane);
#pragma unroll 2
    for (int tc = 0; tc < 16; ++tc) {
      const u16* Bsrc = tc < 8 ? WT : U0T;
      const int tcc = tc & 7;
      f32x4 acc = {0.f, 0.f, 0.f, 0.f};
      acc = mfma16(a0, frag(Bsrc, tcc * 16, 72, 0, lane), acc);
      acc = mfma16(a1, frag(Bsrc, tcc * 16, 72, 32, lane), acc);
      {
        float v[4];
#pragma unroll
        for (int j = 0; j < 4; ++j) v[j] = tc < 8 ? -acc[j] : acc[j];
        quad_transpose(v, lane);
        const size_t o = (size_t)(tr * 16 + lq * 4 + (lane & 3)) * 128 + tcc * 16 + (lr & 12);
        store4_bf16((tc < 8 ? MNEG + (size_t)idx * 16384 : NB + (size_t)(1024 + idx) * 16384) + o, v);
      }
    }
  }
  }
  if (tid < 128) ((float*)(p.ws + W_DVEC))[(size_t)(1024 + idx) * 128 + tid] = __expf(gc[63]);
  RAW_BARRIER();
}

__device__ void phase2(const Params& p, char* smem, int bid, int nb) {
  for (int it = bid; it < 2048; it += nb) {
    if (it >= 1024) { gdn_item(p, smem, it - 1024); if (DUP_MASK & 2048) gdn_item(p, smem, it - 1024); }
    else { hgrn_item(p, smem, it); if (DUP_MASK & 1024) hgrn_item(p, smem, it); }
  }
}

struct ScanRegs {
  bf16x8 Aq[4];
  bf16x8 Am[4];
  u32x2 o0, nn0, nn1;
  f32x4 dd;
};

template <int TYPE>
__device__ __forceinline__ void scan_load(ScanRegs& r, const Params& p, int idx, unsigned qoff, unsigned ooff, unsigned moff,
                                          unsigned noff, unsigned doff) {
  const int ii = __builtin_amdgcn_readfirstlane(idx);
  const int ti = TYPE * 1024 + ii;
  const u16* QSb = (const u16*)(p.ws + W_QS) + (size_t)ti * 8192;
  const u16* O0b = (const u16*)(p.ws + W_H) + (size_t)ti * 8192;
  const u16* NBb = (const u16*)(p.out) + (size_t)ti * 16384;
#pragma unroll
  for (int ks = 0; ks < 4; ++ks) r.Aq[ks] = *(const bf16x8*)(QSb + (qoff + ks * 32));
  r.o0 = *(const u32x2*)(O0b + ooff);
  r.nn0 = *(const u32x2*)(NBb + noff);
  r.nn1 = *(const u32x2*)(NBb + (noff + 16));
  if (TYPE == 1) {
    const u16* Mb = (const u16*)(p.ws + W_MNEG) + (size_t)ii * 16384;
#pragma unroll
    for (int ks = 0; ks < 4; ++ks) r.Am[ks] = *(const bf16x8*)(Mb + (moff + ks * 32));
  }
  r.dd = *(const f32x4*)((const float*)(p.ws + W_DVEC) + (size_t)ti * 128 + doff);
}
__device__ __forceinline__ void unpack4(u32x2 u, float (&v)[4]) {
  v[0] = bf2f((u16)(u[0] & 0xffff)); v[1] = bf2f((u16)(u[0] >> 16));
  v[2] = bf2f((u16)(u[1] & 0xffff)); v[3] = bf2f((u16)(u[1] >> 16));
}

template <int TYPE>
__device__ void scan_unit(const Params& p, char* smem, int rem) {
  const int tid = opaque_tid(), lane = tid & 63, w = tid >> 6;
  const int lr = lane & 15, lq = lane >> 4;
  const int b = rem >> 4, h = (rem >> 2) & 3, vs2 = rem & 3;
  const int tr = lq * 4 + (lane & 3), tc4 = lr & 12;
  const int otr = w & 3, otc = w >> 2;
  float* OPRE = (float*)(p.ws + W_PQ);
  u16* SbT = (u16*)smem;
  for (int i = tid; i < 2 * 32 * 136; i += 512) SbT[i] = 0;
  f32x4 S0 = {0.f, 0.f, 0.f, 0.f}, S1 = {0.f, 0.f, 0.f, 0.f};
  const unsigned qoff = (unsigned)((otr * 16 + lr) * 128 + lq * 8);
  const unsigned ooff = (unsigned)((otr * 16 + tr) * 128 + vs2 * 32 + otc * 16 + tc4);
  const unsigned moff = (unsigned)((w * 16 + lr) * 128 + lq * 8);
  const unsigned noff = (unsigned)((w * 16 + tr) * 128 + vs2 * 32 + tc4);
  const unsigned doff = (unsigned)(w * 16 + lq * 4);
  float* const orow = OPRE + (size_t)(b * 2048 + otr * 16 + tr) * 1024 + TYPE * 512 + h * 128 + vs2 * 32 + otc * 16 + tc4;
  ScanRegs r0, r1, r2, r3;
  const int idx0 = (b * 32) * 4 + h;
  scan_load<TYPE>(r0, p, idx0 + 0, qoff, ooff, moff, noff, doff);
  scan_load<TYPE>(r1, p, idx0 + 4, qoff, ooff, moff, noff, doff);
  scan_load<TYPE>(r2, p, idx0 + 8, qoff, ooff, moff, noff, doff);
  scan_load<TYPE>(r3, p, idx0 + 12, qoff, ooff, moff, noff, doff);
  __builtin_amdgcn_sched_barrier(0);
#define SCAN_STEP(R, c) { \
    RAW_BARRIER(); \
    const u16* Sb = SbT + ((c) & 1) * 32 * 136 + lr * 136 + lq * 8; \
    bf16x8 B0[4], B1[4], Bo[4]; \
    _Pragma("unroll") for (int ks = 0; ks < 4; ++ks) { \
      B0[ks] = *(const bf16x8*)(Sb + ks * 32); \
      B1[ks] = *(const bf16x8*)(Sb + 16 * 136 + ks * 32); \
      Bo[ks] = *(const bf16x8*)(Sb + otc * 16 * 136 + ks * 32); } \
    { \
      float ov[4]; unpack4(R.o0, ov); quad_transpose(ov, lane); \
      f32x4 acc = {ov[0], ov[1], ov[2], ov[3]}; \
      _Pragma("unroll") for (int ks = 0; ks < 4; ++ks) acc = mfma16(R.Aq[ks], Bo[ks], acc); \
      float o[4] = {acc[0], acc[1], acc[2], acc[3]}; \
      quad_transpose(o, lane); \
      *(f32x4*)(orow + (size_t)(c) * 65536) = f32x4{o[0], o[1], o[2], o[3]}; \
    } \
    float n0[4], n1[4]; unpack4(R.nn0, n0); unpack4(R.nn1, n1); \
    quad_transpose(n0, lane); quad_transpose(n1, lane); \
    f32x4 T0, T1; \
    _Pragma("unroll") for (int j = 0; j < 4; ++j) { T0[j] = R.dd[j] * S0[j] + n0[j]; T1[j] = R.dd[j] * S1[j] + n1[j]; } \
    if (TYPE == 1) { _Pragma("unroll") for (int ks = 0; ks < 4; ++ks) { T0 = mfma16(R.Am[ks], B0[ks], T0); T1 = mfma16(R.Am[ks], B1[ks], T1); } } \
    S0 = T0; S1 = T1; \
    u16* Sw = SbT + (((c) + 1) & 1) * 32 * 136 + lr * 136 + w * 16 + lq * 4; \
    *(u32x2*)(Sw) = u32x2{pack2(S0[0], S0[1]), pack2(S0[2], S0[3])}; \
    *(u32x2*)(Sw + 16 * 136) = u32x2{pack2(S1[0], S1[1]), pack2(S1[2], S1[3])}; \
    __builtin_amdgcn_sched_barrier(0); \
    scan_load<TYPE>(R, p, idx0 + (((c) + 4 < 32) ? (c) + 4 : 31) * 4, qoff, ooff, moff, noff, doff); \
    __builtin_amdgcn_sched_barrier(0); \
  }
  for (int c0 = 0; c0 < 32; c0 += 4) {
    SCAN_STEP(r0, c0)
    SCAN_STEP(r1, c0 + 1)
    SCAN_STEP(r2, c0 + 2)
    SCAN_STEP(r3, c0 + 3)
  }
#undef SCAN_STEP
  float* so = p.out + (TYPE ? O_GDP : O_HGP) + (size_t)(b * 4 + h) * 16384 + (w * 16 + tr) * 128 + vs2 * 32 + tc4;
  {
    float sv[4] = {S0[0], S0[1], S0[2], S0[3]};
    quad_transpose(sv, lane);
    *(f32x4*)(so) = f32x4{sv[0], sv[1], sv[2], sv[3]};
    float sw[4] = {S1[0], S1[1], S1[2], S1[3]};
    quad_transpose(sw, lane);
    *(f32x4*)(so + 16) = f32x4{sw[0], sw[1], sw[2], sw[3]};
  }
  __syncthreads();
}

__device__ void sample_item(const Params& p, char* smem, int it) {
  const int tid = opaque_tid(), lane = tid & 63, w = tid >> 6;
  const int type = it >> 9, b = (it >> 2) & 127, h = it & 3;
  const int row = MP + b;
  const u16* PQ = (const u16*)(p.ws + W_PQ);
  const float* LF = (const float*)(p.ws + W_LF);
  const float* BETA = (const float*)(p.ws + W_BETA);
  const float* GDEC = (const float*)(p.ws + W_GDEC);
  float* OPRE = (float*)(p.ws + W_PQ);
  float* fq = (float*)smem;
  float* fk = fq + 128;
  float* fv = fk + 128;
  float* fe = fv + 128;
  float* red = fe + 128;
  float* sc = red + 1024;
  const int n = tid & 127, kp = tid >> 7;
  if (type == 0) {
    if (tid < 128) {
      const float lf = LF[(size_t)row * 512 + h * 128 + tid];
      const float f = __expf(lf);
      fe[tid] = f;
      fk[tid] = 1.f - f;
      fq[tid] = bf2f(PQ[(size_t)row * PQW + h * 128 + tid]);
      fv[tid] = bf2f(PQ[(size_t)row * PQW + 512 + h * 128 + tid]);
    }
    __syncthreads();
    const float* S = p.state_hgrn + ((size_t)(b * 4 + h) * 128) * 128;
    float* So = p.out + O_HGS + ((size_t)(b * 4 + h) * 128) * 128;
    const float vn = fv[n];
    float o = 0.f;
#pragma unroll
    for (int i = 0; i < 32; ++i) {
      const int k = kp * 32 + i;
      const float sn = fe[k] * S[k * 128 + n] + fk[k] * vn;
      So[k * 128 + n] = sn;
      o += fq[k] * sn;
    }
    red[kp * 128 + n] = o;
    __syncthreads();
    if (tid < 128) OPRE[(size_t)row * 1024 + h * 128 + tid] = red[tid] + red[128 + tid] + red[256 + tid] + red[384 + tid];
    __syncthreads();
  } else {
    const float* cprev = p.state_conv + (size_t)b * 3 * 1536;
    if (tid < 384) {
      const int ty = tid >> 7, cc = tid & 127;
      const int ch = ty * 512 + h * 128 + cc;
      const float p0 = cprev[ch], p1 = cprev[1536 + ch], p2 = cprev[3072 + ch];
      const float nw = bf2f(PQ[(size_t)row * PQW + 1024 + ch]);
      const float s = p.conv_w[ch] * p0 + p.conv_w[1536 + ch] * p1 + p.conv_w[3072 + ch] * p2 + p.conv_w[4608 + ch] * nw;
      fq[ty * 128 + cc] = siluf_(s);
      p.out[O_CVS + (size_t)(b * 3 + 0) * 1536 + ch] = p1;
      p.out[O_CVS + (size_t)(b * 3 + 1) * 1536 + ch] = p2;
    }
    __syncthreads();
    if (w < 2) {
      const float a0 = fq[w * 128 + lane], a1 = fq[w * 128 + 64 + lane];
      const float ss = wave_sum(a0 * a0 + a1 * a1);
      if (lane == 0) sc[w] = ss;
    }
    __syncthreads();
    const float rq = rsqrtf(sc[0] + EPS) * 0.08838834764831845f;
    const float rk = rsqrtf(sc[1] + EPS);
    __syncthreads();
    if (tid < 128) fq[tid] *= rq;
    else if (tid < 256) fk[tid - 128] *= rk;
    __syncthreads();
    if (w == 0) {
      const float qk = wave_sum(fq[lane] * fk[lane] + fq[64 + lane] * fk[64 + lane]);
      if (lane == 0) sc[2] = qk;
    }
    const float eg = __expf(GDEC[(size_t)row * 4 + h]);
    const float beta = BETA[(size_t)row * 4 + h];
    const float* S = p.state_gdn + ((size_t)(b * 4 + h) * 128) * 128;
    float* So = p.out + O_GDS + ((size_t)(b * 4 + h) * 128) * 128;
    float sd[32];
    float ks_ = 0.f, qs_ = 0.f;
#pragma unroll
    for (int i = 0; i < 32; ++i) {
      const int k = kp * 32 + i;
      sd[i] = eg * S[k * 128 + n];
      ks_ += fk[k] * sd[i];
      qs_ += fq[k] * sd[i];
    }
    red[kp * 128 + n] = ks_;
    red[512 + kp * 128 + n] = qs_;
    __syncthreads();
    const float kS = red[n] + red[128 + n] + red[256 + n] + red[384 + n];
    const float delta = (fv[n] - kS) * beta;
#pragma unroll
    for (int i = 0; i < 32; ++i) {
      const int k = kp * 32 + i;
      So[k * 128 + n] = sd[i] + fk[k] * delta;
    }
    if (tid < 128) {
      const float qS = red[512 + n] + red[640 + n] + red[768 + n] + red[896 + n];
      OPRE[(size_t)row * 1024 + 512 + h * 128 + n] = qS + sc[2] * delta;
    }
    __syncthreads();
  }
}

__device__ void sample_block4(const Params& p, char* smem, int bid) {
  const int tid = opaque_tid(), lane = tid & 63, w = tid >> 6;
  const u16* PQ = (const u16*)(p.ws + W_PQ);
  const float* LF = (const float*)(p.ws + W_LF);
  const float* BETA = (const float*)(p.ws + W_BETA);
  const float* GDEC = (const float*)(p.ws + W_GDEC);
  float* OPRE = (float*)(p.ws + W_PQ);
  float* vec = (float*)smem;
  float* red = vec + 2048;
  float* sc = red + 1024;
  if (tid < 256) {
    const int j = tid >> 7, c = tid & 127;
    const int it = bid + 256 * j, b = (it >> 2) & 127, h = it & 3, row = MP + b;
    const float f = __expf(LF[(size_t)row * 512 + h * 128 + c]);
    vec[(j * 4 + 0) * 128 + c] = bf2f(PQ[(size_t)row * PQW + h * 128 + c]);
    vec[(j * 4 + 1) * 128 + c] = 1.f - f;
    vec[(j * 4 + 2) * 128 + c] = bf2f(PQ[(size_t)row * PQW + 512 + h * 128 + c]);
    vec[(j * 4 + 3) * 128 + c] = f;
  }
  for (int e = tid; e < 768; e += 512) {
    const int j = 2 + e / 384, r = e % 384, ty = r >> 7, cc = r & 127;
    const int it = bid + 256 * j, b = (it >> 2) & 127, h = it & 3, row = MP + b;
    const int ch = ty * 512 + h * 128 + cc;
    const float* cprev = p.state_conv + (size_t)b * 3 * 1536;
    const float p0 = cprev[ch], p1 = cprev[1536 + ch], p2 = cprev[3072 + ch];
    const float nw = bf2f(PQ[(size_t)row * PQW + 1024 + ch]);
    const float s = p.conv_w[ch] * p0 + p.conv_w[1536 + ch] * p1 + p.conv_w[3072 + ch] * p2 + p.conv_w[4608 + ch] * nw;
    vec[(j * 4 + ty) * 128 + cc] = siluf_(s);
    p.out[O_CVS + (size_t)(b * 3 + 0) * 1536 + ch] = p1;
    p.out[O_CVS + (size_t)(b * 3 + 1) * 1536 + ch] = p2;
  }
  __syncthreads();
  if (w < 4) {
    const int j = 2 + (w >> 1), which = w & 1;
    const float a0 = vec[(j * 4 + which) * 128 + lane], a1 = vec[(j * 4 + which) * 128 + 64 + lane];
    const float ss = wave_sum(a0 * a0 + a1 * a1);
    if (lane == 0) sc[j * 4 + which] = ss;
  }
  __syncthreads();
  {
    const int j = 2 + (tid >> 8), which = (tid >> 7) & 1, c = tid & 127;
    const float r = which == 0 ? rsqrtf(sc[j * 4 + 0] + EPS) * 0.08838834764831845f : rsqrtf(sc[j * 4 + 1] + EPS);
    vec[(j * 4 + which) * 128 + c] *= r;
  }
  __syncthreads();
  if (w < 2) {
    const int j = 2 + w;
    const float qk = wave_sum(vec[(j * 4 + 0) * 128 + lane] * vec[(j * 4 + 1) * 128 + lane] +
                              vec[(j * 4 + 0) * 128 + 64 + lane] * vec[(j * 4 + 1) * 128 + 64 + lane]);
    if (lane == 0) sc[j * 4 + 2] = qk;
  }
  __syncthreads();
  const int n = tid & 127, kp = tid >> 7;
  float cur[32], nxt[32];
  {
    const int it = bid, b = (it >> 2) & 127, h = it & 3;
    const float* S = p.state_hgrn + ((size_t)(b * 4 + h) * 128) * 128;
#pragma unroll
    for (int i = 0; i < 32; ++i) cur[i] = S[(kp * 32 + i) * 128 + n];
  }
#pragma unroll
  for (int j = 0; j < 4; ++j) {
    const int it = bid + 256 * j, b = (it >> 2) & 127, h = it & 3, row = MP + b;
    if (j < 3) {
      const int it2 = bid + 256 * (j + 1), b2 = (it2 >> 2) & 127, h2 = it2 & 3;
      const float* S2 = ((j + 1) < 2 ? p.state_hgrn : p.state_gdn) + ((size_t)(b2 * 4 + h2) * 128) * 128;
#pragma unroll
      for (int i = 0; i < 32; ++i) nxt[i] = S2[(kp * 32 + i) * 128 + n];
    }
    const float* fq = vec + (j * 4 + 0) * 128;
    const float* fk = vec + (j * 4 + 1) * 128;
    const float* fv = vec + (j * 4 + 2) * 128;
    const float* fe = vec + (j * 4 + 3) * 128;
    if (j < 2) {
      float* So = p.out + O_HGS + ((size_t)(b * 4 + h) * 128) * 128;
      const float vn = fv[n];
      float o = 0.f;
#pragma unroll
      for (int i = 0; i < 32; ++i) {
        const int k = kp * 32 + i;
        const float sn = fe[k] * cur[i] + fk[k] * vn;
        So[k * 128 + n] = sn;
        o += fq[k] * sn;
      }
      red[kp * 128 + n] = o;
      __syncthreads();
      if (tid < 128) OPRE[(size_t)row * 1024 + h * 128 + tid] = red[tid] + red[128 + tid] + red[256 + tid] + red[384 + tid];
      __syncthreads();
    } else {
      float* So = p.out + O_GDS + ((size_t)(b * 4 + h) * 128) * 128;
      const float eg = __expf(GDEC[(size_t)row * 4 + h]);
      const float beta = BETA[(size_t)row * 4 + h];
      float ks_ = 0.f, qs_ = 0.f;
#pragma unroll
      for (int i = 0; i < 32; ++i) {
        const int k = kp * 32 + i;
        cur[i] *= eg;
        ks_ += fk[k] * cur[i];
        qs_ += fq[k] * cur[i];
      }
      red[kp * 128 + n] = ks_;
      red[512 + kp * 128 + n] = qs_;
      __syncthreads();
      const float kS = red[n] + red[128 + n] + red[256 + n] + red[384 + n];
      const float delta = (fv[n] - kS) * beta;
#pragma unroll
      for (int i = 0; i < 32; ++i) {
        const int k = kp * 32 + i;
        So[k * 128 + n] = cur[i] + fk[k] * delta;
      }
      if (tid < 128) {
        const float qS = red[512 + n] + red[640 + n] + red[768 + n] + red[896 + n];
        OPRE[(size_t)row * 1024 + 512 + h * 128 + n] = qS + sc[j * 4 + 2] * delta;
      }
      __syncthreads();
    }
#pragma unroll
    for (int i = 0; i < 32; ++i) cur[i] = nxt[i];
  }
}

__device__ void phase3(const Params& p, char* smem, int bid, int nb) {
  for (int u = bid; u < 256; u += nb) {
    int uu = u;
    if (nb == 256) {
      const int xcd = u & 7, j = u >> 3;
      uu = ((xcd * 8 + (j >> 2)) << 2) | (j & 3);
    }
    if (uu < 128) scan_unit<0>(p, smem, uu); else scan_unit<1>(p, smem, uu - 128);
    if (DUP_MASK & 256) { if (uu < 128) scan_unit<0>(p, smem, uu); else scan_unit<1>(p, smem, uu - 128); }
  }
  if (nb == 256) {
    if ((bid & 7) < 4) {
      const int rank = (bid >> 3) * 4 + (bid & 3);
      sample_block4(p, smem, rank);
      sample_block4(p, smem, rank + 128);
    }
  } else {
    for (int it = bid; it < 1024; it += nb) sample_item(p, smem, it);
  }
}

__device__ void phase4(const Params& p, int bid, int nb) {
  const int tid = opaque_tid(), lane = tid & 63, w = tid >> 6;
  const float* OPRE = (const float*)(p.ws + W_PQ);
  const u16* GATES = (const u16*)(p.ws + W_GATES);
  u16* A2 = (u16*)(p.ws + W_QS);
  constexpr int NG = MT / 8;
  for (int g = bid; g < NG; g += 2 * nb) {
    const bool two = (g + nb) < NG;
    const int rows[2] = {g * 8 + w, (two ? g + nb : g) * 8 + w};
    f32x4 v[2][4];
    u32x2 gt[2][4];
#pragma unroll
    for (int r = 0; r < 2; ++r)
#pragma unroll
      for (int i = 0; i < 4; ++i) {
        const int col = i * 256 + lane * 4;
        v[r][i] = *(const f32x4*)(OPRE + (size_t)rows[r] * 1024 + col);
        gt[r][i] = *(const u32x2*)(GATES + (size_t)rows[r] * 1024 + col);
      }
#pragma unroll
    for (int r = 0; r < 2; ++r) {
      if (r == 1 && !two) break;
#pragma unroll
      for (int i = 0; i < 4; ++i) {
        const int col = i * 256 + lane * 4;
        float ss = v[r][i][0] * v[r][i][0] + v[r][i][1] * v[r][i][1] + v[r][i][2] * v[r][i][2] + v[r][i][3] * v[r][i][3];
        ss += dpp_mov<0xB1, 0xf>(ss);
        ss += dpp_mov<0x4E, 0xf>(ss);
        ss += dpp_mov<0x141, 0xf>(ss);
        ss += dpp_mov<0x140, 0xf>(ss);
        ss += __shfl_xor(ss, 16, 64);
        const float rstd = rsqrtf(ss * (1.f / 128.f) + EPS);
        const f32x4 nw = *(const f32x4*)((col < 512 ? p.hg_norm : p.gdn_norm) + (col & 127));
        float gg[4];
        unpack4(gt[r][i], gg);
        *(u32x2*)(A2 + (size_t)rows[r] * LDK + col) =
            u32x2{pack2(v[r][i][0] * rstd * nw[0] * gg[0], v[r][i][1] * rstd * nw[1] * gg[1]),
                  pack2(v[r][i][2] * rstd * nw[2] * gg[2], v[r][i][3] * rstd * nw[3] * gg[3])};
      }
    }
  }
}

__device__ void phase6(const Params& p, int bid, int nb) {
  const int tid = opaque_tid(), lane = tid & 63, w = tid >> 6;
  constexpr int NG = MT / 8, NR = 4;
  for (int g = bid; g < NG; g += NR * nb) {
    float* y[NR];
    bool ok[NR];
    float4 xv[NR][4];
    float ss[NR];
#pragma unroll
    for (int r = 0; r < NR; ++r) {
      ok[r] = (g + r * nb) < NG;
      const int row = (ok[r] ? g + r * nb : g) * 8 + w;
      y[r] = row < MP ? p.out + O_YP + (size_t)row * 1024 : p.out + O_YS + (size_t)(row - MP) * 1024;
#pragma unroll
      for (int i = 0; i < 4; ++i) xv[r][i] = *(const float4*)(y[r] + i * 256 + lane * 4);
    }
#pragma unroll
    for (int r = 0; r < NR; ++r) {
      ss[r] = 0.f;
#pragma unroll
      for (int i = 0; i < 4; ++i) ss[r] += xv[r][i].x * xv[r][i].x + xv[r][i].y * xv[r][i].y + xv[r][i].z * xv[r][i].z + xv[r][i].w * xv[r][i].w;
      ss[r] = wave_sum(ss[r]);
    }
#pragma unroll
    for (int r = 0; r < NR; ++r) {
      if (ok[r]) {
        const float rstd = rsqrtf(ss[r] * (1.f / 1024.f) + EPS);
#pragma unroll
        for (int i = 0; i < 4; ++i) {
          const float4 nw = *(const float4*)(p.final_norm + i * 256 + lane * 4);
          float4 o;
          o.x = xv[r][i].x * rstd * nw.x; o.y = xv[r][i].y * rstd * nw.y; o.z = xv[r][i].z * rstd * nw.z; o.w = xv[r][i].w * rstd * nw.w;
          *(float4*)(y[r] + i * 256 + lane * 4) = o;
        }
      }
    }
  }
}


#define XB_TMO      128
#define XB_XCNT(j)  (256  + 64 * (j))
#define XB_XSUB(j)  (1280 + 64 * (j))
#define XB_XGEN(j)  (2304 + 64 * (j))
#define XB_TOP      3328
#define XB_TOPGEN   3392
#define XCD_BAR_WORDS 3456
#define XB_SPIN_CAP (1u << 18)
#define LAS __attribute__((address_space(3)))
__device__ __forceinline__ unsigned xb_ld(unsigned* p)              { return __hip_atomic_load(p, __ATOMIC_RELAXED, __HIP_MEMORY_SCOPE_AGENT); }
__device__ __forceinline__ unsigned xb_add(unsigned* p, unsigned v) { return __hip_atomic_fetch_add(p, v, __ATOMIC_RELAXED, __HIP_MEMORY_SCOPE_AGENT); }
__device__ __forceinline__ unsigned xb_xcc_id() { return (unsigned)__builtin_amdgcn_s_getreg((3 << 11) | 20) & 0xFu; }
#define XB_SPIN(cond, bar) do { unsigned _sp = 0; while (cond) { __builtin_amdgcn_s_sleep(1); \
    if ((++_sp & 255u) == 0u) { if (xb_ld(&(bar)[XB_TMO])) break; if (_sp > XB_SPIN_CAP) { atomicAdd(&(bar)[XB_TMO], 1u); break; } } } } while (0)
struct XcdBarrier { unsigned* bar; unsigned x; volatile LAS unsigned* st; };
__device__ __forceinline__ XcdBarrier xcd_barrier_post(unsigned* bar, volatile LAS unsigned* st) {
  XcdBarrier b; b.bar = bar; b.x = xb_xcc_id(); b.st = st;
  if (threadIdx.x == 0) (void)xb_add(&bar[XB_XCNT(b.x)], 1u);
  return b;
}
__device__ __forceinline__ void xcd_barrier_complete(unsigned* bar, unsigned x, unsigned& nloc, unsigned& nx) {
  const unsigned G = gridDim.x * gridDim.y * gridDim.z;
  unsigned sum, cnt, mine, sp = 0u;
  for (;;) {
    sum = 0u; cnt = 0u; mine = 0u;
#pragma unroll
    for (unsigned j = 0; j < 16; ++j) { const unsigned c = xb_ld(&bar[XB_XCNT(j)]); sum += c; cnt += (c > 0u) ? 1u : 0u; mine = (j == x) ? c : mine; }
    if (sum == G) break;
    __builtin_amdgcn_s_sleep(1);
    if ((++sp & 255u) == 0u) { if (xb_ld(&bar[XB_TMO])) break; if (sp > XB_SPIN_CAP) { atomicAdd(&bar[XB_TMO], 1u); break; } }
  }
  nloc = mine > 0u ? mine : 1u; nx = cnt > 0u ? cnt : 1u;
}
__device__ __forceinline__ void xcd_barrier(const XcdBarrier& b) {
  asm volatile("s_waitcnt vmcnt(0)" ::: "memory");
  __syncthreads();
  if (threadIdx.x == 0) {
    unsigned* bar = b.bar;
    __builtin_amdgcn_s_waitcnt(0);
    unsigned nloc = b.st[0], nx = b.st[1];
    if (nloc == 0u) { xcd_barrier_complete(bar, b.x, nloc, nx); b.st[0] = nloc; b.st[1] = nx; }
    const unsigned old = xb_add(&bar[XB_XSUB(b.x)], 1u);
    const unsigned gen = old / nloc;
    if (old + 1u == (gen + 1u) * nloc) {
      __builtin_amdgcn_fence(__ATOMIC_RELEASE, "agent");
      asm volatile("s_waitcnt vmcnt(0)" ::: "memory");
      const unsigned og = xb_add(&bar[XB_TOP], 1u);
      const unsigned tg = og / nx;
      if (og + 1u == (tg + 1u) * nx) xb_add(&bar[XB_TOPGEN], 1u);
      else XB_SPIN(xb_ld(&bar[XB_TOPGEN]) == tg, bar);
      __builtin_amdgcn_fence(__ATOMIC_ACQUIRE, "agent");
      xb_add(&bar[XB_XGEN(b.x)], 1u);
      asm volatile("s_waitcnt vmcnt(0)" ::: "memory");
    } else {
      XB_SPIN(xb_ld(&bar[XB_XGEN(b.x)]) == gen, bar);
      __builtin_amdgcn_fence(__ATOMIC_ACQUIRE, "agent");
      asm volatile("s_waitcnt vmcnt(0)" ::: "memory");
    }
  }
  __syncthreads();
}

template <int PH>
__device__ __forceinline__ void run_phase(const Params& p, char* smem, int bid, int nb) {
  if (PH == 0) phase0(p, smem, bid, nb);
  else if (PH == 1) gemm_phase<0>(p, (const u16*)(p.ws + W_H), (const u16*)(p.ws + W_WINT), 16, smem, bid, nb);
  else if (PH == 2) phase2(p, smem, bid, nb);
  else if (PH == 3) phase3(p, smem, bid, nb);
  else if (PH == 4) phase4(p, bid, nb);
  else if (PH == 5) gemm_phase<1>(p, (const u16*)(p.ws + W_QS), (const u16*)(p.ws + W_WOUTT), 4, smem, bid, nb);
  else phase6(p, bid, nb);
}

#if MEGA
__global__ void __launch_bounds__(NTH) mega_kernel(Params p) {
  extern __shared__ __attribute__((aligned(16))) char smem[];
  cg::grid_group grid = cg::this_grid();
  const int bid = blockIdx.x, nb = gridDim.x;
  if (p.out == nullptr) grid.sync();
  volatile LAS unsigned* st = (volatile LAS unsigned*)(unsigned)(size_t)(smem + LDS_BYTES - 16);
  if (threadIdx.x == 0) { st[0] = 0u; st[1] = 0u; }
  __syncthreads();
  const XcdBarrier xb = xcd_barrier_post((unsigned*)(p.ws + W_BAR), st);
#define GSYNC() xcd_barrier(xb)
#define RUNP(k) run_phase<k>(p, smem, bid, nb); GSYNC(); if (DUP_MASK & (1 << k)) { run_phase<k>(p, smem, bid, nb); GSYNC(); }
  RUNP(0)
  if (PROBE_SYNC) { for (int i_ = 0; i_ < PROBE_SYNC; ++i_) GSYNC(); }
  RUNP(1)
  if (PROBE_GEMM) { gemm_phase<0, PROBE_GEMM>(p, (const u16*)(p.ws + W_H), (const u16*)(p.ws + W_WINT), 16, smem, bid, nb); GSYNC(); }
  RUNP(2) RUNP(3) RUNP(4) RUNP(5)
#undef RUNP
#undef GSYNC
  run_phase<6>(p, smem, bid, nb);
}
#else
template <int PH>
__global__ void __launch_bounds__(NTH) phase_kernel(Params p) {
  extern __shared__ __attribute__((aligned(16))) char smem[];
  run_phase<PH>(p, smem, blockIdx.x, gridDim.x);
}
template <int PH>
static void launch_phase(const Params& p, int grid, hipStream_t stream) {
  hipFuncSetAttribute((const void*)phase_kernel<PH>, hipFuncAttributeMaxDynamicSharedMemorySize, (int)LDS_BYTES);
  hipLaunchKernelGGL(phase_kernel<PH>, dim3(grid), dim3(NTH), LDS_BYTES, stream, p);
}
#endif

extern "C" void kernel_launch(void* const* d_in, const int* in_sizes, int n_in, void* d_out, int out_size,
                              void* d_ws, size_t ws_size, hipStream_t stream) {
  Params p{};
  p.x_prompt = (const float*)d_in[0];
  p.x_sample = (const float*)d_in[1];
  p.state_hgrn = (const float*)d_in[2];
  p.state_gdn = (const float*)d_in[3];
  p.state_conv = (const float*)d_in[4];
  p.norm_w = (const float*)d_in[5];
  p.w_in = (const float*)d_in[6];
  p.lb_logits = (const float*)d_in[7];
  p.conv_w = (const float*)d_in[8];
  p.a_log = (const float*)d_in[9];
  p.dt_bias = (const float*)d_in[10];
  p.hg_norm = (const float*)d_in[11];
  p.gdn_norm = (const float*)d_in[12];
  p.w_out = (const float*)d_in[13];
  p.final_norm = (const float*)d_in[14];
  p.out = (float*)d_out;
  p.ws = (char*)d_ws;
  if (ws_size < W_END) { fprintf(stderr, "workspace too small: %zu < %zu\n", ws_size, (size_t)W_END); return; }
#if MEGA
  static int grid_blocks = 0;
  if (!grid_blocks) {
    int dev = 0, cus = 0, per_cu = 0;
    hipGetDevice(&dev);
    hipDeviceGetAttribute(&cus, hipDeviceAttributeMultiprocessorCount, dev);
    hipFuncSetAttribute((const void*)mega_kernel, hipFuncAttributeMaxDynamicSharedMemorySize, (int)LDS_BYTES);
    hipOccupancyMaxActiveBlocksPerMultiprocessor(&per_cu, mega_kernel, NTH, LDS_BYTES);
    if (per_cu < 1) per_cu = 1;
    grid_blocks = cus * per_cu;
  }
  (void)hipMemsetAsync((char*)d_ws + W_BAR, 0, XCD_BAR_WORDS * sizeof(unsigned), stream);
  void* args[] = {&p};
  hipError_t e = hipLaunchCooperativeKernel((void*)mega_kernel, dim3(grid_blocks), dim3(NTH), args, LDS_BYTES, stream);
  if (e != hipSuccess) fprintf(stderr, "cooperative launch failed: %s (grid %d)\n", hipGetErrorString(e), grid_blocks);
#else
  const int grid = 256;
  launch_phase<0>(p, grid, stream);
  launch_phase<1>(p, grid, stream);
  launch_phase<2>(p, grid, stream);
  launch_phase<3>(p, grid, stream);
  launch_phase<4>(p, grid, stream);
  launch_phase<5>(p, grid, stream);
  launch_phase<6>(p, grid, stream);
#endif
}
```

```cpp
#include <hip/hip_runtime.h>
#include <hip/hip_cooperative_groups.h>
#include <cstdio>
namespace cg = cooperative_groups;

#ifndef MEGA
#define MEGA 1
#define PROBE_GEMM 0
#define PROBE_SYNC 0
#define PROBE_G 0
#define DUP_MASK 0
#endif

typedef unsigned short u16;
using bf16x8 = __attribute__((ext_vector_type(8))) short;
using f32x4 = __attribute__((ext_vector_type(4))) float;
using u32x4 = __attribute__((ext_vector_type(4))) unsigned;
using u32x2 = __attribute__((ext_vector_type(2))) unsigned;

#define NTH 512
constexpr int MP = 16384, MS = 128, MT = 16512, DM = 1024, DIN = 4104, PQW = 2560;
constexpr float EPS = 1e-6f;
constexpr int LDK = 1088;
constexpr size_t LDS_BYTES = 139264;

constexpr size_t O_YP = 0, O_YS = 16777216, O_HGP = 16908288, O_GDP = 17432576, O_CVP = 17956864,
                 O_HGS = 17993728, O_GDS = 26382336, O_CVS = 34770944;
constexpr size_t W_WINT = 0;
constexpr size_t W_WOUTT = W_WINT + (size_t)4096 * LDK * 2;
constexpr size_t W_BETA = W_WOUTT + (size_t)1024 * LDK * 2;
constexpr size_t W_GDEC = W_BETA + 264192;
constexpr size_t W_DVEC = W_GDEC + 264192;
constexpr size_t W_DSC = W_DVEC + 1048576;
constexpr size_t W_PQ = W_DSC + 4096;
constexpr size_t W_GATES = W_PQ + 84541440;
constexpr size_t W_H = W_GATES + 33816576;
constexpr size_t W_QS = W_H + (size_t)MT * LDK * 2;
constexpr size_t W_MNEG = W_QS + 33554432;
constexpr size_t W_LF = W_MNEG + 33554432;
constexpr size_t W_BAR = W_LF + 33816576;
constexpr size_t W_END = W_BAR + 16384;

struct Params {
  const float *x_prompt, *x_sample, *state_hgrn, *state_gdn, *state_conv, *norm_w, *w_in, *lb_logits,
      *conv_w, *a_log, *dt_bias, *hg_norm, *gdn_norm, *w_out, *final_norm;
  float* out;
  char* ws;
};

__device__ __forceinline__ int opaque_tid() { int t = threadIdx.x; asm volatile("" : "+v"(t)); return t; }
typedef __bf16 bf16x2_t __attribute__((ext_vector_type(2)));
typedef float f32x2_t __attribute__((ext_vector_type(2)));
__device__ __forceinline__ u16 f2bf(float x) { return __builtin_bit_cast(u16, (__bf16)x); }
__device__ __forceinline__ float bf2f(u16 h) { return __uint_as_float(((unsigned)h) << 16); }
__device__ __forceinline__ unsigned pack2(float a, float b) {
  f32x2_t v = {a, b};
  return __builtin_bit_cast(unsigned, __builtin_convertvector(v, bf16x2_t));
}
template <int CTRL, int ROWMASK>
__device__ __forceinline__ float dpp_mov(float v) {
  return __builtin_bit_cast(float, __builtin_amdgcn_update_dpp(0, __builtin_bit_cast(int, v), CTRL, ROWMASK, 0xf, false));
}
__device__ __forceinline__ float wave_sum(float v) {
  v += dpp_mov<0xB1, 0xf>(v);
  v += dpp_mov<0x4E, 0xf>(v);
  v += dpp_mov<0x141, 0xf>(v);
  v += dpp_mov<0x140, 0xf>(v);
  v += dpp_mov<0x142, 0xa>(v);
  v += dpp_mov<0x143, 0xc>(v);
  return __builtin_bit_cast(float, __builtin_amdgcn_readlane(__builtin_bit_cast(int, v), 63));
}
__device__ __forceinline__ float sigmoidf_(float x) { return 1.f / (1.f + __expf(-x)); }
__device__ __forceinline__ float siluf_(float x) { return x / (1.f + __expf(-x)); }
__device__ __forceinline__ f32x4 mfma16(bf16x8 a, bf16x8 b, f32x4 c) {
  return __builtin_amdgcn_mfma_f32_16x16x32_bf16(a, b, c, 0, 0, 0);
}
__device__ __forceinline__ bf16x8 frag(const u16* base, int row0, int stride, int koff, int lane) {
  return *(const bf16x8*)(base + (row0 + (lane & 15)) * stride + koff + (lane >> 4) * 8);
}

__device__ __forceinline__ void quad_transpose(float (&v)[4], int lane) {
  {
    const bool b = lane & 1;
    float s0 = b ? v[0] : v[1], s1 = b ? v[2] : v[3];
    float r0 = dpp_mov<0xB1, 0xf>(s0), r1 = dpp_mov<0xB1, 0xf>(s1);
    if (b) { v[0] = r0; v[2] = r1; } else { v[1] = r0; v[3] = r1; }
  }
  {
    const bool b = lane & 2;
    float s0 = b ? v[0] : v[2], s1 = b ? v[1] : v[3];
    float r0 = dpp_mov<0x4E, 0xf>(s0), r1 = dpp_mov<0x4E, 0xf>(s1);
    if (b) { v[0] = r0; v[1] = r1; } else { v[2] = r0; v[3] = r1; }
  }
}
__device__ __forceinline__ void store4_bf16(u16* dst, const float (&v)[4]) {
  *(u32x2*)dst = u32x2{pack2(v[0], v[1]), pack2(v[2], v[3])};
}
__device__ void phase0(const Params& p, char* smem, int bid, int nb) {
  const int tid = opaque_tid(), lane = tid & 63, w = tid >> 6;
  u16* WinT = (u16*)(p.ws + W_WINT);
  u16* WoutT = (u16*)(p.ws + W_WOUTT);
  u16* H = (u16*)(p.ws + W_H);
  float* BETA = (float*)(p.ws + W_BETA);
  float* GDEC = (float*)(p.ws + W_GDEC);
  float* tl = (float*)smem;
  for (int t = bid; t < 1280; t += nb) {
    const float* src; int sstride; u16* dst; int kt, nt;
    if (t < 1024) { src = p.w_in; sstride = DIN; dst = WinT; kt = t >> 6; nt = t & 63; }
    else { int u = t - 1024; src = p.w_out; sstride = 1024; dst = WoutT; kt = u >> 4; nt = u & 15; }
#pragma unroll
    for (int i = 0; i < 8; ++i) {
      int idx = tid + 512 * i; int kk = idx >> 6, nn = idx & 63;
      tl[kk * 65 + nn] = src[(size_t)(kt * 64 + kk) * sstride + nt * 64 + nn];
    }
    __syncthreads();
    {
      int nn = tid >> 3, k8 = (tid & 7) * 8;
      unsigned pk[4];
#pragma unroll
      for (int e = 0; e < 4; ++e) pk[e] = pack2(tl[(k8 + 2 * e) * 65 + nn], tl[(k8 + 2 * e + 1) * 65 + nn]);
      *(uint4*)(dst + (size_t)(nt * 64 + nn) * LDK + kt * 64 + k8) = make_uint4(pk[0], pk[1], pk[2], pk[3]);
    }
    __syncthreads();
  }
  float* W8s = (float*)smem;
  for (int idx = tid; idx < 8192; idx += 512) {
    int j = idx & 7, k = idx >> 3;
    W8s[j * 1024 + k] = p.w_in[(size_t)k * DIN + 4096 + j];
  }
  __syncthreads();
  for (int g = bid; g < MT / 8; g += nb) {
    int row = g * 8 + w;
    const float* x = row < MP ? p.x_prompt + (size_t)row * 1024 : p.x_sample + (size_t)(row - MP) * 1024;
    float4 xv[4];
    float ss = 0.f;
#pragma unroll
    for (int i = 0; i < 4; ++i) {
      xv[i] = *(const float4*)(x + i * 256 + lane * 4);
      ss += xv[i].x * xv[i].x + xv[i].y * xv[i].y + xv[i].z * xv[i].z + xv[i].w * xv[i].w;
    }
    ss = wave_sum(ss);
    float rstd = rsqrtf(ss * (1.f / 1024.f) + EPS);
    float d0 = 0, d1 = 0, d2 = 0, d3 = 0, d4 = 0, d5 = 0, d6 = 0, d7 = 0;
#pragma unroll
    for (int i = 0; i < 4; ++i) {
      float4 nw = *(const float4*)(p.norm_w + i * 256 + lane * 4);
      float4 hv;
      hv.x = xv[i].x * rstd * nw.x; hv.y = xv[i].y * rstd * nw.y; hv.z = xv[i].z * rstd * nw.z; hv.w = xv[i].w * rstd * nw.w;
      *(uint2*)(H + (size_t)row * LDK + i * 256 + lane * 4) = make_uint2(pack2(hv.x, hv.y), pack2(hv.z, hv.w));
#define GDOT(j, dj) { float4 wv = *(const float4*)(W8s + j * 1024 + i * 256 + lane * 4); dj += hv.x * wv.x + hv.y * wv.y + hv.z * wv.z + hv.w * wv.w; }
      GDOT(0, d0) GDOT(1, d1) GDOT(2, d2) GDOT(3, d3) GDOT(4, d4) GDOT(5, d5) GDOT(6, d6) GDOT(7, d7)
#undef GDOT
    }
    d0 = wave_sum(d0); d1 = wave_sum(d1); d2 = wave_sum(d2); d3 = wave_sum(d3);
    d4 = wave_sum(d4); d5 = wave_sum(d5); d6 = wave_sum(d6); d7 = wave_sum(d7);
    if (lane < 4) {
      float gb = lane == 0 ? d0 : lane == 1 ? d1 : lane == 2 ? d2 : d3;
      float ga = lane == 0 ? d4 : lane == 1 ? d5 : lane == 2 ? d6 : d7;
      BETA[row * 4 + lane] = 1.f / (1.f + expf(-gb));
      float z = ga + p.dt_bias[lane];
      float sp = z > 20.f ? z : log1pf(expf(z));
      GDEC[row * 4 + lane] = -expf(p.a_log[lane]) * sp;
    }
  }
  __syncthreads();
}

__device__ __forceinline__ int lds_byte2(int r, int c) {
  int st = (r >> 4) * 2 + (c >> 5), ob = (r & 15) * 64 + (c & 31) * 2;
  return st * 1024 + (ob ^ (((ob >> 9) & 1) << 5));
}
__device__ __forceinline__ void stage_rc2(int b, int& R, int& C) {
  int st = b >> 10, sb = b & 1023, swz = sb ^ (((sb >> 9) & 1) << 5);
  R = (st >> 1) * 16 + swz / 64;
  C = (st & 1) * 32 + (swz % 64) / 2;
}
template <int EPI, int SEC>
__device__ __forceinline__ void epi_store4(const Params& p, int row, int col4, const float (&v)[4]) {
  if (EPI == 0) {
    u16* PQ = (u16*)(p.ws + W_PQ);
    u16* GATES = (u16*)(p.ws + W_GATES);
    float* LF = (float*)(p.ws + W_LF);
    const int sec = SEC >= 0 ? SEC : (col4 >> 9);
    if (sec == 0) {
      *(uint2*)(PQ + (size_t)row * PQW + col4) = make_uint2(pack2(v[0], v[1]), pack2(v[2], v[3]));
    } else if (sec == 1) {
      const int cc = col4 - 512;
      const f32x4 l0 = *(const f32x4*)(p.lb_logits + cc), l1 = *(const f32x4*)(p.lb_logits + 512 + cc);
      f32x4 o;
#pragma unroll
      for (int i = 0; i < 4; ++i) {
        const float lbv = 1.f / (1.f + __expf(l1[i] - l0[i]));
        o[i] = __logf(lbv + (1.f - lbv) / (1.f + __expf(-v[i])));
      }
      *(f32x4*)(LF + (size_t)row * 512 + cc) = o;
    } else if (sec == 2) {
      *(uint2*)(PQ + (size_t)row * PQW + 512 + (col4 - 1024)) = make_uint2(pack2(v[0], v[1]), pack2(v[2], v[3]));
    } else if (sec == 3 || sec == 7) {
      const int cc = sec == 3 ? col4 - 1536 : 512 + col4 - 3584;
      *(uint2*)(GATES + (size_t)row * 1024 + cc) =
          make_uint2(pack2(v[0] / (1.f + __expf(-v[0])), v[1] / (1.f + __expf(-v[1]))),
                     pack2(v[2] / (1.f + __expf(-v[2])), v[3] / (1.f + __expf(-v[3]))));
    } else {
      const int cc = col4 - 2048;
      *(uint2*)(PQ + (size_t)row * PQW + 1024 + cc) = make_uint2(pack2(v[0], v[1]), pack2(v[2], v[3]));
      if (row < MP) {
        const int tt = row & 2047;
        if (tt >= 2045) *(f32x4*)(p.out + O_CVP + (size_t)((row >> 11) * 3 + (tt - 2045)) * 1536 + cc) = f32x4{v[0], v[1], v[2], v[3]};
      } else {
        *(f32x4*)(p.out + O_CVS + (size_t)((row - MP) * 3 + 2) * 1536 + cc) = f32x4{v[0], v[1], v[2], v[3]};
      }
    }
  } else {
    const float* xr = row < MP ? p.x_prompt + (size_t)row * 1024 : p.x_sample + (size_t)(row - MP) * 1024;
    float* yr = row < MP ? p.out + O_YP + (size_t)row * 1024 : p.out + O_YS + (size_t)(row - MP) * 1024;
    const f32x4 xv = *(const f32x4*)(xr + col4);
    *(f32x4*)(yr + col4) = f32x4{xv[0] + v[0], xv[1] + v[1], xv[2] + v[2], xv[3] + v[3]};
  }
}

template <int EPI, int MODE = 0>
__device__ void gemm_phase(const Params& p, const u16* __restrict__ A, const u16* __restrict__ Bt, int ntn,
                           char* smem, int bid, int nb) {
  const int tid = opaque_tid(), lane = tid & 63, wid = tid >> 6;
  const int wr = wid >> 2, wc = wid & 3, fr = lane & 15, fq = lane >> 4;
  constexpr int TILE_B = 256 * 64 * 2, STAGE_B = 2 * TILE_B;
  int sR0, sC0;
  stage_rc2(wid * 1024 + lane * 16, sR0, sC0);
  const unsigned goff = (unsigned)(sR0 * LDK + sC0);
  const unsigned lbase = (unsigned)(size_t)smem + (unsigned)(wid * 1024);
  const int aoff = (wr * 16) * 1024 + ((fr * 64 + fq * 16) ^ ((((fr * 64 + fq * 16) >> 9) & 1) << 5));
  const int boff = TILE_B + (wc * 8) * 1024 + ((fr * 64 + fq * 16) ^ ((((fr * 64 + fq * 16) >> 9) & 1) << 5));
  const int ntiles = 64 * ntn;
  auto tile_mn = [&](int tile, int& tm, int& tn) {
    const int rnd = tile >> 8, t = tile & 255, xcd = t & 7, j = t >> 3;
    if (ntn == 16) { tm = rnd * 16 + (xcd >> 1) * 4 + (j & 3); tn = ((xcd & 1) * 8 + (j >> 2) + (rnd & 1) * 2 + (rnd >> 1) * 8) & 15; }
    else { tm = xcd * 8 + (j & 7); tn = j >> 3; }
  };
  bool staged = false;
  for (int tile = bid; tile < ntiles; tile += nb) {
    int tm, tn;
    tile_mn(tile, tm, tn);
    const u16* Ab = A + (size_t)tm * 256 * LDK;
    const u16* Bb = Bt + (size_t)tn * 256 * LDK;
    f32x4 acc[8][4];
#pragma unroll
    for (int m = 0; m < 8; ++m)
#pragma unroll
      for (int n = 0; n < 4; ++n) acc[m][n] = f32x4{0.f, 0.f, 0.f, 0.f};
#define G_STAGE(buf, kt) { _Pragma("unroll") for (int i = 0; i < 4; ++i) { \
      __builtin_amdgcn_global_load_lds((const unsigned*)(Ab + (goff + (unsigned)(i * 64 * LDK + (kt) * 64))), \
          (__attribute__((address_space(3))) unsigned*)(lbase + (buf) * STAGE_B + i * 8192), 16, 0, 0); \
      __builtin_amdgcn_global_load_lds((const unsigned*)(Bb + (goff + (unsigned)(i * 64 * LDK + (kt) * 64))), \
          (__attribute__((address_space(3))) unsigned*)(lbase + (buf) * STAGE_B + TILE_B + i * 8192), 16, 0, 0); } }
    if (!staged) G_STAGE(0, 0);
    asm volatile("s_waitcnt vmcnt(0)" ::: "memory");
    __syncthreads();
    for (int t = 0; t < 16; ++t) {
      const int cur = t & 1;
      if (MODE != 2) { if (t + 1 < 16) G_STAGE(cur ^ 1, t + 1); }
      const char* sA = smem + cur * STAGE_B + aoff;
      const char* sB = smem + cur * STAGE_B + boff;
#pragma unroll
      for (int ks = 0; ks < 2; ++ks) {
        bf16x8 At[8], Bf[4];
#pragma unroll
        for (int m = 0; m < 8; ++m) At[m] = *(const bf16x8*)(sA + (m * 2 + ks) * 1024);
#pragma unroll
        for (int n = 0; n < 4; ++n) Bf[n] = *(const bf16x8*)(sB + (n * 2 + ks) * 1024);
        if (MODE != 3) {
#pragma unroll
          for (int m = 0; m < 8; ++m)
#pragma unroll
            for (int n = 0; n < 4; ++n) acc[m][n] = mfma16(At[m], Bf[n], acc[m][n]);
        } else {
#pragma unroll
          for (int m = 0; m < 8; ++m) acc[m][0][0] += __builtin_bit_cast(float, (int)At[m][0]);
#pragma unroll
          for (int n = 0; n < 4; ++n) acc[0][n][1] += __builtin_bit_cast(float, (int)Bf[n][0]);
        }
        __builtin_amdgcn_sched_barrier(0);
      }
      asm volatile("s_waitcnt vmcnt(0)" ::: "memory");
      __syncthreads();
    }
    staged = false;
    if (tile + nb < ntiles) {
      int tm2, tn2;
      tile_mn(tile + nb, tm2, tn2);
      const u16* Ab2 = A + (size_t)tm2 * 256 * LDK;
      const u16* Bb2 = Bt + (size_t)tn2 * 256 * LDK;
      { const u16* Ab = Ab2; const u16* Bb = Bb2; G_STAGE(0, 0); }
      staged = true;
    }
#undef G_STAGE
    if (MODE != 0 && MODE != 5) {
      float chk = 0.f;
#pragma unroll
      for (int m = 0; m < 8; ++m)
#pragma unroll
        for (int n = 0; n < 4; ++n) chk += acc[m][n][0] + acc[m][n][1] + acc[m][n][2] + acc[m][n][3];
      if (chk == 1.2345e-30f) p.out[0] = chk;
    } else
    {
      int t2 = threadIdx.x;
      asm volatile("" : "+v"(t2));
      const int lane2 = t2 & 63, wid2 = t2 >> 6;
      const int rbase = tm * 256 + (wid2 >> 2) * 128 + (lane2 >> 4) * 4 + (lane2 & 3);
      const int cbase = tn * 256 + (wid2 & 3) * 64 + (lane2 & 12);
#define EPI_LOOP(SEC) { _Pragma("unroll") for (int m = 0; m < 8; ++m) { _Pragma("unroll") for (int n = 0; n < 4; ++n) { \
          float v[4] = {acc[m][n][0], acc[m][n][1], acc[m][n][2], acc[m][n][3]}; \
          quad_transpose(v, lane2); \
          epi_store4<EPI, SEC>(p, rbase + m * 16, cbase + n * 16, v); } } }
      if (EPI == 0) {
        const int sec = tn >> 1;
        if (sec == 1) {
          float* LF = (float*)(p.ws + W_LF);
          float lbv[4][4];
#pragma unroll
          for (int n = 0; n < 4; ++n) {
            const int cc = cbase + n * 16 - 512;
            const f32x4 l0 = *(const f32x4*)(p.lb_logits + cc), l1 = *(const f32x4*)(p.lb_logits + 512 + cc);
#pragma unroll
            for (int e = 0; e < 4; ++e) lbv[n][e] = 1.f / (1.f + __expf(l1[e] - l0[e]));
          }
#pragma unroll
          for (int m = 0; m < 8; ++m)
#pragma unroll
            for (int n = 0; n < 4; ++n) {
              float v[4] = {acc[m][n][0], acc[m][n][1], acc[m][n][2], acc[m][n][3]};
              quad_transpose(v, lane2);
              f32x4 o;
#pragma unroll
              for (int e = 0; e < 4; ++e) o[e] = __logf(lbv[n][e] + (1.f - lbv[n][e]) * __builtin_amdgcn_rcpf(1.f + __expf(-v[e])));
              *(f32x4*)(LF + (size_t)(rbase + m * 16) * 512 + (cbase + n * 16 - 512)) = o;
            }
        } else {
          const bool gate = (sec == 3 || sec == 7);
          u16* dstb; int dstride, dcol;
          const int c0 = tn * 256 + (wid2 & 3) * 64;
          if (gate) { dstb = (u16*)(p.ws + W_GATES); dstride = 1024; dcol = sec == 3 ? c0 - 1536 : 512 + c0 - 3584; }
          else { dstb = (u16*)(p.ws + W_PQ); dstride = PQW; dcol = sec == 0 ? c0 : sec == 2 ? 512 + c0 - 1024 : 1024 + c0 - 2048; }
          char* ebuf = smem + STAGE_B + wid2 * 8192;
          const int wrow = (lane2 >> 4) * 4 + (lane2 & 3), wcol = (lane2 & 12);
          const int row00 = tm * 256 + (wid2 >> 2) * 128;
#pragma unroll
          for (int hf = 0; hf < 2; ++hf) {
#pragma unroll
            for (int m = 0; m < 4; ++m)
#pragma unroll
              for (int n = 0; n < 4; ++n) {
                float v[4] = {acc[hf * 4 + m][n][0], acc[hf * 4 + m][n][1], acc[hf * 4 + m][n][2], acc[hf * 4 + m][n][3]};
                if (gate) {
#pragma unroll
                  for (int e = 0; e < 4; ++e) v[e] = v[e] / (1.f + __expf(-v[e]));
                }
                quad_transpose(v, lane2);
                const int rl = m * 16 + wrow, cl = n * 16 + wcol;
                *(u32x2*)(ebuf + rl * 128 + ((cl * 2) ^ ((rl & 7) << 4))) = u32x2{pack2(v[0], v[1]), pack2(v[2], v[3])};
                if (sec >= 4 && sec <= 6) {
                  const int row = row00 + hf * 64 + rl, cc = c0 - 2048 + cl;
                  const int tt = row & 2047;
                  if (tt >= 2045) *(f32x4*)(p.out + O_CVP + (size_t)((row >> 11) * 3 + (tt - 2045)) * 1536 + cc) = f32x4{v[0], v[1], v[2], v[3]};
                }
              }
            asm volatile("s_waitcnt lgkmcnt(0)" ::: "memory");
#pragma unroll
            for (int i = 0; i < 8; ++i) {
              const int rl = i * 8 + (lane2 >> 3), ch = lane2 & 7;
              const u32x4 d = *(const u32x4*)(ebuf + rl * 128 + ((ch ^ (rl & 7)) << 4));
              *(u32x4*)(dstb + (size_t)(row00 + hf * 64 + rl) * dstride + dcol + ch * 8) = d;
            }
            asm volatile("s_waitcnt lgkmcnt(0)" ::: "memory");
          }
        }
      } else EPI_LOOP(0)
#undef EPI_LOOP
    }
  }
  const int nunits = MODE == 0 ? ntn * 16 : 0;
  int t3 = threadIdx.x;
  asm volatile("" : "+v"(t3));
  for (int u = bid; u < nunits; u += nb) {
    const int lane = t3 & 63, wid = t3 >> 6, fr = lane & 15, fq = lane >> 4;
    const u16* ar = A + (size_t)(MP + wid * 16 + fr) * LDK + fq * 8;
    const u16* br = Bt + (size_t)(u * 16 + fr) * LDK + fq * 8;
    f32x4 acc0 = {0.f, 0.f, 0.f, 0.f}, acc1 = {0.f, 0.f, 0.f, 0.f};
#pragma unroll 4
    for (int ks = 0; ks < 32; ks += 2) {
      const bf16x8 a0 = *(const bf16x8*)(ar + ks * 32), b0 = *(const bf16x8*)(br + ks * 32);
      const bf16x8 a1 = *(const bf16x8*)(ar + ks * 32 + 32), b1 = *(const bf16x8*)(br + ks * 32 + 32);
      acc0 = mfma16(a0, b0, acc0);
      acc1 = mfma16(a1, b1, acc1);
    }
    float v[4] = {acc0[0] + acc1[0], acc0[1] + acc1[1], acc0[2] + acc1[2], acc0[3] + acc1[3]};
    quad_transpose(v, lane);
    epi_store4<EPI, -1>(p, MP + wid * 16 + fq * 4 + (lane & 3), u * 16 + (fr & ~3), v);
  }
  __syncthreads();
}

#define XB_TMO      128
#define XB_XCNT(j)  (256  + 64 * (j))
#define XB_XSUB(j)  (1280 + 64 * (j))
#define XB_XGEN(j)  (2304 + 64 * (j))
#define XB_TOP      3328
#define XB_TOPGEN   3392
#define XCD_BAR_WORDS 3456
#define XB_SPIN_CAP (1u << 18)
#define LAS __attribute__((address_space(3)))
__device__ __forceinline__ unsigned xb_ld(unsigned* p)              { return __hip_atomic_load(p, __ATOMIC_RELAXED, __HIP_MEMORY_SCOPE_AGENT); }
__device__ __forceinline__ unsigned xb_add(unsigned* p, unsigned v) { return __hip_atomic_fetch_add(p, v, __ATOMIC_RELAXED, __HIP_MEMORY_SCOPE_AGENT); }
__device__ __forceinline__ unsigned xb_xcc_id() { return (unsigned)__builtin_amdgcn_s_getreg((3 << 11) | 20) & 0xFu; }
#define XB_SPIN(cond, bar) do { unsigned _sp = 0; while (cond) { __builtin_amdgcn_s_sleep(1); \
    if ((++_sp & 255u) == 0u) { if (xb_ld(&(bar)[XB_TMO])) break; if (_sp > XB_SPIN_CAP) { atomicAdd(&(bar)[XB_TMO], 1u); break; } } } } while (0)
struct XcdBarrier { unsigned* bar; unsigned x; volatile LAS unsigned* st; };
__device__ __forceinline__ XcdBarrier xcd_barrier_post(unsigned* bar, volatile LAS unsigned* st) {
  XcdBarrier b; b.bar = bar; b.x = xb_xcc_id(); b.st = st;
  if (threadIdx.x == 0) (void)xb_add(&bar[XB_XCNT(b.x)], 1u);
  return b;
}
__device__ __forceinline__ void xcd_barrier_complete(unsigned* bar, unsigned x, unsigned& nloc, unsigned& nx) {
  const unsigned G = gridDim.x * gridDim.y * gridDim.z;
  unsigned sum, cnt, mine, sp = 0u;
  for (;;) {
    sum = 0u; cnt = 0u; mine = 0u;
#pragma unroll
    for (unsigned j = 0; j < 16; ++j) { const unsigned c = xb_ld(&bar[XB_XCNT(j)]); sum += c; cnt += (c > 0u) ? 1u : 0u; mine = (j == x) ? c : mine; }
    if (sum == G) break;
    __builtin_amdgcn_s_sleep(1);
    if ((++sp & 255u) == 0u) { if (xb_ld(&bar[XB_TMO])) break; if (sp > XB_SPIN_CAP) { atomicAdd(&bar[XB_TMO], 1u); break; } }
  }
  nloc = mine > 0u ? mine : 1u; nx = cnt > 0u ? cnt : 1u;
}
__device__ __forceinline__ void xcd_barrier(const XcdBarrier& b) {
  asm volatile("s_waitcnt vmcnt(0)" ::: "memory");
  __syncthreads();
  if (threadIdx.x == 0) {
    unsigned* bar = b.bar;
    __builtin_amdgcn_s_waitcnt(0);
    unsigned nloc = b.st[0], nx = b.st[1];
    if (nloc == 0u) { xcd_barrier_complete(bar, b.x, nloc, nx); b.st[0] = nloc; b.st[1] = nx; }
    const unsigned old = xb_add(&bar[XB_XSUB(b.x)], 1u);
    const unsigned gen = old / nloc;
    if (old + 1u == (gen + 1u) * nloc) {
      __builtin_amdgcn_fence(__ATOMIC_RELEASE, "agent");
      asm volatile("s_waitcnt vmcnt(0)" ::: "memory");
      const unsigned og = xb_add(&bar[XB_TOP], 1u);
      const unsigned tg = og / nx;
      if (og + 1u == (tg + 1u) * nx) xb_add(&bar[XB_TOPGEN], 1u);
      else XB_SPIN(xb_ld(&bar[XB_TOPGEN]) == tg, bar);
      __builtin_amdgcn_fence(__ATOMIC_ACQUIRE, "agent");
      xb_add(&bar[XB_XGEN(b.x)], 1u);
      asm volatile("s_waitcnt vmcnt(0)" ::: "memory");
    } else {
      XB_SPIN(xb_ld(&bar[XB_XGEN(b.x)]) == gen, bar);
      __builtin_amdgcn_fence(__ATOMIC_ACQUIRE, "agent");
      asm volatile("s_waitcnt vmcnt(0)" ::: "memory");
    }
  }
  __syncthreads();
}

#define RAW_BARRIER() do { asm volatile("s_waitcnt lgkmcnt(0)" ::: "memory"); __builtin_amdgcn_s_barrier(); asm volatile("" ::: "memory"); } while (0)
__device__ void hgrn_item(const Params& p, char* smem, int idx) {
  const int tid = opaque_tid(), lane = tid & 63, w = tid >> 6;
  const int lr = lane & 15, lq = lane >> 4;
  const int h = idx & 3, c = (idx >> 2) & 31, b = idx >> 7;
  const int r0 = b * 2048 + c * 64;
  const u16* PQ = (const u16*)(p.ws + W_PQ);
  const float* LF = (const float*)(p.ws + W_LF);
  u16* QS = (u16*)(p.ws + W_QS);
  u16* O0 = (u16*)(p.ws + W_H);
  u16* NB = (u16*)(p.out);
  float* DVEC = (float*)(p.ws + W_DVEC);
  u16* qt = (u16*)smem;
  u16* kt = qt + 64 * 136;
  u16* ktT = kt + 64 * 136;
  u16* vT = ktT + 128 * 72;
  u16* sc = vT + 128 * 72;
  float* ps = (float*)(sc + 64 * 72);
  const int col = tid & 127, part = tid >> 7;
  float lfv[16], bcum[16];
  {
    const float* lfp = LF + (size_t)(r0 + part * 16) * 512 + h * 128 + col;
#pragma unroll
    for (int i = 0; i < 16; ++i) lfv[i] = lfp[(size_t)i * 512];
    float run = 0.f;
#pragma unroll
    for (int i = 0; i < 16; ++i) { run += lfv[i]; bcum[i] = run; }
    ps[part * 128 + col] = run;
  }
  u16 qraw[16], vraw[16];
  {
    const u16* qp0 = PQ + (size_t)(r0 + part * 16) * PQW + h * 128 + col;
#pragma unroll
    for (int i = 0; i < 16; ++i) { qraw[i] = qp0[(size_t)i * PQW]; vraw[i] = qp0[(size_t)i * PQW + 512]; }
  }
  RAW_BARRIER();
  {
    float off = 0.f, blast = 0.f;
#pragma unroll
    for (int pp = 0; pp < 4; ++pp) { float t = ps[pp * 128 + col]; blast += t; if (pp < part) off += t; }
    u16* qsout = QS + ((size_t)idx * 64 + part * 16) * 128 + col;
    float kkv[16];
#pragma unroll
    for (int i = 0; i < 16; ++i) {
      const float bb = bcum[i] + off;
      const int row = part * 16 + i;
      const float q = bf2f(qraw[i]);
      qsout[i * 128] = f2bf(q * __expf(bb));
      qt[row * 136 + col] = f2bf(q * __expf(bb - blast));
      kkv[i] = (1.f - __expf(lfv[i])) * __expf(blast - bb);
      kt[row * 136 + col] = f2bf(kkv[i]);
    }
#pragma unroll
    for (int hh = 0; hh < 2; ++hh) {
      *(u32x4*)(ktT + col * 72 + part * 16 + hh * 8) =
          u32x4{pack2(kkv[hh * 8 + 0], kkv[hh * 8 + 1]), pack2(kkv[hh * 8 + 2], kkv[hh * 8 + 3]),
                pack2(kkv[hh * 8 + 4], kkv[hh * 8 + 5]), pack2(kkv[hh * 8 + 6], kkv[hh * 8 + 7])};
      *(u32x4*)(vT + col * 72 + part * 16 + hh * 8) =
          u32x4{(unsigned)vraw[hh * 8 + 0] | ((unsigned)vraw[hh * 8 + 1] << 16), (unsigned)vraw[hh * 8 + 2] | ((unsigned)vraw[hh * 8 + 3] << 16),
                (unsigned)vraw[hh * 8 + 4] | ((unsigned)vraw[hh * 8 + 5] << 16), (unsigned)vraw[hh * 8 + 6] | ((unsigned)vraw[hh * 8 + 7] << 16)};
    }
    if (part == 0) DVEC[idx * 128 + col] = __expf(blast);
  }
  RAW_BARRIER();
  {
    const int tr = w >> 1;
    bf16x8 a[4];
#pragma unroll
    for (int ks = 0; ks < 4; ++ks) a[ks] = frag(qt, tr * 16, 136, ks * 32, lane);
#pragma unroll
    for (int tci = 0; tci < 2; ++tci) {
      const int tc = (w & 1) * 2 + tci;
      f32x4 acc = {0.f, 0.f, 0.f, 0.f};
#pragma unroll
      for (int ks = 0; ks < 4; ++ks) acc = mfma16(a[ks], frag(kt, tc * 16, 136, ks * 32, lane), acc);
#pragma unroll
      for (int j = 0; j < 4; ++j) {
        const int t = tr * 16 + lq * 4 + j, s = tc * 16 + lr;
        sc[t * 72 + s] = f2bf(t >= s ? acc[j] : 0.f);
      }
    }
  }
  RAW_BARRIER();
  {
    const int tr = w >> 1;
    const bf16x8 a0 = frag(sc, tr * 16, 72, 0, lane), a1 = frag(sc, tr * 16, 72, 32, lane);
#pragma unroll
    for (int tci = 0; tci < 4; ++tci) {
      const int tc = (w & 1) * 4 + tci;
      f32x4 acc = {0.f, 0.f, 0.f, 0.f};
      acc = mfma16(a0, frag(vT, tc * 16, 72, 0, lane), acc);
      acc = mfma16(a1, frag(vT, tc * 16, 72, 32, lane), acc);
      {
        float v[4] = {acc[0], acc[1], acc[2], acc[3]};
        quad_transpose(v, lane);
        store4_bf16(O0 + ((size_t)idx * 64 + tr * 16 + lq * 4 + (lane & 3)) * 128 + tc * 16 + (lr & 12), v);
      }
    }
  }
  {
    const int tr = w;
    const bf16x8 a0 = frag(ktT, tr * 16, 72, 0, lane), a1 = frag(ktT, tr * 16, 72, 32, lane);
#pragma unroll
    for (int tc = 0; tc < 8; ++tc) {
      f32x4 acc = {0.f, 0.f, 0.f, 0.f};
      acc = mfma16(a0, frag(vT, tc * 16, 72, 0, lane), acc);
      acc = mfma16(a1, frag(vT, tc * 16, 72, 32, lane), acc);
      {
        float v[4] = {acc[0], acc[1], acc[2], acc[3]};
        quad_transpose(v, lane);
        store4_bf16(NB + ((size_t)idx * 128 + tr * 16 + lq * 4 + (lane & 3)) * 128 + tc * 16 + (lr & 12), v);
      }
    }
  }
  RAW_BARRIER();
}

constexpr int ASTR = 68;
template <int J>
struct SolveCol {
  static __device__ __forceinline__ void run(f32x4 (&x)[16], const f32x4 (&a)[16], const float* AT) {
    if constexpr (J < 63) {
      f32x4 an[16];
      if constexpr (J + 1 < 63) {
#pragma unroll
        for (int B = (J + 2) / 4; B < 16; ++B) an[B] = *(const f32x4*)(AT + (J + 1) * ASTR + B * 4);
      }
      __builtin_amdgcn_sched_barrier(0);
      const float xj = x[J / 4][J % 4];
#pragma unroll
      for (int B = (J + 1) / 4; B < 16; ++B) x[B] -= a[B] * xj;
      __builtin_amdgcn_sched_barrier(0);
      SolveCol<J + 1>::run(x, an, AT);
    }
  }
};

__device__ void gdn_item(const Params& p, char* smem, int idx) {
  const int tid = opaque_tid(), lane = tid & 63, w = tid >> 6;
  const int lr = lane & 15, lq = lane >> 4;
  const int h = idx & 3, c = (idx >> 2) & 31, b = idx >> 7;
  const int r0 = b * 2048 + c * 64;
  const u16* PQ = (const u16*)(p.ws + W_PQ);
  const float* BETA = (const float*)(p.ws + W_BETA);
  const float* GDEC = (const float*)(p.ws + W_GDEC);
  u16* QS = (u16*)(p.ws + W_QS);
  u16* O0 = (u16*)(p.ws + W_H);
  u16* NB = (u16*)(p.out);
  u16* MNEG = (u16*)(p.ws + W_MNEG);
  float* DSC = (float*)(p.ws + W_DSC);
  u16* kb = (u16*)smem;
  u16* qb = kb + 64 * 136;
  u16* vS = qb + 64 * 136;
  float* Asol = (float*)(vS + 64 * 128);
  u16* attn = (u16*)(Asol + 64 * ASTR);
  u16* khT = attn + 64 * 72;
  u16* WT = khT + 128 * 72;
  u16* U0T = WT + 128 * 72;
  float* gc = (float*)(U0T + 128 * 72);
  float* bet = gc + 64;

  if (w == 0) {
    float g = GDEC[(size_t)(r0 + lane) * 4 + h];
#pragma unroll
    for (int o = 1; o < 64; o <<= 1) { float t = __shfl_up(g, o, 64); if (lane >= o) g += t; }
    gc[lane] = g;
    bet[lane] = BETA[(size_t)(r0 + lane) * 4 + h];
  }
  for (int rep_ = 0; rep_ < ((PROBE_G & 1) ? 2 : 1); ++rep_)
  {
    const int chq = 1024 + h * 128 + 2 * lane;
    const int cwq = h * 128 + 2 * lane;
    float cw[3][4][2];
#pragma unroll
    for (int ty = 0; ty < 3; ++ty)
#pragma unroll
      for (int j = 0; j < 4; ++j) {
        float2 t2 = *(const float2*)(p.conv_w + j * 1536 + ty * 512 + cwq);
        cw[ty][j][0] = t2.x; cw[ty][j][1] = t2.y;
      }
    float win[3][3][2];
    const int t0 = w * 8;
#pragma unroll
    for (int a = 0; a < 3; ++a) {
      const int rr = t0 - 3 + a;
      const bool valid = (c > 0) || (rr >= 0);
#pragma unroll
      for (int ty = 0; ty < 3; ++ty) {
        unsigned u = 0;
        if (valid) u = *(const unsigned*)(PQ + (ptrdiff_t)(r0 + rr) * PQW + chq + ty * 512);
        win[ty][a][0] = bf2f((u16)(u & 0xffff)); win[ty][a][1] = bf2f((u16)(u >> 16));
      }
    }
#pragma unroll
    for (int tt = 0; tt < 8; ++tt) {
      const int t = t0 + tt;
      float cv[3][2];
#pragma unroll
      for (int ty = 0; ty < 3; ++ty) {
        unsigned u = *(const unsigned*)(PQ + (size_t)(r0 + t) * PQW + chq + ty * 512);
        float c0 = bf2f((u16)(u & 0xffff)), c1 = bf2f((u16)(u >> 16));
        float s0 = cw[ty][0][0] * win[ty][0][0] + cw[ty][1][0] * win[ty][1][0] + cw[ty][2][0] * win[ty][2][0] + cw[ty][3][0] * c0;
        float s1 = cw[ty][0][1] * win[ty][0][1] + cw[ty][1][1] * win[ty][1][1] + cw[ty][2][1] * win[ty][2][1] + cw[ty][3][1] * c1;
        win[ty][0][0] = win[ty][1][0]; win[ty][0][1] = win[ty][1][1];
        win[ty][1][0] = win[ty][2][0]; win[ty][1][1] = win[ty][2][1];
        win[ty][2][0] = c0; win[ty][2][1] = c1;
        cv[ty][0] = siluf_(s0); cv[ty][1] = siluf_(s1);
      }
      float ssq = wave_sum(cv[0][0] * cv[0][0] + cv[0][1] * cv[0][1]);
      float ssk = wave_sum(cv[1][0] * cv[1][0] + cv[1][1] * cv[1][1]);
      const float rq = rsqrtf(ssq + EPS) * 0.08838834764831845f;
      const float rk = rsqrtf(ssk + EPS);
      *(unsigned*)(qb + t * 136 + 2 * lane) = pack2(cv[0][0] * rq, cv[0][1] * rq);
      *(unsigned*)(kb + t * 136 + 2 * lane) = pack2(cv[1][0] * rk, cv[1][1] * rk);
      *(unsigned*)(vS + t * 128 + 2 * lane) = pack2(cv[2][0], cv[2][1]);
    }
  }
  RAW_BARRIER();
  {
    const int which = w >> 2, tr = w & 3;
    const u16* Asrc = which ? qb : kb;
    bf16x8 a[4];
#pragma unroll
    for (int ks = 0; ks < 4; ++ks) a[ks] = frag(Asrc, tr * 16, 136, ks * 32, lane);
#pragma unroll
    for (int tc = 0; tc < 4; ++tc) {
      f32x4 acc = {0.f, 0.f, 0.f, 0.f};
#pragma unroll
      for (int ks = 0; ks < 4; ++ks) acc = mfma16(a[ks], frag(kb, tc * 16, 136, ks * 32, lane), acc);
#pragma unroll
      for (int j = 0; j < 4; ++j) {
        const int t = tr * 16 + lq * 4 + j, s = tc * 16 + lr;
        const float L = __expf(fminf(gc[t] - gc[s], 0.f));
        if (which == 0) Asol[s * ASTR + t] = (t > s) ? bet[t] * acc[j] * L : 0.f;
        else attn[t * 72 + s] = f2bf((t >= s) ? acc[j] * L : 0.f);
      }
    }
  }
  RAW_BARRIER();
  for (int rep_ = 0; rep_ < ((PROBE_G & 2) ? 2 : 1); ++rep_) {
  if (tid < 256) {
    f32x4 x[16];
    if (tid < 128) {
#pragma unroll
      for (int s = 0; s < 64; ++s) { x[s >> 2][s & 3] = bf2f(vS[s * 128 + tid]) * bet[s]; if ((s & 7) == 7) __builtin_amdgcn_sched_barrier(0); }
    } else {
#pragma unroll
      for (int s = 0; s < 64; ++s) { x[s >> 2][s & 3] = bf2f(kb[s * 136 + tid - 128]) * bet[s] * __expf(gc[s]); if ((s & 7) == 7) __builtin_amdgcn_sched_barrier(0); }
    }
    {
      f32x4 a0[16];
#pragma unroll
      for (int B = 0; B < 16; ++B) a0[B] = *(const f32x4*)(Asol + B * 4);
      SolveCol<0>::run(x, a0, Asol);
    }
    u16* dst = (tid < 128) ? (U0T + tid * 72) : (WT + (tid - 128) * 72);
#pragma unroll
    for (int s8 = 0; s8 < 8; ++s8) {
      *(u32x4*)(dst + s8 * 8) = u32x4{pack2(x[2 * s8][0], x[2 * s8][1]), pack2(x[2 * s8][2], x[2 * s8][3]),
                                      pack2(x[2 * s8 + 1][0], x[2 * s8 + 1][1]), pack2(x[2 * s8 + 1][2], x[2 * s8 + 1][3])};
    }
  } else {
    const float glast = gc[63];
    const int e0 = tid - 256;
#pragma unroll 4
    for (int i = 0; i < 32; ++i) {
      const int e = e0 + 256 * i;
      const int s = e & 63, kd = e >> 6;
      khT[kd * 72 + s] = f2bf(bf2f(kb[s * 136 + kd]) * __expf(glast - gc[s]));
    }
  }
  RAW_BARRIER();
  }
  for (int rep_ = 0; rep_ < ((PROBE_G & 4) ? 2 : 1); ++rep_) {
  {
    const int tr = w & 3, half = w >> 2;
    const u16* Bsrc = half ? U0T : WT;
    const bf16x8 a0 = frag(attn, tr * 16, 72, 0, lane), a1 = frag(attn, tr * 16, 72, 32, lane);
#pragma unroll 2
    for (int tc = 0; tc < 8; ++tc) {
      f32x4 acc = {0.f, 0.f, 0.f, 0.f};
      acc = mfma16(a0, frag(Bsrc, tc * 16, 72, 0, lane), acc);
      acc = mfma16(a1, frag(Bsrc, tc * 16, 72, 32, lane), acc);
      {
        float v[4];
#pragma unroll
        for (int j = 0; j < 4; ++j) {
          const int t = tr * 16 + lq * 4 + j, n = tc * 16 + lr;
          v[j] = half == 0 ? bf2f(qb[t * 136 + n]) * __expf(gc[t]) - acc[j] : acc[j];
        }
        quad_transpose(v, lane);
        const size_t o = ((size_t)(1024 + idx) * 64 + tr * 16 + lq * 4 + (lane & 3)) * 128 + tc * 16 + (lr & 12);
        store4_bf16((half == 0 ? QS : O0) + o, v);
      }
    }
  }
  {
    const int tr = w;
    const bf16x8 a0 = frag(khT, tr * 16, 72, 0, lane), a1 = frag(khT, tr * 16, 72, 32, lane);
#pragma unroll 2
    for (int tc = 0; tc < 16; ++tc) {
      const u16* Bsrc = tc < 8 ? WT : U0T;
      const int tcc = tc & 7;
      f32x4 acc = {0.f, 0.f, 0.f, 0.f};
      acc = mfma16(a0, frag(Bsrc, tcc * 16, 72, 0, lane), acc);
      acc = mfma16(a1, frag(Bsrc, tcc * 16, 72, 32, lane), acc);
      {
        float v[4];
#pragma unroll
        for (int j = 0; j < 4; ++j) v[j] = tc < 8 ? -acc[j] : acc[j];
        quad_transpose(v, lane);
        const size_t o = (size_t)(tr * 16 + lq * 4 + (lane & 3)) * 128 + tcc * 16 + (lr & 12);
        store4_bf16((tc < 8 ? MNEG + (size_t)idx * 16384 : NB + (size_t)(1024 + idx) * 16384) + o, v);
      }
    }
  }
  }
  if (tid < 128) ((float*)(p.ws + W_DVEC))[(size_t)(1024 + idx) * 128 + tid] = __expf(gc[63]);
  RAW_BARRIER();
}

__device__ void phase2(const Params& p, char* smem, int bid, int nb) {
  for (int it = bid; it < 2048; it += nb) {
    if (it >= 1024) { gdn_item(p, smem, it - 1024); if (DUP_MASK & 2048) gdn_item(p, smem, it - 1024); }
    else { hgrn_item(p, smem, it); if (DUP_MASK & 1024) hgrn_item(p, smem, it); }
  }
}

struct ScanRegs {
  bf16x8 Aq[4];
  bf16x8 Am[4];
  u32x2 o0, nn0, nn1;
  f32x4 dd;
};

template <int TYPE>
__device__ __forceinline__ void scan_load(ScanRegs& r, const Params& p, int idx, unsigned qoff, unsigned ooff, unsigned moff,
                                          unsigned noff, unsigned doff) {
  const int ii = __builtin_amdgcn_readfirstlane(idx);
  const int ti = TYPE * 1024 + ii;
  const u16* QSb = (const u16*)(p.ws + W_QS) + (size_t)ti * 8192;
  const u16* O0b = (const u16*)(p.ws + W_H) + (size_t)ti * 8192;
  const u16* NBb = (const u16*)(p.out) + (size_t)ti * 16384;
#pragma unroll
  for (int ks = 0; ks < 4; ++ks) r.Aq[ks] = *(const bf16x8*)(QSb + (qoff + ks * 32));
  r.o0 = *(const u32x2*)(O0b + ooff);
  r.nn0 = *(const u32x2*)(NBb + noff);
  r.nn1 = *(const u32x2*)(NBb + (noff + 16));
  if (TYPE == 1) {
    const u16* Mb = (const u16*)(p.ws + W_MNEG) + (size_t)ii * 16384;
#pragma unroll
    for (int ks = 0; ks < 4; ++ks) r.Am[ks] = *(const bf16x8*)(Mb + (moff + ks * 32));
  }
  r.dd = *(const f32x4*)((const float*)(p.ws + W_DVEC) + (size_t)ti * 128 + doff);
}
__device__ __forceinline__ void unpack4(u32x2 u, float (&v)[4]) {
  v[0] = bf2f((u16)(u[0] & 0xffff)); v[1] = bf2f((u16)(u[0] >> 16));
  v[2] = bf2f((u16)(u[1] & 0xffff)); v[3] = bf2f((u16)(u[1] >> 16));
}

template <int TYPE>
__device__ void scan_unit(const Params& p, char* smem, int rem) {
  const int tid = opaque_tid(), lane = tid & 63, w = tid >> 6;
  const int lr = lane & 15, lq = lane >> 4;
  const int b = rem >> 4, h = (rem >> 2) & 3, vs2 = rem & 3;
  const int tr = lq * 4 + (lane & 3), tc4 = lr & 12;
  const int otr = w & 3, otc = w >> 2;
  float* OPRE = (float*)(p.ws + W_PQ);
  u16* SbT = (u16*)smem;
  for (int i = tid; i < 2 * 32 * 136; i += 512) SbT[i] = 0;
  f32x4 S0 = {0.f, 0.f, 0.f, 0.f}, S1 = {0.f, 0.f, 0.f, 0.f};
  const unsigned qoff = (unsigned)((otr * 16 + lr) * 128 + lq * 8);
  const unsigned ooff = (unsigned)((otr * 16 + tr) * 128 + vs2 * 32 + otc * 16 + tc4);
  const unsigned moff = (unsigned)((w * 16 + lr) * 128 + lq * 8);
  const unsigned noff = (unsigned)((w * 16 + tr) * 128 + vs2 * 32 + tc4);
  const unsigned doff = (unsigned)(w * 16 + lq * 4);
  float* const orow = OPRE + (size_t)(b * 2048 + otr * 16 + tr) * 1024 + TYPE * 512 + h * 128 + vs2 * 32 + otc * 16 + tc4;
  ScanRegs r0, r1, r2, r3;
  const int idx0 = (b * 32) * 4 + h;
  scan_load<TYPE>(r0, p, idx0 + 0, qoff, ooff, moff, noff, doff);
  scan_load<TYPE>(r1, p, idx0 + 4, qoff, ooff, moff, noff, doff);
  scan_load<TYPE>(r2, p, idx0 + 8, qoff, ooff, moff, noff, doff);
  scan_load<TYPE>(r3, p, idx0 + 12, qoff, ooff, moff, noff, doff);
  __builtin_amdgcn_sched_barrier(0);
#define SCAN_STEP(R, c) { \
    RAW_BARRIER(); \
    const u16* Sb = SbT + ((c) & 1) * 32 * 136 + lr * 136 + lq * 8; \
    bf16x8 B0[4], B1[4], Bo[4]; \
    _Pragma("unroll") for (int ks = 0; ks < 4; ++ks) { \
      B0[ks] = *(const bf16x8*)(Sb + ks * 32); \
      B1[ks] = *(const bf16x8*)(Sb + 16 * 136 + ks * 32); \
      Bo[ks] = *(const bf16x8*)(Sb + otc * 16 * 136 + ks * 32); } \
    { \
      float ov[4]; unpack4(R.o0, ov); quad_transpose(ov, lane); \
      f32x4 acc = {ov[0], ov[1], ov[2], ov[3]}; \
      _Pragma("unroll") for (int ks = 0; ks < 4; ++ks) acc = mfma16(R.Aq[ks], Bo[ks], acc); \
      float o[4] = {acc[0], acc[1], acc[2], acc[3]}; \
      quad_transpose(o, lane); \
      *(f32x4*)(orow + (size_t)(c) * 65536) = f32x4{o[0], o[1], o[2], o[3]}; \
    } \
    float n0[4], n1[4]; unpack4(R.nn0, n0); unpack4(R.nn1, n1); \
    quad_transpose(n0, lane); quad_transpose(n1, lane); \
    f32x4 T0, T1; \
    _Pragma("unroll") for (int j = 0; j < 4; ++j) { T0[j] = R.dd[j] * S0[j] + n0[j]; T1[j] = R.dd[j] * S1[j] + n1[j]; } \
    if (TYPE == 1) { _Pragma("unroll") for (int ks = 0; ks < 4; ++ks) { T0 = mfma16(R.Am[ks], B0[ks], T0); T1 = mfma16(R.Am[ks], B1[ks], T1); } } \
    S0 = T0; S1 = T1; \
    u16* Sw = SbT + (((c) + 1) & 1) * 32 * 136 + lr * 136 + w * 16 + lq * 4; \
    *(u32x2*)(Sw) = u32x2{pack2(S0[0], S0[1]), pack2(S0[2], S0[3])}; \
    *(u32x2*)(Sw + 16 * 136) = u32x2{pack2(S1[0], S1[1]), pack2(S1[2], S1[3])}; \
    __builtin_amdgcn_sched_barrier(0); \
    scan_load<TYPE>(R, p, idx0 + (((c) + 4 < 32) ? (c) + 4 : 31) * 4, qoff, ooff, moff, noff, doff); \
    __builtin_amdgcn_sched_barrier(0); \
  }
  for (int c0 = 0; c0 < 32; c0 += 4) {
    SCAN_STEP(r0, c0)
    SCAN_STEP(r1, c0 + 1)
    SCAN_STEP(r2, c0 + 2)
    SCAN_STEP(r3, c0 + 3)
  }
#undef SCAN_STEP
  float* so = p.out + (TYPE ? O_GDP : O_HGP) + (size_t)(b * 4 + h) * 16384 + (w * 16 + tr) * 128 + vs2 * 32 + tc4;
  {
    float sv[4] = {S0[0], S0[1], S0[2], S0[3]};
    quad_transpose(sv, lane);
    *(f32x4*)(so) = f32x4{sv[0], sv[1], sv[2], sv[3]};
    float sw[4] = {S1[0], S1[1], S1[2], S1[3]};
    quad_transpose(sw, lane);
    *(f32x4*)(so + 16) = f32x4{sw[0], sw[1], sw[2], sw[3]};
  }
  __syncthreads();
}

__device__ void sample_item(const Params& p, char* smem, int it) {
  const int tid = opaque_tid(), lane = tid & 63, w = tid >> 6;
  const int type = it >> 9, b = (it >> 2) & 127, h = it & 3;
  const int row = MP + b;
  const u16* PQ = (const u16*)(p.ws + W_PQ);
  const float* LF = (const float*)(p.ws + W_LF);
  const float* BETA = (const float*)(p.ws + W_BETA);
  const float* GDEC = (const float*)(p.ws + W_GDEC);
  float* OPRE = (float*)(p.ws + W_PQ);
  float* fq = (float*)smem;
  float* fk = fq + 128;
  float* fv = fk + 128;
  float* fe = fv + 128;
  float* red = fe + 128;
  float* sc = red + 1024;
  const int n = tid & 127, kp = tid >> 7;
  if (type == 0) {
    if (tid < 128) {
      const float lf = LF[(size_t)row * 512 + h * 128 + tid];
      const float f = __expf(lf);
      fe[tid] = f;
      fk[tid] = 1.f - f;
      fq[tid] = bf2f(PQ[(size_t)row * PQW + h * 128 + tid]);
      fv[tid] = bf2f(PQ[(size_t)row * PQW + 512 + h * 128 + tid]);
    }
    __syncthreads();
    const float* S = p.state_hgrn + ((size_t)(b * 4 + h) * 128) * 128;
    float* So = p.out + O_HGS + ((size_t)(b * 4 + h) * 128) * 128;
    const float vn = fv[n];
    float o = 0.f;
#pragma unroll
    for (int i = 0; i < 32; ++i) {
      const int k = kp * 32 + i;
      const float sn = fe[k] * S[k * 128 + n] + fk[k] * vn;
      So[k * 128 + n] = sn;
      o += fq[k] * sn;
    }
    red[kp * 128 + n] = o;
    __syncthreads();
    if (tid < 128) OPRE[(size_t)row * 1024 + h * 128 + tid] = red[tid] + red[128 + tid] + red[256 + tid] + red[384 + tid];
    __syncthreads();
  } else {
    const float* cprev = p.state_conv + (size_t)b * 3 * 1536;
    if (tid < 384) {
      const int ty = tid >> 7, cc = tid & 127;
      const int ch = ty * 512 + h * 128 + cc;
      const float p0 = cprev[ch], p1 = cprev[1536 + ch], p2 = cprev[3072 + ch];
      const float nw = bf2f(PQ[(size_t)row * PQW + 1024 + ch]);
      const float s = p.conv_w[ch] * p0 + p.conv_w[1536 + ch] * p1 + p.conv_w[3072 + ch] * p2 + p.conv_w[4608 + ch] * nw;
      fq[ty * 128 + cc] = siluf_(s);
      p.out[O_CVS + (size_t)(b * 3 + 0) * 1536 + ch] = p1;
      p.out[O_CVS + (size_t)(b * 3 + 1) * 1536 + ch] = p2;
    }
    __syncthreads();
    if (w < 2) {
      const float a0 = fq[w * 128 + lane], a1 = fq[w * 128 + 64 + lane];
      const float ss = wave_sum(a0 * a0 + a1 * a1);
      if (lane == 0) sc[w] = ss;
    }
    __syncthreads();
    const float rq = rsqrtf(sc[0] + EPS) * 0.08838834764831845f;
    const float rk = rsqrtf(sc[1] + EPS);
    __syncthreads();
    if (tid < 128) fq[tid] *= rq;
    else if (tid < 256) fk[tid - 128] *= rk;
    __syncthreads();
    if (w == 0) {
      const float qk = wave_sum(fq[lane] * fk[lane] + fq[64 + lane] * fk[64 + lane]);
      if (lane == 0) sc[2] = qk;
    }
    const float eg = __expf(GDEC[(size_t)row * 4 + h]);
    const float beta = BETA[(size_t)row * 4 + h];
    const float* S = p.state_gdn + ((size_t)(b * 4 + h) * 128) * 128;
    float* So = p.out + O_GDS + ((size_t)(b * 4 + h) * 128) * 128;
    float sd[32];
    float ks_ = 0.f, qs_ = 0.f;
#pragma unroll
    for (int i = 0; i < 32; ++i) {
      const int k = kp * 32 + i;
      sd[i] = eg * S[k * 128 + n];
      ks_ += fk[k] * sd[i];
      qs_ += fq[k] * sd[i];
    }
    red[kp * 128 + n] = ks_;
    red[512 + kp * 128 + n] = qs_;
    __syncthreads();
    const float kS = red[n] + red[128 + n] + red[256 + n] + red[384 + n];
    const float delta = (fv[n] - kS) * beta;
#pragma unroll
    for (int i = 0; i < 32; ++i) {
      const int k = kp * 32 + i;
      So[k * 128 + n] = sd[i] + fk[k] * delta;
    }
    if (tid < 128) {
      const float qS = red[512 + n] + red[640 + n] + red[768 + n] + red[896 + n];
      OPRE[(size_t)row * 1024 + 512 + h * 128 + n] = qS + sc[2] * delta;
    }
    __syncthreads();
  }
}

__device__ void sample_block4(const Params& p, char* smem, int bid) {
  const int tid = opaque_tid(), lane = tid & 63, w = tid >> 6;
  const u16* PQ = (const u16*)(p.ws + W_PQ);
  const float* LF = (const float*)(p.ws + W_LF);
  const float* BETA = (const float*)(p.ws + W_BETA);
  const float* GDEC = (const float*)(p.ws + W_GDEC);
  float* OPRE = (float*)(p.ws + W_PQ);
  float* vec = (float*)smem;
  float* red = vec + 2048;
  float* sc = red + 1024;
  if (tid < 256) {
    const int j = tid >> 7, c = tid & 127;
    const int it = bid + 256 * j, b = (it >> 2) & 127, h = it & 3, row = MP + b;
    const float f = __expf(LF[(size_t)row * 512 + h * 128 + c]);
    vec[(j * 4 + 0) * 128 + c] = bf2f(PQ[(size_t)row * PQW + h * 128 + c]);
    vec[(j * 4 + 1) * 128 + c] = 1.f - f;
    vec[(j * 4 + 2) * 128 + c] = bf2f(PQ[(size_t)row * PQW + 512 + h * 128 + c]);
    vec[(j * 4 + 3) * 128 + c] = f;
  }
  for (int e = tid; e < 768; e += 512) {
    const int j = 2 + e / 384, r = e % 384, ty = r >> 7, cc = r & 127;
    const int it = bid + 256 * j, b = (it >> 2) & 127, h = it & 3, row = MP + b;
    const int ch = ty * 512 + h * 128 + cc;
    const float* cprev = p.state_conv + (size_t)b * 3 * 1536;
    const float p0 = cprev[ch], p1 = cprev[1536 + ch], p2 = cprev[3072 + ch];
    const float nw = bf2f(PQ[(size_t)row * PQW + 1024 + ch]);
    const float s = p.conv_w[ch] * p0 + p.conv_w[1536 + ch] * p1 + p.conv_w[3072 + ch] * p2 + p.conv_w[4608 + ch] * nw;
    vec[(j * 4 + ty) * 128 + cc] = siluf_(s);
    p.out[O_CVS + (size_t)(b * 3 + 0) * 1536 + ch] = p1;
    p.out[O_CVS + (size_t)(b * 3 + 1) * 1536 + ch] = p2;
  }
  __syncthreads();
  if (w < 4) {
    const int j = 2 + (w >> 1), which = w & 1;
    const float a0 = vec[(j * 4 + which) * 128 + lane], a1 = vec[(j * 4 + which) * 128 + 64 + lane];
    const float ss = wave_sum(a0 * a0 + a1 * a1);
    if (lane == 0) sc[j * 4 + which] = ss;
  }
  __syncthreads();
  {
    const int j = 2 + (tid >> 8), which = (tid >> 7) & 1, c = tid & 127;
    const float r = which == 0 ? rsqrtf(sc[j * 4 + 0] + EPS) * 0.08838834764831845f : rsqrtf(sc[j * 4 + 1] + EPS);
    vec[(j * 4 + which) * 128 + c] *= r;
  }
  __syncthreads();
  if (w < 2) {
    const int j = 2 + w;
    const float qk = wave_sum(vec[(j * 4 + 0) * 128 + lane] * vec[(j * 4 + 1) * 128 + lane] +
                              vec[(j * 4 + 0) * 128 + 64 + lane] * vec[(j * 4 + 1) * 128 + 64 + lane]);
    if (lane == 0) sc[j * 4 + 2] = qk;
  }
  __syncthreads();
  const int n = tid & 127, kp = tid >> 7;
  float cur[32], nxt[32];
  {
    const int it = bid, b = (it >> 2) & 127, h = it & 3;
    const float* S = p.state_hgrn + ((size_t)(b * 4 + h) * 128) * 128;
#pragma unroll
    for (int i = 0; i < 32; ++i) cur[i] = S[(kp * 32 + i) * 128 + n];
  }
#pragma unroll
  for (int j = 0; j < 4; ++j) {
    const int it = bid + 256 * j, b = (it >> 2) & 127, h = it & 3, row = MP + b;
    if (j < 3) {
      const int it2 = bid + 256 * (j + 1), b2 = (it2 >> 2) & 127, h2 = it2 & 3;
      const float* S2 = ((j + 1) < 2 ? p.state_hgrn : p.state_gdn) + ((size_t)(b2 * 4 + h2) * 128) * 128;
#pragma unroll
      for (int i = 0; i < 32; ++i) nxt[i] = S2[(kp * 32 + i) * 128 + n];
    }
    const float* fq = vec + (j * 4 + 0) * 128;
    const float* fk = vec + (j * 4 + 1) * 128;
    const float* fv = vec + (j * 4 + 2) * 128;
    const float* fe = vec + (j * 4 + 3) * 128;
    if (j < 2) {
      float* So = p.out + O_HGS + ((size_t)(b * 4 + h) * 128) * 128;
      const float vn = fv[n];
      float o = 0.f;
#pragma unroll
      for (int i = 0; i < 32; ++i) {
        const int k = kp * 32 + i;
        const float sn = fe[k] * cur[i] + fk[k] * vn;
        So[k * 128 + n] = sn;
        o += fq[k] * sn;
      }
      red[kp * 128 + n] = o;
      __syncthreads();
      if (tid < 128) OPRE[(size_t)row * 1024 + h * 128 + tid] = red[tid] + red[128 + tid] + red[256 + tid] + red[384 + tid];
      __syncthreads();
    } else {
      float* So = p.out + O_GDS + ((size_t)(b * 4 + h) * 128) * 128;
      const float eg = __expf(GDEC[(size_t)row * 4 + h]);
      const float beta = BETA[(size_t)row * 4 + h];
      float ks_ = 0.f, qs_ = 0.f;
#pragma unroll
      for (int i = 0; i < 32; ++i) {
        const int k = kp * 32 + i;
        cur[i] *= eg;
        ks_ += fk[k] * cur[i];
        qs_ += fq[k] * cur[i];
      }
      red[kp * 128 + n] = ks_;
      red[512 + kp * 128 + n] = qs_;
      __syncthreads();
      const float kS = red[n] + red[128 + n] + red[256 + n] + red[384 + n];
      const float delta = (fv[n] - kS) * beta;
#pragma unroll
      for (int i = 0; i < 32; ++i) {
        const int k = kp * 32 + i;
        So[k * 128 + n] = cur[i] + fk[k] * delta;
      }
      if (tid < 128) {
        const float qS = red[512 + n] + red[640 + n] + red[768 + n] + red[896 + n];
        OPRE[(size_t)row * 1024 + 512 + h * 128 + n] = qS + sc[j * 4 + 2] * delta;
      }
      __syncthreads();
    }
#pragma unroll
    for (int i = 0; i < 32; ++i) cur[i] = nxt[i];
  }
}

#define XB_TICKET(j) (3456 + 16 * (j))
__device__ void phase3(const Params& p, char* smem, int bid, int nb) {
  volatile LAS unsigned* st = (volatile LAS unsigned*)(unsigned)(size_t)(smem + LDS_BYTES - 16);
  unsigned* bar = (unsigned*)(p.ws + W_BAR);
  if (threadIdx.x == 0) {
    unsigned ok = (nb == 256) ? 1u : 0u, rank = 0u;
    const unsigned x = xb_xcc_id();
    unsigned npop = 0u;
    for (unsigned j = 0; j < 16; ++j) {
      const unsigned c = xb_ld(&bar[XB_XCNT(j)]);
      if (c != 0u) { ++npop; if (c != 32u) ok = 0u; if (j < x) ++rank; }
    }
    if (npop != 8u) ok = 0u;
    unsigned ticket = 0u;
    if (ok) ticket = xb_add(&bar[XB_TICKET(x)], 1u);
    st[2] = ok ? (0x100u | (rank << 5) | (ticket & 31u)) : 0u;
  }
  __syncthreads();
  const unsigned place = st[2];
  __syncthreads();
  if (place) {
    const int r = (place >> 5) & 7, t = place & 31;
    const int g = (t >> 2) * 8 + r;
    const int uu = (g << 2) | (t & 3);
    if (uu < 128) scan_unit<0>(p, smem, uu); else scan_unit<1>(p, smem, uu - 128);
    if (DUP_MASK & 256) { if (uu < 128) scan_unit<0>(p, smem, uu); else scan_unit<1>(p, smem, uu - 128); }
    if (uu < 128) {
      const int rankH = r * 16 + t;
      sample_block4(p, smem, rankH);
      sample_block4(p, smem, rankH + 128);
    }
    return;
  }
  for (int u = bid; u < 256; u += nb) {
    int uu = u;
    if (nb == 256) {
      const int xcd = u & 7, j = u >> 3;
      uu = ((xcd * 8 + (j >> 2)) << 2) | (j & 3);
    }
    if (uu < 128) scan_unit<0>(p, smem, uu); else scan_unit<1>(p, smem, uu - 128);
  }
  if (nb == 256) {
    if ((bid & 7) < 4) {
      const int rank = (bid >> 3) * 4 + (bid & 3);
      sample_block4(p, smem, rank);
      sample_block4(p, smem, rank + 128);
    }
  } else {
    for (int it = bid; it < 1024; it += nb) sample_item(p, smem, it);
  }
}

__device__ void phase4(const Params& p, int bid, int nb) {
  const int tid = opaque_tid(), lane = tid & 63, w = tid >> 6;
  const float* OPRE = (const float*)(p.ws + W_PQ);
  const u16* GATES = (const u16*)(p.ws + W_GATES);
  u16* A2 = (u16*)(p.ws + W_QS);
  constexpr int NG = MT / 8;
  for (int g = bid; g < NG; g += 2 * nb) {
    const bool two = (g + nb) < NG;
    const int rows[2] = {g * 8 + w, (two ? g + nb : g) * 8 + w};
    f32x4 v[2][4];
    u32x2 gt[2][4];
#pragma unroll
    for (int r = 0; r < 2; ++r)
#pragma unroll
      for (int i = 0; i < 4; ++i) {
        const int col = i * 256 + lane * 4;
        v[r][i] = *(const f32x4*)(OPRE + (size_t)rows[r] * 1024 + col);
        gt[r][i] = *(const u32x2*)(GATES + (size_t)rows[r] * 1024 + col);
      }
#pragma unroll
    for (int r = 0; r < 2; ++r) {
      if (r == 1 && !two) break;
#pragma unroll
      for (int i = 0; i < 4; ++i) {
        const int col = i * 256 + lane * 4;
        float ss = v[r][i][0] * v[r][i][0] + v[r][i][1] * v[r][i][1] + v[r][i][2] * v[r][i][2] + v[r][i][3] * v[r][i][3];
        ss += dpp_mov<0xB1, 0xf>(ss);
        ss += dpp_mov<0x4E, 0xf>(ss);
        ss += dpp_mov<0x141, 0xf>(ss);
        ss += dpp_mov<0x140, 0xf>(ss);
        ss += __shfl_xor(ss, 16, 64);
        const float rstd = rsqrtf(ss * (1.f / 128.f) + EPS);
        const f32x4 nw = *(const f32x4*)((col < 512 ? p.hg_norm : p.gdn_norm) + (col & 127));
        float gg[4];
        unpack4(gt[r][i], gg);
        *(u32x2*)(A2 + (size_t)rows[r] * LDK + col) =
            u32x2{pack2(v[r][i][0] * rstd * nw[0] * gg[0], v[r][i][1] * rstd * nw[1] * gg[1]),
                  pack2(v[r][i][2] * rstd * nw[2] * gg[2], v[r][i][3] * rstd * nw[3] * gg[3])};
      }
    }
  }
}

__device__ void phase6(const Params& p, int bid, int nb) {
  const int tid = opaque_tid(), lane = tid & 63, w = tid >> 6;
  constexpr int NG = MT / 8, NR = 4;
  for (int g = bid; g < NG; g += NR * nb) {
    float* y[NR];
    bool ok[NR];
    float4 xv[NR][4];
    float ss[NR];
#pragma unroll
    for (int r = 0; r < NR; ++r) {
      ok[r] = (g + r * nb) < NG;
      const int row = (ok[r] ? g + r * nb : g) * 8 + w;
      y[r] = row < MP ? p.out + O_YP + (size_t)row * 1024 : p.out + O_YS + (size_t)(row - MP) * 1024;
#pragma unroll
      for (int i = 0; i < 4; ++i) xv[r][i] = *(const float4*)(y[r] + i * 256 + lane * 4);
    }
#pragma unroll
    for (int r = 0; r < NR; ++r) {
      ss[r] = 0.f;
#pragma unroll
      for (int i = 0; i < 4; ++i) ss[r] += xv[r][i].x * xv[r][i].x + xv[r][i].y * xv[r][i].y + xv[r][i].z * xv[r][i].z + xv[r][i].w * xv[r][i].w;
      ss[r] = wave_sum(ss[r]);
    }
#pragma unroll
    for (int r = 0; r < NR; ++r) {
      if (ok[r]) {
        const float rstd = rsqrtf(ss[r] * (1.f / 1024.f) + EPS);
#pragma unroll
        for (int i = 0; i < 4; ++i) {
          const float4 nw = *(const float4*)(p.final_norm + i * 256 + lane * 4);
          float4 o;
          o.x = xv[r][i].x * rstd * nw.x; o.y = xv[r][i].y * rstd * nw.y; o.z = xv[r][i].z * rstd * nw.z; o.w = xv[r][i].w * rstd * nw.w;
          *(float4*)(y[r] + i * 256 + lane * 4) = o;
        }
      }
    }
  }
}


template <int PH>
__device__ __forceinline__ void run_phase(const Params& p, char* smem, int bid, int nb) {
  if (PH == 0) phase0(p, smem, bid, nb);
  else if (PH == 1) gemm_phase<0>(p, (const u16*)(p.ws + W_H), (const u16*)(p.ws + W_WINT), 16, smem, bid, nb);
  else if (PH == 2) phase2(p, smem, bid, nb);
  else if (PH == 3) phase3(p, smem, bid, nb);
  else if (PH == 4) phase4(p, bid, nb);
  else if (PH == 5) gemm_phase<1>(p, (const u16*)(p.ws + W_QS), (const u16*)(p.ws + W_WOUTT), 4, smem, bid, nb);
  else phase6(p, bid, nb);
}

#if MEGA
__global__ void __launch_bounds__(NTH) mega_kernel(Params p) {
  extern __shared__ __attribute__((aligned(16))) char smem[];
  cg::grid_group grid = cg::this_grid();
  const int bid = blockIdx.x, nb = gridDim.x;
  if (p.out == nullptr) grid.sync();
  volatile LAS unsigned* st = (volatile LAS unsigned*)(unsigned)(size_t)(smem + LDS_BYTES - 16);
  if (threadIdx.x == 0) { st[0] = 0u; st[1] = 0u; }
  __syncthreads();
  const XcdBarrier xb = xcd_barrier_post((unsigned*)(p.ws + W_BAR), st);
#define GSYNC() xcd_barrier(xb)
#define RUNP(k) run_phase<k>(p, smem, bid, nb); GSYNC(); if (DUP_MASK & (1 << k)) { run_phase<k>(p, smem, bid, nb); GSYNC(); }
  RUNP(0)
  if (PROBE_SYNC) { for (int i_ = 0; i_ < PROBE_SYNC; ++i_) GSYNC(); }
  RUNP(1)
  if (PROBE_GEMM) { gemm_phase<0, PROBE_GEMM>(p, (const u16*)(p.ws + W_H), (const u16*)(p.ws + W_WINT), 16, smem, bid, nb); GSYNC(); }
  RUNP(2) RUNP(3) RUNP(4) RUNP(5)
#undef RUNP
#undef GSYNC
  run_phase<6>(p, smem, bid, nb);
}
#else
template <int PH>
__global__ void __launch_bounds__(NTH) phase_kernel(Params p) {
  extern __shared__ __attribute__((aligned(16))) char smem[];
  run_phase<PH>(p, smem, blockIdx.x, gridDim.x);
}
template <int PH>
static void launch_phase(const Params& p, int grid, hipStream_t stream) {
  hipFuncSetAttribute((const void*)phase_kernel<PH>, hipFuncAttributeMaxDynamicSharedMemorySize, (int)LDS_BYTES);
  hipLaunchKernelGGL(phase_kernel<PH>, dim3(grid), dim3(NTH), LDS_BYTES, stream, p);
}
#endif

extern "C" void kernel_launch(void* const* d_in, const int* in_sizes, int n_in, void* d_out, int out_size,
                              void* d_ws, size_t ws_size, hipStream_t stream) {
  Params p{};
  p.x_prompt = (const float*)d_in[0];
  p.x_sample = (const float*)d_in[1];
  p.state_hgrn = (const float*)d_in[2];
  p.state_gdn = (const float*)d_in[3];
  p.state_conv = (const float*)d_in[4];
  p.norm_w = (const float*)d_in[5];
  p.w_in = (const float*)d_in[6];
  p.lb_logits = (const float*)d_in[7];
  p.conv_w = (const float*)d_in[8];
  p.a_log = (const float*)d_in[9];
  p.dt_bias = (const float*)d_in[10];
  p.hg_norm = (const float*)d_in[11];
  p.gdn_norm = (const float*)d_in[12];
  p.w_out = (const float*)d_in[13];
  p.final_norm = (const float*)d_in[14];
  p.out = (float*)d_out;
  p.ws = (char*)d_ws;
  if (ws_size < W_END) { fprintf(stderr, "workspace too small: %zu < %zu\n", ws_size, (size_t)W_END); return; }
#if MEGA
  static int grid_blocks = 0;
  if (!grid_blocks) {
    int dev = 0, cus = 0, per_cu = 0;
    hipGetDevice(&dev);
    hipDeviceGetAttribute(&cus, hipDeviceAttributeMultiprocessorCount, dev);
    hipFuncSetAttribute((const void*)mega_kernel, hipFuncAttributeMaxDynamicSharedMemorySize, (int)LDS_BYTES);
    hipOccupancyMaxActiveBlocksPerMultiprocessor(&per_cu, mega_kernel, NTH, LDS_BYTES);
    if (per_cu < 1) per_cu = 1;
    grid_blocks = cus * per_cu;
  }
  (void)hipMemsetAsync((char*)d_ws + W_BAR, 0, 16384, stream);
  void* args[] = {&p};
  hipError_t e = hipLaunchCooperativeKernel((void*)mega_kernel, dim3(grid_blocks), dim3(NTH), args, LDS_BYTES, stream);
  if (e != hipSuccess) fprintf(stderr, "cooperative launch failed: %s (grid %d)\n", hipGetErrorString(e), grid_blocks);
#else
  const int grid = 256;
  launch_phase<0>(p, grid, stream);
  launch_phase<1>(p, grid, stream);
  launch_phase<2>(p, grid, stream);
  launch_phase<3>(p, grid, stream);
  launch_phase<4>(p, grid, stream);
  launch_phase<5>(p, grid, stream);
  launch_phase<6>(p, grid, stream);
#endif
}
```

```cpp
#include <hip/hip_runtime.h>
#include <hip/hip_cooperative_groups.h>
#include <cstdio>
namespace cg = cooperative_groups;

#ifndef MEGA
#define MEGA 1
#define PROBE_GEMM 0
#define PROBE_SYNC 0
#define PROBE_G 0
#define DUP_MASK 0
#endif

typedef unsigned short u16;
using bf16x8 = __attribute__((ext_vector_type(8))) short;
using f32x4 = __attribute__((ext_vector_type(4))) float;
using u32x4 = __attribute__((ext_vector_type(4))) unsigned;
using u32x2 = __attribute__((ext_vector_type(2))) unsigned;

#define NTH 512
constexpr int MP = 16384, MS = 128, MT = 16512, DM = 1024, DIN = 4104, PQW = 2560;
constexpr float EPS = 1e-6f;
constexpr int LDK = 1088;
constexpr size_t LDS_BYTES = 139264;

constexpr size_t O_YP = 0, O_YS = 16777216, O_HGP = 16908288, O_GDP = 17432576, O_CVP = 17956864,
                 O_HGS = 17993728, O_GDS = 26382336, O_CVS = 34770944;
constexpr size_t W_WINT = 0;
constexpr size_t W_WOUTT = W_WINT + (size_t)4096 * LDK * 2;
constexpr size_t W_BETA = W_WOUTT + (size_t)1024 * LDK * 2;
constexpr size_t W_GDEC = W_BETA + 264192;
constexpr size_t W_DVEC = W_GDEC + 264192;
constexpr size_t W_DSC = W_DVEC + 1048576;
constexpr size_t W_PQ = W_DSC + 4096;
constexpr size_t W_GATES = W_PQ + 84541440;
constexpr size_t W_H = W_GATES + 33816576;
constexpr size_t W_QS = W_H + (size_t)MT * LDK * 2;
constexpr size_t W_MNEG = W_QS + 33554432;
constexpr size_t W_LF = W_MNEG + 33554432;
constexpr size_t W_BAR = W_LF + 33816576;
constexpr size_t W_END = W_BAR + 16384;

struct Params {
  const float *x_prompt, *x_sample, *state_hgrn, *state_gdn, *state_conv, *norm_w, *w_in, *lb_logits,
      *conv_w, *a_log, *dt_bias, *hg_norm, *gdn_norm, *w_out, *final_norm;
  float* out;
  char* ws;
};

__device__ __forceinline__ int opaque_tid() { int t = threadIdx.x; asm volatile("" : "+v"(t)); return t; }
typedef __bf16 bf16x2_t __attribute__((ext_vector_type(2)));
typedef float f32x2_t __attribute__((ext_vector_type(2)));
__device__ __forceinline__ u16 f2bf(float x) { return __builtin_bit_cast(u16, (__bf16)x); }
__device__ __forceinline__ float bf2f(u16 h) { return __uint_as_float(((unsigned)h) << 16); }
__device__ __forceinline__ unsigned pack2(float a, float b) {
  f32x2_t v = {a, b};
  return __builtin_bit_cast(unsigned, __builtin_convertvector(v, bf16x2_t));
}
template <int CTRL, int ROWMASK>
__device__ __forceinline__ float dpp_mov(float v) {
  return __builtin_bit_cast(float, __builtin_amdgcn_update_dpp(0, __builtin_bit_cast(int, v), CTRL, ROWMASK, 0xf, false));
}
__device__ __forceinline__ float wave_sum(float v) {
  v += dpp_mov<0xB1, 0xf>(v);
  v += dpp_mov<0x4E, 0xf>(v);
  v += dpp_mov<0x141, 0xf>(v);
  v += dpp_mov<0x140, 0xf>(v);
  v += dpp_mov<0x142, 0xa>(v);
  v += dpp_mov<0x143, 0xc>(v);
  return __builtin_bit_cast(float, __builtin_amdgcn_readlane(__builtin_bit_cast(int, v), 63));
}
__device__ __forceinline__ float sigmoidf_(float x) { return 1.f / (1.f + __expf(-x)); }
__device__ __forceinline__ float siluf_(float x) { return x / (1.f + __expf(-x)); }
__device__ __forceinline__ f32x4 mfma16(bf16x8 a, bf16x8 b, f32x4 c) {
  return __builtin_amdgcn_mfma_f32_16x16x32_bf16(a, b, c, 0, 0, 0);
}
__device__ __forceinline__ bf16x8 frag(const u16* base, int row0, int stride, int koff, int lane) {
  return *(const bf16x8*)(base + (row0 + (lane & 15)) * stride + koff + (lane >> 4) * 8);
}

__device__ __forceinline__ void quad_transpose(float (&v)[4], int lane) {
  {
    const bool b = lane & 1;
    float s0 = b ? v[0] : v[1], s1 = b ? v[2] : v[3];
    float r0 = dpp_mov<0xB1, 0xf>(s0), r1 = dpp_mov<0xB1, 0xf>(s1);
    if (b) { v[0] = r0; v[2] = r1; } else { v[1] = r0; v[3] = r1; }
  }
  {
    const bool b = lane & 2;
    float s0 = b ? v[0] : v[2], s1 = b ? v[1] : v[3];
    float r0 = dpp_mov<0x4E, 0xf>(s0), r1 = dpp_mov<0x4E, 0xf>(s1);
    if (b) { v[0] = r0; v[1] = r1; } else { v[2] = r0; v[3] = r1; }
  }
}
__device__ __forceinline__ void store4_bf16(u16* dst, const float (&v)[4]) {
  *(u32x2*)dst = u32x2{pack2(v[0], v[1]), pack2(v[2], v[3])};
}
__device__ void phase0(const Params& p, char* smem, int bid, int nb) {
  const int tid = opaque_tid(), lane = tid & 63, w = tid >> 6;
  u16* WinT = (u16*)(p.ws + W_WINT);
  u16* WoutT = (u16*)(p.ws + W_WOUTT);
  u16* H = (u16*)(p.ws + W_H);
  float* BETA = (float*)(p.ws + W_BETA);
  float* GDEC = (float*)(p.ws + W_GDEC);
  float* tl = (float*)smem;
  for (int t = bid; t < 1280; t += nb) {
    const float* src; int sstride; u16* dst; int kt, nt;
    if (t < 1024) { src = p.w_in; sstride = DIN; dst = WinT; kt = t >> 6; nt = t & 63; }
    else { int u = t - 1024; src = p.w_out; sstride = 1024; dst = WoutT; kt = u >> 4; nt = u & 15; }
#pragma unroll
    for (int i = 0; i < 8; ++i) {
      int idx = tid + 512 * i; int kk = idx >> 6, nn = idx & 63;
      tl[kk * 65 + nn] = src[(size_t)(kt * 64 + kk) * sstride + nt * 64 + nn];
    }
    __syncthreads();
    {
      int nn = tid >> 3, k8 = (tid & 7) * 8;
      unsigned pk[4];
#pragma unroll
      for (int e = 0; e < 4; ++e) pk[e] = pack2(tl[(k8 + 2 * e) * 65 + nn], tl[(k8 + 2 * e + 1) * 65 + nn]);
      *(uint4*)(dst + (size_t)(nt * 64 + nn) * LDK + kt * 64 + k8) = make_uint4(pk[0], pk[1], pk[2], pk[3]);
    }
    __syncthreads();
  }
  float* W8s = (float*)smem;
  for (int idx = tid; idx < 8192; idx += 512) {
    int j = idx & 7, k = idx >> 3;
    W8s[j * 1024 + k] = p.w_in[(size_t)k * DIN + 4096 + j];
  }
  __syncthreads();
  for (int g = bid; g < MT / 8; g += nb) {
    int row = g * 8 + w;
    const float* x = row < MP ? p.x_prompt + (size_t)row * 1024 : p.x_sample + (size_t)(row - MP) * 1024;
    float4 xv[4];
    float ss = 0.f;
#pragma unroll
    for (int i = 0; i < 4; ++i) {
      xv[i] = *(const float4*)(x + i * 256 + lane * 4);
      ss += xv[i].x * xv[i].x + xv[i].y * xv[i].y + xv[i].z * xv[i].z + xv[i].w * xv[i].w;
    }
    ss = wave_sum(ss);
    float rstd = rsqrtf(ss * (1.f / 1024.f) + EPS);
    float d0 = 0, d1 = 0, d2 = 0, d3 = 0, d4 = 0, d5 = 0, d6 = 0, d7 = 0;
#pragma unroll
    for (int i = 0; i < 4; ++i) {
      float4 nw = *(const float4*)(p.norm_w + i * 256 + lane * 4);
      float4 hv;
      hv.x = xv[i].x * rstd * nw.x; hv.y = xv[i].y * rstd * nw.y; hv.z = xv[i].z * rstd * nw.z; hv.w = xv[i].w * rstd * nw.w;
      *(uint2*)(H + (size_t)row * LDK + i * 256 + lane * 4) = make_uint2(pack2(hv.x, hv.y), pack2(hv.z, hv.w));
#define GDOT(j, dj) { float4 wv = *(const float4*)(W8s + j * 1024 + i * 256 + lane * 4); dj += hv.x * wv.x + hv.y * wv.y + hv.z * wv.z + hv.w * wv.w; }
      GDOT(0, d0) GDOT(1, d1) GDOT(2, d2) GDOT(3, d3) GDOT(4, d4) GDOT(5, d5) GDOT(6, d6) GDOT(7, d7)
#undef GDOT
    }
    d0 = wave_sum(d0); d1 = wave_sum(d1); d2 = wave_sum(d2); d3 = wave_sum(d3);
    d4 = wave_sum(d4); d5 = wave_sum(d5); d6 = wave_sum(d6); d7 = wave_sum(d7);
    if (lane < 4) {
      float gb = lane == 0 ? d0 : lane == 1 ? d1 : lane == 2 ? d2 : d3;
      float ga = lane == 0 ? d4 : lane == 1 ? d5 : lane == 2 ? d6 : d7;
      BETA[row * 4 + lane] = 1.f / (1.f + expf(-gb));
      float z = ga + p.dt_bias[lane];
      float sp = z > 20.f ? z : log1pf(expf(z));
      GDEC[row * 4 + lane] = -expf(p.a_log[lane]) * sp;
    }
  }
  __syncthreads();
}

__device__ __forceinline__ int lds_byte2(int r, int c) {
  int st = (r >> 4) * 2 + (c >> 5), ob = (r & 15) * 64 + (c & 31) * 2;
  return st * 1024 + (ob ^ (((ob >> 9) & 1) << 5));
}
__device__ __forceinline__ void stage_rc2(int b, int& R, int& C) {
  int st = b >> 10, sb = b & 1023, swz = sb ^ (((sb >> 9) & 1) << 5);
  R = (st >> 1) * 16 + swz / 64;
  C = (st & 1) * 32 + (swz % 64) / 2;
}
template <int EPI, int SEC>
__device__ __forceinline__ void epi_store4(const Params& p, int row, int col4, const float (&v)[4]) {
  if (EPI == 0) {
    u16* PQ = (u16*)(p.ws + W_PQ);
    u16* GATES = (u16*)(p.ws + W_GATES);
    float* LF = (float*)(p.ws + W_LF);
    const int sec = SEC >= 0 ? SEC : (col4 >> 9);
    if (sec == 0) {
      *(uint2*)(PQ + (size_t)row * PQW + col4) = make_uint2(pack2(v[0], v[1]), pack2(v[2], v[3]));
    } else if (sec == 1) {
      const int cc = col4 - 512;
      const f32x4 l0 = *(const f32x4*)(p.lb_logits + cc), l1 = *(const f32x4*)(p.lb_logits + 512 + cc);
      f32x4 o;
#pragma unroll
      for (int i = 0; i < 4; ++i) {
        const float lbv = 1.f / (1.f + __expf(l1[i] - l0[i]));
        o[i] = __logf(lbv + (1.f - lbv) / (1.f + __expf(-v[i])));
      }
      *(f32x4*)(LF + (size_t)row * 512 + cc) = o;
    } else if (sec == 2) {
      *(uint2*)(PQ + (size_t)row * PQW + 512 + (col4 - 1024)) = make_uint2(pack2(v[0], v[1]), pack2(v[2], v[3]));
    } else if (sec == 3 || sec == 7) {
      const int cc = sec == 3 ? col4 - 1536 : 512 + col4 - 3584;
      *(uint2*)(GATES + (size_t)row * 1024 + cc) =
          make_uint2(pack2(v[0] / (1.f + __expf(-v[0])), v[1] / (1.f + __expf(-v[1]))),
                     pack2(v[2] / (1.f + __expf(-v[2])), v[3] / (1.f + __expf(-v[3]))));
    } else {
      const int cc = col4 - 2048;
      *(uint2*)(PQ + (size_t)row * PQW + 1024 + cc) = make_uint2(pack2(v[0], v[1]), pack2(v[2], v[3]));
      if (row < MP) {
        const int tt = row & 2047;
        if (tt >= 2045) *(f32x4*)(p.out + O_CVP + (size_t)((row >> 11) * 3 + (tt - 2045)) * 1536 + cc) = f32x4{v[0], v[1], v[2], v[3]};
      } else {
        *(f32x4*)(p.out + O_CVS + (size_t)((row - MP) * 3 + 2) * 1536 + cc) = f32x4{v[0], v[1], v[2], v[3]};
      }
    }
  } else {
    const float* xr = row < MP ? p.x_prompt + (size_t)row * 1024 : p.x_sample + (size_t)(row - MP) * 1024;
    float* yr = row < MP ? p.out + O_YP + (size_t)row * 1024 : p.out + O_YS + (size_t)(row - MP) * 1024;
    const f32x4 xv = *(const f32x4*)(xr + col4);
    *(f32x4*)(yr + col4) = f32x4{xv[0] + v[0], xv[1] + v[1], xv[2] + v[2], xv[3] + v[3]};
  }
}

template <int EPI, int MODE = 0>
__device__ void gemm_phase(const Params& p, const u16* __restrict__ A, const u16* __restrict__ Bt, int ntn,
                           char* smem, int bid, int nb) {
  const int tid = opaque_tid(), lane = tid & 63, wid = tid >> 6;
  const int wr = wid >> 2, wc = wid & 3, fr = lane & 15, fq = lane >> 4;
  constexpr int TILE_B = 256 * 64 * 2, STAGE_B = 2 * TILE_B;
  int sR0, sC0;
  stage_rc2(wid * 1024 + lane * 16, sR0, sC0);
  const unsigned goff = (unsigned)(sR0 * LDK + sC0);
  const unsigned lbase = (unsigned)(size_t)smem + (unsigned)(wid * 1024);
  const int aoff = (wr * 16) * 1024 + ((fr * 64 + fq * 16) ^ ((((fr * 64 + fq * 16) >> 9) & 1) << 5));
  const int boff = TILE_B + (wc * 8) * 1024 + ((fr * 64 + fq * 16) ^ ((((fr * 64 + fq * 16) >> 9) & 1) << 5));
  const int ntiles = 64 * ntn;
  auto tile_mn = [&](int tile, int& tm, int& tn) {
    const int rnd = tile >> 8, t = tile & 255, xcd = t & 7, j = t >> 3;
    if (ntn == 16) { tm = rnd * 16 + (xcd >> 1) * 4 + (j & 3); tn = ((xcd & 1) * 8 + (j >> 2) + (rnd & 1) * 2 + (rnd >> 1) * 8) & 15; }
    else { tm = xcd * 8 + (j & 7); tn = j >> 3; }
  };
  bool staged = false;
  for (int tile = bid; tile < ntiles; tile += nb) {
    int tm, tn;
    tile_mn(tile, tm, tn);
    const u16* Ab = A + (size_t)tm * 256 * LDK;
    const u16* Bb = Bt + (size_t)tn * 256 * LDK;
    f32x4 acc[8][4];
#pragma unroll
    for (int m = 0; m < 8; ++m)
#pragma unroll
      for (int n = 0; n < 4; ++n) acc[m][n] = f32x4{0.f, 0.f, 0.f, 0.f};
#define G_STAGE(buf, kt) { _Pragma("unroll") for (int i = 0; i < 4; ++i) { \
      __builtin_amdgcn_global_load_lds((const unsigned*)(Ab + (goff + (unsigned)(i * 64 * LDK + (kt) * 64))), \
          (__attribute__((address_space(3))) unsigned*)(lbase + (buf) * STAGE_B + i * 8192), 16, 0, 0); \
      __builtin_amdgcn_global_load_lds((const unsigned*)(Bb + (goff + (unsigned)(i * 64 * LDK + (kt) * 64))), \
          (__attribute__((address_space(3))) unsigned*)(lbase + (buf) * STAGE_B + TILE_B + i * 8192), 16, 0, 0); } }
#define G_PIECE_A(buf, kt, i) __builtin_amdgcn_global_load_lds((const unsigned*)(Ab + (goff + (unsigned)((i) * 64 * LDK + (kt) * 64))), \
          (__attribute__((address_space(3))) unsigned*)(lbase + (buf) * STAGE_B + (i) * 8192), 16, 0, 0)
#define G_PIECE_B(buf, kt, i) __builtin_amdgcn_global_load_lds((const unsigned*)(Bb + (goff + (unsigned)((i) * 64 * LDK + (kt) * 64))), \
          (__attribute__((address_space(3))) unsigned*)(lbase + (buf) * STAGE_B + TILE_B + (i) * 8192), 16, 0, 0)
    if (!staged) G_STAGE(0, 0);
    asm volatile("s_waitcnt vmcnt(0)" ::: "memory");
    __syncthreads();
    for (int t = 0; t < 16; ++t) {
      const int cur = t & 1;
      const bool more = (MODE != 2) && (t + 1 < 16);
      const char* sA = smem + cur * STAGE_B + aoff;
      const char* sB = smem + cur * STAGE_B + boff;
#pragma unroll
      for (int ks = 0; ks < 2; ++ks) {
        bf16x8 At[8], Bf[4];
#pragma unroll
        for (int m = 0; m < 8; ++m) At[m] = *(const bf16x8*)(sA + (m * 2 + ks) * 1024);
#pragma unroll
        for (int n = 0; n < 4; ++n) Bf[n] = *(const bf16x8*)(sB + (n * 2 + ks) * 1024);
        if (MODE != 3) {
#pragma unroll
          for (int m = 0; m < 8; ++m) {
#pragma unroll
            for (int n = 0; n < 4; ++n) acc[m][n] = mfma16(At[m], Bf[n], acc[m][n]);
            if (ks == 0 && more) {
              if (m < 4) G_PIECE_A(cur ^ 1, t + 1, m); else G_PIECE_B(cur ^ 1, t + 1, m - 4);
              __builtin_amdgcn_sched_barrier(0);
            }
          }
        } else {
          if (ks == 0 && more) G_STAGE(cur ^ 1, t + 1);
#pragma unroll
          for (int m = 0; m < 8; ++m) acc[m][0][0] += __builtin_bit_cast(float, (int)At[m][0]);
#pragma unroll
          for (int n = 0; n < 4; ++n) acc[0][n][1] += __builtin_bit_cast(float, (int)Bf[n][0]);
        }
        __builtin_amdgcn_sched_barrier(0);
      }
      asm volatile("s_waitcnt vmcnt(0)" ::: "memory");
      __syncthreads();
    }
    staged = false;
    if (tile + nb < ntiles) {
      int tm2, tn2;
      tile_mn(tile + nb, tm2, tn2);
      const u16* Ab2 = A + (size_t)tm2 * 256 * LDK;
      const u16* Bb2 = Bt + (size_t)tn2 * 256 * LDK;
      { const u16* Ab = Ab2; const u16* Bb = Bb2; G_STAGE(0, 0); }
      staged = true;
    }
#undef G_STAGE
#undef G_PIECE_A
#undef G_PIECE_B
    if (MODE != 0 && MODE != 5) {
      float chk = 0.f;
#pragma unroll
      for (int m = 0; m < 8; ++m)
#pragma unroll
        for (int n = 0; n < 4; ++n) chk += acc[m][n][0] + acc[m][n][1] + acc[m][n][2] + acc[m][n][3];
      if (chk == 1.2345e-30f) p.out[0] = chk;
    } else
    {
      int t2 = threadIdx.x;
      asm volatile("" : "+v"(t2));
      const int lane2 = t2 & 63, wid2 = t2 >> 6;
      const int rbase = tm * 256 + (wid2 >> 2) * 128 + (lane2 >> 4) * 4 + (lane2 & 3);
      const int cbase = tn * 256 + (wid2 & 3) * 64 + (lane2 & 12);
#define EPI_LOOP(SEC) { _Pragma("unroll") for (int m = 0; m < 8; ++m) { _Pragma("unroll") for (int n = 0; n < 4; ++n) { \
          float v[4] = {acc[m][n][0], acc[m][n][1], acc[m][n][2], acc[m][n][3]}; \
          quad_transpose(v, lane2); \
          epi_store4<EPI, SEC>(p, rbase + m * 16, cbase + n * 16, v); } } }
      if (EPI == 0) {
        const int sec = tn >> 1;
        if (sec == 1) {
          float* LF = (float*)(p.ws + W_LF);
          float lbv[4][4];
#pragma unroll
          for (int n = 0; n < 4; ++n) {
            const int cc = cbase + n * 16 - 512;
            const f32x4 l0 = *(const f32x4*)(p.lb_logits + cc), l1 = *(const f32x4*)(p.lb_logits + 512 + cc);
#pragma unroll
            for (int e = 0; e < 4; ++e) lbv[n][e] = 1.f / (1.f + __expf(l1[e] - l0[e]));
          }
#pragma unroll
          for (int m = 0; m < 8; ++m)
#pragma unroll
            for (int n = 0; n < 4; ++n) {
              float v[4] = {acc[m][n][0], acc[m][n][1], acc[m][n][2], acc[m][n][3]};
              quad_transpose(v, lane2);
              f32x4 o;
#pragma unroll
              for (int e = 0; e < 4; ++e) o[e] = __logf(lbv[n][e] + (1.f - lbv[n][e]) * __builtin_amdgcn_rcpf(1.f + __expf(-v[e])));
              *(f32x4*)(LF + (size_t)(rbase + m * 16) * 512 + (cbase + n * 16 - 512)) = o;
            }
        } else {
          const bool gate = (sec == 3 || sec == 7);
          u16* dstb; int dstride, dcol;
          const int c0 = tn * 256 + (wid2 & 3) * 64;
          if (gate) { dstb = (u16*)(p.ws + W_GATES); dstride = 1024; dcol = sec == 3 ? c0 - 1536 : 512 + c0 - 3584; }
          else { dstb = (u16*)(p.ws + W_PQ); dstride = PQW; dcol = sec == 0 ? c0 : sec == 2 ? 512 + c0 - 1024 : 1024 + c0 - 2048; }
          char* ebuf = smem + STAGE_B + wid2 * 8192;
          const int wrow = (lane2 >> 4) * 4 + (lane2 & 3), wcol = (lane2 & 12);
          const int row00 = tm * 256 + (wid2 >> 2) * 128;
#pragma unroll
          for (int hf = 0; hf < 2; ++hf) {
#pragma unroll
            for (int m = 0; m < 4; ++m)
#pragma unroll
              for (int n = 0; n < 4; ++n) {
                float v[4] = {acc[hf * 4 + m][n][0], acc[hf * 4 + m][n][1], acc[hf * 4 + m][n][2], acc[hf * 4 + m][n][3]};
                if (gate) {
#pragma unroll
                  for (int e = 0; e < 4; ++e) v[e] = v[e] / (1.f + __expf(-v[e]));
                }
                quad_transpose(v, lane2);
                const int rl = m * 16 + wrow, cl = n * 16 + wcol;
                *(u32x2*)(ebuf + rl * 128 + ((cl * 2) ^ ((rl & 7) << 4))) = u32x2{pack2(v[0], v[1]), pack2(v[2], v[3])};
                if (sec >= 4 && sec <= 6) {
                  const int row = row00 + hf * 64 + rl, cc = c0 - 2048 + cl;
                  const int tt = row & 2047;
                  if (tt >= 2045) *(f32x4*)(p.out + O_CVP + (size_t)((row >> 11) * 3 + (tt - 2045)) * 1536 + cc) = f32x4{v[0], v[1], v[2], v[3]};
                }
              }
            asm volatile("s_waitcnt lgkmcnt(0)" ::: "memory");
#pragma unroll
            for (int i = 0; i < 8; ++i) {
              const int rl = i * 8 + (lane2 >> 3), ch = lane2 & 7;
              const u32x4 d = *(const u32x4*)(ebuf + rl * 128 + ((ch ^ (rl & 7)) << 4));
              *(u32x4*)(dstb + (size_t)(row00 + hf * 64 + rl) * dstride + dcol + ch * 8) = d;
            }
            asm volatile("s_waitcnt lgkmcnt(0)" ::: "memory");
          }
        }
      } else EPI_LOOP(0)
#undef EPI_LOOP
    }
  }
  const int nunits = MODE == 0 ? ntn * 16 : 0;
  int t3 = threadIdx.x;
  asm volatile("" : "+v"(t3));
  for (int u = bid; u < nunits; u += nb) {
    const int lane = t3 & 63, wid = t3 >> 6, fr = lane & 15, fq = lane >> 4;
    const u16* ar = A + (size_t)(MP + wid * 16 + fr) * LDK + fq * 8;
    const u16* br = Bt + (size_t)(u * 16 + fr) * LDK + fq * 8;
    f32x4 acc0 = {0.f, 0.f, 0.f, 0.f}, acc1 = {0.f, 0.f, 0.f, 0.f};
#pragma unroll 4
    for (int ks = 0; ks < 32; ks += 2) {
      const bf16x8 a0 = *(const bf16x8*)(ar + ks * 32), b0 = *(const bf16x8*)(br + ks * 32);
      const bf16x8 a1 = *(const bf16x8*)(ar + ks * 32 + 32), b1 = *(const bf16x8*)(br + ks * 32 + 32);
      acc0 = mfma16(a0, b0, acc0);
      acc1 = mfma16(a1, b1, acc1);
    }
    float v[4] = {acc0[0] + acc1[0], acc0[1] + acc1[1], acc0[2] + acc1[2], acc0[3] + acc1[3]};
    quad_transpose(v, lane);
    epi_store4<EPI, -1>(p, MP + wid * 16 + fq * 4 + (lane & 3), u * 16 + (fr & ~3), v);
  }
  __syncthreads();
}

#define XB_TMO      128
#define XB_XCNT(j)  (256  + 64 * (j))
#define XB_XSUB(j)  (1280 + 64 * (j))
#define XB_XGEN(j)  (2304 + 64 * (j))
#define XB_TOP      3328
#define XB_TOPGEN   3392
#define XCD_BAR_WORDS 3456
#define XB_SPIN_CAP (1u << 18)
#define LAS __attribute__((address_space(3)))
__device__ __forceinline__ unsigned xb_ld(unsigned* p)              { return __hip_atomic_load(p, __ATOMIC_RELAXED, __HIP_MEMORY_SCOPE_AGENT); }
__device__ __forceinline__ unsigned xb_add(unsigned* p, unsigned v) { return __hip_atomic_fetch_add(p, v, __ATOMIC_RELAXED, __HIP_MEMORY_SCOPE_AGENT); }
__device__ __forceinline__ unsigned xb_xcc_id() { return (unsigned)__builtin_amdgcn_s_getreg((3 << 11) | 20) & 0xFu; }
#define XB_SPIN(cond, bar) do { unsigned _sp = 0; while (cond) { __builtin_amdgcn_s_sleep(1); \
    if ((++_sp & 255u) == 0u) { if (xb_ld(&(bar)[XB_TMO])) break; if (_sp > XB_SPIN_CAP) { atomicAdd(&(bar)[XB_TMO], 1u); break; } } } } while (0)
struct XcdBarrier { unsigned* bar; unsigned x; volatile LAS unsigned* st; };
__device__ __forceinline__ XcdBarrier xcd_barrier_post(unsigned* bar, volatile LAS unsigned* st) {
  XcdBarrier b; b.bar = bar; b.x = xb_xcc_id(); b.st = st;
  if (threadIdx.x == 0) (void)xb_add(&bar[XB_XCNT(b.x)], 1u);
  return b;
}
__device__ __forceinline__ void xcd_barrier_complete(unsigned* bar, unsigned x, unsigned& nloc, unsigned& nx) {
  const unsigned G = gridDim.x * gridDim.y * gridDim.z;
  unsigned sum, cnt, mine, sp = 0u;
  for (;;) {
    sum = 0u; cnt = 0u; mine = 0u;
#pragma unroll
    for (unsigned j = 0; j < 16; ++j) { const unsigned c = xb_ld(&bar[XB_XCNT(j)]); sum += c; cnt += (c > 0u) ? 1u : 0u; mine = (j == x) ? c : mine; }
    if (sum == G) break;
    __builtin_amdgcn_s_sleep(1);
    if ((++sp & 255u) == 0u) { if (xb_ld(&bar[XB_TMO])) break; if (sp > XB_SPIN_CAP) { atomicAdd(&bar[XB_TMO], 1u); break; } }
  }
  nloc = mine > 0u ? mine : 1u; nx = cnt > 0u ? cnt : 1u;
}
__device__ __forceinline__ void xcd_barrier(const XcdBarrier& b) {
  asm volatile("s_waitcnt vmcnt(0)" ::: "memory");
  __syncthreads();
  if (threadIdx.x == 0) {
    unsigned* bar = b.bar;
    __builtin_amdgcn_s_waitcnt(0);
    unsigned nloc = b.st[0], nx = b.st[1];
    if (nloc == 0u) { xcd_barrier_complete(bar, b.x, nloc, nx); b.st[0] = nloc; b.st[1] = nx; }
    const unsigned old = xb_add(&bar[XB_XSUB(b.x)], 1u);
    const unsigned gen = old / nloc;
    if (old + 1u == (gen + 1u) * nloc) {
      __builtin_amdgcn_fence(__ATOMIC_RELEASE, "agent");
      asm volatile("s_waitcnt vmcnt(0)" ::: "memory");
      const unsigned og = xb_add(&bar[XB_TOP], 1u);
      const unsigned tg = og / nx;
      if (og + 1u == (tg + 1u) * nx) xb_add(&bar[XB_TOPGEN], 1u);
      else XB_SPIN(xb_ld(&bar[XB_TOPGEN]) == tg, bar);
      __builtin_amdgcn_fence(__ATOMIC_ACQUIRE, "agent");
      xb_add(&bar[XB_XGEN(b.x)], 1u);
      asm volatile("s_waitcnt vmcnt(0)" ::: "memory");
    } else {
      XB_SPIN(xb_ld(&bar[XB_XGEN(b.x)]) == gen, bar);
      __builtin_amdgcn_fence(__ATOMIC_ACQUIRE, "agent");
      asm volatile("s_waitcnt vmcnt(0)" ::: "memory");
    }
  }
  __syncthreads();
}

#define RAW_BARRIER() do { asm volatile("s_waitcnt lgkmcnt(0)" ::: "memory"); __builtin_amdgcn_s_barrier(); asm volatile("" ::: "memory"); } while (0)
__device__ void hgrn_item(const Params& p, char* smem, int idx) {
  const int tid = opaque_tid(), lane = tid & 63, w = tid >> 6;
  const int lr = lane & 15, lq = lane >> 4;
  const int h = idx & 3, c = (idx >> 2) & 31, b = idx >> 7;
  const int r0 = b * 2048 + c * 64;
  const u16* PQ = (const u16*)(p.ws + W_PQ);
  const float* LF = (const float*)(p.ws + W_LF);
  u16* QS = (u16*)(p.ws + W_QS);
  u16* O0 = (u16*)(p.ws + W_H);
  u16* NB = (u16*)(p.out);
  float* DVEC = (float*)(p.ws + W_DVEC);
  u16* qt = (u16*)smem;
  u16* kt = qt + 64 * 136;
  u16* ktT = kt + 64 * 136;
  u16* vT = ktT + 128 * 72;
  u16* sc = vT + 128 * 72;
  float* ps = (float*)(sc + 64 * 72);
  const int col = tid & 127, part = tid >> 7;
  float lfv[16], bcum[16];
  {
    const float* lfp = LF + (size_t)(r0 + part * 16) * 512 + h * 128 + col;
#pragma unroll
    for (int i = 0; i < 16; ++i) lfv[i] = lfp[(size_t)i * 512];
    float run = 0.f;
#pragma unroll
    for (int i = 0; i < 16; ++i) { run += lfv[i]; bcum[i] = run; }
    ps[part * 128 + col] = run;
  }
  u16 qraw[16], vraw[16];
  {
    const u16* qp0 = PQ + (size_t)(r0 + part * 16) * PQW + h * 128 + col;
#pragma unroll
    for (int i = 0; i < 16; ++i) { qraw[i] = qp0[(size_t)i * PQW]; vraw[i] = qp0[(size_t)i * PQW + 512]; }
  }
  RAW_BARRIER();
  {
    float off = 0.f, blast = 0.f;
#pragma unroll
    for (int pp = 0; pp < 4; ++pp) { float t = ps[pp * 128 + col]; blast += t; if (pp < part) off += t; }
    u16* qsout = QS + ((size_t)idx * 64 + part * 16) * 128 + col;
    float kkv[16];
#pragma unroll
    for (int i = 0; i < 16; ++i) {
      const float bb = bcum[i] + off;
      const int row = part * 16 + i;
      const float q = bf2f(qraw[i]);
      qsout[i * 128] = f2bf(q * __expf(bb));
      qt[row * 136 + col] = f2bf(q * __expf(bb - blast));
      kkv[i] = (1.f - __expf(lfv[i])) * __expf(blast - bb);
      kt[row * 136 + col] = f2bf(kkv[i]);
    }
#pragma unroll
    for (int hh = 0; hh < 2; ++hh) {
      *(u32x4*)(ktT + col * 72 + part * 16 + hh * 8) =
          u32x4{pack2(kkv[hh * 8 + 0], kkv[hh * 8 + 1]), pack2(kkv[hh * 8 + 2], kkv[hh * 8 + 3]),
                pack2(kkv[hh * 8 + 4], kkv[hh * 8 + 5]), pack2(kkv[hh * 8 + 6], kkv[hh * 8 + 7])};
      *(u32x4*)(vT + col * 72 + part * 16 + hh * 8) =
          u32x4{(unsigned)vraw[hh * 8 + 0] | ((unsigned)vraw[hh * 8 + 1] << 16), (unsigned)vraw[hh * 8 + 2] | ((unsigned)vraw[hh * 8 + 3] << 16),
                (unsigned)vraw[hh * 8 + 4] | ((unsigned)vraw[hh * 8 + 5] << 16), (unsigned)vraw[hh * 8 + 6] | ((unsigned)vraw[hh * 8 + 7] << 16)};
    }
    if (part == 0) DVEC[idx * 128 + col] = __expf(blast);
  }
  RAW_BARRIER();
  {
    const int tr = w >> 1;
    bf16x8 a[4];
#pragma unroll
    for (int ks = 0; ks < 4; ++ks) a[ks] = frag(qt, tr * 16, 136, ks * 32, lane);
#pragma unroll
    for (int tci = 0; tci < 2; ++tci) {
      const int tc = (w & 1) * 2 + tci;
      f32x4 acc = {0.f, 0.f, 0.f, 0.f};
#pragma unroll
      for (int ks = 0; ks < 4; ++ks) acc = mfma16(a[ks], frag(kt, tc * 16, 136, ks * 32, lane), acc);
#pragma unroll
      for (int j = 0; j < 4; ++j) {
        const int t = tr * 16 + lq * 4 + j, s = tc * 16 + lr;
        sc[t * 72 + s] = f2bf(t >= s ? acc[j] : 0.f);
      }
    }
  }
  RAW_BARRIER();
  {
    const int tr = w >> 1;
    const bf16x8 a0 = frag(sc, tr * 16, 72, 0, lane), a1 = frag(sc, tr * 16, 72, 32, lane);
#pragma unroll
    for (int tci = 0; tci < 4; ++tci) {
      const int tc = (w & 1) * 4 + tci;
      f32x4 acc = {0.f, 0.f, 0.f, 0.f};
      acc = mfma16(a0, frag(vT, tc * 16, 72, 0, lane), acc);
      acc = mfma16(a1, frag(vT, tc * 16, 72, 32, lane), acc);
      {
        float v[4] = {acc[0], acc[1], acc[2], acc[3]};
        quad_transpose(v, lane);
        store4_bf16(O0 + ((size_t)idx * 64 + tr * 16 + lq * 4 + (lane & 3)) * 128 + tc * 16 + (lr & 12), v);
      }
    }
  }
  {
    const int tr = w;
    const bf16x8 a0 = frag(ktT, tr * 16, 72, 0, lane), a1 = frag(ktT, tr * 16, 72, 32, lane);
#pragma unroll
    for (int tc = 0; tc < 8; ++tc) {
      f32x4 acc = {0.f, 0.f, 0.f, 0.f};
      acc = mfma16(a0, frag(vT, tc * 16, 72, 0, lane), acc);
      acc = mfma16(a1, frag(vT, tc * 16, 72, 32, lane), acc);
      {
        float v[4] = {acc[0], acc[1], acc[2], acc[3]};
        quad_transpose(v, lane);
        store4_bf16(NB + ((size_t)idx * 128 + tr * 16 + lq * 4 + (lane & 3)) * 128 + tc * 16 + (lr & 12), v);
      }
    }
  }
  RAW_BARRIER();
}

constexpr int ASTR = 68;
template <int J>
struct SolveCol {
  static __device__ __forceinline__ void run(f32x4 (&x)[16], const f32x4 (&a)[16], const float* AT) {
    if constexpr (J < 63) {
      f32x4 an[16];
      if constexpr (J + 1 < 63) {
#pragma unroll
        for (int B = (J + 2) / 4; B < 16; ++B) an[B] = *(const f32x4*)(AT + (J + 1) * ASTR + B * 4);
      }
      __builtin_amdgcn_sched_barrier(0);
      const float xj = x[J / 4][J % 4];
#pragma unroll
      for (int B = (J + 1) / 4; B < 16; ++B) x[B] -= a[B] * xj;
      __builtin_amdgcn_sched_barrier(0);
      SolveCol<J + 1>::run(x, an, AT);
    }
  }
};

__device__ void gdn_item(const Params& p, char* smem, int idx) {
  const int tid = opaque_tid(), lane = tid & 63, w = tid >> 6;
  const int lr = lane & 15, lq = lane >> 4;
  const int h = idx & 3, c = (idx >> 2) & 31, b = idx >> 7;
  const int r0 = b * 2048 + c * 64;
  const u16* PQ = (const u16*)(p.ws + W_PQ);
  const float* BETA = (const float*)(p.ws + W_BETA);
  const float* GDEC = (const float*)(p.ws + W_GDEC);
  u16* QS = (u16*)(p.ws + W_QS);
  u16* O0 = (u16*)(p.ws + W_H);
  u16* NB = (u16*)(p.out);
  u16* MNEG = (u16*)(p.ws + W_MNEG);
  float* DSC = (float*)(p.ws + W_DSC);
  u16* kb = (u16*)smem;
  u16* qb = kb + 64 * 136;
  u16* vS = qb + 64 * 136;
  float* Asol = (float*)(vS + 64 * 128);
  u16* attn = (u16*)(Asol + 64 * ASTR);
  u16* khT = attn + 64 * 72;
  u16* WT = khT + 128 * 72;
  u16* U0T = WT + 128 * 72;
  float* gc = (float*)(U0T + 128 * 72);
  float* bet = gc + 64;

  if (w == 0) {
    float g = GDEC[(size_t)(r0 + lane) * 4 + h];
#pragma unroll
    for (int o = 1; o < 64; o <<= 1) { float t = __shfl_up(g, o, 64); if (lane >= o) g += t; }
    gc[lane] = g;
    bet[lane] = BETA[(size_t)(r0 + lane) * 4 + h];
  }
  for (int rep_ = 0; rep_ < ((PROBE_G & 1) ? 2 : 1); ++rep_)
  {
    const int chq = 1024 + h * 128 + 2 * lane;
    const int cwq = h * 128 + 2 * lane;
    float cw[3][4][2];
#pragma unroll
    for (int ty = 0; ty < 3; ++ty)
#pragma unroll
      for (int j = 0; j < 4; ++j) {
        float2 t2 = *(const float2*)(p.conv_w + j * 1536 + ty * 512 + cwq);
        cw[ty][j][0] = t2.x; cw[ty][j][1] = t2.y;
      }
    float win[3][3][2];
    const int t0 = w * 8;
#pragma unroll
    for (int a = 0; a < 3; ++a) {
      const int rr = t0 - 3 + a;
      const bool valid = (c > 0) || (rr >= 0);
#pragma unroll
      for (int ty = 0; ty < 3; ++ty) {
        unsigned u = 0;
        if (valid) u = *(const unsigned*)(PQ + (ptrdiff_t)(r0 + rr) * PQW + chq + ty * 512);
        win[ty][a][0] = bf2f((u16)(u & 0xffff)); win[ty][a][1] = bf2f((u16)(u >> 16));
      }
    }
#pragma unroll
    for (int tt = 0; tt < 8; ++tt) {
      const int t = t0 + tt;
      float cv[3][2];
#pragma unroll
      for (int ty = 0; ty < 3; ++ty) {
        unsigned u = *(const unsigned*)(PQ + (size_t)(r0 + t) * PQW + chq + ty * 512);
        float c0 = bf2f((u16)(u & 0xffff)), c1 = bf2f((u16)(u >> 16));
        float s0 = cw[ty][0][0] * win[ty][0][0] + cw[ty][1][0] * win[ty][1][0] + cw[ty][2][0] * win[ty][2][0] + cw[ty][3][0] * c0;
        float s1 = cw[ty][0][1] * win[ty][0][1] + cw[ty][1][1] * win[ty][1][1] + cw[ty][2][1] * win[ty][2][1] + cw[ty][3][1] * c1;
        win[ty][0][0] = win[ty][1][0]; win[ty][0][1] = win[ty][1][1];
        win[ty][1][0] = win[ty][2][0]; win[ty][1][1] = win[ty][2][1];
        win[ty][2][0] = c0; win[ty][2][1] = c1;
        cv[ty][0] = siluf_(s0); cv[ty][1] = siluf_(s1);
      }
      float ssq = wave_sum(cv[0][0] * cv[0][0] + cv[0][1] * cv[0][1]);
      float ssk = wave_sum(cv[1][0] * cv[1][0] + cv[1][1] * cv[1][1]);
      const float rq = rsqrtf(ssq + EPS) * 0.08838834764831845f;
      const float rk = rsqrtf(ssk + EPS);
      *(unsigned*)(qb + t * 136 + 2 * lane) = pack2(cv[0][0] * rq, cv[0][1] * rq);
      *(unsigned*)(kb + t * 136 + 2 * lane) = pack2(cv[1][0] * rk, cv[1][1] * rk);
      *(unsigned*)(vS + t * 128 + 2 * lane) = pack2(cv[2][0], cv[2][1]);
    }
  }
  RAW_BARRIER();
  {
    const int which = w >> 2, tr = w & 3;
    const u16* Asrc = which ? qb : kb;
    bf16x8 a[4];
#pragma unroll
    for (int ks = 0; ks < 4; ++ks) a[ks] = frag(Asrc, tr * 16, 136, ks * 32, lane);
#pragma unroll
    for (int tc = 0; tc < 4; ++tc) {
      f32x4 acc = {0.f, 0.f, 0.f, 0.f};
#pragma unroll
      for (int ks = 0; ks < 4; ++ks) acc = mfma16(a[ks], frag(kb, tc * 16, 136, ks * 32, lane), acc);
#pragma unroll
      for (int j = 0; j < 4; ++j) {
        const int t = tr * 16 + lq * 4 + j, s = tc * 16 + lr;
        const float L = __expf(fminf(gc[t] - gc[s], 0.f));
        if (which == 0) Asol[s * ASTR + t] = (t > s) ? bet[t] * acc[j] * L : 0.f;
        else attn[t * 72 + s] = f2bf((t >= s) ? acc[j] * L : 0.f);
      }
    }
  }
  RAW_BARRIER();
  for (int rep_ = 0; rep_ < ((PROBE_G & 2) ? 2 : 1); ++rep_) {
  if (tid < 256) {
    f32x4 x[16];
    if (tid < 128) {
#pragma unroll
      for (int s = 0; s < 64; ++s) { x[s >> 2][s & 3] = bf2f(vS[s * 128 + tid]) * bet[s]; if ((s & 7) == 7) __builtin_amdgcn_sched_barrier(0); }
    } else {
#pragma unroll
      for (int s = 0; s < 64; ++s) { x[s >> 2][s & 3] = bf2f(kb[s * 136 + tid - 128]) * bet[s] * __expf(gc[s]); if ((s & 7) == 7) __builtin_amdgcn_sched_barrier(0); }
    }
    {
      f32x4 a0[16];
#pragma unroll
      for (int B = 0; B < 16; ++B) a0[B] = *(const f32x4*)(Asol + B * 4);
      SolveCol<0>::run(x, a0, Asol);
    }
    u16* dst = (tid < 128) ? (U0T + tid * 72) : (WT + (tid - 128) * 72);
#pragma unroll
    for (int s8 = 0; s8 < 8; ++s8) {
      *(u32x4*)(dst + s8 * 8) = u32x4{pack2(x[2 * s8][0], x[2 * s8][1]), pack2(x[2 * s8][2], x[2 * s8][3]),
                                      pack2(x[2 * s8 + 1][0], x[2 * s8 + 1][1]), pack2(x[2 * s8 + 1][2], x[2 * s8 + 1][3])};
    }
  } else {
    const float glast = gc[63];
    const int e0 = tid - 256;
#pragma unroll 4
    for (int i = 0; i < 32; ++i) {
      const int e = e0 + 256 * i;
      const int s = e & 63, kd = e >> 6;
      khT[kd * 72 + s] = f2bf(bf2f(kb[s * 136 + kd]) * __expf(glast - gc[s]));
    }
  }
  RAW_BARRIER();
  }
  for (int rep_ = 0; rep_ < ((PROBE_G & 4) ? 2 : 1); ++rep_) {
  {
    const int tr = w & 3, half = w >> 2;
    const u16* Bsrc = half ? U0T : WT;
    const bf16x8 a0 = frag(attn, tr * 16, 72, 0, lane), a1 = frag(attn, tr * 16, 72, 32, lane);
#pragma unroll 2
    for (int tc = 0; tc < 8; ++tc) {
      f32x4 acc = {0.f, 0.f, 0.f, 0.f};
      acc = mfma16(a0, frag(Bsrc, tc * 16, 72, 0, lane), acc);
      acc = mfma16(a1, frag(Bsrc, tc * 16, 72, 32, lane), acc);
      {
        float v[4];
#pragma unroll
        for (int j = 0; j < 4; ++j) {
          const int t = tr * 16 + lq * 4 + j, n = tc * 16 + lr;
          v[j] = half == 0 ? bf2f(qb[t * 136 + n]) * __expf(gc[t]) - acc[j] : acc[j];
        }
        quad_transpose(v, lane);
        const size_t o = ((size_t)(1024 + idx) * 64 + tr * 16 + lq * 4 + (lane & 3)) * 128 + tc * 16 + (lr & 12);
        store4_bf16((half == 0 ? QS : O0) + o, v);
      }
    }
  }
  {
    const int tr = w;
    const bf16x8 a0 = frag(khT, tr * 16, 72, 0, lane), a1 = frag(khT, tr * 16, 72, 32, lane);
#pragma unroll 2
    for (int tc = 0; tc < 16; ++tc) {
      const u16* Bsrc = tc < 8 ? WT : U0T;
      const int tcc = tc & 7;
      f32x4 acc = {0.f, 0.f, 0.f, 0.f};
      acc = mfma16(a0, frag(Bsrc, tcc * 16, 72, 0, lane), acc);
      acc = mfma16(a1, frag(Bsrc, tcc * 16, 72, 32, lane), acc);
      {
        float v[4];
#pragma unroll
        for (int j = 0; j < 4; ++j) v[j] = tc < 8 ? -acc[j] : acc[j];
        quad_transpose(v, lane);
        const size_t o = (size_t)(tr * 16 + lq * 4 + (lane & 3)) * 128 + tcc * 16 + (lr & 12);
        store4_bf16((tc < 8 ? MNEG + (size_t)idx * 16384 : NB + (size_t)(1024 + idx) * 16384) + o, v);
      }
    }
  }
  }
  if (tid < 128) ((float*)(p.ws + W_DVEC))[(size_t)(1024 + idx) * 128 + tid] = __expf(gc[63]);
  RAW_BARRIER();
}

__device__ void phase2(const Params& p, char* smem, int bid, int nb) {
  for (int it = bid; it < 2048; it += nb) {
    if (it >= 1024) { gdn_item(p, smem, it - 1024); if (DUP_MASK & 2048) gdn_item(p, smem, it - 1024); }
    else { hgrn_item(p, smem, it); if (DUP_MASK & 1024) hgrn_item(p, smem, it); }
  }
}

struct ScanRegs {
  bf16x8 Aq[4];
  bf16x8 Am[4];
  u32x2 o0, nn0, nn1;
  f32x4 dd;
};

template <int TYPE>
__device__ __forceinline__ void scan_load(ScanRegs& r, const Params& p, int idx, unsigned qoff, unsigned ooff, unsigned moff,
                                          unsigned noff, unsigned doff) {
  const int ii = __builtin_amdgcn_readfirstlane(idx);
  const int ti = TYPE * 1024 + ii;
  const u16* QSb = (const u16*)(p.ws + W_QS) + (size_t)ti * 8192;
  const u16* O0b = (const u16*)(p.ws + W_H) + (size_t)ti * 8192;
  const u16* NBb = (const u16*)(p.out) + (size_t)ti * 16384;
#pragma unroll
  for (int ks = 0; ks < 4; ++ks) r.Aq[ks] = *(const bf16x8*)(QSb + (qoff + ks * 32));
  r.o0 = *(const u32x2*)(O0b + ooff);
  r.nn0 = *(const u32x2*)(NBb + noff);
  r.nn1 = *(const u32x2*)(NBb + (noff + 16));
  if (TYPE == 1) {
    const u16* Mb = (const u16*)(p.ws + W_MNEG) + (size_t)ii * 16384;
#pragma unroll
    for (int ks = 0; ks < 4; ++ks) r.Am[ks] = *(const bf16x8*)(Mb + (moff + ks * 32));
  }
  r.dd = *(const f32x4*)((const float*)(p.ws + W_DVEC) + (size_t)ti * 128 + doff);
}
__device__ __forceinline__ void unpack4(u32x2 u, float (&v)[4]) {
  v[0] = bf2f((u16)(u[0] & 0xffff)); v[1] = bf2f((u16)(u[0] >> 16));
  v[2] = bf2f((u16)(u[1] & 0xffff)); v[3] = bf2f((u16)(u[1] >> 16));
}

template <int TYPE>
__device__ void scan_unit(const Params& p, char* smem, int rem) {
  const int tid = opaque_tid(), lane = tid & 63, w = tid >> 6;
  const int lr = lane & 15, lq = lane >> 4;
  const int b = rem >> 4, h = (rem >> 2) & 3, vs2 = rem & 3;
  const int tr = lq * 4 + (lane & 3), tc4 = lr & 12;
  const int otr = w & 3, otc = w >> 2;
  float* OPRE = (float*)(p.ws + W_PQ);
  u16* SbT = (u16*)smem;
  for (int i = tid; i < 2 * 32 * 136; i += 512) SbT[i] = 0;
  f32x4 S0 = {0.f, 0.f, 0.f, 0.f}, S1 = {0.f, 0.f, 0.f, 0.f};
  const unsigned qoff = (unsigned)((otr * 16 + lr) * 128 + lq * 8);
  const unsigned ooff = (unsigned)((otr * 16 + tr) * 128 + vs2 * 32 + otc * 16 + tc4);
  const unsigned moff = (unsigned)((w * 16 + lr) * 128 + lq * 8);
  const unsigned noff = (unsigned)((w * 16 + tr) * 128 + vs2 * 32 + tc4);
  const unsigned doff = (unsigned)(w * 16 + lq * 4);
  float* const orow = OPRE + (size_t)(b * 2048 + otr * 16 + tr) * 1024 + TYPE * 512 + h * 128 + vs2 * 32 + otc * 16 + tc4;
  ScanRegs r0, r1, r2, r3;
  const int idx0 = (b * 32) * 4 + h;
  scan_load<TYPE>(r0, p, idx0 + 0, qoff, ooff, moff, noff, doff);
  scan_load<TYPE>(r1, p, idx0 + 4, qoff, ooff, moff, noff, doff);
  scan_load<TYPE>(r2, p, idx0 + 8, qoff, ooff, moff, noff, doff);
  scan_load<TYPE>(r3, p, idx0 + 12, qoff, ooff, moff, noff, doff);
  __builtin_amdgcn_sched_barrier(0);
#define SCAN_STEP(R, c) { \
    RAW_BARRIER(); \
    const u16* Sb = SbT + ((c) & 1) * 32 * 136 + lr * 136 + lq * 8; \
    bf16x8 B0[4], B1[4], Bo[4]; \
    _Pragma("unroll") for (int ks = 0; ks < 4; ++ks) { \
      B0[ks] = *(const bf16x8*)(Sb + ks * 32); \
      B1[ks] = *(const bf16x8*)(Sb + 16 * 136 + ks * 32); \
      Bo[ks] = *(const bf16x8*)(Sb + otc * 16 * 136 + ks * 32); } \
    { \
      float ov[4]; unpack4(R.o0, ov); quad_transpose(ov, lane); \
      f32x4 acc = {ov[0], ov[1], ov[2], ov[3]}; \
      _Pragma("unroll") for (int ks = 0; ks < 4; ++ks) acc = mfma16(R.Aq[ks], Bo[ks], acc); \
      float o[4] = {acc[0], acc[1], acc[2], acc[3]}; \
      quad_transpose(o, lane); \
      *(f32x4*)(orow + (size_t)(c) * 65536) = f32x4{o[0], o[1], o[2], o[3]}; \
    } \
    float n0[4], n1[4]; unpack4(R.nn0, n0); unpack4(R.nn1, n1); \
    quad_transpose(n0, lane); quad_transpose(n1, lane); \
    f32x4 T0, T1; \
    _Pragma("unroll") for (int j = 0; j < 4; ++j) { T0[j] = R.dd[j] * S0[j] + n0[j]; T1[j] = R.dd[j] * S1[j] + n1[j]; } \
    if (TYPE == 1) { _Pragma("unroll") for (int ks = 0; ks < 4; ++ks) { T0 = mfma16(R.Am[ks], B0[ks], T0); T1 = mfma16(R.Am[ks], B1[ks], T1); } } \
    S0 = T0; S1 = T1; \
    u16* Sw = SbT + (((c) + 1) & 1) * 32 * 136 + lr * 136 + w * 16 + lq * 4; \
    *(u32x2*)(Sw) = u32x2{pack2(S0[0], S0[1]), pack2(S0[2], S0[3])}; \
    *(u32x2*)(Sw + 16 * 136) = u32x2{pack2(S1[0], S1[1]), pack2(S1[2], S1[3])}; \
    __builtin_amdgcn_sched_barrier(0); \
    scan_load<TYPE>(R, p, idx0 + (((c) + 4 < 32) ? (c) + 4 : 31) * 4, qoff, ooff, moff, noff, doff); \
    __builtin_amdgcn_sched_barrier(0); \
  }
  for (int c0 = 0; c0 < 32; c0 += 4) {
    SCAN_STEP(r0, c0)
    SCAN_STEP(r1, c0 + 1)
    SCAN_STEP(r2, c0 + 2)
    SCAN_STEP(r3, c0 + 3)
  }
#undef SCAN_STEP
  float* so = p.out + (TYPE ? O_GDP : O_HGP) + (size_t)(b * 4 + h) * 16384 + (w * 16 + tr) * 128 + vs2 * 32 + tc4;
  {
    float sv[4] = {S0[0], S0[1], S0[2], S0[3]};
    quad_transpose(sv, lane);
    *(f32x4*)(so) = f32x4{sv[0], sv[1], sv[2], sv[3]};
    float sw[4] = {S1[0], S1[1], S1[2], S1[3]};
    quad_transpose(sw, lane);
    *(f32x4*)(so + 16) = f32x4{sw[0], sw[1], sw[2], sw[3]};
  }
  __syncthreads();
}

__device__ void sample_item(const Params& p, char* smem, int it) {
  const int tid = opaque_tid(), lane = tid & 63, w = tid >> 6;
  const int type = it >> 9, b = (it >> 2) & 127, h = it & 3;
  const int row = MP + b;
  const u16* PQ = (const u16*)(p.ws + W_PQ);
  const float* LF = (const float*)(p.ws + W_LF);
  const float* BETA = (const float*)(p.ws + W_BETA);
  const float* GDEC = (const float*)(p.ws + W_GDEC);
  float* OPRE = (float*)(p.ws + W_PQ);
  float* fq = (float*)smem;
  float* fk = fq + 128;
  float* fv = fk + 128;
  float* fe = fv + 128;
  float* red = fe + 128;
  float* sc = red + 1024;
  const int n = tid & 127, kp = tid >> 7;
  if (type == 0) {
    if (tid < 128) {
      const float lf = LF[(size_t)row * 512 + h * 128 + tid];
      const float f = __expf(lf);
      fe[tid] = f;
      fk[tid] = 1.f - f;
      fq[tid] = bf2f(PQ[(size_t)row * PQW + h * 128 + tid]);
      fv[tid] = bf2f(PQ[(size_t)row * PQW + 512 + h * 128 + tid]);
    }
    __syncthreads();
    const float* S = p.state_hgrn + ((size_t)(b * 4 + h) * 128) * 128;
    float* So = p.out + O_HGS + ((size_t)(b * 4 + h) * 128) * 128;
    const float vn = fv[n];
    float o = 0.f;
#pragma unroll
    for (int i = 0; i < 32; ++i) {
      const int k = kp * 32 + i;
      const float sn = fe[k] * S[k * 128 + n] + fk[k] * vn;
      So[k * 128 + n] = sn;
      o += fq[k] * sn;
    }
    red[kp * 128 + n] = o;
    __syncthreads();
    if (tid < 128) OPRE[(size_t)row * 1024 + h * 128 + tid] = red[tid] + red[128 + tid] + red[256 + tid] + red[384 + tid];
    __syncthreads();
  } else {
    const float* cprev = p.state_conv + (size_t)b * 3 * 1536;
    if (tid < 384) {
      const int ty = tid >> 7, cc = tid & 127;
      const int ch = ty * 512 + h * 128 + cc;
      const float p0 = cprev[ch], p1 = cprev[1536 + ch], p2 = cprev[3072 + ch];
      const float nw = bf2f(PQ[(size_t)row * PQW + 1024 + ch]);
      const float s = p.conv_w[ch] * p0 + p.conv_w[1536 + ch] * p1 + p.conv_w[3072 + ch] * p2 + p.conv_w[4608 + ch] * nw;
      fq[ty * 128 + cc] = siluf_(s);
      p.out[O_CVS + (size_t)(b * 3 + 0) * 1536 + ch] = p1;
      p.out[O_CVS + (size_t)(b * 3 + 1) * 1536 + ch] = p2;
    }
    __syncthreads();
    if (w < 2) {
      const float a0 = fq[w * 128 + lane], a1 = fq[w * 128 + 64 + lane];
      const float ss = wave_sum(a0 * a0 + a1 * a1);
      if (lane == 0) sc[w] = ss;
    }
    __syncthreads();
    const float rq = rsqrtf(sc[0] + EPS) * 0.08838834764831845f;
    const float rk = rsqrtf(sc[1] + EPS);
    __syncthreads();
    if (tid < 128) fq[tid] *= rq;
    else if (tid < 256) fk[tid - 128] *= rk;
    __syncthreads();
    if (w == 0) {
      const float qk = wave_sum(fq[lane] * fk[lane] + fq[64 + lane] * fk[64 + lane]);
      if (lane == 0) sc[2] = qk;
    }
    const float eg = __expf(GDEC[(size_t)row * 4 + h]);
    const float beta = BETA[(size_t)row * 4 + h];
    const float* S = p.state_gdn + ((size_t)(b * 4 + h) * 128) * 128;
    float* So = p.out + O_GDS + ((size_t)(b * 4 + h) * 128) * 128;
    float sd[32];
    float ks_ = 0.f, qs_ = 0.f;
#pragma unroll
    for (int i = 0; i < 32; ++i) {
      const int k = kp * 32 + i;
      sd[i] = eg * S[k * 128 + n];
      ks_ += fk[k] * sd[i];
      qs_ += fq[k] * sd[i];
    }
    red[kp * 128 + n] = ks_;
    red[512 + kp * 128 + n] = qs_;
    __syncthreads();
    const float kS = red[n] + red[128 + n] + red[256 + n] + red[384 + n];
    const float delta = (fv[n] - kS) * beta;
#pragma unroll
    for (int i = 0; i < 32; ++i) {
      const int k = kp * 32 + i;
      So[k * 128 + n] = sd[i] + fk[k] * delta;
    }
    if (tid < 128) {
      const float qS = red[512 + n] + red[640 + n] + red[768 + n] + red[896 + n];
      OPRE[(size_t)row * 1024 + 512 + h * 128 + n] = qS + sc[2] * delta;
    }
    __syncthreads();
  }
}

__device__ void sample_block4(const Params& p, char* smem, int bid) {
  const int tid = opaque_tid(), lane = tid & 63, w = tid >> 6;
  const u16* PQ = (const u16*)(p.ws + W_PQ);
  const float* LF = (const float*)(p.ws + W_LF);
  const float* BETA = (const float*)(p.ws + W_BETA);
  const float* GDEC = (const float*)(p.ws + W_GDEC);
  float* OPRE = (float*)(p.ws + W_PQ);
  float* vec = (float*)smem;
  float* red = vec + 2048;
  float* sc = red + 1024;
  if (tid < 256) {
    const int j = tid >> 7, c = tid & 127;
    const int it = bid + 256 * j, b = (it >> 2) & 127, h = it & 3, row = MP + b;
    const float f = __expf(LF[(size_t)row * 512 + h * 128 + c]);
    vec[(j * 4 + 0) * 128 + c] = bf2f(PQ[(size_t)row * PQW + h * 128 + c]);
    vec[(j * 4 + 1) * 128 + c] = 1.f - f;
    vec[(j * 4 + 2) * 128 + c] = bf2f(PQ[(size_t)row * PQW + 512 + h * 128 + c]);
    vec[(j * 4 + 3) * 128 + c] = f;
  }
  for (int e = tid; e < 768; e += 512) {
    const int j = 2 + e / 384, r = e % 384, ty = r >> 7, cc = r & 127;
    const int it = bid + 256 * j, b = (it >> 2) & 127, h = it & 3, row = MP + b;
    const int ch = ty * 512 + h * 128 + cc;
    const float* cprev = p.state_conv + (size_t)b * 3 * 1536;
    const float p0 = cprev[ch], p1 = cprev[1536 + ch], p2 = cprev[3072 + ch];
    const float nw = bf2f(PQ[(size_t)row * PQW + 1024 + ch]);
    const float s = p.conv_w[ch] * p0 + p.conv_w[1536 + ch] * p1 + p.conv_w[3072 + ch] * p2 + p.conv_w[4608 + ch] * nw;
    vec[(j * 4 + ty) * 128 + cc] = siluf_(s);
    p.out[O_CVS + (size_t)(b * 3 + 0) * 1536 + ch] = p1;
    p.out[O_CVS + (size_t)(b * 3 + 1) * 1536 + ch] = p2;
  }
  __syncthreads();
  if (w < 4) {
    const int j = 2 + (w >> 1), which = w & 1;
    const float a0 = vec[(j * 4 + which) * 128 + lane], a1 = vec[(j * 4 + which) * 128 + 64 + lane];
    const float ss = wave_sum(a0 * a0 + a1 * a1);
    if (lane == 0) sc[j * 4 + which] = ss;
  }
  __syncthreads();
  {
    const int j = 2 + (tid >> 8), which = (tid >> 7) & 1, c = tid & 127;
    const float r = which == 0 ? rsqrtf(sc[j * 4 + 0] + EPS) * 0.08838834764831845f : rsqrtf(sc[j * 4 + 1] + EPS);
    vec[(j * 4 + which) * 128 + c] *= r;
  }
  __syncthreads();
  if (w < 2) {
    const int j = 2 + w;
    const float qk = wave_sum(vec[(j * 4 + 0) * 128 + lane] * vec[(j * 4 + 1) * 128 + lane] +
                              vec[(j * 4 + 0) * 128 + 64 + lane] * vec[(j * 4 + 1) * 128 + 64 + lane]);
    if (lane == 0) sc[j * 4 + 2] = qk;
  }
  __syncthreads();
  const int n = tid & 127, kp = tid >> 7;
  float cur[32], nxt[32];
  {
    const int it = bid, b = (it >> 2) & 127, h = it & 3;
    const float* S = p.state_hgrn + ((size_t)(b * 4 + h) * 128) * 128;
#pragma unroll
    for (int i = 0; i < 32; ++i) cur[i] = S[(kp * 32 + i) * 128 + n];
  }
#pragma unroll
  for (int j = 0; j < 4; ++j) {
    const int it = bid + 256 * j, b = (it >> 2) & 127, h = it & 3, row = MP + b;
    if (j < 3) {
      const int it2 = bid + 256 * (j + 1), b2 = (it2 >> 2) & 127, h2 = it2 & 3;
      const float* S2 = ((j + 1) < 2 ? p.state_hgrn : p.state_gdn) + ((size_t)(b2 * 4 + h2) * 128) * 128;
#pragma unroll
      for (int i = 0; i < 32; ++i) nxt[i] = S2[(kp * 32 + i) * 128 + n];
    }
    const float* fq = vec + (j * 4 + 0) * 128;
    const float* fk = vec + (j * 4 + 1) * 128;
    const float* fv = vec + (j * 4 + 2) * 128;
    const float* fe = vec + (j * 4 + 3) * 128;
    if (j < 2) {
      float* So = p.out + O_HGS + ((size_t)(b * 4 + h) * 128) * 128;
      const float vn = fv[n];
      float o = 0.f;
#pragma unroll
      for (int i = 0; i < 32; ++i) {
        const int k = kp * 32 + i;
        const float sn = fe[k] * cur[i] + fk[k] * vn;
        So[k * 128 + n] = sn;
        o += fq[k] * sn;
      }
      red[kp * 128 + n] = o;
      __syncthreads();
      if (tid < 128) OPRE[(size_t)row * 1024 + h * 128 + tid] = red[tid] + red[128 + tid] + red[256 + tid] + red[384 + tid];
      __syncthreads();
    } else {
      float* So = p.out + O_GDS + ((size_t)(b * 4 + h) * 128) * 128;
      const float eg = __expf(GDEC[(size_t)row * 4 + h]);
      const float beta = BETA[(size_t)row * 4 + h];
      float ks_ = 0.f, qs_ = 0.f;
#pragma unroll
      for (int i = 0; i < 32; ++i) {
        const int k = kp * 32 + i;
        cur[i] *= eg;
        ks_ += fk[k] * cur[i];
        qs_ += fq[k] * cur[i];
      }
      red[kp * 128 + n] = ks_;
      red[512 + kp * 128 + n] = qs_;
      __syncthreads();
      const float kS = red[n] + red[128 + n] + red[256 + n] + red[384 + n];
      const float delta = (fv[n] - kS) * beta;
#pragma unroll
      for (int i = 0; i < 32; ++i) {
        const int k = kp * 32 + i;
        So[k * 128 + n] = cur[i] + fk[k] * delta;
      }
      if (tid < 128) {
        const float qS = red[512 + n] + red[640 + n] + red[768 + n] + red[896 + n];
        OPRE[(size_t)row * 1024 + 512 + h * 128 + n] = qS + sc[j * 4 + 2] * delta;
      }
      __syncthreads();
    }
#pragma unroll
    for (int i = 0; i < 32; ++i) cur[i] = nxt[i];
  }
}

#define XB_TICKET(j) (3456 + 16 * (j))
__device__ void phase3(const Params& p, char* smem, int bid, int nb) {
  volatile LAS unsigned* st = (volatile LAS unsigned*)(unsigned)(size_t)(smem + LDS_BYTES - 16);
  unsigned* bar = (unsigned*)(p.ws + W_BAR);
  if (threadIdx.x == 0) {
    unsigned ok = (nb == 256) ? 1u : 0u, rank = 0u;
    const unsigned x = xb_xcc_id();
    unsigned npop = 0u;
    for (unsigned j = 0; j < 16; ++j) {
      const unsigned c = xb_ld(&bar[XB_XCNT(j)]);
      if (c != 0u) { ++npop; if (c != 32u) ok = 0u; if (j < x) ++rank; }
    }
    if (npop != 8u) ok = 0u;
    unsigned ticket = 0u;
    if (ok) ticket = xb_add(&bar[XB_TICKET(x)], 1u);
    st[2] = ok ? (0x100u | (rank << 5) | (ticket & 31u)) : 0u;
  }
  __syncthreads();
  const unsigned place = st[2];
  __syncthreads();
  if (place) {
    const int r = (place >> 5) & 7, t = place & 31;
    const int g = (t >> 2) * 8 + r;
    const int uu = (g << 2) | (t & 3);
    if (uu < 128) scan_unit<0>(p, smem, uu); else scan_unit<1>(p, smem, uu - 128);
    if (DUP_MASK & 256) { if (uu < 128) scan_unit<0>(p, smem, uu); else scan_unit<1>(p, smem, uu - 128); }
    if (uu < 128) {
      const int rankH = r * 16 + t;
      sample_block4(p, smem, rankH);
      sample_block4(p, smem, rankH + 128);
    }
    return;
  }
  for (int u = bid; u < 256; u += nb) {
    int uu = u;
    if (nb == 256) {
      const int xcd = u & 7, j = u >> 3;
      uu = ((xcd * 8 + (j >> 2)) << 2) | (j & 3);
    }
    if (uu < 128) scan_unit<0>(p, smem, uu); else scan_unit<1>(p, smem, uu - 128);
  }
  if (nb == 256) {
    if ((bid & 7) < 4) {
      const int rank = (bid >> 3) * 4 + (bid & 3);
      sample_block4(p, smem, rank);
      sample_block4(p, smem, rank + 128);
    }
  } else {
    for (int it = bid; it < 1024; it += nb) sample_item(p, smem, it);
  }
}

__device__ void phase4(const Params& p, int bid, int nb) {
  const int tid = opaque_tid(), lane = tid & 63, w = tid >> 6;
  const float* OPRE = (const float*)(p.ws + W_PQ);
  const u16* GATES = (const u16*)(p.ws + W_GATES);
  u16* A2 = (u16*)(p.ws + W_QS);
  constexpr int NG = MT / 8;
  for (int g = bid; g < NG; g += 2 * nb) {
    const bool two = (g + nb) < NG;
    const int rows[2] = {g * 8 + w, (two ? g + nb : g) * 8 + w};
    f32x4 v[2][4];
    u32x2 gt[2][4];
#pragma unroll
    for (int r = 0; r < 2; ++r)
#pragma unroll
      for (int i = 0; i < 4; ++i) {
        const int col = i * 256 + lane * 4;
        v[r][i] = *(const f32x4*)(OPRE + (size_t)rows[r] * 1024 + col);
        gt[r][i] = *(const u32x2*)(GATES + (size_t)rows[r] * 1024 + col);
      }
#pragma unroll
    for (int r = 0; r < 2; ++r) {
      if (r == 1 && !two) break;
#pragma unroll
      for (int i = 0; i < 4; ++i) {
        const int col = i * 256 + lane * 4;
        float ss = v[r][i][0] * v[r][i][0] + v[r][i][1] * v[r][i][1] + v[r][i][2] * v[r][i][2] + v[r][i][3] * v[r][i][3];
        ss += dpp_mov<0xB1, 0xf>(ss);
        ss += dpp_mov<0x4E, 0xf>(ss);
        ss += dpp_mov<0x141, 0xf>(ss);
        ss += dpp_mov<0x140, 0xf>(ss);
        ss += __shfl_xor(ss, 16, 64);
        const float rstd = rsqrtf(ss * (1.f / 128.f) + EPS);
        const f32x4 nw = *(const f32x4*)((col < 512 ? p.hg_norm : p.gdn_norm) + (col & 127));
        float gg[4];
        unpack4(gt[r][i], gg);
        *(u32x2*)(A2 + (size_t)rows[r] * LDK + col) =
            u32x2{pack2(v[r][i][0] * rstd * nw[0] * gg[0], v[r][i][1] * rstd * nw[1] * gg[1]),
                  pack2(v[r][i][2] * rstd * nw[2] * gg[2], v[r][i][3] * rstd * nw[3] * gg[3])};
      }
    }
  }
}

__device__ void phase6(const Params& p, int bid, int nb) {
  const int tid = opaque_tid(), lane = tid & 63, w = tid >> 6;
  constexpr int NG = MT / 8, NR = 4;
  for (int g = bid; g < NG; g += NR * nb) {
    float* y[NR];
    bool ok[NR];
    float4 xv[NR][4];
    float ss[NR];
#pragma unroll
    for (int r = 0; r < NR; ++r) {
      ok[r] = (g + r * nb) < NG;
      const int row = (ok[r] ? g + r * nb : g) * 8 + w;
      y[r] = row < MP ? p.out + O_YP + (size_t)row * 1024 : p.out + O_YS + (size_t)(row - MP) * 1024;
#pragma unroll
      for (int i = 0; i < 4; ++i) xv[r][i] = *(const float4*)(y[r] + i * 256 + lane * 4);
    }
#pragma unroll
    for (int r = 0; r < NR; ++r) {
      ss[r] = 0.f;
#pragma unroll
      for (int i = 0; i < 4; ++i) ss[r] += xv[r][i].x * xv[r][i].x + xv[r][i].y * xv[r][i].y + xv[r][i].z * xv[r][i].z + xv[r][i].w * xv[r][i].w;
      ss[r] = wave_sum(ss[r]);
    }
#pragma unroll
    for (int r = 0; r < NR; ++r) {
      if (ok[r]) {
        const float rstd = rsqrtf(ss[r] * (1.f / 1024.f) + EPS);
#pragma unroll
        for (int i = 0; i < 4; ++i) {
          const float4 nw = *(const float4*)(p.final_norm + i * 256 + lane * 4);
          float4 o;
          o.x = xv[r][i].x * rstd * nw.x; o.y = xv[r][i].y * rstd * nw.y; o.z = xv[r][i].z * rstd * nw.z; o.w = xv[r][i].w * rstd * nw.w;
          *(float4*)(y[r] + i * 256 + lane * 4) = o;
        }
      }
    }
  }
}


template <int PH>
__device__ __forceinline__ void run_phase(const Params& p, char* smem, int bid, int nb) {
  if (PH == 0) phase0(p, smem, bid, nb);
  else if (PH == 1) gemm_phase<0>(p, (const u16*)(p.ws + W_H), (const u16*)(p.ws + W_WINT), 16, smem, bid, nb);
  else if (PH == 2) phase2(p, smem, bid, nb);
  else if (PH == 3) phase3(p, smem, bid, nb);
  else if (PH == 4) phase4(p, bid, nb);
  else if (PH == 5) gemm_phase<1>(p, (const u16*)(p.ws + W_QS), (const u16*)(p.ws + W_WOUTT), 4, smem, bid, nb);
  else phase6(p, bid, nb);
}

#if MEGA
__global__ void __launch_bounds__(NTH) mega_kernel(Params p) {
  extern __shared__ __attribute__((aligned(16))) char smem[];
  cg::grid_group grid = cg::this_grid();
  const int bid = blockIdx.x, nb = gridDim.x;
  if (p.out == nullptr) grid.sync();
  volatile LAS unsigned* st = (volatile LAS unsigned*)(unsigned)(size_t)(smem + LDS_BYTES - 16);
  if (threadIdx.x == 0) { st[0] = 0u; st[1] = 0u; }
  __syncthreads();
  const XcdBarrier xb = xcd_barrier_post((unsigned*)(p.ws + W_BAR), st);
#define GSYNC() xcd_barrier(xb)
#define RUNP(k) run_phase<k>(p, smem, bid, nb); GSYNC(); if (DUP_MASK & (1 << k)) { run_phase<k>(p, smem, bid, nb); GSYNC(); }
  RUNP(0)
  if (PROBE_SYNC) { for (int i_ = 0; i_ < PROBE_SYNC; ++i_) GSYNC(); }
  RUNP(1)
  if (PROBE_GEMM) { gemm_phase<0, PROBE_GEMM>(p, (const u16*)(p.ws + W_H), (const u16*)(p.ws + W_WINT), 16, smem, bid, nb); GSYNC(); }
  RUNP(2) RUNP(3) RUNP(4) RUNP(5)
#undef RUNP
#undef GSYNC
  run_phase<6>(p, smem, bid, nb);
}
#else
template <int PH>
__global__ void __launch_bounds__(NTH) phase_kernel(Params p) {
  extern __shared__ __attribute__((aligned(16))) char smem[];
  run_phase<PH>(p, smem, blockIdx.x, gridDim.x);
}
template <int PH>
static void launch_phase(const Params& p, int grid, hipStream_t stream) {
  hipFuncSetAttribute((const void*)phase_kernel<PH>, hipFuncAttributeMaxDynamicSharedMemorySize, (int)LDS_BYTES);
  hipLaunchKernelGGL(phase_kernel<PH>, dim3(grid), dim3(NTH), LDS_BYTES, stream, p);
}
#endif

extern "C" void kernel_launch(void* const* d_in, const int* in_sizes, int n_in, void* d_out, int out_size,
                              void* d_ws, size_t ws_size, hipStream_t stream) {
  Params p{};
  p.x_prompt = (const float*)d_in[0];
  p.x_sample = (const float*)d_in[1];
  p.state_hgrn = (const float*)d_in[2];
  p.state_gdn = (const float*)d_in[3];
  p.state_conv = (const float*)d_in[4];
  p.norm_w = (const float*)d_in[5];
  p.w_in = (const float*)d_in[6];
  p.lb_logits = (const float*)d_in[7];
  p.conv_w = (const float*)d_in[8];
  p.a_log = (const float*)d_in[9];
  p.dt_bias = (const float*)d_in[10];
  p.hg_norm = (const float*)d_in[11];
  p.gdn_norm = (const float*)d_in[12];
  p.w_out = (const float*)d_in[13];
  p.final_norm = (const float*)d_in[14];
  p.out = (float*)d_out;
  p.ws = (char*)d_ws;
  if (ws_size < W_END) { fprintf(stderr, "workspace too small: %zu < %zu\n", ws_size, (size_t)W_END); return; }
#if MEGA
  static int grid_blocks = 0;
  if (!grid_blocks) {
    int dev = 0, cus = 0, per_cu = 0;
    hipGetDevice(&dev);
    hipDeviceGetAttribute(&cus, hipDeviceAttributeMultiprocessorCount, dev);
    hipFuncSetAttribute((const void*)mega_kernel, hipFuncAttributeMaxDynamicSharedMemorySize, (int)LDS_BYTES);
    hipOccupancyMaxActiveBlocksPerMultiprocessor(&per_cu, mega_kernel, NTH, LDS_BYTES);
    if (per_cu < 1) per_cu = 1;
    grid_blocks = cus * per_cu;
  }
  (void)hipMemsetAsync((char*)d_ws + W_BAR, 0, 16384, stream);
  void* args[] = {&p};
  hipError_t e = hipLaunchCooperativeKernel((void*)mega_kernel, dim3(grid_blocks), dim3(NTH), args, LDS_BYTES, stream);
  if (e != hipSuccess) fprintf(stderr, "cooperative launch failed: %s (grid %d)\n", hipGetErrorString(e), grid_blocks);
#else
  const int grid = 256;
  launch_phase<0>(p, grid, stream);
  launch_phase<1>(p, grid, stream);
  launch_phase<2>(p, grid, stream);
  launch_phase<3>(p, grid, stream);
  launch_phase<4>(p, grid, stream);
  launch_phase<5>(p, grid, stream);
  launch_phase<6>(p, grid, stream);
#endif
}
```

```cpp
#include <hip/hip_runtime.h>
#include <hip/hip_cooperative_groups.h>
#include <cstdio>
namespace cg = cooperative_groups;

#ifndef MEGA
#define MEGA 1
#define PROBE_GEMM 0
#define PROBE_SYNC 0
#define PROBE_G 0
#define DUP_MASK 0
#endif

typedef unsigned short u16;
using bf16x8 = __attribute__((ext_vector_type(8))) short;
using f32x4 = __attribute__((ext_vector_type(4))) float;
using u32x4 = __attribute__((ext_vector_type(4))) unsigned;
using u32x2 = __attribute__((ext_vector_type(2))) unsigned;

#define NTH 512
constexpr int MP = 16384, MS = 128, MT = 16512, DM = 1024, DIN = 4104, PQW = 2560;
constexpr float EPS = 1e-6f;
constexpr int LDK = 1088;
constexpr size_t LDS_BYTES = 139264;

constexpr size_t O_YP = 0, O_YS = 16777216, O_HGP = 16908288, O_GDP = 17432576, O_CVP = 17956864,
                 O_HGS = 17993728, O_GDS = 26382336, O_CVS = 34770944;
constexpr size_t W_WINT = 0;
constexpr size_t W_WOUTT = W_WINT + (size_t)4096 * LDK * 2;
constexpr size_t W_BETA = W_WOUTT + (size_t)1024 * LDK * 2;
constexpr size_t W_GDEC = W_BETA + 264192;
constexpr size_t W_DVEC = W_GDEC + 264192;
constexpr size_t W_DSC = W_DVEC + 1048576;
constexpr size_t W_PQ = W_DSC + 4096;
constexpr size_t W_GATES = W_PQ + 84541440;
constexpr size_t W_H = W_GATES + 33816576;
constexpr size_t W_QS = W_H + (size_t)MT * LDK * 2;
constexpr size_t W_MNEG = W_QS + 33554432;
constexpr size_t W_LF = W_MNEG + 33554432;
constexpr size_t W_BAR = W_LF + 33816576;
constexpr size_t W_END = W_BAR + 16384;

struct Params {
  const float *x_prompt, *x_sample, *state_hgrn, *state_gdn, *state_conv, *norm_w, *w_in, *lb_logits,
      *conv_w, *a_log, *dt_bias, *hg_norm, *gdn_norm, *w_out, *final_norm;
  float* out;
  char* ws;
};

__device__ __forceinline__ int opaque_tid() { int t = threadIdx.x; asm volatile("" : "+v"(t)); return t; }
typedef __bf16 bf16x2_t __attribute__((ext_vector_type(2)));
typedef float f32x2_t __attribute__((ext_vector_type(2)));
__device__ __forceinline__ u16 f2bf(float x) { return __builtin_bit_cast(u16, (__bf16)x); }
__device__ __forceinline__ float bf2f(u16 h) { return __uint_as_float(((unsigned)h) << 16); }
__device__ __forceinline__ unsigned pack2(float a, float b) {
  f32x2_t v = {a, b};
  return __builtin_bit_cast(unsigned, __builtin_convertvector(v, bf16x2_t));
}
template <int CTRL, int ROWMASK>
__device__ __forceinline__ float dpp_mov(float v) {
  return __builtin_bit_cast(float, __builtin_amdgcn_update_dpp(0, __builtin_bit_cast(int, v), CTRL, ROWMASK, 0xf, false));
}
__device__ __forceinline__ float wave_sum(float v) {
  v += dpp_mov<0xB1, 0xf>(v);
  v += dpp_mov<0x4E, 0xf>(v);
  v += dpp_mov<0x141, 0xf>(v);
  v += dpp_mov<0x140, 0xf>(v);
  v += dpp_mov<0x142, 0xa>(v);
  v += dpp_mov<0x143, 0xc>(v);
  return __builtin_bit_cast(float, __builtin_amdgcn_readlane(__builtin_bit_cast(int, v), 63));
}
__device__ __forceinline__ float sigmoidf_(float x) { return 1.f / (1.f + __expf(-x)); }
__device__ __forceinline__ float siluf_(float x) { return x / (1.f + __expf(-x)); }
__device__ __forceinline__ f32x4 mfma16(bf16x8 a, bf16x8 b, f32x4 c) {
  return __builtin_amdgcn_mfma_f32_16x16x32_bf16(a, b, c, 0, 0, 0);
}
__device__ __forceinline__ bf16x8 frag(const u16* base, int row0, int stride, int koff, int lane) {
  return *(const bf16x8*)(base + (row0 + (lane & 15)) * stride + koff + (lane >> 4) * 8);
}

__device__ __forceinline__ void quad_transpose(float (&v)[4], int lane) {
  {
    const bool b = lane & 1;
    float s0 = b ? v[0] : v[1], s1 = b ? v[2] : v[3];
    float r0 = dpp_mov<0xB1, 0xf>(s0), r1 = dpp_mov<0xB1, 0xf>(s1);
    if (b) { v[0] = r0; v[2] = r1; } else { v[1] = r0; v[3] = r1; }
  }
  {
    const bool b = lane & 2;
    float s0 = b ? v[0] : v[2], s1 = b ? v[1] : v[3];
    float r0 = dpp_mov<0x4E, 0xf>(s0), r1 = dpp_mov<0x4E, 0xf>(s1);
    if (b) { v[0] = r0; v[1] = r1; } else { v[2] = r0; v[3] = r1; }
  }
}
__device__ __forceinline__ void store4_bf16(u16* dst, const float (&v)[4]) {
  *(u32x2*)dst = u32x2{pack2(v[0], v[1]), pack2(v[2], v[3])};
}
__device__ void phase0(const Params& p, char* smem, int bid, int nb) {
  const int tid = opaque_tid(), lane = tid & 63, w = tid >> 6;
  u16* WinT = (u16*)(p.ws + W_WINT);
  u16* WoutT = (u16*)(p.ws + W_WOUTT);
  u16* H = (u16*)(p.ws + W_H);
  float* BETA = (float*)(p.ws + W_BETA);
  float* GDEC = (float*)(p.ws + W_GDEC);
  float* tl = (float*)smem;
  for (int t = bid; t < 1280; t += nb) {
    const float* src; int sstride; u16* dst; int kt, nt;
    if (t < 1024) { src = p.w_in; sstride = DIN; dst = WinT; kt = t >> 6; nt = t & 63; }
    else { int u = t - 1024; src = p.w_out; sstride = 1024; dst = WoutT; kt = u >> 4; nt = u & 15; }
#pragma unroll
    for (int i = 0; i < 8; ++i) {
      int idx = tid + 512 * i; int kk = idx >> 6, nn = idx & 63;
      tl[kk * 65 + nn] = src[(size_t)(kt * 64 + kk) * sstride + nt * 64 + nn];
    }
    __syncthreads();
    {
      int nn = tid >> 3, k8 = (tid & 7) * 8;
      unsigned pk[4];
#pragma unroll
      for (int e = 0; e < 4; ++e) pk[e] = pack2(tl[(k8 + 2 * e) * 65 + nn], tl[(k8 + 2 * e + 1) * 65 + nn]);
      *(uint4*)(dst + (size_t)(nt * 64 + nn) * LDK + kt * 64 + k8) = make_uint4(pk[0], pk[1], pk[2], pk[3]);
    }
    __syncthreads();
  }
  float* W8s = (float*)smem;
  for (int idx = tid; idx < 8192; idx += 512) {
    int j = idx & 7, k = idx >> 3;
    W8s[j * 1024 + k] = p.w_in[(size_t)k * DIN + 4096 + j];
  }
  __syncthreads();
  for (int g = bid; g < MT / 8; g += nb) {
    int row = g * 8 + w;
    const float* x = row < MP ? p.x_prompt + (size_t)row * 1024 : p.x_sample + (size_t)(row - MP) * 1024;
    float4 xv[4];
    float ss = 0.f;
#pragma unroll
    for (int i = 0; i < 4; ++i) {
      xv[i] = *(const float4*)(x + i * 256 + lane * 4);
      ss += xv[i].x * xv[i].x + xv[i].y * xv[i].y + xv[i].z * xv[i].z + xv[i].w * xv[i].w;
    }
    ss = wave_sum(ss);
    float rstd = rsqrtf(ss * (1.f / 1024.f) + EPS);
    float d0 = 0, d1 = 0, d2 = 0, d3 = 0, d4 = 0, d5 = 0, d6 = 0, d7 = 0;
#pragma unroll
    for (int i = 0; i < 4; ++i) {
      float4 nw = *(const float4*)(p.norm_w + i * 256 + lane * 4);
      float4 hv;
      hv.x = xv[i].x * rstd * nw.x; hv.y = xv[i].y * rstd * nw.y; hv.z = xv[i].z * rstd * nw.z; hv.w = xv[i].w * rstd * nw.w;
      *(uint2*)(H + (size_t)row * LDK + i * 256 + lane * 4) = make_uint2(pack2(hv.x, hv.y), pack2(hv.z, hv.w));
#define GDOT(j, dj) { float4 wv = *(const float4*)(W8s + j * 1024 + i * 256 + lane * 4); dj += hv.x * wv.x + hv.y * wv.y + hv.z * wv.z + hv.w * wv.w; }
      GDOT(0, d0) GDOT(1, d1) GDOT(2, d2) GDOT(3, d3) GDOT(4, d4) GDOT(5, d5) GDOT(6, d6) GDOT(7, d7)
#undef GDOT
    }
    d0 = wave_sum(d0); d1 = wave_sum(d1); d2 = wave_sum(d2); d3 = wave_sum(d3);
    d4 = wave_sum(d4); d5 = wave_sum(d5); d6 = wave_sum(d6); d7 = wave_sum(d7);
    if (lane < 4) {
      float gb = lane == 0 ? d0 : lane == 1 ? d1 : lane == 2 ? d2 : d3;
      float ga = lane == 0 ? d4 : lane == 1 ? d5 : lane == 2 ? d6 : d7;
      BETA[row * 4 + lane] = 1.f / (1.f + expf(-gb));
      float z = ga + p.dt_bias[lane];
      float sp = z > 20.f ? z : log1pf(expf(z));
      GDEC[row * 4 + lane] = -expf(p.a_log[lane]) * sp;
    }
  }
  __syncthreads();
}

__device__ __forceinline__ int lds_byte2(int r, int c) {
  int st = (r >> 4) * 2 + (c >> 5), ob = (r & 15) * 64 + (c & 31) * 2;
  return st * 1024 + (ob ^ (((ob >> 9) & 1) << 5));
}
__device__ __forceinline__ void stage_rc2(int b, int& R, int& C) {
  int st = b >> 10, sb = b & 1023, swz = sb ^ (((sb >> 9) & 1) << 5);
  R = (st >> 1) * 16 + swz / 64;
  C = (st & 1) * 32 + (swz % 64) / 2;
}
template <int EPI, int SEC>
__device__ __forceinline__ void epi_store4(const Params& p, int row, int col4, const float (&v)[4]) {
  if (EPI == 0) {
    u16* PQ = (u16*)(p.ws + W_PQ);
    u16* GATES = (u16*)(p.ws + W_GATES);
    float* LF = (float*)(p.ws + W_LF);
    const int sec = SEC >= 0 ? SEC : (col4 >> 9);
    if (sec == 0) {
      *(uint2*)(PQ + (size_t)row * PQW + col4) = make_uint2(pack2(v[0], v[1]), pack2(v[2], v[3]));
    } else if (sec == 1) {
      const int cc = col4 - 512;
      const f32x4 l0 = *(const f32x4*)(p.lb_logits + cc), l1 = *(const f32x4*)(p.lb_logits + 512 + cc);
      f32x4 o;
#pragma unroll
      for (int i = 0; i < 4; ++i) {
        const float lbv = 1.f / (1.f + __expf(l1[i] - l0[i]));
        o[i] = __logf(lbv + (1.f - lbv) / (1.f + __expf(-v[i])));
      }
      *(f32x4*)(LF + (size_t)row * 512 + cc) = o;
    } else if (sec == 2) {
      *(uint2*)(PQ + (size_t)row * PQW + 512 + (col4 - 1024)) = make_uint2(pack2(v[0], v[1]), pack2(v[2], v[3]));
    } else if (sec == 3 || sec == 7) {
      const int cc = sec == 3 ? col4 - 1536 : 512 + col4 - 3584;
      *(uint2*)(GATES + (size_t)row * 1024 + cc) =
          make_uint2(pack2(v[0] / (1.f + __expf(-v[0])), v[1] / (1.f + __expf(-v[1]))),
                     pack2(v[2] / (1.f + __expf(-v[2])), v[3] / (1.f + __expf(-v[3]))));
    } else {
      const int cc = col4 - 2048;
      *(uint2*)(PQ + (size_t)row * PQW + 1024 + cc) = make_uint2(pack2(v[0], v[1]), pack2(v[2], v[3]));
      if (row < MP) {
        const int tt = row & 2047;
        if (tt >= 2045) *(f32x4*)(p.out + O_CVP + (size_t)((row >> 11) * 3 + (tt - 2045)) * 1536 + cc) = f32x4{v[0], v[1], v[2], v[3]};
      } else {
        *(f32x4*)(p.out + O_CVS + (size_t)((row - MP) * 3 + 2) * 1536 + cc) = f32x4{v[0], v[1], v[2], v[3]};
      }
    }
  } else {
    const float* xr = row < MP ? p.x_prompt + (size_t)row * 1024 : p.x_sample + (size_t)(row - MP) * 1024;
    float* yr = row < MP ? p.out + O_YP + (size_t)row * 1024 : p.out + O_YS + (size_t)(row - MP) * 1024;
    const f32x4 xv = *(const f32x4*)(xr + col4);
    *(f32x4*)(yr + col4) = f32x4{xv[0] + v[0], xv[1] + v[1], xv[2] + v[2], xv[3] + v[3]};
  }
}

template <int EPI, int MODE = 0>
__device__ void gemm_phase(const Params& p, const u16* __restrict__ A, const u16* __restrict__ Bt, int ntn,
                           char* smem, int bid, int nb) {
  const int tid = opaque_tid(), lane = tid & 63, wid = tid >> 6;
  const int wr = wid >> 2, wc = wid & 3, fr = lane & 15, fq = lane >> 4;
  constexpr int TILE_B = 256 * 64 * 2, STAGE_B = 2 * TILE_B;
  int sR0, sC0;
  stage_rc2(wid * 1024 + lane * 16, sR0, sC0);
  const unsigned goff = (unsigned)(sR0 * LDK + sC0);
  const unsigned lbase = (unsigned)(size_t)smem + (unsigned)(wid * 1024);
  const int aoff = (wr * 16) * 1024 + ((fr * 64 + fq * 16) ^ ((((fr * 64 + fq * 16) >> 9) & 1) << 5));
  const int boff = TILE_B + (wc * 8) * 1024 + ((fr * 64 + fq * 16) ^ ((((fr * 64 + fq * 16) >> 9) & 1) << 5));
  const int ntiles = 64 * ntn;
  auto tile_mn = [&](int tile, int& tm, int& tn) {
    const int rnd = tile >> 8, t = tile & 255, xcd = t & 7, j = t >> 3;
    if (ntn == 16) { tm = rnd * 16 + (xcd >> 1) * 4 + (j & 3); tn = ((xcd & 1) * 8 + (j >> 2) + (rnd & 1) * 2 + (rnd >> 1) * 8) & 15; }
    else { tm = xcd * 8 + (j & 7); tn = j >> 3; }
  };
  bool staged = false;
  for (int tile = bid; tile < ntiles; tile += nb) {
    int tm, tn;
    tile_mn(tile, tm, tn);
    const u16* Ab = A + (size_t)tm * 256 * LDK;
    const u16* Bb = Bt + (size_t)tn * 256 * LDK;
    f32x4 acc[8][4];
#pragma unroll
    for (int m = 0; m < 8; ++m)
#pragma unroll
      for (int n = 0; n < 4; ++n) acc[m][n] = f32x4{0.f, 0.f, 0.f, 0.f};
#define G_STAGE(buf, kt) { _Pragma("unroll") for (int i = 0; i < 4; ++i) { \
      __builtin_amdgcn_global_load_lds((const unsigned*)(Ab + (goff + (unsigned)(i * 64 * LDK + (kt) * 64))), \
          (__attribute__((address_space(3))) unsigned*)(lbase + (buf) * STAGE_B + i * 8192), 16, 0, 0); \
      __builtin_amdgcn_global_load_lds((const unsigned*)(Bb + (goff + (unsigned)(i * 64 * LDK + (kt) * 64))), \
          (__attribute__((address_space(3))) unsigned*)(lbase + (buf) * STAGE_B + TILE_B + i * 8192), 16, 0, 0); } }
#define G_PIECE_A(buf, kt, i) __builtin_amdgcn_global_load_lds((const unsigned*)(Ab + (goff + (unsigned)((i) * 64 * LDK + (kt) * 64))), \
          (__attribute__((address_space(3))) unsigned*)(lbase + (buf) * STAGE_B + (i) * 8192), 16, 0, 0)
#define G_PIECE_B(buf, kt, i) __builtin_amdgcn_global_load_lds((const unsigned*)(Bb + (goff + (unsigned)((i) * 64 * LDK + (kt) * 64))), \
          (__attribute__((address_space(3))) unsigned*)(lbase + (buf) * STAGE_B + TILE_B + (i) * 8192), 16, 0, 0)
    if (!staged) G_STAGE(0, 0);
    asm volatile("s_waitcnt vmcnt(0)" ::: "memory");
    __syncthreads();
    for (int t = 0; t < 16; ++t) {
      const int cur = t & 1;
      const bool more = (MODE != 2) && (t + 1 < 16);
      const char* sA = smem + cur * STAGE_B + aoff;
      const char* sB = smem + cur * STAGE_B + boff;
#pragma unroll
      for (int ks = 0; ks < 2; ++ks) {
        bf16x8 At[8], Bf[4];
#pragma unroll
        for (int m = 0; m < 8; ++m) At[m] = *(const bf16x8*)(sA + (m * 2 + ks) * 1024);
#pragma unroll
        for (int n = 0; n < 4; ++n) Bf[n] = *(const bf16x8*)(sB + (n * 2 + ks) * 1024);
        if (MODE != 3) {
#pragma unroll
          for (int m = 0; m < 8; ++m) {
#pragma unroll
            for (int n = 0; n < 4; ++n) acc[m][n] = mfma16(At[m], Bf[n], acc[m][n]);
            if (ks == 0 && more) {
              if (m < 4) G_PIECE_A(cur ^ 1, t + 1, m); else G_PIECE_B(cur ^ 1, t + 1, m - 4);
              __builtin_amdgcn_sched_barrier(0);
            }
          }
        } else {
          if (ks == 0 && more) G_STAGE(cur ^ 1, t + 1);
#pragma unroll
          for (int m = 0; m < 8; ++m) acc[m][0][0] += __builtin_bit_cast(float, (int)At[m][0]);
#pragma unroll
          for (int n = 0; n < 4; ++n) acc[0][n][1] += __builtin_bit_cast(float, (int)Bf[n][0]);
        }
        __builtin_amdgcn_sched_barrier(0);
      }
      asm volatile("s_waitcnt vmcnt(0)" ::: "memory");
      __syncthreads();
    }
    staged = false;
    if (tile + nb < ntiles) {
      int tm2, tn2;
      tile_mn(tile + nb, tm2, tn2);
      const u16* Ab2 = A + (size_t)tm2 * 256 * LDK;
      const u16* Bb2 = Bt + (size_t)tn2 * 256 * LDK;
      { const u16* Ab = Ab2; const u16* Bb = Bb2; G_STAGE(0, 0); }
      staged = true;
    }
#undef G_STAGE
#undef G_PIECE_A
#undef G_PIECE_B
    if (MODE != 0 && MODE != 5) {
      float chk = 0.f;
#pragma unroll
      for (int m = 0; m < 8; ++m)
#pragma unroll
        for (int n = 0; n < 4; ++n) chk += acc[m][n][0] + acc[m][n][1] + acc[m][n][2] + acc[m][n][3];
      if (chk == 1.2345e-30f) p.out[0] = chk;
    } else
    {
      int t2 = threadIdx.x;
      asm volatile("" : "+v"(t2));
      const int lane2 = t2 & 63, wid2 = t2 >> 6;
      const int rbase = tm * 256 + (wid2 >> 2) * 128 + (lane2 >> 4) * 4 + (lane2 & 3);
      const int cbase = tn * 256 + (wid2 & 3) * 64 + (lane2 & 12);
#define EPI_LOOP(SEC) { _Pragma("unroll") for (int m = 0; m < 8; ++m) { _Pragma("unroll") for (int n = 0; n < 4; ++n) { \
          float v[4] = {acc[m][n][0], acc[m][n][1], acc[m][n][2], acc[m][n][3]}; \
          quad_transpose(v, lane2); \
          epi_store4<EPI, SEC>(p, rbase + m * 16, cbase + n * 16, v); } } }
      if (EPI == 0) {
        const int sec = tn >> 1;
        if (sec == 1) {
          float* LF = (float*)(p.ws + W_LF);
          float lbv[4][4];
#pragma unroll
          for (int n = 0; n < 4; ++n) {
            const int cc = cbase + n * 16 - 512;
            const f32x4 l0 = *(const f32x4*)(p.lb_logits + cc), l1 = *(const f32x4*)(p.lb_logits + 512 + cc);
#pragma unroll
            for (int e = 0; e < 4; ++e) lbv[n][e] = 1.f / (1.f + __expf(l1[e] - l0[e]));
          }
#pragma unroll
          for (int m = 0; m < 8; ++m)
#pragma unroll
            for (int n = 0; n < 4; ++n) {
              float v[4] = {acc[m][n][0], acc[m][n][1], acc[m][n][2], acc[m][n][3]};
              quad_transpose(v, lane2);
              f32x4 o;
#pragma unroll
              for (int e = 0; e < 4; ++e) o[e] = __logf(lbv[n][e] + (1.f - lbv[n][e]) * __builtin_amdgcn_rcpf(1.f + __expf(-v[e])));
              *(f32x4*)(LF + (size_t)(rbase + m * 16) * 512 + (cbase + n * 16 - 512)) = o;
            }
        } else {
          const bool gate = (sec == 3 || sec == 7);
          u16* dstb; int dstride, dcol;
          const int c0 = tn * 256 + (wid2 & 3) * 64;
          if (gate) { dstb = (u16*)(p.ws + W_GATES); dstride = 1024; dcol = sec == 3 ? c0 - 1536 : 512 + c0 - 3584; }
          else { dstb = (u16*)(p.ws + W_PQ); dstride = PQW; dcol = sec == 0 ? c0 : sec == 2 ? 512 + c0 - 1024 : 1024 + c0 - 2048; }
          char* ebuf = smem + STAGE_B + wid2 * 8192;
          const int wrow = (lane2 >> 4) * 4 + (lane2 & 3), wcol = (lane2 & 12);
          const int row00 = tm * 256 + (wid2 >> 2) * 128;
#pragma unroll
          for (int hf = 0; hf < 2; ++hf) {
#pragma unroll
            for (int m = 0; m < 4; ++m)
#pragma unroll
              for (int n = 0; n < 4; ++n) {
                float v[4] = {acc[hf * 4 + m][n][0], acc[hf * 4 + m][n][1], acc[hf * 4 + m][n][2], acc[hf * 4 + m][n][3]};
                if (gate) {
#pragma unroll
                  for (int e = 0; e < 4; ++e) v[e] = v[e] / (1.f + __expf(-v[e]));
                }
                quad_transpose(v, lane2);
                const int rl = m * 16 + wrow, cl = n * 16 + wcol;
                *(u32x2*)(ebuf + rl * 128 + ((cl * 2) ^ ((rl & 7) << 4))) = u32x2{pack2(v[0], v[1]), pack2(v[2], v[3])};
                if (sec >= 4 && sec <= 6) {
                  const int row = row00 + hf * 64 + rl, cc = c0 - 2048 + cl;
                  const int tt = row & 2047;
                  if (tt >= 2045) *(f32x4*)(p.out + O_CVP + (size_t)((row >> 11) * 3 + (tt - 2045)) * 1536 + cc) = f32x4{v[0], v[1], v[2], v[3]};
                }
              }
            asm volatile("s_waitcnt lgkmcnt(0)" ::: "memory");
#pragma unroll
            for (int i = 0; i < 8; ++i) {
              const int rl = i * 8 + (lane2 >> 3), ch = lane2 & 7;
              const u32x4 d = *(const u32x4*)(ebuf + rl * 128 + ((ch ^ (rl & 7)) << 4));
              *(u32x4*)(dstb + (size_t)(row00 + hf * 64 + rl) * dstride + dcol + ch * 8) = d;
            }
            asm volatile("s_waitcnt lgkmcnt(0)" ::: "memory");
          }
        }
      } else EPI_LOOP(0)
#undef EPI_LOOP
    }
  }
  const int nunits = MODE == 0 ? ntn * 16 : 0;
  int t3 = threadIdx.x;
  asm volatile("" : "+v"(t3));
  for (int u = bid; u < nunits; u += nb) {
    const int lane = t3 & 63, wid = t3 >> 6, fr = lane & 15, fq = lane >> 4;
    const u16* ar = A + (size_t)(MP + fr) * LDK + wid * 128 + fq * 8;
    const u16* br = Bt + (size_t)(u * 16 + fr) * LDK + wid * 128 + fq * 8;
    bf16x8 bfr[4];
#pragma unroll
    for (int ks = 0; ks < 4; ++ks) bfr[ks] = *(const bf16x8*)(br + ks * 32);
    bf16x8 afr[8][4];
#pragma unroll
    for (int rt = 0; rt < 8; ++rt)
#pragma unroll
      for (int ks = 0; ks < 4; ++ks) afr[rt][ks] = *(const bf16x8*)(ar + (size_t)rt * 16 * LDK + ks * 32);
    f32x4* red = (f32x4*)smem;
#pragma unroll
    for (int rt = 0; rt < 8; ++rt) {
      f32x4 acc = {0.f, 0.f, 0.f, 0.f};
#pragma unroll
      for (int ks = 0; ks < 4; ++ks) acc = mfma16(afr[rt][ks], bfr[ks], acc);
      red[(wid * 8 + rt) * 64 + lane] = acc;
    }
    __syncthreads();
    f32x4 tot = red[(0 * 8 + wid) * 64 + lane];
#pragma unroll
    for (int sw = 1; sw < 8; ++sw) tot += red[(sw * 8 + wid) * 64 + lane];
    float v[4] = {tot[0], tot[1], tot[2], tot[3]};
    quad_transpose(v, lane);
    epi_store4<EPI, -1>(p, MP + wid * 16 + fq * 4 + (lane & 3), u * 16 + (fr & ~3), v);
    __syncthreads();
  }
  __syncthreads();
}

#define XB_TMO      128
#define XB_XCNT(j)  (256  + 64 * (j))
#define XB_XSUB(j)  (1280 + 64 * (j))
#define XB_XGEN(j)  (2304 + 64 * (j))
#define XB_TOP      3328
#define XB_TOPGEN   3392
#define XCD_BAR_WORDS 3456
#define XB_SPIN_CAP (1u << 18)
#define LAS __attribute__((address_space(3)))
__device__ __forceinline__ unsigned xb_ld(unsigned* p)              { return __hip_atomic_load(p, __ATOMIC_RELAXED, __HIP_MEMORY_SCOPE_AGENT); }
__device__ __forceinline__ unsigned xb_add(unsigned* p, unsigned v) { return __hip_atomic_fetch_add(p, v, __ATOMIC_RELAXED, __HIP_MEMORY_SCOPE_AGENT); }
__device__ __forceinline__ unsigned xb_xcc_id() { return (unsigned)__builtin_amdgcn_s_getreg((3 << 11) | 20) & 0xFu; }
#define XB_SPIN(cond, bar) do { unsigned _sp = 0; while (cond) { __builtin_amdgcn_s_sleep(1); \
    if ((++_sp & 255u) == 0u) { if (xb_ld(&(bar)[XB_TMO])) break; if (_sp > XB_SPIN_CAP) { atomicAdd(&(bar)[XB_TMO], 1u); break; } } } } while (0)
struct XcdBarrier { unsigned* bar; unsigned x; volatile LAS unsigned* st; };
__device__ __forceinline__ XcdBarrier xcd_barrier_post(unsigned* bar, volatile LAS unsigned* st) {
  XcdBarrier b; b.bar = bar; b.x = xb_xcc_id(); b.st = st;
  if (threadIdx.x == 0) (void)xb_add(&bar[XB_XCNT(b.x)], 1u);
  return b;
}
__device__ __forceinline__ void xcd_barrier_complete(unsigned* bar, unsigned x, unsigned& nloc, unsigned& nx) {
  const unsigned G = gridDim.x * gridDim.y * gridDim.z;
  unsigned sum, cnt, mine, sp = 0u;
  for (;;) {
    sum = 0u; cnt = 0u; mine = 0u;
#pragma unroll
    for (unsigned j = 0; j < 16; ++j) { const unsigned c = xb_ld(&bar[XB_XCNT(j)]); sum += c; cnt += (c > 0u) ? 1u : 0u; mine = (j == x) ? c : mine; }
    if (sum == G) break;
    __builtin_amdgcn_s_sleep(1);
    if ((++sp & 255u) == 0u) { if (xb_ld(&bar[XB_TMO])) break; if (sp > XB_SPIN_CAP) { atomicAdd(&bar[XB_TMO], 1u); break; } }
  }
  nloc = mine > 0u ? mine : 1u; nx = cnt > 0u ? cnt : 1u;
}
__device__ __forceinline__ void xcd_barrier(const XcdBarrier& b) {
  asm volatile("s_waitcnt vmcnt(0)" ::: "memory");
  __syncthreads();
  if (threadIdx.x == 0) {
    unsigned* bar = b.bar;
    __builtin_amdgcn_s_waitcnt(0);
    unsigned nloc = b.st[0], nx = b.st[1];
    if (nloc == 0u) { xcd_barrier_complete(bar, b.x, nloc, nx); b.st[0] = nloc; b.st[1] = nx; }
    const unsigned old = xb_add(&bar[XB_XSUB(b.x)], 1u);
    const unsigned gen = old / nloc;
    if (old + 1u == (gen + 1u) * nloc) {
      __builtin_amdgcn_fence(__ATOMIC_RELEASE, "agent");
      asm volatile("s_waitcnt vmcnt(0)" ::: "memory");
      const unsigned og = xb_add(&bar[XB_TOP], 1u);
      const unsigned tg = og / nx;
      if (og + 1u == (tg + 1u) * nx) xb_add(&bar[XB_TOPGEN], 1u);
      else XB_SPIN(xb_ld(&bar[XB_TOPGEN]) == tg, bar);
      __builtin_amdgcn_fence(__ATOMIC_ACQUIRE, "agent");
      xb_add(&bar[XB_XGEN(b.x)], 1u);
      asm volatile("s_waitcnt vmcnt(0)" ::: "memory");
    } else {
      XB_SPIN(xb_ld(&bar[XB_XGEN(b.x)]) == gen, bar);
      __builtin_amdgcn_fence(__ATOMIC_ACQUIRE, "agent");
      asm volatile("s_waitcnt vmcnt(0)" ::: "memory");
    }
  }
  __syncthreads();
}

#define RAW_BARRIER() do { asm volatile("s_waitcnt lgkmcnt(0)" ::: "memory"); __builtin_amdgcn_s_barrier(); asm volatile("" ::: "memory"); } while (0)
__device__ void hgrn_item(const Params& p, char* smem, int idx) {
  const int tid = opaque_tid(), lane = tid & 63, w = tid >> 6;
  const int lr = lane & 15, lq = lane >> 4;
  const int h = idx & 3, c = (idx >> 2) & 31, b = idx >> 7;
  const int r0 = b * 2048 + c * 64;
  const u16* PQ = (const u16*)(p.ws + W_PQ);
  const float* LF = (const float*)(p.ws + W_LF);
  u16* QS = (u16*)(p.ws + W_QS);
  u16* O0 = (u16*)(p.ws + W_H);
  u16* NB = (u16*)(p.out);
  float* DVEC = (float*)(p.ws + W_DVEC);
  u16* qt = (u16*)smem;
  u16* kt = qt + 64 * 136;
  u16* ktT = kt + 64 * 136;
  u16* vT = ktT + 128 * 72;
  u16* sc = vT + 128 * 72;
  float* ps = (float*)(sc + 64 * 72);
  const int col = tid & 127, part = tid >> 7;
  float lfv[16], bcum[16];
  {
    const float* lfp = LF + (size_t)(r0 + part * 16) * 512 + h * 128 + col;
#pragma unroll
    for (int i = 0; i < 16; ++i) lfv[i] = lfp[(size_t)i * 512];
    float run = 0.f;
#pragma unroll
    for (int i = 0; i < 16; ++i) { run += lfv[i]; bcum[i] = run; }
    ps[part * 128 + col] = run;
  }
  u16 qraw[16], vraw[16];
  {
    const u16* qp0 = PQ + (size_t)(r0 + part * 16) * PQW + h * 128 + col;
#pragma unroll
    for (int i = 0; i < 16; ++i) { qraw[i] = qp0[(size_t)i * PQW]; vraw[i] = qp0[(size_t)i * PQW + 512]; }
  }
  RAW_BARRIER();
  {
    float off = 0.f, blast = 0.f;
#pragma unroll
    for (int pp = 0; pp < 4; ++pp) { float t = ps[pp * 128 + col]; blast += t; if (pp < part) off += t; }
    u16* qsout = QS + ((size_t)idx * 64 + part * 16) * 128 + col;
    float kkv[16];
#pragma unroll
    for (int i = 0; i < 16; ++i) {
      const float bb = bcum[i] + off;
      const int row = part * 16 + i;
      const float q = bf2f(qraw[i]);
      qsout[i * 128] = f2bf(q * __expf(bb));
      qt[row * 136 + col] = f2bf(q * __expf(bb - blast));
      kkv[i] = (1.f - __expf(lfv[i])) * __expf(blast - bb);
      kt[row * 136 + col] = f2bf(kkv[i]);
    }
#pragma unroll
    for (int hh = 0; hh < 2; ++hh) {
      *(u32x4*)(ktT + col * 72 + part * 16 + hh * 8) =
          u32x4{pack2(kkv[hh * 8 + 0], kkv[hh * 8 + 1]), pack2(kkv[hh * 8 + 2], kkv[hh * 8 + 3]),
                pack2(kkv[hh * 8 + 4], kkv[hh * 8 + 5]), pack2(kkv[hh * 8 + 6], kkv[hh * 8 + 7])};
      *(u32x4*)(vT + col * 72 + part * 16 + hh * 8) =
          u32x4{(unsigned)vraw[hh * 8 + 0] | ((unsigned)vraw[hh * 8 + 1] << 16), (unsigned)vraw[hh * 8 + 2] | ((unsigned)vraw[hh * 8 + 3] << 16),
                (unsigned)vraw[hh * 8 + 4] | ((unsigned)vraw[hh * 8 + 5] << 16), (unsigned)vraw[hh * 8 + 6] | ((unsigned)vraw[hh * 8 + 7] << 16)};
    }
    if (part == 0) DVEC[idx * 128 + col] = __expf(blast);
  }
  RAW_BARRIER();
  {
    const int tr = w >> 1;
    bf16x8 a[4];
#pragma unroll
    for (int ks = 0; ks < 4; ++ks) a[ks] = frag(qt, tr * 16, 136, ks * 32, lane);
#pragma unroll
    for (int tci = 0; tci < 2; ++tci) {
      const int tc = (w & 1) * 2 + tci;
      f32x4 acc = {0.f, 0.f, 0.f, 0.f};
#pragma unroll
      for (int ks = 0; ks < 4; ++ks) acc = mfma16(a[ks], frag(kt, tc * 16, 136, ks * 32, lane), acc);
#pragma unroll
      for (int j = 0; j < 4; ++j) {
        const int t = tr * 16 + lq * 4 + j, s = tc * 16 + lr;
        sc[t * 72 + s] = f2bf(t >= s ? acc[j] : 0.f);
      }
    }
  }
  RAW_BARRIER();
  {
    const int tr = w >> 1;
    const bf16x8 a0 = frag(sc, tr * 16, 72, 0, lane), a1 = frag(sc, tr * 16, 72, 32, lane);
#pragma unroll
    for (int tci = 0; tci < 4; ++tci) {
      const int tc = (w & 1) * 4 + tci;
      f32x4 acc = {0.f, 0.f, 0.f, 0.f};
      acc = mfma16(a0, frag(vT, tc * 16, 72, 0, lane), acc);
      acc = mfma16(a1, frag(vT, tc * 16, 72, 32, lane), acc);
      {
        float v[4] = {acc[0], acc[1], acc[2], acc[3]};
        quad_transpose(v, lane);
        store4_bf16(O0 + ((size_t)idx * 64 + tr * 16 + lq * 4 + (lane & 3)) * 128 + tc * 16 + (lr & 12), v);
      }
    }
  }
  {
    const int tr = w;
    const bf16x8 a0 = frag(ktT, tr * 16, 72, 0, lane), a1 = frag(ktT, tr * 16, 72, 32, lane);
#pragma unroll
    for (int tc = 0; tc < 8; ++tc) {
      f32x4 acc = {0.f, 0.f, 0.f, 0.f};
      acc = mfma16(a0, frag(vT, tc * 16, 72, 0, lane), acc);
      acc = mfma16(a1, frag(vT, tc * 16, 72, 32, lane), acc);
      {
        float v[4] = {acc[0], acc[1], acc[2], acc[3]};
        quad_transpose(v, lane);
        store4_bf16(NB + ((size_t)idx * 128 + tr * 16 + lq * 4 + (lane & 3)) * 128 + tc * 16 + (lr & 12), v);
      }
    }
  }
  RAW_BARRIER();
}

constexpr int ASTR = 68;
template <int J>
struct SolveCol {
  static __device__ __forceinline__ void run(f32x4 (&x)[16], const f32x4 (&a)[16], const float* AT) {
    if constexpr (J < 63) {
      f32x4 an[16];
      if constexpr (J + 1 < 63) {
#pragma unroll
        for (int B = (J + 2) / 4; B < 16; ++B) an[B] = *(const f32x4*)(AT + (J + 1) * ASTR + B * 4);
      }
      __builtin_amdgcn_sched_barrier(0);
      const float xj = x[J / 4][J % 4];
#pragma unroll
      for (int B = (J + 1) / 4; B < 16; ++B) x[B] -= a[B] * xj;
      __builtin_amdgcn_sched_barrier(0);
      SolveCol<J + 1>::run(x, an, AT);
    }
  }
};

__device__ void gdn_item(const Params& p, char* smem, int idx) {
  const int tid = opaque_tid(), lane = tid & 63, w = tid >> 6;
  const int lr = lane & 15, lq = lane >> 4;
  const int h = idx & 3, c = (idx >> 2) & 31, b = idx >> 7;
  const int r0 = b * 2048 + c * 64;
  const u16* PQ = (const u16*)(p.ws + W_PQ);
  const float* BETA = (const float*)(p.ws + W_BETA);
  const float* GDEC = (const float*)(p.ws + W_GDEC);
  u16* QS = (u16*)(p.ws + W_QS);
  u16* O0 = (u16*)(p.ws + W_H);
  u16* NB = (u16*)(p.out);
  u16* MNEG = (u16*)(p.ws + W_MNEG);
  float* DSC = (float*)(p.ws + W_DSC);
  u16* kb = (u16*)smem;
  u16* qb = kb + 64 * 136;
  u16* vS = qb + 64 * 136;
  float* Asol = (float*)(vS + 64 * 128);
  u16* attn = (u16*)(Asol + 64 * ASTR);
  u16* khT = attn + 64 * 72;
  u16* WT = khT + 128 * 72;
  u16* U0T = WT + 128 * 72;
  float* gc = (float*)(U0T + 128 * 72);
  float* bet = gc + 64;

  if (w == 0) {
    float g = GDEC[(size_t)(r0 + lane) * 4 + h];
#pragma unroll
    for (int o = 1; o < 64; o <<= 1) { float t = __shfl_up(g, o, 64); if (lane >= o) g += t; }
    gc[lane] = g;
    bet[lane] = BETA[(size_t)(r0 + lane) * 4 + h];
  }
  for (int rep_ = 0; rep_ < ((PROBE_G & 1) ? 2 : 1); ++rep_)
  {
    const int chq = 1024 + h * 128 + 2 * lane;
    const int cwq = h * 128 + 2 * lane;
    float cw[3][4][2];
#pragma unroll
    for (int ty = 0; ty < 3; ++ty)
#pragma unroll
      for (int j = 0; j < 4; ++j) {
        float2 t2 = *(const float2*)(p.conv_w + j * 1536 + ty * 512 + cwq);
        cw[ty][j][0] = t2.x; cw[ty][j][1] = t2.y;
      }
    float win[3][3][2];
    const int t0 = w * 8;
#pragma unroll
    for (int a = 0; a < 3; ++a) {
      const int rr = t0 - 3 + a;
      const bool valid = (c > 0) || (rr >= 0);
#pragma unroll
      for (int ty = 0; ty < 3; ++ty) {
        unsigned u = 0;
        if (valid) u = *(const unsigned*)(PQ + (ptrdiff_t)(r0 + rr) * PQW + chq + ty * 512);
        win[ty][a][0] = bf2f((u16)(u & 0xffff)); win[ty][a][1] = bf2f((u16)(u >> 16));
      }
    }
#pragma unroll
    for (int tt = 0; tt < 8; ++tt) {
      const int t = t0 + tt;
      float cv[3][2];
#pragma unroll
      for (int ty = 0; ty < 3; ++ty) {
        unsigned u = *(const unsigned*)(PQ + (size_t)(r0 + t) * PQW + chq + ty * 512);
        float c0 = bf2f((u16)(u & 0xffff)), c1 = bf2f((u16)(u >> 16));
        float s0 = cw[ty][0][0] * win[ty][0][0] + cw[ty][1][0] * win[ty][1][0] + cw[ty][2][0] * win[ty][2][0] + cw[ty][3][0] * c0;
        float s1 = cw[ty][0][1] * win[ty][0][1] + cw[ty][1][1] * win[ty][1][1] + cw[ty][2][1] * win[ty][2][1] + cw[ty][3][1] * c1;
        win[ty][0][0] = win[ty][1][0]; win[ty][0][1] = win[ty][1][1];
        win[ty][1][0] = win[ty][2][0]; win[ty][1][1] = win[ty][2][1];
        win[ty][2][0] = c0; win[ty][2][1] = c1;
        cv[ty][0] = siluf_(s0); cv[ty][1] = siluf_(s1);
      }
      float ssq = wave_sum(cv[0][0] * cv[0][0] + cv[0][1] * cv[0][1]);
      float ssk = wave_sum(cv[1][0] * cv[1][0] + cv[1][1] * cv[1][1]);
      const float rq = rsqrtf(ssq + EPS) * 0.08838834764831845f;
      const float rk = rsqrtf(ssk + EPS);
      *(unsigned*)(qb + t * 136 + 2 * lane) = pack2(cv[0][0] * rq, cv[0][1] * rq);
      *(unsigned*)(kb + t * 136 + 2 * lane) = pack2(cv[1][0] * rk, cv[1][1] * rk);
      *(unsigned*)(vS + t * 128 + 2 * lane) = pack2(cv[2][0], cv[2][1]);
    }
  }
  RAW_BARRIER();
  {
    const int which = w >> 2, tr = w & 3;
    const u16* Asrc = which ? qb : kb;
    bf16x8 a[4];
#pragma unroll
    for (int ks = 0; ks < 4; ++ks) a[ks] = frag(Asrc, tr * 16, 136, ks * 32, lane);
#pragma unroll
    for (int tc = 0; tc < 4; ++tc) {
      f32x4 acc = {0.f, 0.f, 0.f, 0.f};
#pragma unroll
      for (int ks = 0; ks < 4; ++ks) acc = mfma16(a[ks], frag(kb, tc * 16, 136, ks * 32, lane), acc);
#pragma unroll
      for (int j = 0; j < 4; ++j) {
        const int t = tr * 16 + lq * 4 + j, s = tc * 16 + lr;
        const float L = __expf(fminf(gc[t] - gc[s], 0.f));
        if (which == 0) Asol[s * ASTR + t] = (t > s) ? bet[t] * acc[j] * L : 0.f;
        else attn[t * 72 + s] = f2bf((t >= s) ? acc[j] * L : 0.f);
      }
    }
  }
  RAW_BARRIER();
  for (int rep_ = 0; rep_ < ((PROBE_G & 2) ? 2 : 1); ++rep_) {
  if (tid < 256) {
    f32x4 x[16];
    if (tid < 128) {
#pragma unroll
      for (int s = 0; s < 64; ++s) { x[s >> 2][s & 3] = bf2f(vS[s * 128 + tid]) * bet[s]; if ((s & 7) == 7) __builtin_amdgcn_sched_barrier(0); }
    } else {
#pragma unroll
      for (int s = 0; s < 64; ++s) { x[s >> 2][s & 3] = bf2f(kb[s * 136 + tid - 128]) * bet[s] * __expf(gc[s]); if ((s & 7) == 7) __builtin_amdgcn_sched_barrier(0); }
    }
    {
      f32x4 a0[16];
#pragma unroll
      for (int B = 0; B < 16; ++B) a0[B] = *(const f32x4*)(Asol + B * 4);
      SolveCol<0>::run(x, a0, Asol);
    }
    u16* dst = (tid < 128) ? (U0T + tid * 72) : (WT + (tid - 128) * 72);
#pragma unroll
    for (int s8 = 0; s8 < 8; ++s8) {
      *(u32x4*)(dst + s8 * 8) = u32x4{pack2(x[2 * s8][0], x[2 * s8][1]), pack2(x[2 * s8][2], x[2 * s8][3]),
                                      pack2(x[2 * s8 + 1][0], x[2 * s8 + 1][1]), pack2(x[2 * s8 + 1][2], x[2 * s8 + 1][3])};
    }
  } else {
    const float glast = gc[63];
    const int e0 = tid - 256;
#pragma unroll 4
    for (int i = 0; i < 32; ++i) {
      const int e = e0 + 256 * i;
      const int s = e & 63, kd = e >> 6;
      khT[kd * 72 + s] = f2bf(bf2f(kb[s * 136 + kd]) * __expf(glast - gc[s]));
    }
  }
  RAW_BARRIER();
  }
  for (int rep_ = 0; rep_ < ((PROBE_G & 4) ? 2 : 1); ++rep_) {
  {
    const int tr = w & 3, half = w >> 2;
    const u16* Bsrc = half ? U0T : WT;
    const bf16x8 a0 = frag(attn, tr * 16, 72, 0, lane), a1 = frag(attn, tr * 16, 72, 32, lane);
#pragma unroll 2
    for (int tc = 0; tc < 8; ++tc) {
      f32x4 acc = {0.f, 0.f, 0.f, 0.f};
      acc = mfma16(a0, frag(Bsrc, tc * 16, 72, 0, lane), acc);
      acc = mfma16(a1, frag(Bsrc, tc * 16, 72, 32, lane), acc);
      {
        float v[4];
#pragma unroll
        for (int j = 0; j < 4; ++j) {
          const int t = tr * 16 + lq * 4 + j, n = tc * 16 + lr;
          v[j] = half == 0 ? bf2f(qb[t * 136 + n]) * __expf(gc[t]) - acc[j] : acc[j];
        }
        quad_transpose(v, lane);
        const size_t o = ((size_t)(1024 + idx) * 64 + tr * 16 + lq * 4 + (lane & 3)) * 128 + tc * 16 + (lr & 12);
        store4_bf16((half == 0 ? QS : O0) + o, v);
      }
    }
  }
  {
    const int tr = w;
    const bf16x8 a0 = frag(khT, tr * 16, 72, 0, lane), a1 = frag(khT, tr * 16, 72, 32, lane);
#pragma unroll 2
    for (int tc = 0; tc < 16; ++tc) {
      const u16* Bsrc = tc < 8 ? WT : U0T;
      const int tcc = tc & 7;
      f32x4 acc = {0.f, 0.f, 0.f, 0.f};
      acc = mfma16(a0, frag(Bsrc, tcc * 16, 72, 0, lane), acc);
      acc = mfma16(a1, frag(Bsrc, tcc * 16, 72, 32, lane), acc);
      {
        float v[4];
#pragma unroll
        for (int j = 0; j < 4; ++j) v[j] = tc < 8 ? -acc[j] : acc[j];
        quad_transpose(v, lane);
        const size_t o = (size_t)(tr * 16 + lq * 4 + (lane & 3)) * 128 + tcc * 16 + (lr & 12);
        store4_bf16((tc < 8 ? MNEG + (size_t)idx * 16384 : NB + (size_t)(1024 + idx) * 16384) + o, v);
      }
    }
  }
  }
  if (tid < 128) ((float*)(p.ws + W_DVEC))[(size_t)(1024 + idx) * 128 + tid] = __expf(gc[63]);
  RAW_BARRIER();
}

__device__ void phase2(const Params& p, char* smem, int bid, int nb) {
  for (int it = bid; it < 2048; it += nb) {
    if (it >= 1024) { gdn_item(p, smem, it - 1024); if (DUP_MASK & 2048) gdn_item(p, smem, it - 1024); }
    else { hgrn_item(p, smem, it); if (DUP_MASK & 1024) hgrn_item(p, smem, it); }
  }
}

struct ScanRegs {
  bf16x8 Aq[4];
  bf16x8 Am[4];
  u32x2 o0, nn0, nn1;
  f32x4 dd;
};

template <int TYPE>
__device__ __forceinline__ void scan_load(ScanRegs& r, const Params& p, int idx, unsigned qoff, unsigned ooff, unsigned moff,
                                          unsigned noff, unsigned doff) {
  const int ii = __builtin_amdgcn_readfirstlane(idx);
  const int ti = TYPE * 1024 + ii;
  const u16* QSb = (const u16*)(p.ws + W_QS) + (size_t)ti * 8192;
  const u16* O0b = (const u16*)(p.ws + W_H) + (size_t)ti * 8192;
  const u16* NBb = (const u16*)(p.out) + (size_t)ti * 16384;
#pragma unroll
  for (int ks = 0; ks < 4; ++ks) r.Aq[ks] = *(const bf16x8*)(QSb + (qoff + ks * 32));
  r.o0 = *(const u32x2*)(O0b + ooff);
  r.nn0 = *(const u32x2*)(NBb + noff);
  r.nn1 = *(const u32x2*)(NBb + (noff + 16));
  if (TYPE == 1) {
    const u16* Mb = (const u16*)(p.ws + W_MNEG) + (size_t)ii * 16384;
#pragma unroll
    for (int ks = 0; ks < 4; ++ks) r.Am[ks] = *(const bf16x8*)(Mb + (moff + ks * 32));
  }
  r.dd = *(const f32x4*)((const float*)(p.ws + W_DVEC) + (size_t)ti * 128 + doff);
}
__device__ __forceinline__ void unpack4(u32x2 u, float (&v)[4]) {
  v[0] = bf2f((u16)(u[0] & 0xffff)); v[1] = bf2f((u16)(u[0] >> 16));
  v[2] = bf2f((u16)(u[1] & 0xffff)); v[3] = bf2f((u16)(u[1] >> 16));
}

template <int TYPE>
__device__ void scan_unit(const Params& p, char* smem, int rem) {
  const int tid = opaque_tid(), lane = tid & 63, w = tid >> 6;
  const int lr = lane & 15, lq = lane >> 4;
  const int b = rem >> 4, h = (rem >> 2) & 3, vs2 = rem & 3;
  const int tr = lq * 4 + (lane & 3), tc4 = lr & 12;
  const int otr = w & 3, otc = w >> 2;
  float* OPRE = (float*)(p.ws + W_PQ);
  u16* SbT = (u16*)smem;
  for (int i = tid; i < 2 * 32 * 136; i += 512) SbT[i] = 0;
  f32x4 S0 = {0.f, 0.f, 0.f, 0.f}, S1 = {0.f, 0.f, 0.f, 0.f};
  const unsigned qoff = (unsigned)((otr * 16 + lr) * 128 + lq * 8);
  const unsigned ooff = (unsigned)((otr * 16 + tr) * 128 + vs2 * 32 + otc * 16 + tc4);
  const unsigned moff = (unsigned)((w * 16 + lr) * 128 + lq * 8);
  const unsigned noff = (unsigned)((w * 16 + tr) * 128 + vs2 * 32 + tc4);
  const unsigned doff = (unsigned)(w * 16 + lq * 4);
  float* const orow = OPRE + (size_t)(b * 2048 + otr * 16 + tr) * 1024 + TYPE * 512 + h * 128 + vs2 * 32 + otc * 16 + tc4;
  ScanRegs r0, r1, r2, r3;
  const int idx0 = (b * 32) * 4 + h;
  scan_load<TYPE>(r0, p, idx0 + 0, qoff, ooff, moff, noff, doff);
  scan_load<TYPE>(r1, p, idx0 + 4, qoff, ooff, moff, noff, doff);
  scan_load<TYPE>(r2, p, idx0 + 8, qoff, ooff, moff, noff, doff);
  scan_load<TYPE>(r3, p, idx0 + 12, qoff, ooff, moff, noff, doff);
  __builtin_amdgcn_sched_barrier(0);
#define SCAN_STEP(R, c) { \
    RAW_BARRIER(); \
    const u16* Sb = SbT + ((c) & 1) * 32 * 136 + lr * 136 + lq * 8; \
    bf16x8 B0[4], B1[4], Bo[4]; \
    _Pragma("unroll") for (int ks = 0; ks < 4; ++ks) { \
      B0[ks] = *(const bf16x8*)(Sb + ks * 32); \
      B1[ks] = *(const bf16x8*)(Sb + 16 * 136 + ks * 32); \
      Bo[ks] = *(const bf16x8*)(Sb + otc * 16 * 136 + ks * 32); } \
    { \
      float ov[4]; unpack4(R.o0, ov); quad_transpose(ov, lane); \
      f32x4 acc = {ov[0], ov[1], ov[2], ov[3]}; \
      _Pragma("unroll") for (int ks = 0; ks < 4; ++ks) acc = mfma16(R.Aq[ks], Bo[ks], acc); \
      float o[4] = {acc[0], acc[1], acc[2], acc[3]}; \
      quad_transpose(o, lane); \
      *(f32x4*)(orow + (size_t)(c) * 65536) = f32x4{o[0], o[1], o[2], o[3]}; \
    } \
    float n0[4], n1[4]; unpack4(R.nn0, n0); unpack4(R.nn1, n1); \
    quad_transpose(n0, lane); quad_transpose(n1, lane); \
    f32x4 T0, T1; \
    _Pragma("unroll") for (int j = 0; j < 4; ++j) { T0[j] = R.dd[j] * S0[j] + n0[j]; T1[j] = R.dd[j] * S1[j] + n1[j]; } \
    if (TYPE == 1) { _Pragma("unroll") for (int ks = 0; ks < 4; ++ks) { T0 = mfma16(R.Am[ks], B0[ks], T0); T1 = mfma16(R.Am[ks], B1[ks], T1); } } \
    S0 = T0; S1 = T1; \
    u16* Sw = SbT + (((c) + 1) & 1) * 32 * 136 + lr * 136 + w * 16 + lq * 4; \
    *(u32x2*)(Sw) = u32x2{pack2(S0[0], S0[1]), pack2(S0[2], S0[3])}; \
    *(u32x2*)(Sw + 16 * 136) = u32x2{pack2(S1[0], S1[1]), pack2(S1[2], S1[3])}; \
    __builtin_amdgcn_sched_barrier(0); \
    scan_load<TYPE>(R, p, idx0 + (((c) + 4 < 32) ? (c) + 4 : 31) * 4, qoff, ooff, moff, noff, doff); \
    __builtin_amdgcn_sched_barrier(0); \
  }
  for (int c0 = 0; c0 < 32; c0 += 4) {
    SCAN_STEP(r0, c0)
    SCAN_STEP(r1, c0 + 1)
    SCAN_STEP(r2, c0 + 2)
    SCAN_STEP(r3, c0 + 3)
  }
#undef SCAN_STEP
  float* so = p.out + (TYPE ? O_GDP : O_HGP) + (size_t)(b * 4 + h) * 16384 + (w * 16 + tr) * 128 + vs2 * 32 + tc4;
  {
    float sv[4] = {S0[0], S0[1], S0[2], S0[3]};
    quad_transpose(sv, lane);
    *(f32x4*)(so) = f32x4{sv[0], sv[1], sv[2], sv[3]};
    float sw[4] = {S1[0], S1[1], S1[2], S1[3]};
    quad_transpose(sw, lane);
    *(f32x4*)(so + 16) = f32x4{sw[0], sw[1], sw[2], sw[3]};
  }
  __syncthreads();
}

__device__ void sample_item(const Params& p, char* smem, int it) {
  const int tid = opaque_tid(), lane = tid & 63, w = tid >> 6;
  const int type = it >> 9, b = (it >> 2) & 127, h = it & 3;
  const int row = MP + b;
  const u16* PQ = (const u16*)(p.ws + W_PQ);
  const float* LF = (const float*)(p.ws + W_LF);
  const float* BETA = (const float*)(p.ws + W_BETA);
  const float* GDEC = (const float*)(p.ws + W_GDEC);
  float* OPRE = (float*)(p.ws + W_PQ);
  float* fq = (float*)smem;
  float* fk = fq + 128;
  float* fv = fk + 128;
  float* fe = fv + 128;
  float* red = fe + 128;
  float* sc = red + 1024;
  const int n = tid & 127, kp = tid >> 7;
  if (type == 0) {
    if (tid < 128) {
      const float lf = LF[(size_t)row * 512 + h * 128 + tid];
      const float f = __expf(lf);
      fe[tid] = f;
      fk[tid] = 1.f - f;
      fq[tid] = bf2f(PQ[(size_t)row * PQW + h * 128 + tid]);
      fv[tid] = bf2f(PQ[(size_t)row * PQW + 512 + h * 128 + tid]);
    }
    __syncthreads();
    const float* S = p.state_hgrn + ((size_t)(b * 4 + h) * 128) * 128;
    float* So = p.out + O_HGS + ((size_t)(b * 4 + h) * 128) * 128;
    const float vn = fv[n];
    float o = 0.f;
#pragma unroll
    for (int i = 0; i < 32; ++i) {
      const int k = kp * 32 + i;
      const float sn = fe[k] * S[k * 128 + n] + fk[k] * vn;
      So[k * 128 + n] = sn;
      o += fq[k] * sn;
    }
    red[kp * 128 + n] = o;
    __syncthreads();
    if (tid < 128) OPRE[(size_t)row * 1024 + h * 128 + tid] = red[tid] + red[128 + tid] + red[256 + tid] + red[384 + tid];
    __syncthreads();
  } else {
    const float* cprev = p.state_conv + (size_t)b * 3 * 1536;
    if (tid < 384) {
      const int ty = tid >> 7, cc = tid & 127;
      const int ch = ty * 512 + h * 128 + cc;
      const float p0 = cprev[ch], p1 = cprev[1536 + ch], p2 = cprev[3072 + ch];
      const float nw = bf2f(PQ[(size_t)row * PQW + 1024 + ch]);
      const float s = p.conv_w[ch] * p0 + p.conv_w[1536 + ch] * p1 + p.conv_w[3072 + ch] * p2 + p.conv_w[4608 + ch] * nw;
      fq[ty * 128 + cc] = siluf_(s);
      p.out[O_CVS + (size_t)(b * 3 + 0) * 1536 + ch] = p1;
      p.out[O_CVS + (size_t)(b * 3 + 1) * 1536 + ch] = p2;
    }
    __syncthreads();
    if (w < 2) {
      const float a0 = fq[w * 128 + lane], a1 = fq[w * 128 + 64 + lane];
      const float ss = wave_sum(a0 * a0 + a1 * a1);
      if (lane == 0) sc[w] = ss;
    }
    __syncthreads();
    const float rq = rsqrtf(sc[0] + EPS) * 0.08838834764831845f;
    const float rk = rsqrtf(sc[1] + EPS);
    __syncthreads();
    if (tid < 128) fq[tid] *= rq;
    else if (tid < 256) fk[tid - 128] *= rk;
    __syncthreads();
    if (w == 0) {
      const float qk = wave_sum(fq[lane] * fk[lane] + fq[64 + lane] * fk[64 + lane]);
      if (lane == 0) sc[2] = qk;
    }
    const float eg = __expf(GDEC[(size_t)row * 4 + h]);
    const float beta = BETA[(size_t)row * 4 + h];
    const float* S = p.state_gdn + ((size_t)(b * 4 + h) * 128) * 128;
    float* So = p.out + O_GDS + ((size_t)(b * 4 + h) * 128) * 128;
    float sd[32];
    float ks_ = 0.f, qs_ = 0.f;
#pragma unroll
    for (int i = 0; i < 32; ++i) {
      const int k = kp * 32 + i;
      sd[i] = eg * S[k * 128 + n];
      ks_ += fk[k] * sd[i];
      qs_ += fq[k] * sd[i];
    }
    red[kp * 128 + n] = ks_;
    red[512 + kp * 128 + n] = qs_;
    __syncthreads();
    const float kS = red[n] + red[128 + n] + red[256 + n] + red[384 + n];
    const float delta = (fv[n] - kS) * beta;
#pragma unroll
    for (int i = 0; i < 32; ++i) {
      const int k = kp * 32 + i;
      So[k * 128 + n] = sd[i] + fk[k] * delta;
    }
    if (tid < 128) {
      const float qS = red[512 + n] + red[640 + n] + red[768 + n] + red[896 + n];
      OPRE[(size_t)row * 1024 + 512 + h * 128 + n] = qS + sc[2] * delta;
    }
    __syncthreads();
  }
}

__device__ void sample_block4(const Params& p, char* smem, int bid) {
  const int tid = opaque_tid(), lane = tid & 63, w = tid >> 6;
  const u16* PQ = (const u16*)(p.ws + W_PQ);
  const float* LF = (const float*)(p.ws + W_LF);
  const float* BETA = (const float*)(p.ws + W_BETA);
  const float* GDEC = (const float*)(p.ws + W_GDEC);
  float* OPRE = (float*)(p.ws + W_PQ);
  float* vec = (float*)smem;
  float* red = vec + 2048;
  float* sc = red + 1024;
  if (tid < 256) {
    const int j = tid >> 7, c = tid & 127;
    const int it = bid + 256 * j, b = (it >> 2) & 127, h = it & 3, row = MP + b;
    const float f = __expf(LF[(size_t)row * 512 + h * 128 + c]);
    vec[(j * 4 + 0) * 128 + c] = bf2f(PQ[(size_t)row * PQW + h * 128 + c]);
    vec[(j * 4 + 1) * 128 + c] = 1.f - f;
    vec[(j * 4 + 2) * 128 + c] = bf2f(PQ[(size_t)row * PQW + 512 + h * 128 + c]);
    vec[(j * 4 + 3) * 128 + c] = f;
  }
  for (int e = tid; e < 768; e += 512) {
    const int j = 2 + e / 384, r = e % 384, ty = r >> 7, cc = r & 127;
    const int it = bid + 256 * j, b = (it >> 2) & 127, h = it & 3, row = MP + b;
    const int ch = ty * 512 + h * 128 + cc;
    const float* cprev = p.state_conv + (size_t)b * 3 * 1536;
    const float p0 = cprev[ch], p1 = cprev[1536 + ch], p2 = cprev[3072 + ch];
    const float nw = bf2f(PQ[(size_t)row * PQW + 1024 + ch]);
    const float s = p.conv_w[ch] * p0 + p.conv_w[1536 + ch] * p1 + p.conv_w[3072 + ch] * p2 + p.conv_w[4608 + ch] * nw;
    vec[(j * 4 + ty) * 128 + cc] = siluf_(s);
    p.out[O_CVS + (size_t)(b * 3 + 0) * 1536 + ch] = p1;
    p.out[O_CVS + (size_t)(b * 3 + 1) * 1536 + ch] = p2;
  }
  __syncthreads();
  if (w < 4) {
    const int j = 2 + (w >> 1), which = w & 1;
    const float a0 = vec[(j * 4 + which) * 128 + lane], a1 = vec[(j * 4 + which) * 128 + 64 + lane];
    const float ss = wave_sum(a0 * a0 + a1 * a1);
    if (lane == 0) sc[j * 4 + which] = ss;
  }
  __syncthreads();
  {
    const int j = 2 + (tid >> 8), which = (tid >> 7) & 1, c = tid & 127;
    const float r = which == 0 ? rsqrtf(sc[j * 4 + 0] + EPS) * 0.08838834764831845f : rsqrtf(sc[j * 4 + 1] + EPS);
    vec[(j * 4 + which) * 128 + c] *= r;
  }
  __syncthreads();
  if (w < 2) {
    const int j = 2 + w;
    const float qk = wave_sum(vec[(j * 4 + 0) * 128 + lane] * vec[(j * 4 + 1) * 128 + lane] +
                              vec[(j * 4 + 0) * 128 + 64 + lane] * vec[(j * 4 + 1) * 128 + 64 + lane]);
    if (lane == 0) sc[j * 4 + 2] = qk;
  }
  __syncthreads();
  const int n = tid & 127, kp = tid >> 7;
  float cur[32], nxt[32];
  {
    const int it = bid, b = (it >> 2) & 127, h = it & 3;
    const float* S = p.state_hgrn + ((size_t)(b * 4 + h) * 128) * 128;
#pragma unroll
    for (int i = 0; i < 32; ++i) cur[i] = S[(kp * 32 + i) * 128 + n];
  }
#pragma unroll
  for (int j = 0; j < 4; ++j) {
    const int it = bid + 256 * j, b = (it >> 2) & 127, h = it & 3, row = MP + b;
    if (j < 3) {
      const int it2 = bid + 256 * (j + 1), b2 = (it2 >> 2) & 127, h2 = it2 & 3;
      const float* S2 = ((j + 1) < 2 ? p.state_hgrn : p.state_gdn) + ((size_t)(b2 * 4 + h2) * 128) * 128;
#pragma unroll
      for (int i = 0; i < 32; ++i) nxt[i] = S2[(kp * 32 + i) * 128 + n];
    }
    const float* fq = vec + (j * 4 + 0) * 128;
    const float* fk = vec + (j * 4 + 1) * 128;
    const float* fv = vec + (j * 4 + 2) * 128;
    const float* fe = vec + (j * 4 + 3) * 128;
    if (j < 2) {
      float* So = p.out + O_HGS + ((size_t)(b * 4 + h) * 128) * 128;
      const float vn = fv[n];
      float o = 0.f;
#pragma unroll
      for (int i = 0; i < 32; ++i) {
        const int k = kp * 32 + i;
        const float sn = fe[k] * cur[i] + fk[k] * vn;
        So[k * 128 + n] = sn;
        o += fq[k] * sn;
      }
      red[kp * 128 + n] = o;
      __syncthreads();
      if (tid < 128) OPRE[(size_t)row * 1024 + h * 128 + tid] = red[tid] + red[128 + tid] + red[256 + tid] + red[384 + tid];
      __syncthreads();
    } else {
      float* So = p.out + O_GDS + ((size_t)(b * 4 + h) * 128) * 128;
      const float eg = __expf(GDEC[(size_t)row * 4 + h]);
      const float beta = BETA[(size_t)row * 4 + h];
      float ks_ = 0.f, qs_ = 0.f;
#pragma unroll
      for (int i = 0; i < 32; ++i) {
        const int k = kp * 32 + i;
        cur[i] *= eg;
        ks_ += fk[k] * cur[i];
        qs_ += fq[k] * cur[i];
      }
      red[kp * 128 + n] = ks_;
      red[512 + kp * 128 + n] = qs_;
      __syncthreads();
      const float kS = red[n] + red[128 + n] + red[256 + n] + red[384 + n];
      const float delta = (fv[n] - kS) * beta;
#pragma unroll
      for (int i = 0; i < 32; ++i) {
        const int k = kp * 32 + i;
        So[k * 128 + n] = cur[i] + fk[k] * delta;
      }
      if (tid < 128) {
        const float qS = red[512 + n] + red[640 + n] + red[768 + n] + red[896 + n];
        OPRE[(size_t)row * 1024 + 512 + h * 128 + n] = qS + sc[j * 4 + 2] * delta;
      }
      __syncthreads();
    }
#pragma unroll
    for (int i = 0; i < 32; ++i) cur[i] = nxt[i];
  }
}

#define XB_TICKET(j) (3456 + 16 * (j))
__device__ void phase3(const Params& p, char* smem, int bid, int nb) {
  volatile LAS unsigned* st = (volatile LAS unsigned*)(unsigned)(size_t)(smem + LDS_BYTES - 16);
  unsigned* bar = (unsigned*)(p.ws + W_BAR);
  if (threadIdx.x == 0) {
    unsigned ok = (nb == 256) ? 1u : 0u, rank = 0u;
    const unsigned x = xb_xcc_id();
    unsigned npop = 0u;
    for (unsigned j = 0; j < 16; ++j) {
      const unsigned c = xb_ld(&bar[XB_XCNT(j)]);
      if (c != 0u) { ++npop; if (c != 32u) ok = 0u; if (j < x) ++rank; }
    }
    if (npop != 8u) ok = 0u;
    unsigned ticket = 0u;
    if (ok) ticket = xb_add(&bar[XB_TICKET(x)], 1u);
    st[2] = ok ? (0x100u | (rank << 5) | (ticket & 31u)) : 0u;
  }
  __syncthreads();
  const unsigned place = st[2];
  __syncthreads();
  if (place) {
    const int r = (place >> 5) & 7, t = place & 31;
    const int g = (t >> 2) * 8 + r;
    const int uu = (g << 2) | (t & 3);
    if (uu < 128) scan_unit<0>(p, smem, uu); else scan_unit<1>(p, smem, uu - 128);
    if (DUP_MASK & 256) { if (uu < 128) scan_unit<0>(p, smem, uu); else scan_unit<1>(p, smem, uu - 128); }
    if (uu < 128) {
      const int rankH = r * 16 + t;
      sample_block4(p, smem, rankH);
      sample_block4(p, smem, rankH + 128);
    }
    return;
  }
  for (int u = bid; u < 256; u += nb) {
    int uu = u;
    if (nb == 256) {
      const int xcd = u & 7, j = u >> 3;
      uu = ((xcd * 8 + (j >> 2)) << 2) | (j & 3);
    }
    if (uu < 128) scan_unit<0>(p, smem, uu); else scan_unit<1>(p, smem, uu - 128);
  }
  if (nb == 256) {
    if ((bid & 7) < 4) {
      const int rank = (bid >> 3) * 4 + (bid & 3);
      sample_block4(p, smem, rank);
      sample_block4(p, smem, rank + 128);
    }
  } else {
    for (int it = bid; it < 1024; it += nb) sample_item(p, smem, it);
  }
}

__device__ void phase4(const Params& p, int bid, int nb) {
  const int tid = opaque_tid(), lane = tid & 63, w = tid >> 6;
  const float* OPRE = (const float*)(p.ws + W_PQ);
  const u16* GATES = (const u16*)(p.ws + W_GATES);
  u16* A2 = (u16*)(p.ws + W_QS);
  constexpr int NG = MT / 8;
  for (int g = bid; g < NG; g += 2 * nb) {
    const bool two = (g + nb) < NG;
    const int rows[2] = {g * 8 + w, (two ? g + nb : g) * 8 + w};
    f32x4 v[2][4];
    u32x2 gt[2][4];
#pragma unroll
    for (int r = 0; r < 2; ++r)
#pragma unroll
      for (int i = 0; i < 4; ++i) {
        const int col = i * 256 + lane * 4;
        v[r][i] = *(const f32x4*)(OPRE + (size_t)rows[r] * 1024 + col);
        gt[r][i] = *(const u32x2*)(GATES + (size_t)rows[r] * 1024 + col);
      }
#pragma unroll
    for (int r = 0; r < 2; ++r) {
      if (r == 1 && !two) break;
#pragma unroll
      for (int i = 0; i < 4; ++i) {
        const int col = i * 256 + lane * 4;
        float ss = v[r][i][0] * v[r][i][0] + v[r][i][1] * v[r][i][1] + v[r][i][2] * v[r][i][2] + v[r][i][3] * v[r][i][3];
        ss += dpp_mov<0xB1, 0xf>(ss);
        ss += dpp_mov<0x4E, 0xf>(ss);
        ss += dpp_mov<0x141, 0xf>(ss);
        ss += dpp_mov<0x140, 0xf>(ss);
        ss += __shfl_xor(ss, 16, 64);
        const float rstd = rsqrtf(ss * (1.f / 128.f) + EPS);
        const f32x4 nw = *(const f32x4*)((col < 512 ? p.hg_norm : p.gdn_norm) + (col & 127));
        float gg[4];
        unpack4(gt[r][i], gg);
        *(u32x2*)(A2 + (size_t)rows[r] * LDK + col) =
            u32x2{pack2(v[r][i][0] * rstd * nw[0] * gg[0], v[r][i][1] * rstd * nw[1] * gg[1]),
                  pack2(v[r][i][2] * rstd * nw[2] * gg[2], v[r][i][3] * rstd * nw[3] * gg[3])};
      }
    }
  }
}

__device__ void phase6(const Params& p, int bid, int nb) {
  const int tid = opaque_tid(), lane = tid & 63, w = tid >> 6;
  constexpr int NG = MT / 8, NR = 4;
  for (int g = bid; g < NG; g += NR * nb) {
    float* y[NR];
    bool ok[NR];
    float4 xv[NR][4];
    float ss[NR];
#pragma unroll
    for (int r = 0; r < NR; ++r) {
      ok[r] = (g + r * nb) < NG;
      const int row = (ok[r] ? g + r * nb : g) * 8 + w;
      y[r] = row < MP ? p.out + O_YP + (size_t)row * 1024 : p.out + O_YS + (size_t)(row - MP) * 1024;
#pragma unroll
      for (int i = 0; i < 4; ++i) xv[r][i] = *(const float4*)(y[r] + i * 256 + lane * 4);
    }
#pragma unroll
    for (int r = 0; r < NR; ++r) {
      ss[r] = 0.f;
#pragma unroll
      for (int i = 0; i < 4; ++i) ss[r] += xv[r][i].x * xv[r][i].x + xv[r][i].y * xv[r][i].y + xv[r][i].z * xv[r][i].z + xv[r][i].w * xv[r][i].w;
      ss[r] = wave_sum(ss[r]);
    }
#pragma unroll
    for (int r = 0; r < NR; ++r) {
      if (ok[r]) {
        const float rstd = rsqrtf(ss[r] * (1.f / 1024.f) + EPS);
#pragma unroll
        for (int i = 0; i < 4; ++i) {
          const float4 nw = *(const float4*)(p.final_norm + i * 256 + lane * 4);
          float4 o;
          o.x = xv[r][i].x * rstd * nw.x; o.y = xv[r][i].y * rstd * nw.y; o.z = xv[r][i].z * rstd * nw.z; o.w = xv[r][i].w * rstd * nw.w;
          *(float4*)(y[r] + i * 256 + lane * 4) = o;
        }
      }
    }
  }
}


template <int PH>
__device__ __forceinline__ void run_phase(const Params& p, char* smem, int bid, int nb) {
  if (PH == 0) phase0(p, smem, bid, nb);
  else if (PH == 1) gemm_phase<0>(p, (const u16*)(p.ws + W_H), (const u16*)(p.ws + W_WINT), 16, smem, bid, nb);
  else if (PH == 2) phase2(p, smem, bid, nb);
  else if (PH == 3) phase3(p, smem, bid, nb);
  else if (PH == 4) phase4(p, bid, nb);
  else if (PH == 5) gemm_phase<1>(p, (const u16*)(p.ws + W_QS), (const u16*)(p.ws + W_WOUTT), 4, smem, bid, nb);
  else phase6(p, bid, nb);
}

#if MEGA
__global__ void __launch_bounds__(NTH) mega_kernel(Params p) {
  extern __shared__ __attribute__((aligned(16))) char smem[];
  cg::grid_group grid = cg::this_grid();
  const int bid = blockIdx.x, nb = gridDim.x;
  if (p.out == nullptr) grid.sync();
  volatile LAS unsigned* st = (volatile LAS unsigned*)(unsigned)(size_t)(smem + LDS_BYTES - 16);
  if (threadIdx.x == 0) { st[0] = 0u; st[1] = 0u; }
  __syncthreads();
  const XcdBarrier xb = xcd_barrier_post((unsigned*)(p.ws + W_BAR), st);
#define GSYNC() xcd_barrier(xb)
#define RUNP(k) run_phase<k>(p, smem, bid, nb); GSYNC(); if (DUP_MASK & (1 << k)) { run_phase<k>(p, smem, bid, nb); GSYNC(); }
  RUNP(0)
  if (PROBE_SYNC) { for (int i_ = 0; i_ < PROBE_SYNC; ++i_) GSYNC(); }
  RUNP(1)
  if (PROBE_GEMM) { gemm_phase<0, PROBE_GEMM>(p, (const u16*)(p.ws + W_H), (const u16*)(p.ws + W_WINT), 16, smem, bid, nb); GSYNC(); }
  RUNP(2) RUNP(3) RUNP(4) RUNP(5)
#undef RUNP
#undef GSYNC
  run_phase<6>(p, smem, bid, nb);
}
#else
template <int PH>
__global__ void __launch_bounds__(NTH) phase_kernel(Params p) {
  extern __shared__ __attribute__((aligned(16))) char smem[];
  run_phase<PH>(p, smem, blockIdx.x, gridDim.x);
}
template <int PH>
static void launch_phase(const Params& p, int grid, hipStream_t stream) {
  hipFuncSetAttribute((const void*)phase_kernel<PH>, hipFuncAttributeMaxDynamicSharedMemorySize, (int)LDS_BYTES);
  hipLaunchKernelGGL(phase_kernel<PH>, dim3(grid), dim3(NTH), LDS_BYTES, stream, p);
}
#endif

extern "C" void kernel_launch(void* const* d_in, const int* in_sizes, int n_in, void* d_out, int out_size,
                              void* d_ws, size_t ws_size, hipStream_t stream) {
  Params p{};
  p.x_prompt = (const float*)d_in[0];
  p.x_sample = (const float*)d_in[1];
  p.state_hgrn = (const float*)d_in[2];
  p.state_gdn = (const float*)d_in[3];
  p.state_conv = (const float*)d_in[4];
  p.norm_w = (const float*)d_in[5];
  p.w_in = (const float*)d_in[6];
  p.lb_logits = (const float*)d_in[7];
  p.conv_w = (const float*)d_in[8];
  p.a_log = (const float*)d_in[9];
  p.dt_bias = (const float*)d_in[10];
  p.hg_norm = (const float*)d_in[11];
  p.gdn_norm = (const float*)d_in[12];
  p.w_out = (const float*)d_in[13];
  p.final_norm = (const float*)d_in[14];
  p.out = (float*)d_out;
  p.ws = (char*)d_ws;
  if (ws_size < W_END) { fprintf(stderr, "workspace too small: %zu < %zu\n", ws_size, (size_t)W_END); return; }
#if MEGA
  static int grid_blocks = 0;
  if (!grid_blocks) {
    int dev = 0, cus = 0, per_cu = 0;
    hipGetDevice(&dev);
    hipDeviceGetAttribute(&cus, hipDeviceAttributeMultiprocessorCount, dev);
    hipFuncSetAttribute((const void*)mega_kernel, hipFuncAttributeMaxDynamicSharedMemorySize, (int)LDS_BYTES);
    hipOccupancyMaxActiveBlocksPerMultiprocessor(&per_cu, mega_kernel, NTH, LDS_BYTES);
    if (per_cu < 1) per_cu = 1;
    grid_blocks = cus * per_cu;
  }
  (void)hipMemsetAsync((char*)d_ws + W_BAR, 0, 16384, stream);
  void* args[] = {&p};
  hipError_t e = hipLaunchCooperativeKernel((void*)mega_kernel, dim3(grid_blocks), dim3(NTH), args, LDS_BYTES, stream);
  if (e != hipSuccess) fprintf(stderr, "cooperative launch failed: %s (grid %d)\n", hipGetErrorString(e), grid_blocks);
#else
  const int grid = 256;
  launch_phase<0>(p, grid, stream);
  launch_phase<1>(p, grid, stream);
  launch_phase<2>(p, grid, stream);
  launch_phase<3>(p, grid, stream);
  launch_phase<4>(p, grid, stream);
  launch_phase<5>(p, grid, stream);
  launch_phase<6>(p, grid, stream);
#endif
}
```

```cpp
#include <hip/hip_runtime.h>
#include <hip/hip_cooperative_groups.h>
#include <cstdio>
namespace cg = cooperative_groups;

#ifndef MEGA
#define MEGA 1
#define PROBE_GEMM 0
#define PROBE_SYNC 0
#define PROBE_G 0
#define DUP_MASK 0
#endif

typedef unsigned short u16;
using bf16x8 = __attribute__((ext_vector_type(8))) short;
using f32x4 = __attribute__((ext_vector_type(4))) float;
using u32x4 = __attribute__((ext_vector_type(4))) unsigned;
using u32x2 = __attribute__((ext_vector_type(2))) unsigned;

#define NTH 512
constexpr int MP = 16384, MS = 128, MT = 16512, DM = 1024, DIN = 4104, PQW = 2560;
constexpr float EPS = 1e-6f;
constexpr int LDK = 1088;
constexpr size_t LDS_BYTES = 139264;

constexpr size_t O_YP = 0, O_YS = 16777216, O_HGP = 16908288, O_GDP = 17432576, O_CVP = 17956864,
                 O_HGS = 17993728, O_GDS = 26382336, O_CVS = 34770944;
constexpr size_t W_WINT = 0;
constexpr size_t W_WOUTT = W_WINT + (size_t)4096 * LDK * 2;
constexpr size_t W_BETA = W_WOUTT + (size_t)1024 * LDK * 2;
constexpr size_t W_GDEC = W_BETA + 264192;
constexpr size_t W_DVEC = W_GDEC + 264192;
constexpr size_t W_DSC = W_DVEC + 1048576;
constexpr size_t W_PQ = W_DSC + 4096;
constexpr size_t W_GATES = W_PQ + 84541440;
constexpr size_t W_H = W_GATES + 33816576;
constexpr size_t W_QS = W_H + (size_t)MT * LDK * 2;
constexpr size_t W_MNEG = W_QS + 33554432;
constexpr size_t W_LF = W_MNEG + 33554432;
constexpr size_t W_BAR = W_LF + 33816576;
constexpr size_t W_END = W_BAR + 16384;

struct Params {
  const float *x_prompt, *x_sample, *state_hgrn, *state_gdn, *state_conv, *norm_w, *w_in, *lb_logits,
      *conv_w, *a_log, *dt_bias, *hg_norm, *gdn_norm, *w_out, *final_norm;
  float* out;
  char* ws;
};

__device__ __forceinline__ int opaque_tid() { int t = threadIdx.x; asm volatile("" : "+v"(t)); return t; }
typedef __bf16 bf16x2_t __attribute__((ext_vector_type(2)));
typedef float f32x2_t __attribute__((ext_vector_type(2)));
__device__ __forceinline__ u16 f2bf(float x) { return __builtin_bit_cast(u16, (__bf16)x); }
__device__ __forceinline__ float bf2f(u16 h) { return __uint_as_float(((unsigned)h) << 16); }
__device__ __forceinline__ unsigned pack2(float a, float b) {
  f32x2_t v = {a, b};
  return __builtin_bit_cast(unsigned, __builtin_convertvector(v, bf16x2_t));
}
template <int CTRL, int ROWMASK>
__device__ __forceinline__ float dpp_mov(float v) {
  return __builtin_bit_cast(float, __builtin_amdgcn_update_dpp(0, __builtin_bit_cast(int, v), CTRL, ROWMASK, 0xf, false));
}
__device__ __forceinline__ float wave_sum(float v) {
  v += dpp_mov<0xB1, 0xf>(v);
  v += dpp_mov<0x4E, 0xf>(v);
  v += dpp_mov<0x141, 0xf>(v);
  v += dpp_mov<0x140, 0xf>(v);
  v += dpp_mov<0x142, 0xa>(v);
  v += dpp_mov<0x143, 0xc>(v);
  return __builtin_bit_cast(float, __builtin_amdgcn_readlane(__builtin_bit_cast(int, v), 63));
}
__device__ __forceinline__ float sigmoidf_(float x) { return 1.f / (1.f + __expf(-x)); }
__device__ __forceinline__ float siluf_(float x) { return x / (1.f + __expf(-x)); }
__device__ __forceinline__ f32x4 mfma16(bf16x8 a, bf16x8 b, f32x4 c) {
  return __builtin_amdgcn_mfma_f32_16x16x32_bf16(a, b, c, 0, 0, 0);
}
__device__ __forceinline__ bf16x8 frag(const u16* base, int row0, int stride, int koff, int lane) {
  return *(const bf16x8*)(base + (row0 + (lane & 15)) * stride + koff + (lane >> 4) * 8);
}

__device__ __forceinline__ void quad_transpose(float (&v)[4], int lane) {
  {
    const bool b = lane & 1;
    float s0 = b ? v[0] : v[1], s1 = b ? v[2] : v[3];
    float r0 = dpp_mov<0xB1, 0xf>(s0), r1 = dpp_mov<0xB1, 0xf>(s1);
    if (b) { v[0] = r0; v[2] = r1; } else { v[1] = r0; v[3] = r1; }
  }
  {
    const bool b = lane & 2;
    float s0 = b ? v[0] : v[2], s1 = b ? v[1] : v[3];
    float r0 = dpp_mov<0x4E, 0xf>(s0), r1 = dpp_mov<0x4E, 0xf>(s1);
    if (b) { v[0] = r0; v[1] = r1; } else { v[2] = r0; v[3] = r1; }
  }
}
__device__ __forceinline__ void store4_bf16(u16* dst, const float (&v)[4]) {
  *(u32x2*)dst = u32x2{pack2(v[0], v[1]), pack2(v[2], v[3])};
}
__device__ void phase0(const Params& p, char* smem, int bid, int nb) {
  const int tid = opaque_tid(), lane = tid & 63, w = tid >> 6;
  u16* WinT = (u16*)(p.ws + W_WINT);
  u16* WoutT = (u16*)(p.ws + W_WOUTT);
  u16* H = (u16*)(p.ws + W_H);
  float* BETA = (float*)(p.ws + W_BETA);
  float* GDEC = (float*)(p.ws + W_GDEC);
  float* tl = (float*)smem;
  {
    float pre[8];
    auto tile_src = [&](int t, const float*& src, int& sstride, u16*& dst, int& kt, int& nt) {
      if (t < 1024) { src = p.w_in; sstride = DIN; dst = WinT; kt = t >> 6; nt = t & 63; }
      else { int u = t - 1024; src = p.w_out; sstride = 1024; dst = WoutT; kt = u >> 4; nt = u & 15; }
    };
    if (bid < 1280) {
      const float* src; int sstride; u16* dst; int kt, nt;
      tile_src(bid, src, sstride, dst, kt, nt);
#pragma unroll
      for (int i = 0; i < 8; ++i) { int idx = tid + 512 * i; pre[i] = src[(size_t)(kt * 64 + (idx >> 6)) * sstride + nt * 64 + (idx & 63)]; }
    }
    for (int t = bid; t < 1280; t += nb) {
      const float* src; int sstride; u16* dst; int kt, nt;
      tile_src(t, src, sstride, dst, kt, nt);
#pragma unroll
      for (int i = 0; i < 8; ++i) { int idx = tid + 512 * i; tl[(idx >> 6) * 65 + (idx & 63)] = pre[i]; }
      __syncthreads();
      if (t + nb < 1280) {
        const float* src2; int ss2; u16* dst2; int kt2, nt2;
        tile_src(t + nb, src2, ss2, dst2, kt2, nt2);
#pragma unroll
        for (int i = 0; i < 8; ++i) { int idx = tid + 512 * i; pre[i] = src2[(size_t)(kt2 * 64 + (idx >> 6)) * ss2 + nt2 * 64 + (idx & 63)]; }
      }
      {
        int nn = tid >> 3, k8 = (tid & 7) * 8;
        unsigned pk[4];
#pragma unroll
        for (int e = 0; e < 4; ++e) pk[e] = pack2(tl[(k8 + 2 * e) * 65 + nn], tl[(k8 + 2 * e + 1) * 65 + nn]);
        *(uint4*)(dst + (size_t)(nt * 64 + nn) * LDK + kt * 64 + k8) = make_uint4(pk[0], pk[1], pk[2], pk[3]);
      }
      __syncthreads();
    }
  }
  float* W8s = (float*)smem;
  for (int idx = tid; idx < 8192; idx += 512) {
    int j = idx & 7, k = idx >> 3;
    W8s[j * 1024 + k] = p.w_in[(size_t)k * DIN + 4096 + j];
  }
  __syncthreads();
  float4 xn[4];
  if (bid < MT / 8) {
    const int row = bid * 8 + w;
    const float* x = row < MP ? p.x_prompt + (size_t)row * 1024 : p.x_sample + (size_t)(row - MP) * 1024;
#pragma unroll
    for (int i = 0; i < 4; ++i) xn[i] = *(const float4*)(x + i * 256 + lane * 4);
  }
  for (int g = bid; g < MT / 8; g += nb) {
    int row = g * 8 + w;
    float4 xv[4];
    float ss = 0.f;
#pragma unroll
    for (int i = 0; i < 4; ++i) {
      xv[i] = xn[i];
      ss += xv[i].x * xv[i].x + xv[i].y * xv[i].y + xv[i].z * xv[i].z + xv[i].w * xv[i].w;
    }
    if (g + nb < MT / 8) {
      const int row2 = (g + nb) * 8 + w;
      const float* x2 = row2 < MP ? p.x_prompt + (size_t)row2 * 1024 : p.x_sample + (size_t)(row2 - MP) * 1024;
#pragma unroll
      for (int i = 0; i < 4; ++i) xn[i] = *(const float4*)(x2 + i * 256 + lane * 4);
    }
    ss = wave_sum(ss);
    float rstd = rsqrtf(ss * (1.f / 1024.f) + EPS);
    float d0 = 0, d1 = 0, d2 = 0, d3 = 0, d4 = 0, d5 = 0, d6 = 0, d7 = 0;
#pragma unroll
    for (int i = 0; i < 4; ++i) {
      float4 nw = *(const float4*)(p.norm_w + i * 256 + lane * 4);
      float4 hv;
      hv.x = xv[i].x * rstd * nw.x; hv.y = xv[i].y * rstd * nw.y; hv.z = xv[i].z * rstd * nw.z; hv.w = xv[i].w * rstd * nw.w;
      *(uint2*)(H + (size_t)row * LDK + i * 256 + lane * 4) = make_uint2(pack2(hv.x, hv.y), pack2(hv.z, hv.w));
#define GDOT(j, dj) { float4 wv = *(const float4*)(W8s + j * 1024 + i * 256 + lane * 4); dj += hv.x * wv.x + hv.y * wv.y + hv.z * wv.z + hv.w * wv.w; }
      GDOT(0, d0) GDOT(1, d1) GDOT(2, d2) GDOT(3, d3) GDOT(4, d4) GDOT(5, d5) GDOT(6, d6) GDOT(7, d7)
#undef GDOT
    }
    d0 = wave_sum(d0); d1 = wave_sum(d1); d2 = wave_sum(d2); d3 = wave_sum(d3);
    d4 = wave_sum(d4); d5 = wave_sum(d5); d6 = wave_sum(d6); d7 = wave_sum(d7);
    if (lane < 4) {
      float gb = lane == 0 ? d0 : lane == 1 ? d1 : lane == 2 ? d2 : d3;
      float ga = lane == 0 ? d4 : lane == 1 ? d5 : lane == 2 ? d6 : d7;
      BETA[row * 4 + lane] = 1.f / (1.f + expf(-gb));
      float z = ga + p.dt_bias[lane];
      float sp = z > 20.f ? z : log1pf(expf(z));
      GDEC[row * 4 + lane] = -expf(p.a_log[lane]) * sp;
    }
  }
  __syncthreads();
}

__device__ __forceinline__ int lds_byte2(int r, int c) {
  int st = (r >> 4) * 2 + (c >> 5), ob = (r & 15) * 64 + (c & 31) * 2;
  return st * 1024 + (ob ^ (((ob >> 9) & 1) << 5));
}
__device__ __forceinline__ void stage_rc2(int b, int& R, int& C) {
  int st = b >> 10, sb = b & 1023, swz = sb ^ (((sb >> 9) & 1) << 5);
  R = (st >> 1) * 16 + swz / 64;
  C = (st & 1) * 32 + (swz % 64) / 2;
}
template <int EPI, int SEC>
__device__ __forceinline__ void epi_store4(const Params& p, int row, int col4, const float (&v)[4]) {
  if (EPI == 0) {
    u16* PQ = (u16*)(p.ws + W_PQ);
    u16* GATES = (u16*)(p.ws + W_GATES);
    float* LF = (float*)(p.ws + W_LF);
    const int sec = SEC >= 0 ? SEC : (col4 >> 9);
    if (sec == 0) {
      *(uint2*)(PQ + (size_t)row * PQW + col4) = make_uint2(pack2(v[0], v[1]), pack2(v[2], v[3]));
    } else if (sec == 1) {
      const int cc = col4 - 512;
      const f32x4 l0 = *(const f32x4*)(p.lb_logits + cc), l1 = *(const f32x4*)(p.lb_logits + 512 + cc);
      f32x4 o;
#pragma unroll
      for (int i = 0; i < 4; ++i) {
        const float lbv = 1.f / (1.f + __expf(l1[i] - l0[i]));
        o[i] = __logf(lbv + (1.f - lbv) / (1.f + __expf(-v[i])));
      }
      *(f32x4*)(LF + (size_t)row * 512 + cc) = o;
    } else if (sec == 2) {
      *(uint2*)(PQ + (size_t)row * PQW + 512 + (col4 - 1024)) = make_uint2(pack2(v[0], v[1]), pack2(v[2], v[3]));
    } else if (sec == 3 || sec == 7) {
      const int cc = sec == 3 ? col4 - 1536 : 512 + col4 - 3584;
      *(uint2*)(GATES + (size_t)row * 1024 + cc) =
          make_uint2(pack2(v[0] / (1.f + __expf(-v[0])), v[1] / (1.f + __expf(-v[1]))),
                     pack2(v[2] / (1.f + __expf(-v[2])), v[3] / (1.f + __expf(-v[3]))));
    } else {
      const int cc = col4 - 2048;
      *(uint2*)(PQ + (size_t)row * PQW + 1024 + cc) = make_uint2(pack2(v[0], v[1]), pack2(v[2], v[3]));
      if (row < MP) {
        const int tt = row & 2047;
        if (tt >= 2045) *(f32x4*)(p.out + O_CVP + (size_t)((row >> 11) * 3 + (tt - 2045)) * 1536 + cc) = f32x4{v[0], v[1], v[2], v[3]};
      } else {
        *(f32x4*)(p.out + O_CVS + (size_t)((row - MP) * 3 + 2) * 1536 + cc) = f32x4{v[0], v[1], v[2], v[3]};
      }
    }
  } else {
    const float* xr = row < MP ? p.x_prompt + (size_t)row * 1024 : p.x_sample + (size_t)(row - MP) * 1024;
    float* yr = row < MP ? p.out + O_YP + (size_t)row * 1024 : p.out + O_YS + (size_t)(row - MP) * 1024;
    const f32x4 xv = *(const f32x4*)(xr + col4);
    *(f32x4*)(yr + col4) = f32x4{xv[0] + v[0], xv[1] + v[1], xv[2] + v[2], xv[3] + v[3]};
  }
}

template <int EPI, int MODE = 0>
__device__ void gemm_phase(const Params& p, const u16* __restrict__ A, const u16* __restrict__ Bt, int ntn,
                           char* smem, int bid, int nb) {
  const int tid = opaque_tid(), lane = tid & 63, wid = tid >> 6;
  const int wr = wid >> 2, wc = wid & 3, fr = lane & 15, fq = lane >> 4;
  constexpr int TILE_B = 256 * 64 * 2, STAGE_B = 2 * TILE_B;
  int sR0, sC0;
  stage_rc2(wid * 1024 + lane * 16, sR0, sC0);
  const unsigned goff = (unsigned)(sR0 * LDK + sC0);
  const unsigned lbase = (unsigned)(size_t)smem + (unsigned)(wid * 1024);
  const int aoff = (wr * 16) * 1024 + ((fr * 64 + fq * 16) ^ ((((fr * 64 + fq * 16) >> 9) & 1) << 5));
  const int boff = TILE_B + (wc * 8) * 1024 + ((fr * 64 + fq * 16) ^ ((((fr * 64 + fq * 16) >> 9) & 1) << 5));
  const int ntiles = 64 * ntn;
  auto tile_mn = [&](int tile, int& tm, int& tn) {
    const int rnd = tile >> 8, t = tile & 255, xcd = t & 7, j = t >> 3;
    if (ntn == 16) { tm = rnd * 16 + (xcd >> 1) * 4 + (j & 3); tn = ((xcd & 1) * 8 + (j >> 2) + (rnd & 1) * 2 + (rnd >> 1) * 8) & 15; }
    else { tm = xcd * 8 + (j & 7); tn = j >> 3; }
  };
  bool staged = false;
  for (int tile = bid; tile < ntiles; tile += nb) {
    int tm, tn;
    tile_mn(tile, tm, tn);
    const u16* Ab = A + (size_t)tm * 256 * LDK;
    const u16* Bb = Bt + (size_t)tn * 256 * LDK;
    f32x4 acc[8][4];
#pragma unroll
    for (int m = 0; m < 8; ++m)
#pragma unroll
      for (int n = 0; n < 4; ++n) acc[m][n] = f32x4{0.f, 0.f, 0.f, 0.f};
#define G_STAGE(buf, kt) { _Pragma("unroll") for (int i = 0; i < 4; ++i) { \
      __builtin_amdgcn_global_load_lds((const unsigned*)(Ab + (goff + (unsigned)(i * 64 * LDK + (kt) * 64))), \
          (__attribute__((address_space(3))) unsigned*)(lbase + (buf) * STAGE_B + i * 8192), 16, 0, 0); \
      __builtin_amdgcn_global_load_lds((const unsigned*)(Bb + (goff + (unsigned)(i * 64 * LDK + (kt) * 64))), \
          (__attribute__((address_space(3))) unsigned*)(lbase + (buf) * STAGE_B + TILE_B + i * 8192), 16, 0, 0); } }
#define G_PIECE_A(buf, kt, i) __builtin_amdgcn_global_load_lds((const unsigned*)(Ab + (goff + (unsigned)((i) * 64 * LDK + (kt) * 64))), \
          (__attribute__((address_space(3))) unsigned*)(lbase + (buf) * STAGE_B + (i) * 8192), 16, 0, 0)
#define G_PIECE_B(buf, kt, i) __builtin_amdgcn_global_load_lds((const unsigned*)(Bb + (goff + (unsigned)((i) * 64 * LDK + (kt) * 64))), \
          (__attribute__((address_space(3))) unsigned*)(lbase + (buf) * STAGE_B + TILE_B + (i) * 8192), 16, 0, 0)
    if (!staged) G_STAGE(0, 0);
    asm volatile("s_waitcnt vmcnt(0)" ::: "memory");
    __syncthreads();
    for (int t = 0; t < 16; ++t) {
      const int cur = t & 1;
      const bool more = (MODE != 2) && (t + 1 < 16);
      const char* sA = smem + cur * STAGE_B + aoff;
      const char* sB = smem + cur * STAGE_B + boff;
#pragma unroll
      for (int ks = 0; ks < 2; ++ks) {
        bf16x8 At[8], Bf[4];
#pragma unroll
        for (int m = 0; m < 8; ++m) At[m] = *(const bf16x8*)(sA + (m * 2 + ks) * 1024);
#pragma unroll
        for (int n = 0; n < 4; ++n) Bf[n] = *(const bf16x8*)(sB + (n * 2 + ks) * 1024);
        if (MODE != 3) {
#pragma unroll
          for (int m = 0; m < 8; ++m) {
#pragma unroll
            for (int n = 0; n < 4; ++n) acc[m][n] = mfma16(At[m], Bf[n], acc[m][n]);
            if (ks == 0 && more) {
              if (m < 4) G_PIECE_A(cur ^ 1, t + 1, m); else G_PIECE_B(cur ^ 1, t + 1, m - 4);
              __builtin_amdgcn_sched_barrier(0);
            }
          }
        } else {
          if (ks == 0 && more) G_STAGE(cur ^ 1, t + 1);
#pragma unroll
          for (int m = 0; m < 8; ++m) acc[m][0][0] += __builtin_bit_cast(float, (int)At[m][0]);
#pragma unroll
          for (int n = 0; n < 4; ++n) acc[0][n][1] += __builtin_bit_cast(float, (int)Bf[n][0]);
        }
        __builtin_amdgcn_sched_barrier(0);
      }
      asm volatile("s_waitcnt vmcnt(0)" ::: "memory");
      __syncthreads();
    }
    staged = false;
    if (tile + nb < ntiles) {
      int tm2, tn2;
      tile_mn(tile + nb, tm2, tn2);
      const u16* Ab2 = A + (size_t)tm2 * 256 * LDK;
      const u16* Bb2 = Bt + (size_t)tn2 * 256 * LDK;
      { const u16* Ab = Ab2; const u16* Bb = Bb2; G_STAGE(0, 0); }
      staged = true;
    }
#undef G_STAGE
#undef G_PIECE_A
#undef G_PIECE_B
    if (MODE != 0 && MODE != 5) {
      float chk = 0.f;
#pragma unroll
      for (int m = 0; m < 8; ++m)
#pragma unroll
        for (int n = 0; n < 4; ++n) chk += acc[m][n][0] + acc[m][n][1] + acc[m][n][2] + acc[m][n][3];
      if (chk == 1.2345e-30f) p.out[0] = chk;
    } else
    {
      int t2 = threadIdx.x;
      asm volatile("" : "+v"(t2));
      const int lane2 = t2 & 63, wid2 = t2 >> 6;
      const int rbase = tm * 256 + (wid2 >> 2) * 128 + (lane2 >> 4) * 4 + (lane2 & 3);
      const int cbase = tn * 256 + (wid2 & 3) * 64 + (lane2 & 12);
#define EPI_LOOP(SEC) { _Pragma("unroll") for (int m = 0; m < 8; ++m) { _Pragma("unroll") for (int n = 0; n < 4; ++n) { \
          float v[4] = {acc[m][n][0], acc[m][n][1], acc[m][n][2], acc[m][n][3]}; \
          quad_transpose(v, lane2); \
          epi_store4<EPI, SEC>(p, rbase + m * 16, cbase + n * 16, v); } } }
      if (EPI == 0) {
        const int sec = tn >> 1;
        if (sec == 1) {
          float* LF = (float*)(p.ws + W_LF);
          float lbv[4][4];
#pragma unroll
          for (int n = 0; n < 4; ++n) {
            const int cc = cbase + n * 16 - 512;
            const f32x4 l0 = *(const f32x4*)(p.lb_logits + cc), l1 = *(const f32x4*)(p.lb_logits + 512 + cc);
#pragma unroll
            for (int e = 0; e < 4; ++e) lbv[n][e] = 1.f / (1.f + __expf(l1[e] - l0[e]));
          }
#pragma unroll
          for (int m = 0; m < 8; ++m)
#pragma unroll
            for (int n = 0; n < 4; ++n) {
              float v[4] = {acc[m][n][0], acc[m][n][1], acc[m][n][2], acc[m][n][3]};
              quad_transpose(v, lane2);
              f32x4 o;
#pragma unroll
              for (int e = 0; e < 4; ++e) o[e] = __logf(lbv[n][e] + (1.f - lbv[n][e]) * __builtin_amdgcn_rcpf(1.f + __expf(-v[e])));
              *(f32x4*)(LF + (size_t)(rbase + m * 16) * 512 + (cbase + n * 16 - 512)) = o;
            }
        } else {
          const bool gate = (sec == 3 || sec == 7);
          u16* dstb; int dstride, dcol;
          const int c0 = tn * 256 + (wid2 & 3) * 64;
          if (gate) { dstb = (u16*)(p.ws + W_GATES); dstride = 1024; dcol = sec == 3 ? c0 - 1536 : 512 + c0 - 3584; }
          else { dstb = (u16*)(p.ws + W_PQ); dstride = PQW; dcol = sec == 0 ? c0 : sec == 2 ? 512 + c0 - 1024 : 1024 + c0 - 2048; }
          char* ebuf = smem + STAGE_B + wid2 * 8192;
          const int wrow = (lane2 >> 4) * 4 + (lane2 & 3), wcol = (lane2 & 12);
          const int row00 = tm * 256 + (wid2 >> 2) * 128;
#pragma unroll
          for (int hf = 0; hf < 2; ++hf) {
#pragma unroll
            for (int m = 0; m < 4; ++m)
#pragma unroll
              for (int n = 0; n < 4; ++n) {
                float v[4] = {acc[hf * 4 + m][n][0], acc[hf * 4 + m][n][1], acc[hf * 4 + m][n][2], acc[hf * 4 + m][n][3]};
                if (gate) {
#pragma unroll
                  for (int e = 0; e < 4; ++e) v[e] = v[e] / (1.f + __expf(-v[e]));
                }
                quad_transpose(v, lane2);
                const int rl = m * 16 + wrow, cl = n * 16 + wcol;
                *(u32x2*)(ebuf + rl * 128 + ((cl * 2) ^ ((rl & 7) << 4))) = u32x2{pack2(v[0], v[1]), pack2(v[2], v[3])};
                if (sec >= 4 && sec <= 6) {
                  const int row = row00 + hf * 64 + rl, cc = c0 - 2048 + cl;
                  const int tt = row & 2047;
                  if (tt >= 2045) *(f32x4*)(p.out + O_CVP + (size_t)((row >> 11) * 3 + (tt - 2045)) * 1536 + cc) = f32x4{v[0], v[1], v[2], v[3]};
                }
              }
            asm volatile("s_waitcnt lgkmcnt(0)" ::: "memory");
#pragma unroll
            for (int i = 0; i < 8; ++i) {
              const int rl = i * 8 + (lane2 >> 3), ch = lane2 & 7;
              const u32x4 d = *(const u32x4*)(ebuf + rl * 128 + ((ch ^ (rl & 7)) << 4));
              *(u32x4*)(dstb + (size_t)(row00 + hf * 64 + rl) * dstride + dcol + ch * 8) = d;
            }
            asm volatile("s_waitcnt lgkmcnt(0)" ::: "memory");
          }
        }
      } else EPI_LOOP(0)
#undef EPI_LOOP
    }
  }
  const int nunits = MODE == 0 ? ntn * 16 : 0;
  int t3 = threadIdx.x;
  asm volatile("" : "+v"(t3));
  for (int u = bid; u < nunits; u += nb) {
    const int lane = t3 & 63, wid = t3 >> 6, fr = lane & 15, fq = lane >> 4;
    const u16* ar = A + (size_t)(MP + fr) * LDK + wid * 128 + fq * 8;
    const u16* br = Bt + (size_t)(u * 16 + fr) * LDK + wid * 128 + fq * 8;
    bf16x8 bfr[4];
#pragma unroll
    for (int ks = 0; ks < 4; ++ks) bfr[ks] = *(const bf16x8*)(br + ks * 32);
    bf16x8 afr[8][4];
#pragma unroll
    for (int rt = 0; rt < 8; ++rt)
#pragma unroll
      for (int ks = 0; ks < 4; ++ks) afr[rt][ks] = *(const bf16x8*)(ar + (size_t)rt * 16 * LDK + ks * 32);
    f32x4* red = (f32x4*)smem;
#pragma unroll
    for (int rt = 0; rt < 8; ++rt) {
      f32x4 acc = {0.f, 0.f, 0.f, 0.f};
#pragma unroll
      for (int ks = 0; ks < 4; ++ks) acc = mfma16(afr[rt][ks], bfr[ks], acc);
      red[(wid * 8 + rt) * 64 + lane] = acc;
    }
    __syncthreads();
    f32x4 tot = red[(0 * 8 + wid) * 64 + lane];
#pragma unroll
    for (int sw = 1; sw < 8; ++sw) tot += red[(sw * 8 + wid) * 64 + lane];
    float v[4] = {tot[0], tot[1], tot[2], tot[3]};
    quad_transpose(v, lane);
    epi_store4<EPI, -1>(p, MP + wid * 16 + fq * 4 + (lane & 3), u * 16 + (fr & ~3), v);
    __syncthreads();
  }
  __syncthreads();
}

#define XB_TMO      128
#define XB_XCNT(j)  (256  + 64 * (j))
#define XB_XSUB(j)  (1280 + 64 * (j))
#define XB_XGEN(j)  (2304 + 64 * (j))
#define XB_TOP      3328
#define XB_TOPGEN   3392
#define XCD_BAR_WORDS 3456
#define XB_SPIN_CAP (1u << 18)
#define LAS __attribute__((address_space(3)))
__device__ __forceinline__ unsigned xb_ld(unsigned* p)              { return __hip_atomic_load(p, __ATOMIC_RELAXED, __HIP_MEMORY_SCOPE_AGENT); }
__device__ __forceinline__ unsigned xb_add(unsigned* p, unsigned v) { return __hip_atomic_fetch_add(p, v, __ATOMIC_RELAXED, __HIP_MEMORY_SCOPE_AGENT); }
__device__ __forceinline__ unsigned xb_xcc_id() { return (unsigned)__builtin_amdgcn_s_getreg((3 << 11) | 20) & 0xFu; }
#define XB_SPIN(cond, bar) do { unsigned _sp = 0; while (cond) { __builtin_amdgcn_s_sleep(1); \
    if ((++_sp & 255u) == 0u) { if (xb_ld(&(bar)[XB_TMO])) break; if (_sp > XB_SPIN_CAP) { atomicAdd(&(bar)[XB_TMO], 1u); break; } } } } while (0)
struct XcdBarrier { unsigned* bar; unsigned x; volatile LAS unsigned* st; };
__device__ __forceinline__ XcdBarrier xcd_barrier_post(unsigned* bar, volatile LAS unsigned* st) {
  XcdBarrier b; b.bar = bar; b.x = xb_xcc_id(); b.st = st;
  if (threadIdx.x == 0) (void)xb_add(&bar[XB_XCNT(b.x)], 1u);
  return b;
}
__device__ __forceinline__ void xcd_barrier_complete(unsigned* bar, unsigned x, unsigned& nloc, unsigned& nx) {
  const unsigned G = gridDim.x * gridDim.y * gridDim.z;
  unsigned sum, cnt, mine, sp = 0u;
  for (;;) {
    sum = 0u; cnt = 0u; mine = 0u;
#pragma unroll
    for (unsigned j = 0; j < 16; ++j) { const unsigned c = xb_ld(&bar[XB_XCNT(j)]); sum += c; cnt += (c > 0u) ? 1u : 0u; mine = (j == x) ? c : mine; }
    if (sum == G) break;
    __builtin_amdgcn_s_sleep(1);
    if ((++sp & 255u) == 0u) { if (xb_ld(&bar[XB_TMO])) break; if (sp > XB_SPIN_CAP) { atomicAdd(&bar[XB_TMO], 1u); break; } }
  }
  nloc = mine > 0u ? mine : 1u; nx = cnt > 0u ? cnt : 1u;
}
__device__ __forceinline__ void xcd_barrier(const XcdBarrier& b) {
  asm volatile("s_waitcnt vmcnt(0)" ::: "memory");
  __syncthreads();
  if (threadIdx.x == 0) {
    unsigned* bar = b.bar;
    __builtin_amdgcn_s_waitcnt(0);
    unsigned nloc = b.st[0], nx = b.st[1];
    if (nloc == 0u) { xcd_barrier_complete(bar, b.x, nloc, nx); b.st[0] = nloc; b.st[1] = nx; }
    const unsigned old = xb_add(&bar[XB_XSUB(b.x)], 1u);
    const unsigned gen = old / nloc;
    if (old + 1u == (gen + 1u) * nloc) {
      __builtin_amdgcn_fence(__ATOMIC_RELEASE, "agent");
      asm volatile("s_waitcnt vmcnt(0)" ::: "memory");
      const unsigned og = xb_add(&bar[XB_TOP], 1u);
      const unsigned tg = og / nx;
      if (og + 1u == (tg + 1u) * nx) xb_add(&bar[XB_TOPGEN], 1u);
      else XB_SPIN(xb_ld(&bar[XB_TOPGEN]) == tg, bar);
      __builtin_amdgcn_fence(__ATOMIC_ACQUIRE, "agent");
      xb_add(&bar[XB_XGEN(b.x)], 1u);
      asm volatile("s_waitcnt vmcnt(0)" ::: "memory");
    } else {
      XB_SPIN(xb_ld(&bar[XB_XGEN(b.x)]) == gen, bar);
      __builtin_amdgcn_fence(__ATOMIC_ACQUIRE, "agent");
      asm volatile("s_waitcnt vmcnt(0)" ::: "memory");
    }
  }
  __syncthreads();
}

#define RAW_BARRIER() do { asm volatile("s_waitcnt lgkmcnt(0)" ::: "memory"); __builtin_amdgcn_s_barrier(); asm volatile("" ::: "memory"); } while (0)
__device__ void hgrn_item(const Params& p, char* smem, int idx) {
  const int tid = opaque_tid(), lane = tid & 63, w = tid >> 6;
  const int lr = lane & 15, lq = lane >> 4;
  const int h = idx & 3, c = (idx >> 2) & 31, b = idx >> 7;
  const int r0 = b * 2048 + c * 64;
  const u16* PQ = (const u16*)(p.ws + W_PQ);
  const float* LF = (const float*)(p.ws + W_LF);
  u16* QS = (u16*)(p.ws + W_QS);
  u16* O0 = (u16*)(p.ws + W_H);
  u16* NB = (u16*)(p.out);
  float* DVEC = (float*)(p.ws + W_DVEC);
  u16* qt = (u16*)smem;
  u16* kt = qt + 64 * 136;
  u16* ktT = kt + 64 * 136;
  u16* vT = ktT + 128 * 72;
  u16* sc = vT + 128 * 72;
  float* ps = (float*)(sc + 64 * 72);
  const int col = tid & 127, part = tid >> 7;
  float lfv[16], bcum[16];
  {
    const float* lfp = LF + (size_t)(r0 + part * 16) * 512 + h * 128 + col;
#pragma unroll
    for (int i = 0; i < 16; ++i) lfv[i] = lfp[(size_t)i * 512];
    float run = 0.f;
#pragma unroll
    for (int i = 0; i < 16; ++i) { run += lfv[i]; bcum[i] = run; }
    ps[part * 128 + col] = run;
  }
  u16 qraw[16], vraw[16];
  {
    const u16* qp0 = PQ + (size_t)(r0 + part * 16) * PQW + h * 128 + col;
#pragma unroll
    for (int i = 0; i < 16; ++i) { qraw[i] = qp0[(size_t)i * PQW]; vraw[i] = qp0[(size_t)i * PQW + 512]; }
  }
  RAW_BARRIER();
  {
    float off = 0.f, blast = 0.f;
#pragma unroll
    for (int pp = 0; pp < 4; ++pp) { float t = ps[pp * 128 + col]; blast += t; if (pp < part) off += t; }
    u16* qsout = QS + ((size_t)idx * 64 + part * 16) * 128 + col;
    float kkv[16];
#pragma unroll
    for (int i = 0; i < 16; ++i) {
      const float bb = bcum[i] + off;
      const int row = part * 16 + i;
      const float q = bf2f(qraw[i]);
      qsout[i * 128] = f2bf(q * __expf(bb));
      qt[row * 136 + col] = f2bf(q * __expf(bb - blast));
      kkv[i] = (1.f - __expf(lfv[i])) * __expf(blast - bb);
      kt[row * 136 + col] = f2bf(kkv[i]);
    }
#pragma unroll
    for (int hh = 0; hh < 2; ++hh) {
      *(u32x4*)(ktT + col * 72 + part * 16 + hh * 8) =
          u32x4{pack2(kkv[hh * 8 + 0], kkv[hh * 8 + 1]), pack2(kkv[hh * 8 + 2], kkv[hh * 8 + 3]),
                pack2(kkv[hh * 8 + 4], kkv[hh * 8 + 5]), pack2(kkv[hh * 8 + 6], kkv[hh * 8 + 7])};
      *(u32x4*)(vT + col * 72 + part * 16 + hh * 8) =
          u32x4{(unsigned)vraw[hh * 8 + 0] | ((unsigned)vraw[hh * 8 + 1] << 16), (unsigned)vraw[hh * 8 + 2] | ((unsigned)vraw[hh * 8 + 3] << 16),
                (unsigned)vraw[hh * 8 + 4] | ((unsigned)vraw[hh * 8 + 5] << 16), (unsigned)vraw[hh * 8 + 6] | ((unsigned)vraw[hh * 8 + 7] << 16)};
    }
    if (part == 0) DVEC[idx * 128 + col] = __expf(blast);
  }
  RAW_BARRIER();
  {
    const int tr = w >> 1;
    bf16x8 a[4];
#pragma unroll
    for (int ks = 0; ks < 4; ++ks) a[ks] = frag(qt, tr * 16, 136, ks * 32, lane);
#pragma unroll
    for (int tci = 0; tci < 2; ++tci) {
      const int tc = (w & 1) * 2 + tci;
      f32x4 acc = {0.f, 0.f, 0.f, 0.f};
#pragma unroll
      for (int ks = 0; ks < 4; ++ks) acc = mfma16(a[ks], frag(kt, tc * 16, 136, ks * 32, lane), acc);
#pragma unroll
      for (int j = 0; j < 4; ++j) {
        const int t = tr * 16 + lq * 4 + j, s = tc * 16 + lr;
        sc[t * 72 + s] = f2bf(t >= s ? acc[j] : 0.f);
      }
    }
  }
  RAW_BARRIER();
  {
    const int tr = w >> 1;
    const bf16x8 a0 = frag(sc, tr * 16, 72, 0, lane), a1 = frag(sc, tr * 16, 72, 32, lane);
#pragma unroll
    for (int tci = 0; tci < 4; ++tci) {
      const int tc = (w & 1) * 4 + tci;
      f32x4 acc = {0.f, 0.f, 0.f, 0.f};
      acc = mfma16(a0, frag(vT, tc * 16, 72, 0, lane), acc);
      acc = mfma16(a1, frag(vT, tc * 16, 72, 32, lane), acc);
      {
        float v[4] = {acc[0], acc[1], acc[2], acc[3]};
        quad_transpose(v, lane);
        store4_bf16(O0 + ((size_t)idx * 64 + tr * 16 + lq * 4 + (lane & 3)) * 128 + tc * 16 + (lr & 12), v);
      }
    }
  }
  {
    const int tr = w;
    const bf16x8 a0 = frag(ktT, tr * 16, 72, 0, lane), a1 = frag(ktT, tr * 16, 72, 32, lane);
#pragma unroll
    for (int tc = 0; tc < 8; ++tc) {
      f32x4 acc = {0.f, 0.f, 0.f, 0.f};
      acc = mfma16(a0, frag(vT, tc * 16, 72, 0, lane), acc);
      acc = mfma16(a1, frag(vT, tc * 16, 72, 32, lane), acc);
      {
        float v[4] = {acc[0], acc[1], acc[2], acc[3]};
        quad_transpose(v, lane);
        store4_bf16(NB + ((size_t)idx * 128 + tr * 16 + lq * 4 + (lane & 3)) * 128 + tc * 16 + (lr & 12), v);
      }
    }
  }
  RAW_BARRIER();
}

constexpr int ASTR = 68;
template <int J>
struct SolveCol {
  static __device__ __forceinline__ void run(f32x4 (&x)[16], const f32x4 (&a)[16], const float* AT) {
    if constexpr (J < 63) {
      f32x4 an[16];
      if constexpr (J + 1 < 63) {
#pragma unroll
        for (int B = (J + 2) / 4; B < 16; ++B) an[B] = *(const f32x4*)(AT + (J + 1) * ASTR + B * 4);
      }
      __builtin_amdgcn_sched_barrier(0);
      const float xj = x[J / 4][J % 4];
#pragma unroll
      for (int B = (J + 1) / 4; B < 16; ++B) x[B] -= a[B] * xj;
      __builtin_amdgcn_sched_barrier(0);
      SolveCol<J + 1>::run(x, an, AT);
    }
  }
};

__device__ void gdn_item(const Params& p, char* smem, int idx) {
  const int tid = opaque_tid(), lane = tid & 63, w = tid >> 6;
  const int lr = lane & 15, lq = lane >> 4;
  const int h = idx & 3, c = (idx >> 2) & 31, b = idx >> 7;
  const int r0 = b * 2048 + c * 64;
  const u16* PQ = (const u16*)(p.ws + W_PQ);
  const float* BETA = (const float*)(p.ws + W_BETA);
  const float* GDEC = (const float*)(p.ws + W_GDEC);
  u16* QS = (u16*)(p.ws + W_QS);
  u16* O0 = (u16*)(p.ws + W_H);
  u16* NB = (u16*)(p.out);
  u16* MNEG = (u16*)(p.ws + W_MNEG);
  float* DSC = (float*)(p.ws + W_DSC);
  u16* kb = (u16*)smem;
  u16* qb = kb + 64 * 136;
  u16* vS = qb + 64 * 136;
  float* Asol = (float*)(vS + 64 * 128);
  u16* attn = (u16*)(Asol + 64 * ASTR);
  u16* khT = attn + 64 * 72;
  u16* WT = khT + 128 * 72;
  u16* U0T = WT + 128 * 72;
  float* gc = (float*)(U0T + 128 * 72);
  float* bet = gc + 64;

  if (w == 0) {
    float g = GDEC[(size_t)(r0 + lane) * 4 + h];
#pragma unroll
    for (int o = 1; o < 64; o <<= 1) { float t = __shfl_up(g, o, 64); if (lane >= o) g += t; }
    gc[lane] = g;
    bet[lane] = BETA[(size_t)(r0 + lane) * 4 + h];
  }
  for (int rep_ = 0; rep_ < ((PROBE_G & 1) ? 2 : 1); ++rep_)
  {
    const int chq = 1024 + h * 128 + 2 * lane;
    const int cwq = h * 128 + 2 * lane;
    float cw[3][4][2];
#pragma unroll
    for (int ty = 0; ty < 3; ++ty)
#pragma unroll
      for (int j = 0; j < 4; ++j) {
        float2 t2 = *(const float2*)(p.conv_w + j * 1536 + ty * 512 + cwq);
        cw[ty][j][0] = t2.x; cw[ty][j][1] = t2.y;
      }
    float win[3][3][2];
    const int t0 = w * 8;
#pragma unroll
    for (int a = 0; a < 3; ++a) {
      const int rr = t0 - 3 + a;
      const bool valid = (c > 0) || (rr >= 0);
#pragma unroll
      for (int ty = 0; ty < 3; ++ty) {
        unsigned u = 0;
        if (valid) u = *(const unsigned*)(PQ + (ptrdiff_t)(r0 + rr) * PQW + chq + ty * 512);
        win[ty][a][0] = bf2f((u16)(u & 0xffff)); win[ty][a][1] = bf2f((u16)(u >> 16));
      }
    }
#pragma unroll
    for (int tt = 0; tt < 8; ++tt) {
      const int t = t0 + tt;
      float cv[3][2];
#pragma unroll
      for (int ty = 0; ty < 3; ++ty) {
        unsigned u = *(const unsigned*)(PQ + (size_t)(r0 + t) * PQW + chq + ty * 512);
        float c0 = bf2f((u16)(u & 0xffff)), c1 = bf2f((u16)(u >> 16));
        float s0 = cw[ty][0][0] * win[ty][0][0] + cw[ty][1][0] * win[ty][1][0] + cw[ty][2][0] * win[ty][2][0] + cw[ty][3][0] * c0;
        float s1 = cw[ty][0][1] * win[ty][0][1] + cw[ty][1][1] * win[ty][1][1] + cw[ty][2][1] * win[ty][2][1] + cw[ty][3][1] * c1;
        win[ty][0][0] = win[ty][1][0]; win[ty][0][1] = win[ty][1][1];
        win[ty][1][0] = win[ty][2][0]; win[ty][1][1] = win[ty][2][1];
        win[ty][2][0] = c0; win[ty][2][1] = c1;
        cv[ty][0] = siluf_(s0); cv[ty][1] = siluf_(s1);
      }
      float ssq = wave_sum(cv[0][0] * cv[0][0] + cv[0][1] * cv[0][1]);
      float ssk = wave_sum(cv[1][0] * cv[1][0] + cv[1][1] * cv[1][1]);
      const float rq = rsqrtf(ssq + EPS) * 0.08838834764831845f;
      const float rk = rsqrtf(ssk + EPS);
      *(unsigned*)(qb + t * 136 + 2 * lane) = pack2(cv[0][0] * rq, cv[0][1] * rq);
      *(unsigned*)(kb + t * 136 + 2 * lane) = pack2(cv[1][0] * rk, cv[1][1] * rk);
      *(unsigned*)(vS + t * 128 + 2 * lane) = pack2(cv[2][0], cv[2][1]);
    }
  }
  RAW_BARRIER();
  {
    const int which = w >> 2, tr = w & 3;
    const u16* Asrc = which ? qb : kb;
    bf16x8 a[4];
#pragma unroll
    for (int ks = 0; ks < 4; ++ks) a[ks] = frag(Asrc, tr * 16, 136, ks * 32, lane);
#pragma unroll
    for (int tc = 0; tc < 4; ++tc) {
      f32x4 acc = {0.f, 0.f, 0.f, 0.f};
#pragma unroll
      for (int ks = 0; ks < 4; ++ks) acc = mfma16(a[ks], frag(kb, tc * 16, 136, ks * 32, lane), acc);
#pragma unroll
      for (int j = 0; j < 4; ++j) {
        const int t = tr * 16 + lq * 4 + j, s = tc * 16 + lr;
        const float L = __expf(fminf(gc[t] - gc[s], 0.f));
        if (which == 0) Asol[s * ASTR + t] = (t > s) ? bet[t] * acc[j] * L : 0.f;
        else attn[t * 72 + s] = f2bf((t >= s) ? acc[j] * L : 0.f);
      }
    }
  }
  RAW_BARRIER();
  for (int rep_ = 0; rep_ < ((PROBE_G & 2) ? 2 : 1); ++rep_) {
  if (tid < 256) {
    f32x4 x[16];
    if (tid < 128) {
#pragma unroll
      for (int s = 0; s < 64; ++s) { x[s >> 2][s & 3] = bf2f(vS[s * 128 + tid]) * bet[s]; if ((s & 7) == 7) __builtin_amdgcn_sched_barrier(0); }
    } else {
#pragma unroll
      for (int s = 0; s < 64; ++s) { x[s >> 2][s & 3] = bf2f(kb[s * 136 + tid - 128]) * bet[s] * __expf(gc[s]); if ((s & 7) == 7) __builtin_amdgcn_sched_barrier(0); }
    }
    {
      f32x4 a0[16];
#pragma unroll
      for (int B = 0; B < 16; ++B) a0[B] = *(const f32x4*)(Asol + B * 4);
      SolveCol<0>::run(x, a0, Asol);
    }
    u16* dst = (tid < 128) ? (U0T + tid * 72) : (WT + (tid - 128) * 72);
#pragma unroll
    for (int s8 = 0; s8 < 8; ++s8) {
      *(u32x4*)(dst + s8 * 8) = u32x4{pack2(x[2 * s8][0], x[2 * s8][1]), pack2(x[2 * s8][2], x[2 * s8][3]),
                                      pack2(x[2 * s8 + 1][0], x[2 * s8 + 1][1]), pack2(x[2 * s8 + 1][2], x[2 * s8 + 1][3])};
    }
  } else {
    const float glast = gc[63];
    const int e0 = tid - 256;
#pragma unroll 4
    for (int i = 0; i < 32; ++i) {
      const int e = e0 + 256 * i;
      const int s = e & 63, kd = e >> 6;
      khT[kd * 72 + s] = f2bf(bf2f(kb[s * 136 + kd]) * __expf(glast - gc[s]));
    }
  }
  RAW_BARRIER();
  }
  for (int rep_ = 0; rep_ < ((PROBE_G & 4) ? 2 : 1); ++rep_) {
  {
    const int tr = w & 3, half = w >> 2;
    const u16* Bsrc = half ? U0T : WT;
    const bf16x8 a0 = frag(attn, tr * 16, 72, 0, lane), a1 = frag(attn, tr * 16, 72, 32, lane);
#pragma unroll 2
    for (int tc = 0; tc < 8; ++tc) {
      f32x4 acc = {0.f, 0.f, 0.f, 0.f};
      acc = mfma16(a0, frag(Bsrc, tc * 16, 72, 0, lane), acc);
      acc = mfma16(a1, frag(Bsrc, tc * 16, 72, 32, lane), acc);
      {
        float v[4];
#pragma unroll
        for (int j = 0; j < 4; ++j) {
          const int t = tr * 16 + lq * 4 + j, n = tc * 16 + lr;
          v[j] = half == 0 ? bf2f(qb[t * 136 + n]) * __expf(gc[t]) - acc[j] : acc[j];
        }
        quad_transpose(v, lane);
        const size_t o = ((size_t)(1024 + idx) * 64 + tr * 16 + lq * 4 + (lane & 3)) * 128 + tc * 16 + (lr & 12);
        store4_bf16((half == 0 ? QS : O0) + o, v);
      }
    }
  }
  {
    const int tr = w;
    const bf16x8 a0 = frag(khT, tr * 16, 72, 0, lane), a1 = frag(khT, tr * 16, 72, 32, lane);
#pragma unroll 2
    for (int tc = 0; tc < 16; ++tc) {
      const u16* Bsrc = tc < 8 ? WT : U0T;
      const int tcc = tc & 7;
      f32x4 acc = {0.f, 0.f, 0.f, 0.f};
      acc = mfma16(a0, frag(Bsrc, tcc * 16, 72, 0, lane), acc);
      acc = mfma16(a1, frag(Bsrc, tcc * 16, 72, 32, lane), acc);
      {
        float v[4];
#pragma unroll
        for (int j = 0; j < 4; ++j) v[j] = tc < 8 ? -acc[j] : acc[j];
        quad_transpose(v, lane);
        const size_t o = (size_t)(tr * 16 + lq * 4 + (lane & 3)) * 128 + tcc * 16 + (lr & 12);
        store4_bf16((tc < 8 ? MNEG + (size_t)idx * 16384 : NB + (size_t)(1024 + idx) * 16384) + o, v);
      }
    }
  }
  }
  if (tid < 128) ((float*)(p.ws + W_DVEC))[(size_t)(1024 + idx) * 128 + tid] = __expf(gc[63]);
  RAW_BARRIER();
}

__device__ void phase2(const Params& p, char* smem, int bid, int nb) {
  for (int it = bid; it < 2048; it += nb) {
    if (it >= 1024) { gdn_item(p, smem, it - 1024); if (DUP_MASK & 2048) gdn_item(p, smem, it - 1024); }
    else { hgrn_item(p, smem, it); if (DUP_MASK & 1024) hgrn_item(p, smem, it); }
  }
}

struct ScanRegs {
  bf16x8 Aq[4];
  bf16x8 Am[4];
  u32x2 o0, nn0, nn1;
  f32x4 dd;
};

template <int TYPE>
__device__ __forceinline__ void scan_load(ScanRegs& r, const Params& p, int idx, unsigned qoff, unsigned ooff, unsigned moff,
                                          unsigned noff, unsigned doff) {
  const int ii = __builtin_amdgcn_readfirstlane(idx);
  const int ti = TYPE * 1024 + ii;
  const u16* QSb = (const u16*)(p.ws + W_QS) + (size_t)ti * 8192;
  const u16* O0b = (const u16*)(p.ws + W_H) + (size_t)ti * 8192;
  const u16* NBb = (const u16*)(p.out) + (size_t)ti * 16384;
#pragma unroll
  for (int ks = 0; ks < 4; ++ks) r.Aq[ks] = *(const bf16x8*)(QSb + (qoff + ks * 32));
  r.o0 = *(const u32x2*)(O0b + ooff);
  r.nn0 = *(const u32x2*)(NBb + noff);
  r.nn1 = *(const u32x2*)(NBb + (noff + 16));
  if (TYPE == 1) {
    const u16* Mb = (const u16*)(p.ws + W_MNEG) + (size_t)ii * 16384;
#pragma unroll
    for (int ks = 0; ks < 4; ++ks) r.Am[ks] = *(const bf16x8*)(Mb + (moff + ks * 32));
  }
  r.dd = *(const f32x4*)((const float*)(p.ws + W_DVEC) + (size_t)ti * 128 + doff);
}
__device__ __forceinline__ void unpack4(u32x2 u, float (&v)[4]) {
  v[0] = bf2f((u16)(u[0] & 0xffff)); v[1] = bf2f((u16)(u[0] >> 16));
  v[2] = bf2f((u16)(u[1] & 0xffff)); v[3] = bf2f((u16)(u[1] >> 16));
}

template <int TYPE>
__device__ void scan_unit(const Params& p, char* smem, int rem) {
  const int tid = opaque_tid(), lane = tid & 63, w = tid >> 6;
  const int lr = lane & 15, lq = lane >> 4;
  const int b = rem >> 4, h = (rem >> 2) & 3, vs2 = rem & 3;
  const int tr = lq * 4 + (lane & 3), tc4 = lr & 12;
  const int otr = w & 3, otc = w >> 2;
  float* OPRE = (float*)(p.ws + W_PQ);
  u16* SbT = (u16*)smem;
  for (int i = tid; i < 2 * 32 * 136; i += 512) SbT[i] = 0;
  f32x4 S0 = {0.f, 0.f, 0.f, 0.f}, S1 = {0.f, 0.f, 0.f, 0.f};
  const unsigned qoff = (unsigned)((otr * 16 + lr) * 128 + lq * 8);
  const unsigned ooff = (unsigned)((otr * 16 + tr) * 128 + vs2 * 32 + otc * 16 + tc4);
  const unsigned moff = (unsigned)((w * 16 + lr) * 128 + lq * 8);
  const unsigned noff = (unsigned)((w * 16 + tr) * 128 + vs2 * 32 + tc4);
  const unsigned doff = (unsigned)(w * 16 + lq * 4);
  float* const orow = OPRE + (size_t)(b * 2048 + otr * 16 + tr) * 1024 + TYPE * 512 + h * 128 + vs2 * 32 + otc * 16 + tc4;
  ScanRegs r0, r1, r2, r3;
  const int idx0 = (b * 32) * 4 + h;
  scan_load<TYPE>(r0, p, idx0 + 0, qoff, ooff, moff, noff, doff);
  scan_load<TYPE>(r1, p, idx0 + 4, qoff, ooff, moff, noff, doff);
  scan_load<TYPE>(r2, p, idx0 + 8, qoff, ooff, moff, noff, doff);
  scan_load<TYPE>(r3, p, idx0 + 12, qoff, ooff, moff, noff, doff);
  __builtin_amdgcn_sched_barrier(0);
#define SCAN_STEP(R, c) { \
    RAW_BARRIER(); \
    const u16* Sb = SbT + ((c) & 1) * 32 * 136 + lr * 136 + lq * 8; \
    bf16x8 B0[4], B1[4], Bo[4]; \
    _Pragma("unroll") for (int ks = 0; ks < 4; ++ks) { \
      B0[ks] = *(const bf16x8*)(Sb + ks * 32); \
      B1[ks] = *(const bf16x8*)(Sb + 16 * 136 + ks * 32); \
      Bo[ks] = *(const bf16x8*)(Sb + otc * 16 * 136 + ks * 32); } \
    { \
      float ov[4]; unpack4(R.o0, ov); quad_transpose(ov, lane); \
      f32x4 acc = {ov[0], ov[1], ov[2], ov[3]}; \
      _Pragma("unroll") for (int ks = 0; ks < 4; ++ks) acc = mfma16(R.Aq[ks], Bo[ks], acc); \
      float o[4] = {acc[0], acc[1], acc[2], acc[3]}; \
      quad_transpose(o, lane); \
      *(f32x4*)(orow + (size_t)(c) * 65536) = f32x4{o[0], o[1], o[2], o[3]}; \
    } \
    float n0[4], n1[4]; unpack4(R.nn0, n0); unpack4(R.nn1, n1); \
    quad_transpose(n0, lane); quad_transpose(n1, lane); \
    f32x4 T0, T1; \
    _Pragma("unroll") for (int j = 0; j < 4; ++j) { T0[j] = R.dd[j] * S0[j] + n0[j]; T1[j] = R.dd[j] * S1[j] + n1[j]; } \
    if (TYPE == 1) { _Pragma("unroll") for (int ks = 0; ks < 4; ++ks) { T0 = mfma16(R.Am[ks], B0[ks], T0); T1 = mfma16(R.Am[ks], B1[ks], T1); } } \
    S0 = T0; S1 = T1; \
    u16* Sw = SbT + (((c) + 1) & 1) * 32 * 136 + lr * 136 + w * 16 + lq * 4; \
    *(u32x2*)(Sw) = u32x2{pack2(S0[0], S0[1]), pack2(S0[2], S0[3])}; \
    *(u32x2*)(Sw + 16 * 136) = u32x2{pack2(S1[0], S1[1]), pack2(S1[2], S1[3])}; \
    __builtin_amdgcn_sched_barrier(0); \
    scan_load<TYPE>(R, p, idx0 + (((c) + 4 < 32) ? (c) + 4 : 31) * 4, qoff, ooff, moff, noff, doff); \
    __builtin_amdgcn_sched_barrier(0); \
  }
  for (int c0 = 0; c0 < 32; c0 += 4) {
    SCAN_STEP(r0, c0)
    SCAN_STEP(r1, c0 + 1)
    SCAN_STEP(r2, c0 + 2)
    SCAN_STEP(r3, c0 + 3)
  }
#undef SCAN_STEP
  float* so = p.out + (TYPE ? O_GDP : O_HGP) + (size_t)(b * 4 + h) * 16384 + (w * 16 + tr) * 128 + vs2 * 32 + tc4;
  {
    float sv[4] = {S0[0], S0[1], S0[2], S0[3]};
    quad_transpose(sv, lane);
    *(f32x4*)(so) = f32x4{sv[0], sv[1], sv[2], sv[3]};
    float sw[4] = {S1[0], S1[1], S1[2], S1[3]};
    quad_transpose(sw, lane);
    *(f32x4*)(so + 16) = f32x4{sw[0], sw[1], sw[2], sw[3]};
  }
  __syncthreads();
}

__device__ void sample_item(const Params& p, char* smem, int it) {
  const int tid = opaque_tid(), lane = tid & 63, w = tid >> 6;
  const int type = it >> 9, b = (it >> 2) & 127, h = it & 3;
  const int row = MP + b;
  const u16* PQ = (const u16*)(p.ws + W_PQ);
  const float* LF = (const float*)(p.ws + W_LF);
  const float* BETA = (const float*)(p.ws + W_BETA);
  const float* GDEC = (const float*)(p.ws + W_GDEC);
  float* OPRE = (float*)(p.ws + W_PQ);
  float* fq = (float*)smem;
  float* fk = fq + 128;
  float* fv = fk + 128;
  float* fe = fv + 128;
  float* red = fe + 128;
  float* sc = red + 1024;
  const int n = tid & 127, kp = tid >> 7;
  if (type == 0) {
    if (tid < 128) {
      const float lf = LF[(size_t)row * 512 + h * 128 + tid];
      const float f = __expf(lf);
      fe[tid] = f;
      fk[tid] = 1.f - f;
      fq[tid] = bf2f(PQ[(size_t)row * PQW + h * 128 + tid]);
      fv[tid] = bf2f(PQ[(size_t)row * PQW + 512 + h * 128 + tid]);
    }
    __syncthreads();
    const float* S = p.state_hgrn + ((size_t)(b * 4 + h) * 128) * 128;
    float* So = p.out + O_HGS + ((size_t)(b * 4 + h) * 128) * 128;
    const float vn = fv[n];
    float o = 0.f;
#pragma unroll
    for (int i = 0; i < 32; ++i) {
      const int k = kp * 32 + i;
      const float sn = fe[k] * S[k * 128 + n] + fk[k] * vn;
      So[k * 128 + n] = sn;
      o += fq[k] * sn;
    }
    red[kp * 128 + n] = o;
    __syncthreads();
    if (tid < 128) OPRE[(size_t)row * 1024 + h * 128 + tid] = red[tid] + red[128 + tid] + red[256 + tid] + red[384 + tid];
    __syncthreads();
  } else {
    const float* cprev = p.state_conv + (size_t)b * 3 * 1536;
    if (tid < 384) {
      const int ty = tid >> 7, cc = tid & 127;
      const int ch = ty * 512 + h * 128 + cc;
      const float p0 = cprev[ch], p1 = cprev[1536 + ch], p2 = cprev[3072 + ch];
      const float nw = bf2f(PQ[(size_t)row * PQW + 1024 + ch]);
      const float s = p.conv_w[ch] * p0 + p.conv_w[1536 + ch] * p1 + p.conv_w[3072 + ch] * p2 + p.conv_w[4608 + ch] * nw;
      fq[ty * 128 + cc] = siluf_(s);
      p.out[O_CVS + (size_t)(b * 3 + 0) * 1536 + ch] = p1;
      p.out[O_CVS + (size_t)(b * 3 + 1) * 1536 + ch] = p2;
    }
    __syncthreads();
    if (w < 2) {
      const float a0 = fq[w * 128 + lane], a1 = fq[w * 128 + 64 + lane];
      const float ss = wave_sum(a0 * a0 + a1 * a1);
      if (lane == 0) sc[w] = ss;
    }
    __syncthreads();
    const float rq = rsqrtf(sc[0] + EPS) * 0.08838834764831845f;
    const float rk = rsqrtf(sc[1] + EPS);
    __syncthreads();
    if (tid < 128) fq[tid] *= rq;
    else if (tid < 256) fk[tid - 128] *= rk;
    __syncthreads();
    if (w == 0) {
      const float qk = wave_sum(fq[lane] * fk[lane] + fq[64 + lane] * fk[64 + lane]);
      if (lane == 0) sc[2] = qk;
    }
    const float eg = __expf(GDEC[(size_t)row * 4 + h]);
    const float beta = BETA[(size_t)row * 4 + h];
    const float* S = p.state_gdn + ((size_t)(b * 4 + h) * 128) * 128;
    float* So = p.out + O_GDS + ((size_t)(b * 4 + h) * 128) * 128;
    float sd[32];
    float ks_ = 0.f, qs_ = 0.f;
#pragma unroll
    for (int i = 0; i < 32; ++i) {
      const int k = kp * 32 + i;
      sd[i] = eg * S[k * 128 + n];
      ks_ += fk[k] * sd[i];
      qs_ += fq[k] * sd[i];
    }
    red[kp * 128 + n] = ks_;
    red[512 + kp * 128 + n] = qs_;
    __syncthreads();
    const float kS = red[n] + red[128 + n] + red[256 + n] + red[384 + n];
    const float delta = (fv[n] - kS) * beta;
#pragma unroll
    for (int i = 0; i < 32; ++i) {
      const int k = kp * 32 + i;
      So[k * 128 + n] = sd[i] + fk[k] * delta;
    }
    if (tid < 128) {
      const float qS = red[512 + n] + red[640 + n] + red[768 + n] + red[896 + n];
      OPRE[(size_t)row * 1024 + 512 + h * 128 + n] = qS + sc[2] * delta;
    }
    __syncthreads();
  }
}

__device__ void sample_block4(const Params& p, char* smem, int bid) {
  const int tid = opaque_tid(), lane = tid & 63, w = tid >> 6;
  const u16* PQ = (const u16*)(p.ws + W_PQ);
  const float* LF = (const float*)(p.ws + W_LF);
  const float* BETA = (const float*)(p.ws + W_BETA);
  const float* GDEC = (const float*)(p.ws + W_GDEC);
  float* OPRE = (float*)(p.ws + W_PQ);
  float* vec = (float*)smem;
  float* red = vec + 2048;
  float* sc = red + 1024;
  if (tid < 256) {
    const int j = tid >> 7, c = tid & 127;
    const int it = bid + 256 * j, b = (it >> 2) & 127, h = it & 3, row = MP + b;
    const float f = __expf(LF[(size_t)row * 512 + h * 128 + c]);
    vec[(j * 4 + 0) * 128 + c] = bf2f(PQ[(size_t)row * PQW + h * 128 + c]);
    vec[(j * 4 + 1) * 128 + c] = 1.f - f;
    vec[(j * 4 + 2) * 128 + c] = bf2f(PQ[(size_t)row * PQW + 512 + h * 128 + c]);
    vec[(j * 4 + 3) * 128 + c] = f;
  }
  for (int e = tid; e < 768; e += 512) {
    const int j = 2 + e / 384, r = e % 384, ty = r >> 7, cc = r & 127;
    const int it = bid + 256 * j, b = (it >> 2) & 127, h = it & 3, row = MP + b;
    const int ch = ty * 512 + h * 128 + cc;
    const float* cprev = p.state_conv + (size_t)b * 3 * 1536;
    const float p0 = cprev[ch], p1 = cprev[1536 + ch], p2 = cprev[3072 + ch];
    const float nw = bf2f(PQ[(size_t)row * PQW + 1024 + ch]);
    const float s = p.conv_w[ch] * p0 + p.conv_w[1536 + ch] * p1 + p.conv_w[3072 + ch] * p2 + p.conv_w[4608 + ch] * nw;
    vec[(j * 4 + ty) * 128 + cc] = siluf_(s);
    p.out[O_CVS + (size_t)(b * 3 + 0) * 1536 + ch] = p1;
    p.out[O_CVS + (size_t)(b * 3 + 1) * 1536 + ch] = p2;
  }
  __syncthreads();
  if (w < 4) {
    const int j = 2 + (w >> 1), which = w & 1;
    const float a0 = vec[(j * 4 + which) * 128 + lane], a1 = vec[(j * 4 + which) * 128 + 64 + lane];
    const float ss = wave_sum(a0 * a0 + a1 * a1);
    if (lane == 0) sc[j * 4 + which] = ss;
  }
  __syncthreads();
  {
    const int j = 2 + (tid >> 8), which = (tid >> 7) & 1, c = tid & 127;
    const float r = which == 0 ? rsqrtf(sc[j * 4 + 0] + EPS) * 0.08838834764831845f : rsqrtf(sc[j * 4 + 1] + EPS);
    vec[(j * 4 + which) * 128 + c] *= r;
  }
  __syncthreads();
  if (w < 2) {
    const int j = 2 + w;
    const float qk = wave_sum(vec[(j * 4 + 0) * 128 + lane] * vec[(j * 4 + 1) * 128 + lane] +
                              vec[(j * 4 + 0) * 128 + 64 + lane] * vec[(j * 4 + 1) * 128 + 64 + lane]);
    if (lane == 0) sc[j * 4 + 2] = qk;
  }
  __syncthreads();
  const int n = tid & 127, kp = tid >> 7;
  float cur[32], nxt[32];
  {
    const int it = bid, b = (it >> 2) & 127, h = it & 3;
    const float* S = p.state_hgrn + ((size_t)(b * 4 + h) * 128) * 128;
#pragma unroll
    for (int i = 0; i < 32; ++i) cur[i] = S[(kp * 32 + i) * 128 + n];
  }
#pragma unroll
  for (int j = 0; j < 4; ++j) {
    const int it = bid + 256 * j, b = (it >> 2) & 127, h = it & 3, row = MP + b;
    if (j < 3) {
      const int it2 = bid + 256 * (j + 1), b2 = (it2 >> 2) & 127, h2 = it2 & 3;
      const float* S2 = ((j + 1) < 2 ? p.state_hgrn : p.state_gdn) + ((size_t)(b2 * 4 + h2) * 128) * 128;
#pragma unroll
      for (int i = 0; i < 32; ++i) nxt[i] = S2[(kp * 32 + i) * 128 + n];
    }
    const float* fq = vec + (j * 4 + 0) * 128;
    const float* fk = vec + (j * 4 + 1) * 128;
    const float* fv = vec + (j * 4 + 2) * 128;
    const float* fe = vec + (j * 4 + 3) * 128;
    if (j < 2) {
      float* So = p.out + O_HGS + ((size_t)(b * 4 + h) * 128) * 128;
      const float vn = fv[n];
      float o = 0.f;
#pragma unroll
      for (int i = 0; i < 32; ++i) {
        const int k = kp * 32 + i;
        const float sn = fe[k] * cur[i] + fk[k] * vn;
        So[k * 128 + n] = sn;
        o += fq[k] * sn;
      }
      red[kp * 128 + n] = o;
      __syncthreads();
      if (tid < 128) OPRE[(size_t)row * 1024 + h * 128 + tid] = red[tid] + red[128 + tid] + red[256 + tid] + red[384 + tid];
      __syncthreads();
    } else {
      float* So = p.out + O_GDS + ((size_t)(b * 4 + h) * 128) * 128;
      const float eg = __expf(GDEC[(size_t)row * 4 + h]);
      const float beta = BETA[(size_t)row * 4 + h];
      float ks_ = 0.f, qs_ = 0.f;
#pragma unroll
      for (int i = 0; i < 32; ++i) {
        const int k = kp * 32 + i;
        cur[i] *= eg;
        ks_ += fk[k] * cur[i];
        qs_ += fq[k] * cur[i];
      }
      red[kp * 128 + n] = ks_;
      red[512 + kp * 128 + n] = qs_;
      __syncthreads();
      const float kS = red[n] + red[128 + n] + red[256 + n] + red[384 + n];
      const float delta = (fv[n] - kS) * beta;
#pragma unroll
      for (int i = 0; i < 32; ++i) {
        const int k = kp * 32 + i;
        So[k * 128 + n] = cur[i] + fk[k] * delta;
      }
      if (tid < 128) {
        const float qS = red[512 + n] + red[640 + n] + red[768 + n] + red[896 + n];
        OPRE[(size_t)row * 1024 + 512 + h * 128 + n] = qS + sc[j * 4 + 2] * delta;
      }
      __syncthreads();
    }
#pragma unroll
    for (int i = 0; i < 32; ++i) cur[i] = nxt[i];
  }
}

#define XB_TICKET(j) (3456 + 16 * (j))
__device__ void phase3(const Params& p, char* smem, int bid, int nb) {
  volatile LAS unsigned* st = (volatile LAS unsigned*)(unsigned)(size_t)(smem + LDS_BYTES - 16);
  unsigned* bar = (unsigned*)(p.ws + W_BAR);
  if (threadIdx.x == 0) {
    unsigned ok = (nb == 256) ? 1u : 0u, rank = 0u;
    const unsigned x = xb_xcc_id();
    unsigned npop = 0u;
    for (unsigned j = 0; j < 16; ++j) {
      const unsigned c = xb_ld(&bar[XB_XCNT(j)]);
      if (c != 0u) { ++npop; if (c != 32u) ok = 0u; if (j < x) ++rank; }
    }
    if (npop != 8u) ok = 0u;
    unsigned ticket = 0u;
    if (ok) ticket = xb_add(&bar[XB_TICKET(x)], 1u);
    st[2] = ok ? (0x100u | (rank << 5) | (ticket & 31u)) : 0u;
  }
  __syncthreads();
  const unsigned place = st[2];
  __syncthreads();
  if (place) {
    const int r = (place >> 5) & 7, t = place & 31;
    const int g = (t >> 2) * 8 + r;
    const int uu = (g << 2) | (t & 3);
    if (uu < 128) scan_unit<0>(p, smem, uu); else scan_unit<1>(p, smem, uu - 128);
    if (DUP_MASK & 256) { if (uu < 128) scan_unit<0>(p, smem, uu); else scan_unit<1>(p, smem, uu - 128); }
    if (uu < 128) {
      const int rankH = r * 16 + t;
      sample_block4(p, smem, rankH);
      sample_block4(p, smem, rankH + 128);
    }
    return;
  }
  for (int u = bid; u < 256; u += nb) {
    int uu = u;
    if (nb == 256) {
      const int xcd = u & 7, j = u >> 3;
      uu = ((xcd * 8 + (j >> 2)) << 2) | (j & 3);
    }
    if (uu < 128) scan_unit<0>(p, smem, uu); else scan_unit<1>(p, smem, uu - 128);
  }
  if (nb == 256) {
    if ((bid & 7) < 4) {
      const int rank = (bid >> 3) * 4 + (bid & 3);
      sample_block4(p, smem, rank);
      sample_block4(p, smem, rank + 128);
    }
  } else {
    for (int it = bid; it < 1024; it += nb) sample_item(p, smem, it);
  }
}

__device__ void phase4(const Params& p, int bid, int nb) {
  const int tid = opaque_tid(), lane = tid & 63, w = tid >> 6;
  const float* OPRE = (const float*)(p.ws + W_PQ);
  const u16* GATES = (const u16*)(p.ws + W_GATES);
  u16* A2 = (u16*)(p.ws + W_QS);
  constexpr int NG = MT / 8;
  for (int g = bid; g < NG; g += 2 * nb) {
    const bool two = (g + nb) < NG;
    const int rows[2] = {g * 8 + w, (two ? g + nb : g) * 8 + w};
    f32x4 v[2][4];
    u32x2 gt[2][4];
#pragma unroll
    for (int r = 0; r < 2; ++r)
#pragma unroll
      for (int i = 0; i < 4; ++i) {
        const int col = i * 256 + lane * 4;
        v[r][i] = *(const f32x4*)(OPRE + (size_t)rows[r] * 1024 + col);
        gt[r][i] = *(const u32x2*)(GATES + (size_t)rows[r] * 1024 + col);
      }
#pragma unroll
    for (int r = 0; r < 2; ++r) {
      if (r == 1 && !two) break;
#pragma unroll
      for (int i = 0; i < 4; ++i) {
        const int col = i * 256 + lane * 4;
        float ss = v[r][i][0] * v[r][i][0] + v[r][i][1] * v[r][i][1] + v[r][i][2] * v[r][i][2] + v[r][i][3] * v[r][i][3];
        ss += dpp_mov<0xB1, 0xf>(ss);
        ss += dpp_mov<0x4E, 0xf>(ss);
        ss += dpp_mov<0x141, 0xf>(ss);
        ss += dpp_mov<0x140, 0xf>(ss);
        ss += __shfl_xor(ss, 16, 64);
        const float rstd = rsqrtf(ss * (1.f / 128.f) + EPS);
        const f32x4 nw = *(const f32x4*)((col < 512 ? p.hg_norm : p.gdn_norm) + (col & 127));
        float gg[4];
        unpack4(gt[r][i], gg);
        *(u32x2*)(A2 + (size_t)rows[r] * LDK + col) =
            u32x2{pack2(v[r][i][0] * rstd * nw[0] * gg[0], v[r][i][1] * rstd * nw[1] * gg[1]),
                  pack2(v[r][i][2] * rstd * nw[2] * gg[2], v[r][i][3] * rstd * nw[3] * gg[3])};
      }
    }
  }
}

__device__ void phase6(const Params& p, int bid, int nb) {
  const int tid = opaque_tid(), lane = tid & 63, w = tid >> 6;
  constexpr int NG = MT / 8, NR = 4;
  for (int g = bid; g < NG; g += NR * nb) {
    float* y[NR];
    bool ok[NR];
    float4 xv[NR][4];
    float ss[NR];
#pragma unroll
    for (int r = 0; r < NR; ++r) {
      ok[r] = (g + r * nb) < NG;
      const int row = (ok[r] ? g + r * nb : g) * 8 + w;
      y[r] = row < MP ? p.out + O_YP + (size_t)row * 1024 : p.out + O_YS + (size_t)(row - MP) * 1024;
#pragma unroll
      for (int i = 0; i < 4; ++i) xv[r][i] = *(const float4*)(y[r] + i * 256 + lane * 4);
    }
#pragma unroll
    for (int r = 0; r < NR; ++r) {
      ss[r] = 0.f;
#pragma unroll
      for (int i = 0; i < 4; ++i) ss[r] += xv[r][i].x * xv[r][i].x + xv[r][i].y * xv[r][i].y + xv[r][i].z * xv[r][i].z + xv[r][i].w * xv[r][i].w;
      ss[r] = wave_sum(ss[r]);
    }
#pragma unroll
    for (int r = 0; r < NR; ++r) {
      if (ok[r]) {
        const float rstd = rsqrtf(ss[r] * (1.f / 1024.f) + EPS);
#pragma unroll
        for (int i = 0; i < 4; ++i) {
          const float4 nw = *(const float4*)(p.final_norm + i * 256 + lane * 4);
          float4 o;
          o.x = xv[r][i].x * rstd * nw.x; o.y = xv[r][i].y * rstd * nw.y; o.z = xv[r][i].z * rstd * nw.z; o.w = xv[r][i].w * rstd * nw.w;
          *(float4*)(y[r] + i * 256 + lane * 4) = o;
        }
      }
    }
  }
}


template <int PH>
__device__ __forceinline__ void run_phase(const Params& p, char* smem, int bid, int nb) {
  if (PH == 0) phase0(p, smem, bid, nb);
  else if (PH == 1) gemm_phase<0>(p, (const u16*)(p.ws + W_H), (const u16*)(p.ws + W_WINT), 16, smem, bid, nb);
  else if (PH == 2) phase2(p, smem, bid, nb);
  else if (PH == 3) phase3(p, smem, bid, nb);
  else if (PH == 4) phase4(p, bid, nb);
  else if (PH == 5) gemm_phase<1>(p, (const u16*)(p.ws + W_QS), (const u16*)(p.ws + W_WOUTT), 4, smem, bid, nb);
  else phase6(p, bid, nb);
}

#if MEGA
__global__ void __launch_bounds__(NTH) mega_kernel(Params p) {
  extern __shared__ __attribute__((aligned(16))) char smem[];
  cg::grid_group grid = cg::this_grid();
  const int bid = blockIdx.x, nb = gridDim.x;
  if (p.out == nullptr) grid.sync();
  volatile LAS unsigned* st = (volatile LAS unsigned*)(unsigned)(size_t)(smem + LDS_BYTES - 16);
  if (threadIdx.x == 0) { st[0] = 0u; st[1] = 0u; }
  __syncthreads();
  const XcdBarrier xb = xcd_barrier_post((unsigned*)(p.ws + W_BAR), st);
#define GSYNC() xcd_barrier(xb)
#define RUNP(k) run_phase<k>(p, smem, bid, nb); GSYNC(); if (DUP_MASK & (1 << k)) { run_phase<k>(p, smem, bid, nb); GSYNC(); }
  RUNP(0)
  if (PROBE_SYNC) { for (int i_ = 0; i_ < PROBE_SYNC; ++i_) GSYNC(); }
  RUNP(1)
  if (PROBE_GEMM) { gemm_phase<0, PROBE_GEMM>(p, (const u16*)(p.ws + W_H), (const u16*)(p.ws + W_WINT), 16, smem, bid, nb); GSYNC(); }
  RUNP(2) RUNP(3) RUNP(4) RUNP(5)
#undef RUNP
#undef GSYNC
  run_phase<6>(p, smem, bid, nb);
}
#else
template <int PH>
__global__ void __launch_bounds__(NTH) phase_kernel(Params p) {
  extern __shared__ __attribute__((aligned(16))) char smem[];
  run_phase<PH>(p, smem, blockIdx.x, gridDim.x);
}
template <int PH>
static void launch_phase(const Params& p, int grid, hipStream_t stream) {
  hipFuncSetAttribute((const void*)phase_kernel<PH>, hipFuncAttributeMaxDynamicSharedMemorySize, (int)LDS_BYTES);
  hipLaunchKernelGGL(phase_kernel<PH>, dim3(grid), dim3(NTH), LDS_BYTES, stream, p);
}
#endif

extern "C" void kernel_launch(void* const* d_in, const int* in_sizes, int n_in, void* d_out, int out_size,
                              void* d_ws, size_t ws_size, hipStream_t stream) {
  Params p{};
  p.x_prompt = (const float*)d_in[0];
  p.x_sample = (const float*)d_in[1];
  p.state_hgrn = (const float*)d_in[2];
  p.state_gdn = (const float*)d_in[3];
  p.state_conv = (const float*)d_in[4];
  p.norm_w = (const float*)d_in[5];
  p.w_in = (const float*)d_in[6];
  p.lb_logits = (const float*)d_in[7];
  p.conv_w = (const float*)d_in[8];
  p.a_log = (const float*)d_in[9];
  p.dt_bias = (const float*)d_in[10];
  p.hg_norm = (const float*)d_in[11];
  p.gdn_norm = (const float*)d_in[12];
  p.w_out = (const float*)d_in[13];
  p.final_norm = (const float*)d_in[14];
  p.out = (float*)d_out;
  p.ws = (char*)d_ws;
  if (ws_size < W_END) { fprintf(stderr, "workspace too small: %zu < %zu\n", ws_size, (size_t)W_END); return; }
#if MEGA
  static int grid_blocks = 0;
  if (!grid_blocks) {
    int dev = 0, cus = 0, per_cu = 0;
    hipGetDevice(&dev);
    hipDeviceGetAttribute(&cus, hipDeviceAttributeMultiprocessorCount, dev);
    hipFuncSetAttribute((const void*)mega_kernel, hipFuncAttributeMaxDynamicSharedMemorySize, (int)LDS_BYTES);
    hipOccupancyMaxActiveBlocksPerMultiprocessor(&per_cu, mega_kernel, NTH, LDS_BYTES);
    if (per_cu < 1) per_cu = 1;
    grid_blocks = cus * per_cu;
  }
  (void)hipMemsetAsync((char*)d_ws + W_BAR, 0, 16384, stream);
  void* args[] = {&p};
  hipError_t e = hipLaunchCooperativeKernel((void*)mega_kernel, dim3(grid_blocks), dim3(NTH), args, LDS_BYTES, stream);
  if (e != hipSuccess) fprintf(stderr, "cooperative launch failed: %s (grid %d)\n", hipGetErrorString(e), grid_blocks);
#else
  const int grid = 256;
  launch_phase<0>(p, grid, stream);
  launch_phase<1>(p, grid, stream);
  launch_phase<2>(p, grid, stream);
  launch_phase<3>(p, grid, stream);
  launch_phase<4>(p, grid, stream);
  launch_phase<5>(p, grid, stream);
  launch_phase<6>(p, grid, stream);
#endif
}
```

```cpp
#include <hip/hip_runtime.h>
#include <hip/hip_cooperative_groups.h>
#include <cstdio>
namespace cg = cooperative_groups;

#ifndef MEGA
#define MEGA 1
#define PROBE_GEMM 0
#define PROBE_SYNC 0
#define PROBE_G 0
#define DUP_MASK 0
#endif

typedef unsigned short u16;
using bf16x8 = __attribute__((ext_vector_type(8))) short;
using f32x4 = __attribute__((ext_vector_type(4))) float;
using u32x4 = __attribute__((ext_vector_type(4))) unsigned;
using u32x2 = __attribute__((ext_vector_type(2))) unsigned;

#define NTH 512
constexpr int MP = 16384, MS = 128, MT = 16512, DM = 1024, DIN = 4104, PQW = 2560;
constexpr float EPS = 1e-6f;
constexpr int LDK = 1088;
constexpr size_t LDS_BYTES = 139264;

constexpr size_t O_YP = 0, O_YS = 16777216, O_HGP = 16908288, O_GDP = 17432576, O_CVP = 17956864,
                 O_HGS = 17993728, O_GDS = 26382336, O_CVS = 34770944;
constexpr size_t W_WINT = 0;
constexpr size_t W_WOUTT = W_WINT + (size_t)4096 * LDK * 2;
constexpr size_t W_BETA = W_WOUTT + (size_t)1024 * LDK * 2;
constexpr size_t W_GDEC = W_BETA + 264192;
constexpr size_t W_DVEC = W_GDEC + 264192;
constexpr size_t W_DSC = W_DVEC + 1048576;
constexpr size_t W_PQ = W_DSC + 4096;
constexpr size_t W_GATES = W_PQ + 84541440;
constexpr size_t W_H = W_GATES + 33816576;
constexpr size_t W_QS = W_H + (size_t)MT * LDK * 2;
constexpr size_t W_MNEG = W_QS + 33554432;
constexpr size_t W_LF = W_MNEG + 33554432;
constexpr size_t W_BAR = W_LF + 33816576;
constexpr size_t W_END = W_BAR + 16384;

struct Params {
  const float *x_prompt, *x_sample, *state_hgrn, *state_gdn, *state_conv, *norm_w, *w_in, *lb_logits,
      *conv_w, *a_log, *dt_bias, *hg_norm, *gdn_norm, *w_out, *final_norm;
  float* out;
  char* ws;
};

__device__ __forceinline__ int opaque_tid() { int t = threadIdx.x; asm volatile("" : "+v"(t)); return t; }
typedef __bf16 bf16x2_t __attribute__((ext_vector_type(2)));
typedef float f32x2_t __attribute__((ext_vector_type(2)));
__device__ __forceinline__ u16 f2bf(float x) { return __builtin_bit_cast(u16, (__bf16)x); }
__device__ __forceinline__ float bf2f(u16 h) { return __uint_as_float(((unsigned)h) << 16); }
__device__ __forceinline__ unsigned pack2(float a, float b) {
  f32x2_t v = {a, b};
  return __builtin_bit_cast(unsigned, __builtin_convertvector(v, bf16x2_t));
}
template <int CTRL, int ROWMASK>
__device__ __forceinline__ float dpp_mov(float v) {
  return __builtin_bit_cast(float, __builtin_amdgcn_update_dpp(0, __builtin_bit_cast(int, v), CTRL, ROWMASK, 0xf, false));
}
__device__ __forceinline__ float wave_sum(float v) {
  v += dpp_mov<0xB1, 0xf>(v);
  v += dpp_mov<0x4E, 0xf>(v);
  v += dpp_mov<0x141, 0xf>(v);
  v += dpp_mov<0x140, 0xf>(v);
  v += dpp_mov<0x142, 0xa>(v);
  v += dpp_mov<0x143, 0xc>(v);
  return __builtin_bit_cast(float, __builtin_amdgcn_readlane(__builtin_bit_cast(int, v), 63));
}
__device__ __forceinline__ float sigmoidf_(float x) { return 1.f / (1.f + __expf(-x)); }
__device__ __forceinline__ float siluf_(float x) { return x / (1.f + __expf(-x)); }
__device__ __forceinline__ f32x4 mfma16(bf16x8 a, bf16x8 b, f32x4 c) {
  return __builtin_amdgcn_mfma_f32_16x16x32_bf16(a, b, c, 0, 0, 0);
}
__device__ __forceinline__ bf16x8 frag(const u16* base, int row0, int stride, int koff, int lane) {
  return *(const bf16x8*)(base + (row0 + (lane & 15)) * stride + koff + (lane >> 4) * 8);
}

__device__ __forceinline__ void quad_transpose(float (&v)[4], int lane) {
  {
    const bool b = lane & 1;
    float s0 = b ? v[0] : v[1], s1 = b ? v[2] : v[3];
    float r0 = dpp_mov<0xB1, 0xf>(s0), r1 = dpp_mov<0xB1, 0xf>(s1);
    if (b) { v[0] = r0; v[2] = r1; } else { v[1] = r0; v[3] = r1; }
  }
  {
    const bool b = lane & 2;
    float s0 = b ? v[0] : v[2], s1 = b ? v[1] : v[3];
    float r0 = dpp_mov<0x4E, 0xf>(s0), r1 = dpp_mov<0x4E, 0xf>(s1);
    if (b) { v[0] = r0; v[1] = r1; } else { v[2] = r0; v[3] = r1; }
  }
}
__device__ __forceinline__ void store4_bf16(u16* dst, const float (&v)[4]) {
  *(u32x2*)dst = u32x2{pack2(v[0], v[1]), pack2(v[2], v[3])};
}
__device__ void phase0(const Params& p, char* smem, int bid, int nb) {
  const int tid = opaque_tid(), lane = tid & 63, w = tid >> 6;
  u16* WinT = (u16*)(p.ws + W_WINT);
  u16* WoutT = (u16*)(p.ws + W_WOUTT);
  u16* H = (u16*)(p.ws + W_H);
  float* BETA = (float*)(p.ws + W_BETA);
  float* GDEC = (float*)(p.ws + W_GDEC);
  float* tl = (float*)smem;
  {
    float pre[8];
    auto tile_src = [&](int t, const float*& src, int& sstride, u16*& dst, int& kt, int& nt) {
      if (t < 1024) { src = p.w_in; sstride = DIN; dst = WinT; kt = t >> 6; nt = t & 63; }
      else { int u = t - 1024; src = p.w_out; sstride = 1024; dst = WoutT; kt = u >> 4; nt = u & 15; }
    };
    if (bid < 1280) {
      const float* src; int sstride; u16* dst; int kt, nt;
      tile_src(bid, src, sstride, dst, kt, nt);
#pragma unroll
      for (int i = 0; i < 8; ++i) { int idx = tid + 512 * i; pre[i] = src[(size_t)(kt * 64 + (idx >> 6)) * sstride + nt * 64 + (idx & 63)]; }
    }
    for (int t = bid; t < 1280; t += nb) {
      const float* src; int sstride; u16* dst; int kt, nt;
      tile_src(t, src, sstride, dst, kt, nt);
#pragma unroll
      for (int i = 0; i < 8; ++i) { int idx = tid + 512 * i; tl[(idx >> 6) * 65 + (idx & 63)] = pre[i]; }
      __syncthreads();
      if (t + nb < 1280) {
        const float* src2; int ss2; u16* dst2; int kt2, nt2;
        tile_src(t + nb, src2, ss2, dst2, kt2, nt2);
#pragma unroll
        for (int i = 0; i < 8; ++i) { int idx = tid + 512 * i; pre[i] = src2[(size_t)(kt2 * 64 + (idx >> 6)) * ss2 + nt2 * 64 + (idx & 63)]; }
      }
      {
        int nn = tid >> 3, k8 = (tid & 7) * 8;
        unsigned pk[4];
#pragma unroll
        for (int e = 0; e < 4; ++e) pk[e] = pack2(tl[(k8 + 2 * e) * 65 + nn], tl[(k8 + 2 * e + 1) * 65 + nn]);
        *(uint4*)(dst + (size_t)(nt * 64 + nn) * LDK + kt * 64 + k8) = make_uint4(pk[0], pk[1], pk[2], pk[3]);
      }
      __syncthreads();
    }
  }
  float* W8s = (float*)smem;
  for (int idx = tid; idx < 8192; idx += 512) {
    int j = idx & 7, k = idx >> 3;
    W8s[j * 1024 + k] = p.w_in[(size_t)k * DIN + 4096 + j];
  }
  __syncthreads();
  float4 xn[4];
  if (bid < MT / 8) {
    const int row = bid * 8 + w;
    const float* x = row < MP ? p.x_prompt + (size_t)row * 1024 : p.x_sample + (size_t)(row - MP) * 1024;
#pragma unroll
    for (int i = 0; i < 4; ++i) xn[i] = *(const float4*)(x + i * 256 + lane * 4);
  }
  for (int g = bid; g < MT / 8; g += nb) {
    int row = g * 8 + w;
    float4 xv[4];
    float ss = 0.f;
#pragma unroll
    for (int i = 0; i < 4; ++i) {
      xv[i] = xn[i];
      ss += xv[i].x * xv[i].x + xv[i].y * xv[i].y + xv[i].z * xv[i].z + xv[i].w * xv[i].w;
    }
    if (g + nb < MT / 8) {
      const int row2 = (g + nb) * 8 + w;
      const float* x2 = row2 < MP ? p.x_prompt + (size_t)row2 * 1024 : p.x_sample + (size_t)(row2 - MP) * 1024;
#pragma unroll
      for (int i = 0; i < 4; ++i) xn[i] = *(const float4*)(x2 + i * 256 + lane * 4);
    }
    ss = wave_sum(ss);
    float rstd = rsqrtf(ss * (1.f / 1024.f) + EPS);
    float d0 = 0, d1 = 0, d2 = 0, d3 = 0, d4 = 0, d5 = 0, d6 = 0, d7 = 0;
#pragma unroll
    for (int i = 0; i < 4; ++i) {
      float4 nw = *(const float4*)(p.norm_w + i * 256 + lane * 4);
      float4 hv;
      hv.x = xv[i].x * rstd * nw.x; hv.y = xv[i].y * rstd * nw.y; hv.z = xv[i].z * rstd * nw.z; hv.w = xv[i].w * rstd * nw.w;
      *(uint2*)(H + (size_t)row * LDK + i * 256 + lane * 4) = make_uint2(pack2(hv.x, hv.y), pack2(hv.z, hv.w));
#define GDOT(j, dj) { float4 wv = *(const float4*)(W8s + j * 1024 + i * 256 + lane * 4); dj += hv.x * wv.x + hv.y * wv.y + hv.z * wv.z + hv.w * wv.w; }
      GDOT(0, d0) GDOT(1, d1) GDOT(2, d2) GDOT(3, d3) GDOT(4, d4) GDOT(5, d5) GDOT(6, d6) GDOT(7, d7)
#undef GDOT
    }
    d0 = wave_sum(d0); d1 = wave_sum(d1); d2 = wave_sum(d2); d3 = wave_sum(d3);
    d4 = wave_sum(d4); d5 = wave_sum(d5); d6 = wave_sum(d6); d7 = wave_sum(d7);
    if (lane < 4) {
      float gb = lane == 0 ? d0 : lane == 1 ? d1 : lane == 2 ? d2 : d3;
      float ga = lane == 0 ? d4 : lane == 1 ? d5 : lane == 2 ? d6 : d7;
      BETA[row * 4 + lane] = 1.f / (1.f + expf(-gb));
      float z = ga + p.dt_bias[lane];
      float sp = z > 20.f ? z : log1pf(expf(z));
      GDEC[row * 4 + lane] = -expf(p.a_log[lane]) * sp;
    }
  }
  __syncthreads();
}

__device__ __forceinline__ int lds_byte2(int r, int c) {
  int st = (r >> 4) * 2 + (c >> 5), ob = (r & 15) * 64 + (c & 31) * 2;
  return st * 1024 + (ob ^ (((ob >> 9) & 1) << 5));
}
__device__ __forceinline__ void stage_rc2(int b, int& R, int& C) {
  int st = b >> 10, sb = b & 1023, swz = sb ^ (((sb >> 9) & 1) << 5);
  R = (st >> 1) * 16 + swz / 64;
  C = (st & 1) * 32 + (swz % 64) / 2;
}
template <int EPI, int SEC>
__device__ __forceinline__ void epi_store4(const Params& p, int row, int col4, const float (&v)[4]) {
  if (EPI == 0) {
    u16* PQ = (u16*)(p.ws + W_PQ);
    u16* GATES = (u16*)(p.ws + W_GATES);
    float* LF = (float*)(p.ws + W_LF);
    const int sec = SEC >= 0 ? SEC : (col4 >> 9);
    if (sec == 0) {
      *(uint2*)(PQ + (size_t)row * PQW + col4) = make_uint2(pack2(v[0], v[1]), pack2(v[2], v[3]));
    } else if (sec == 1) {
      const int cc = col4 - 512;
      const f32x4 l0 = *(const f32x4*)(p.lb_logits + cc), l1 = *(const f32x4*)(p.lb_logits + 512 + cc);
      f32x4 o;
#pragma unroll
      for (int i = 0; i < 4; ++i) {
        const float lbv = 1.f / (1.f + __expf(l1[i] - l0[i]));
        o[i] = __logf(lbv + (1.f - lbv) / (1.f + __expf(-v[i])));
      }
      *(f32x4*)(LF + (size_t)row * 512 + cc) = o;
    } else if (sec == 2) {
      *(uint2*)(PQ + (size_t)row * PQW + 512 + (col4 - 1024)) = make_uint2(pack2(v[0], v[1]), pack2(v[2], v[3]));
    } else if (sec == 3 || sec == 7) {
      const int cc = sec == 3 ? col4 - 1536 : 512 + col4 - 3584;
      *(uint2*)(GATES + (size_t)row * 1024 + cc) =
          make_uint2(pack2(v[0] / (1.f + __expf(-v[0])), v[1] / (1.f + __expf(-v[1]))),
                     pack2(v[2] / (1.f + __expf(-v[2])), v[3] / (1.f + __expf(-v[3]))));
    } else {
      const int cc = col4 - 2048;
      *(uint2*)(PQ + (size_t)row * PQW + 1024 + cc) = make_uint2(pack2(v[0], v[1]), pack2(v[2], v[3]));
      if (row < MP) {
        const int tt = row & 2047;
        if (tt >= 2045) *(f32x4*)(p.out + O_CVP + (size_t)((row >> 11) * 3 + (tt - 2045)) * 1536 + cc) = f32x4{v[0], v[1], v[2], v[3]};
      } else {
        *(f32x4*)(p.out + O_CVS + (size_t)((row - MP) * 3 + 2) * 1536 + cc) = f32x4{v[0], v[1], v[2], v[3]};
      }
    }
  } else {
    const float* xr = row < MP ? p.x_prompt + (size_t)row * 1024 : p.x_sample + (size_t)(row - MP) * 1024;
    float* yr = row < MP ? p.out + O_YP + (size_t)row * 1024 : p.out + O_YS + (size_t)(row - MP) * 1024;
    const f32x4 xv = *(const f32x4*)(xr + col4);
    *(f32x4*)(yr + col4) = f32x4{xv[0] + v[0], xv[1] + v[1], xv[2] + v[2], xv[3] + v[3]};
  }
}

template <int EPI, int MODE = 0>
__device__ void gemm_phase(const Params& p, const u16* __restrict__ A, const u16* __restrict__ Bt, int ntn,
                           char* smem, int bid, int nb) {
  const int tid = opaque_tid(), lane = tid & 63, wid = tid >> 6;
  const int wr = wid >> 2, wc = wid & 3, fr = lane & 15, fq = lane >> 4;
  constexpr int TILE_B = 256 * 64 * 2, STAGE_B = 2 * TILE_B;
  int sR0, sC0;
  stage_rc2(wid * 1024 + lane * 16, sR0, sC0);
  const unsigned goff = (unsigned)(sR0 * LDK + sC0);
  const unsigned lbase = (unsigned)(size_t)smem + (unsigned)(wid * 1024);
  const int aoff = (wr * 16) * 1024 + ((fr * 64 + fq * 16) ^ ((((fr * 64 + fq * 16) >> 9) & 1) << 5));
  const int boff = TILE_B + (wc * 8) * 1024 + ((fr * 64 + fq * 16) ^ ((((fr * 64 + fq * 16) >> 9) & 1) << 5));
  const int ntiles = 64 * ntn;
  auto tile_mn = [&](int tile, int& tm, int& tn) {
    const int rnd = tile >> 8, t = tile & 255, xcd = t & 7, j = t >> 3;
    if (ntn == 16) { tm = rnd * 16 + (xcd >> 1) * 4 + (j & 3); tn = ((xcd & 1) * 8 + (j >> 2) + (rnd & 1) * 2 + (rnd >> 1) * 8) & 15; }
    else { tm = xcd * 8 + (j & 7); tn = j >> 3; }
  };
  bool staged = false;
  for (int tile = bid; tile < ntiles; tile += nb) {
    int tm, tn;
    tile_mn(tile, tm, tn);
    const u16* Ab = A + (size_t)tm * 256 * LDK;
    const u16* Bb = Bt + (size_t)tn * 256 * LDK;
    f32x4 acc[8][4];
#pragma unroll
    for (int m = 0; m < 8; ++m)
#pragma unroll
      for (int n = 0; n < 4; ++n) acc[m][n] = f32x4{0.f, 0.f, 0.f, 0.f};
#define G_STAGE(buf, kt) { _Pragma("unroll") for (int i = 0; i < 4; ++i) { \
      __builtin_amdgcn_global_load_lds((const unsigned*)(Ab + (goff + (unsigned)(i * 64 * LDK + (kt) * 64))), \
          (__attribute__((address_space(3))) unsigned*)(lbase + (buf) * STAGE_B + i * 8192), 16, 0, 0); \
      __builtin_amdgcn_global_load_lds((const unsigned*)(Bb + (goff + (unsigned)(i * 64 * LDK + (kt) * 64))), \
          (__attribute__((address_space(3))) unsigned*)(lbase + (buf) * STAGE_B + TILE_B + i * 8192), 16, 0, 0); } }
#define G_PIECE_A(buf, kt, i) __builtin_amdgcn_global_load_lds((const unsigned*)(Ab + (goff + (unsigned)((i) * 64 * LDK + (kt) * 64))), \
          (__attribute__((address_space(3))) unsigned*)(lbase + (buf) * STAGE_B + (i) * 8192), 16, 0, 0)
#define G_PIECE_B(buf, kt, i) __builtin_amdgcn_global_load_lds((const unsigned*)(Bb + (goff + (unsigned)((i) * 64 * LDK + (kt) * 64))), \
          (__attribute__((address_space(3))) unsigned*)(lbase + (buf) * STAGE_B + TILE_B + (i) * 8192), 16, 0, 0)
    if (!staged) G_STAGE(0, 0);
    asm volatile("s_waitcnt vmcnt(0)" ::: "memory");
    __syncthreads();
    for (int t = 0; t < 16; ++t) {
      const int cur = t & 1;
      const bool more = (MODE != 2) && (t + 1 < 16);
      const char* sA = smem + cur * STAGE_B + aoff;
      const char* sB = smem + cur * STAGE_B + boff;
#pragma unroll
      for (int ks = 0; ks < 2; ++ks) {
        bf16x8 At[8], Bf[4];
#pragma unroll
        for (int m = 0; m < 8; ++m) At[m] = *(const bf16x8*)(sA + (m * 2 + ks) * 1024);
#pragma unroll
        for (int n = 0; n < 4; ++n) Bf[n] = *(const bf16x8*)(sB + (n * 2 + ks) * 1024);
        if (MODE != 3) {
          __builtin_amdgcn_s_setprio(1);
#pragma unroll
          for (int m = 0; m < 8; ++m) {
#pragma unroll
            for (int n = 0; n < 4; ++n) acc[m][n] = mfma16(At[m], Bf[n], acc[m][n]);
            if (ks == 0 && more) {
              if (m < 4) G_PIECE_A(cur ^ 1, t + 1, m); else G_PIECE_B(cur ^ 1, t + 1, m - 4);
              __builtin_amdgcn_sched_barrier(0);
            }
          }
          __builtin_amdgcn_s_setprio(0);
        } else {
          if (ks == 0 && more) G_STAGE(cur ^ 1, t + 1);
#pragma unroll
          for (int m = 0; m < 8; ++m) acc[m][0][0] += __builtin_bit_cast(float, (int)At[m][0]);
#pragma unroll
          for (int n = 0; n < 4; ++n) acc[0][n][1] += __builtin_bit_cast(float, (int)Bf[n][0]);
        }
        __builtin_amdgcn_sched_barrier(0);
      }
      asm volatile("s_waitcnt vmcnt(0)" ::: "memory");
      __syncthreads();
    }
    staged = false;
    if (tile + nb < ntiles) {
      int tm2, tn2;
      tile_mn(tile + nb, tm2, tn2);
      const u16* Ab2 = A + (size_t)tm2 * 256 * LDK;
      const u16* Bb2 = Bt + (size_t)tn2 * 256 * LDK;
      { const u16* Ab = Ab2; const u16* Bb = Bb2; G_STAGE(0, 0); }
      staged = true;
    }
#undef G_STAGE
#undef G_PIECE_A
#undef G_PIECE_B
    if (MODE != 0 && MODE != 5) {
      float chk = 0.f;
#pragma unroll
      for (int m = 0; m < 8; ++m)
#pragma unroll
        for (int n = 0; n < 4; ++n) chk += acc[m][n][0] + acc[m][n][1] + acc[m][n][2] + acc[m][n][3];
      if (chk == 1.2345e-30f) p.out[0] = chk;
    } else
    {
      int t2 = threadIdx.x;
      asm volatile("" : "+v"(t2));
      const int lane2 = t2 & 63, wid2 = t2 >> 6;
      const int rbase = tm * 256 + (wid2 >> 2) * 128 + (lane2 >> 4) * 4 + (lane2 & 3);
      const int cbase = tn * 256 + (wid2 & 3) * 64 + (lane2 & 12);
#define EPI_LOOP(SEC) { _Pragma("unroll") for (int m = 0; m < 8; ++m) { _Pragma("unroll") for (int n = 0; n < 4; ++n) { \
          float v[4] = {acc[m][n][0], acc[m][n][1], acc[m][n][2], acc[m][n][3]}; \
          quad_transpose(v, lane2); \
          epi_store4<EPI, SEC>(p, rbase + m * 16, cbase + n * 16, v); } } }
      if (EPI == 0) {
        const int sec = tn >> 1;
        if (sec == 1) {
          float* LF = (float*)(p.ws + W_LF);
          float lbv[4][4];
#pragma unroll
          for (int n = 0; n < 4; ++n) {
            const int cc = cbase + n * 16 - 512;
            const f32x4 l0 = *(const f32x4*)(p.lb_logits + cc), l1 = *(const f32x4*)(p.lb_logits + 512 + cc);
#pragma unroll
            for (int e = 0; e < 4; ++e) lbv[n][e] = 1.f / (1.f + __expf(l1[e] - l0[e]));
          }
#pragma unroll
          for (int m = 0; m < 8; ++m)
#pragma unroll
            for (int n = 0; n < 4; ++n) {
              float v[4] = {acc[m][n][0], acc[m][n][1], acc[m][n][2], acc[m][n][3]};
              quad_transpose(v, lane2);
              f32x4 o;
#pragma unroll
              for (int e = 0; e < 4; ++e) o[e] = __logf(lbv[n][e] + (1.f - lbv[n][e]) * __builtin_amdgcn_rcpf(1.f + __expf(-v[e])));
              *(f32x4*)(LF + (size_t)(rbase + m * 16) * 512 + (cbase + n * 16 - 512)) = o;
            }
        } else {
          const bool gate = (sec == 3 || sec == 7);
          u16* dstb; int dstride, dcol;
          const int c0 = tn * 256 + (wid2 & 3) * 64;
          if (gate) { dstb = (u16*)(p.ws + W_GATES); dstride = 1024; dcol = sec == 3 ? c0 - 1536 : 512 + c0 - 3584; }
          else { dstb = (u16*)(p.ws + W_PQ); dstride = PQW; dcol = sec == 0 ? c0 : sec == 2 ? 512 + c0 - 1024 : 1024 + c0 - 2048; }
          char* ebuf = smem + STAGE_B + wid2 * 8192;
          const int wrow = (lane2 >> 4) * 4 + (lane2 & 3), wcol = (lane2 & 12);
          const int row00 = tm * 256 + (wid2 >> 2) * 128;
#pragma unroll
          for (int hf = 0; hf < 2; ++hf) {
#pragma unroll
            for (int m = 0; m < 4; ++m)
#pragma unroll
              for (int n = 0; n < 4; ++n) {
                float v[4] = {acc[hf * 4 + m][n][0], acc[hf * 4 + m][n][1], acc[hf * 4 + m][n][2], acc[hf * 4 + m][n][3]};
                if (gate) {
#pragma unroll
                  for (int e = 0; e < 4; ++e) v[e] = v[e] / (1.f + __expf(-v[e]));
                }
                quad_transpose(v, lane2);
                const int rl = m * 16 + wrow, cl = n * 16 + wcol;
                *(u32x2*)(ebuf + rl * 128 + ((cl * 2) ^ ((rl & 7) << 4))) = u32x2{pack2(v[0], v[1]), pack2(v[2], v[3])};
                if (sec >= 4 && sec <= 6) {
                  const int row = row00 + hf * 64 + rl, cc = c0 - 2048 + cl;
                  const int tt = row & 2047;
                  if (tt >= 2045) *(f32x4*)(p.out + O_CVP + (size_t)((row >> 11) * 3 + (tt - 2045)) * 1536 + cc) = f32x4{v[0], v[1], v[2], v[3]};
                }
              }
            asm volatile("s_waitcnt lgkmcnt(0)" ::: "memory");
#pragma unroll
            for (int i = 0; i < 8; ++i) {
              const int rl = i * 8 + (lane2 >> 3), ch = lane2 & 7;
              const u32x4 d = *(const u32x4*)(ebuf + rl * 128 + ((ch ^ (rl & 7)) << 4));
              *(u32x4*)(dstb + (size_t)(row00 + hf * 64 + rl) * dstride + dcol + ch * 8) = d;
            }
            asm volatile("s_waitcnt lgkmcnt(0)" ::: "memory");
          }
        }
      } else EPI_LOOP(0)
#undef EPI_LOOP
    }
  }
  const int nunits = MODE == 0 ? ntn * 16 : 0;
  int t3 = threadIdx.x;
  asm volatile("" : "+v"(t3));
  for (int u = bid; u < nunits; u += nb) {
    const int lane = t3 & 63, wid = t3 >> 6, fr = lane & 15, fq = lane >> 4;
    const u16* ar = A + (size_t)(MP + fr) * LDK + wid * 128 + fq * 8;
    const u16* br = Bt + (size_t)(u * 16 + fr) * LDK + wid * 128 + fq * 8;
    bf16x8 bfr[4];
#pragma unroll
    for (int ks = 0; ks < 4; ++ks) bfr[ks] = *(const bf16x8*)(br + ks * 32);
    bf16x8 afr[8][4];
#pragma unroll
    for (int rt = 0; rt < 8; ++rt)
#pragma unroll
      for (int ks = 0; ks < 4; ++ks) afr[rt][ks] = *(const bf16x8*)(ar + (size_t)rt * 16 * LDK + ks * 32);
    f32x4* red = (f32x4*)smem;
#pragma unroll
    for (int rt = 0; rt < 8; ++rt) {
      f32x4 acc = {0.f, 0.f, 0.f, 0.f};
#pragma unroll
      for (int ks = 0; ks < 4; ++ks) acc = mfma16(afr[rt][ks], bfr[ks], acc);
      red[(wid * 8 + rt) * 64 + lane] = acc;
    }
    __syncthreads();
    f32x4 tot = red[(0 * 8 + wid) * 64 + lane];
#pragma unroll
    for (int sw = 1; sw < 8; ++sw) tot += red[(sw * 8 + wid) * 64 + lane];
    float v[4] = {tot[0], tot[1], tot[2], tot[3]};
    quad_transpose(v, lane);
    epi_store4<EPI, -1>(p, MP + wid * 16 + fq * 4 + (lane & 3), u * 16 + (fr & ~3), v);
    __syncthreads();
  }
  __syncthreads();
}

#define XB_TMO      128
#define XB_XCNT(j)  (256  + 64 * (j))
#define XB_XSUB(j)  (1280 + 64 * (j))
#define XB_XGEN(j)  (2304 + 64 * (j))
#define XB_TOP      3328
#define XB_TOPGEN   3392
#define XCD_BAR_WORDS 3456
#define XB_SPIN_CAP (1u << 18)
#define LAS __attribute__((address_space(3)))
__device__ __forceinline__ unsigned xb_ld(unsigned* p)              { return __hip_atomic_load(p, __ATOMIC_RELAXED, __HIP_MEMORY_SCOPE_AGENT); }
__device__ __forceinline__ unsigned xb_add(unsigned* p, unsigned v) { return __hip_atomic_fetch_add(p, v, __ATOMIC_RELAXED, __HIP_MEMORY_SCOPE_AGENT); }
__device__ __forceinline__ unsigned xb_xcc_id() { return (unsigned)__builtin_amdgcn_s_getreg((3 << 11) | 20) & 0xFu; }
#define XB_SPIN(cond, bar) do { unsigned _sp = 0; while (cond) { __builtin_amdgcn_s_sleep(1); \
    if ((++_sp & 255u) == 0u) { if (xb_ld(&(bar)[XB_TMO])) break; if (_sp > XB_SPIN_CAP) { atomicAdd(&(bar)[XB_TMO], 1u); break; } } } } while (0)
struct XcdBarrier { unsigned* bar; unsigned x; volatile LAS unsigned* st; };
__device__ __forceinline__ XcdBarrier xcd_barrier_post(unsigned* bar, volatile LAS unsigned* st) {
  XcdBarrier b; b.bar = bar; b.x = xb_xcc_id(); b.st = st;
  if (threadIdx.x == 0) (void)xb_add(&bar[XB_XCNT(b.x)], 1u);
  return b;
}
__device__ __forceinline__ void xcd_barrier_complete(unsigned* bar, unsigned x, unsigned& nloc, unsigned& nx) {
  const unsigned G = gridDim.x * gridDim.y * gridDim.z;
  unsigned sum, cnt, mine, sp = 0u;
  for (;;) {
    sum = 0u; cnt = 0u; mine = 0u;
#pragma unroll
    for (unsigned j = 0; j < 16; ++j) { const unsigned c = xb_ld(&bar[XB_XCNT(j)]); sum += c; cnt += (c > 0u) ? 1u : 0u; mine = (j == x) ? c : mine; }
    if (sum == G) break;
    __builtin_amdgcn_s_sleep(1);
    if ((++sp & 255u) == 0u) { if (xb_ld(&bar[XB_TMO])) break; if (sp > XB_SPIN_CAP) { atomicAdd(&bar[XB_TMO], 1u); break; } }
  }
  nloc = mine > 0u ? mine : 1u; nx = cnt > 0u ? cnt : 1u;
}
__device__ __forceinline__ void xcd_barrier(const XcdBarrier& b) {
  asm volatile("s_waitcnt vmcnt(0)" ::: "memory");
  __syncthreads();
  if (threadIdx.x == 0) {
    unsigned* bar = b.bar;
    __builtin_amdgcn_s_waitcnt(0);
    unsigned nloc = b.st[0], nx = b.st[1];
    if (nloc == 0u) { xcd_barrier_complete(bar, b.x, nloc, nx); b.st[0] = nloc; b.st[1] = nx; }
    const unsigned old = xb_add(&bar[XB_XSUB(b.x)], 1u);
    const unsigned gen = old / nloc;
    if (old + 1u == (gen + 1u) * nloc) {
      __builtin_amdgcn_fence(__ATOMIC_RELEASE, "agent");
      asm volatile("s_waitcnt vmcnt(0)" ::: "memory");
      const unsigned og = xb_add(&bar[XB_TOP], 1u);
      const unsigned tg = og / nx;
      if (og + 1u == (tg + 1u) * nx) xb_add(&bar[XB_TOPGEN], 1u);
      else XB_SPIN(xb_ld(&bar[XB_TOPGEN]) == tg, bar);
      __builtin_amdgcn_fence(__ATOMIC_ACQUIRE, "agent");
      xb_add(&bar[XB_XGEN(b.x)], 1u);
      asm volatile("s_waitcnt vmcnt(0)" ::: "memory");
    } else {
      XB_SPIN(xb_ld(&bar[XB_XGEN(b.x)]) == gen, bar);
      __builtin_amdgcn_fence(__ATOMIC_ACQUIRE, "agent");
      asm volatile("s_waitcnt vmcnt(0)" ::: "memory");
    }
  }
  __syncthreads();
}

#define RAW_BARRIER() do { asm volatile("s_waitcnt lgkmcnt(0)" ::: "memory"); __builtin_amdgcn_s_barrier(); asm volatile("" ::: "memory"); } while (0)
__device__ void hgrn_item(const Params& p, char* smem, int idx) {
  const int tid = opaque_tid(), lane = tid & 63, w = tid >> 6;
  const int lr = lane & 15, lq = lane >> 4;
  const int h = idx & 3, c = (idx >> 2) & 31, b = idx >> 7;
  const int r0 = b * 2048 + c * 64;
  const u16* PQ = (const u16*)(p.ws + W_PQ);
  const float* LF = (const float*)(p.ws + W_LF);
  u16* QS = (u16*)(p.ws + W_QS);
  u16* O0 = (u16*)(p.ws + W_H);
  u16* NB = (u16*)(p.out);
  float* DVEC = (float*)(p.ws + W_DVEC);
  u16* qt = (u16*)smem;
  u16* kt = qt + 64 * 136;
  u16* ktT = kt + 64 * 136;
  u16* vT = ktT + 128 * 72;
  u16* sc = vT + 128 * 72;
  float* ps = (float*)(sc + 64 * 72);
  const int col = tid & 127, part = tid >> 7;
  float lfv[16], bcum[16];
  {
    const float* lfp = LF + (size_t)(r0 + part * 16) * 512 + h * 128 + col;
#pragma unroll
    for (int i = 0; i < 16; ++i) lfv[i] = lfp[(size_t)i * 512];
    float run = 0.f;
#pragma unroll
    for (int i = 0; i < 16; ++i) { run += lfv[i]; bcum[i] = run; }
    ps[part * 128 + col] = run;
  }
  u16 qraw[16], vraw[16];
  {
    const u16* qp0 = PQ + (size_t)(r0 + part * 16) * PQW + h * 128 + col;
#pragma unroll
    for (int i = 0; i < 16; ++i) { qraw[i] = qp0[(size_t)i * PQW]; vraw[i] = qp0[(size_t)i * PQW + 512]; }
  }
  RAW_BARRIER();
  {
    float off = 0.f, blast = 0.f;
#pragma unroll
    for (int pp = 0; pp < 4; ++pp) { float t = ps[pp * 128 + col]; blast += t; if (pp < part) off += t; }
    u16* qsout = QS + ((size_t)idx * 64 + part * 16) * 128 + col;
    float kkv[16];
#pragma unroll
    for (int i = 0; i < 16; ++i) {
      const float bb = bcum[i] + off;
      const int row = part * 16 + i;
      const float q = bf2f(qraw[i]);
      qsout[i * 128] = f2bf(q * __expf(bb));
      qt[row * 136 + col] = f2bf(q * __expf(bb - blast));
      kkv[i] = (1.f - __expf(lfv[i])) * __expf(blast - bb);
      kt[row * 136 + col] = f2bf(kkv[i]);
    }
#pragma unroll
    for (int hh = 0; hh < 2; ++hh) {
      *(u32x4*)(ktT + col * 72 + part * 16 + hh * 8) =
          u32x4{pack2(kkv[hh * 8 + 0], kkv[hh * 8 + 1]), pack2(kkv[hh * 8 + 2], kkv[hh * 8 + 3]),
                pack2(kkv[hh * 8 + 4], kkv[hh * 8 + 5]), pack2(kkv[hh * 8 + 6], kkv[hh * 8 + 7])};
      *(u32x4*)(vT + col * 72 + part * 16 + hh * 8) =
          u32x4{(unsigned)vraw[hh * 8 + 0] | ((unsigned)vraw[hh * 8 + 1] << 16), (unsigned)vraw[hh * 8 + 2] | ((unsigned)vraw[hh * 8 + 3] << 16),
                (unsigned)vraw[hh * 8 + 4] | ((unsigned)vraw[hh * 8 + 5] << 16), (unsigned)vraw[hh * 8 + 6] | ((unsigned)vraw[hh * 8 + 7] << 16)};
    }
    if (part == 0) DVEC[idx * 128 + col] = __expf(blast);
  }
  RAW_BARRIER();
  {
    const int tr = w >> 1;
    bf16x8 a[4];
#pragma unroll
    for (int ks = 0; ks < 4; ++ks) a[ks] = frag(qt, tr * 16, 136, ks * 32, lane);
#pragma unroll
    for (int tci = 0; tci < 2; ++tci) {
      const int tc = (w & 1) * 2 + tci;
      f32x4 acc = {0.f, 0.f, 0.f, 0.f};
#pragma unroll
      for (int ks = 0; ks < 4; ++ks) acc = mfma16(a[ks], frag(kt, tc * 16, 136, ks * 32, lane), acc);
#pragma unroll
      for (int j = 0; j < 4; ++j) {
        const int t = tr * 16 + lq * 4 + j, s = tc * 16 + lr;
        sc[t * 72 + s] = f2bf(t >= s ? acc[j] : 0.f);
      }
    }
  }
  RAW_BARRIER();
  {
    const int tr = w >> 1;
    const bf16x8 a0 = frag(sc, tr * 16, 72, 0, lane), a1 = frag(sc, tr * 16, 72, 32, lane);
#pragma unroll
    for (int tci = 0; tci < 4; ++tci) {
      const int tc = (w & 1) * 4 + tci;
      f32x4 acc = {0.f, 0.f, 0.f, 0.f};
      acc = mfma16(a0, frag(vT, tc * 16, 72, 0, lane), acc);
      acc = mfma16(a1, frag(vT, tc * 16, 72, 32, lane), acc);
      {
        float v[4] = {acc[0], acc[1], acc[2], acc[3]};
        quad_transpose(v, lane);
        store4_bf16(O0 + ((size_t)idx * 64 + tr * 16 + lq * 4 + (lane & 3)) * 128 + tc * 16 + (lr & 12), v);
      }
    }
  }
  {
    const int tr = w;
    const bf16x8 a0 = frag(ktT, tr * 16, 72, 0, lane), a1 = frag(ktT, tr * 16, 72, 32, lane);
#pragma unroll
    for (int tc = 0; tc < 8; ++tc) {
      f32x4 acc = {0.f, 0.f, 0.f, 0.f};
      acc = mfma16(a0, frag(vT, tc * 16, 72, 0, lane), acc);
      acc = mfma16(a1, frag(vT, tc * 16, 72, 32, lane), acc);
      {
        float v[4] = {acc[0], acc[1], acc[2], acc[3]};
        quad_transpose(v, lane);
        store4_bf16(NB + ((size_t)idx * 128 + tr * 16 + lq * 4 + (lane & 3)) * 128 + tc * 16 + (lr & 12), v);
      }
    }
  }
  RAW_BARRIER();
}

constexpr int ASTR = 68;
template <int J>
struct SolveCol {
  static __device__ __forceinline__ void run(f32x4 (&x)[16], const f32x4 (&a)[16], const float* AT) {
    if constexpr (J < 63) {
      f32x4 an[16];
      if constexpr (J + 1 < 63) {
#pragma unroll
        for (int B = (J + 2) / 4; B < 16; ++B) an[B] = *(const f32x4*)(AT + (J + 1) * ASTR + B * 4);
      }
      __builtin_amdgcn_sched_barrier(0);
      const float xj = x[J / 4][J % 4];
#pragma unroll
      for (int B = (J + 1) / 4; B < 16; ++B) x[B] -= a[B] * xj;
      __builtin_amdgcn_sched_barrier(0);
      SolveCol<J + 1>::run(x, an, AT);
    }
  }
};

__device__ void gdn_item(const Params& p, char* smem, int idx) {
  const int tid = opaque_tid(), lane = tid & 63, w = tid >> 6;
  const int lr = lane & 15, lq = lane >> 4;
  const int h = idx & 3, c = (idx >> 2) & 31, b = idx >> 7;
  const int r0 = b * 2048 + c * 64;
  const u16* PQ = (const u16*)(p.ws + W_PQ);
  const float* BETA = (const float*)(p.ws + W_BETA);
  const float* GDEC = (const float*)(p.ws + W_GDEC);
  u16* QS = (u16*)(p.ws + W_QS);
  u16* O0 = (u16*)(p.ws + W_H);
  u16* NB = (u16*)(p.out);
  u16* MNEG = (u16*)(p.ws + W_MNEG);
  float* DSC = (float*)(p.ws + W_DSC);
  u16* kb = (u16*)smem;
  u16* qb = kb + 64 * 136;
  u16* vS = qb + 64 * 136;
  float* Asol = (float*)(vS + 64 * 128);
  u16* attn = (u16*)(Asol + 64 * ASTR);
  u16* khT = attn + 64 * 72;
  u16* WT = khT + 128 * 72;
  u16* U0T = WT + 128 * 72;
  float* gc = (float*)(U0T + 128 * 72);
  float* bet = gc + 64;

  if (w == 0) {
    float g = GDEC[(size_t)(r0 + lane) * 4 + h];
#pragma unroll
    for (int o = 1; o < 64; o <<= 1) { float t = __shfl_up(g, o, 64); if (lane >= o) g += t; }
    gc[lane] = g;
    bet[lane] = BETA[(size_t)(r0 + lane) * 4 + h];
  }
  for (int rep_ = 0; rep_ < ((PROBE_G & 1) ? 2 : 1); ++rep_)
  {
    const int chq = 1024 + h * 128 + 2 * lane;
    const int cwq = h * 128 + 2 * lane;
    float cw[3][4][2];
#pragma unroll
    for (int ty = 0; ty < 3; ++ty)
#pragma unroll
      for (int j = 0; j < 4; ++j) {
        float2 t2 = *(const float2*)(p.conv_w + j * 1536 + ty * 512 + cwq);
        cw[ty][j][0] = t2.x; cw[ty][j][1] = t2.y;
      }
    float win[3][3][2];
    const int t0 = w * 8;
#pragma unroll
    for (int a = 0; a < 3; ++a) {
      const int rr = t0 - 3 + a;
      const bool valid = (c > 0) || (rr >= 0);
#pragma unroll
      for (int ty = 0; ty < 3; ++ty) {
        unsigned u = 0;
        if (valid) u = *(const unsigned*)(PQ + (ptrdiff_t)(r0 + rr) * PQW + chq + ty * 512);
        win[ty][a][0] = bf2f((u16)(u & 0xffff)); win[ty][a][1] = bf2f((u16)(u >> 16));
      }
    }
#pragma unroll
    for (int tt = 0; tt < 8; ++tt) {
      const int t = t0 + tt;
      float cv[3][2];
#pragma unroll
      for (int ty = 0; ty < 3; ++ty) {
        unsigned u = *(const unsigned*)(PQ + (size_t)(r0 + t) * PQW + chq + ty * 512);
        float c0 = bf2f((u16)(u & 0xffff)), c1 = bf2f((u16)(u >> 16));
        float s0 = cw[ty][0][0] * win[ty][0][0] + cw[ty][1][0] * win[ty][1][0] + cw[ty][2][0] * win[ty][2][0] + cw[ty][3][0] * c0;
        float s1 = cw[ty][0][1] * win[ty][0][1] + cw[ty][1][1] * win[ty][1][1] + cw[ty][2][1] * win[ty][2][1] + cw[ty][3][1] * c1;
        win[ty][0][0] = win[ty][1][0]; win[ty][0][1] = win[ty][1][1];
        win[ty][1][0] = win[ty][2][0]; win[ty][1][1] = win[ty][2][1];
        win[ty][2][0] = c0; win[ty][2][1] = c1;
        cv[ty][0] = siluf_(s0); cv[ty][1] = siluf_(s1);
      }
      float ssq = wave_sum(cv[0][0] * cv[0][0] + cv[0][1] * cv[0][1]);
      float ssk = wave_sum(cv[1][0] * cv[1][0] + cv[1][1] * cv[1][1]);
      const float rq = rsqrtf(ssq + EPS) * 0.08838834764831845f;
      const float rk = rsqrtf(ssk + EPS);
      *(unsigned*)(qb + t * 136 + 2 * lane) = pack2(cv[0][0] * rq, cv[0][1] * rq);
      *(unsigned*)(kb + t * 136 + 2 * lane) = pack2(cv[1][0] * rk, cv[1][1] * rk);
      *(unsigned*)(vS + t * 128 + 2 * lane) = pack2(cv[2][0], cv[2][1]);
    }
  }
  RAW_BARRIER();
  {
    const int which = w >> 2, tr = w & 3;
    const u16* Asrc = which ? qb : kb;
    bf16x8 a[4];
#pragma unroll
    for (int ks = 0; ks < 4; ++ks) a[ks] = frag(Asrc, tr * 16, 136, ks * 32, lane);
#pragma unroll
    for (int tc = 0; tc < 4; ++tc) {
      f32x4 acc = {0.f, 0.f, 0.f, 0.f};
#pragma unroll
      for (int ks = 0; ks < 4; ++ks) acc = mfma16(a[ks], frag(kb, tc * 16, 136, ks * 32, lane), acc);
#pragma unroll
      for (int j = 0; j < 4; ++j) {
        const int t = tr * 16 + lq * 4 + j, s = tc * 16 + lr;
        const float L = __expf(fminf(gc[t] - gc[s], 0.f));
        if (which == 0) Asol[s * ASTR + t] = (t > s) ? bet[t] * acc[j] * L : 0.f;
        else attn[t * 72 + s] = f2bf((t >= s) ? acc[j] * L : 0.f);
      }
    }
  }
  RAW_BARRIER();
  for (int rep_ = 0; rep_ < ((PROBE_G & 2) ? 2 : 1); ++rep_) {
  if (tid < 256) {
    f32x4 x[16];
    if (tid < 128) {
#pragma unroll
      for (int s = 0; s < 64; ++s) { x[s >> 2][s & 3] = bf2f(vS[s * 128 + tid]) * bet[s]; if ((s & 7) == 7) __builtin_amdgcn_sched_barrier(0); }
    } else {
#pragma unroll
      for (int s = 0; s < 64; ++s) { x[s >> 2][s & 3] = bf2f(kb[s * 136 + tid - 128]) * bet[s] * __expf(gc[s]); if ((s & 7) == 7) __builtin_amdgcn_sched_barrier(0); }
    }
    {
      f32x4 a0[16];
#pragma unroll
      for (int B = 0; B < 16; ++B) a0[B] = *(const f32x4*)(Asol + B * 4);
      SolveCol<0>::run(x, a0, Asol);
    }
    u16* dst = (tid < 128) ? (U0T + tid * 72) : (WT + (tid - 128) * 72);
#pragma unroll
    for (int s8 = 0; s8 < 8; ++s8) {
      *(u32x4*)(dst + s8 * 8) = u32x4{pack2(x[2 * s8][0], x[2 * s8][1]), pack2(x[2 * s8][2], x[2 * s8][3]),
                                      pack2(x[2 * s8 + 1][0], x[2 * s8 + 1][1]), pack2(x[2 * s8 + 1][2], x[2 * s8 + 1][3])};
    }
  } else {
    const float glast = gc[63];
    const int e0 = tid - 256;
#pragma unroll 4
    for (int i = 0; i < 32; ++i) {
      const int e = e0 + 256 * i;
      const int s = e & 63, kd = e >> 6;
      khT[kd * 72 + s] = f2bf(bf2f(kb[s * 136 + kd]) * __expf(glast - gc[s]));
    }
  }
  RAW_BARRIER();
  }
  for (int rep_ = 0; rep_ < ((PROBE_G & 4) ? 2 : 1); ++rep_) {
  {
    const int tr = w & 3, half = w >> 2;
    const u16* Bsrc = half ? U0T : WT;
    const bf16x8 a0 = frag(attn, tr * 16, 72, 0, lane), a1 = frag(attn, tr * 16, 72, 32, lane);
#pragma unroll 2
    for (int tc = 0; tc < 8; ++tc) {
      f32x4 acc = {0.f, 0.f, 0.f, 0.f};
      acc = mfma16(a0, frag(Bsrc, tc * 16, 72, 0, lane), acc);
      acc = mfma16(a1, frag(Bsrc, tc * 16, 72, 32, lane), acc);
      {
        float v[4];
#pragma unroll
        for (int j = 0; j < 4; ++j) {
          const int t = tr * 16 + lq * 4 + j, n = tc * 16 + lr;
          v[j] = half == 0 ? bf2f(qb[t * 136 + n]) * __expf(gc[t]) - acc[j] : acc[j];
        }
        quad_transpose(v, lane);
        const size_t o = ((size_t)(1024 + idx) * 64 + tr * 16 + lq * 4 + (lane & 3)) * 128 + tc * 16 + (lr & 12);
        store4_bf16((half == 0 ? QS : O0) + o, v);
      }
    }
  }
  {
    const int tr = w;
    const bf16x8 a0 = frag(khT, tr * 16, 72, 0, lane), a1 = frag(khT, tr * 16, 72, 32, lane);
#pragma unroll 2
    for (int tc = 0; tc < 16; ++tc) {
      const u16* Bsrc = tc < 8 ? WT : U0T;
      const int tcc = tc & 7;
      f32x4 acc = {0.f, 0.f, 0.f, 0.f};
      acc = mfma16(a0, frag(Bsrc, tcc * 16, 72, 0, lane), acc);
      acc = mfma16(a1, frag(Bsrc, tcc * 16, 72, 32, lane), acc);
      {
        float v[4];
#pragma unroll
        for (int j = 0; j < 4; ++j) v[j] = tc < 8 ? -acc[j] : acc[j];
        quad_transpose(v, lane);
        const size_t o = (size_t)(tr * 16 + lq * 4 + (lane & 3)) * 128 + tcc * 16 + (lr & 12);
        store4_bf16((tc < 8 ? MNEG + (size_t)idx * 16384 : NB + (size_t)(1024 + idx) * 16384) + o, v);
      }
    }
  }
  }
  if (tid < 128) ((float*)(p.ws + W_DVEC))[(size_t)(1024 + idx) * 128 + tid] = __expf(gc[63]);
  RAW_BARRIER();
}

__device__ void phase2(const Params& p, char* smem, int bid, int nb) {
  for (int it = bid; it < 2048; it += nb) {
    if (it >= 1024) { gdn_item(p, smem, it - 1024); if (DUP_MASK & 2048) gdn_item(p, smem, it - 1024); }
    else { hgrn_item(p, smem, it); if (DUP_MASK & 1024) hgrn_item(p, smem, it); }
  }
}

struct ScanRegs {
  bf16x8 Aq[4];
  bf16x8 Am[4];
  u32x2 o0, nn0, nn1;
  f32x4 dd;
};

template <int TYPE>
__device__ __forceinline__ void scan_load(ScanRegs& r, const Params& p, int idx, unsigned qoff, unsigned ooff, unsigned moff,
                                          unsigned noff, unsigned doff) {
  const int ii = __builtin_amdgcn_readfirstlane(idx);
  const int ti = TYPE * 1024 + ii;
  const u16* QSb = (const u16*)(p.ws + W_QS) + (size_t)ti * 8192;
  const u16* O0b = (const u16*)(p.ws + W_H) + (size_t)ti * 8192;
  const u16* NBb = (const u16*)(p.out) + (size_t)ti * 16384;
#pragma unroll
  for (int ks = 0; ks < 4; ++ks) r.Aq[ks] = *(const bf16x8*)(QSb + (qoff + ks * 32));
  r.o0 = *(const u32x2*)(O0b + ooff);
  r.nn0 = *(const u32x2*)(NBb + noff);
  r.nn1 = *(const u32x2*)(NBb + (noff + 16));
  if (TYPE == 1) {
    const u16* Mb = (const u16*)(p.ws + W_MNEG) + (size_t)ii * 16384;
#pragma unroll
    for (int ks = 0; ks < 4; ++ks) r.Am[ks] = *(const bf16x8*)(Mb + (moff + ks * 32));
  }
  r.dd = *(const f32x4*)((const float*)(p.ws + W_DVEC) + (size_t)ti * 128 + doff);
}
__device__ __forceinline__ void unpack4(u32x2 u, float (&v)[4]) {
  v[0] = bf2f((u16)(u[0] & 0xffff)); v[1] = bf2f((u16)(u[0] >> 16));
  v[2] = bf2f((u16)(u[1] & 0xffff)); v[3] = bf2f((u16)(u[1] >> 16));
}

template <int TYPE>
__device__ void scan_unit(const Params& p, char* smem, int rem) {
  const int tid = opaque_tid(), lane = tid & 63, w = tid >> 6;
  const int lr = lane & 15, lq = lane >> 4;
  const int b = rem >> 4, h = (rem >> 2) & 3, vs2 = rem & 3;
  const int tr = lq * 4 + (lane & 3), tc4 = lr & 12;
  const int otr = w & 3, otc = w >> 2;
  float* OPRE = (float*)(p.ws + W_PQ);
  u16* SbT = (u16*)smem;
  for (int i = tid; i < 2 * 32 * 136; i += 512) SbT[i] = 0;
  f32x4 S0 = {0.f, 0.f, 0.f, 0.f}, S1 = {0.f, 0.f, 0.f, 0.f};
  const unsigned qoff = (unsigned)((otr * 16 + lr) * 128 + lq * 8);
  const unsigned ooff = (unsigned)((otr * 16 + tr) * 128 + vs2 * 32 + otc * 16 + tc4);
  const unsigned moff = (unsigned)((w * 16 + lr) * 128 + lq * 8);
  const unsigned noff = (unsigned)((w * 16 + tr) * 128 + vs2 * 32 + tc4);
  const unsigned doff = (unsigned)(w * 16 + lq * 4);
  float* const orow = OPRE + (size_t)(b * 2048 + otr * 16 + tr) * 1024 + TYPE * 512 + h * 128 + vs2 * 32 + otc * 16 + tc4;
  ScanRegs r0, r1, r2, r3;
  const int idx0 = (b * 32) * 4 + h;
  scan_load<TYPE>(r0, p, idx0 + 0, qoff, ooff, moff, noff, doff);
  scan_load<TYPE>(r1, p, idx0 + 4, qoff, ooff, moff, noff, doff);
  scan_load<TYPE>(r2, p, idx0 + 8, qoff, ooff, moff, noff, doff);
  scan_load<TYPE>(r3, p, idx0 + 12, qoff, ooff, moff, noff, doff);
  __builtin_amdgcn_sched_barrier(0);
#define SCAN_STEP(R, c) { \
    RAW_BARRIER(); \
    const u16* Sb = SbT + ((c) & 1) * 32 * 136 + lr * 136 + lq * 8; \
    bf16x8 B0[4], B1[4], Bo[4]; \
    _Pragma("unroll") for (int ks = 0; ks < 4; ++ks) { \
      B0[ks] = *(const bf16x8*)(Sb + ks * 32); \
      B1[ks] = *(const bf16x8*)(Sb + 16 * 136 + ks * 32); \
      Bo[ks] = *(const bf16x8*)(Sb + otc * 16 * 136 + ks * 32); } \
    { \
      float ov[4]; unpack4(R.o0, ov); quad_transpose(ov, lane); \
      f32x4 acc = {ov[0], ov[1], ov[2], ov[3]}; \
      _Pragma("unroll") for (int ks = 0; ks < 4; ++ks) acc = mfma16(R.Aq[ks], Bo[ks], acc); \
      float o[4] = {acc[0], acc[1], acc[2], acc[3]}; \
      quad_transpose(o, lane); \
      *(f32x4*)(orow + (size_t)(c) * 65536) = f32x4{o[0], o[1], o[2], o[3]}; \
    } \
    float n0[4], n1[4]; unpack4(R.nn0, n0); unpack4(R.nn1, n1); \
    quad_transpose(n0, lane); quad_transpose(n1, lane); \
    f32x4 T0, T1; \
    _Pragma("unroll") for (int j = 0; j < 4; ++j) { T0[j] = R.dd[j] * S0[j] + n0[j]; T1[j] = R.dd[j] * S1[j] + n1[j]; } \
    if (TYPE == 1) { _Pragma("unroll") for (int ks = 0; ks < 4; ++ks) { T0 = mfma16(R.Am[ks], B0[ks], T0); T1 = mfma16(R.Am[ks], B1[ks], T1); } } \
    S0 = T0; S1 = T1; \
    u16* Sw = SbT + (((c) + 1) & 1) * 32 * 136 + lr * 136 + w * 16 + lq * 4; \
    *(u32x2*)(Sw) = u32x2{pack2(S0[0], S0[1]), pack2(S0[2], S0[3])}; \
    *(u32x2*)(Sw + 16 * 136) = u32x2{pack2(S1[0], S1[1]), pack2(S1[2], S1[3])}; \
    __builtin_amdgcn_sched_barrier(0); \
    scan_load<TYPE>(R, p, idx0 + (((c) + 4 < 32) ? (c) + 4 : 31) * 4, qoff, ooff, moff, noff, doff); \
    __builtin_amdgcn_sched_barrier(0); \
  }
  for (int c0 = 0; c0 < 32; c0 += 4) {
    SCAN_STEP(r0, c0)
    SCAN_STEP(r1, c0 + 1)
    SCAN_STEP(r2, c0 + 2)
    SCAN_STEP(r3, c0 + 3)
  }
#undef SCAN_STEP
  float* so = p.out + (TYPE ? O_GDP : O_HGP) + (size_t)(b * 4 + h) * 16384 + (w * 16 + tr) * 128 + vs2 * 32 + tc4;
  {
    float sv[4] = {S0[0], S0[1], S0[2], S0[3]};
    quad_transpose(sv, lane);
    *(f32x4*)(so) = f32x4{sv[0], sv[1], sv[2], sv[3]};
    float sw[4] = {S1[0], S1[1], S1[2], S1[3]};
    quad_transpose(sw, lane);
    *(f32x4*)(so + 16) = f32x4{sw[0], sw[1], sw[2], sw[3]};
  }
  __syncthreads();
}

__device__ void sample_item(const Params& p, char* smem, int it) {
  const int tid = opaque_tid(), lane = tid & 63, w = tid >> 6;
  const int type = it >> 9, b = (it >> 2) & 127, h = it & 3;
  const int row = MP + b;
  const u16* PQ = (const u16*)(p.ws + W_PQ);
  const float* LF = (const float*)(p.ws + W_LF);
  const float* BETA = (const float*)(p.ws + W_BETA);
  const float* GDEC = (const float*)(p.ws + W_GDEC);
  float* OPRE = (float*)(p.ws + W_PQ);
  float* fq = (float*)smem;
  float* fk = fq + 128;
  float* fv = fk + 128;
  float* fe = fv + 128;
  float* red = fe + 128;
  float* sc = red + 1024;
  const int n = tid & 127, kp = tid >> 7;
  if (type == 0) {
    if (tid < 128) {
      const float lf = LF[(size_t)row * 512 + h * 128 + tid];
      const float f = __expf(lf);
      fe[tid] = f;
      fk[tid] = 1.f - f;
      fq[tid] = bf2f(PQ[(size_t)row * PQW + h * 128 + tid]);
      fv[tid] = bf2f(PQ[(size_t)row * PQW + 512 + h * 128 + tid]);
    }
    __syncthreads();
    const float* S = p.state_hgrn + ((size_t)(b * 4 + h) * 128) * 128;
    float* So = p.out + O_HGS + ((size_t)(b * 4 + h) * 128) * 128;
    const float vn = fv[n];
    float o = 0.f;
#pragma unroll
    for (int i = 0; i < 32; ++i) {
      const int k = kp * 32 + i;
      const float sn = fe[k] * S[k * 128 + n] + fk[k] * vn;
      So[k * 128 + n] = sn;
      o += fq[k] * sn;
    }
    red[kp * 128 + n] = o;
    __syncthreads();
    if (tid < 128) OPRE[(size_t)row * 1024 + h * 128 + tid] = red[tid] + red[128 + tid] + red[256 + tid] + red[384 + tid];
    __syncthreads();
  } else {
    const float* cprev = p.state_conv + (size_t)b * 3 * 1536;
    if (tid < 384) {
      const int ty = tid >> 7, cc = tid & 127;
      const int ch = ty * 512 + h * 128 + cc;
      const float p0 = cprev[ch], p1 = cprev[1536 + ch], p2 = cprev[3072 + ch];
      const float nw = bf2f(PQ[(size_t)row * PQW + 1024 + ch]);
      const float s = p.conv_w[ch] * p0 + p.conv_w[1536 + ch] * p1 + p.conv_w[3072 + ch] * p2 + p.conv_w[4608 + ch] * nw;
      fq[ty * 128 + cc] = siluf_(s);
      p.out[O_CVS + (size_t)(b * 3 + 0) * 1536 + ch] = p1;
      p.out[O_CVS + (size_t)(b * 3 + 1) * 1536 + ch] = p2;
    }
    __syncthreads();
    if (w < 2) {
      const float a0 = fq[w * 128 + lane], a1 = fq[w * 128 + 64 + lane];
      const float ss = wave_sum(a0 * a0 + a1 * a1);
      if (lane == 0) sc[w] = ss;
    }
    __syncthreads();
    const float rq = rsqrtf(sc[0] + EPS) * 0.08838834764831845f;
    const float rk = rsqrtf(sc[1] + EPS);
    __syncthreads();
    if (tid < 128) fq[tid] *= rq;
    else if (tid < 256) fk[tid - 128] *= rk;
    __syncthreads();
    if (w == 0) {
      const float qk = wave_sum(fq[lane] * fk[lane] + fq[64 + lane] * fk[64 + lane]);
      if (lane == 0) sc[2] = qk;
    }
    const float eg = __expf(GDEC[(size_t)row * 4 + h]);
    const float beta = BETA[(size_t)row * 4 + h];
    const float* S = p.state_gdn + ((size_t)(b * 4 + h) * 128) * 128;
    float* So = p.out + O_GDS + ((size_t)(b * 4 + h) * 128) * 128;
    float sd[32];
    float ks_ = 0.f, qs_ = 0.f;
#pragma unroll
    for (int i = 0; i < 32; ++i) {
      const int k = kp * 32 + i;
      sd[i] = eg * S[k * 128 + n];
      ks_ += fk[k] * sd[i];
      qs_ += fq[k] * sd[i];
    }
    red[kp * 128 + n] = ks_;
    red[512 + kp * 128 + n] = qs_;
    __syncthreads();
    const float kS = red[n] + red[128 + n] + red[256 + n] + red[384 + n];
    const float delta = (fv[n] - kS) * beta;
#pragma unroll
    for (int i = 0; i < 32; ++i) {
      const int k = kp * 32 + i;
      So[k * 128 + n] = sd[i] + fk[k] * delta;
    }
    if (tid < 128) {
      const float qS = red[512 + n] + red[640 + n] + red[768 + n] + red[896 + n];
      OPRE[(size_t)row * 1024 + 512 + h * 128 + n] = qS + sc[2] * delta;
    }
    __syncthreads();
  }
}

__device__ void sample_block4(const Params& p, char* smem, int bid) {
  const int tid = opaque_tid(), lane = tid & 63, w = tid >> 6;
  const u16* PQ = (const u16*)(p.ws + W_PQ);
  const float* LF = (const float*)(p.ws + W_LF);
  const float* BETA = (const float*)(p.ws + W_BETA);
  const float* GDEC = (const float*)(p.ws + W_GDEC);
  float* OPRE = (float*)(p.ws + W_PQ);
  float* vec = (float*)smem;
  float* red = vec + 2048;
  float* sc = red + 1024;
  if (tid < 256) {
    const int j = tid >> 7, c = tid & 127;
    const int it = bid + 256 * j, b = (it >> 2) & 127, h = it & 3, row = MP + b;
    const float f = __expf(LF[(size_t)row * 512 + h * 128 + c]);
    vec[(j * 4 + 0) * 128 + c] = bf2f(PQ[(size_t)row * PQW + h * 128 + c]);
    vec[(j * 4 + 1) * 128 + c] = 1.f - f;
    vec[(j * 4 + 2) * 128 + c] = bf2f(PQ[(size_t)row * PQW + 512 + h * 128 + c]);
    vec[(j * 4 + 3) * 128 + c] = f;
  }
  for (int e = tid; e < 768; e += 512) {
    const int j = 2 + e / 384, r = e % 384, ty = r >> 7, cc = r & 127;
    const int it = bid + 256 * j, b = (it >> 2) & 127, h = it & 3, row = MP + b;
    const int ch = ty * 512 + h * 128 + cc;
    const float* cprev = p.state_conv + (size_t)b * 3 * 1536;
    const float p0 = cprev[ch], p1 = cprev[1536 + ch], p2 = cprev[3072 + ch];
    const float nw = bf2f(PQ[(size_t)row * PQW + 1024 + ch]);
    const float s = p.conv_w[ch] * p0 + p.conv_w[1536 + ch] * p1 + p.conv_w[3072 + ch] * p2 + p.conv_w[4608 + ch] * nw;
    vec[(j * 4 + ty) * 128 + cc] = siluf_(s);
    p.out[O_CVS + (size_t)(b * 3 + 0) * 1536 + ch] = p1;
    p.out[O_CVS + (size_t)(b * 3 + 1) * 1536 + ch] = p2;
  }
  __syncthreads();
  if (w < 4) {
    const int j = 2 + (w >> 1), which = w & 1;
    const float a0 = vec[(j * 4 + which) * 128 + lane], a1 = vec[(j * 4 + which) * 128 + 64 + lane];
    const float ss = wave_sum(a0 * a0 + a1 * a1);
    if (lane == 0) sc[j * 4 + which] = ss;
  }
  __syncthreads();
  {
    const int j = 2 + (tid >> 8), which = (tid >> 7) & 1, c = tid & 127;
    const float r = which == 0 ? rsqrtf(sc[j * 4 + 0] + EPS) * 0.08838834764831845f : rsqrtf(sc[j * 4 + 1] + EPS);
    vec[(j * 4 + which) * 128 + c] *= r;
  }
  __syncthreads();
  if (w < 2) {
    const int j = 2 + w;
    const float qk = wave_sum(vec[(j * 4 + 0) * 128 + lane] * vec[(j * 4 + 1) * 128 + lane] +
                              vec[(j * 4 + 0) * 128 + 64 + lane] * vec[(j * 4 + 1) * 128 + 64 + lane]);
    if (lane == 0) sc[j * 4 + 2] = qk;
  }
  __syncthreads();
  const int n = tid & 127, kp = tid >> 7;
  float cur[32], nxt[32];
  {
    const int it = bid, b = (it >> 2) & 127, h = it & 3;
    const float* S = p.state_hgrn + ((size_t)(b * 4 + h) * 128) * 128;
#pragma unroll
    for (int i = 0; i < 32; ++i) cur[i] = S[(kp * 32 + i) * 128 + n];
  }
#pragma unroll
  for (int j = 0; j < 4; ++j) {
    const int it = bid + 256 * j, b = (it >> 2) & 127, h = it & 3, row = MP + b;
    if (j < 3) {
      const int it2 = bid + 256 * (j + 1), b2 = (it2 >> 2) & 127, h2 = it2 & 3;
      const float* S2 = ((j + 1) < 2 ? p.state_hgrn : p.state_gdn) + ((size_t)(b2 * 4 + h2) * 128) * 128;
#pragma unroll
      for (int i = 0; i < 32; ++i) nxt[i] = S2[(kp * 32 + i) * 128 + n];
    }
    const float* fq = vec + (j * 4 + 0) * 128;
    const float* fk = vec + (j * 4 + 1) * 128;
    const float* fv = vec + (j * 4 + 2) * 128;
    const float* fe = vec + (j * 4 + 3) * 128;
    if (j < 2) {
      float* So = p.out + O_HGS + ((size_t)(b * 4 + h) * 128) * 128;
      const float vn = fv[n];
      float o = 0.f;
#pragma unroll
      for (int i = 0; i < 32; ++i) {
        const int k = kp * 32 + i;
        const float sn = fe[k] * cur[i] + fk[k] * vn;
        So[k * 128 + n] = sn;
        o += fq[k] * sn;
      }
      red[kp * 128 + n] = o;
      __syncthreads();
      if (tid < 128) OPRE[(size_t)row * 1024 + h * 128 + tid] = red[tid] + red[128 + tid] + red[256 + tid] + red[384 + tid];
      __syncthreads();
    } else {
      float* So = p.out + O_GDS + ((size_t)(b * 4 + h) * 128) * 128;
      const float eg = __expf(GDEC[(size_t)row * 4 + h]);
      const float beta = BETA[(size_t)row * 4 + h];
      float ks_ = 0.f, qs_ = 0.f;
#pragma unroll
      for (int i = 0; i < 32; ++i) {
        const int k = kp * 32 + i;
        cur[i] *= eg;
        ks_ += fk[k] * cur[i];
        qs_ += fq[k] * cur[i];
      }
      red[kp * 128 + n] = ks_;
      red[512 + kp * 128 + n] = qs_;
      __syncthreads();
      const float kS = red[n] + red[128 + n] + red[256 + n] + red[384 + n];
      const float delta = (fv[n] - kS) * beta;
#pragma unroll
      for (int i = 0; i < 32; ++i) {
        const int k = kp * 32 + i;
        So[k * 128 + n] = cur[i] + fk[k] * delta;
      }
      if (tid < 128) {
        const float qS = red[512 + n] + red[640 + n] + red[768 + n] + red[896 + n];
        OPRE[(size_t)row * 1024 + 512 + h * 128 + n] = qS + sc[j * 4 + 2] * delta;
      }
      __syncthreads();
    }
#pragma unroll
    for (int i = 0; i < 32; ++i) cur[i] = nxt[i];
  }
}

#define XB_TICKET(j) (3456 + 16 * (j))
__device__ void phase3(const Params& p, char* smem, int bid, int nb) {
  volatile LAS unsigned* st = (volatile LAS unsigned*)(unsigned)(size_t)(smem + LDS_BYTES - 16);
  unsigned* bar = (unsigned*)(p.ws + W_BAR);
  if (threadIdx.x == 0) {
    unsigned ok = (nb == 256) ? 1u : 0u, rank = 0u;
    const unsigned x = xb_xcc_id();
    unsigned npop = 0u;
    for (unsigned j = 0; j < 16; ++j) {
      const unsigned c = xb_ld(&bar[XB_XCNT(j)]);
      if (c != 0u) { ++npop; if (c != 32u) ok = 0u; if (j < x) ++rank; }
    }
    if (npop != 8u) ok = 0u;
    unsigned ticket = 0u;
    if (ok) ticket = xb_add(&bar[XB_TICKET(x)], 1u);
    st[2] = ok ? (0x100u | (rank << 5) | (ticket & 31u)) : 0u;
  }
  __syncthreads();
  const unsigned place = st[2];
  __syncthreads();
  if (place) {
    const int r = (place >> 5) & 7, t = place & 31;
    const int g = (t >> 2) * 8 + r;
    const int uu = (g << 2) | (t & 3);
    if (uu < 128) scan_unit<0>(p, smem, uu); else scan_unit<1>(p, smem, uu - 128);
    if (DUP_MASK & 256) { if (uu < 128) scan_unit<0>(p, smem, uu); else scan_unit<1>(p, smem, uu - 128); }
    if (uu < 128) {
      const int rankH = r * 16 + t;
      sample_block4(p, smem, rankH);
      sample_block4(p, smem, rankH + 128);
    }
    return;
  }
  for (int u = bid; u < 256; u += nb) {
    int uu = u;
    if (nb == 256) {
      const int xcd = u & 7, j = u >> 3;
      uu = ((xcd * 8 + (j >> 2)) << 2) | (j & 3);
    }
    if (uu < 128) scan_unit<0>(p, smem, uu); else scan_unit<1>(p, smem, uu - 128);
  }
  if (nb == 256) {
    if ((bid & 7) < 4) {
      const int rank = (bid >> 3) * 4 + (bid & 3);
      sample_block4(p, smem, rank);
      sample_block4(p, smem, rank + 128);
    }
  } else {
    for (int it = bid; it < 1024; it += nb) sample_item(p, smem, it);
  }
}

__device__ void phase4(const Params& p, int bid, int nb) {
  const int tid = opaque_tid(), lane = tid & 63, w = tid >> 6;
  const float* OPRE = (const float*)(p.ws + W_PQ);
  const u16* GATES = (const u16*)(p.ws + W_GATES);
  u16* A2 = (u16*)(p.ws + W_QS);
  constexpr int NG = MT / 8;
  for (int g = bid; g < NG; g += 2 * nb) {
    const bool two = (g + nb) < NG;
    const int rows[2] = {g * 8 + w, (two ? g + nb : g) * 8 + w};
    f32x4 v[2][4];
    u32x2 gt[2][4];
#pragma unroll
    for (int r = 0; r < 2; ++r)
#pragma unroll
      for (int i = 0; i < 4; ++i) {
        const int col = i * 256 + lane * 4;
        v[r][i] = *(const f32x4*)(OPRE + (size_t)rows[r] * 1024 + col);
        gt[r][i] = *(const u32x2*)(GATES + (size_t)rows[r] * 1024 + col);
      }
#pragma unroll
    for (int r = 0; r < 2; ++r) {
      if (r == 1 && !two) break;
#pragma unroll
      for (int i = 0; i < 4; ++i) {
        const int col = i * 256 + lane * 4;
        float ss = v[r][i][0] * v[r][i][0] + v[r][i][1] * v[r][i][1] + v[r][i][2] * v[r][i][2] + v[r][i][3] * v[r][i][3];
        ss += dpp_mov<0xB1, 0xf>(ss);
        ss += dpp_mov<0x4E, 0xf>(ss);
        ss += dpp_mov<0x141, 0xf>(ss);
        ss += dpp_mov<0x140, 0xf>(ss);
        ss += __shfl_xor(ss, 16, 64);
        const float rstd = rsqrtf(ss * (1.f / 128.f) + EPS);
        const f32x4 nw = *(const f32x4*)((col < 512 ? p.hg_norm : p.gdn_norm) + (col & 127));
        float gg[4];
        unpack4(gt[r][i], gg);
        *(u32x2*)(A2 + (size_t)rows[r] * LDK + col) =
            u32x2{pack2(v[r][i][0] * rstd * nw[0] * gg[0], v[r][i][1] * rstd * nw[1] * gg[1]),
                  pack2(v[r][i][2] * rstd * nw[2] * gg[2], v[r][i][3] * rstd * nw[3] * gg[3])};
      }
    }
  }
}

__device__ void phase6(const Params& p, int bid, int nb) {
  const int tid = opaque_tid(), lane = tid & 63, w = tid >> 6;
  constexpr int NG = MT / 8, NR = 4;
  for (int g = bid; g < NG; g += NR * nb) {
    float* y[NR];
    bool ok[NR];
    float4 xv[NR][4];
    float ss[NR];
#pragma unroll
    for (int r = 0; r < NR; ++r) {
      ok[r] = (g + r * nb) < NG;
      const int row = (ok[r] ? g + r * nb : g) * 8 + w;
      y[r] = row < MP ? p.out + O_YP + (size_t)row * 1024 : p.out + O_YS + (size_t)(row - MP) * 1024;
#pragma unroll
      for (int i = 0; i < 4; ++i) xv[r][i] = *(const float4*)(y[r] + i * 256 + lane * 4);
    }
#pragma unroll
    for (int r = 0; r < NR; ++r) {
      ss[r] = 0.f;
#pragma unroll
      for (int i = 0; i < 4; ++i) ss[r] += xv[r][i].x * xv[r][i].x + xv[r][i].y * xv[r][i].y + xv[r][i].z * xv[r][i].z + xv[r][i].w * xv[r][i].w;
      ss[r] = wave_sum(ss[r]);
    }
#pragma unroll
    for (int r = 0; r < NR; ++r) {
      if (ok[r]) {
        const float rstd = rsqrtf(ss[r] * (1.f / 1024.f) + EPS);
#pragma unroll
        for (int i = 0; i < 4; ++i) {
          const float4 nw = *(const float4*)(p.final_norm + i * 256 + lane * 4);
          float4 o;
          o.x = xv[r][i].x * rstd * nw.x; o.y = xv[r][i].y * rstd * nw.y; o.z = xv[r][i].z * rstd * nw.z; o.w = xv[r][i].w * rstd * nw.w;
          *(float4*)(y[r] + i * 256 + lane * 4) = o;
        }
      }
    }
  }
}


template <int PH>
__device__ __forceinline__ void run_phase(const Params& p, char* smem, int bid, int nb) {
  if (PH == 0) phase0(p, smem, bid, nb);
  else if (PH == 1) gemm_phase<0>(p, (const u16*)(p.ws + W_H), (const u16*)(p.ws + W_WINT), 16, smem, bid, nb);
  else if (PH == 2) phase2(p, smem, bid, nb);
  else if (PH == 3) phase3(p, smem, bid, nb);
  else if (PH == 4) phase4(p, bid, nb);
  else if (PH == 5) gemm_phase<1>(p, (const u16*)(p.ws + W_QS), (const u16*)(p.ws + W_WOUTT), 4, smem, bid, nb);
  else phase6(p, bid, nb);
}

#if MEGA
__global__ void __launch_bounds__(NTH) mega_kernel(Params p) {
  extern __shared__ __attribute__((aligned(16))) char smem[];
  cg::grid_group grid = cg::this_grid();
  const int bid = blockIdx.x, nb = gridDim.x;
  if (p.out == nullptr) grid.sync();
  volatile LAS unsigned* st = (volatile LAS unsigned*)(unsigned)(size_t)(smem + LDS_BYTES - 16);
  if (threadIdx.x == 0) { st[0] = 0u; st[1] = 0u; }
  __syncthreads();
  const XcdBarrier xb = xcd_barrier_post((unsigned*)(p.ws + W_BAR), st);
#define GSYNC() xcd_barrier(xb)
#define RUNP(k) run_phase<k>(p, smem, bid, nb); GSYNC(); if (DUP_MASK & (1 << k)) { run_phase<k>(p, smem, bid, nb); GSYNC(); }
  RUNP(0)
  if (PROBE_SYNC) { for (int i_ = 0; i_ < PROBE_SYNC; ++i_) GSYNC(); }
  RUNP(1)
  if (PROBE_GEMM) { gemm_phase<0, PROBE_GEMM>(p, (const u16*)(p.ws + W_H), (const u16*)(p.ws + W_WINT), 16, smem, bid, nb); GSYNC(); }
  RUNP(2) RUNP(3) RUNP(4) RUNP(5)
#undef RUNP
#undef GSYNC
  run_phase<6>(p, smem, bid, nb);
}
#else
template <int PH>
__global__ void __launch_bounds__(NTH) phase_kernel(Params p) {
  extern __shared__ __attribute__((aligned(16))) char smem[];
  run_phase<PH>(p, smem, blockIdx.x, gridDim.x);
}
template <int PH>
static void launch_phase(const Params& p, int grid, hipStream_t stream) {
  hipFuncSetAttribute((const void*)phase_kernel<PH>, hipFuncAttributeMaxDynamicSharedMemorySize, (int)LDS_BYTES);
  hipLaunchKernelGGL(phase_kernel<PH>, dim3(grid), dim3(NTH), LDS_BYTES, stream, p);
}
#endif

extern "C" void kernel_launch(void* const* d_in, const int* in_sizes, int n_in, void* d_out, int out_size,
                              void* d_ws, size_t ws_size, hipStream_t stream) {
  Params p{};
  p.x_prompt = (const float*)d_in[0];
  p.x_sample = (const float*)d_in[1];
  p.state_hgrn = (const float*)d_in[2];
  p.state_gdn = (const float*)d_in[3];
  p.state_conv = (const float*)d_in[4];
  p.norm_w = (const float*)d_in[5];
  p.w_in = (const float*)d_in[6];
  p.lb_logits = (const float*)d_in[7];
  p.conv_w = (const float*)d_in[8];
  p.a_log = (const float*)d_in[9];
  p.dt_bias = (const float*)d_in[10];
  p.hg_norm = (const float*)d_in[11];
  p.gdn_norm = (const float*)d_in[12];
  p.w_out = (const float*)d_in[13];
  p.final_norm = (const float*)d_in[14];
  p.out = (float*)d_out;
  p.ws = (char*)d_ws;
  if (ws_size < W_END) { fprintf(stderr, "workspace too small: %zu < %zu\n", ws_size, (size_t)W_END); return; }
#if MEGA
  static int grid_blocks = 0;
  if (!grid_blocks) {
    int dev = 0, cus = 0, per_cu = 0;
    hipGetDevice(&dev);
    hipDeviceGetAttribute(&cus, hipDeviceAttributeMultiprocessorCount, dev);
    hipFuncSetAttribute((const void*)mega_kernel, hipFuncAttributeMaxDynamicSharedMemorySize, (int)LDS_BYTES);
    hipOccupancyMaxActiveBlocksPerMultiprocessor(&per_cu, mega_kernel, NTH, LDS_BYTES);
    if (per_cu < 1) per_cu = 1;
    grid_blocks = cus * per_cu;
  }
  (void)hipMemsetAsync((char*)d_ws + W_BAR, 0, 16384, stream);
  void* args[] = {&p};
  hipError_t e = hipLaunchCooperativeKernel((void*)mega_kernel, dim3(grid_blocks), dim3(NTH), args, LDS_BYTES, stream);
  if (e != hipSuccess) fprintf(stderr, "cooperative launch failed: %s (grid %d)\n", hipGetErrorString(e), grid_blocks);
#else
  const int grid = 256;
  launch_phase<0>(p, grid, stream);
  launch_phase<1>(p, grid, stream);
  launch_phase<2>(p, grid, stream);
  launch_phase<3>(p, grid, stream);
  launch_phase<4>(p, grid, stream);
  launch_phase<5>(p, grid, stream);
  launch_phase<6>(p, grid, stream);
#endif
}
```

```cpp
#include <hip/hip_runtime.h>
#include <hip/hip_cooperative_groups.h>
#include <cstdio>
namespace cg = cooperative_groups;

#ifndef MEGA
#define MEGA 1
#define PROBE_GEMM 0
#define PROBE_SYNC 0
#define PROBE_G 0
#define DUP_MASK 0
#endif

typedef unsigned short u16;
using bf16x8 = __attribute__((ext_vector_type(8))) short;
using f32x4 = __attribute__((ext_vector_type(4))) float;
using u32x4 = __attribute__((ext_vector_type(4))) unsigned;
using u32x2 = __attribute__((ext_vector_type(2))) unsigned;

#define NTH 512
constexpr int MP = 16384, MS = 128, MT = 16512, DM = 1024, DIN = 4104, PQW = 2560;
constexpr float EPS = 1e-6f;
constexpr int LDK = 1088;
constexpr size_t LDS_BYTES = 139264;

constexpr size_t O_YP = 0, O_YS = 16777216, O_HGP = 16908288, O_GDP = 17432576, O_CVP = 17956864,
                 O_HGS = 17993728, O_GDS = 26382336, O_CVS = 34770944;
constexpr size_t W_WINT = 0;
constexpr size_t W_WOUTT = W_WINT + (size_t)4096 * LDK * 2;
constexpr size_t W_BETA = W_WOUTT + (size_t)1024 * LDK * 2;
constexpr size_t W_GDEC = W_BETA + 264192;
constexpr size_t W_DVEC = W_GDEC + 264192;
constexpr size_t W_DSC = W_DVEC + 1048576;
constexpr size_t W_PQ = W_DSC + 4096;
constexpr size_t W_GATES = W_PQ + 84541440;
constexpr size_t W_H = W_GATES + 33816576;
constexpr size_t W_QS = W_H + (size_t)MT * LDK * 2;
constexpr size_t W_MNEG = W_QS + 33554432;
constexpr size_t W_LF = W_MNEG + 33554432;
constexpr size_t W_BAR = W_LF + 33816576;
constexpr size_t W_END = W_BAR + 16384;

struct Params {
  const float *x_prompt, *x_sample, *state_hgrn, *state_gdn, *state_conv, *norm_w, *w_in, *lb_logits,
      *conv_w, *a_log, *dt_bias, *hg_norm, *gdn_norm, *w_out, *final_norm;
  float* out;
  char* ws;
};

__device__ __forceinline__ int opaque_tid() { int t = threadIdx.x; asm volatile("" : "+v"(t)); return t; }
typedef __bf16 bf16x2_t __attribute__((ext_vector_type(2)));
typedef float f32x2_t __attribute__((ext_vector_type(2)));
__device__ __forceinline__ u16 f2bf(float x) { return __builtin_bit_cast(u16, (__bf16)x); }
__device__ __forceinline__ float bf2f(u16 h) { return __uint_as_float(((unsigned)h) << 16); }
__device__ __forceinline__ unsigned pack2(float a, float b) {
  f32x2_t v = {a, b};
  return __builtin_bit_cast(unsigned, __builtin_convertvector(v, bf16x2_t));
}
template <int CTRL, int ROWMASK>
__device__ __forceinline__ float dpp_mov(float v) {
  return __builtin_bit_cast(float, __builtin_amdgcn_update_dpp(0, __builtin_bit_cast(int, v), CTRL, ROWMASK, 0xf, false));
}
__device__ __forceinline__ float wave_sum(float v) {
  v += dpp_mov<0xB1, 0xf>(v);
  v += dpp_mov<0x4E, 0xf>(v);
  v += dpp_mov<0x141, 0xf>(v);
  v += dpp_mov<0x140, 0xf>(v);
  v += dpp_mov<0x142, 0xa>(v);
  v += dpp_mov<0x143, 0xc>(v);
  return __builtin_bit_cast(float, __builtin_amdgcn_readlane(__builtin_bit_cast(int, v), 63));
}
__device__ __forceinline__ float sigmoidf_(float x) { return 1.f / (1.f + __expf(-x)); }
__device__ __forceinline__ float siluf_(float x) { return x / (1.f + __expf(-x)); }
__device__ __forceinline__ f32x4 mfma16(bf16x8 a, bf16x8 b, f32x4 c) {
  return __builtin_amdgcn_mfma_f32_16x16x32_bf16(a, b, c, 0, 0, 0);
}
__device__ __forceinline__ bf16x8 frag(const u16* base, int row0, int stride, int koff, int lane) {
  return *(const bf16x8*)(base + (row0 + (lane & 15)) * stride + koff + (lane >> 4) * 8);
}

__device__ __forceinline__ void quad_transpose(float (&v)[4], int lane) {
  {
    const bool b = lane & 1;
    float s0 = b ? v[0] : v[1], s1 = b ? v[2] : v[3];
    float r0 = dpp_mov<0xB1, 0xf>(s0), r1 = dpp_mov<0xB1, 0xf>(s1);
    if (b) { v[0] = r0; v[2] = r1; } else { v[1] = r0; v[3] = r1; }
  }
  {
    const bool b = lane & 2;
    float s0 = b ? v[0] : v[2], s1 = b ? v[1] : v[3];
    float r0 = dpp_mov<0x4E, 0xf>(s0), r1 = dpp_mov<0x4E, 0xf>(s1);
    if (b) { v[0] = r0; v[1] = r1; } else { v[2] = r0; v[3] = r1; }
  }
}
__device__ __forceinline__ void store4_bf16(u16* dst, const float (&v)[4]) {
  *(u32x2*)dst = u32x2{pack2(v[0], v[1]), pack2(v[2], v[3])};
}
__device__ void phase0(const Params& p, char* smem, int bid, int nb) {
  const int tid = opaque_tid(), lane = tid & 63, w = tid >> 6;
  u16* WinT = (u16*)(p.ws + W_WINT);
  u16* WoutT = (u16*)(p.ws + W_WOUTT);
  u16* H = (u16*)(p.ws + W_H);
  float* BETA = (float*)(p.ws + W_BETA);
  float* GDEC = (float*)(p.ws + W_GDEC);
  float* tl = (float*)smem;
  {
    float pre[8];
    auto tile_src = [&](int t, const float*& src, int& sstride, u16*& dst, int& kt, int& nt) {
      if (t < 1024) { src = p.w_in; sstride = DIN; dst = WinT; kt = t >> 6; nt = t & 63; }
      else { int u = t - 1024; src = p.w_out; sstride = 1024; dst = WoutT; kt = u >> 4; nt = u & 15; }
    };
    if (bid < 1280) {
      const float* src; int sstride; u16* dst; int kt, nt;
      tile_src(bid, src, sstride, dst, kt, nt);
#pragma unroll
      for (int i = 0; i < 8; ++i) { int idx = tid + 512 * i; pre[i] = src[(size_t)(kt * 64 + (idx >> 6)) * sstride + nt * 64 + (idx & 63)]; }
    }
    for (int t = bid; t < 1280; t += nb) {
      const float* src; int sstride; u16* dst; int kt, nt;
      tile_src(t, src, sstride, dst, kt, nt);
#pragma unroll
      for (int i = 0; i < 8; ++i) { int idx = tid + 512 * i; tl[(idx >> 6) * 65 + (idx & 63)] = pre[i]; }
      __syncthreads();
      if (t + nb < 1280) {
        const float* src2; int ss2; u16* dst2; int kt2, nt2;
        tile_src(t + nb, src2, ss2, dst2, kt2, nt2);
#pragma unroll
        for (int i = 0; i < 8; ++i) { int idx = tid + 512 * i; pre[i] = src2[(size_t)(kt2 * 64 + (idx >> 6)) * ss2 + nt2 * 64 + (idx & 63)]; }
      }
      {
        int nn = tid >> 3, k8 = (tid & 7) * 8;
        unsigned pk[4];
#pragma unroll
        for (int e = 0; e < 4; ++e) pk[e] = pack2(tl[(k8 + 2 * e) * 65 + nn], tl[(k8 + 2 * e + 1) * 65 + nn]);
        *(uint4*)(dst + (size_t)(nt * 64 + nn) * LDK + kt * 64 + k8) = make_uint4(pk[0], pk[1], pk[2], pk[3]);
      }
      __syncthreads();
    }
  }
  float* W8s = (float*)smem;
  for (int idx = tid; idx < 8192; idx += 512) {
    int j = idx & 7, k = idx >> 3;
    W8s[j * 1024 + k] = p.w_in[(size_t)k * DIN + 4096 + j];
  }
  __syncthreads();
  float4 xn[4];
  if (bid < MT / 8) {
    const int row = bid * 8 + w;
    const float* x = row < MP ? p.x_prompt + (size_t)row * 1024 : p.x_sample + (size_t)(row - MP) * 1024;
#pragma unroll
    for (int i = 0; i < 4; ++i) xn[i] = *(const float4*)(x + i * 256 + lane * 4);
  }
  for (int g = bid; g < MT / 8; g += nb) {
    int row = g * 8 + w;
    float4 xv[4];
    float ss = 0.f;
#pragma unroll
    for (int i = 0; i < 4; ++i) {
      xv[i] = xn[i];
      ss += xv[i].x * xv[i].x + xv[i].y * xv[i].y + xv[i].z * xv[i].z + xv[i].w * xv[i].w;
    }
    if (g + nb < MT / 8) {
      const int row2 = (g + nb) * 8 + w;
      const float* x2 = row2 < MP ? p.x_prompt + (size_t)row2 * 1024 : p.x_sample + (size_t)(row2 - MP) * 1024;
#pragma unroll
      for (int i = 0; i < 4; ++i) xn[i] = *(const float4*)(x2 + i * 256 + lane * 4);
    }
    ss = wave_sum(ss);
    float rstd = rsqrtf(ss * (1.f / 1024.f) + EPS);
    float d0 = 0, d1 = 0, d2 = 0, d3 = 0, d4 = 0, d5 = 0, d6 = 0, d7 = 0;
#pragma unroll
    for (int i = 0; i < 4; ++i) {
      float4 nw = *(const float4*)(p.norm_w + i * 256 + lane * 4);
      float4 hv;
      hv.x = xv[i].x * rstd * nw.x; hv.y = xv[i].y * rstd * nw.y; hv.z = xv[i].z * rstd * nw.z; hv.w = xv[i].w * rstd * nw.w;
      *(uint2*)(H + (size_t)row * LDK + i * 256 + lane * 4) = make_uint2(pack2(hv.x, hv.y), pack2(hv.z, hv.w));
#define GDOT(j, dj) { float4 wv = *(const float4*)(W8s + j * 1024 + i * 256 + lane * 4); dj += hv.x * wv.x + hv.y * wv.y + hv.z * wv.z + hv.w * wv.w; }
      GDOT(0, d0) GDOT(1, d1) GDOT(2, d2) GDOT(3, d3) GDOT(4, d4) GDOT(5, d5) GDOT(6, d6) GDOT(7, d7)
#undef GDOT
    }
    d0 = wave_sum(d0); d1 = wave_sum(d1); d2 = wave_sum(d2); d3 = wave_sum(d3);
    d4 = wave_sum(d4); d5 = wave_sum(d5); d6 = wave_sum(d6); d7 = wave_sum(d7);
    if (lane < 4) {
      float gb = lane == 0 ? d0 : lane == 1 ? d1 : lane == 2 ? d2 : d3;
      float ga = lane == 0 ? d4 : lane == 1 ? d5 : lane == 2 ? d6 : d7;
      BETA[row * 4 + lane] = 1.f / (1.f + expf(-gb));
      float z = ga + p.dt_bias[lane];
      float sp = z > 20.f ? z : log1pf(expf(z));
      GDEC[row * 4 + lane] = -expf(p.a_log[lane]) * sp;
    }
  }
  __syncthreads();
}

__device__ __forceinline__ int lds_byte2(int r, int c) {
  int st = (r >> 4) * 2 + (c >> 5), ob = (r & 15) * 64 + (c & 31) * 2;
  return st * 1024 + (ob ^ (((ob >> 9) & 1) << 5));
}
__device__ __forceinline__ void stage_rc2(int b, int& R, int& C) {
  int st = b >> 10, sb = b & 1023, swz = sb ^ (((sb >> 9) & 1) << 5);
  R = (st >> 1) * 16 + swz / 64;
  C = (st & 1) * 32 + (swz % 64) / 2;
}
template <int EPI, int SEC>
__device__ __forceinline__ void epi_store4(const Params& p, int row, int col4, const float (&v)[4]) {
  if (EPI == 0) {
    u16* PQ = (u16*)(p.ws + W_PQ);
    u16* GATES = (u16*)(p.ws + W_GATES);
    float* LF = (float*)(p.ws + W_LF);
    const int sec = SEC >= 0 ? SEC : (col4 >> 9);
    if (sec == 0) {
      *(uint2*)(PQ + (size_t)row * PQW + col4) = make_uint2(pack2(v[0], v[1]), pack2(v[2], v[3]));
    } else if (sec == 1) {
      const int cc = col4 - 512;
      const f32x4 l0 = *(const f32x4*)(p.lb_logits + cc), l1 = *(const f32x4*)(p.lb_logits + 512 + cc);
      f32x4 o;
#pragma unroll
      for (int i = 0; i < 4; ++i) {
        const float lbv = 1.f / (1.f + __expf(l1[i] - l0[i]));
        o[i] = __logf(lbv + (1.f - lbv) / (1.f + __expf(-v[i])));
      }
      *(f32x4*)(LF + (size_t)row * 512 + cc) = o;
    } else if (sec == 2) {
      *(uint2*)(PQ + (size_t)row * PQW + 512 + (col4 - 1024)) = make_uint2(pack2(v[0], v[1]), pack2(v[2], v[3]));
    } else if (sec == 3 || sec == 7) {
      const int cc = sec == 3 ? col4 - 1536 : 512 + col4 - 3584;
      *(uint2*)(GATES + (size_t)row * 1024 + cc) =
          make_uint2(pack2(v[0] / (1.f + __expf(-v[0])), v[1] / (1.f + __expf(-v[1]))),
                     pack2(v[2] / (1.f + __expf(-v[2])), v[3] / (1.f + __expf(-v[3]))));
    } else {
      const int cc = col4 - 2048;
      *(uint2*)(PQ + (size_t)row * PQW + 1024 + cc) = make_uint2(pack2(v[0], v[1]), pack2(v[2], v[3]));
      if (row < MP) {
        const int tt = row & 2047;
        if (tt >= 2045) *(f32x4*)(p.out + O_CVP + (size_t)((row >> 11) * 3 + (tt - 2045)) * 1536 + cc) = f32x4{v[0], v[1], v[2], v[3]};
      } else {
        *(f32x4*)(p.out + O_CVS + (size_t)((row - MP) * 3 + 2) * 1536 + cc) = f32x4{v[0], v[1], v[2], v[3]};
      }
    }
  } else {
    const float* xr = row < MP ? p.x_prompt + (size_t)row * 1024 : p.x_sample + (size_t)(row - MP) * 1024;
    float* yr = row < MP ? p.out + O_YP + (size_t)row * 1024 : p.out + O_YS + (size_t)(row - MP) * 1024;
    const f32x4 xv = *(const f32x4*)(xr + col4);
    *(f32x4*)(yr + col4) = f32x4{xv[0] + v[0], xv[1] + v[1], xv[2] + v[2], xv[3] + v[3]};
  }
}

template <int EPI, int MODE = 0>
__device__ void gemm_phase(const Params& p, const u16* __restrict__ A, const u16* __restrict__ Bt, int ntn,
                           char* smem, int bid, int nb) {
  const int tid = opaque_tid(), lane = tid & 63, wid = tid >> 6;
  const int wr = wid >> 2, wc = wid & 3, fr = lane & 15, fq = lane >> 4;
  constexpr int TILE_B = 256 * 64 * 2, STAGE_B = 2 * TILE_B;
  int sR0, sC0;
  stage_rc2(wid * 1024 + lane * 16, sR0, sC0);
  const unsigned goff = (unsigned)(sR0 * LDK + sC0);
  const unsigned lbase = (unsigned)(size_t)smem + (unsigned)(wid * 1024);
  const int aoff = (wr * 16) * 1024 + ((fr * 64 + fq * 16) ^ ((((fr * 64 + fq * 16) >> 9) & 1) << 5));
  const int boff = TILE_B + (wc * 8) * 1024 + ((fr * 64 + fq * 16) ^ ((((fr * 64 + fq * 16) >> 9) & 1) << 5));
  const int ntiles = 64 * ntn;
  auto tile_mn = [&](int tile, int& tm, int& tn) {
    const int rnd = tile >> 8, t = tile & 255, xcd = t & 7, j = t >> 3;
    if (ntn == 16) { tm = rnd * 16 + (xcd >> 1) * 4 + (j & 3); tn = ((xcd & 1) * 8 + (j >> 2) + (rnd & 1) * 2 + (rnd >> 1) * 8) & 15; }
    else { tm = xcd * 8 + (j & 7); tn = j >> 3; }
  };
  bool staged = false;
  for (int tile = bid; tile < ntiles; tile += nb) {
    int tm, tn;
    tile_mn(tile, tm, tn);
    const u16* Ab = A + (size_t)tm * 256 * LDK;
    const u16* Bb = Bt + (size_t)tn * 256 * LDK;
    f32x4 acc[8][4];
#pragma unroll
    for (int m = 0; m < 8; ++m)
#pragma unroll
      for (int n = 0; n < 4; ++n) acc[m][n] = f32x4{0.f, 0.f, 0.f, 0.f};
#define G_STAGE(buf, kt) { _Pragma("unroll") for (int i = 0; i < 4; ++i) { \
      __builtin_amdgcn_global_load_lds((const unsigned*)(Ab + (goff + (unsigned)(i * 64 * LDK + (kt) * 64))), \
          (__attribute__((address_space(3))) unsigned*)(lbase + (buf) * STAGE_B + i * 8192), 16, 0, 0); \
      __builtin_amdgcn_global_load_lds((const unsigned*)(Bb + (goff + (unsigned)(i * 64 * LDK + (kt) * 64))), \
          (__attribute__((address_space(3))) unsigned*)(lbase + (buf) * STAGE_B + TILE_B + i * 8192), 16, 0, 0); } }
#define G_PIECE_A(buf, kt, i) __builtin_amdgcn_global_load_lds((const unsigned*)(Ab + (goff + (unsigned)((i) * 64 * LDK + (kt) * 64))), \
          (__attribute__((address_space(3))) unsigned*)(lbase + (buf) * STAGE_B + (i) * 8192), 16, 0, 0)
#define G_PIECE_B(buf, kt, i) __builtin_amdgcn_global_load_lds((const unsigned*)(Bb + (goff + (unsigned)((i) * 64 * LDK + (kt) * 64))), \
          (__attribute__((address_space(3))) unsigned*)(lbase + (buf) * STAGE_B + TILE_B + (i) * 8192), 16, 0, 0)
    if (!staged) G_STAGE(0, 0);
    asm volatile("s_waitcnt vmcnt(0)" ::: "memory");
    __syncthreads();
    for (int t = 0; t < 16; ++t) {
      const int cur = t & 1;
      const bool more = (MODE != 2) && (t + 1 < 16);
      const char* sA = smem + cur * STAGE_B + aoff;
      const char* sB = smem + cur * STAGE_B + boff;
#pragma unroll
      for (int ks = 0; ks < 2; ++ks) {
        bf16x8 At[8], Bf[4];
#pragma unroll
        for (int m = 0; m < 8; ++m) At[m] = *(const bf16x8*)(sA + (m * 2 + ks) * 1024);
#pragma unroll
        for (int n = 0; n < 4; ++n) Bf[n] = *(const bf16x8*)(sB + (n * 2 + ks) * 1024);
        if (MODE != 3) {
#pragma unroll
          for (int m = 0; m < 8; ++m) {
#pragma unroll
            for (int n = 0; n < 4; ++n) acc[m][n] = mfma16(At[m], Bf[n], acc[m][n]);
            if (ks == 0 && more) {
              if (m < 4) G_PIECE_A(cur ^ 1, t + 1, m); else G_PIECE_B(cur ^ 1, t + 1, m - 4);
              __builtin_amdgcn_sched_barrier(0);
            }
          }
        } else {
          if (ks == 0 && more) G_STAGE(cur ^ 1, t + 1);
#pragma unroll
          for (int m = 0; m < 8; ++m) acc[m][0][0] += __builtin_bit_cast(float, (int)At[m][0]);
#pragma unroll
          for (int n = 0; n < 4; ++n) acc[0][n][1] += __builtin_bit_cast(float, (int)Bf[n][0]);
        }
        __builtin_amdgcn_sched_barrier(0);
      }
      asm volatile("s_waitcnt vmcnt(0)" ::: "memory");
      __syncthreads();
    }
    staged = false;
    if (tile + nb < ntiles) {
      int tm2, tn2;
      tile_mn(tile + nb, tm2, tn2);
      const u16* Ab2 = A + (size_t)tm2 * 256 * LDK;
      const u16* Bb2 = Bt + (size_t)tn2 * 256 * LDK;
      { const u16* Ab = Ab2; const u16* Bb = Bb2; G_STAGE(0, 0); }
      staged = true;
    }
#undef G_STAGE
#undef G_PIECE_A
#undef G_PIECE_B
    if (MODE != 0 && MODE != 5) {
      float chk = 0.f;
#pragma unroll
      for (int m = 0; m < 8; ++m)
#pragma unroll
        for (int n = 0; n < 4; ++n) chk += acc[m][n][0] + acc[m][n][1] + acc[m][n][2] + acc[m][n][3];
      if (chk == 1.2345e-30f) p.out[0] = chk;
    } else
    {
      int t2 = threadIdx.x;
      asm volatile("" : "+v"(t2));
      const int lane2 = t2 & 63, wid2 = t2 >> 6;
      const int rbase = tm * 256 + (wid2 >> 2) * 128 + (lane2 >> 4) * 4 + (lane2 & 3);
      const int cbase = tn * 256 + (wid2 & 3) * 64 + (lane2 & 12);
#define EPI_LOOP(SEC) { _Pragma("unroll") for (int m = 0; m < 8; ++m) { _Pragma("unroll") for (int n = 0; n < 4; ++n) { \
          float v[4] = {acc[m][n][0], acc[m][n][1], acc[m][n][2], acc[m][n][3]}; \
          quad_transpose(v, lane2); \
          epi_store4<EPI, SEC>(p, rbase + m * 16, cbase + n * 16, v); } } }
      if (EPI == 0) {
        const int sec = tn >> 1;
        if (sec == 1) {
          float* LF = (float*)(p.ws + W_LF);
          float lbv[4][4];
#pragma unroll
          for (int n = 0; n < 4; ++n) {
            const int cc = cbase + n * 16 - 512;
            const f32x4 l0 = *(const f32x4*)(p.lb_logits + cc), l1 = *(const f32x4*)(p.lb_logits + 512 + cc);
#pragma unroll
            for (int e = 0; e < 4; ++e) lbv[n][e] = 1.f / (1.f + __expf(l1[e] - l0[e]));
          }
#pragma unroll
          for (int m = 0; m < 8; ++m)
#pragma unroll
            for (int n = 0; n < 4; ++n) {
              float v[4] = {acc[m][n][0], acc[m][n][1], acc[m][n][2], acc[m][n][3]};
              quad_transpose(v, lane2);
              f32x4 o;
#pragma unroll
              for (int e = 0; e < 4; ++e) o[e] = __logf(lbv[n][e] + (1.f - lbv[n][e]) * __builtin_amdgcn_rcpf(1.f + __expf(-v[e])));
              *(f32x4*)(LF + (size_t)(rbase + m * 16) * 512 + (cbase + n * 16 - 512)) = o;
            }
        } else {
          const bool gate = (sec == 3 || sec == 7);
          u16* dstb; int dstride, dcol;
          const int c0 = tn * 256 + (wid2 & 3) * 64;
          if (gate) { dstb = (u16*)(p.ws + W_GATES); dstride = 1024; dcol = sec == 3 ? c0 - 1536 : 512 + c0 - 3584; }
          else { dstb = (u16*)(p.ws + W_PQ); dstride = PQW; dcol = sec == 0 ? c0 : sec == 2 ? 512 + c0 - 1024 : 1024 + c0 - 2048; }
          char* ebuf = smem + STAGE_B + wid2 * 8192;
          const int wrow = (lane2 >> 4) * 4 + (lane2 & 3), wcol = (lane2 & 12);
          const int row00 = tm * 256 + (wid2 >> 2) * 128;
#pragma unroll
          for (int hf = 0; hf < 2; ++hf) {
#pragma unroll
            for (int m = 0; m < 4; ++m)
#pragma unroll
              for (int n = 0; n < 4; ++n) {
                float v[4] = {acc[hf * 4 + m][n][0], acc[hf * 4 + m][n][1], acc[hf * 4 + m][n][2], acc[hf * 4 + m][n][3]};
                if (gate) {
#pragma unroll
                  for (int e = 0; e < 4; ++e) v[e] = v[e] / (1.f + __expf(-v[e]));
                }
                quad_transpose(v, lane2);
                const int rl = m * 16 + wrow, cl = n * 16 + wcol;
                *(u32x2*)(ebuf + rl * 128 + ((cl * 2) ^ ((rl & 7) << 4))) = u32x2{pack2(v[0], v[1]), pack2(v[2], v[3])};
                if (sec >= 4 && sec <= 6) {
                  const int row = row00 + hf * 64 + rl, cc = c0 - 2048 + cl;
                  const int tt = row & 2047;
                  if (tt >= 2045) *(f32x4*)(p.out + O_CVP + (size_t)((row >> 11) * 3 + (tt - 2045)) * 1536 + cc) = f32x4{v[0], v[1], v[2], v[3]};
                }
              }
            asm volatile("s_waitcnt lgkmcnt(0)" ::: "memory");
#pragma unroll
            for (int i = 0; i < 8; ++i) {
              const int rl = i * 8 + (lane2 >> 3), ch = lane2 & 7;
              const u32x4 d = *(const u32x4*)(ebuf + rl * 128 + ((ch ^ (rl & 7)) << 4));
              *(u32x4*)(dstb + (size_t)(row00 + hf * 64 + rl) * dstride + dcol + ch * 8) = d;
            }
            asm volatile("s_waitcnt lgkmcnt(0)" ::: "memory");
          }
        }
      } else EPI_LOOP(0)
#undef EPI_LOOP
    }
  }
  const int nunits = MODE == 0 ? ntn * 16 : 0;
  int t3 = threadIdx.x;
  asm volatile("" : "+v"(t3));
  for (int u = bid; u < nunits; u += nb) {
    const int lane = t3 & 63, wid = t3 >> 6, fr = lane & 15, fq = lane >> 4;
    const u16* ar = A + (size_t)(MP + fr) * LDK + wid * 128 + fq * 8;
    const u16* br = Bt + (size_t)(u * 16 + fr) * LDK + wid * 128 + fq * 8;
    bf16x8 bfr[4];
#pragma unroll
    for (int ks = 0; ks < 4; ++ks) bfr[ks] = *(const bf16x8*)(br + ks * 32);
    bf16x8 afr[8][4];
#pragma unroll
    for (int rt = 0; rt < 8; ++rt)
#pragma unroll
      for (int ks = 0; ks < 4; ++ks) afr[rt][ks] = *(const bf16x8*)(ar + (size_t)rt * 16 * LDK + ks * 32);
    f32x4* red = (f32x4*)smem;
#pragma unroll
    for (int rt = 0; rt < 8; ++rt) {
      f32x4 acc = {0.f, 0.f, 0.f, 0.f};
#pragma unroll
      for (int ks = 0; ks < 4; ++ks) acc = mfma16(afr[rt][ks], bfr[ks], acc);
      red[(wid * 8 + rt) * 64 + lane] = acc;
    }
    __syncthreads();
    f32x4 tot = red[(0 * 8 + wid) * 64 + lane];
#pragma unroll
    for (int sw = 1; sw < 8; ++sw) tot += red[(sw * 8 + wid) * 64 + lane];
    float v[4] = {tot[0], tot[1], tot[2], tot[3]};
    quad_transpose(v, lane);
    epi_store4<EPI, -1>(p, MP + wid * 16 + fq * 4 + (lane & 3), u * 16 + (fr & ~3), v);
    __syncthreads();
  }
  __syncthreads();
}

#define XB_TMO      128
#define XB_XCNT(j)  (256  + 64 * (j))
#define XB_XSUB(j)  (1280 + 64 * (j))
#define XB_XGEN(j)  (2304 + 64 * (j))
#define XB_TOP      3328
#define XB_TOPGEN   3392
#define XCD_BAR_WORDS 3456
#define XB_SPIN_CAP (1u << 18)
#define LAS __attribute__((address_space(3)))
__device__ __forceinline__ unsigned xb_ld(unsigned* p)              { return __hip_atomic_load(p, __ATOMIC_RELAXED, __HIP_MEMORY_SCOPE_AGENT); }
__device__ __forceinline__ unsigned xb_add(unsigned* p, unsigned v) { return __hip_atomic_fetch_add(p, v, __ATOMIC_RELAXED, __HIP_MEMORY_SCOPE_AGENT); }
__device__ __forceinline__ unsigned xb_xcc_id() { return (unsigned)__builtin_amdgcn_s_getreg((3 << 11) | 20) & 0xFu; }
#define XB_SPIN(cond, bar) do { unsigned _sp = 0; while (cond) { __builtin_amdgcn_s_sleep(1); \
    if ((++_sp & 255u) == 0u) { if (xb_ld(&(bar)[XB_TMO])) break; if (_sp > XB_SPIN_CAP) { atomicAdd(&(bar)[XB_TMO], 1u); break; } } } } while (0)
struct XcdBarrier { unsigned* bar; unsigned x; volatile LAS unsigned* st; };
__device__ __forceinline__ XcdBarrier xcd_barrier_post(unsigned* bar, volatile LAS unsigned* st) {
  XcdBarrier b; b.bar = bar; b.x = xb_xcc_id(); b.st = st;
  if (threadIdx.x == 0) (void)xb_add(&bar[XB_XCNT(b.x)], 1u);
  return b;
}
__device__ __forceinline__ void xcd_barrier_complete(unsigned* bar, unsigned x, unsigned& nloc, unsigned& nx) {
  const unsigned G = gridDim.x * gridDim.y * gridDim.z;
  unsigned sum, cnt, mine, sp = 0u;
  for (;;) {
    sum = 0u; cnt = 0u; mine = 0u;
#pragma unroll
    for (unsigned j = 0; j < 16; ++j) { const unsigned c = xb_ld(&bar[XB_XCNT(j)]); sum += c; cnt += (c > 0u) ? 1u : 0u; mine = (j == x) ? c : mine; }
    if (sum == G) break;
    __builtin_amdgcn_s_sleep(1);
    if ((++sp & 255u) == 0u) { if (xb_ld(&bar[XB_TMO])) break; if (sp > XB_SPIN_CAP) { atomicAdd(&bar[XB_TMO], 1u); break; } }
  }
  nloc = mine > 0u ? mine : 1u; nx = cnt > 0u ? cnt : 1u;
}
__device__ __forceinline__ void xcd_barrier(const XcdBarrier& b) {
  asm volatile("s_waitcnt vmcnt(0)" ::: "memory");
  __syncthreads();
  if (threadIdx.x == 0) {
    unsigned* bar = b.bar;
    __builtin_amdgcn_s_waitcnt(0);
    unsigned nloc = b.st[0], nx = b.st[1];
    if (nloc == 0u) { xcd_barrier_complete(bar, b.x, nloc, nx); b.st[0] = nloc; b.st[1] = nx; }
    const unsigned old = xb_add(&bar[XB_XSUB(b.x)], 1u);
    const unsigned gen = old / nloc;
    if (old + 1u == (gen + 1u) * nloc) {
      __builtin_amdgcn_fence(__ATOMIC_RELEASE, "agent");
      asm volatile("s_waitcnt vmcnt(0)" ::: "memory");
      const unsigned og = xb_add(&bar[XB_TOP], 1u);
      const unsigned tg = og / nx;
      if (og + 1u == (tg + 1u) * nx) xb_add(&bar[XB_TOPGEN], 1u);
      else XB_SPIN(xb_ld(&bar[XB_TOPGEN]) == tg, bar);
      __builtin_amdgcn_fence(__ATOMIC_ACQUIRE, "agent");
      xb_add(&bar[XB_XGEN(b.x)], 1u);
      asm volatile("s_waitcnt vmcnt(0)" ::: "memory");
    } else {
      XB_SPIN(xb_ld(&bar[XB_XGEN(b.x)]) == gen, bar);
      __builtin_amdgcn_fence(__ATOMIC_ACQUIRE, "agent");
      asm volatile("s_waitcnt vmcnt(0)" ::: "memory");
    }
  }
  __syncthreads();
}

#define RAW_BARRIER() do { asm volatile("s_waitcnt lgkmcnt(0)" ::: "memory"); __builtin_amdgcn_s_barrier(); asm volatile("" ::: "memory"); } while (0)
__device__ void hgrn_item(const Params& p, char* smem, int idx) {
  const int tid = opaque_tid(), lane = tid & 63, w = tid >> 6;
  const int lr = lane & 15, lq = lane >> 4;
  const int h = idx & 3, c = (idx >> 2) & 31, b = idx >> 7;
  const int r0 = b * 2048 + c * 64;
  const u16* PQ = (const u16*)(p.ws + W_PQ);
  const float* LF = (const float*)(p.ws + W_LF);
  u16* QS = (u16*)(p.ws + W_QS);
  u16* O0 = (u16*)(p.ws + W_H);
  u16* NB = (u16*)(p.out);
  float* DVEC = (float*)(p.ws + W_DVEC);
  u16* qt = (u16*)smem;
  u16* kt = qt + 64 * 136;
  u16* ktT = kt + 64 * 136;
  u16* vT = ktT + 128 * 72;
  u16* sc = vT + 128 * 72;
  float* ps = (float*)(sc + 64 * 72);
  const int col = tid & 127, part = tid >> 7;
  float lfv[16], bcum[16];
  {
    const float* lfp = LF + (size_t)(r0 + part * 16) * 512 + h * 128 + col;
#pragma unroll
    for (int i = 0; i < 16; ++i) lfv[i] = lfp[(size_t)i * 512];
    float run = 0.f;
#pragma unroll
    for (int i = 0; i < 16; ++i) { run += lfv[i]; bcum[i] = run; }
    ps[part * 128 + col] = run;
  }
  u16 qraw[16], vraw[16];
  {
    const u16* qp0 = PQ + (size_t)(r0 + part * 16) * PQW + h * 128 + col;
#pragma unroll
    for (int i = 0; i < 16; ++i) { qraw[i] = qp0[(size_t)i * PQW]; vraw[i] = qp0[(size_t)i * PQW + 512]; }
  }
  RAW_BARRIER();
  {
    float off = 0.f, blast = 0.f;
#pragma unroll
    for (int pp = 0; pp < 4; ++pp) { float t = ps[pp * 128 + col]; blast += t; if (pp < part) off += t; }
    u16* qsout = QS + ((size_t)idx * 64 + part * 16) * 128 + col;
    float kkv[16];
#pragma unroll
    for (int i = 0; i < 16; ++i) {
      const float bb = bcum[i] + off;
      const int row = part * 16 + i;
      const float q = bf2f(qraw[i]);
      qsout[i * 128] = f2bf(q * __expf(bb));
      qt[row * 136 + col] = f2bf(q * __expf(bb - blast));
      kkv[i] = (1.f - __expf(lfv[i])) * __expf(blast - bb);
      kt[row * 136 + col] = f2bf(kkv[i]);
    }
#pragma unroll
    for (int hh = 0; hh < 2; ++hh) {
      *(u32x4*)(ktT + col * 72 + part * 16 + hh * 8) =
          u32x4{pack2(kkv[hh * 8 + 0], kkv[hh * 8 + 1]), pack2(kkv[hh * 8 + 2], kkv[hh * 8 + 3]),
                pack2(kkv[hh * 8 + 4], kkv[hh * 8 + 5]), pack2(kkv[hh * 8 + 6], kkv[hh * 8 + 7])};
      *(u32x4*)(vT + col * 72 + part * 16 + hh * 8) =
          u32x4{(unsigned)vraw[hh * 8 + 0] | ((unsigned)vraw[hh * 8 + 1] << 16), (unsigned)vraw[hh * 8 + 2] | ((unsigned)vraw[hh * 8 + 3] << 16),
                (unsigned)vraw[hh * 8 + 4] | ((unsigned)vraw[hh * 8 + 5] << 16), (unsigned)vraw[hh * 8 + 6] | ((unsigned)vraw[hh * 8 + 7] << 16)};
    }
    if (part == 0) DVEC[idx * 128 + col] = __expf(blast);
  }
  RAW_BARRIER();
  {
    const int tr = w >> 1;
    bf16x8 a[4];
#pragma unroll
    for (int ks = 0; ks < 4; ++ks) a[ks] = frag(qt, tr * 16, 136, ks * 32, lane);
#pragma unroll
    for (int tci = 0; tci < 2; ++tci) {
      const int tc = (w & 1) * 2 + tci;
      f32x4 acc = {0.f, 0.f, 0.f, 0.f};
#pragma unroll
      for (int ks = 0; ks < 4; ++ks) acc = mfma16(a[ks], frag(kt, tc * 16, 136, ks * 32, lane), acc);
#pragma unroll
      for (int j = 0; j < 4; ++j) {
        const int t = tr * 16 + lq * 4 + j, s = tc * 16 + lr;
        sc[t * 72 + s] = f2bf(t >= s ? acc[j] : 0.f);
      }
    }
  }
  RAW_BARRIER();
  {
    const int tr = w >> 1;
    const bf16x8 a0 = frag(sc, tr * 16, 72, 0, lane), a1 = frag(sc, tr * 16, 72, 32, lane);
#pragma unroll
    for (int tci = 0; tci < 4; ++tci) {
      const int tc = (w & 1) * 4 + tci;
      f32x4 acc = {0.f, 0.f, 0.f, 0.f};
      acc = mfma16(a0, frag(vT, tc * 16, 72, 0, lane), acc);
      acc = mfma16(a1, frag(vT, tc * 16, 72, 32, lane), acc);
      {
        float v[4] = {acc[0], acc[1], acc[2], acc[3]};
        quad_transpose(v, lane);
        store4_bf16(O0 + ((size_t)idx * 64 + tr * 16 + lq * 4 + (lane & 3)) * 128 + tc * 16 + (lr & 12), v);
      }
    }
  }
  {
    const int tr = w;
    const bf16x8 a0 = frag(ktT, tr * 16, 72, 0, lane), a1 = frag(ktT, tr * 16, 72, 32, lane);
#pragma unroll
    for (int tc = 0; tc < 8; ++tc) {
      f32x4 acc = {0.f, 0.f, 0.f, 0.f};
      acc = mfma16(a0, frag(vT, tc * 16, 72, 0, lane), acc);
      acc = mfma16(a1, frag(vT, tc * 16, 72, 32, lane), acc);
      {
        float v[4] = {acc[0], acc[1], acc[2], acc[3]};
        quad_transpose(v, lane);
        store4_bf16(NB + ((size_t)idx * 128 + tr * 16 + lq * 4 + (lane & 3)) * 128 + tc * 16 + (lr & 12), v);
      }
    }
  }
  RAW_BARRIER();
}

constexpr int ASTR = 68;
template <int J>
struct SolveCol {
  static __device__ __forceinline__ void run(f32x4 (&x)[16], const f32x4 (&a)[16], const float* AT) {
    if constexpr (J < 63) {
      f32x4 an[16];
      if constexpr (J + 1 < 63) {
#pragma unroll
        for (int B = (J + 2) / 4; B < 16; ++B) an[B] = *(const f32x4*)(AT + (J + 1) * ASTR + B * 4);
      }
      __builtin_amdgcn_sched_barrier(0);
      const float xj = x[J / 4][J % 4];
#pragma unroll
      for (int B = (J + 1) / 4; B < 16; ++B) x[B] -= a[B] * xj;
      __builtin_amdgcn_sched_barrier(0);
      SolveCol<J + 1>::run(x, an, AT);
    }
  }
};

__device__ void gdn_item(const Params& p, char* smem, int idx) {
  const int tid = opaque_tid(), lane = tid & 63, w = tid >> 6;
  const int lr = lane & 15, lq = lane >> 4;
  const int h = idx & 3, c = (idx >> 2) & 31, b = idx >> 7;
  const int r0 = b * 2048 + c * 64;
  const u16* PQ = (const u16*)(p.ws + W_PQ);
  const float* BETA = (const float*)(p.ws + W_BETA);
  const float* GDEC = (const float*)(p.ws + W_GDEC);
  u16* QS = (u16*)(p.ws + W_QS);
  u16* O0 = (u16*)(p.ws + W_H);
  u16* NB = (u16*)(p.out);
  u16* MNEG = (u16*)(p.ws + W_MNEG);
  float* DSC = (float*)(p.ws + W_DSC);
  u16* kb = (u16*)smem;
  u16* qb = kb + 64 * 136;
  u16* vS = qb + 64 * 136;
  float* Asol = (float*)(vS + 64 * 128);
  u16* attn = (u16*)(Asol + 64 * ASTR);
  u16* khT = attn + 64 * 72;
  u16* WT = khT + 128 * 72;
  u16* U0T = WT + 128 * 72;
  float* gc = (float*)(U0T + 128 * 72);
  float* bet = gc + 64;

  if (w == 0) {
    float g = GDEC[(size_t)(r0 + lane) * 4 + h];
#pragma unroll
    for (int o = 1; o < 64; o <<= 1) { float t = __shfl_up(g, o, 64); if (lane >= o) g += t; }
    gc[lane] = g;
    bet[lane] = BETA[(size_t)(r0 + lane) * 4 + h];
  }
  for (int rep_ = 0; rep_ < ((PROBE_G & 1) ? 2 : 1); ++rep_)
  {
    const int chq = 1024 + h * 128 + 2 * lane;
    const int cwq = h * 128 + 2 * lane;
    float cw[3][4][2];
#pragma unroll
    for (int ty = 0; ty < 3; ++ty)
#pragma unroll
      for (int j = 0; j < 4; ++j) {
        float2 t2 = *(const float2*)(p.conv_w + j * 1536 + ty * 512 + cwq);
        cw[ty][j][0] = t2.x; cw[ty][j][1] = t2.y;
      }
    float win[3][3][2];
    const int t0 = w * 8;
#pragma unroll
    for (int a = 0; a < 3; ++a) {
      const int rr = t0 - 3 + a;
      const bool valid = (c > 0) || (rr >= 0);
#pragma unroll
      for (int ty = 0; ty < 3; ++ty) {
        unsigned u = 0;
        if (valid) u = *(const unsigned*)(PQ + (ptrdiff_t)(r0 + rr) * PQW + chq + ty * 512);
        win[ty][a][0] = bf2f((u16)(u & 0xffff)); win[ty][a][1] = bf2f((u16)(u >> 16));
      }
    }
#pragma unroll
    for (int tt = 0; tt < 8; ++tt) {
      const int t = t0 + tt;
      float cv[3][2];
#pragma unroll
      for (int ty = 0; ty < 3; ++ty) {
        unsigned u = *(const unsigned*)(PQ + (size_t)(r0 + t) * PQW + chq + ty * 512);
        float c0 = bf2f((u16)(u & 0xffff)), c1 = bf2f((u16)(u >> 16));
        float s0 = cw[ty][0][0] * win[ty][0][0] + cw[ty][1][0] * win[ty][1][0] + cw[ty][2][0] * win[ty][2][0] + cw[ty][3][0] * c0;
        float s1 = cw[ty][0][1] * win[ty][0][1] + cw[ty][1][1] * win[ty][1][1] + cw[ty][2][1] * win[ty][2][1] + cw[ty][3][1] * c1;
        win[ty][0][0] = win[ty][1][0]; win[ty][0][1] = win[ty][1][1];
        win[ty][1][0] = win[ty][2][0]; win[ty][1][1] = win[ty][2][1];
        win[ty][2][0] = c0; win[ty][2][1] = c1;
        cv[ty][0] = siluf_(s0); cv[ty][1] = siluf_(s1);
      }
      float ssq = wave_sum(cv[0][0] * cv[0][0] + cv[0][1] * cv[0][1]);
      float ssk = wave_sum(cv[1][0] * cv[1][0] + cv[1][1] * cv[1][1]);
      const float rq = rsqrtf(ssq + EPS) * 0.08838834764831845f;
      const float rk = rsqrtf(ssk + EPS);
      *(unsigned*)(qb + t * 136 + 2 * lane) = pack2(cv[0][0] * rq, cv[0][1] * rq);
      *(unsigned*)(kb + t * 136 + 2 * lane) = pack2(cv[1][0] * rk, cv[1][1] * rk);
      *(unsigned*)(vS + t * 128 + 2 * lane) = pack2(cv[2][0], cv[2][1]);
    }
  }
  RAW_BARRIER();
  {
    const int which = w >> 2, tr = w & 3;
    const u16* Asrc = which ? qb : kb;
    bf16x8 a[4];
#pragma unroll
    for (int ks = 0; ks < 4; ++ks) a[ks] = frag(Asrc, tr * 16, 136, ks * 32, lane);
#pragma unroll
    for (int tc = 0; tc < 4; ++tc) {
      f32x4 acc = {0.f, 0.f, 0.f, 0.f};
#pragma unroll
      for (int ks = 0; ks < 4; ++ks) acc = mfma16(a[ks], frag(kb, tc * 16, 136, ks * 32, lane), acc);
#pragma unroll
      for (int j = 0; j < 4; ++j) {
        const int t = tr * 16 + lq * 4 + j, s = tc * 16 + lr;
        const float L = __expf(fminf(gc[t] - gc[s], 0.f));
        if (which == 0) Asol[s * ASTR + t] = (t > s) ? bet[t] * acc[j] * L : 0.f;
        else attn[t * 72 + s] = f2bf((t >= s) ? acc[j] * L : 0.f);
      }
    }
  }
  RAW_BARRIER();
  for (int rep_ = 0; rep_ < ((PROBE_G & 2) ? 2 : 1); ++rep_) {
  if (tid < 256) {
    f32x4 x[16];
    if (tid < 128) {
#pragma unroll
      for (int s = 0; s < 64; ++s) { x[s >> 2][s & 3] = bf2f(vS[s * 128 + tid]) * bet[s]; if ((s & 7) == 7) __builtin_amdgcn_sched_barrier(0); }
    } else {
#pragma unroll
      for (int s = 0; s < 64; ++s) { x[s >> 2][s & 3] = bf2f(kb[s * 136 + tid - 128]) * bet[s] * __expf(gc[s]); if ((s & 7) == 7) __builtin_amdgcn_sched_barrier(0); }
    }
    {
      f32x4 a0[16];
#pragma unroll
      for (int B = 0; B < 16; ++B) a0[B] = *(const f32x4*)(Asol + B * 4);
      SolveCol<0>::run(x, a0, Asol);
    }
    u16* dst = (tid < 128) ? (U0T + tid * 72) : (WT + (tid - 128) * 72);
#pragma unroll
    for (int s8 = 0; s8 < 8; ++s8) {
      *(u32x4*)(dst + s8 * 8) = u32x4{pack2(x[2 * s8][0], x[2 * s8][1]), pack2(x[2 * s8][2], x[2 * s8][3]),
                                      pack2(x[2 * s8 + 1][0], x[2 * s8 + 1][1]), pack2(x[2 * s8 + 1][2], x[2 * s8 + 1][3])};
    }
  } else {
    const float glast = gc[63];
    const int e0 = tid - 256;
#pragma unroll 4
    for (int i = 0; i < 32; ++i) {
      const int e = e0 + 256 * i;
      const int s = e & 63, kd = e >> 6;
      khT[kd * 72 + s] = f2bf(bf2f(kb[s * 136 + kd]) * __expf(glast - gc[s]));
    }
  }
  RAW_BARRIER();
  }
  for (int rep_ = 0; rep_ < ((PROBE_G & 4) ? 2 : 1); ++rep_) {
  {
    const int tr = w & 3, half = w >> 2;
    const u16* Bsrc = half ? U0T : WT;
    const bf16x8 a0 = frag(attn, tr * 16, 72, 0, lane), a1 = frag(attn, tr * 16, 72, 32, lane);
#pragma unroll 2
    for (int tc = 0; tc < 8; ++tc) {
      f32x4 acc = {0.f, 0.f, 0.f, 0.f};
      acc = mfma16(a0, frag(Bsrc, tc * 16, 72, 0, lane), acc);
      acc = mfma16(a1, frag(Bsrc, tc * 16, 72, 32, lane), acc);
      {
        float v[4];
#pragma unroll
        for (int j = 0; j < 4; ++j) {
          const int t = tr * 16 + lq * 4 + j, n = tc * 16 + lr;
          v[j] = half == 0 ? bf2f(qb[t * 136 + n]) * __expf(gc[t]) - acc[j] : acc[j];
        }
        quad_transpose(v, lane);
        const size_t o = ((size_t)(1024 + idx) * 64 + tr * 16 + lq * 4 + (lane & 3)) * 128 + tc * 16 + (lr & 12);
        store4_bf16((half == 0 ? QS : O0) + o, v);
      }
    }
  }
  {
    const int tr = w;
    const bf16x8 a0 = frag(khT, tr * 16, 72, 0, lane), a1 = frag(khT, tr * 16, 72, 32, lane);
#pragma unroll 2
    for (int tc = 0; tc < 16; ++tc) {
      const u16* Bsrc = tc < 8 ? WT : U0T;
      const int tcc = tc & 7;
      f32x4 acc = {0.f, 0.f, 0.f, 0.f};
      acc = mfma16(a0, frag(Bsrc, tcc * 16, 72, 0, lane), acc);
      acc = mfma16(a1, frag(Bsrc, tcc * 16, 72, 32, lane), acc);
      {
        float v[4];
#pragma unroll
        for (int j = 0; j < 4; ++j) v[j] = tc < 8 ? -acc[j] : acc[j];
        quad_transpose(v, lane);
        const size_t o = (size_t)(tr * 16 + lq * 4 + (lane & 3)) * 128 + tcc * 16 + (lr & 12);
        store4_bf16((tc < 8 ? MNEG + (size_t)idx * 16384 : NB + (size_t)(1024 + idx) * 16384) + o, v);
      }
    }
  }
  }
  if (tid < 128) ((float*)(p.ws + W_DVEC))[(size_t)(1024 + idx) * 128 + tid] = __expf(gc[63]);
  RAW_BARRIER();
}

__device__ void phase2(const Params& p, char* smem, int bid, int nb) {
  for (int it = bid; it < 2048; it += nb) {
    if (it >= 1024) { gdn_item(p, smem, it - 1024); if (DUP_MASK & 2048) gdn_item(p, smem, it - 1024); }
    else { hgrn_item(p, smem, it); if (DUP_MASK & 1024) hgrn_item(p, smem, it); }
  }
}

struct ScanRegs {
  bf16x8 Aq[4];
  bf16x8 Am[4];
  u32x2 o0, o1, nn0, nn1;
  f32x4 dd;
};

template <int TYPE, int ROLE>
__device__ __forceinline__ void scan_load(ScanRegs& r, const Params& p, int idx, unsigned qoff, unsigned ooff, unsigned moff,
                                          unsigned noff, unsigned doff) {
  const int ii = __builtin_amdgcn_readfirstlane(idx);
  const int ti = TYPE * 1024 + ii;
  const u16* NBb = (const u16*)(p.out) + (size_t)ti * 16384;
  if (ROLE == 0) {
    const u16* QSb = (const u16*)(p.ws + W_QS) + (size_t)ti * 8192;
    const u16* O0b = (const u16*)(p.ws + W_H) + (size_t)ti * 8192;
#pragma unroll
    for (int ks = 0; ks < 4; ++ks) r.Aq[ks] = *(const bf16x8*)(QSb + (qoff + ks * 32));
    r.o0 = *(const u32x2*)(O0b + ooff);
    r.o1 = *(const u32x2*)(O0b + (ooff + 16));
  }
  r.nn0 = *(const u32x2*)(NBb + noff);
  r.nn1 = *(const u32x2*)(NBb + (noff + 16));
  if (TYPE == 1) {
    const u16* Mb = (const u16*)(p.ws + W_MNEG) + (size_t)ii * 16384;
#pragma unroll
    for (int ks = 0; ks < 4; ++ks) r.Am[ks] = *(const bf16x8*)(Mb + (moff + ks * 32));
  }
  r.dd = *(const f32x4*)((const float*)(p.ws + W_DVEC) + (size_t)ti * 128 + doff);
}
__device__ __forceinline__ void unpack4(u32x2 u, float (&v)[4]) {
  v[0] = bf2f((u16)(u[0] & 0xffff)); v[1] = bf2f((u16)(u[0] >> 16));
  v[2] = bf2f((u16)(u[1] & 0xffff)); v[3] = bf2f((u16)(u[1] >> 16));
}

template <int TYPE, int ROLE>
__device__ __forceinline__ void scan_steps(const Params& p, u16* SbT, int lane, int w, int b, int h, int vs2, f32x4& S0, f32x4& S1) {
  const int lr = lane & 15, lq = lane >> 4;
  const int tr = lq * 4 + (lane & 3), tc4 = lr & 12;
  float* OPRE = (float*)(p.ws + W_PQ);
  const unsigned qoff = (unsigned)((w * 16 + lr) * 128 + lq * 8);
  const unsigned ooff = (unsigned)((w * 16 + tr) * 128 + vs2 * 32 + tc4);
  const unsigned moff = (unsigned)((w * 16 + lr) * 128 + lq * 8);
  const unsigned noff = (unsigned)((w * 16 + tr) * 128 + vs2 * 32 + tc4);
  const unsigned doff = (unsigned)(w * 16 + lq * 4);
  float* const orow = OPRE + (size_t)(b * 2048 + w * 16 + tr) * 1024 + TYPE * 512 + h * 128 + vs2 * 32 + tc4;
  ScanRegs r0, r1, r2, r3;
  const int idx0 = (b * 32) * 4 + h;
  scan_load<TYPE, ROLE>(r0, p, idx0 + 0, qoff, ooff, moff, noff, doff);
  scan_load<TYPE, ROLE>(r1, p, idx0 + 4, qoff, ooff, moff, noff, doff);
  scan_load<TYPE, ROLE>(r2, p, idx0 + 8, qoff, ooff, moff, noff, doff);
  scan_load<TYPE, ROLE>(r3, p, idx0 + 12, qoff, ooff, moff, noff, doff);
  __builtin_amdgcn_sched_barrier(0);
#define SCAN_STEP(R, c) { \
    RAW_BARRIER(); \
    const u16* Sb = SbT + ((c) & 1) * 32 * 136 + lr * 136 + lq * 8; \
    bf16x8 B0[4], B1[4]; \
    _Pragma("unroll") for (int ks = 0; ks < 4; ++ks) { \
      B0[ks] = *(const bf16x8*)(Sb + ks * 32); \
      B1[ks] = *(const bf16x8*)(Sb + 16 * 136 + ks * 32); } \
    if (ROLE == 0) { \
      float ov[4], ow[4]; unpack4(R.o0, ov); unpack4(R.o1, ow); quad_transpose(ov, lane); quad_transpose(ow, lane); \
      f32x4 a0 = {ov[0], ov[1], ov[2], ov[3]}, a1 = {ow[0], ow[1], ow[2], ow[3]}; \
      _Pragma("unroll") for (int ks = 0; ks < 4; ++ks) { a0 = mfma16(R.Aq[ks], B0[ks], a0); a1 = mfma16(R.Aq[ks], B1[ks], a1); } \
      float o[4] = {a0[0], a0[1], a0[2], a0[3]}, q[4] = {a1[0], a1[1], a1[2], a1[3]}; \
      quad_transpose(o, lane); quad_transpose(q, lane); \
      *(f32x4*)(orow + (size_t)(c) * 65536) = f32x4{o[0], o[1], o[2], o[3]}; \
      *(f32x4*)(orow + (size_t)(c) * 65536 + 16) = f32x4{q[0], q[1], q[2], q[3]}; \
    } \
    float n0[4], n1[4]; unpack4(R.nn0, n0); unpack4(R.nn1, n1); \
    quad_transpose(n0, lane); quad_transpose(n1, lane); \
    f32x4 T0, T1; \
    _Pragma("unroll") for (int j = 0; j < 4; ++j) { T0[j] = R.dd[j] * S0[j] + n0[j]; T1[j] = R.dd[j] * S1[j] + n1[j]; } \
    if (TYPE == 1) { _Pragma("unroll") for (int ks = 0; ks < 4; ++ks) { T0 = mfma16(R.Am[ks], B0[ks], T0); T1 = mfma16(R.Am[ks], B1[ks], T1); } } \
    S0 = T0; S1 = T1; \
    u16* Sw = SbT + (((c) + 1) & 1) * 32 * 136 + lr * 136 + w * 16 + lq * 4; \
    *(u32x2*)(Sw) = u32x2{pack2(S0[0], S0[1]), pack2(S0[2], S0[3])}; \
    *(u32x2*)(Sw + 16 * 136) = u32x2{pack2(S1[0], S1[1]), pack2(S1[2], S1[3])}; \
    __builtin_amdgcn_sched_barrier(0); \
    scan_load<TYPE, ROLE>(R, p, idx0 + (((c) + 4 < 32) ? (c) + 4 : 31) * 4, qoff, ooff, moff, noff, doff); \
    __builtin_amdgcn_sched_barrier(0); \
  }
  for (int c0 = 0; c0 < 32; c0 += 4) {
    SCAN_STEP(r0, c0)
    SCAN_STEP(r1, c0 + 1)
    SCAN_STEP(r2, c0 + 2)
    SCAN_STEP(r3, c0 + 3)
  }
#undef SCAN_STEP
}

template <int TYPE>
__device__ void scan_unit(const Params& p, char* smem, int rem) {
  const int tid = opaque_tid(), lane = tid & 63, w = tid >> 6;
  const int lq = lane >> 4, lr = lane & 15;
  const int b = rem >> 4, h = (rem >> 2) & 3, vs2 = rem & 3;
  const int tr = lq * 4 + (lane & 3), tc4 = lr & 12;
  u16* SbT = (u16*)smem;
  for (int i = tid; i < 2 * 32 * 136; i += 512) SbT[i] = 0;
  f32x4 S0 = {0.f, 0.f, 0.f, 0.f}, S1 = {0.f, 0.f, 0.f, 0.f};
  if (__builtin_amdgcn_readfirstlane(w) < 4) scan_steps<TYPE, 0>(p, SbT, lane, w, b, h, vs2, S0, S1);
  else scan_steps<TYPE, 1>(p, SbT, lane, w, b, h, vs2, S0, S1);
  float* so = p.out + (TYPE ? O_GDP : O_HGP) + (size_t)(b * 4 + h) * 16384 + (w * 16 + tr) * 128 + vs2 * 32 + tc4;
  {
    float sv[4] = {S0[0], S0[1], S0[2], S0[3]};
    quad_transpose(sv, lane);
    *(f32x4*)(so) = f32x4{sv[0], sv[1], sv[2], sv[3]};
    float sw[4] = {S1[0], S1[1], S1[2], S1[3]};
    quad_transpose(sw, lane);
    *(f32x4*)(so + 16) = f32x4{sw[0], sw[1], sw[2], sw[3]};
  }
  __syncthreads();
}

__device__ void sample_item(const Params& p, char* smem, int it) {
  const int tid = opaque_tid(), lane = tid & 63, w = tid >> 6;
  const int type = it >> 9, b = (it >> 2) & 127, h = it & 3;
  const int row = MP + b;
  const u16* PQ = (const u16*)(p.ws + W_PQ);
  const float* LF = (const float*)(p.ws + W_LF);
  const float* BETA = (const float*)(p.ws + W_BETA);
  const float* GDEC = (const float*)(p.ws + W_GDEC);
  float* OPRE = (float*)(p.ws + W_PQ);
  float* fq = (float*)smem;
  float* fk = fq + 128;
  float* fv = fk + 128;
  float* fe = fv + 128;
  float* red = fe + 128;
  float* sc = red + 1024;
  const int n = tid & 127, kp = tid >> 7;
  if (type == 0) {
    if (tid < 128) {
      const float lf = LF[(size_t)row * 512 + h * 128 + tid];
      const float f = __expf(lf);
      fe[tid] = f;
      fk[tid] = 1.f - f;
      fq[tid] = bf2f(PQ[(size_t)row * PQW + h * 128 + tid]);
      fv[tid] = bf2f(PQ[(size_t)row * PQW + 512 + h * 128 + tid]);
    }
    __syncthreads();
    const float* S = p.state_hgrn + ((size_t)(b * 4 + h) * 128) * 128;
    float* So = p.out + O_HGS + ((size_t)(b * 4 + h) * 128) * 128;
    const float vn = fv[n];
    float o = 0.f;
#pragma unroll
    for (int i = 0; i < 32; ++i) {
      const int k = kp * 32 + i;
      const float sn = fe[k] * S[k * 128 + n] + fk[k] * vn;
      So[k * 128 + n] = sn;
      o += fq[k] * sn;
    }
    red[kp * 128 + n] = o;
    __syncthreads();
    if (tid < 128) OPRE[(size_t)row * 1024 + h * 128 + tid] = red[tid] + red[128 + tid] + red[256 + tid] + red[384 + tid];
    __syncthreads();
  } else {
    const float* cprev = p.state_conv + (size_t)b * 3 * 1536;
    if (tid < 384) {
      const int ty = tid >> 7, cc = tid & 127;
      const int ch = ty * 512 + h * 128 + cc;
      const float p0 = cprev[ch], p1 = cprev[1536 + ch], p2 = cprev[3072 + ch];
      const float nw = bf2f(PQ[(size_t)row * PQW + 1024 + ch]);
      const float s = p.conv_w[ch] * p0 + p.conv_w[1536 + ch] * p1 + p.conv_w[3072 + ch] * p2 + p.conv_w[4608 + ch] * nw;
      fq[ty * 128 + cc] = siluf_(s);
      p.out[O_CVS + (size_t)(b * 3 + 0) * 1536 + ch] = p1;
      p.out[O_CVS + (size_t)(b * 3 + 1) * 1536 + ch] = p2;
    }
    __syncthreads();
    if (w < 2) {
      const float a0 = fq[w * 128 + lane], a1 = fq[w * 128 + 64 + lane];
      const float ss = wave_sum(a0 * a0 + a1 * a1);
      if (lane == 0) sc[w] = ss;
    }
    __syncthreads();
    const float rq = rsqrtf(sc[0] + EPS) * 0.08838834764831845f;
    const float rk = rsqrtf(sc[1] + EPS);
    __syncthreads();
    if (tid < 128) fq[tid] *= rq;
    else if (tid < 256) fk[tid - 128] *= rk;
    __syncthreads();
    if (w == 0) {
      const float qk = wave_sum(fq[lane] * fk[lane] + fq[64 + lane] * fk[64 + lane]);
      if (lane == 0) sc[2] = qk;
    }
    const float eg = __expf(GDEC[(size_t)row * 4 + h]);
    const float beta = BETA[(size_t)row * 4 + h];
    const float* S = p.state_gdn + ((size_t)(b * 4 + h) * 128) * 128;
    float* So = p.out + O_GDS + ((size_t)(b * 4 + h) * 128) * 128;
    float sd[32];
    float ks_ = 0.f, qs_ = 0.f;
#pragma unroll
    for (int i = 0; i < 32; ++i) {
      const int k = kp * 32 + i;
      sd[i] = eg * S[k * 128 + n];
      ks_ += fk[k] * sd[i];
      qs_ += fq[k] * sd[i];
    }
    red[kp * 128 + n] = ks_;
    red[512 + kp * 128 + n] = qs_;
    __syncthreads();
    const float kS = red[n] + red[128 + n] + red[256 + n] + red[384 + n];
    const float delta = (fv[n] - kS) * beta;
#pragma unroll
    for (int i = 0; i < 32; ++i) {
      const int k = kp * 32 + i;
      So[k * 128 + n] = sd[i] + fk[k] * delta;
    }
    if (tid < 128) {
      const float qS = red[512 + n] + red[640 + n] + red[768 + n] + red[896 + n];
      OPRE[(size_t)row * 1024 + 512 + h * 128 + n] = qS + sc[2] * delta;
    }
    __syncthreads();
  }
}

__device__ void sample_block4(const Params& p, char* smem, int bid) {
  const int tid = opaque_tid(), lane = tid & 63, w = tid >> 6;
  const u16* PQ = (const u16*)(p.ws + W_PQ);
  const float* LF = (const float*)(p.ws + W_LF);
  const float* BETA = (const float*)(p.ws + W_BETA);
  const float* GDEC = (const float*)(p.ws + W_GDEC);
  float* OPRE = (float*)(p.ws + W_PQ);
  float* vec = (float*)smem;
  float* red = vec + 2048;
  float* sc = red + 1024;
  if (tid < 256) {
    const int j = tid >> 7, c = tid & 127;
    const int it = bid + 256 * j, b = (it >> 2) & 127, h = it & 3, row = MP + b;
    const float f = __expf(LF[(size_t)row * 512 + h * 128 + c]);
    vec[(j * 4 + 0) * 128 + c] = bf2f(PQ[(size_t)row * PQW + h * 128 + c]);
    vec[(j * 4 + 1) * 128 + c] = 1.f - f;
    vec[(j * 4 + 2) * 128 + c] = bf2f(PQ[(size_t)row * PQW + 512 + h * 128 + c]);
    vec[(j * 4 + 3) * 128 + c] = f;
  }
  for (int e = tid; e < 768; e += 512) {
    const int j = 2 + e / 384, r = e % 384, ty = r >> 7, cc = r & 127;
    const int it = bid + 256 * j, b = (it >> 2) & 127, h = it & 3, row = MP + b;
    const int ch = ty * 512 + h * 128 + cc;
    const float* cprev = p.state_conv + (size_t)b * 3 * 1536;
    const float p0 = cprev[ch], p1 = cprev[1536 + ch], p2 = cprev[3072 + ch];
    const float nw = bf2f(PQ[(size_t)row * PQW + 1024 + ch]);
    const float s = p.conv_w[ch] * p0 + p.conv_w[1536 + ch] * p1 + p.conv_w[3072 + ch] * p2 + p.conv_w[4608 + ch] * nw;
    vec[(j * 4 + ty) * 128 + cc] = siluf_(s);
    p.out[O_CVS + (size_t)(b * 3 + 0) * 1536 + ch] = p1;
    p.out[O_CVS + (size_t)(b * 3 + 1) * 1536 + ch] = p2;
  }
  __syncthreads();
  if (w < 4) {
    const int j = 2 + (w >> 1), which = w & 1;
    const float a0 = vec[(j * 4 + which) * 128 + lane], a1 = vec[(j * 4 + which) * 128 + 64 + lane];
    const float ss = wave_sum(a0 * a0 + a1 * a1);
    if (lane == 0) sc[j * 4 + which] = ss;
  }
  __syncthreads();
  {
    const int j = 2 + (tid >> 8), which = (tid >> 7) & 1, c = tid & 127;
    const float r = which == 0 ? rsqrtf(sc[j * 4 + 0] + EPS) * 0.08838834764831845f : rsqrtf(sc[j * 4 + 1] + EPS);
    vec[(j * 4 + which) * 128 + c] *= r;
  }
  __syncthreads();
  if (w < 2) {
    const int j = 2 + w;
    const float qk = wave_sum(vec[(j * 4 + 0) * 128 + lane] * vec[(j * 4 + 1) * 128 + lane] +
                              vec[(j * 4 + 0) * 128 + 64 + lane] * vec[(j * 4 + 1) * 128 + 64 + lane]);
    if (lane == 0) sc[j * 4 + 2] = qk;
  }
  __syncthreads();
  const int n = tid & 127, kp = tid >> 7;
  float cur[32], nxt[32];
  {
    const int it = bid, b = (it >> 2) & 127, h = it & 3;
    const float* S = p.state_hgrn + ((size_t)(b * 4 + h) * 128) * 128;
#pragma unroll
    for (int i = 0; i < 32; ++i) cur[i] = S[(kp * 32 + i) * 128 + n];
  }
#pragma unroll
  for (int j = 0; j < 4; ++j) {
    const int it = bid + 256 * j, b = (it >> 2) & 127, h = it & 3, row = MP + b;
    if (j < 3) {
      const int it2 = bid + 256 * (j + 1), b2 = (it2 >> 2) & 127, h2 = it2 & 3;
      const float* S2 = ((j + 1) < 2 ? p.state_hgrn : p.state_gdn) + ((size_t)(b2 * 4 + h2) * 128) * 128;
#pragma unroll
      for (int i = 0; i < 32; ++i) nxt[i] = S2[(kp * 32 + i) * 128 + n];
    }
    const float* fq = vec + (j * 4 + 0) * 128;
    const float* fk = vec + (j * 4 + 1) * 128;
    const float* fv = vec + (j * 4 + 2) * 128;
    const float* fe = vec + (j * 4 + 3) * 128;
    if (j < 2) {
      float* So = p.out + O_HGS + ((size_t)(b * 4 + h) * 128) * 128;
      const float vn = fv[n];
      float o = 0.f;
#pragma unroll
      for (int i = 0; i < 32; ++i) {
        const int k = kp * 32 + i;
        const float sn = fe[k] * cur[i] + fk[k] * vn;
        So[k * 128 + n] = sn;
        o += fq[k] * sn;
      }
      red[kp * 128 + n] = o;
      __syncthreads();
      if (tid < 128) OPRE[(size_t)row * 1024 + h * 128 + tid] = red[tid] + red[128 + tid] + red[256 + tid] + red[384 + tid];
      __syncthreads();
    } else {
      float* So = p.out + O_GDS + ((size_t)(b * 4 + h) * 128) * 128;
      const float eg = __expf(GDEC[(size_t)row * 4 + h]);
      const float beta = BETA[(size_t)row * 4 + h];
      float ks_ = 0.f, qs_ = 0.f;
#pragma unroll
      for (int i = 0; i < 32; ++i) {
        const int k = kp * 32 + i;
        cur[i] *= eg;
        ks_ += fk[k] * cur[i];
        qs_ += fq[k] * cur[i];
      }
      red[kp * 128 + n] = ks_;
      red[512 + kp * 128 + n] = qs_;
      __syncthreads();
      const float kS = red[n] + red[128 + n] + red[256 + n] + red[384 + n];
      const float delta = (fv[n] - kS) * beta;
#pragma unroll
      for (int i = 0; i < 32; ++i) {
        const int k = kp * 32 + i;
        So[k * 128 + n] = cur[i] + fk[k] * delta;
      }
      if (tid < 128) {
        const float qS = red[512 + n] + red[640 + n] + red[768 + n] + red[896 + n];
        OPRE[(size_t)row * 1024 + 512 + h * 128 + n] = qS + sc[j * 4 + 2] * delta;
      }
      __syncthreads();
    }
#pragma unroll
    for (int i = 0; i < 32; ++i) cur[i] = nxt[i];
  }
}

#define XB_TICKET(j) (3456 + 16 * (j))
__device__ void phase3(const Params& p, char* smem, int bid, int nb) {
  volatile LAS unsigned* st = (volatile LAS unsigned*)(unsigned)(size_t)(smem + LDS_BYTES - 16);
  unsigned* bar = (unsigned*)(p.ws + W_BAR);
  if (threadIdx.x == 0) {
    unsigned ok = (nb == 256) ? 1u : 0u, rank = 0u;
    const unsigned x = xb_xcc_id();
    unsigned npop = 0u;
    for (unsigned j = 0; j < 16; ++j) {
      const unsigned c = xb_ld(&bar[XB_XCNT(j)]);
      if (c != 0u) { ++npop; if (c != 32u) ok = 0u; if (j < x) ++rank; }
    }
    if (npop != 8u) ok = 0u;
    unsigned ticket = 0u;
    if (ok) ticket = xb_add(&bar[XB_TICKET(x)], 1u);
    st[2] = ok ? (0x100u | (rank << 5) | (ticket & 31u)) : 0u;
  }
  __syncthreads();
  const unsigned place = st[2];
  __syncthreads();
  if (place) {
    const int r = (place >> 5) & 7, t = place & 31;
    const int g = (t >> 2) * 8 + r;
    const int uu = (g << 2) | (t & 3);
    if (uu < 128) scan_unit<0>(p, smem, uu); else scan_unit<1>(p, smem, uu - 128);
    if (DUP_MASK & 256) { if (uu < 128) scan_unit<0>(p, smem, uu); else scan_unit<1>(p, smem, uu - 128); }
    if (uu < 128) {
      const int rankH = r * 16 + t;
      sample_block4(p, smem, rankH);
      sample_block4(p, smem, rankH + 128);
    }
    return;
  }
  for (int u = bid; u < 256; u += nb) {
    int uu = u;
    if (nb == 256) {
      const int xcd = u & 7, j = u >> 3;
      uu = ((xcd * 8 + (j >> 2)) << 2) | (j & 3);
    }
    if (uu < 128) scan_unit<0>(p, smem, uu); else scan_unit<1>(p, smem, uu - 128);
  }
  if (nb == 256) {
    if ((bid & 7) < 4) {
      const int rank = (bid >> 3) * 4 + (bid & 3);
      sample_block4(p, smem, rank);
      sample_block4(p, smem, rank + 128);
    }
  } else {
    for (int it = bid; it < 1024; it += nb) sample_item(p, smem, it);
  }
}

__device__ void phase4(const Params& p, int bid, int nb) {
  const int tid = opaque_tid(), lane = tid & 63, w = tid >> 6;
  const float* OPRE = (const float*)(p.ws + W_PQ);
  const u16* GATES = (const u16*)(p.ws + W_GATES);
  u16* A2 = (u16*)(p.ws + W_QS);
  constexpr int NG = MT / 8;
  for (int g = bid; g < NG; g += 2 * nb) {
    const bool two = (g + nb) < NG;
    const int rows[2] = {g * 8 + w, (two ? g + nb : g) * 8 + w};
    f32x4 v[2][4];
    u32x2 gt[2][4];
#pragma unroll
    for (int r = 0; r < 2; ++r)
#pragma unroll
      for (int i = 0; i < 4; ++i) {
        const int col = i * 256 + lane * 4;
        v[r][i] = *(const f32x4*)(OPRE + (size_t)rows[r] * 1024 + col);
        gt[r][i] = *(const u32x2*)(GATES + (size_t)rows[r] * 1024 + col);
      }
#pragma unroll
    for (int r = 0; r < 2; ++r) {
      if (r == 1 && !two) break;
#pragma unroll
      for (int i = 0; i < 4; ++i) {
        const int col = i * 256 + lane * 4;
        float ss = v[r][i][0] * v[r][i][0] + v[r][i][1] * v[r][i][1] + v[r][i][2] * v[r][i][2] + v[r][i][3] * v[r][i][3];
        ss += dpp_mov<0xB1, 0xf>(ss);
        ss += dpp_mov<0x4E, 0xf>(ss);
        ss += dpp_mov<0x141, 0xf>(ss);
        ss += dpp_mov<0x140, 0xf>(ss);
        ss += __shfl_xor(ss, 16, 64);
        const float rstd = rsqrtf(ss * (1.f / 128.f) + EPS);
        const f32x4 nw = *(const f32x4*)((col < 512 ? p.hg_norm : p.gdn_norm) + (col & 127));
        float gg[4];
        unpack4(gt[r][i], gg);
        *(u32x2*)(A2 + (size_t)rows[r] * LDK + col) =
            u32x2{pack2(v[r][i][0] * rstd * nw[0] * gg[0], v[r][i][1] * rstd * nw[1] * gg[1]),
                  pack2(v[r][i][2] * rstd * nw[2] * gg[2], v[r][i][3] * rstd * nw[3] * gg[3])};
      }
    }
  }
}

__device__ void phase6(const Params& p, int bid, int nb) {
  const int tid = opaque_tid(), lane = tid & 63, w = tid >> 6;
  constexpr int NG = MT / 8, NR = 4;
  for (int g = bid; g < NG; g += NR * nb) {
    float* y[NR];
    bool ok[NR];
    float4 xv[NR][4];
    float ss[NR];
#pragma unroll
    for (int r = 0; r < NR; ++r) {
      ok[r] = (g + r * nb) < NG;
      const int row = (ok[r] ? g + r * nb : g) * 8 + w;
      y[r] = row < MP ? p.out + O_YP + (size_t)row * 1024 : p.out + O_YS + (size_t)(row - MP) * 1024;
#pragma unroll
      for (int i = 0; i < 4; ++i) xv[r][i] = *(const float4*)(y[r] + i * 256 + lane * 4);
    }
#pragma unroll
    for (int r = 0; r < NR; ++r) {
      ss[r] = 0.f;
#pragma unroll
      for (int i = 0; i < 4; ++i) ss[r] += xv[r][i].x * xv[r][i].x + xv[r][i].y * xv[r][i].y + xv[r][i].z * xv[r][i].z + xv[r][i].w * xv[r][i].w;
      ss[r] = wave_sum(ss[r]);
    }
#pragma unroll
    for (int r = 0; r < NR; ++r) {
      if (ok[r]) {
        const float rstd = rsqrtf(ss[r] * (1.f / 1024.f) + EPS);
#pragma unroll
        for (int i = 0; i < 4; ++i) {
          const float4 nw = *(const float4*)(p.final_norm + i * 256 + lane * 4);
          float4 o;
          o.x = xv[r][i].x * rstd * nw.x; o.y = xv[r][i].y * rstd * nw.y; o.z = xv[r][i].z * rstd * nw.z; o.w = xv[r][i].w * rstd * nw.w;
          *(float4*)(y[r] + i * 256 + lane * 4) = o;
        }
      }
    }
  }
}


template <int PH>
__device__ __forceinline__ void run_phase(const Params& p, char* smem, int bid, int nb) {
  if (PH == 0) phase0(p, smem, bid, nb);
  else if (PH == 1) gemm_phase<0>(p, (const u16*)(p.ws + W_H), (const u16*)(p.ws + W_WINT), 16, smem, bid, nb);
  else if (PH == 2) phase2(p, smem, bid, nb);
  else if (PH == 3) phase3(p, smem, bid, nb);
  else if (PH == 4) phase4(p, bid, nb);
  else if (PH == 5) gemm_phase<1>(p, (const u16*)(p.ws + W_QS), (const u16*)(p.ws + W_WOUTT), 4, smem, bid, nb);
  else phase6(p, bid, nb);
}

#if MEGA
__global__ void __launch_bounds__(NTH) mega_kernel(Params p) {
  extern __shared__ __attribute__((aligned(16))) char smem[];
  cg::grid_group grid = cg::this_grid();
  const int bid = blockIdx.x, nb = gridDim.x;
  if (p.out == nullptr) grid.sync();
  volatile LAS unsigned* st = (volatile LAS unsigned*)(unsigned)(size_t)(smem + LDS_BYTES - 16);
  if (threadIdx.x == 0) { st[0] = 0u; st[1] = 0u; }
  __syncthreads();
  const XcdBarrier xb = xcd_barrier_post((unsigned*)(p.ws + W_BAR), st);
#define GSYNC() xcd_barrier(xb)
#define RUNP(k) run_phase<k>(p, smem, bid, nb); GSYNC(); if (DUP_MASK & (1 << k)) { run_phase<k>(p, smem, bid, nb); GSYNC(); }
  RUNP(0)
  if (PROBE_SYNC) { for (int i_ = 0; i_ < PROBE_SYNC; ++i_) GSYNC(); }
  RUNP(1)
  if (PROBE_GEMM) { gemm_phase<0, PROBE_GEMM>(p, (const u16*)(p.ws + W_H), (const u16*)(p.ws + W_WINT), 16, smem, bid, nb); GSYNC(); }
  RUNP(2) RUNP(3) RUNP(4) RUNP(5)
#undef RUNP
#undef GSYNC
  run_phase<6>(p, smem, bid, nb);
}
#else
template <int PH>
__global__ void __launch_bounds__(NTH) phase_kernel(Params p) {
  extern __shared__ __attribute__((aligned(16))) char smem[];
  run_phase<PH>(p, smem, blockIdx.x, gridDim.x);
}
template <int PH>
static void launch_phase(const Params& p, int grid, hipStream_t stream) {
  hipFuncSetAttribute((const void*)phase_kernel<PH>, hipFuncAttributeMaxDynamicSharedMemorySize, (int)LDS_BYTES);
  hipLaunchKernelGGL(phase_kernel<PH>, dim3(grid), dim3(NTH), LDS_BYTES, stream, p);
}
#endif

extern "C" void kernel_launch(void* const* d_in, const int* in_sizes, int n_in, void* d_out, int out_size,
                              void* d_ws, size_t ws_size, hipStream_t stream) {
  Params p{};
  p.x_prompt = (const float*)d_in[0];
  p.x_sample = (const float*)d_in[1];
  p.state_hgrn = (const float*)d_in[2];
  p.state_gdn = (const float*)d_in[3];
  p.state_conv = (const float*)d_in[4];
  p.norm_w = (const float*)d_in[5];
  p.w_in = (const float*)d_in[6];
  p.lb_logits = (const float*)d_in[7];
  p.conv_w = (const float*)d_in[8];
  p.a_log = (const float*)d_in[9];
  p.dt_bias = (const float*)d_in[10];
  p.hg_norm = (const float*)d_in[11];
  p.gdn_norm = (const float*)d_in[12];
  p.w_out = (const float*)d_in[13];
  p.final_norm = (const float*)d_in[14];
  p.out = (float*)d_out;
  p.ws = (char*)d_ws;
  if (ws_size < W_END) { fprintf(stderr, "workspace too small: %zu < %zu\n", ws_size, (size_t)W_END); return; }
#if MEGA
  static int grid_blocks = 0;
  if (!grid_blocks) {
    int dev = 0, cus = 0, per_cu = 0;
    hipGetDevice(&dev);
    hipDeviceGetAttribute(&cus, hipDeviceAttributeMultiprocessorCount, dev);
    hipFuncSetAttribute((const void*)mega_kernel, hipFuncAttributeMaxDynamicSharedMemorySize, (int)LDS_BYTES);
    hipOccupancyMaxActiveBlocksPerMultiprocessor(&per_cu, mega_kernel, NTH, LDS_BYTES);
    if (per_cu < 1) per_cu = 1;
    grid_blocks = cus * per_cu;
  }
  (void)hipMemsetAsync((char*)d_ws + W_BAR, 0, 16384, stream);
  void* args[] = {&p};
  hipError_t e = hipLaunchCooperativeKernel((void*)mega_kernel, dim3(grid_blocks), dim3(NTH), args, LDS_BYTES, stream);
  if (e != hipSuccess) fprintf(stderr, "cooperative launch failed: %s (grid %d)\n", hipGetErrorString(e), grid_blocks);
#else
  const int grid = 256;
  launch_phase<0>(p, grid, stream);
  launch_phase<1>(p, grid, stream);
  launch_phase<2>(p, grid, stream);
  launch_phase<3>(p, grid, stream);
  launch_phase<4>(p, grid, stream);
  launch_phase<5>(p, grid, stream);
  launch_phase<6>(p, grid, stream);
#endif
}
```
